# Optimizing an MI355X kernel written in HIP

```python
import math
import jax
import jax.numpy as jnp
from jax import lax
import numpy as np

D_MODEL = 1024
BATCH = 8
SEQ = 4096
DEPTH = 1

CHUNK = 64
D_MIX = D_MODEL
HG_WIDTH = D_MIX // 2
HG_DK = 128
HG_HEADS = HG_WIDTH // HG_DK
HG_DV = HG_WIDTH // HG_HEADS
S5_WIDTH = D_MIX - HG_WIDTH
S5_GROUP = 16
S5_GROUPS = S5_WIDTH // S5_GROUP
S5_STATE = 64
S5_DT_MIN = 1e-3
S5_DT_MAX = 1e-1
IN_COLS = 4 * HG_WIDTH + S5_WIDTH
PEER_KEYS = 128
PEER_EXPERTS = PEER_KEYS * PEER_KEYS
PEER_HEADS = 8
PEER_TOPK = 16
PEER_QDIM = 256
PEER_HALF = PEER_QDIM // 2
PEER_TOKEN_BLOCK = 128
DN_ALPHA = (2.0 * DEPTH) ** 0.25
DN_BETA = (8.0 * DEPTH) ** -0.25
LN_EPS = 1e-5
RMS_EPS = 1e-6

kernel_name = 'hymba_hgrn2_s5_peer_deepnorm'


def layer_norm(x, g, b):
    x = x.astype(jnp.float32)
    mu = jnp.mean(x, axis=-1, keepdims=True)
    var = jnp.mean(jnp.square(x - mu), axis=-1, keepdims=True)
    return (x - mu) * lax.rsqrt(var + LN_EPS) * g + b


def hgrn2_heads(q, f_logit, v_in, gate, lower_bound, norm_g):
    bsz, seq, _ = q.shape
    n_chunks = seq // CHUNK
    forget = lower_bound + (1.0 - lower_bound) * jax.nn.sigmoid(f_logit)
    log_f = jnp.log(forget)
    k_in = 1.0 - forget

    def to_chunks(t, width):
        return t.reshape(bsz, n_chunks, CHUNK, HG_HEADS, width).transpose(1, 0, 3, 2, 4)

    qc = to_chunks(q * HG_DK ** -0.5, HG_DK)
    kc = to_chunks(k_in, HG_DK)
    gc = to_chunks(log_f, HG_DK)
    vc = to_chunks(v_in, HG_DV)
    causal = jnp.tril(jnp.ones((CHUNK, CHUNK), dtype=bool))[:, :, None]

    def chunk_step(state, blk):
        qb, kb, gb, vb = blk
        cum = jnp.cumsum(gb, axis=2)
        inter = jnp.einsum('bhtk,bhkv->bhtv', qb * jnp.exp(cum), state)
        diff = cum[:, :, :, None, :] - cum[:, :, None, :, :]
        decay = jnp.where(causal, jnp.exp(jnp.minimum(diff, 0.0)), 0.0)
        scores = jnp.einsum('bhtk,bhsk,bhtsk->bhts', qb, kb, decay)
        intra = jnp.einsum('bhts,bhsv->bhtv', scores, vb)
        last = cum[:, :, -1, :]
        new_state = jnp.exp(last)[..., None] * state + jnp.einsum(
            'bhsk,bhsv->bhkv', kb * jnp.exp(last[:, :, None, :] - cum), vb)
        return new_state, inter + intra

    state0 = jnp.zeros((bsz, HG_HEADS, HG_DK, HG_DV), jnp.float32)
    _, out = lax.scan(chunk_step, state0, (qc, kc, gc, vc))
    out = out.transpose(1, 0, 3, 2, 4).reshape(bsz, seq, HG_HEADS, HG_DV)
    rms = lax.rsqrt(jnp.mean(jnp.square(out), axis=-1, keepdims=True) + RMS_EPS)
    gate = gate.reshape(bsz, seq, HG_HEADS, HG_DV)
    out = out * rms * norm_g * jax.nn.silu(gate)
    return out.reshape(bsz, seq, HG_WIDTH)


def complex_affine_combine(e1, e2):
    a1r, a1i, b1r, b1i = e1
    a2r, a2i, b2r, b2i = e2
    return (a2r * a1r - a2i * a1i,
            a2r * a1i + a2i * a1r,
            a2r * b1r - a2i * b1i + b2r,
            a2r * b1i + a2i * b1r + b2i)


def s5_groups(u, a_re, a_im, log_step, b_re, b_im, c_re, c_im, d_skip, w_glu, b_glu):
    f32 = jnp.float32
    a_re, a_im = a_re.astype(f32), a_im.astype(f32)
    b_re, b_im = b_re.astype(f32), b_im.astype(f32)
    bsz, seq, _ = u.shape
    ug = u.reshape(bsz, seq, S5_GROUPS, S5_GROUP)
    step = jnp.exp(log_step.astype(f32))[:, None]
    mag = jnp.exp(step * a_re)
    abar_re = mag * jnp.cos(step * a_im)
    abar_im = mag * jnp.sin(step * a_im)
    num_re, num_im = abar_re - 1.0, abar_im
    den = jnp.square(a_re) + jnp.square(a_im)
    coef_re = ((num_re * a_re + num_im * a_im) / den)[..., None]
    coef_im = ((num_im * a_re - num_re * a_im) / den)[..., None]
    bbar_re = coef_re * b_re - coef_im * b_im
    bbar_im = coef_re * b_im + coef_im * b_re
    bu_re = jnp.einsum('bsgp,gnp->bsgn', ug, bbar_re)
    bu_im = jnp.einsum('bsgp,gnp->bsgn', ug, bbar_im)
    ar = jnp.broadcast_to(abar_re, (1, seq, S5_GROUPS, S5_STATE))
    ai = jnp.broadcast_to(abar_im, (1, seq, S5_GROUPS, S5_STATE))
    _, _, x_re, x_im = lax.associative_scan(
        complex_affine_combine, (ar, ai, bu_re, bu_im), axis=1)
    y = (jnp.einsum('bsgn,gpn->bsgp', x_re, c_re)
         - jnp.einsum('bsgn,gpn->bsgp', x_im, c_im)
         + d_skip * ug)
    y = y.reshape(bsz, seq, S5_WIDTH)
    z = jax.nn.gelu(y)
    return z * jax.nn.sigmoid(jnp.einsum('bsc,cd->bsd', z, w_glu) + b_glu)


def peer_ffn(h, w_query, keys_1, keys_2, w_down, w_up):
    bsz, seq, dim = h.shape
    tokens = h.reshape(-1, PEER_TOKEN_BLOCK, dim)

    def block(xb):
        q = jnp.einsum('td,dq->tq', xb, w_query).reshape(
            PEER_TOKEN_BLOCK, PEER_HEADS, 2, PEER_HALF)
        s1 = jnp.einsum('thd,nd->thn', q[:, :, 0], keys_1)
        s2 = jnp.einsum('thd,nd->thn', q[:, :, 1], keys_2)
        v1, i1 = lax.top_k(s1, PEER_TOPK)
        v2, i2 = lax.top_k(s2, PEER_TOPK)
        cand = (v1[..., :, None] + v2[..., None, :]).reshape(
            PEER_TOKEN_BLOCK, PEER_HEADS, PEER_TOPK * PEER_TOPK)
        cidx = (i1[..., :, None] * PEER_KEYS + i2[..., None, :]).reshape(
            PEER_TOKEN_BLOCK, PEER_HEADS, PEER_TOPK * PEER_TOPK)
        best, pos = lax.top_k(cand, PEER_TOPK)
        expert = jnp.take_along_axis(cidx, pos, axis=-1)
        gate = jax.nn.softmax(best.astype(jnp.float32), axis=-1)
        u = jnp.take(w_down, expert, axis=0)
        act = jax.nn.gelu(jnp.einsum('td,thkd->thk', xb, u)) * gate
        v = jnp.take(w_up, expert, axis=0)
        return jnp.einsum('thk,thkd->td', act, v)

    out = lax.map(block, tokens)
    return out.reshape(bsz, seq, dim)


def setup_inputs(seed: int = 0) -> dict:
    key = jax.random.key(seed)
    ks = jax.random.split(key, 32)
    f32 = jnp.float32

    def nrm(k, shape, scale):
        return jax.random.normal(k, shape, f32) * scale

    col_scale = jnp.concatenate([
        jnp.ones((2 * HG_WIDTH,), f32),
        jnp.full((HG_WIDTH,), DN_BETA, f32),
        jnp.ones((HG_WIDTH,), f32),
        jnp.full((S5_WIDTH,), DN_BETA, f32)])
    n_idx = jnp.arange(S5_STATE, dtype=f32)
    return {
        'x': nrm(ks[0], (BATCH, SEQ, D_MODEL), 1.0),
        'ln0_g': 1.0 + nrm(ks[1], (D_MODEL,), 0.02),
        'ln0_b': nrm(ks[2], (D_MODEL,), 0.02),
        'w_in': nrm(ks[3], (DEPTH, D_MODEL, IN_COLS), D_MODEL ** -0.5) * col_scale,
        'hg_lb_logits': nrm(ks[4], (DEPTH + 1, HG_WIDTH), 1.0),
        'hg_norm_g': 1.0 + nrm(ks[5], (DEPTH, HG_DV), 0.02),
        's5_a_re': -0.5 + nrm(ks[6], (DEPTH, S5_GROUPS, S5_STATE), 0.01),
        's5_a_im': jnp.pi * n_idx + nrm(ks[7], (DEPTH, S5_GROUPS, S5_STATE), 0.01),
        's5_log_step': jax.random.uniform(ks[8], (DEPTH, S5_GROUPS), f32,
                                          math.log(S5_DT_MIN), math.log(S5_DT_MAX)),
        's5_b_re': nrm(ks[9], (DEPTH, S5_GROUPS, S5_STATE, S5_GROUP), (2.0 * S5_GROUP) ** -0.5),
        's5_b_im': nrm(ks[10], (DEPTH, S5_GROUPS, S5_STATE, S5_GROUP), (2.0 * S5_GROUP) ** -0.5),
        's5_c_re': nrm(ks[11], (DEPTH, S5_GROUPS, S5_GROUP, S5_STATE), (2.0 * S5_STATE) ** -0.5),
        's5_c_im': nrm(ks[12], (DEPTH, S5_GROUPS, S5_GROUP, S5_STATE), (2.0 * S5_STATE) ** -0.5),
        's5_d': nrm(ks[13], (DEPTH, S5_GROUPS, S5_GROUP), 1.0),
        'w_glu': nrm(ks[14], (DEPTH, S5_WIDTH, S5_WIDTH), S5_WIDTH ** -0.5),
        'b_glu': nrm(ks[15], (DEPTH, S5_WIDTH), 0.02),
        'w_out': nrm(ks[16], (DEPTH, D_MIX, D_MODEL), DN_BETA * D_MIX ** -0.5),
        'ln1_g': 1.0 + nrm(ks[17], (DEPTH, D_MODEL), 0.02),
        'ln1_b': nrm(ks[18], (DEPTH, D_MODEL), 0.02),
        'w_query': nrm(ks[19], (DEPTH, D_MODEL, PEER_HEADS * PEER_QDIM), D_MODEL ** -0.5),
        'peer_keys_1': nrm(ks[20], (DEPTH, PEER_KEYS, PEER_HALF), PEER_HALF ** -0.5),
        'peer_keys_2': nrm(ks[21], (DEPTH, PEER_KEYS, PEER_HALF), PEER_HALF ** -0.5),
        'peer_down': nrm(ks[22], (DEPTH, PEER_EXPERTS, D_MODEL), D_MODEL ** -0.5),
        'peer_up': nrm(ks[23], (DEPTH, PEER_EXPERTS, D_MODEL), DN_BETA * PEER_HEADS ** -0.5),
        'ln2_g': 1.0 + nrm(ks[24], (DEPTH, D_MODEL), 0.02),
        'ln2_b': nrm(ks[25], (DEPTH, D_MODEL), 0.02),
    }


def reference(x, ln0_g, ln0_b, w_in, hg_lb_logits, hg_norm_g, s5_a_re, s5_a_im,
              s5_log_step, s5_b_re, s5_b_im, s5_c_re, s5_c_im, s5_d, w_glu, b_glu,
              w_out, ln1_g, ln1_b, w_query, peer_keys_1, peer_keys_2, peer_down,
              peer_up, ln2_g, ln2_b):
    h = layer_norm(x, ln0_g, ln0_b)
    lower_bounds = jnp.cumsum(
        jax.nn.softmax(hg_lb_logits.astype(jnp.float32), axis=0), axis=0)
    for layer in range(DEPTH):
        proj = jnp.einsum('bsd,dc->bsc', h, w_in[layer])
        q, f_logit, v_in, gate, u = jnp.split(
            proj, [HG_WIDTH, 2 * HG_WIDTH, 3 * HG_WIDTH, 4 * HG_WIDTH], axis=-1)
        mix_a = hgrn2_heads(q, f_logit, v_in, gate, lower_bounds[layer], hg_norm_g[layer])
        mix_b = s5_groups(u, s5_a_re[layer], s5_a_im[layer], s5_log_step[layer],
                          s5_b_re[layer], s5_b_im[layer], s5_c_re[layer], s5_c_im[layer],
                          s5_d[layer], w_glu[layer], b_glu[layer])
        mixed = jnp.einsum('bsc,cd->bsd', jnp.concatenate([mix_a, mix_b], axis=-1),
                           w_out[layer])
        h = layer_norm(DN_ALPHA * h + mixed, ln1_g[layer], ln1_b[layer])
        ffn = peer_ffn(h, w_query[layer], peer_keys_1[layer], peer_keys_2[layer],
                       peer_down[layer], peer_up[layer])
        h = layer_norm(DN_ALPHA * h + ffn, ln2_g[layer], ln2_b[layer])
    return h.astype(x.dtype)
```

```cpp
#include <hip/hip_runtime.h>
#include <cstdio>
#include <cstdint>
namespace pg8 {
#define PG8_LAS __attribute__((address_space(3)))
typedef unsigned short bf16_t;
typedef short bf16x8 __attribute__((ext_vector_type(8)));
typedef float f32x4 __attribute__((ext_vector_type(4)));
typedef unsigned u32x4 __attribute__((ext_vector_type(4)));
constexpr int BM = 256, BK = 64, HALF = 128, HTB = HALF * BK * 2  , STAGE_BYTES = 8 * HTB, NXCD = 8, WGM = 8;

__host__ __device__ __forceinline__ int lds_byte(int r, int c) { const int st = (r >> 4) * 2 + (c >> 5), rr = r & 15, cc = c & 31, ob = rr * 64 + cc * 2; return st * 1024 + (ob ^ (((ob >> 9) & 1) << 5)); }
__host__ __device__ __forceinline__ void stage_rc(int b, int& R, int& C) { const int st = b / 1024, sb = b % 1024, swz = sb ^ (((sb >> 9) & 1) << 5); R = (st >> 1) * 16 + swz / 64; C = (st & 1) * 32 + (swz % 64) / 2; }
__host__ __device__ __forceinline__ int perm32(int rho) { const int n = rho >> 4, i = rho & 15; return 8 * (i >> 2) + 4 * n + (i & 3); }

struct Unit { int pm, pn; };
struct Gemm { const bf16_t* A; const bf16_t* Bt; int M, N, K; };

struct StaticOrder {
    int nM, nN, nwg, G, c;
    __host__ __device__ void init(int M, int N, int G_, int c_) { nM = M / BM; nN = N / BM; nwg = nM * nN; G = G_; c = c_; }
    __host__ __device__ bool next(int i, Unit& u) const {
        const long L = (long)i * G + c; if (L >= nwg) return false;
        int wgid = (int)L; { const int q = nwg / NXCD, r = nwg % NXCD, xcd = wgid % NXCD, off = wgid / NXCD; wgid = (xcd < r ? xcd * (q + 1) : r * (q + 1) + (xcd - r) * q) + off; }
        const int nig = WGM * nN, gid = wgid / nig, fm = gid * WGM, gsz = (nM - fm) < WGM ? (nM - fm) : WGM;
        u.pm = fm + ((wgid % nig) % gsz); u.pn = (wgid % nig) / gsz; return true;
    }
    __device__ __forceinline__ void a_ready(const Unit&) const {}
    __device__ __forceinline__ void done(const Unit&) const {}
};

__device__ __forceinline__ unsigned cvt_pk_bf16(float lo, float hi) { unsigned r; asm volatile("v_cvt_pk_bf16_f32 %0, %1, %2" : "=v"(r) : "v"(lo), "v"(hi)); return r; }
__device__ __forceinline__ void unpack8(const u32x4 w, float (&f)[8]) {
    f[0] = __builtin_bit_cast(float, w.x << 16); f[1] = __builtin_bit_cast(float, w.x & 0xffff0000u);
    f[2] = __builtin_bit_cast(float, w.y << 16); f[3] = __builtin_bit_cast(float, w.y & 0xffff0000u);
    f[4] = __builtin_bit_cast(float, w.z << 16); f[5] = __builtin_bit_cast(float, w.z & 0xffff0000u);
    f[6] = __builtin_bit_cast(float, w.w << 16); f[7] = __builtin_bit_cast(float, w.w & 0xffff0000u);
}
__device__ __forceinline__ u32x4 pack8(const float (&f)[8]) { u32x4 w; w.x = cvt_pk_bf16(f[0], f[1]); w.y = cvt_pk_bf16(f[2], f[3]); w.z = cvt_pk_bf16(f[4], f[5]); w.w = cvt_pk_bf16(f[6], f[7]); return w; }

struct EpiStore {
    static constexpr bool PERM = true, AFTER_DRAIN = false;
    bf16_t* O; int ldc;
    __device__ __forceinline__ void operator()(const f32x4 (&acc)[2][2][4][2], const Unit& u, int wr, int wc, int fr, int fq) const {
        const int row0 = u.pm * BM + wr * 64 + fr, col0 = u.pn * BM + wc * 32 + 8 * fq;
#pragma unroll
        for (int ai = 0; ai < 2; ++ai)
#pragma unroll
            for (int m = 0; m < 4; ++m) { bf16_t* rowp = O + (size_t)(row0 + ai * HALF + m * 16) * ldc + col0;
#pragma unroll
                for (int bj = 0; bj < 2; ++bj) { const f32x4 v0 = acc[ai][bj][m][0], v1 = acc[ai][bj][m][1];
                    u32x4 w; w.x = cvt_pk_bf16(v0[0], v0[1]); w.y = cvt_pk_bf16(v0[2], v0[3]); w.z = cvt_pk_bf16(v1[0], v1[1]); w.w = cvt_pk_bf16(v1[2], v1[3]);
                    *(u32x4*)(rowp + bj * HALF) = w; } }
    }
};

struct EpiProj {
    static constexpr bool PERM = true, AFTER_DRAIN = false;
    bf16_t* Qb; bf16_t* LFb; bf16_t* Vb; bf16_t* Gb; bf16_t* Ub; const float* lb; int M;
    __device__ __forceinline__ void operator()(const f32x4 (&acc)[2][2][4][2], const Unit& u, int wr, int wc, int fr, int fq) const {
        const int row0 = u.pm * BM + wr * 64 + fr; const int colt = u.pn * BM; const int t = colt >> 9;
        const int cb = (colt & 511) + wc * 32 + 8 * fq;
        float lbv[2][8];
        if (t == 1) {
#pragma unroll
            for (int bj = 0; bj < 2; ++bj) { const f32x4 a = *(const f32x4*)(lb + cb + bj * HALF), b = *(const f32x4*)(lb + cb + bj * HALF + 4);
                lbv[bj][0] = a[0]; lbv[bj][1] = a[1]; lbv[bj][2] = a[2]; lbv[bj][3] = a[3]; lbv[bj][4] = b[0]; lbv[bj][5] = b[1]; lbv[bj][6] = b[2]; lbv[bj][7] = b[3]; }
        }
#pragma unroll
        for (int ai = 0; ai < 2; ++ai)
#pragma unroll
            for (int m = 0; m < 4; ++m) { const int row = row0 + ai * HALF + m * 16;
#pragma unroll
                for (int bj = 0; bj < 2; ++bj) { const f32x4 v0 = acc[ai][bj][m][0], v1 = acc[ai][bj][m][1]; const int c = cb + bj * HALF;
                    float f[8] = {v0[0], v0[1], v0[2], v0[3], v1[0], v1[1], v1[2], v1[3]};
                    if (t == 0) {
#pragma unroll
                        for (int j = 0; j < 8; ++j) f[j] *= 0.08838834764831845f;
                        *(u32x4*)(Qb + (size_t)row * 512 + c) = pack8(f);
                    } else if (t == 1) {
#pragma unroll
                        for (int j = 0; j < 8; ++j) { const float l = lbv[bj][j]; const float sg = 1.f / (1.f + __expf(-f[j])); f[j] = __logf(l + (1.f - l) * sg); }
                        *(u32x4*)(LFb + (size_t)row * 512 + c) = pack8(f);
                    } else if (t == 2) { *(u32x4*)(Vb + (size_t)row * 512 + c) = pack8(f);
                    } else if (t == 3) { *(u32x4*)(Gb + (size_t)row * 512 + c) = pack8(f);
                    } else { *(u32x4*)(Ub + ((size_t)(c >> 4) * M + row) * 16 + (c & 15)) = pack8(f); }
                } }
    }
};

struct EpiGlu {
    static constexpr bool PERM = true, AFTER_DRAIN = false;
    const bf16_t* Z; bf16_t* MIX; const float* bglu;
    __device__ __forceinline__ void operator()(const f32x4 (&acc)[2][2][4][2], const Unit& u, int wr, int wc, int fr, int fq) const {
        const int row0 = u.pm * BM + wr * 64 + fr, col0 = u.pn * BM + wc * 32 + 8 * fq;
#pragma unroll
        for (int bj = 0; bj < 2; ++bj) { const int c = col0 + bj * HALF;
            const f32x4 b0 = *(const f32x4*)(bglu + c), b1 = *(const f32x4*)(bglu + c + 4);
#pragma unroll
            for (int ai = 0; ai < 2; ++ai)
#pragma unroll
                for (int m = 0; m < 4; ++m) { const int row = row0 + ai * HALF + m * 16;
                    const f32x4 v0 = acc[ai][bj][m][0] + b0, v1 = acc[ai][bj][m][1] + b1;
                    float z[8]; unpack8(*(const u32x4*)(Z + (size_t)row * 512 + c), z);
                    float f[8] = {v0[0], v0[1], v0[2], v0[3], v1[0], v1[1], v1[2], v1[3]};
#pragma unroll
                    for (int j = 0; j < 8; ++j) f[j] = z[j] / (1.f + __expf(-f[j]));
                    *(u32x4*)(MIX + (size_t)row * 1024 + 512 + c) = pack8(f); } }
    }
};

struct EpiOut {
    static constexpr bool PERM = true, AFTER_DRAIN = false;
    bf16_t* H; float alpha;
    __device__ __forceinline__ void operator()(const f32x4 (&acc)[2][2][4][2], const Unit& u, int wr, int wc, int fr, int fq) const {
        const int row0 = u.pm * BM + wr * 64 + fr, col0 = u.pn * BM + wc * 32 + 8 * fq;
#pragma unroll
        for (int ai = 0; ai < 2; ++ai)
#pragma unroll
            for (int m = 0; m < 4; ++m) { bf16_t* rowp = H + (size_t)(row0 + ai * HALF + m * 16) * 1024 + col0;
#pragma unroll
                for (int bj = 0; bj < 2; ++bj) { const f32x4 v0 = acc[ai][bj][m][0], v1 = acc[ai][bj][m][1];
                    float h[8]; unpack8(*(const u32x4*)(rowp + bj * HALF), h);
                    float f[8] = {v0[0], v0[1], v0[2], v0[3], v1[0], v1[1], v1[2], v1[3]};
#pragma unroll
                    for (int j = 0; j < 8; ++j) f[j] = alpha * h[j] + f[j];
                    *(u32x4*)(rowp + bj * HALF) = pack8(f); } }
    }
};

template <class Epi, class Sched, bool ALIGN_EPI = false, bool SP2 = false>
__device__ __forceinline__ void gemm_phase(PG8_LAS unsigned char* lds, const Gemm g, const Sched& S, const Epi& E) {
    const int tid = threadIdx.x, wid = __builtin_amdgcn_readfirstlane(tid >> 6), lane = tid & 63, wr = wid >> 2, wc = wid & 3, fr = lane & 15, fq = lane >> 4;
    const int K = g.K, nt = K / BK;
    unsigned voffA[2], voffB[2];
#pragma unroll
    for (int i = 0; i < 2; ++i) { int R, C; stage_rc(tid * 16 + i * 8192, R, C); const int Rb = Epi::PERM ? ((R & ~31) + perm32(R & 31)) : R;
        voffA[i] = (unsigned)(R * K + C) * 2u; voffB[i] = (unsigned)(Rb * K + C) * 2u; }
    const size_t kstep = (size_t)(BK * 2);
    const size_t hstep = (size_t)HALF * K * 2;
    const size_t tstep = 2 * hstep;
    const unsigned ldsw = (unsigned)wid * 1024u;
    const int aoff = lds_byte(wr * 64 + fr, fq * 8), boff = lds_byte(wc * 32 + fr, fq * 8);
#define PG8_SA(b, h) (((b) * 2 + (h)) * HTB)
#define PG8_SB(b, h) ((4 + (b) * 2 + (h)) * HTB)
#define PG8_STAGE(bufoff, gbase, voff) do { _Pragma("unroll") for (int _i = 0; _i < 2; ++_i) \
        __builtin_amdgcn_global_load_lds((const unsigned*)((const char*)(gbase) + (voff)[_i]), (PG8_LAS unsigned*)(lds + (bufoff) + ldsw + _i * 8192), 16, 0, 0); } while (0)
#define PG8_LDA(dst, b, h) do { _Pragma("unroll") for (int m = 0; m < 4; ++m) _Pragma("unroll") for (int k = 0; k < 2; ++k) dst[m][k] = *(const PG8_LAS bf16x8*)(lds + PG8_SA(b, h) + aoff + m * 2048 + k * 1024); } while (0)
#define PG8_LDB(dst, b, h) do { _Pragma("unroll") for (int n = 0; n < 2; ++n) _Pragma("unroll") for (int k = 0; k < 2; ++k) dst[n][k] = *(const PG8_LAS bf16x8*)(lds + PG8_SB(b, h) + boff + n * 2048 + k * 1024); } while (0)
#define PG8_MMA(ai, bj, At, Bt) do { __builtin_amdgcn_s_setprio(1); _Pragma("unroll") for (int m = 0; m < 4; ++m) _Pragma("unroll") for (int n = 0; n < 2; ++n) _Pragma("unroll") for (int k = 0; k < 2; ++k) \
        acc[ai][bj][m][n] = __builtin_amdgcn_mfma_f32_16x16x32_bf16(Bt[n][k], At[m][k], acc[ai][bj][m][n], 0, 0, 0); __builtin_amdgcn_s_setprio(0); } while (0)
#define PG8_WAIT_V(n) asm volatile("s_waitcnt vmcnt(" #n ")" ::: "memory")
#define PG8_WAIT_L(n) asm volatile("s_waitcnt lgkmcnt(" #n ")" ::: "memory")
#define PG8_BAR __builtin_amdgcn_s_barrier()
#define PG8_SCHED __builtin_amdgcn_sched_barrier(0)
    Unit cur, nxt; int ui = 0;
    if (!S.next(0, cur)) return;
    f32x4 acc[2][2][4][2];
#pragma unroll
    for (int a = 0; a < 2; ++a)
#pragma unroll
        for (int b = 0; b < 2; ++b)
#pragma unroll
            for (int m = 0; m < 4; ++m)
#pragma unroll
                for (int n = 0; n < 2; ++n) acc[a][b][m][n] = (f32x4){0.f, 0.f, 0.f, 0.f};
    bf16x8 At[4][2], B0[2][2], B1[2][2];
    const char* cA = (const char*)g.A + (size_t)cur.pm * tstep; const char* cB = (const char*)g.Bt + (size_t)cur.pn * tstep;
    S.a_ready(cur);
    if constexpr (SP2) {
        PG8_STAGE(PG8_SB(0, 0), cB, voffB); PG8_STAGE(PG8_SB(0, 1), cB + hstep, voffB); PG8_STAGE(PG8_SA(0, 0), cA, voffA); PG8_STAGE(PG8_SA(0, 1), cA + hstep, voffA);
        if (wr == 1) PG8_BAR;
        PG8_WAIT_V(2); PG8_BAR;
        PG8_STAGE(PG8_SB(1, 0), cB + kstep, voffB); PG8_STAGE(PG8_SA(1, 0), cA + kstep, voffA); PG8_STAGE(PG8_SB(1, 1), cB + hstep + kstep, voffB);
        PG8_WAIT_V(6); PG8_BAR;
    } else {
        PG8_STAGE(PG8_SB(0, 0), cB, voffB); PG8_STAGE(PG8_SA(0, 0), cA, voffA); PG8_STAGE(PG8_SB(0, 1), cB + hstep, voffB); PG8_STAGE(PG8_SA(0, 1), cA + hstep, voffA);
        if (wr == 1) PG8_BAR;
        PG8_WAIT_V(4); PG8_BAR;
        PG8_STAGE(PG8_SB(1, 0), cB + kstep, voffB); PG8_STAGE(PG8_SA(1, 0), cA + kstep, voffA); PG8_STAGE(PG8_SB(1, 1), cB + hstep + kstep, voffB);
        PG8_WAIT_V(6); PG8_BAR;
    }
    for (;;) {
        const bool has_next = S.next(ui + 1, nxt);
        const char* nA = has_next ? (const char*)g.A + (size_t)nxt.pm * tstep : cA; const char* nB = has_next ? (const char*)g.Bt + (size_t)nxt.pn * tstep : cB;
        for (int t = 0; t < nt; t += 2) {
            const bool last = (t == nt - 2);
            const char* a1 = cA + (size_t)(t + 1) * kstep;
            const char* a2 = last ? nA : cA + (size_t)(t + 2) * kstep; const char* b2 = last ? nB : cB + (size_t)(t + 2) * kstep;
            const char* a3 = a2 + kstep; const char* b3 = b2 + kstep;
            if (last && has_next) S.a_ready(nxt);
            if constexpr (SP2) {
            PG8_LDB(B0, 0, 0); PG8_LDB(B1, 0, 1); PG8_SCHED; PG8_LDA(At, 0, 0); PG8_STAGE(PG8_SA(1, 1), a1 + hstep, voffA);
            PG8_WAIT_V(8); PG8_WAIT_L(0); PG8_BAR; PG8_MMA(0, 0, At, B0); PG8_MMA(0, 1, At, B1); PG8_BAR; PG8_SCHED;
            PG8_LDA(At, 0, 1); PG8_STAGE(PG8_SB(0, 0), b2, voffB); PG8_STAGE(PG8_SB(0, 1), b2 + hstep, voffB); PG8_STAGE(PG8_SA(0, 0), a2, voffA);
            PG8_WAIT_V(8); PG8_WAIT_L(0); PG8_BAR; PG8_MMA(1, 0, At, B0); PG8_MMA(1, 1, At, B1); PG8_BAR; PG8_SCHED;
            PG8_LDB(B0, 1, 0); PG8_LDB(B1, 1, 1); PG8_SCHED; PG8_LDA(At, 1, 0); PG8_STAGE(PG8_SA(0, 1), a2 + hstep, voffA);
            PG8_WAIT_V(8); PG8_WAIT_L(0); PG8_BAR; PG8_MMA(0, 0, At, B0); PG8_MMA(0, 1, At, B1); PG8_BAR; PG8_SCHED;
            PG8_LDA(At, 1, 1); PG8_STAGE(PG8_SB(1, 0), b3, voffB); PG8_STAGE(PG8_SB(1, 1), b3 + hstep, voffB); PG8_STAGE(PG8_SA(1, 0), a3, voffA);
            PG8_WAIT_V(8); PG8_WAIT_L(0); PG8_BAR; PG8_MMA(1, 0, At, B0); PG8_MMA(1, 1, At, B1); PG8_BAR; PG8_SCHED;
            } else {
            PG8_LDB(B0, 0, 0); PG8_SCHED; PG8_LDA(At, 0, 0); PG8_STAGE(PG8_SA(1, 1), a1 + hstep, voffA);
            PG8_WAIT_L(8); PG8_BAR; PG8_WAIT_L(0); PG8_MMA(0, 0, At, B0); PG8_BAR; PG8_SCHED;
            PG8_LDB(B1, 0, 1); PG8_STAGE(PG8_SB(0, 0), b2, voffB);
            PG8_BAR; PG8_WAIT_L(0); PG8_MMA(0, 1, At, B1); PG8_BAR;
            PG8_LDA(At, 0, 1); PG8_STAGE(PG8_SA(0, 0), a2, voffA);
            PG8_BAR; PG8_WAIT_L(0); PG8_MMA(1, 0, At, B0); PG8_BAR; PG8_SCHED;
            PG8_STAGE(PG8_SB(0, 1), b2 + hstep, voffB);
            PG8_WAIT_V(6); PG8_BAR; PG8_MMA(1, 1, At, B1); PG8_BAR;
            PG8_LDB(B0, 1, 0); PG8_SCHED; PG8_LDA(At, 1, 0); PG8_STAGE(PG8_SA(0, 1), a2 + hstep, voffA);
            PG8_WAIT_L(8); PG8_BAR; PG8_WAIT_L(0); PG8_MMA(0, 0, At, B0); PG8_BAR; PG8_SCHED;
            PG8_LDB(B1, 1, 1); PG8_STAGE(PG8_SB(1, 0), b3, voffB);
            PG8_BAR; PG8_WAIT_L(0); PG8_MMA(0, 1, At, B1); PG8_BAR;
            PG8_LDA(At, 1, 1); PG8_STAGE(PG8_SA(1, 0), a3, voffA);
            PG8_BAR; PG8_WAIT_L(0); PG8_MMA(1, 0, At, B0); PG8_BAR; PG8_SCHED;
            PG8_STAGE(PG8_SB(1, 1), b3 + hstep, voffB);
            PG8_WAIT_V(6); PG8_BAR; PG8_MMA(1, 1, At, B1); PG8_BAR;
            }
        }
        if constexpr (ALIGN_EPI) { if (wr == 0) PG8_BAR; }
        if constexpr (!Epi::AFTER_DRAIN) { E(acc, cur, wr, wc, fr, fq); S.done(cur); }
        if (!has_next) break;
#pragma unroll
        for (int a = 0; a < 2; ++a)
#pragma unroll
            for (int b = 0; b < 2; ++b)
#pragma unroll
                for (int m = 0; m < 4; ++m)
#pragma unroll
                    for (int n = 0; n < 2; ++n) acc[a][b][m][n] = (f32x4){0.f, 0.f, 0.f, 0.f};
        cur = nxt; cA = nA; cB = nB; ++ui;
        if constexpr (ALIGN_EPI) { if (wr == 1) PG8_BAR; }
    }
    PG8_WAIT_V(0);
    if constexpr (!ALIGN_EPI) { if (wr == 0) PG8_BAR; }
    PG8_BAR;
    if constexpr (Epi::AFTER_DRAIN) { E.fused(acc, cur, wr, wc, fr, fq, lds, wid, lane); S.done(cur); }
#undef PG8_SA
#undef PG8_SB
#undef PG8_STAGE
#undef PG8_LDA
#undef PG8_LDB
#undef PG8_MMA
#undef PG8_WAIT_V
#undef PG8_WAIT_L
#undef PG8_BAR
#undef PG8_SCHED
}
}

constexpr int NWAVES = 8;
#ifndef MK_N_LAUNCHES
#define MK_N_LAUNCHES 9
#endif
constexpr int N_LAUNCHES = MK_N_LAUNCHES;
constexpr int NPH = 9;

constexpr int BATCH = 8, SEQ = 4096, D = 1024, M = BATCH * SEQ;
constexpr int HGW = 512, HGH = 4, HGK = 128;
constexpr int S5W = 512, S5G = 32, S5P = 16, S5N = 64;
constexpr int NPROJ = 2560;
constexpr int PK = 128, PH = 8, PTOPK = 16, PQ = 256, PHALF = 128, PE = PK * PK, NQ2 = PH * PQ;
constexpr float LN_EPS = 1e-5f, RMS_EPS = 1e-6f;
constexpr float DN_ALPHA = 1.189207115002721f;

constexpr size_t MiB = 1u << 20;
constexpr size_t WS_CTL = 0, CTL_ZERO_BYTES = 1 * MiB;
constexpr size_t WS_WIN = 1 * MiB;
constexpr size_t WS_WGLU = 6 * MiB;
constexpr size_t WS_KEYS = 6 * MiB + 512 * 1024;
constexpr size_t WS_LB = 6 * MiB + 640 * 1024;
constexpr size_t WS_S5T = 6 * MiB + 704 * 1024;
constexpr size_t WS_WOUT = 7 * MiB + 512 * 1024;
constexpr size_t WS_WQ = 10 * MiB;
constexpr size_t WS_PD = 14 * MiB;
constexpr size_t WS_PU = 46 * MiB;
constexpr size_t WS_H = 78 * MiB;
constexpr size_t WS_PROJ = 142 * MiB;
constexpr size_t WS_Q2 = WS_PROJ;
constexpr size_t WS_MIX = 302 * MiB;
constexpr size_t WS_Z = 366 * MiB;
constexpr size_t WS_EIDX = 398 * MiB;
constexpr size_t WS_EGATE = 414 * MiB;
constexpr size_t WS_END = 430 * MiB;
constexpr int CW_TMO = 0, CW_CODE = 1;
constexpr int CW_BAR = 4096;

constexpr int RING_OFF = 0, RING_BYTES = 131072;
constexpr int LDSCTL_OFF = RING_BYTES, MISC_OFF = LDSCTL_OFF + 320;
constexpr int LDS_BYTES = 147456;
static_assert(MISC_OFF + 128 <= LDS_BYTES, "LDS map");

#define GAS __attribute__((address_space(1)))
#define LAS __attribute__((address_space(3)))
typedef unsigned short bf16;
typedef unsigned v4u __attribute__((ext_vector_type(4)));
typedef float f32x4 __attribute__((ext_vector_type(4)));
typedef short bf16x8 __attribute__((ext_vector_type(8)));
typedef GAS unsigned gu32;
typedef GAS unsigned long long gu64;
#define RLX_AGENT __ATOMIC_RELAXED, __HIP_MEMORY_SCOPE_AGENT
#define LDS_WAIT() asm volatile("s_waitcnt lgkmcnt(0)" ::: "memory")
#define VM_WAIT() asm volatile("s_waitcnt vmcnt(0)" ::: "memory")
__device__ __forceinline__ unsigned long long rt() { return __builtin_amdgcn_s_memrealtime(); }
__device__ __forceinline__ unsigned f2bf(float f) { unsigned u = __builtin_bit_cast(unsigned, f); return (u + 0x7fffu + ((u >> 16) & 1u)) >> 16; }
__device__ __forceinline__ unsigned pk2(float lo, float hi) { return f2bf(lo) | (f2bf(hi) << 16); }

#define XB_TMO      128
#define XB_XCNT(j)  (256  + 64 * (j))
#define XB_XSUB(j)  (1280 + 64 * (j))
#define XB_XGEN(j)  (2304 + 64 * (j))
#define XB_TOP      3328
#define XB_TOPGEN   3392
#define XCD_BAR_WORDS 3456
#define XB_SPIN_CAP (1u << 18)

__device__ __forceinline__ unsigned xb_ld(unsigned* p)              { return __hip_atomic_load(p, __ATOMIC_RELAXED, __HIP_MEMORY_SCOPE_AGENT); }
__device__ __forceinline__ unsigned xb_add(unsigned* p, unsigned v) { return __hip_atomic_fetch_add(p, v, __ATOMIC_RELAXED, __HIP_MEMORY_SCOPE_AGENT); }
__device__ __forceinline__ unsigned xb_xcc_id() { return (unsigned)__builtin_amdgcn_s_getreg((3 << 11) | 20) & 0xFu; }
#define XB_SPIN(cond, bar) do { unsigned _sp = 0; while (cond) { __builtin_amdgcn_s_sleep(1); \
    if ((++_sp & 255u) == 0u) { if (xb_ld(&(bar)[XB_TMO])) break; if (_sp > XB_SPIN_CAP) { atomicAdd(&(bar)[XB_TMO], 1u); break; } } } } while (0)

struct XcdBarrier {
    unsigned* bar; unsigned x;
    volatile LAS unsigned* st;
};

__device__ __forceinline__ XcdBarrier xcd_barrier_post(unsigned* bar, volatile LAS unsigned* st) {
    XcdBarrier b; b.bar = bar; b.x = xb_xcc_id(); b.st = st;
    if (threadIdx.x == 0) (void)xb_add(&bar[XB_XCNT(b.x)], 1u);
    return b;
}
__device__ __forceinline__ void xcd_barrier_complete(unsigned* bar, unsigned x, unsigned& nloc, unsigned& nx) {
    const unsigned G = gridDim.x * gridDim.y * gridDim.z;
    unsigned sum, cnt, mine, sp = 0u;
    for (;;) {
        sum = 0u; cnt = 0u; mine = 0u;
#pragma unroll
        for (unsigned j = 0; j < 16; ++j) { const unsigned c = xb_ld(&bar[XB_XCNT(j)]); sum += c; cnt += (c > 0u) ? 1u : 0u; mine = (j == x) ? c : mine; }
        if (sum == G) break;
        __builtin_amdgcn_s_sleep(1);
        if ((++sp & 255u) == 0u) { if (xb_ld(&bar[XB_TMO])) break; if (sp > XB_SPIN_CAP) { atomicAdd(&bar[XB_TMO], 1u); break; } }
    }
    nloc = mine > 0u ? mine : 1u; nx = cnt > 0u ? cnt : 1u;
}

__device__ __forceinline__ void xcd_barrier(const XcdBarrier& b) {
    asm volatile("s_waitcnt vmcnt(0)" ::: "memory");
    __syncthreads();
    if (threadIdx.x == 0) {
        unsigned* bar = b.bar;
        __builtin_amdgcn_s_waitcnt(0);
        unsigned nloc = b.st[0], nx = b.st[1];
        if (nloc == 0u) { xcd_barrier_complete(bar, b.x, nloc, nx); b.st[0] = nloc; b.st[1] = nx; }
        const unsigned old = xb_add(&bar[XB_XSUB(b.x)], 1u);
        const unsigned gen = old / nloc;
        if (old + 1u == (gen + 1u) * nloc) {
            __builtin_amdgcn_fence(__ATOMIC_RELEASE, "agent");
            asm volatile("s_waitcnt vmcnt(0)" ::: "memory");
            const unsigned og = xb_add(&bar[XB_TOP], 1u);
            const unsigned tg = og / nx;
            if (og + 1u == (tg + 1u) * nx) xb_add(&bar[XB_TOPGEN], 1u);
            else XB_SPIN(xb_ld(&bar[XB_TOPGEN]) == tg, bar);
            __builtin_amdgcn_fence(__ATOMIC_ACQUIRE, "agent");
            xb_add(&bar[XB_XGEN(b.x)], 1u);
            asm volatile("s_waitcnt vmcnt(0)" ::: "memory");
        } else {
            XB_SPIN(xb_ld(&bar[XB_XGEN(b.x)]) == gen, bar);
            __builtin_amdgcn_fence(__ATOMIC_ACQUIRE, "agent");
            asm volatile("s_waitcnt vmcnt(0)" ::: "memory");
        }
    }
    __syncthreads();
}

struct Frame {
    LAS unsigned char* lds;
    volatile LAS unsigned* MISC;
    gu32* ctl;
    int tid, lane, wave;
    int vcu, G;
    const float* in[26]; float* out; unsigned char* ws;
};
enum { I_X = 0, I_LN0G, I_LN0B, I_WIN, I_LBL, I_HGNG, I_ARE, I_AIM, I_LSTEP, I_BRE, I_BIM, I_CRE, I_CIM, I_DSK, I_WGLU, I_BGLU, I_WOUT, I_LN1G, I_LN1B, I_WQ, I_K1, I_K2, I_PD, I_PU, I_LN2G, I_LN2B };

__device__ __forceinline__ float bf2f(bf16 v) { return __builtin_bit_cast(float, (unsigned)v << 16); }
__device__ __forceinline__ float wave_sum(float v) {
#pragma unroll
    for (int o = 1; o < 64; o <<= 1) v += __shfl_xor(v, o);
    return v;
}
__device__ __forceinline__ float wave_max(float v) {
#pragma unroll
    for (int o = 1; o < 64; o <<= 1) v = fmaxf(v, __shfl_xor(v, o));
    return v;
}
__device__ __forceinline__ float gelu_tanh(float x) { const float y = 0.7978845608028654f * (x + 0.044715f * x * x * x); return x / (1.f + __expf(-2.f * y)); }
__device__ __forceinline__ float silu_f(float x) { return x / (1.f + __expf(-x)); }
__device__ __forceinline__ void unpack8(const v4u w, float (&f)[8]) {
    f[0] = __builtin_bit_cast(float, w.x << 16); f[1] = __builtin_bit_cast(float, w.x & 0xffff0000u);
    f[2] = __builtin_bit_cast(float, w.y << 16); f[3] = __builtin_bit_cast(float, w.y & 0xffff0000u);
    f[4] = __builtin_bit_cast(float, w.z << 16); f[5] = __builtin_bit_cast(float, w.z & 0xffff0000u);
    f[6] = __builtin_bit_cast(float, w.w << 16); f[7] = __builtin_bit_cast(float, w.w & 0xffff0000u);
}
__device__ __forceinline__ v4u pack8(const float (&f)[8]) { v4u w; w.x = pk2(f[0], f[1]); w.y = pk2(f[2], f[3]); w.z = pk2(f[4], f[5]); w.w = pk2(f[6], f[7]); return w; }

__device__ __forceinline__ void p0_transpose_item(const float* W, int K, int N, bf16* WT, int row_off, LAS float* scr, int item, int lane) {
    const int nblk = N / 32, kb = item / nblk, nb = item % nblk, k0 = 64 * kb, n0 = 32 * nb;
#pragma unroll 8
    for (int i = 0; i < 32; ++i) { const int kk = 2 * i + (lane >> 5); scr[kk * 33 + (lane & 31)] = W[(size_t)(k0 + kk) * N + n0 + (lane & 31)]; }
    LDS_WAIT(); asm volatile("" ::: "memory");
    const int c = lane & 7;
#pragma unroll
    for (int j = 0; j < 4; ++j) { const int n = (lane >> 3) + 8 * j; const LAS float* s = scr + (8 * c) * 33 + n;
        v4u o; o.x = pk2(s[0 * 33], s[1 * 33]); o.y = pk2(s[2 * 33], s[3 * 33]); o.z = pk2(s[4 * 33], s[5 * 33]); o.w = pk2(s[6 * 33], s[7 * 33]);
        *(GAS v4u*)(WT + (size_t)(row_off + n0 + n) * K + k0 + 8 * c) = o; }
    LDS_WAIT(); asm volatile("" ::: "memory");
}
__device__ __forceinline__ void ln0_row(const float* xrow, const float* g, const float* b, bf16* orow, int lane) {
    const GAS f32x4* xr = (const GAS f32x4*)xrow + lane;
    f32x4 v[4]; float s = 0.f;
#pragma unroll
    for (int j = 0; j < 4; ++j) { v[j] = xr[64 * j]; s += (v[j].x + v[j].y) + (v[j].z + v[j].w); }
    const float mean = wave_sum(s) * (1.f / D); float s2 = 0.f;
#pragma unroll
    for (int j = 0; j < 4; ++j) { v[j] = v[j] - mean; s2 += (v[j].x * v[j].x + v[j].y * v[j].y) + (v[j].z * v[j].z + v[j].w * v[j].w); }
    const float rstd = 1.f / sqrtf(wave_sum(s2) * (1.f / D) + LN_EPS);
    GAS unsigned long long* o8 = (GAS unsigned long long*)orow + lane;
#pragma unroll
    for (int j = 0; j < 4; ++j) { const f32x4 gg = ((const GAS f32x4*)g)[lane + 64 * j], bb = ((const GAS f32x4*)b)[lane + 64 * j];
        const f32x4 o = v[j] * rstd * gg + bb;
        o8[64 * j] = (unsigned long long)pk2(o.x, o.y) | ((unsigned long long)pk2(o.z, o.w) << 32); }
}
__device__ __forceinline__ void p0_prologue(Frame& F) {
    LAS float* scr = (LAS float*)(F.lds + RING_OFF + F.wave * 16384);
    const int gw = F.vcu * NWAVES + F.wave, NGW = F.G * NWAVES;
    unsigned char* ws = F.ws;
    constexpr int I_IN = (D / 64) * (NPROJ / 32), I_GLU = (512 / 64) * (512 / 32), I_OUT = (1024 / 64) * (1024 / 32), I_Q = (1024 / 64) * (2048 / 32);
    constexpr int NITEMS = I_IN + I_GLU + I_OUT + I_Q;
    for (int it = gw; it < NITEMS; it += NGW) {
        int r = it;
        if (r < I_IN) { p0_transpose_item(F.in[I_WIN], D, NPROJ, (bf16*)(ws + WS_WIN), 0, scr, r, F.lane); continue; } r -= I_IN;
        if (r < I_GLU) { p0_transpose_item(F.in[I_WGLU], 512, 512, (bf16*)(ws + WS_WGLU), 0, scr, r, F.lane); continue; } r -= I_GLU;
        if (r < I_OUT) { p0_transpose_item(F.in[I_WOUT], 1024, 1024, (bf16*)(ws + WS_WOUT), 0, scr, r, F.lane); continue; } r -= I_OUT;
        p0_transpose_item(F.in[I_WQ], 1024, 2048, (bf16*)(ws + WS_WQ), 0, scr, r, F.lane);
    }
    const int gt = gw * 64 + F.lane, NGT = NGW * 64;
    for (int i = gt; i < 2 * PK * PHALF; i += NGT) { const float v = (i < PK * PHALF) ? F.in[I_K1][i] : F.in[I_K2][i - PK * PHALF]; ((bf16*)(ws + WS_KEYS))[i] = (bf16)f2bf(v); }
    constexpr int NTAB8 = PE * D / 8;
    for (int i = gt; i < 2 * NTAB8; i += NGT) { const bool up = i >= NTAB8; const int j = up ? i - NTAB8 : i; const float* src = (up ? F.in[I_PU] : F.in[I_PD]) + (size_t)j * 8;
        const f32x4 a = *(const GAS f32x4*)src, b = *(const GAS f32x4*)(src + 4);
        v4u o; o.x = pk2(a.x, a.y); o.y = pk2(a.z, a.w); o.z = pk2(b.x, b.y); o.w = pk2(b.z, b.w);
        *(GAS v4u*)((bf16*)(ws + (up ? WS_PU : WS_PD)) + (size_t)j * 8) = o; }
    for (int i = gt; i < HGW; i += NGT) { const float l0 = F.in[I_LBL][i], l1 = F.in[I_LBL][HGW + i]; ((float*)(ws + WS_LB))[i] = 1.f / (1.f + expf(l1 - l0)); }
    for (int i = gt; i < S5G * S5N; i += NGT) { const int g = i / S5N;
        const float are = F.in[I_ARE][i], aim = F.in[I_AIM][i], step = expf(F.in[I_LSTEP][g]);
        const float zr = step * are, zi = step * aim, mag = expf(zr), cz = cosf(zi), sz = sinf(zi), sh = sinf(0.5f * zi);
        const float abr = mag * cz, abi = mag * sz;
        const float nre = expm1f(zr) * cz - 2.f * sh * sh, nim = abi;
        const float den = are * are + aim * aim;
        const float cre = (nre * are + nim * aim) / den, cim = (nim * are - nre * aim) / den;
        float* t = (float*)(ws + WS_S5T) + (size_t)i * 40; t[0] = abr; t[1] = abi;
        for (int p = 0; p < S5P; ++p) { const float br = F.in[I_BRE][(size_t)i * S5P + p], bi = F.in[I_BIM][(size_t)i * S5P + p];
            t[2 + p] = cre * br - cim * bi; t[18 + p] = cre * bi + cim * br; } }
    for (int m = gw; m < M; m += NGW) ln0_row(F.in[I_X] + (size_t)m * D, F.in[I_LN0G], F.in[I_LN0B], (bf16*)(ws + WS_H) + (size_t)m * D, F.lane);
}

__device__ __forceinline__ void hgrn2_seq(Frame& F, int bh) {
    const int b = bh >> 2, h = bh & 3, tid = F.tid, kq = tid >> 7, j = tid & 127;
    LAS float* sF = (LAS float*)(F.lds + RING_OFF);
    LAS float* sK = sF + 8 * 128; LAS float* sQ = sK + 8 * 128;
    LAS float* sO = sQ + 8 * 128;
    const bf16* Qb = (const bf16*)(F.ws + WS_PROJ); const bf16* LFb = Qb + (size_t)M * 512; const bf16* Vb = LFb + (size_t)M * 512; const bf16* Gb = Vb + (size_t)M * 512;
    bf16* MIX = (bf16*)(F.ws + WS_MIX);
    const float ng0 = F.in[I_HGNG][F.lane], ng1 = F.in[I_HGNG][F.lane + 64];
    float S[32];
#pragma unroll
    for (int k = 0; k < 32; ++k) S[k] = 0.f;
    for (int t0 = 0; t0 < SEQ; t0 += 8) {
        const size_t tok0 = (size_t)b * SEQ + t0;
#pragma unroll
        for (int r = 0; r < 2; ++r) { const int item = tid + 512 * r, tt = item >> 7, kk = item & 127; const size_t off = (tok0 + tt) * 512 + h * 128 + kk;
            const float lf = bf2f(LFb[off]); sF[tt * 128 + kk] = __expf(lf); sK[tt * 128 + kk] = -expm1f(lf); sQ[tt * 128 + kk] = bf2f(Qb[off]); }
        __syncthreads();
#pragma unroll 1
        for (int tt = 0; tt < 8; ++tt) { const float v = bf2f(Vb[(tok0 + tt) * 512 + h * 128 + j]); float o = 0.f;
            const LAS float* f = sF + tt * 128 + kq * 32; const LAS float* kx = sK + tt * 128 + kq * 32; const LAS float* q = sQ + tt * 128 + kq * 32;
#pragma unroll
            for (int k = 0; k < 32; ++k) { S[k] = f[k] * S[k] + kx[k] * v; o += q[k] * S[k]; }
            sO[(tt * 4 + kq) * 128 + j] = o; }
        __syncthreads();
        { const int tt = F.wave; const size_t tok = tok0 + tt;
            const float o0 = (sO[(tt * 4 + 0) * 128 + F.lane] + sO[(tt * 4 + 1) * 128 + F.lane]) + (sO[(tt * 4 + 2) * 128 + F.lane] + sO[(tt * 4 + 3) * 128 + F.lane]);
            const float o1 = (sO[(tt * 4 + 0) * 128 + 64 + F.lane] + sO[(tt * 4 + 1) * 128 + 64 + F.lane]) + (sO[(tt * 4 + 2) * 128 + 64 + F.lane] + sO[(tt * 4 + 3) * 128 + 64 + F.lane]);
            const float ss = wave_sum(o0 * o0 + o1 * o1), r = 1.f / sqrtf(ss * (1.f / 128.f) + RMS_EPS);
            const float g0 = bf2f(Gb[tok * 512 + h * 128 + F.lane]), g1 = bf2f(Gb[tok * 512 + h * 128 + 64 + F.lane]);
            MIX[tok * 1024 + h * 128 + F.lane] = (bf16)f2bf(o0 * r * ng0 * silu_f(g0));
            MIX[tok * 1024 + h * 128 + 64 + F.lane] = (bf16)f2bf(o1 * r * ng1 * silu_f(g1)); }
    }
    __syncthreads();
}
__device__ __forceinline__ void s5_seq(Frame& F, int pair) {
    const int b = pair >> 5, g = pair & 31, lane = F.lane;
    const float* tb = (const float*)(F.ws + WS_S5T) + (size_t)(g * S5N + lane) * 40;
    const float abr = tb[0], abi = tb[1];
    float bbr[16], bbi[16], cr[16], ci[16], dsk[16];
#pragma unroll
    for (int p = 0; p < 16; ++p) { bbr[p] = tb[2 + p]; bbi[p] = tb[18 + p]; cr[p] = F.in[I_CRE][(size_t)(g * 16 + p) * S5N + lane]; ci[p] = F.in[I_CIM][(size_t)(g * 16 + p) * S5N + lane];
        dsk[p] = (lane == 0) ? F.in[I_DSK][g * 16 + p] : 0.f; }
    const bf16* Ub = (const bf16*)(F.ws + WS_PROJ) + (size_t)4 * M * 512 + ((size_t)g * M + (size_t)b * SEQ) * 16;
    bf16* Zb = (bf16*)(F.ws + WS_Z) + (size_t)b * SEQ * 512 + g * 16;
    const int pme = ((lane >> 5) & 1) * 8 + ((lane >> 4) & 1) * 4 + ((lane >> 3) & 1) * 2 + ((lane >> 2) & 1);
    float xr = 0.f, xi = 0.f;
    v4u nu0 = *(const GAS v4u*)(Ub + (size_t)lane * 16), nu1 = *(const GAS v4u*)(Ub + (size_t)lane * 16 + 8);
    for (int t0 = 0; t0 < SEQ; t0 += 64) {
        const v4u u0 = nu0, u1 = nu1;
        if (t0 + 64 < SEQ) { nu0 = *(const GAS v4u*)(Ub + (size_t)(t0 + 64 + lane) * 16); nu1 = *(const GAS v4u*)(Ub + (size_t)(t0 + 64 + lane) * 16 + 8); }
#pragma unroll 1
        for (int tt = 0; tt < 64; ++tt) {
            v4u a, c;
            a.x = __builtin_amdgcn_readlane(u0.x, tt); a.y = __builtin_amdgcn_readlane(u0.y, tt); a.z = __builtin_amdgcn_readlane(u0.z, tt); a.w = __builtin_amdgcn_readlane(u0.w, tt);
            c.x = __builtin_amdgcn_readlane(u1.x, tt); c.y = __builtin_amdgcn_readlane(u1.y, tt); c.z = __builtin_amdgcn_readlane(u1.z, tt); c.w = __builtin_amdgcn_readlane(u1.w, tt);
            float u[16]; { float f0[8], f1[8]; unpack8(a, f0); unpack8(c, f1);
#pragma unroll
                for (int p = 0; p < 8; ++p) { u[p] = f0[p]; u[8 + p] = f1[p]; } }
            float bur = 0.f, bui = 0.f;
#pragma unroll
            for (int p = 0; p < 16; ++p) { bur += bbr[p] * u[p]; bui += bbi[p] * u[p]; }
            const float nxr = abr * xr - abi * xi + bur, nxi = abr * xi + abi * xr + bui; xr = nxr; xi = nxi;
            float r[16];
#pragma unroll
            for (int p = 0; p < 16; ++p) r[p] = cr[p] * xr - ci[p] * xi + dsk[p] * u[p];
#pragma unroll
            for (int i = 0; i < 8; ++i) { const float keep = (lane & 32) ? r[i + 8] : r[i], send = (lane & 32) ? r[i] : r[i + 8]; r[i] = keep + __shfl_xor(send, 32); }
#pragma unroll
            for (int i = 0; i < 4; ++i) { const float keep = (lane & 16) ? r[i + 4] : r[i], send = (lane & 16) ? r[i] : r[i + 4]; r[i] = keep + __shfl_xor(send, 16); }
#pragma unroll
            for (int i = 0; i < 2; ++i) { const float keep = (lane & 8) ? r[i + 2] : r[i], send = (lane & 8) ? r[i] : r[i + 2]; r[i] = keep + __shfl_xor(send, 8); }
            { const float keep = (lane & 4) ? r[1] : r[0], send = (lane & 4) ? r[0] : r[1]; r[0] = keep + __shfl_xor(send, 4); }
            r[0] += __shfl_xor(r[0], 2); r[0] += __shfl_xor(r[0], 1);
            if ((lane & 3) == 0) Zb[(size_t)(t0 + tt) * 512 + pme] = (bf16)f2bf(gelu_tanh(r[0]));
        }
    }
}

__device__ __forceinline__ void ln1_row(bf16* row, const float* g, const float* b, int lane) {
    const v4u w0 = *(const GAS v4u*)(row + lane * 8), w1 = *(const GAS v4u*)(row + 512 + lane * 8);
    float a[8], c[8]; unpack8(w0, a); unpack8(w1, c);
    float s = 0.f;
#pragma unroll
    for (int j = 0; j < 8; ++j) s += a[j] + c[j];
    const float mean = wave_sum(s) * (1.f / D); float s2 = 0.f;
#pragma unroll
    for (int j = 0; j < 8; ++j) { a[j] -= mean; c[j] -= mean; s2 += a[j] * a[j] + c[j] * c[j]; }
    const float rstd = 1.f / sqrtf(wave_sum(s2) * (1.f / D) + LN_EPS);
    const f32x4 g0 = *(const GAS f32x4*)(g + lane * 8), g1 = *(const GAS f32x4*)(g + lane * 8 + 4), g2 = *(const GAS f32x4*)(g + 512 + lane * 8), g3 = *(const GAS f32x4*)(g + 512 + lane * 8 + 4);
    const f32x4 b0 = *(const GAS f32x4*)(b + lane * 8), b1 = *(const GAS f32x4*)(b + lane * 8 + 4), b2 = *(const GAS f32x4*)(b + 512 + lane * 8), b3 = *(const GAS f32x4*)(b + 512 + lane * 8 + 4);
    const float gg0[8] = {g0.x, g0.y, g0.z, g0.w, g1.x, g1.y, g1.z, g1.w}, gg1[8] = {g2.x, g2.y, g2.z, g2.w, g3.x, g3.y, g3.z, g3.w};
    const float bb0[8] = {b0.x, b0.y, b0.z, b0.w, b1.x, b1.y, b1.z, b1.w}, bb1[8] = {b2.x, b2.y, b2.z, b2.w, b3.x, b3.y, b3.z, b3.w};
#pragma unroll
    for (int j = 0; j < 8; ++j) { a[j] = a[j] * rstd * gg0[j] + bb0[j]; c[j] = c[j] * rstd * gg1[j] + bb1[j]; }
    *(GAS v4u*)(row + lane * 8) = pack8(a); *(GAS v4u*)(row + 512 + lane * 8) = pack8(c);
}

__device__ __forceinline__ void peer_score_phase(Frame& F) {
    LAS unsigned* sk = (LAS unsigned*)(F.lds + RING_OFF);
    LAS unsigned* wsq = (LAS unsigned*)(F.lds + RING_OFF + 65536 + F.wave * 1024);
    LAS float* wv = (LAS float*)(wsq + 128);
    LAS int* wi = (LAS int*)(wsq + 160);
    const unsigned* keys = (const unsigned*)(F.ws + WS_KEYS);
    for (int i = F.tid; i < 2 * 64 * 128; i += NWAVES * 64) { const int s = i >> 13, dp = (i >> 7) & 63, n = i & 127; sk[i] = keys[(s * 128 + n) * 64 + dp]; }
    __syncthreads();
    const int gw = F.vcu * NWAVES + F.wave, NGW = F.G * NWAVES, lane = F.lane;
    const bf16* Q2 = (const bf16*)(F.ws + WS_Q2);
    int* EIDX = (int*)(F.ws + WS_EIDX); float* EGATE = (float*)(F.ws + WS_EGATE);
    for (int item = gw; item < M * PH; item += NGW) {
        const size_t tok = item >> 3; const int h = item & 7;
        const unsigned* qrow = (const unsigned*)(Q2 + tok * NQ2 + h * PQ);
        wsq[lane] = qrow[lane]; wsq[64 + lane] = qrow[64 + lane];
        LDS_WAIT();
        float vtop[2][16]; int itop[2][16];
#pragma unroll
        for (int s = 0; s < 2; ++s) {
            float a0 = 0.f, a1 = 0.f;
            const LAS unsigned* kk = sk + s * 8192;
#pragma unroll 8
            for (int dp = 0; dp < 64; ++dp) { const unsigned qd = wsq[s * 64 + dp], k0 = kk[dp * 128 + lane], k1 = kk[dp * 128 + 64 + lane];
                const float q0 = __builtin_bit_cast(float, qd << 16), q1 = __builtin_bit_cast(float, qd & 0xffff0000u);
                a0 += q0 * __builtin_bit_cast(float, k0 << 16) + q1 * __builtin_bit_cast(float, k0 & 0xffff0000u);
                a1 += q0 * __builtin_bit_cast(float, k1 << 16) + q1 * __builtin_bit_cast(float, k1 & 0xffff0000u); }
#pragma unroll
            for (int r = 0; r < 16; ++r) { const float m = fmaxf(a0, a1), wm = wave_max(m);
                const unsigned long long bal = __ballot(m == wm); const int wl = __ffsll((long long)bal) - 1;
                const int myidx = (a0 >= a1) ? lane : lane + 64;
                const int idx = __shfl(myidx, wl);
                if (lane == wl) { if (a0 >= a1) a0 = -3.0e38f; else a1 = -3.0e38f; }
                vtop[s][r] = wm; itop[s][r] = idx; }
        }
        if (lane < 16) {
#pragma unroll
            for (int r = 0; r < 16; ++r) if (lane == r) { wv[r] = vtop[0][r]; wv[16 + r] = vtop[1][r]; wi[r] = itop[0][r]; wi[16 + r] = itop[1][r]; }
        }
        LDS_WAIT();
        float cand[4];
#pragma unroll
        for (int r = 0; r < 4; ++r) cand[r] = wv[(lane >> 4) + 4 * r] + wv[16 + (lane & 15)];
        float mybest = 0.f; int mypos = 0;
#pragma unroll
        for (int rr = 0; rr < 16; ++rr) { const float m = fmaxf(fmaxf(cand[0], cand[1]), fmaxf(cand[2], cand[3])), wm = wave_max(m);
            const unsigned long long bal = __ballot(m == wm); const int wl = __ffsll((long long)bal) - 1;
            const int myr = (cand[0] == m) ? 0 : (cand[1] == m) ? 1 : (cand[2] == m) ? 2 : 3;
            const int pos = __shfl(lane + 64 * myr, wl);
            if (lane == wl) { if (myr == 0) cand[0] = -3.0e38f; else if (myr == 1) cand[1] = -3.0e38f; else if (myr == 2) cand[2] = -3.0e38f; else cand[3] = -3.0e38f; }
            if (lane == rr) { mybest = wm; mypos = pos; } }
        const float mx = __shfl(mybest, 0);
        float e = (lane < 16) ? __expf(mybest - mx) : 0.f;
        float sum = e; sum += __shfl_xor(sum, 8); sum += __shfl_xor(sum, 4); sum += __shfl_xor(sum, 2); sum += __shfl_xor(sum, 1);
        if (lane < 16) { const int ex = wi[mypos >> 4] * PK + wi[16 + (mypos & 15)]; EIDX[(size_t)item * 16 + lane] = ex; EGATE[(size_t)item * 16 + lane] = e / sum; }
        LDS_WAIT();
    }
}

__device__ __forceinline__ void peer_gather_phase(Frame& F) {
    const int gw = F.vcu * NWAVES + F.wave, NGW = F.G * NWAVES, lane = F.lane;
    const bf16* H1 = (const bf16*)(F.ws + WS_H); const bf16* PD = (const bf16*)(F.ws + WS_PD); const bf16* PU = (const bf16*)(F.ws + WS_PU);
    const int* EIDX = (const int*)(F.ws + WS_EIDX); const float* EGATE = (const float*)(F.ws + WS_EGATE);
    const int rep = ((lane >> 5) & 1) * 4 + ((lane >> 4) & 1) * 2 + ((lane >> 3) & 1);
    for (int tok = gw; tok < M; tok += NGW) {
        float x0[8], x1[8]; unpack8(*(const GAS v4u*)(H1 + (size_t)tok * D + lane * 8), x0); unpack8(*(const GAS v4u*)(H1 + (size_t)tok * D + 512 + lane * 8), x1);
        const int e0 = EIDX[(size_t)tok * 128 + lane], e1 = EIDX[(size_t)tok * 128 + 64 + lane];
        const float g0 = EGATE[(size_t)tok * 128 + lane], g1 = EGATE[(size_t)tok * 128 + 64 + lane];
        float o0[8], o1[8];
#pragma unroll
        for (int j = 0; j < 8; ++j) { o0[j] = 0.f; o1[j] = 0.f; }
#pragma unroll 1
        for (int bt = 0; bt < 16; ++bt) {
            const int ev = (bt < 8) ? e0 : e1; const float gv = (bt < 8) ? g0 : g1; const int lb8 = (bt & 7) * 8;
            v4u dw[8][2], uw[8][2];
#pragma unroll
            for (int i = 0; i < 8; ++i) { const int e = __builtin_amdgcn_readlane(ev, lb8 + i);
                const bf16* dr = PD + (size_t)e * D; const bf16* ur = PU + (size_t)e * D;
                dw[i][0] = *(const GAS v4u*)(dr + lane * 8); dw[i][1] = *(const GAS v4u*)(dr + 512 + lane * 8);
                uw[i][0] = *(const GAS v4u*)(ur + lane * 8); uw[i][1] = *(const GAS v4u*)(ur + 512 + lane * 8); }
            float p[8];
#pragma unroll
            for (int i = 0; i < 8; ++i) { float a[8], c[8]; unpack8(dw[i][0], a); unpack8(dw[i][1], c); float s = 0.f;
#pragma unroll
                for (int j = 0; j < 8; ++j) s += a[j] * x0[j] + c[j] * x1[j];
                p[i] = s; }
#pragma unroll
            for (int i = 0; i < 4; ++i) { const float keep = (lane & 32) ? p[i + 4] : p[i], send = (lane & 32) ? p[i] : p[i + 4]; p[i] = keep + __shfl_xor(send, 32); }
#pragma unroll
            for (int i = 0; i < 2; ++i) { const float keep = (lane & 16) ? p[i + 2] : p[i], send = (lane & 16) ? p[i] : p[i + 2]; p[i] = keep + __shfl_xor(send, 16); }
            { const float keep = (lane & 8) ? p[1] : p[0], send = (lane & 8) ? p[0] : p[1]; p[0] = keep + __shfl_xor(send, 8); }
            p[0] += __shfl_xor(p[0], 4); p[0] += __shfl_xor(p[0], 2); p[0] += __shfl_xor(p[0], 1);
            const float gate = __shfl(gv, lb8 + rep);
            const float act = gelu_tanh(p[0]) * gate;
#pragma unroll
            for (int i = 0; i < 8; ++i) { const float af = __builtin_bit_cast(float, __builtin_amdgcn_readlane(__builtin_bit_cast(int, act), ((i >> 2) & 1) * 32 + ((i >> 1) & 1) * 16 + (i & 1) * 8));
                float a[8], c[8]; unpack8(uw[i][0], a); unpack8(uw[i][1], c);
#pragma unroll
                for (int j = 0; j < 8; ++j) { o0[j] += af * a[j]; o1[j] += af * c[j]; } }
        }
        float s = 0.f;
#pragma unroll
        for (int j = 0; j < 8; ++j) { o0[j] += DN_ALPHA * x0[j]; o1[j] += DN_ALPHA * x1[j]; s += o0[j] + o1[j]; }
        const float mean = wave_sum(s) * (1.f / D); float s2 = 0.f;
#pragma unroll
        for (int j = 0; j < 8; ++j) { o0[j] -= mean; o1[j] -= mean; s2 += o0[j] * o0[j] + o1[j] * o1[j]; }
        const float rstd = 1.f / sqrtf(wave_sum(s2) * (1.f / D) + LN_EPS);
        const float* g = F.in[I_LN2G]; const float* b = F.in[I_LN2B];
        float* orow = F.out + (size_t)tok * D;
#pragma unroll
        for (int q = 0; q < 2; ++q) { const int c0 = lane * 8 + 4 * q;
            const f32x4 ga = *(const GAS f32x4*)(g + c0), ba = *(const GAS f32x4*)(b + c0), gb = *(const GAS f32x4*)(g + 512 + c0), bb = *(const GAS f32x4*)(b + 512 + c0);
            f32x4 ya, yb;
            ya.x = o0[4 * q + 0] * rstd * ga.x + ba.x; ya.y = o0[4 * q + 1] * rstd * ga.y + ba.y; ya.z = o0[4 * q + 2] * rstd * ga.z + ba.z; ya.w = o0[4 * q + 3] * rstd * ga.w + ba.w;
            yb.x = o1[4 * q + 0] * rstd * gb.x + bb.x; yb.y = o1[4 * q + 1] * rstd * gb.y + bb.y; yb.z = o1[4 * q + 2] * rstd * gb.z + bb.z; yb.w = o1[4 * q + 3] * rstd * gb.w + bb.w;
            *(GAS f32x4*)(orow + c0) = ya; *(GAS f32x4*)(orow + 512 + c0) = yb; }
    }
}

struct Args { const float* in[26]; float* out; unsigned char* ws; int ph_lo, ph_hi, li, pad; };
__global__ void __launch_bounds__(NWAVES * 64, 2) fwd_kernel(Args args) {
    extern __shared__ __attribute__((aligned(16))) unsigned char lds[];
    Frame F;
    F.lds = (LAS unsigned char*)lds;
    F.MISC = (volatile LAS unsigned*)(F.lds + MISC_OFF);
    F.tid = threadIdx.x; F.lane = F.tid & 63; F.wave = __builtin_amdgcn_readfirstlane(F.tid >> 6);
    F.G = gridDim.x; { const int bx = blockIdx.x; F.vcu = (F.G % 8 == 0) ? (bx % 8) * (F.G / 8) + bx / 8 : bx; }
#pragma unroll
    for (int i = 0; i < 26; ++i) F.in[i] = args.in[i];
    F.out = args.out; F.ws = args.ws;
    unsigned char* ws = args.ws;
    F.ctl = (gu32*)(ws + WS_CTL);
    for (int u = F.tid; u < (LDS_BYTES - LDSCTL_OFF) / 4; u += NWAVES * 64) ((LAS unsigned*)(F.lds + LDSCTL_OFF))[u] = 0u;
    __syncthreads();
    XcdBarrier bar; bar.bar = (unsigned*)(F.ctl + CW_BAR); bar.x = 0; bar.st = nullptr;
    if (N_LAUNCHES == 1) bar = xcd_barrier_post((unsigned*)(F.ctl + CW_BAR), F.MISC + 8);
#define GRID_BAR() do { if (N_LAUNCHES == 1) xcd_barrier(bar); } while (0)
    const int lo = args.ph_lo, hi = args.ph_hi;
#define IN(k) (lo <= (k) && (k) < hi)
#define BOTH(k) (IN(k) && IN((k) + 1))
    bf16* const Hb = (bf16*)(ws + WS_H);
    bf16* const PRJ = (bf16*)(ws + WS_PROJ);

    if (IN(0)) { p0_prologue(F); if (BOTH(0)) GRID_BAR(); }

    if (IN(1)) {
        pg8::Gemm g{Hb, (const bf16*)(ws + WS_WIN), M, NPROJ, D}; pg8::StaticOrder S; S.init(M, NPROJ, F.G, (int)blockIdx.x);
        pg8::EpiProj E{PRJ, PRJ + (size_t)M * 512, PRJ + (size_t)2 * M * 512, PRJ + (size_t)3 * M * 512, PRJ + (size_t)4 * M * 512, (const float*)(ws + WS_LB), M};
        pg8::gemm_phase<pg8::EpiProj, pg8::StaticOrder, true, true>(F.lds + RING_OFF, g, S, E);
        if (BOTH(1)) GRID_BAR();
    }

    if (IN(2)) {
        if (F.vcu < 32) hgrn2_seq(F, F.vcu);
        else if (F.vcu < 64) s5_seq(F, (F.vcu - 32) * NWAVES + F.wave);
        if (BOTH(2)) GRID_BAR();
    }

    if (IN(3)) {
        pg8::Gemm g{(const bf16*)(ws + WS_Z), (const bf16*)(ws + WS_WGLU), M, 512, 512}; pg8::StaticOrder S; S.init(M, 512, F.G, (int)blockIdx.x);
        pg8::EpiGlu E{(const bf16*)(ws + WS_Z), (bf16*)(ws + WS_MIX), F.in[I_BGLU]};
        pg8::gemm_phase<pg8::EpiGlu, pg8::StaticOrder, true, true>(F.lds + RING_OFF, g, S, E);
        if (BOTH(3)) GRID_BAR();
    }

    if (IN(4)) {
        pg8::Gemm g{(const bf16*)(ws + WS_MIX), (const bf16*)(ws + WS_WOUT), M, D, D}; pg8::StaticOrder S; S.init(M, D, F.G, (int)blockIdx.x);
        pg8::EpiOut E{Hb, DN_ALPHA};
        pg8::gemm_phase<pg8::EpiOut, pg8::StaticOrder, true, true>(F.lds + RING_OFF, g, S, E);
        if (BOTH(4)) GRID_BAR();
    }

    if (IN(5)) {
        const int gw = F.vcu * NWAVES + F.wave, NGW = F.G * NWAVES;
        for (int m = gw; m < M; m += NGW) ln1_row(Hb + (size_t)m * D, F.in[I_LN1G], F.in[I_LN1B], F.lane);
        if (BOTH(5)) GRID_BAR();
    }

    if (IN(6)) {
        pg8::Gemm g{Hb, (const bf16*)(ws + WS_WQ), M, NQ2, D}; pg8::StaticOrder S; S.init(M, NQ2, F.G, (int)blockIdx.x);
        pg8::EpiStore E{(bf16*)(ws + WS_Q2), NQ2};
        pg8::gemm_phase<pg8::EpiStore, pg8::StaticOrder, true, true>(F.lds + RING_OFF, g, S, E);
        if (BOTH(6)) GRID_BAR();
    }

    if (IN(7)) { peer_score_phase(F); if (BOTH(7)) GRID_BAR(); }

    if (IN(8)) { peer_gather_phase(F); }
#undef IN
#undef BOTH
}

extern "C" void kernel_launch(void* const* d_in, const int* in_sizes, int n_in, void* d_out, int out_size, void* d_ws, size_t ws_size, hipStream_t stream) {
    static int grid = 0;
    if (grid == 0) {
        if (n_in != 26 || in_sizes[0] != M * D || out_size != M * D || ws_size < WS_END) { fprintf(stderr, "kernel_launch: unexpected shapes: n_in %d in0 %d out %d ws %zu (need %zu)\n", n_in, n_in > 0 ? in_sizes[0] : -1, out_size, ws_size, (size_t)WS_END); grid = -1; return; }
        int dev = 0, cus = 0;
        if (hipGetDevice(&dev) != hipSuccess || hipDeviceGetAttribute(&cus, hipDeviceAttributeMultiprocessorCount, dev) != hipSuccess) { grid = -1; return; }
        if (hipFuncSetAttribute((const void*)fwd_kernel, hipFuncAttributeMaxDynamicSharedMemorySize, LDS_BYTES) != hipSuccess) { fprintf(stderr, "kernel_launch: hipFuncSetAttribute failed\n"); grid = -1; return; }
        (void)hipGetLastError();
        grid = cus;
    }
    if (grid < 0) return;
    if (hipMemsetAsync((char*)d_ws + WS_CTL, 0, CTL_ZERO_BYTES, stream) != hipSuccess) return;
    Args a{};
    for (int i = 0; i < 26; ++i) a.in[i] = (const float*)d_in[i];
    a.out = (float*)d_out; a.ws = (unsigned char*)d_ws;
    if (N_LAUNCHES == 1) { a.ph_lo = 0; a.ph_hi = NPH; a.li = 0; hipLaunchKernelGGL(fwd_kernel, dim3(grid), dim3(NWAVES * 64), LDS_BYTES, stream, a); }
    else for (int li = 0; li < NPH; ++li) { a.ph_lo = li; a.ph_hi = li + 1; a.li = li; hipLaunchKernelGGL(fwd_kernel, dim3(grid), dim3(NWAVES * 64), LDS_BYTES, stream, a); }
}
```

```cpp
#include <hip/hip_runtime.h>
#include <cstdio>
#include <cstdint>
namespace pg8 {
#define PG8_LAS __attribute__((address_space(3)))
typedef unsigned short bf16_t;
typedef short bf16x8 __attribute__((ext_vector_type(8)));
typedef float f32x4 __attribute__((ext_vector_type(4)));
typedef unsigned u32x4 __attribute__((ext_vector_type(4)));
constexpr int BM = 256, BK = 64, HALF = 128, HTB = HALF * BK * 2  , STAGE_BYTES = 8 * HTB, NXCD = 8, WGM = 8;

__host__ __device__ __forceinline__ int lds_byte(int r, int c) { const int st = (r >> 4) * 2 + (c >> 5), rr = r & 15, cc = c & 31, ob = rr * 64 + cc * 2; return st * 1024 + (ob ^ (((ob >> 9) & 1) << 5)); }
__host__ __device__ __forceinline__ void stage_rc(int b, int& R, int& C) { const int st = b / 1024, sb = b % 1024, swz = sb ^ (((sb >> 9) & 1) << 5); R = (st >> 1) * 16 + swz / 64; C = (st & 1) * 32 + (swz % 64) / 2; }
__host__ __device__ __forceinline__ int perm32(int rho) { const int n = rho >> 4, i = rho & 15; return 8 * (i >> 2) + 4 * n + (i & 3); }

struct Unit { int pm, pn; };
struct Gemm { const bf16_t* A; const bf16_t* Bt; int M, N, K; };

struct StaticOrder {
    int nM, nN, nwg, G, c;
    __host__ __device__ void init(int M, int N, int G_, int c_) { nM = M / BM; nN = N / BM; nwg = nM * nN; G = G_; c = c_; }
    __host__ __device__ bool next(int i, Unit& u) const {
        const long L = (long)i * G + c; if (L >= nwg) return false;
        int wgid = (int)L; { const int q = nwg / NXCD, r = nwg % NXCD, xcd = wgid % NXCD, off = wgid / NXCD; wgid = (xcd < r ? xcd * (q + 1) : r * (q + 1) + (xcd - r) * q) + off; }
        const int nig = WGM * nN, gid = wgid / nig, fm = gid * WGM, gsz = (nM - fm) < WGM ? (nM - fm) : WGM;
        u.pm = fm + ((wgid % nig) % gsz); u.pn = (wgid % nig) / gsz; return true;
    }
    __device__ __forceinline__ void a_ready(const Unit&) const {}
    __device__ __forceinline__ void done(const Unit&) const {}
};

__device__ __forceinline__ unsigned cvt_pk_bf16(float lo, float hi) { unsigned r; asm volatile("v_cvt_pk_bf16_f32 %0, %1, %2" : "=v"(r) : "v"(lo), "v"(hi)); return r; }
__device__ __forceinline__ void unpack8(const u32x4 w, float (&f)[8]) {
    f[0] = __builtin_bit_cast(float, w.x << 16); f[1] = __builtin_bit_cast(float, w.x & 0xffff0000u);
    f[2] = __builtin_bit_cast(float, w.y << 16); f[3] = __builtin_bit_cast(float, w.y & 0xffff0000u);
    f[4] = __builtin_bit_cast(float, w.z << 16); f[5] = __builtin_bit_cast(float, w.z & 0xffff0000u);
    f[6] = __builtin_bit_cast(float, w.w << 16); f[7] = __builtin_bit_cast(float, w.w & 0xffff0000u);
}
__device__ __forceinline__ u32x4 pack8(const float (&f)[8]) { u32x4 w; w.x = cvt_pk_bf16(f[0], f[1]); w.y = cvt_pk_bf16(f[2], f[3]); w.z = cvt_pk_bf16(f[4], f[5]); w.w = cvt_pk_bf16(f[6], f[7]); return w; }

struct EpiStore {
    static constexpr bool PERM = true, AFTER_DRAIN = false;
    bf16_t* O; int ldc;
    __device__ __forceinline__ void operator()(const f32x4 (&acc)[2][2][4][2], const Unit& u, int wr, int wc, int fr, int fq) const {
        const int row0 = u.pm * BM + wr * 64 + fr, col0 = u.pn * BM + wc * 32 + 8 * fq;
#pragma unroll
        for (int ai = 0; ai < 2; ++ai)
#pragma unroll
            for (int m = 0; m < 4; ++m) { bf16_t* rowp = O + (size_t)(row0 + ai * HALF + m * 16) * ldc + col0;
#pragma unroll
                for (int bj = 0; bj < 2; ++bj) { const f32x4 v0 = acc[ai][bj][m][0], v1 = acc[ai][bj][m][1];
                    u32x4 w; w.x = cvt_pk_bf16(v0[0], v0[1]); w.y = cvt_pk_bf16(v0[2], v0[3]); w.z = cvt_pk_bf16(v1[0], v1[1]); w.w = cvt_pk_bf16(v1[2], v1[3]);
                    *(u32x4*)(rowp + bj * HALF) = w; } }
    }
};

struct EpiProj {
    static constexpr bool PERM = true, AFTER_DRAIN = false;
    bf16_t* Qb; bf16_t* LFb; bf16_t* Vb; bf16_t* Gb; bf16_t* Ub; const float* lb; int M;
    __device__ __forceinline__ void operator()(const f32x4 (&acc)[2][2][4][2], const Unit& u, int wr, int wc, int fr, int fq) const {
        const int row0 = u.pm * BM + wr * 64 + fr; const int colt = u.pn * BM; const int t = colt >> 9;
        const int cb = (colt & 511) + wc * 32 + 8 * fq;
        float lbv[2][8];
        if (t == 1) {
#pragma unroll
            for (int bj = 0; bj < 2; ++bj) { const f32x4 a = *(const f32x4*)(lb + cb + bj * HALF), b = *(const f32x4*)(lb + cb + bj * HALF + 4);
                lbv[bj][0] = a[0]; lbv[bj][1] = a[1]; lbv[bj][2] = a[2]; lbv[bj][3] = a[3]; lbv[bj][4] = b[0]; lbv[bj][5] = b[1]; lbv[bj][6] = b[2]; lbv[bj][7] = b[3]; }
        }
#pragma unroll
        for (int ai = 0; ai < 2; ++ai)
#pragma unroll
            for (int m = 0; m < 4; ++m) { const int row = row0 + ai * HALF + m * 16;
#pragma unroll
                for (int bj = 0; bj < 2; ++bj) { const f32x4 v0 = acc[ai][bj][m][0], v1 = acc[ai][bj][m][1]; const int c = cb + bj * HALF;
                    float f[8] = {v0[0], v0[1], v0[2], v0[3], v1[0], v1[1], v1[2], v1[3]};
                    if (t == 0) {
#pragma unroll
                        for (int j = 0; j < 8; ++j) f[j] *= 0.08838834764831845f;
                        *(u32x4*)(Qb + (size_t)row * 512 + c) = pack8(f);
                    } else if (t == 1) {
#pragma unroll
                        for (int j = 0; j < 8; ++j) { const float l = lbv[bj][j]; const float sg = 1.f / (1.f + __expf(-f[j])); f[j] = __logf(l + (1.f - l) * sg); }
                        *(u32x4*)(LFb + (size_t)row * 512 + c) = pack8(f);
                    } else if (t == 2) { *(u32x4*)(Vb + (size_t)row * 512 + c) = pack8(f);
                    } else if (t == 3) { *(u32x4*)(Gb + (size_t)row * 512 + c) = pack8(f);
                    } else { *(u32x4*)(Ub + ((size_t)(c >> 4) * M + row) * 16 + (c & 15)) = pack8(f); }
                } }
    }
};

struct EpiGlu {
    static constexpr bool PERM = true, AFTER_DRAIN = false;
    const bf16_t* Z; bf16_t* MIX; const float* bglu;
    __device__ __forceinline__ void operator()(const f32x4 (&acc)[2][2][4][2], const Unit& u, int wr, int wc, int fr, int fq) const {
        const int row0 = u.pm * BM + wr * 64 + fr, col0 = u.pn * BM + wc * 32 + 8 * fq;
#pragma unroll
        for (int bj = 0; bj < 2; ++bj) { const int c = col0 + bj * HALF;
            const f32x4 b0 = *(const f32x4*)(bglu + c), b1 = *(const f32x4*)(bglu + c + 4);
#pragma unroll
            for (int ai = 0; ai < 2; ++ai)
#pragma unroll
                for (int m = 0; m < 4; ++m) { const int row = row0 + ai * HALF + m * 16;
                    const f32x4 v0 = acc[ai][bj][m][0] + b0, v1 = acc[ai][bj][m][1] + b1;
                    float z[8]; unpack8(*(const u32x4*)(Z + (size_t)row * 512 + c), z);
                    float f[8] = {v0[0], v0[1], v0[2], v0[3], v1[0], v1[1], v1[2], v1[3]};
#pragma unroll
                    for (int j = 0; j < 8; ++j) f[j] = z[j] / (1.f + __expf(-f[j]));
                    *(u32x4*)(MIX + (size_t)row * 1024 + 512 + c) = pack8(f); } }
    }
};

struct EpiOut {
    static constexpr bool PERM = true, AFTER_DRAIN = false;
    bf16_t* H; float alpha;
    __device__ __forceinline__ void operator()(const f32x4 (&acc)[2][2][4][2], const Unit& u, int wr, int wc, int fr, int fq) const {
        const int row0 = u.pm * BM + wr * 64 + fr, col0 = u.pn * BM + wc * 32 + 8 * fq;
#pragma unroll
        for (int ai = 0; ai < 2; ++ai)
#pragma unroll
            for (int m = 0; m < 4; ++m) { bf16_t* rowp = H + (size_t)(row0 + ai * HALF + m * 16) * 1024 + col0;
#pragma unroll
                for (int bj = 0; bj < 2; ++bj) { const f32x4 v0 = acc[ai][bj][m][0], v1 = acc[ai][bj][m][1];
                    float h[8]; unpack8(*(const u32x4*)(rowp + bj * HALF), h);
                    float f[8] = {v0[0], v0[1], v0[2], v0[3], v1[0], v1[1], v1[2], v1[3]};
#pragma unroll
                    for (int j = 0; j < 8; ++j) f[j] = alpha * h[j] + f[j];
                    *(u32x4*)(rowp + bj * HALF) = pack8(f); } }
    }
};

template <class Epi, class Sched, bool ALIGN_EPI = false, bool SP2 = false>
__device__ __forceinline__ void gemm_phase(PG8_LAS unsigned char* lds, const Gemm g, const Sched& S, const Epi& E) {
    const int tid = threadIdx.x, wid = __builtin_amdgcn_readfirstlane(tid >> 6), lane = tid & 63, wr = wid >> 2, wc = wid & 3, fr = lane & 15, fq = lane >> 4;
    const int K = g.K, nt = K / BK;
    unsigned voffA[2], voffB[2];
#pragma unroll
    for (int i = 0; i < 2; ++i) { int R, C; stage_rc(tid * 16 + i * 8192, R, C); const int Rb = Epi::PERM ? ((R & ~31) + perm32(R & 31)) : R;
        voffA[i] = (unsigned)(R * K + C) * 2u; voffB[i] = (unsigned)(Rb * K + C) * 2u; }
    const size_t kstep = (size_t)(BK * 2);
    const size_t hstep = (size_t)HALF * K * 2;
    const size_t tstep = 2 * hstep;
    const unsigned ldsw = (unsigned)wid * 1024u;
    const int aoff = lds_byte(wr * 64 + fr, fq * 8), boff = lds_byte(wc * 32 + fr, fq * 8);
#define PG8_SA(b, h) (((b) * 2 + (h)) * HTB)
#define PG8_SB(b, h) ((4 + (b) * 2 + (h)) * HTB)
#define PG8_STAGE(bufoff, gbase, voff) do { _Pragma("unroll") for (int _i = 0; _i < 2; ++_i) \
        __builtin_amdgcn_global_load_lds((const unsigned*)((const char*)(gbase) + (voff)[_i]), (PG8_LAS unsigned*)(lds + (bufoff) + ldsw + _i * 8192), 16, 0, 0); } while (0)
#define PG8_LDA(dst, b, h) do { _Pragma("unroll") for (int m = 0; m < 4; ++m) _Pragma("unroll") for (int k = 0; k < 2; ++k) dst[m][k] = *(const PG8_LAS bf16x8*)(lds + PG8_SA(b, h) + aoff + m * 2048 + k * 1024); } while (0)
#define PG8_LDB(dst, b, h) do { _Pragma("unroll") for (int n = 0; n < 2; ++n) _Pragma("unroll") for (int k = 0; k < 2; ++k) dst[n][k] = *(const PG8_LAS bf16x8*)(lds + PG8_SB(b, h) + boff + n * 2048 + k * 1024); } while (0)
#define PG8_MMA(ai, bj, At, Bt) do { __builtin_amdgcn_s_setprio(1); _Pragma("unroll") for (int m = 0; m < 4; ++m) _Pragma("unroll") for (int n = 0; n < 2; ++n) _Pragma("unroll") for (int k = 0; k < 2; ++k) \
        acc[ai][bj][m][n] = __builtin_amdgcn_mfma_f32_16x16x32_bf16(Bt[n][k], At[m][k], acc[ai][bj][m][n], 0, 0, 0); __builtin_amdgcn_s_setprio(0); } while (0)
#define PG8_WAIT_V(n) asm volatile("s_waitcnt vmcnt(" #n ")" ::: "memory")
#define PG8_WAIT_L(n) asm volatile("s_waitcnt lgkmcnt(" #n ")" ::: "memory")
#define PG8_BAR __builtin_amdgcn_s_barrier()
#define PG8_SCHED __builtin_amdgcn_sched_barrier(0)
    Unit cur, nxt; int ui = 0;
    if (!S.next(0, cur)) return;
    f32x4 acc[2][2][4][2];
#pragma unroll
    for (int a = 0; a < 2; ++a)
#pragma unroll
        for (int b = 0; b < 2; ++b)
#pragma unroll
            for (int m = 0; m < 4; ++m)
#pragma unroll
                for (int n = 0; n < 2; ++n) acc[a][b][m][n] = (f32x4){0.f, 0.f, 0.f, 0.f};
    bf16x8 At[4][2], B0[2][2], B1[2][2];
    const char* cA = (const char*)g.A + (size_t)cur.pm * tstep; const char* cB = (const char*)g.Bt + (size_t)cur.pn * tstep;
    S.a_ready(cur);
    if constexpr (SP2) {
        PG8_STAGE(PG8_SB(0, 0), cB, voffB); PG8_STAGE(PG8_SB(0, 1), cB + hstep, voffB); PG8_STAGE(PG8_SA(0, 0), cA, voffA); PG8_STAGE(PG8_SA(0, 1), cA + hstep, voffA);
        if (wr == 1) PG8_BAR;
        PG8_WAIT_V(2); PG8_BAR;
        PG8_STAGE(PG8_SB(1, 0), cB + kstep, voffB); PG8_STAGE(PG8_SA(1, 0), cA + kstep, voffA); PG8_STAGE(PG8_SB(1, 1), cB + hstep + kstep, voffB);
        PG8_WAIT_V(6); PG8_BAR;
    } else {
        PG8_STAGE(PG8_SB(0, 0), cB, voffB); PG8_STAGE(PG8_SA(0, 0), cA, voffA); PG8_STAGE(PG8_SB(0, 1), cB + hstep, voffB); PG8_STAGE(PG8_SA(0, 1), cA + hstep, voffA);
        if (wr == 1) PG8_BAR;
        PG8_WAIT_V(4); PG8_BAR;
        PG8_STAGE(PG8_SB(1, 0), cB + kstep, voffB); PG8_STAGE(PG8_SA(1, 0), cA + kstep, voffA); PG8_STAGE(PG8_SB(1, 1), cB + hstep + kstep, voffB);
        PG8_WAIT_V(6); PG8_BAR;
    }
    for (;;) {
        const bool has_next = S.next(ui + 1, nxt);
        const char* nA = has_next ? (const char*)g.A + (size_t)nxt.pm * tstep : cA; const char* nB = has_next ? (const char*)g.Bt + (size_t)nxt.pn * tstep : cB;
        for (int t = 0; t < nt; t += 2) {
            const bool last = (t == nt - 2);
            const char* a1 = cA + (size_t)(t + 1) * kstep;
            const char* a2 = last ? nA : cA + (size_t)(t + 2) * kstep; const char* b2 = last ? nB : cB + (size_t)(t + 2) * kstep;
            const char* a3 = a2 + kstep; const char* b3 = b2 + kstep;
            if (last && has_next) S.a_ready(nxt);
            if constexpr (SP2) {
            PG8_LDB(B0, 0, 0); PG8_LDB(B1, 0, 1); PG8_SCHED; PG8_LDA(At, 0, 0); PG8_STAGE(PG8_SA(1, 1), a1 + hstep, voffA);
            PG8_WAIT_V(8); PG8_WAIT_L(0); PG8_BAR; PG8_MMA(0, 0, At, B0); PG8_MMA(0, 1, At, B1); PG8_BAR; PG8_SCHED;
            PG8_LDA(At, 0, 1); PG8_STAGE(PG8_SB(0, 0), b2, voffB); PG8_STAGE(PG8_SB(0, 1), b2 + hstep, voffB); PG8_STAGE(PG8_SA(0, 0), a2, voffA);
            PG8_WAIT_V(8); PG8_WAIT_L(0); PG8_BAR; PG8_MMA(1, 0, At, B0); PG8_MMA(1, 1, At, B1); PG8_BAR; PG8_SCHED;
            PG8_LDB(B0, 1, 0); PG8_LDB(B1, 1, 1); PG8_SCHED; PG8_LDA(At, 1, 0); PG8_STAGE(PG8_SA(0, 1), a2 + hstep, voffA);
            PG8_WAIT_V(8); PG8_WAIT_L(0); PG8_BAR; PG8_MMA(0, 0, At, B0); PG8_MMA(0, 1, At, B1); PG8_BAR; PG8_SCHED;
            PG8_LDA(At, 1, 1); PG8_STAGE(PG8_SB(1, 0), b3, voffB); PG8_STAGE(PG8_SB(1, 1), b3 + hstep, voffB); PG8_STAGE(PG8_SA(1, 0), a3, voffA);
            PG8_WAIT_V(8); PG8_WAIT_L(0); PG8_BAR; PG8_MMA(1, 0, At, B0); PG8_MMA(1, 1, At, B1); PG8_BAR; PG8_SCHED;
            } else {
            PG8_LDB(B0, 0, 0); PG8_SCHED; PG8_LDA(At, 0, 0); PG8_STAGE(PG8_SA(1, 1), a1 + hstep, voffA);
            PG8_WAIT_L(8); PG8_BAR; PG8_WAIT_L(0); PG8_MMA(0, 0, At, B0); PG8_BAR; PG8_SCHED;
            PG8_LDB(B1, 0, 1); PG8_STAGE(PG8_SB(0, 0), b2, voffB);
            PG8_BAR; PG8_WAIT_L(0); PG8_MMA(0, 1, At, B1); PG8_BAR;
            PG8_LDA(At, 0, 1); PG8_STAGE(PG8_SA(0, 0), a2, voffA);
            PG8_BAR; PG8_WAIT_L(0); PG8_MMA(1, 0, At, B0); PG8_BAR; PG8_SCHED;
            PG8_STAGE(PG8_SB(0, 1), b2 + hstep, voffB);
            PG8_WAIT_V(6); PG8_BAR; PG8_MMA(1, 1, At, B1); PG8_BAR;
            PG8_LDB(B0, 1, 0); PG8_SCHED; PG8_LDA(At, 1, 0); PG8_STAGE(PG8_SA(0, 1), a2 + hstep, voffA);
            PG8_WAIT_L(8); PG8_BAR; PG8_WAIT_L(0); PG8_MMA(0, 0, At, B0); PG8_BAR; PG8_SCHED;
            PG8_LDB(B1, 1, 1); PG8_STAGE(PG8_SB(1, 0), b3, voffB);
            PG8_BAR; PG8_WAIT_L(0); PG8_MMA(0, 1, At, B1); PG8_BAR;
            PG8_LDA(At, 1, 1); PG8_STAGE(PG8_SA(1, 0), a3, voffA);
            PG8_BAR; PG8_WAIT_L(0); PG8_MMA(1, 0, At, B0); PG8_BAR; PG8_SCHED;
            PG8_STAGE(PG8_SB(1, 1), b3 + hstep, voffB);
            PG8_WAIT_V(6); PG8_BAR; PG8_MMA(1, 1, At, B1); PG8_BAR;
            }
        }
        if constexpr (ALIGN_EPI) { if (wr == 0) PG8_BAR; }
        if constexpr (!Epi::AFTER_DRAIN) { E(acc, cur, wr, wc, fr, fq); S.done(cur); }
        if (!has_next) break;
#pragma unroll
        for (int a = 0; a < 2; ++a)
#pragma unroll
            for (int b = 0; b < 2; ++b)
#pragma unroll
                for (int m = 0; m < 4; ++m)
#pragma unroll
                    for (int n = 0; n < 2; ++n) acc[a][b][m][n] = (f32x4){0.f, 0.f, 0.f, 0.f};
        cur = nxt; cA = nA; cB = nB; ++ui;
        if constexpr (ALIGN_EPI) { if (wr == 1) PG8_BAR; }
    }
    PG8_WAIT_V(0);
    if constexpr (!ALIGN_EPI) { if (wr == 0) PG8_BAR; }
    PG8_BAR;
    if constexpr (Epi::AFTER_DRAIN) { E.fused(acc, cur, wr, wc, fr, fq, lds, wid, lane); S.done(cur); }
#undef PG8_SA
#undef PG8_SB
#undef PG8_STAGE
#undef PG8_LDA
#undef PG8_LDB
#undef PG8_MMA
#undef PG8_WAIT_V
#undef PG8_WAIT_L
#undef PG8_BAR
#undef PG8_SCHED
}
}

constexpr int NWAVES = 8;
#ifndef MK_N_LAUNCHES
#define MK_N_LAUNCHES 1
#endif
constexpr int N_LAUNCHES = MK_N_LAUNCHES;
constexpr int NPH = 9;

constexpr int BATCH = 8, SEQ = 4096, D = 1024, M = BATCH * SEQ;
constexpr int HGW = 512, HGH = 4, HGK = 128;
constexpr int S5W = 512, S5G = 32, S5P = 16, S5N = 64;
constexpr int NPROJ = 2560;
constexpr int PK = 128, PH = 8, PTOPK = 16, PQ = 256, PHALF = 128, PE = PK * PK, NQ2 = PH * PQ;
constexpr float LN_EPS = 1e-5f, RMS_EPS = 1e-6f;
constexpr float DN_ALPHA = 1.189207115002721f;

constexpr size_t MiB = 1u << 20;
constexpr size_t WS_CTL = 0, CTL_ZERO_BYTES = 1 * MiB;
constexpr size_t WS_WIN = 1 * MiB;
constexpr size_t WS_WGLU = 6 * MiB;
constexpr size_t WS_KEYS = 6 * MiB + 512 * 1024;
constexpr size_t WS_LB = 6 * MiB + 640 * 1024;
constexpr size_t WS_S5T = 6 * MiB + 704 * 1024;
constexpr size_t WS_WOUT = 7 * MiB + 512 * 1024;
constexpr size_t WS_WQ = 10 * MiB;
constexpr size_t WS_PD = 14 * MiB;
constexpr size_t WS_PU = 46 * MiB;
constexpr size_t WS_H = 78 * MiB;
constexpr size_t WS_PROJ = 142 * MiB;
constexpr size_t WS_Q2 = WS_PROJ;
constexpr size_t WS_MIX = 302 * MiB;
constexpr size_t WS_Z = 366 * MiB;
constexpr size_t WS_EIDX = 398 * MiB;
constexpr size_t WS_EGATE = 414 * MiB;
constexpr size_t WS_END = 430 * MiB;
constexpr int CW_TMO = 0, CW_CODE = 1;
constexpr int CW_BAR = 4096;

constexpr int RING_OFF = 0, RING_BYTES = 131072;
constexpr int LDSCTL_OFF = RING_BYTES, MISC_OFF = LDSCTL_OFF + 320;
constexpr int LDS_BYTES = 147456;
static_assert(MISC_OFF + 128 <= LDS_BYTES, "LDS map");

#define GAS __attribute__((address_space(1)))
#define LAS __attribute__((address_space(3)))
typedef unsigned short bf16;
typedef unsigned v4u __attribute__((ext_vector_type(4)));
typedef float f32x4 __attribute__((ext_vector_type(4)));
typedef short bf16x8 __attribute__((ext_vector_type(8)));
typedef GAS unsigned gu32;
typedef GAS unsigned long long gu64;
#define RLX_AGENT __ATOMIC_RELAXED, __HIP_MEMORY_SCOPE_AGENT
#define LDS_WAIT() asm volatile("s_waitcnt lgkmcnt(0)" ::: "memory")
#define VM_WAIT() asm volatile("s_waitcnt vmcnt(0)" ::: "memory")
__device__ __forceinline__ unsigned long long rt() { return __builtin_amdgcn_s_memrealtime(); }
__device__ __forceinline__ unsigned f2bf(float f) { unsigned u = __builtin_bit_cast(unsigned, f); return (u + 0x7fffu + ((u >> 16) & 1u)) >> 16; }
__device__ __forceinline__ unsigned pk2(float lo, float hi) { return f2bf(lo) | (f2bf(hi) << 16); }

#define XB_TMO      128
#define XB_XCNT(j)  (256  + 64 * (j))
#define XB_XSUB(j)  (1280 + 64 * (j))
#define XB_XGEN(j)  (2304 + 64 * (j))
#define XB_TOP      3328
#define XB_TOPGEN   3392
#define XCD_BAR_WORDS 3456
#define XB_SPIN_CAP (1u << 18)

__device__ __forceinline__ unsigned xb_ld(unsigned* p)              { return __hip_atomic_load(p, __ATOMIC_RELAXED, __HIP_MEMORY_SCOPE_AGENT); }
__device__ __forceinline__ unsigned xb_add(unsigned* p, unsigned v) { return __hip_atomic_fetch_add(p, v, __ATOMIC_RELAXED, __HIP_MEMORY_SCOPE_AGENT); }
__device__ __forceinline__ unsigned xb_xcc_id() { return (unsigned)__builtin_amdgcn_s_getreg((3 << 11) | 20) & 0xFu; }
#define XB_SPIN(cond, bar) do { unsigned _sp = 0; while (cond) { __builtin_amdgcn_s_sleep(1); \
    if ((++_sp & 255u) == 0u) { if (xb_ld(&(bar)[XB_TMO])) break; if (_sp > XB_SPIN_CAP) { atomicAdd(&(bar)[XB_TMO], 1u); break; } } } } while (0)

struct XcdBarrier {
    unsigned* bar; unsigned x;
    volatile LAS unsigned* st;
};

__device__ __forceinline__ XcdBarrier xcd_barrier_post(unsigned* bar, volatile LAS unsigned* st) {
    XcdBarrier b; b.bar = bar; b.x = xb_xcc_id(); b.st = st;
    if (threadIdx.x == 0) (void)xb_add(&bar[XB_XCNT(b.x)], 1u);
    return b;
}
__device__ __forceinline__ void xcd_barrier_complete(unsigned* bar, unsigned x, unsigned& nloc, unsigned& nx) {
    const unsigned G = gridDim.x * gridDim.y * gridDim.z;
    unsigned sum, cnt, mine, sp = 0u;
    for (;;) {
        sum = 0u; cnt = 0u; mine = 0u;
#pragma unroll
        for (unsigned j = 0; j < 16; ++j) { const unsigned c = xb_ld(&bar[XB_XCNT(j)]); sum += c; cnt += (c > 0u) ? 1u : 0u; mine = (j == x) ? c : mine; }
        if (sum == G) break;
        __builtin_amdgcn_s_sleep(1);
        if ((++sp & 255u) == 0u) { if (xb_ld(&bar[XB_TMO])) break; if (sp > XB_SPIN_CAP) { atomicAdd(&bar[XB_TMO], 1u); break; } }
    }
    nloc = mine > 0u ? mine : 1u; nx = cnt > 0u ? cnt : 1u;
}

__device__ __forceinline__ void xcd_barrier(const XcdBarrier& b) {
    asm volatile("s_waitcnt vmcnt(0)" ::: "memory");
    __syncthreads();
    if (threadIdx.x == 0) {
        unsigned* bar = b.bar;
        __builtin_amdgcn_s_waitcnt(0);
        unsigned nloc = b.st[0], nx = b.st[1];
        if (nloc == 0u) { xcd_barrier_complete(bar, b.x, nloc, nx); b.st[0] = nloc; b.st[1] = nx; }
        const unsigned old = xb_add(&bar[XB_XSUB(b.x)], 1u);
        const unsigned gen = old / nloc;
        if (old + 1u == (gen + 1u) * nloc) {
            __builtin_amdgcn_fence(__ATOMIC_RELEASE, "agent");
            asm volatile("s_waitcnt vmcnt(0)" ::: "memory");
            const unsigned og = xb_add(&bar[XB_TOP], 1u);
            const unsigned tg = og / nx;
            if (og + 1u == (tg + 1u) * nx) xb_add(&bar[XB_TOPGEN], 1u);
            else XB_SPIN(xb_ld(&bar[XB_TOPGEN]) == tg, bar);
            __builtin_amdgcn_fence(__ATOMIC_ACQUIRE, "agent");
            xb_add(&bar[XB_XGEN(b.x)], 1u);
            asm volatile("s_waitcnt vmcnt(0)" ::: "memory");
        } else {
            XB_SPIN(xb_ld(&bar[XB_XGEN(b.x)]) == gen, bar);
            __builtin_amdgcn_fence(__ATOMIC_ACQUIRE, "agent");
            asm volatile("s_waitcnt vmcnt(0)" ::: "memory");
        }
    }
    __syncthreads();
}

struct Frame {
    LAS unsigned char* lds;
    volatile LAS unsigned* MISC;
    gu32* ctl;
    int tid, lane, wave;
    int vcu, G;
    const float* in[26]; float* out; unsigned char* ws;
};
enum { I_X = 0, I_LN0G, I_LN0B, I_WIN, I_LBL, I_HGNG, I_ARE, I_AIM, I_LSTEP, I_BRE, I_BIM, I_CRE, I_CIM, I_DSK, I_WGLU, I_BGLU, I_WOUT, I_LN1G, I_LN1B, I_WQ, I_K1, I_K2, I_PD, I_PU, I_LN2G, I_LN2B };

__device__ __forceinline__ float bf2f(bf16 v) { return __builtin_bit_cast(float, (unsigned)v << 16); }
__device__ __forceinline__ float wave_sum(float v) {
#pragma unroll
    for (int o = 1; o < 64; o <<= 1) v += __shfl_xor(v, o);
    return v;
}
__device__ __forceinline__ float wave_max(float v) {
#pragma unroll
    for (int o = 1; o < 64; o <<= 1) v = fmaxf(v, __shfl_xor(v, o));
    return v;
}
__device__ __forceinline__ float gelu_tanh(float x) { const float y = 0.7978845608028654f * (x + 0.044715f * x * x * x); return x / (1.f + __expf(-2.f * y)); }
__device__ __forceinline__ float silu_f(float x) { return x / (1.f + __expf(-x)); }
__device__ __forceinline__ void unpack8(const v4u w, float (&f)[8]) {
    f[0] = __builtin_bit_cast(float, w.x << 16); f[1] = __builtin_bit_cast(float, w.x & 0xffff0000u);
    f[2] = __builtin_bit_cast(float, w.y << 16); f[3] = __builtin_bit_cast(float, w.y & 0xffff0000u);
    f[4] = __builtin_bit_cast(float, w.z << 16); f[5] = __builtin_bit_cast(float, w.z & 0xffff0000u);
    f[6] = __builtin_bit_cast(float, w.w << 16); f[7] = __builtin_bit_cast(float, w.w & 0xffff0000u);
}
__device__ __forceinline__ v4u pack8(const float (&f)[8]) { v4u w; w.x = pk2(f[0], f[1]); w.y = pk2(f[2], f[3]); w.z = pk2(f[4], f[5]); w.w = pk2(f[6], f[7]); return w; }

__device__ __forceinline__ void p0_transpose_item(const float* W, int K, int N, bf16* WT, int row_off, LAS float* scr, int item, int lane) {
    const int nblk = N / 32, kb = item / nblk, nb = item % nblk, k0 = 64 * kb, n0 = 32 * nb;
#pragma unroll 8
    for (int i = 0; i < 32; ++i) { const int kk = 2 * i + (lane >> 5); scr[kk * 33 + (lane & 31)] = W[(size_t)(k0 + kk) * N + n0 + (lane & 31)]; }
    LDS_WAIT(); asm volatile("" ::: "memory");
    const int c = lane & 7;
#pragma unroll
    for (int j = 0; j < 4; ++j) { const int n = (lane >> 3) + 8 * j; const LAS float* s = scr + (8 * c) * 33 + n;
        v4u o; o.x = pk2(s[0 * 33], s[1 * 33]); o.y = pk2(s[2 * 33], s[3 * 33]); o.z = pk2(s[4 * 33], s[5 * 33]); o.w = pk2(s[6 * 33], s[7 * 33]);
        *(GAS v4u*)(WT + (size_t)(row_off + n0 + n) * K + k0 + 8 * c) = o; }
    LDS_WAIT(); asm volatile("" ::: "memory");
}
__device__ __forceinline__ void ln0_row(const float* xrow, const float* g, const float* b, bf16* orow, int lane) {
    const GAS f32x4* xr = (const GAS f32x4*)xrow + lane;
    f32x4 v[4]; float s = 0.f;
#pragma unroll
    for (int j = 0; j < 4; ++j) { v[j] = xr[64 * j]; s += (v[j].x + v[j].y) + (v[j].z + v[j].w); }
    const float mean = wave_sum(s) * (1.f / D); float s2 = 0.f;
#pragma unroll
    for (int j = 0; j < 4; ++j) { v[j] = v[j] - mean; s2 += (v[j].x * v[j].x + v[j].y * v[j].y) + (v[j].z * v[j].z + v[j].w * v[j].w); }
    const float rstd = 1.f / sqrtf(wave_sum(s2) * (1.f / D) + LN_EPS);
    GAS unsigned long long* o8 = (GAS unsigned long long*)orow + lane;
#pragma unroll
    for (int j = 0; j < 4; ++j) { const f32x4 gg = ((const GAS f32x4*)g)[lane + 64 * j], bb = ((const GAS f32x4*)b)[lane + 64 * j];
        const f32x4 o = v[j] * rstd * gg + bb;
        o8[64 * j] = (unsigned long long)pk2(o.x, o.y) | ((unsigned long long)pk2(o.z, o.w) << 32); }
}
__device__ __forceinline__ void p0_prologue(Frame& F) {
    LAS float* scr = (LAS float*)(F.lds + RING_OFF + F.wave * 16384);
    const int gw = F.vcu * NWAVES + F.wave, NGW = F.G * NWAVES;
    unsigned char* ws = F.ws;
    constexpr int I_IN = (D / 64) * (NPROJ / 32), I_GLU = (512 / 64) * (512 / 32), I_OUT = (1024 / 64) * (1024 / 32), I_Q = (1024 / 64) * (2048 / 32);
    constexpr int NITEMS = I_IN + I_GLU + I_OUT + I_Q;
    for (int it = gw; it < NITEMS; it += NGW) {
        int r = it;
        if (r < I_IN) { p0_transpose_item(F.in[I_WIN], D, NPROJ, (bf16*)(ws + WS_WIN), 0, scr, r, F.lane); continue; } r -= I_IN;
        if (r < I_GLU) { p0_transpose_item(F.in[I_WGLU], 512, 512, (bf16*)(ws + WS_WGLU), 0, scr, r, F.lane); continue; } r -= I_GLU;
        if (r < I_OUT) { p0_transpose_item(F.in[I_WOUT], 1024, 1024, (bf16*)(ws + WS_WOUT), 0, scr, r, F.lane); continue; } r -= I_OUT;
        p0_transpose_item(F.in[I_WQ], 1024, 2048, (bf16*)(ws + WS_WQ), 0, scr, r, F.lane);
    }
    const int gt = gw * 64 + F.lane, NGT = NGW * 64;
    for (int i = gt; i < 2 * PK * PHALF; i += NGT) { const float v = (i < PK * PHALF) ? F.in[I_K1][i] : F.in[I_K2][i - PK * PHALF]; ((bf16*)(ws + WS_KEYS))[i] = (bf16)f2bf(v); }
    constexpr int NTAB8 = PE * D / 8;
    for (int i = gt; i < 2 * NTAB8; i += NGT) { const bool up = i >= NTAB8; const int j = up ? i - NTAB8 : i; const float* src = (up ? F.in[I_PU] : F.in[I_PD]) + (size_t)j * 8;
        const f32x4 a = *(const GAS f32x4*)src, b = *(const GAS f32x4*)(src + 4);
        v4u o; o.x = pk2(a.x, a.y); o.y = pk2(a.z, a.w); o.z = pk2(b.x, b.y); o.w = pk2(b.z, b.w);
        *(GAS v4u*)((bf16*)(ws + (up ? WS_PU : WS_PD)) + (size_t)j * 8) = o; }
    for (int i = gt; i < HGW; i += NGT) { const float l0 = F.in[I_LBL][i], l1 = F.in[I_LBL][HGW + i]; ((float*)(ws + WS_LB))[i] = 1.f / (1.f + expf(l1 - l0)); }
    for (int i = gt; i < S5G * S5N; i += NGT) { const int g = i / S5N;
        const float are = F.in[I_ARE][i], aim = F.in[I_AIM][i], step = expf(F.in[I_LSTEP][g]);
        const float zr = step * are, zi = step * aim, mag = expf(zr), cz = cosf(zi), sz = sinf(zi), sh = sinf(0.5f * zi);
        const float abr = mag * cz, abi = mag * sz;
        const float nre = expm1f(zr) * cz - 2.f * sh * sh, nim = abi;
        const float den = are * are + aim * aim;
        const float cre = (nre * are + nim * aim) / den, cim = (nim * are - nre * aim) / den;
        float* t = (float*)(ws + WS_S5T) + (size_t)i * 40; t[0] = abr; t[1] = abi;
        for (int p = 0; p < S5P; ++p) { const float br = F.in[I_BRE][(size_t)i * S5P + p], bi = F.in[I_BIM][(size_t)i * S5P + p];
            t[2 + p] = cre * br - cim * bi; t[18 + p] = cre * bi + cim * br; } }
    for (int m = gw; m < M; m += NGW) ln0_row(F.in[I_X] + (size_t)m * D, F.in[I_LN0G], F.in[I_LN0B], (bf16*)(ws + WS_H) + (size_t)m * D, F.lane);
}

__device__ __forceinline__ void hgrn2_seq(Frame& F, int bh) {
    const int b = bh >> 2, h = bh & 3, tid = F.tid, kq = tid >> 7, j = tid & 127;
    LAS float* sF = (LAS float*)(F.lds + RING_OFF);
    LAS float* sK = sF + 8 * 128; LAS float* sQ = sK + 8 * 128;
    LAS float* sO = sQ + 8 * 128;
    const bf16* Qb = (const bf16*)(F.ws + WS_PROJ); const bf16* LFb = Qb + (size_t)M * 512; const bf16* Vb = LFb + (size_t)M * 512; const bf16* Gb = Vb + (size_t)M * 512;
    bf16* MIX = (bf16*)(F.ws + WS_MIX);
    const float ng0 = F.in[I_HGNG][F.lane], ng1 = F.in[I_HGNG][F.lane + 64];
    float S[32];
#pragma unroll
    for (int k = 0; k < 32; ++k) S[k] = 0.f;
    for (int t0 = 0; t0 < SEQ; t0 += 8) {
        const size_t tok0 = (size_t)b * SEQ + t0;
#pragma unroll
        for (int r = 0; r < 2; ++r) { const int item = tid + 512 * r, tt = item >> 7, kk = item & 127; const size_t off = (tok0 + tt) * 512 + h * 128 + kk;
            const float lf = bf2f(LFb[off]); sF[tt * 128 + kk] = __expf(lf); sK[tt * 128 + kk] = -expm1f(lf); sQ[tt * 128 + kk] = bf2f(Qb[off]); }
        __syncthreads();
#pragma unroll 1
        for (int tt = 0; tt < 8; ++tt) { const float v = bf2f(Vb[(tok0 + tt) * 512 + h * 128 + j]); float o = 0.f;
            const LAS float* f = sF + tt * 128 + kq * 32; const LAS float* kx = sK + tt * 128 + kq * 32; const LAS float* q = sQ + tt * 128 + kq * 32;
#pragma unroll
            for (int k = 0; k < 32; ++k) { S[k] = f[k] * S[k] + kx[k] * v; o += q[k] * S[k]; }
            sO[(tt * 4 + kq) * 128 + j] = o; }
        __syncthreads();
        { const int tt = F.wave; const size_t tok = tok0 + tt;
            const float o0 = (sO[(tt * 4 + 0) * 128 + F.lane] + sO[(tt * 4 + 1) * 128 + F.lane]) + (sO[(tt * 4 + 2) * 128 + F.lane] + sO[(tt * 4 + 3) * 128 + F.lane]);
            const float o1 = (sO[(tt * 4 + 0) * 128 + 64 + F.lane] + sO[(tt * 4 + 1) * 128 + 64 + F.lane]) + (sO[(tt * 4 + 2) * 128 + 64 + F.lane] + sO[(tt * 4 + 3) * 128 + 64 + F.lane]);
            const float ss = wave_sum(o0 * o0 + o1 * o1), r = 1.f / sqrtf(ss * (1.f / 128.f) + RMS_EPS);
            const float g0 = bf2f(Gb[tok * 512 + h * 128 + F.lane]), g1 = bf2f(Gb[tok * 512 + h * 128 + 64 + F.lane]);
            MIX[tok * 1024 + h * 128 + F.lane] = (bf16)f2bf(o0 * r * ng0 * silu_f(g0));
            MIX[tok * 1024 + h * 128 + 64 + F.lane] = (bf16)f2bf(o1 * r * ng1 * silu_f(g1)); }
    }
    __syncthreads();
}
__device__ __forceinline__ void s5_seq(Frame& F, int pair) {
    const int b = pair >> 5, g = pair & 31, lane = F.lane;
    const float* tb = (const float*)(F.ws + WS_S5T) + (size_t)(g * S5N + lane) * 40;
    const float abr = tb[0], abi = tb[1];
    float bbr[16], bbi[16], cr[16], ci[16], dsk[16];
#pragma unroll
    for (int p = 0; p < 16; ++p) { bbr[p] = tb[2 + p]; bbi[p] = tb[18 + p]; cr[p] = F.in[I_CRE][(size_t)(g * 16 + p) * S5N + lane]; ci[p] = F.in[I_CIM][(size_t)(g * 16 + p) * S5N + lane];
        dsk[p] = (lane == 0) ? F.in[I_DSK][g * 16 + p] : 0.f; }
    const bf16* Ub = (const bf16*)(F.ws + WS_PROJ) + (size_t)4 * M * 512 + ((size_t)g * M + (size_t)b * SEQ) * 16;
    bf16* Zb = (bf16*)(F.ws + WS_Z) + (size_t)b * SEQ * 512 + g * 16;
    const int pme = ((lane >> 5) & 1) * 8 + ((lane >> 4) & 1) * 4 + ((lane >> 3) & 1) * 2 + ((lane >> 2) & 1);
    float xr = 0.f, xi = 0.f;
    v4u nu0 = *(const GAS v4u*)(Ub + (size_t)lane * 16), nu1 = *(const GAS v4u*)(Ub + (size_t)lane * 16 + 8);
    for (int t0 = 0; t0 < SEQ; t0 += 64) {
        const v4u u0 = nu0, u1 = nu1;
        if (t0 + 64 < SEQ) { nu0 = *(const GAS v4u*)(Ub + (size_t)(t0 + 64 + lane) * 16); nu1 = *(const GAS v4u*)(Ub + (size_t)(t0 + 64 + lane) * 16 + 8); }
#pragma unroll 1
        for (int tt = 0; tt < 64; ++tt) {
            v4u a, c;
            a.x = __builtin_amdgcn_readlane(u0.x, tt); a.y = __builtin_amdgcn_readlane(u0.y, tt); a.z = __builtin_amdgcn_readlane(u0.z, tt); a.w = __builtin_amdgcn_readlane(u0.w, tt);
            c.x = __builtin_amdgcn_readlane(u1.x, tt); c.y = __builtin_amdgcn_readlane(u1.y, tt); c.z = __builtin_amdgcn_readlane(u1.z, tt); c.w = __builtin_amdgcn_readlane(u1.w, tt);
            float u[16]; { float f0[8], f1[8]; unpack8(a, f0); unpack8(c, f1);
#pragma unroll
                for (int p = 0; p < 8; ++p) { u[p] = f0[p]; u[8 + p] = f1[p]; } }
            float bur = 0.f, bui = 0.f;
#pragma unroll
            for (int p = 0; p < 16; ++p) { bur += bbr[p] * u[p]; bui += bbi[p] * u[p]; }
            const float nxr = abr * xr - abi * xi + bur, nxi = abr * xi + abi * xr + bui; xr = nxr; xi = nxi;
            float r[16];
#pragma unroll
            for (int p = 0; p < 16; ++p) r[p] = cr[p] * xr - ci[p] * xi + dsk[p] * u[p];
#pragma unroll
            for (int i = 0; i < 8; ++i) { const float keep = (lane & 32) ? r[i + 8] : r[i], send = (lane & 32) ? r[i] : r[i + 8]; r[i] = keep + __shfl_xor(send, 32); }
#pragma unroll
            for (int i = 0; i < 4; ++i) { const float keep = (lane & 16) ? r[i + 4] : r[i], send = (lane & 16) ? r[i] : r[i + 4]; r[i] = keep + __shfl_xor(send, 16); }
#pragma unroll
            for (int i = 0; i < 2; ++i) { const float keep = (lane & 8) ? r[i + 2] : r[i], send = (lane & 8) ? r[i] : r[i + 2]; r[i] = keep + __shfl_xor(send, 8); }
            { const float keep = (lane & 4) ? r[1] : r[0], send = (lane & 4) ? r[0] : r[1]; r[0] = keep + __shfl_xor(send, 4); }
            r[0] += __shfl_xor(r[0], 2); r[0] += __shfl_xor(r[0], 1);
            if ((lane & 3) == 0) Zb[(size_t)(t0 + tt) * 512 + pme] = (bf16)f2bf(gelu_tanh(r[0]));
        }
    }
}

__device__ __forceinline__ void ln1_row(bf16* row, const float* g, const float* b, int lane) {
    const v4u w0 = *(const GAS v4u*)(row + lane * 8), w1 = *(const GAS v4u*)(row + 512 + lane * 8);
    float a[8], c[8]; unpack8(w0, a); unpack8(w1, c);
    float s = 0.f;
#pragma unroll
    for (int j = 0; j < 8; ++j) s += a[j] + c[j];
    const float mean = wave_sum(s) * (1.f / D); float s2 = 0.f;
#pragma unroll
    for (int j = 0; j < 8; ++j) { a[j] -= mean; c[j] -= mean; s2 += a[j] * a[j] + c[j] * c[j]; }
    const float rstd = 1.f / sqrtf(wave_sum(s2) * (1.f / D) + LN_EPS);
    const f32x4 g0 = *(const GAS f32x4*)(g + lane * 8), g1 = *(const GAS f32x4*)(g + lane * 8 + 4), g2 = *(const GAS f32x4*)(g + 512 + lane * 8), g3 = *(const GAS f32x4*)(g + 512 + lane * 8 + 4);
    const f32x4 b0 = *(const GAS f32x4*)(b + lane * 8), b1 = *(const GAS f32x4*)(b + lane * 8 + 4), b2 = *(const GAS f32x4*)(b + 512 + lane * 8), b3 = *(const GAS f32x4*)(b + 512 + lane * 8 + 4);
    const float gg0[8] = {g0.x, g0.y, g0.z, g0.w, g1.x, g1.y, g1.z, g1.w}, gg1[8] = {g2.x, g2.y, g2.z, g2.w, g3.x, g3.y, g3.z, g3.w};
    const float bb0[8] = {b0.x, b0.y, b0.z, b0.w, b1.x, b1.y, b1.z, b1.w}, bb1[8] = {b2.x, b2.y, b2.z, b2.w, b3.x, b3.y, b3.z, b3.w};
#pragma unroll
    for (int j = 0; j < 8; ++j) { a[j] = a[j] * rstd * gg0[j] + bb0[j]; c[j] = c[j] * rstd * gg1[j] + bb1[j]; }
    *(GAS v4u*)(row + lane * 8) = pack8(a); *(GAS v4u*)(row + 512 + lane * 8) = pack8(c);
}

__device__ __forceinline__ void peer_score_phase(Frame& F) {
    LAS unsigned* sk = (LAS unsigned*)(F.lds + RING_OFF);
    LAS unsigned* wsq = (LAS unsigned*)(F.lds + RING_OFF + 65536 + F.wave * 1024);
    LAS float* wv = (LAS float*)(wsq + 128);
    LAS int* wi = (LAS int*)(wsq + 160);
    const unsigned* keys = (const unsigned*)(F.ws + WS_KEYS);
    for (int i = F.tid; i < 2 * 64 * 128; i += NWAVES * 64) { const int s = i >> 13, dp = (i >> 7) & 63, n = i & 127; sk[i] = keys[(s * 128 + n) * 64 + dp]; }
    __syncthreads();
    const int gw = F.vcu * NWAVES + F.wave, NGW = F.G * NWAVES, lane = F.lane;
    const bf16* Q2 = (const bf16*)(F.ws + WS_Q2);
    int* EIDX = (int*)(F.ws + WS_EIDX); float* EGATE = (float*)(F.ws + WS_EGATE);
    for (int item = gw; item < M * PH; item += NGW) {
        const size_t tok = item >> 3; const int h = item & 7;
        const unsigned* qrow = (const unsigned*)(Q2 + tok * NQ2 + h * PQ);
        wsq[lane] = qrow[lane]; wsq[64 + lane] = qrow[64 + lane];
        LDS_WAIT();
        float vtop[2][16]; int itop[2][16];
#pragma unroll
        for (int s = 0; s < 2; ++s) {
            float a0 = 0.f, a1 = 0.f;
            const LAS unsigned* kk = sk + s * 8192;
#pragma unroll 8
            for (int dp = 0; dp < 64; ++dp) { const unsigned qd = wsq[s * 64 + dp], k0 = kk[dp * 128 + lane], k1 = kk[dp * 128 + 64 + lane];
                const float q0 = __builtin_bit_cast(float, qd << 16), q1 = __builtin_bit_cast(float, qd & 0xffff0000u);
                a0 += q0 * __builtin_bit_cast(float, k0 << 16) + q1 * __builtin_bit_cast(float, k0 & 0xffff0000u);
                a1 += q0 * __builtin_bit_cast(float, k1 << 16) + q1 * __builtin_bit_cast(float, k1 & 0xffff0000u); }
#pragma unroll
            for (int r = 0; r < 16; ++r) { const float m = fmaxf(a0, a1), wm = wave_max(m);
                const unsigned long long bal = __ballot(m == wm); const int wl = __ffsll((long long)bal) - 1;
                const int myidx = (a0 >= a1) ? lane : lane + 64;
                const int idx = __shfl(myidx, wl);
                if (lane == wl) { if (a0 >= a1) a0 = -3.0e38f; else a1 = -3.0e38f; }
                vtop[s][r] = wm; itop[s][r] = idx; }
        }
        if (lane < 16) {
#pragma unroll
            for (int r = 0; r < 16; ++r) if (lane == r) { wv[r] = vtop[0][r]; wv[16 + r] = vtop[1][r]; wi[r] = itop[0][r]; wi[16 + r] = itop[1][r]; }
        }
        LDS_WAIT();
        float cand[4];
#pragma unroll
        for (int r = 0; r < 4; ++r) cand[r] = wv[(lane >> 4) + 4 * r] + wv[16 + (lane & 15)];
        float mybest = 0.f; int mypos = 0;
#pragma unroll
        for (int rr = 0; rr < 16; ++rr) { const float m = fmaxf(fmaxf(cand[0], cand[1]), fmaxf(cand[2], cand[3])), wm = wave_max(m);
            const unsigned long long bal = __ballot(m == wm); const int wl = __ffsll((long long)bal) - 1;
            const int myr = (cand[0] == m) ? 0 : (cand[1] == m) ? 1 : (cand[2] == m) ? 2 : 3;
            const int pos = __shfl(lane + 64 * myr, wl);
            if (lane == wl) { if (myr == 0) cand[0] = -3.0e38f; else if (myr == 1) cand[1] = -3.0e38f; else if (myr == 2) cand[2] = -3.0e38f; else cand[3] = -3.0e38f; }
            if (lane == rr) { mybest = wm; mypos = pos; } }
        const float mx = __shfl(mybest, 0);
        float e = (lane < 16) ? __expf(mybest - mx) : 0.f;
        float sum = e; sum += __shfl_xor(sum, 8); sum += __shfl_xor(sum, 4); sum += __shfl_xor(sum, 2); sum += __shfl_xor(sum, 1);
        if (lane < 16) { const int ex = wi[mypos >> 4] * PK + wi[16 + (mypos & 15)]; EIDX[(size_t)item * 16 + lane] = ex; EGATE[(size_t)item * 16 + lane] = e / sum; }
        LDS_WAIT();
    }
}

__device__ __forceinline__ void peer_gather_phase(Frame& F) {
    const int gw = F.vcu * NWAVES + F.wave, NGW = F.G * NWAVES, lane = F.lane;
    const bf16* H1 = (const bf16*)(F.ws + WS_H); const bf16* PD = (const bf16*)(F.ws + WS_PD); const bf16* PU = (const bf16*)(F.ws + WS_PU);
    const int* EIDX = (const int*)(F.ws + WS_EIDX); const float* EGATE = (const float*)(F.ws + WS_EGATE);
    const int rep = ((lane >> 5) & 1) * 4 + ((lane >> 4) & 1) * 2 + ((lane >> 3) & 1);
    for (int tok = gw; tok < M; tok += NGW) {
        float x0[8], x1[8]; unpack8(*(const GAS v4u*)(H1 + (size_t)tok * D + lane * 8), x0); unpack8(*(const GAS v4u*)(H1 + (size_t)tok * D + 512 + lane * 8), x1);
        const int e0 = EIDX[(size_t)tok * 128 + lane], e1 = EIDX[(size_t)tok * 128 + 64 + lane];
        const float g0 = EGATE[(size_t)tok * 128 + lane], g1 = EGATE[(size_t)tok * 128 + 64 + lane];
        float o0[8], o1[8];
#pragma unroll
        for (int j = 0; j < 8; ++j) { o0[j] = 0.f; o1[j] = 0.f; }
#pragma unroll 1
        for (int bt = 0; bt < 16; ++bt) {
            const int ev = (bt < 8) ? e0 : e1; const float gv = (bt < 8) ? g0 : g1; const int lb8 = (bt & 7) * 8;
            v4u dw[8][2], uw[8][2];
#pragma unroll
            for (int i = 0; i < 8; ++i) { const int e = __builtin_amdgcn_readlane(ev, lb8 + i);
                const bf16* dr = PD + (size_t)e * D; const bf16* ur = PU + (size_t)e * D;
                dw[i][0] = *(const GAS v4u*)(dr + lane * 8); dw[i][1] = *(const GAS v4u*)(dr + 512 + lane * 8);
                uw[i][0] = *(const GAS v4u*)(ur + lane * 8); uw[i][1] = *(const GAS v4u*)(ur + 512 + lane * 8); }
            float p[8];
#pragma unroll
            for (int i = 0; i < 8; ++i) { float a[8], c[8]; unpack8(dw[i][0], a); unpack8(dw[i][1], c); float s = 0.f;
#pragma unroll
                for (int j = 0; j < 8; ++j) s += a[j] * x0[j] + c[j] * x1[j];
                p[i] = s; }
#pragma unroll
            for (int i = 0; i < 4; ++i) { const float keep = (lane & 32) ? p[i + 4] : p[i], send = (lane & 32) ? p[i] : p[i + 4]; p[i] = keep + __shfl_xor(send, 32); }
#pragma unroll
            for (int i = 0; i < 2; ++i) { const float keep = (lane & 16) ? p[i + 2] : p[i], send = (lane & 16) ? p[i] : p[i + 2]; p[i] = keep + __shfl_xor(send, 16); }
            { const float keep = (lane & 8) ? p[1] : p[0], send = (lane & 8) ? p[0] : p[1]; p[0] = keep + __shfl_xor(send, 8); }
            p[0] += __shfl_xor(p[0], 4); p[0] += __shfl_xor(p[0], 2); p[0] += __shfl_xor(p[0], 1);
            const float gate = __shfl(gv, lb8 + rep);
            const float act = gelu_tanh(p[0]) * gate;
#pragma unroll
            for (int i = 0; i < 8; ++i) { const float af = __builtin_bit_cast(float, __builtin_amdgcn_readlane(__builtin_bit_cast(int, act), ((i >> 2) & 1) * 32 + ((i >> 1) & 1) * 16 + (i & 1) * 8));
                float a[8], c[8]; unpack8(uw[i][0], a); unpack8(uw[i][1], c);
#pragma unroll
                for (int j = 0; j < 8; ++j) { o0[j] += af * a[j]; o1[j] += af * c[j]; } }
        }
        float s = 0.f;
#pragma unroll
        for (int j = 0; j < 8; ++j) { o0[j] += DN_ALPHA * x0[j]; o1[j] += DN_ALPHA * x1[j]; s += o0[j] + o1[j]; }
        const float mean = wave_sum(s) * (1.f / D); float s2 = 0.f;
#pragma unroll
        for (int j = 0; j < 8; ++j) { o0[j] -= mean; o1[j] -= mean; s2 += o0[j] * o0[j] + o1[j] * o1[j]; }
        const float rstd = 1.f / sqrtf(wave_sum(s2) * (1.f / D) + LN_EPS);
        const float* g = F.in[I_LN2G]; const float* b = F.in[I_LN2B];
        float* orow = F.out + (size_t)tok * D;
#pragma unroll
        for (int q = 0; q < 2; ++q) { const int c0 = lane * 8 + 4 * q;
            const f32x4 ga = *(const GAS f32x4*)(g + c0), ba = *(const GAS f32x4*)(b + c0), gb = *(const GAS f32x4*)(g + 512 + c0), bb = *(const GAS f32x4*)(b + 512 + c0);
            f32x4 ya, yb;
            ya.x = o0[4 * q + 0] * rstd * ga.x + ba.x; ya.y = o0[4 * q + 1] * rstd * ga.y + ba.y; ya.z = o0[4 * q + 2] * rstd * ga.z + ba.z; ya.w = o0[4 * q + 3] * rstd * ga.w + ba.w;
            yb.x = o1[4 * q + 0] * rstd * gb.x + bb.x; yb.y = o1[4 * q + 1] * rstd * gb.y + bb.y; yb.z = o1[4 * q + 2] * rstd * gb.z + bb.z; yb.w = o1[4 * q + 3] * rstd * gb.w + bb.w;
            *(GAS f32x4*)(orow + c0) = ya; *(GAS f32x4*)(orow + 512 + c0) = yb; }
    }
}

struct Args { const float* in[26]; float* out; unsigned char* ws; int ph_lo, ph_hi, li, pad; };
__global__ void __launch_bounds__(NWAVES * 64, 2) fwd_kernel(Args args) {
    extern __shared__ __attribute__((aligned(16))) unsigned char lds[];
    Frame F;
    F.lds = (LAS unsigned char*)lds;
    F.MISC = (volatile LAS unsigned*)(F.lds + MISC_OFF);
    F.tid = threadIdx.x; F.lane = F.tid & 63; F.wave = __builtin_amdgcn_readfirstlane(F.tid >> 6);
    F.G = gridDim.x; { const int bx = blockIdx.x; F.vcu = (F.G % 8 == 0) ? (bx % 8) * (F.G / 8) + bx / 8 : bx; }
#pragma unroll
    for (int i = 0; i < 26; ++i) F.in[i] = args.in[i];
    F.out = args.out; F.ws = args.ws;
    unsigned char* ws = args.ws;
    F.ctl = (gu32*)(ws + WS_CTL);
    for (int u = F.tid; u < (LDS_BYTES - LDSCTL_OFF) / 4; u += NWAVES * 64) ((LAS unsigned*)(F.lds + LDSCTL_OFF))[u] = 0u;
    __syncthreads();
    XcdBarrier bar; bar.bar = (unsigned*)(F.ctl + CW_BAR); bar.x = 0; bar.st = nullptr;
    if (N_LAUNCHES == 1) bar = xcd_barrier_post((unsigned*)(F.ctl + CW_BAR), F.MISC + 8);
#define GRID_BAR() do { if (N_LAUNCHES == 1) xcd_barrier(bar); } while (0)
    const int lo = args.ph_lo, hi = args.ph_hi;
#define IN(k) (lo <= (k) && (k) < hi)
#define BOTH(k) (IN(k) && IN((k) + 1))
    bf16* const Hb = (bf16*)(ws + WS_H);
    bf16* const PRJ = (bf16*)(ws + WS_PROJ);

    if (IN(0)) { p0_prologue(F); if (BOTH(0)) GRID_BAR(); }

    if (IN(1)) {
        pg8::Gemm g{Hb, (const bf16*)(ws + WS_WIN), M, NPROJ, D}; pg8::StaticOrder S; S.init(M, NPROJ, F.G, (int)blockIdx.x);
        pg8::EpiProj E{PRJ, PRJ + (size_t)M * 512, PRJ + (size_t)2 * M * 512, PRJ + (size_t)3 * M * 512, PRJ + (size_t)4 * M * 512, (const float*)(ws + WS_LB), M};
        pg8::gemm_phase<pg8::EpiProj, pg8::StaticOrder, true, true>(F.lds + RING_OFF, g, S, E);
        if (BOTH(1)) GRID_BAR();
    }

    if (IN(2)) {
        if (F.vcu < 32) hgrn2_seq(F, F.vcu);
        else if (F.vcu < 64) s5_seq(F, (F.vcu - 32) * NWAVES + F.wave);
        if (BOTH(2)) GRID_BAR();
    }

    if (IN(3)) {
        pg8::Gemm g{(const bf16*)(ws + WS_Z), (const bf16*)(ws + WS_WGLU), M, 512, 512}; pg8::StaticOrder S; S.init(M, 512, F.G, (int)blockIdx.x);
        pg8::EpiGlu E{(const bf16*)(ws + WS_Z), (bf16*)(ws + WS_MIX), F.in[I_BGLU]};
        pg8::gemm_phase<pg8::EpiGlu, pg8::StaticOrder, true, true>(F.lds + RING_OFF, g, S, E);
        if (BOTH(3)) GRID_BAR();
    }

    if (IN(4)) {
        pg8::Gemm g{(const bf16*)(ws + WS_MIX), (const bf16*)(ws + WS_WOUT), M, D, D}; pg8::StaticOrder S; S.init(M, D, F.G, (int)blockIdx.x);
        pg8::EpiOut E{Hb, DN_ALPHA};
        pg8::gemm_phase<pg8::EpiOut, pg8::StaticOrder, true, true>(F.lds + RING_OFF, g, S, E);
        if (BOTH(4)) GRID_BAR();
    }

    if (IN(5)) {
        const int gw = F.vcu * NWAVES + F.wave, NGW = F.G * NWAVES;
        for (int m = gw; m < M; m += NGW) ln1_row(Hb + (size_t)m * D, F.in[I_LN1G], F.in[I_LN1B], F.lane);
        if (BOTH(5)) GRID_BAR();
    }

    if (IN(6)) {
        pg8::Gemm g{Hb, (const bf16*)(ws + WS_WQ), M, NQ2, D}; pg8::StaticOrder S; S.init(M, NQ2, F.G, (int)blockIdx.x);
        pg8::EpiStore E{(bf16*)(ws + WS_Q2), NQ2};
        pg8::gemm_phase<pg8::EpiStore, pg8::StaticOrder, true, true>(F.lds + RING_OFF, g, S, E);
        if (BOTH(6)) GRID_BAR();
    }

    if (IN(7)) { peer_score_phase(F); if (BOTH(7)) GRID_BAR(); }

    if (IN(8)) { peer_gather_phase(F); }
#undef IN
#undef BOTH
}

extern "C" void kernel_launch(void* const* d_in, const int* in_sizes, int n_in, void* d_out, int out_size, void* d_ws, size_t ws_size, hipStream_t stream) {
    static int grid = 0;
    if (grid == 0) {
        if (n_in != 26 || in_sizes[0] != M * D || out_size != M * D || ws_size < WS_END) { fprintf(stderr, "kernel_launch: unexpected shapes: n_in %d in0 %d out %d ws %zu (need %zu)\n", n_in, n_in > 0 ? in_sizes[0] : -1, out_size, ws_size, (size_t)WS_END); grid = -1; return; }
        int dev = 0, cus = 0;
        if (hipGetDevice(&dev) != hipSuccess || hipDeviceGetAttribute(&cus, hipDeviceAttributeMultiprocessorCount, dev) != hipSuccess) { grid = -1; return; }
        if (hipFuncSetAttribute((const void*)fwd_kernel, hipFuncAttributeMaxDynamicSharedMemorySize, LDS_BYTES) != hipSuccess) { fprintf(stderr, "kernel_launch: hipFuncSetAttribute failed\n"); grid = -1; return; }
        (void)hipGetLastError();
        grid = cus;
    }
    if (grid < 0) return;
    if (hipMemsetAsync((char*)d_ws + WS_CTL, 0, CTL_ZERO_BYTES, stream) != hipSuccess) return;
    Args a{};
    for (int i = 0; i < 26; ++i) a.in[i] = (const float*)d_in[i];
    a.out = (float*)d_out; a.ws = (unsigned char*)d_ws;
    if (N_LAUNCHES == 1) { a.ph_lo = 0; a.ph_hi = NPH; a.li = 0; hipLaunchKernelGGL(fwd_kernel, dim3(grid), dim3(NWAVES * 64), LDS_BYTES, stream, a); }
    else for (int li = 0; li < NPH; ++li) { a.ph_lo = li; a.ph_hi = li + 1; a.li = li; hipLaunchKernelGGL(fwd_kernel, dim3(grid), dim3(NWAVES * 64), LDS_BYTES, stream, a); }
}
```

```cpp
#include <hip/hip_runtime.h>
#include <cstdio>
#include <cstdint>
namespace pg8 {
#define PG8_LAS __attribute__((address_space(3)))
typedef unsigned short bf16_t;
typedef short bf16x8 __attribute__((ext_vector_type(8)));
typedef float f32x4 __attribute__((ext_vector_type(4)));
typedef unsigned u32x4 __attribute__((ext_vector_type(4)));
constexpr int BM = 256, BK = 64, HALF = 128, HTB = HALF * BK * 2  , STAGE_BYTES = 8 * HTB, NXCD = 8, WGM = 8;

__host__ __device__ __forceinline__ int lds_byte(int r, int c) { const int st = (r >> 4) * 2 + (c >> 5), rr = r & 15, cc = c & 31, ob = rr * 64 + cc * 2; return st * 1024 + (ob ^ (((ob >> 9) & 1) << 5)); }
__host__ __device__ __forceinline__ void stage_rc(int b, int& R, int& C) { const int st = b / 1024, sb = b % 1024, swz = sb ^ (((sb >> 9) & 1) << 5); R = (st >> 1) * 16 + swz / 64; C = (st & 1) * 32 + (swz % 64) / 2; }
__host__ __device__ __forceinline__ int perm32(int rho) { const int n = rho >> 4, i = rho & 15; return 8 * (i >> 2) + 4 * n + (i & 3); }

struct Unit { int pm, pn; };
struct Gemm { const bf16_t* A; const bf16_t* Bt; int M, N, K; };

struct StaticOrder {
    int nM, nN, nwg, G, c;
    __host__ __device__ void init(int M, int N, int G_, int c_) { nM = M / BM; nN = N / BM; nwg = nM * nN; G = G_; c = c_; }
    __host__ __device__ bool next(int i, Unit& u) const {
        const long L = (long)i * G + c; if (L >= nwg) return false;
        int wgid = (int)L; { const int q = nwg / NXCD, r = nwg % NXCD, xcd = wgid % NXCD, off = wgid / NXCD; wgid = (xcd < r ? xcd * (q + 1) : r * (q + 1) + (xcd - r) * q) + off; }
        const int nig = WGM * nN, gid = wgid / nig, fm = gid * WGM, gsz = (nM - fm) < WGM ? (nM - fm) : WGM;
        u.pm = fm + ((wgid % nig) % gsz); u.pn = (wgid % nig) / gsz; return true;
    }
    __device__ __forceinline__ void a_ready(const Unit&) const {}
    __device__ __forceinline__ void done(const Unit&) const {}
};

__device__ __forceinline__ unsigned cvt_pk_bf16(float lo, float hi) { unsigned r; asm volatile("v_cvt_pk_bf16_f32 %0, %1, %2" : "=v"(r) : "v"(lo), "v"(hi)); return r; }
__device__ __forceinline__ void unpack8(const u32x4 w, float (&f)[8]) {
    f[0] = __builtin_bit_cast(float, w.x << 16); f[1] = __builtin_bit_cast(float, w.x & 0xffff0000u);
    f[2] = __builtin_bit_cast(float, w.y << 16); f[3] = __builtin_bit_cast(float, w.y & 0xffff0000u);
    f[4] = __builtin_bit_cast(float, w.z << 16); f[5] = __builtin_bit_cast(float, w.z & 0xffff0000u);
    f[6] = __builtin_bit_cast(float, w.w << 16); f[7] = __builtin_bit_cast(float, w.w & 0xffff0000u);
}
__device__ __forceinline__ u32x4 pack8(const float (&f)[8]) { u32x4 w; w.x = cvt_pk_bf16(f[0], f[1]); w.y = cvt_pk_bf16(f[2], f[3]); w.z = cvt_pk_bf16(f[4], f[5]); w.w = cvt_pk_bf16(f[6], f[7]); return w; }

struct EpiStore {
    static constexpr bool PERM = true, AFTER_DRAIN = false;
    bf16_t* O; int ldc;
    __device__ __forceinline__ void operator()(const f32x4 (&acc)[2][2][4][2], const Unit& u, int wr, int wc, int fr, int fq) const {
        const int row0 = u.pm * BM + wr * 64 + fr, col0 = u.pn * BM + wc * 32 + 8 * fq;
#pragma unroll
        for (int ai = 0; ai < 2; ++ai)
#pragma unroll
            for (int m = 0; m < 4; ++m) { bf16_t* rowp = O + (size_t)(row0 + ai * HALF + m * 16) * ldc + col0;
#pragma unroll
                for (int bj = 0; bj < 2; ++bj) { const f32x4 v0 = acc[ai][bj][m][0], v1 = acc[ai][bj][m][1];
                    u32x4 w; w.x = cvt_pk_bf16(v0[0], v0[1]); w.y = cvt_pk_bf16(v0[2], v0[3]); w.z = cvt_pk_bf16(v1[0], v1[1]); w.w = cvt_pk_bf16(v1[2], v1[3]);
                    *(u32x4*)(rowp + bj * HALF) = w; } }
    }
};

struct EpiProj {
    static constexpr bool PERM = true, AFTER_DRAIN = false;
    bf16_t* Qb; bf16_t* LFb; bf16_t* Vb; bf16_t* Gb; bf16_t* Ub; const float* lb; int M;
    __device__ __forceinline__ void operator()(const f32x4 (&acc)[2][2][4][2], const Unit& u, int wr, int wc, int fr, int fq) const {
        const int row0 = u.pm * BM + wr * 64 + fr; const int colt = u.pn * BM; const int t = colt >> 9;
        const int cb = (colt & 511) + wc * 32 + 8 * fq;
        float lbv[2][8];
        if (t == 1) {
#pragma unroll
            for (int bj = 0; bj < 2; ++bj) { const f32x4 a = *(const f32x4*)(lb + cb + bj * HALF), b = *(const f32x4*)(lb + cb + bj * HALF + 4);
                lbv[bj][0] = a[0]; lbv[bj][1] = a[1]; lbv[bj][2] = a[2]; lbv[bj][3] = a[3]; lbv[bj][4] = b[0]; lbv[bj][5] = b[1]; lbv[bj][6] = b[2]; lbv[bj][7] = b[3]; }
        }
#pragma unroll
        for (int ai = 0; ai < 2; ++ai)
#pragma unroll
            for (int m = 0; m < 4; ++m) { const int row = row0 + ai * HALF + m * 16;
#pragma unroll
                for (int bj = 0; bj < 2; ++bj) { const f32x4 v0 = acc[ai][bj][m][0], v1 = acc[ai][bj][m][1]; const int c = cb + bj * HALF;
                    float f[8] = {v0[0], v0[1], v0[2], v0[3], v1[0], v1[1], v1[2], v1[3]};
                    if (t == 0) {
#pragma unroll
                        for (int j = 0; j < 8; ++j) f[j] *= 0.08838834764831845f;
                        *(u32x4*)(Qb + (size_t)row * 512 + c) = pack8(f);
                    } else if (t == 1) {
#pragma unroll
                        for (int j = 0; j < 8; ++j) { const float l = lbv[bj][j]; const float sg = 1.f / (1.f + __expf(-f[j])); f[j] = __logf(l + (1.f - l) * sg); }
                        *(u32x4*)(LFb + (size_t)row * 512 + c) = pack8(f);
                    } else if (t == 2) { *(u32x4*)(Vb + (size_t)row * 512 + c) = pack8(f);
                    } else if (t == 3) { *(u32x4*)(Gb + (size_t)row * 512 + c) = pack8(f);
                    } else { *(u32x4*)(Ub + ((size_t)(c >> 4) * M + row) * 16 + (c & 15)) = pack8(f); }
                } }
    }
};

struct EpiGlu {
    static constexpr bool PERM = true, AFTER_DRAIN = false;
    const bf16_t* Z; bf16_t* MIX; const float* bglu;
    __device__ __forceinline__ void operator()(const f32x4 (&acc)[2][2][4][2], const Unit& u, int wr, int wc, int fr, int fq) const {
        const int row0 = u.pm * BM + wr * 64 + fr, col0 = u.pn * BM + wc * 32 + 8 * fq;
#pragma unroll
        for (int bj = 0; bj < 2; ++bj) { const int c = col0 + bj * HALF;
            const f32x4 b0 = *(const f32x4*)(bglu + c), b1 = *(const f32x4*)(bglu + c + 4);
#pragma unroll
            for (int ai = 0; ai < 2; ++ai)
#pragma unroll
                for (int m = 0; m < 4; ++m) { const int row = row0 + ai * HALF + m * 16;
                    const f32x4 v0 = acc[ai][bj][m][0] + b0, v1 = acc[ai][bj][m][1] + b1;
                    float z[8]; unpack8(*(const u32x4*)(Z + (size_t)row * 512 + c), z);
                    float f[8] = {v0[0], v0[1], v0[2], v0[3], v1[0], v1[1], v1[2], v1[3]};
#pragma unroll
                    for (int j = 0; j < 8; ++j) f[j] = z[j] / (1.f + __expf(-f[j]));
                    *(u32x4*)(MIX + (size_t)row * 1024 + 512 + c) = pack8(f); } }
    }
};

struct EpiOut {
    static constexpr bool PERM = true, AFTER_DRAIN = false;
    bf16_t* H; float alpha;
    __device__ __forceinline__ void operator()(const f32x4 (&acc)[2][2][4][2], const Unit& u, int wr, int wc, int fr, int fq) const {
        const int row0 = u.pm * BM + wr * 64 + fr, col0 = u.pn * BM + wc * 32 + 8 * fq;
#pragma unroll
        for (int ai = 0; ai < 2; ++ai)
#pragma unroll
            for (int m = 0; m < 4; ++m) { bf16_t* rowp = H + (size_t)(row0 + ai * HALF + m * 16) * 1024 + col0;
#pragma unroll
                for (int bj = 0; bj < 2; ++bj) { const f32x4 v0 = acc[ai][bj][m][0], v1 = acc[ai][bj][m][1];
                    float h[8]; unpack8(*(const u32x4*)(rowp + bj * HALF), h);
                    float f[8] = {v0[0], v0[1], v0[2], v0[3], v1[0], v1[1], v1[2], v1[3]};
#pragma unroll
                    for (int j = 0; j < 8; ++j) f[j] = alpha * h[j] + f[j];
                    *(u32x4*)(rowp + bj * HALF) = pack8(f); } }
    }
};

template <class Epi, class Sched, bool ALIGN_EPI = false, bool SP2 = false>
__device__ __forceinline__ void gemm_phase(PG8_LAS unsigned char* lds, const Gemm g, const Sched& S, const Epi& E) {
    const int tid = threadIdx.x, wid = __builtin_amdgcn_readfirstlane(tid >> 6), lane = tid & 63, wr = wid >> 2, wc = wid & 3, fr = lane & 15, fq = lane >> 4;
    const int K = g.K, nt = K / BK;
    unsigned voffA[2], voffB[2];
#pragma unroll
    for (int i = 0; i < 2; ++i) { int R, C; stage_rc(tid * 16 + i * 8192, R, C); const int Rb = Epi::PERM ? ((R & ~31) + perm32(R & 31)) : R;
        voffA[i] = (unsigned)(R * K + C) * 2u; voffB[i] = (unsigned)(Rb * K + C) * 2u; }
    const size_t kstep = (size_t)(BK * 2);
    const size_t hstep = (size_t)HALF * K * 2;
    const size_t tstep = 2 * hstep;
    const unsigned ldsw = (unsigned)wid * 1024u;
    const int aoff = lds_byte(wr * 64 + fr, fq * 8), boff = lds_byte(wc * 32 + fr, fq * 8);
#define PG8_SA(b, h) (((b) * 2 + (h)) * HTB)
#define PG8_SB(b, h) ((4 + (b) * 2 + (h)) * HTB)
#define PG8_STAGE(bufoff, gbase, voff) do { _Pragma("unroll") for (int _i = 0; _i < 2; ++_i) \
        __builtin_amdgcn_global_load_lds((const unsigned*)((const char*)(gbase) + (voff)[_i]), (PG8_LAS unsigned*)(lds + (bufoff) + ldsw + _i * 8192), 16, 0, 0); } while (0)
#define PG8_LDA(dst, b, h) do { _Pragma("unroll") for (int m = 0; m < 4; ++m) _Pragma("unroll") for (int k = 0; k < 2; ++k) dst[m][k] = *(const PG8_LAS bf16x8*)(lds + PG8_SA(b, h) + aoff + m * 2048 + k * 1024); } while (0)
#define PG8_LDB(dst, b, h) do { _Pragma("unroll") for (int n = 0; n < 2; ++n) _Pragma("unroll") for (int k = 0; k < 2; ++k) dst[n][k] = *(const PG8_LAS bf16x8*)(lds + PG8_SB(b, h) + boff + n * 2048 + k * 1024); } while (0)
#define PG8_MMA(ai, bj, At, Bt) do { __builtin_amdgcn_s_setprio(1); _Pragma("unroll") for (int m = 0; m < 4; ++m) _Pragma("unroll") for (int n = 0; n < 2; ++n) _Pragma("unroll") for (int k = 0; k < 2; ++k) \
        acc[ai][bj][m][n] = __builtin_amdgcn_mfma_f32_16x16x32_bf16(Bt[n][k], At[m][k], acc[ai][bj][m][n], 0, 0, 0); __builtin_amdgcn_s_setprio(0); } while (0)
#define PG8_WAIT_V(n) asm volatile("s_waitcnt vmcnt(" #n ")" ::: "memory")
#define PG8_WAIT_L(n) asm volatile("s_waitcnt lgkmcnt(" #n ")" ::: "memory")
#define PG8_BAR __builtin_amdgcn_s_barrier()
#define PG8_SCHED __builtin_amdgcn_sched_barrier(0)
    Unit cur, nxt; int ui = 0;
    if (!S.next(0, cur)) return;
    f32x4 acc[2][2][4][2];
#pragma unroll
    for (int a = 0; a < 2; ++a)
#pragma unroll
        for (int b = 0; b < 2; ++b)
#pragma unroll
            for (int m = 0; m < 4; ++m)
#pragma unroll
                for (int n = 0; n < 2; ++n) acc[a][b][m][n] = (f32x4){0.f, 0.f, 0.f, 0.f};
    bf16x8 At[4][2], B0[2][2], B1[2][2];
    const char* cA = (const char*)g.A + (size_t)cur.pm * tstep; const char* cB = (const char*)g.Bt + (size_t)cur.pn * tstep;
    S.a_ready(cur);
    if constexpr (SP2) {
        PG8_STAGE(PG8_SB(0, 0), cB, voffB); PG8_STAGE(PG8_SB(0, 1), cB + hstep, voffB); PG8_STAGE(PG8_SA(0, 0), cA, voffA); PG8_STAGE(PG8_SA(0, 1), cA + hstep, voffA);
        if (wr == 1) PG8_BAR;
        PG8_WAIT_V(2); PG8_BAR;
        PG8_STAGE(PG8_SB(1, 0), cB + kstep, voffB); PG8_STAGE(PG8_SA(1, 0), cA + kstep, voffA); PG8_STAGE(PG8_SB(1, 1), cB + hstep + kstep, voffB);
        PG8_WAIT_V(6); PG8_BAR;
    } else {
        PG8_STAGE(PG8_SB(0, 0), cB, voffB); PG8_STAGE(PG8_SA(0, 0), cA, voffA); PG8_STAGE(PG8_SB(0, 1), cB + hstep, voffB); PG8_STAGE(PG8_SA(0, 1), cA + hstep, voffA);
        if (wr == 1) PG8_BAR;
        PG8_WAIT_V(4); PG8_BAR;
        PG8_STAGE(PG8_SB(1, 0), cB + kstep, voffB); PG8_STAGE(PG8_SA(1, 0), cA + kstep, voffA); PG8_STAGE(PG8_SB(1, 1), cB + hstep + kstep, voffB);
        PG8_WAIT_V(6); PG8_BAR;
    }
    for (;;) {
        const bool has_next = S.next(ui + 1, nxt);
        const char* nA = has_next ? (const char*)g.A + (size_t)nxt.pm * tstep : cA; const char* nB = has_next ? (const char*)g.Bt + (size_t)nxt.pn * tstep : cB;
        for (int t = 0; t < nt; t += 2) {
            const bool last = (t == nt - 2);
            const char* a1 = cA + (size_t)(t + 1) * kstep;
            const char* a2 = last ? nA : cA + (size_t)(t + 2) * kstep; const char* b2 = last ? nB : cB + (size_t)(t + 2) * kstep;
            const char* a3 = a2 + kstep; const char* b3 = b2 + kstep;
            if (last && has_next) S.a_ready(nxt);
            if constexpr (SP2) {
            PG8_LDB(B0, 0, 0); PG8_LDB(B1, 0, 1); PG8_SCHED; PG8_LDA(At, 0, 0); PG8_STAGE(PG8_SA(1, 1), a1 + hstep, voffA);
            PG8_WAIT_V(8); PG8_WAIT_L(0); PG8_BAR; PG8_MMA(0, 0, At, B0); PG8_MMA(0, 1, At, B1); PG8_BAR; PG8_SCHED;
            PG8_LDA(At, 0, 1); PG8_STAGE(PG8_SB(0, 0), b2, voffB); PG8_STAGE(PG8_SB(0, 1), b2 + hstep, voffB); PG8_STAGE(PG8_SA(0, 0), a2, voffA);
            PG8_WAIT_V(8); PG8_WAIT_L(0); PG8_BAR; PG8_MMA(1, 0, At, B0); PG8_MMA(1, 1, At, B1); PG8_BAR; PG8_SCHED;
            PG8_LDB(B0, 1, 0); PG8_LDB(B1, 1, 1); PG8_SCHED; PG8_LDA(At, 1, 0); PG8_STAGE(PG8_SA(0, 1), a2 + hstep, voffA);
            PG8_WAIT_V(8); PG8_WAIT_L(0); PG8_BAR; PG8_MMA(0, 0, At, B0); PG8_MMA(0, 1, At, B1); PG8_BAR; PG8_SCHED;
            PG8_LDA(At, 1, 1); PG8_STAGE(PG8_SB(1, 0), b3, voffB); PG8_STAGE(PG8_SB(1, 1), b3 + hstep, voffB); PG8_STAGE(PG8_SA(1, 0), a3, voffA);
            PG8_WAIT_V(8); PG8_WAIT_L(0); PG8_BAR; PG8_MMA(1, 0, At, B0); PG8_MMA(1, 1, At, B1); PG8_BAR; PG8_SCHED;
            } else {
            PG8_LDB(B0, 0, 0); PG8_SCHED; PG8_LDA(At, 0, 0); PG8_STAGE(PG8_SA(1, 1), a1 + hstep, voffA);
            PG8_WAIT_L(8); PG8_BAR; PG8_WAIT_L(0); PG8_MMA(0, 0, At, B0); PG8_BAR; PG8_SCHED;
            PG8_LDB(B1, 0, 1); PG8_STAGE(PG8_SB(0, 0), b2, voffB);
            PG8_BAR; PG8_WAIT_L(0); PG8_MMA(0, 1, At, B1); PG8_BAR;
            PG8_LDA(At, 0, 1); PG8_STAGE(PG8_SA(0, 0), a2, voffA);
            PG8_BAR; PG8_WAIT_L(0); PG8_MMA(1, 0, At, B0); PG8_BAR; PG8_SCHED;
            PG8_STAGE(PG8_SB(0, 1), b2 + hstep, voffB);
            PG8_WAIT_V(6); PG8_BAR; PG8_MMA(1, 1, At, B1); PG8_BAR;
            PG8_LDB(B0, 1, 0); PG8_SCHED; PG8_LDA(At, 1, 0); PG8_STAGE(PG8_SA(0, 1), a2 + hstep, voffA);
            PG8_WAIT_L(8); PG8_BAR; PG8_WAIT_L(0); PG8_MMA(0, 0, At, B0); PG8_BAR; PG8_SCHED;
            PG8_LDB(B1, 1, 1); PG8_STAGE(PG8_SB(1, 0), b3, voffB);
            PG8_BAR; PG8_WAIT_L(0); PG8_MMA(0, 1, At, B1); PG8_BAR;
            PG8_LDA(At, 1, 1); PG8_STAGE(PG8_SA(1, 0), a3, voffA);
            PG8_BAR; PG8_WAIT_L(0); PG8_MMA(1, 0, At, B0); PG8_BAR; PG8_SCHED;
            PG8_STAGE(PG8_SB(1, 1), b3 + hstep, voffB);
            PG8_WAIT_V(6); PG8_BAR; PG8_MMA(1, 1, At, B1); PG8_BAR;
            }
        }
        if constexpr (ALIGN_EPI) { if (wr == 0) PG8_BAR; }
        if constexpr (!Epi::AFTER_DRAIN) { E(acc, cur, wr, wc, fr, fq); S.done(cur); }
        if (!has_next) break;
#pragma unroll
        for (int a = 0; a < 2; ++a)
#pragma unroll
            for (int b = 0; b < 2; ++b)
#pragma unroll
                for (int m = 0; m < 4; ++m)
#pragma unroll
                    for (int n = 0; n < 2; ++n) acc[a][b][m][n] = (f32x4){0.f, 0.f, 0.f, 0.f};
        cur = nxt; cA = nA; cB = nB; ++ui;
        if constexpr (ALIGN_EPI) { if (wr == 1) PG8_BAR; }
    }
    PG8_WAIT_V(0);
    if constexpr (!ALIGN_EPI) { if (wr == 0) PG8_BAR; }
    PG8_BAR;
    if constexpr (Epi::AFTER_DRAIN) { E.fused(acc, cur, wr, wc, fr, fq, lds, wid, lane); S.done(cur); }
#undef PG8_SA
#undef PG8_SB
#undef PG8_STAGE
#undef PG8_LDA
#undef PG8_LDB
#undef PG8_MMA
#undef PG8_WAIT_V
#undef PG8_WAIT_L
#undef PG8_BAR
#undef PG8_SCHED
}
}

constexpr int NWAVES = 8;
#ifndef MK_N_LAUNCHES
#define MK_N_LAUNCHES 1
#endif
constexpr int N_LAUNCHES = MK_N_LAUNCHES;
constexpr int NPH = 9;
#ifndef PROBE_REP
#define PROBE_REP -1
#endif

constexpr int BATCH = 8, SEQ = 4096, D = 1024, M = BATCH * SEQ;
constexpr int HGW = 512, HGH = 4, HGK = 128;
constexpr int S5W = 512, S5G = 32, S5P = 16, S5N = 64;
constexpr int NPROJ = 2560;
constexpr int PK = 128, PH = 8, PTOPK = 16, PQ = 256, PHALF = 128, PE = PK * PK, NQ2 = PH * PQ;
constexpr float LN_EPS = 1e-5f, RMS_EPS = 1e-6f;
constexpr float DN_ALPHA = 1.189207115002721f;

constexpr size_t MiB = 1u << 20;
constexpr size_t WS_CTL = 0, CTL_ZERO_BYTES = 1 * MiB;
constexpr size_t WS_WIN = 1 * MiB;
constexpr size_t WS_WGLU = 6 * MiB;
constexpr size_t WS_KEYS = 6 * MiB + 512 * 1024;
constexpr size_t WS_LB = 6 * MiB + 640 * 1024;
constexpr size_t WS_S5T = 6 * MiB + 704 * 1024;
constexpr size_t WS_WOUT = 7 * MiB + 512 * 1024;
constexpr size_t WS_WQ = 10 * MiB;
constexpr size_t WS_PD = 14 * MiB;
constexpr size_t WS_PU = 46 * MiB;
constexpr size_t WS_H = 78 * MiB;
constexpr size_t WS_PROJ = 142 * MiB;
constexpr size_t WS_Q2 = WS_PROJ;
constexpr size_t WS_MIX = 302 * MiB;
constexpr size_t WS_Z = 366 * MiB;
constexpr size_t WS_EIDX = 398 * MiB;
constexpr size_t WS_EGATE = 414 * MiB;
constexpr size_t WS_END = 430 * MiB;
constexpr int CW_TMO = 0, CW_CODE = 1;
constexpr int CW_BAR = 4096;

constexpr int RING_OFF = 0, RING_BYTES = 131072;
constexpr int LDSCTL_OFF = RING_BYTES, MISC_OFF = LDSCTL_OFF + 320;
constexpr int LDS_BYTES = 147456;
static_assert(MISC_OFF + 128 <= LDS_BYTES, "LDS map");

#define GAS __attribute__((address_space(1)))
#define LAS __attribute__((address_space(3)))
typedef unsigned short bf16;
typedef unsigned v4u __attribute__((ext_vector_type(4)));
typedef float f32x4 __attribute__((ext_vector_type(4)));
typedef short bf16x8 __attribute__((ext_vector_type(8)));
typedef GAS unsigned gu32;
typedef GAS unsigned long long gu64;
#define RLX_AGENT __ATOMIC_RELAXED, __HIP_MEMORY_SCOPE_AGENT
#define LDS_WAIT() asm volatile("s_waitcnt lgkmcnt(0)" ::: "memory")
#define VM_WAIT() asm volatile("s_waitcnt vmcnt(0)" ::: "memory")
__device__ __forceinline__ unsigned long long rt() { return __builtin_amdgcn_s_memrealtime(); }
__device__ __forceinline__ unsigned f2bf(float f) { unsigned u = __builtin_bit_cast(unsigned, f); return (u + 0x7fffu + ((u >> 16) & 1u)) >> 16; }
__device__ __forceinline__ unsigned pk2(float lo, float hi) { return f2bf(lo) | (f2bf(hi) << 16); }

#define XB_TMO      128
#define XB_XCNT(j)  (256  + 64 * (j))
#define XB_XSUB(j)  (1280 + 64 * (j))
#define XB_XGEN(j)  (2304 + 64 * (j))
#define XB_TOP      3328
#define XB_TOPGEN   3392
#define XCD_BAR_WORDS 3456
#define XB_SPIN_CAP (1u << 18)

__device__ __forceinline__ unsigned xb_ld(unsigned* p)              { return __hip_atomic_load(p, __ATOMIC_RELAXED, __HIP_MEMORY_SCOPE_AGENT); }
__device__ __forceinline__ unsigned xb_add(unsigned* p, unsigned v) { return __hip_atomic_fetch_add(p, v, __ATOMIC_RELAXED, __HIP_MEMORY_SCOPE_AGENT); }
__device__ __forceinline__ unsigned xb_xcc_id() { return (unsigned)__builtin_amdgcn_s_getreg((3 << 11) | 20) & 0xFu; }
#define XB_SPIN(cond, bar) do { unsigned _sp = 0; while (cond) { __builtin_amdgcn_s_sleep(1); \
    if ((++_sp & 255u) == 0u) { if (xb_ld(&(bar)[XB_TMO])) break; if (_sp > XB_SPIN_CAP) { atomicAdd(&(bar)[XB_TMO], 1u); break; } } } } while (0)

struct XcdBarrier {
    unsigned* bar; unsigned x;
    volatile LAS unsigned* st;
};

__device__ __forceinline__ XcdBarrier xcd_barrier_post(unsigned* bar, volatile LAS unsigned* st) {
    XcdBarrier b; b.bar = bar; b.x = xb_xcc_id(); b.st = st;
    if (threadIdx.x == 0) (void)xb_add(&bar[XB_XCNT(b.x)], 1u);
    return b;
}
__device__ __forceinline__ void xcd_barrier_complete(unsigned* bar, unsigned x, unsigned& nloc, unsigned& nx) {
    const unsigned G = gridDim.x * gridDim.y * gridDim.z;
    unsigned sum, cnt, mine, sp = 0u;
    for (;;) {
        sum = 0u; cnt = 0u; mine = 0u;
#pragma unroll
        for (unsigned j = 0; j < 16; ++j) { const unsigned c = xb_ld(&bar[XB_XCNT(j)]); sum += c; cnt += (c > 0u) ? 1u : 0u; mine = (j == x) ? c : mine; }
        if (sum == G) break;
        __builtin_amdgcn_s_sleep(1);
        if ((++sp & 255u) == 0u) { if (xb_ld(&bar[XB_TMO])) break; if (sp > XB_SPIN_CAP) { atomicAdd(&bar[XB_TMO], 1u); break; } }
    }
    nloc = mine > 0u ? mine : 1u; nx = cnt > 0u ? cnt : 1u;
}

__device__ __forceinline__ void xcd_barrier(const XcdBarrier& b) {
    asm volatile("s_waitcnt vmcnt(0)" ::: "memory");
    __syncthreads();
    if (threadIdx.x == 0) {
        unsigned* bar = b.bar;
        __builtin_amdgcn_s_waitcnt(0);
        unsigned nloc = b.st[0], nx = b.st[1];
        if (nloc == 0u) { xcd_barrier_complete(bar, b.x, nloc, nx); b.st[0] = nloc; b.st[1] = nx; }
        const unsigned old = xb_add(&bar[XB_XSUB(b.x)], 1u);
        const unsigned gen = old / nloc;
        if (old + 1u == (gen + 1u) * nloc) {
            __builtin_amdgcn_fence(__ATOMIC_RELEASE, "agent");
            asm volatile("s_waitcnt vmcnt(0)" ::: "memory");
            const unsigned og = xb_add(&bar[XB_TOP], 1u);
            const unsigned tg = og / nx;
            if (og + 1u == (tg + 1u) * nx) xb_add(&bar[XB_TOPGEN], 1u);
            else XB_SPIN(xb_ld(&bar[XB_TOPGEN]) == tg, bar);
            __builtin_amdgcn_fence(__ATOMIC_ACQUIRE, "agent");
            xb_add(&bar[XB_XGEN(b.x)], 1u);
            asm volatile("s_waitcnt vmcnt(0)" ::: "memory");
        } else {
            XB_SPIN(xb_ld(&bar[XB_XGEN(b.x)]) == gen, bar);
            __builtin_amdgcn_fence(__ATOMIC_ACQUIRE, "agent");
            asm volatile("s_waitcnt vmcnt(0)" ::: "memory");
        }
    }
    __syncthreads();
}

struct Frame {
    LAS unsigned char* lds;
    volatile LAS unsigned* MISC;
    gu32* ctl;
    int tid, lane, wave;
    int vcu, G;
    const float* in[26]; float* out; unsigned char* ws;
};
enum { I_X = 0, I_LN0G, I_LN0B, I_WIN, I_LBL, I_HGNG, I_ARE, I_AIM, I_LSTEP, I_BRE, I_BIM, I_CRE, I_CIM, I_DSK, I_WGLU, I_BGLU, I_WOUT, I_LN1G, I_LN1B, I_WQ, I_K1, I_K2, I_PD, I_PU, I_LN2G, I_LN2B };

__device__ __forceinline__ float bf2f(bf16 v) { return __builtin_bit_cast(float, (unsigned)v << 16); }
__device__ __forceinline__ float wave_sum(float v) {
#pragma unroll
    for (int o = 1; o < 64; o <<= 1) v += __shfl_xor(v, o);
    return v;
}
__device__ __forceinline__ float wave_max(float v) {
#pragma unroll
    for (int o = 1; o < 64; o <<= 1) v = fmaxf(v, __shfl_xor(v, o));
    return v;
}
__device__ __forceinline__ float gelu_tanh(float x) { const float y = 0.7978845608028654f * (x + 0.044715f * x * x * x); return x / (1.f + __expf(-2.f * y)); }
__device__ __forceinline__ float silu_f(float x) { return x / (1.f + __expf(-x)); }
__device__ __forceinline__ void unpack8(const v4u w, float (&f)[8]) {
    f[0] = __builtin_bit_cast(float, w.x << 16); f[1] = __builtin_bit_cast(float, w.x & 0xffff0000u);
    f[2] = __builtin_bit_cast(float, w.y << 16); f[3] = __builtin_bit_cast(float, w.y & 0xffff0000u);
    f[4] = __builtin_bit_cast(float, w.z << 16); f[5] = __builtin_bit_cast(float, w.z & 0xffff0000u);
    f[6] = __builtin_bit_cast(float, w.w << 16); f[7] = __builtin_bit_cast(float, w.w & 0xffff0000u);
}
__device__ __forceinline__ v4u pack8(const float (&f)[8]) { v4u w; w.x = pk2(f[0], f[1]); w.y = pk2(f[2], f[3]); w.z = pk2(f[4], f[5]); w.w = pk2(f[6], f[7]); return w; }

__device__ __forceinline__ void p0_transpose_item(const float* W, int K, int N, bf16* WT, int row_off, LAS float* scr, int item, int lane) {
    const int nblk = N / 32, kb = item / nblk, nb = item % nblk, k0 = 64 * kb, n0 = 32 * nb;
#pragma unroll 8
    for (int i = 0; i < 32; ++i) { const int kk = 2 * i + (lane >> 5); scr[kk * 33 + (lane & 31)] = W[(size_t)(k0 + kk) * N + n0 + (lane & 31)]; }
    LDS_WAIT(); asm volatile("" ::: "memory");
    const int c = lane & 7;
#pragma unroll
    for (int j = 0; j < 4; ++j) { const int n = (lane >> 3) + 8 * j; const LAS float* s = scr + (8 * c) * 33 + n;
        v4u o; o.x = pk2(s[0 * 33], s[1 * 33]); o.y = pk2(s[2 * 33], s[3 * 33]); o.z = pk2(s[4 * 33], s[5 * 33]); o.w = pk2(s[6 * 33], s[7 * 33]);
        *(GAS v4u*)(WT + (size_t)(row_off + n0 + n) * K + k0 + 8 * c) = o; }
    LDS_WAIT(); asm volatile("" ::: "memory");
}
__device__ __forceinline__ void ln0_row(const float* xrow, const float* g, const float* b, bf16* orow, int lane) {
    const GAS f32x4* xr = (const GAS f32x4*)xrow + lane;
    f32x4 v[4]; float s = 0.f;
#pragma unroll
    for (int j = 0; j < 4; ++j) { v[j] = xr[64 * j]; s += (v[j].x + v[j].y) + (v[j].z + v[j].w); }
    const float mean = wave_sum(s) * (1.f / D); float s2 = 0.f;
#pragma unroll
    for (int j = 0; j < 4; ++j) { v[j] = v[j] - mean; s2 += (v[j].x * v[j].x + v[j].y * v[j].y) + (v[j].z * v[j].z + v[j].w * v[j].w); }
    const float rstd = 1.f / sqrtf(wave_sum(s2) * (1.f / D) + LN_EPS);
    GAS unsigned long long* o8 = (GAS unsigned long long*)orow + lane;
#pragma unroll
    for (int j = 0; j < 4; ++j) { const f32x4 gg = ((const GAS f32x4*)g)[lane + 64 * j], bb = ((const GAS f32x4*)b)[lane + 64 * j];
        const f32x4 o = v[j] * rstd * gg + bb;
        o8[64 * j] = (unsigned long long)pk2(o.x, o.y) | ((unsigned long long)pk2(o.z, o.w) << 32); }
}
__device__ __forceinline__ void p0_prologue(Frame& F) {
    LAS float* scr = (LAS float*)(F.lds + RING_OFF + F.wave * 16384);
    const int gw = F.vcu * NWAVES + F.wave, NGW = F.G * NWAVES;
    unsigned char* ws = F.ws;
    constexpr int I_IN = (D / 64) * (NPROJ / 32), I_GLU = (512 / 64) * (512 / 32), I_OUT = (1024 / 64) * (1024 / 32), I_Q = (1024 / 64) * (2048 / 32);
    constexpr int NITEMS = I_IN + I_GLU + I_OUT + I_Q;
    for (int it = gw; it < NITEMS; it += NGW) {
        int r = it;
        if (r < I_IN) { p0_transpose_item(F.in[I_WIN], D, NPROJ, (bf16*)(ws + WS_WIN), 0, scr, r, F.lane); continue; } r -= I_IN;
        if (r < I_GLU) { p0_transpose_item(F.in[I_WGLU], 512, 512, (bf16*)(ws + WS_WGLU), 0, scr, r, F.lane); continue; } r -= I_GLU;
        if (r < I_OUT) { p0_transpose_item(F.in[I_WOUT], 1024, 1024, (bf16*)(ws + WS_WOUT), 0, scr, r, F.lane); continue; } r -= I_OUT;
        p0_transpose_item(F.in[I_WQ], 1024, 2048, (bf16*)(ws + WS_WQ), 0, scr, r, F.lane);
    }
    const int gt = gw * 64 + F.lane, NGT = NGW * 64;
    for (int i = gt; i < 2 * PK * PHALF; i += NGT) { const float v = (i < PK * PHALF) ? F.in[I_K1][i] : F.in[I_K2][i - PK * PHALF]; ((bf16*)(ws + WS_KEYS))[i] = (bf16)f2bf(v); }
    constexpr int NTAB8 = PE * D / 8;
    for (int i = gt; i < 2 * NTAB8; i += NGT) { const bool up = i >= NTAB8; const int j = up ? i - NTAB8 : i; const float* src = (up ? F.in[I_PU] : F.in[I_PD]) + (size_t)j * 8;
        const f32x4 a = *(const GAS f32x4*)src, b = *(const GAS f32x4*)(src + 4);
        v4u o; o.x = pk2(a.x, a.y); o.y = pk2(a.z, a.w); o.z = pk2(b.x, b.y); o.w = pk2(b.z, b.w);
        *(GAS v4u*)((bf16*)(ws + (up ? WS_PU : WS_PD)) + (size_t)j * 8) = o; }
    for (int i = gt; i < HGW; i += NGT) { const float l0 = F.in[I_LBL][i], l1 = F.in[I_LBL][HGW + i]; ((float*)(ws + WS_LB))[i] = 1.f / (1.f + expf(l1 - l0)); }
    for (int i = gt; i < S5G * S5N; i += NGT) { const int g = i / S5N;
        const float are = F.in[I_ARE][i], aim = F.in[I_AIM][i], step = expf(F.in[I_LSTEP][g]);
        const float zr = step * are, zi = step * aim, mag = expf(zr), cz = cosf(zi), sz = sinf(zi), sh = sinf(0.5f * zi);
        const float abr = mag * cz, abi = mag * sz;
        const float nre = expm1f(zr) * cz - 2.f * sh * sh, nim = abi;
        const float den = are * are + aim * aim;
        const float cre = (nre * are + nim * aim) / den, cim = (nim * are - nre * aim) / den;
        float* t = (float*)(ws + WS_S5T) + (size_t)i * 40; t[0] = abr; t[1] = abi;
        for (int p = 0; p < S5P; ++p) { const float br = F.in[I_BRE][(size_t)i * S5P + p], bi = F.in[I_BIM][(size_t)i * S5P + p];
            t[2 + p] = cre * br - cim * bi; t[18 + p] = cre * bi + cim * br; } }
    for (int m = gw; m < M; m += NGW) ln0_row(F.in[I_X] + (size_t)m * D, F.in[I_LN0G], F.in[I_LN0B], (bf16*)(ws + WS_H) + (size_t)m * D, F.lane);
}

__device__ __forceinline__ void hgrn2_seq(Frame& F, int bh) {
    const int b = bh >> 2, h = bh & 3, tid = F.tid, kq = tid >> 7, j = tid & 127;
    LAS float* sF = (LAS float*)(F.lds + RING_OFF);
    LAS float* sK = sF + 8 * 128; LAS float* sQ = sK + 8 * 128;
    LAS float* sO = sQ + 8 * 128;
    const bf16* Qb = (const bf16*)(F.ws + WS_PROJ); const bf16* LFb = Qb + (size_t)M * 512; const bf16* Vb = LFb + (size_t)M * 512; const bf16* Gb = Vb + (size_t)M * 512;
    bf16* MIX = (bf16*)(F.ws + WS_MIX);
    const float ng0 = F.in[I_HGNG][F.lane], ng1 = F.in[I_HGNG][F.lane + 64];
    float S[32];
#pragma unroll
    for (int k = 0; k < 32; ++k) S[k] = 0.f;
    for (int t0 = 0; t0 < SEQ; t0 += 8) {
        const size_t tok0 = (size_t)b * SEQ + t0;
#pragma unroll
        for (int r = 0; r < 2; ++r) { const int item = tid + 512 * r, tt = item >> 7, kk = item & 127; const size_t off = (tok0 + tt) * 512 + h * 128 + kk;
            const float lf = bf2f(LFb[off]); sF[tt * 128 + kk] = __expf(lf); sK[tt * 128 + kk] = -expm1f(lf); sQ[tt * 128 + kk] = bf2f(Qb[off]); }
        __syncthreads();
#pragma unroll 1
        for (int tt = 0; tt < 8; ++tt) { const float v = bf2f(Vb[(tok0 + tt) * 512 + h * 128 + j]); float o = 0.f;
            const LAS float* f = sF + tt * 128 + kq * 32; const LAS float* kx = sK + tt * 128 + kq * 32; const LAS float* q = sQ + tt * 128 + kq * 32;
#pragma unroll
            for (int k = 0; k < 32; ++k) { S[k] = f[k] * S[k] + kx[k] * v; o += q[k] * S[k]; }
            sO[(tt * 4 + kq) * 128 + j] = o; }
        __syncthreads();
        { const int tt = F.wave; const size_t tok = tok0 + tt;
            const float o0 = (sO[(tt * 4 + 0) * 128 + F.lane] + sO[(tt * 4 + 1) * 128 + F.lane]) + (sO[(tt * 4 + 2) * 128 + F.lane] + sO[(tt * 4 + 3) * 128 + F.lane]);
            const float o1 = (sO[(tt * 4 + 0) * 128 + 64 + F.lane] + sO[(tt * 4 + 1) * 128 + 64 + F.lane]) + (sO[(tt * 4 + 2) * 128 + 64 + F.lane] + sO[(tt * 4 + 3) * 128 + 64 + F.lane]);
            const float ss = wave_sum(o0 * o0 + o1 * o1), r = 1.f / sqrtf(ss * (1.f / 128.f) + RMS_EPS);
            const float g0 = bf2f(Gb[tok * 512 + h * 128 + F.lane]), g1 = bf2f(Gb[tok * 512 + h * 128 + 64 + F.lane]);
            MIX[tok * 1024 + h * 128 + F.lane] = (bf16)f2bf(o0 * r * ng0 * silu_f(g0));
            MIX[tok * 1024 + h * 128 + 64 + F.lane] = (bf16)f2bf(o1 * r * ng1 * silu_f(g1)); }
    }
    __syncthreads();
}
__device__ __forceinline__ void s5_seq(Frame& F, int pair) {
    const int b = pair >> 5, g = pair & 31, lane = F.lane;
    const float* tb = (const float*)(F.ws + WS_S5T) + (size_t)(g * S5N + lane) * 40;
    const float abr = tb[0], abi = tb[1];
    float bbr[16], bbi[16], cr[16], ci[16], dsk[16];
#pragma unroll
    for (int p = 0; p < 16; ++p) { bbr[p] = tb[2 + p]; bbi[p] = tb[18 + p]; cr[p] = F.in[I_CRE][(size_t)(g * 16 + p) * S5N + lane]; ci[p] = F.in[I_CIM][(size_t)(g * 16 + p) * S5N + lane];
        dsk[p] = (lane == 0) ? F.in[I_DSK][g * 16 + p] : 0.f; }
    const bf16* Ub = (const bf16*)(F.ws + WS_PROJ) + (size_t)4 * M * 512 + ((size_t)g * M + (size_t)b * SEQ) * 16;
    bf16* Zb = (bf16*)(F.ws + WS_Z) + (size_t)b * SEQ * 512 + g * 16;
    const int pme = ((lane >> 5) & 1) * 8 + ((lane >> 4) & 1) * 4 + ((lane >> 3) & 1) * 2 + ((lane >> 2) & 1);
    float xr = 0.f, xi = 0.f;
    v4u nu0 = *(const GAS v4u*)(Ub + (size_t)lane * 16), nu1 = *(const GAS v4u*)(Ub + (size_t)lane * 16 + 8);
    for (int t0 = 0; t0 < SEQ; t0 += 64) {
        const v4u u0 = nu0, u1 = nu1;
        if (t0 + 64 < SEQ) { nu0 = *(const GAS v4u*)(Ub + (size_t)(t0 + 64 + lane) * 16); nu1 = *(const GAS v4u*)(Ub + (size_t)(t0 + 64 + lane) * 16 + 8); }
#pragma unroll 1
        for (int tt = 0; tt < 64; ++tt) {
            v4u a, c;
            a.x = __builtin_amdgcn_readlane(u0.x, tt); a.y = __builtin_amdgcn_readlane(u0.y, tt); a.z = __builtin_amdgcn_readlane(u0.z, tt); a.w = __builtin_amdgcn_readlane(u0.w, tt);
            c.x = __builtin_amdgcn_readlane(u1.x, tt); c.y = __builtin_amdgcn_readlane(u1.y, tt); c.z = __builtin_amdgcn_readlane(u1.z, tt); c.w = __builtin_amdgcn_readlane(u1.w, tt);
            float u[16]; { float f0[8], f1[8]; unpack8(a, f0); unpack8(c, f1);
#pragma unroll
                for (int p = 0; p < 8; ++p) { u[p] = f0[p]; u[8 + p] = f1[p]; } }
            float bur = 0.f, bui = 0.f;
#pragma unroll
            for (int p = 0; p < 16; ++p) { bur += bbr[p] * u[p]; bui += bbi[p] * u[p]; }
            const float nxr = abr * xr - abi * xi + bur, nxi = abr * xi + abi * xr + bui; xr = nxr; xi = nxi;
            float r[16];
#pragma unroll
            for (int p = 0; p < 16; ++p) r[p] = cr[p] * xr - ci[p] * xi + dsk[p] * u[p];
#pragma unroll
            for (int i = 0; i < 8; ++i) { const float keep = (lane & 32) ? r[i + 8] : r[i], send = (lane & 32) ? r[i] : r[i + 8]; r[i] = keep + __shfl_xor(send, 32); }
#pragma unroll
            for (int i = 0; i < 4; ++i) { const float keep = (lane & 16) ? r[i + 4] : r[i], send = (lane & 16) ? r[i] : r[i + 4]; r[i] = keep + __shfl_xor(send, 16); }
#pragma unroll
            for (int i = 0; i < 2; ++i) { const float keep = (lane & 8) ? r[i + 2] : r[i], send = (lane & 8) ? r[i] : r[i + 2]; r[i] = keep + __shfl_xor(send, 8); }
            { const float keep = (lane & 4) ? r[1] : r[0], send = (lane & 4) ? r[0] : r[1]; r[0] = keep + __shfl_xor(send, 4); }
            r[0] += __shfl_xor(r[0], 2); r[0] += __shfl_xor(r[0], 1);
            if ((lane & 3) == 0) Zb[(size_t)(t0 + tt) * 512 + pme] = (bf16)f2bf(gelu_tanh(r[0]));
        }
    }
}

__device__ __forceinline__ void ln1_row(bf16* row, const float* g, const float* b, int lane) {
    const v4u w0 = *(const GAS v4u*)(row + lane * 8), w1 = *(const GAS v4u*)(row + 512 + lane * 8);
    float a[8], c[8]; unpack8(w0, a); unpack8(w1, c);
    float s = 0.f;
#pragma unroll
    for (int j = 0; j < 8; ++j) s += a[j] + c[j];
    const float mean = wave_sum(s) * (1.f / D); float s2 = 0.f;
#pragma unroll
    for (int j = 0; j < 8; ++j) { a[j] -= mean; c[j] -= mean; s2 += a[j] * a[j] + c[j] * c[j]; }
    const float rstd = 1.f / sqrtf(wave_sum(s2) * (1.f / D) + LN_EPS);
    const f32x4 g0 = *(const GAS f32x4*)(g + lane * 8), g1 = *(const GAS f32x4*)(g + lane * 8 + 4), g2 = *(const GAS f32x4*)(g + 512 + lane * 8), g3 = *(const GAS f32x4*)(g + 512 + lane * 8 + 4);
    const f32x4 b0 = *(const GAS f32x4*)(b + lane * 8), b1 = *(const GAS f32x4*)(b + lane * 8 + 4), b2 = *(const GAS f32x4*)(b + 512 + lane * 8), b3 = *(const GAS f32x4*)(b + 512 + lane * 8 + 4);
    const float gg0[8] = {g0.x, g0.y, g0.z, g0.w, g1.x, g1.y, g1.z, g1.w}, gg1[8] = {g2.x, g2.y, g2.z, g2.w, g3.x, g3.y, g3.z, g3.w};
    const float bb0[8] = {b0.x, b0.y, b0.z, b0.w, b1.x, b1.y, b1.z, b1.w}, bb1[8] = {b2.x, b2.y, b2.z, b2.w, b3.x, b3.y, b3.z, b3.w};
#pragma unroll
    for (int j = 0; j < 8; ++j) { a[j] = a[j] * rstd * gg0[j] + bb0[j]; c[j] = c[j] * rstd * gg1[j] + bb1[j]; }
    *(GAS v4u*)(row + lane * 8) = pack8(a); *(GAS v4u*)(row + 512 + lane * 8) = pack8(c);
}

typedef float f32x16 __attribute__((ext_vector_type(16)));
__device__ __forceinline__ int f2ord(float f) { const int x = __builtin_bit_cast(int, f); return x ^ ((x >> 31) & 0x7fffffff); }
__device__ __forceinline__ float ord2f(int x) { return __builtin_bit_cast(float, x ^ ((x >> 31) & 0x7fffffff)); }
#define CE_DESC(a, b) do { const int _h = max((a), (b)), _l = min((a), (b)); (a) = _h; (b) = _l; } while (0)
__device__ __forceinline__ void sort16_desc(int (&v)[16]) {
#pragma unroll
    for (int k = 2; k <= 16; k <<= 1)
#pragma unroll
        for (int j = k >> 1; j > 0; j >>= 1)
#pragma unroll
            for (int i = 0; i < 16; ++i) { const int l = i ^ j; if (l > i) { if ((i & k) == 0) CE_DESC(v[i], v[l]); else CE_DESC(v[l], v[i]); } }
}
__device__ __forceinline__ void merge16_desc(int (&a)[16], const int (&b)[16]) {
#pragma unroll
    for (int i = 0; i < 16; ++i) a[i] = max(a[i], b[15 - i]);
#pragma unroll
    for (int j = 8; j > 0; j >>= 1)
#pragma unroll
        for (int i = 0; i < 16; ++i) { const int l = i ^ j; if (l > i) CE_DESC(a[i], a[l]); }
}
__device__ __forceinline__ void peer_topk_side(const f32x16 (&acc)[4], int hi, int (&top)[16]) {
    int t[4][16];
#pragma unroll
    for (int kt = 0; kt < 4; ++kt)
#pragma unroll
        for (int j = 0; j < 16; ++j) { const unsigned key = (unsigned)(kt * 32 + (j & 3) + 8 * (j >> 2)) | (unsigned)(4 * hi);
            const float av = acc[kt][j];
            t[kt][j] = f2ord(__builtin_bit_cast(float, (__builtin_bit_cast(unsigned, av) & 0xFFFFFF80u) | key)); }
    sort16_desc(t[0]); sort16_desc(t[1]); sort16_desc(t[2]); sort16_desc(t[3]);
    merge16_desc(t[0], t[1]); merge16_desc(t[2], t[3]); merge16_desc(t[0], t[2]);
    int p[16];
#pragma unroll
    for (int i = 0; i < 16; ++i) p[i] = __shfl_xor(t[0][i], 32);
    merge16_desc(t[0], p);
#pragma unroll
    for (int i = 0; i < 16; ++i) top[i] = t[0][i];
}
__device__ __forceinline__ void peer_score_phase(Frame& F) {
    LAS unsigned char* kl = F.lds + RING_OFF;
    LAS unsigned* look = (LAS unsigned*)(F.lds + RING_OFF + 65536 + F.wave * 8192);
    const bf16* keys = (const bf16*)(F.ws + WS_KEYS);
    for (int i = F.tid; i < 2 * 128 * 16; i += NWAVES * 64) { const int sn = i >> 4, c = i & 15, n = sn & 127;
        *(LAS v4u*)(kl + sn * 256 + ((c ^ (n & 15)) << 4)) = *(const GAS v4u*)(keys + (size_t)sn * 128 + c * 8); }
    __syncthreads();
    const int gw = F.vcu * NWAVES + F.wave, NGW = F.G * NWAVES, lane = F.lane, r32 = lane & 31, hi = lane >> 5;
    const bf16* Q2 = (const bf16*)(F.ws + WS_Q2);
    int* EIDX = (int*)(F.ws + WS_EIDX); float* EGATE = (float*)(F.ws + WS_EGATE);
    for (int unit = gw; unit < (M / 32) * PH; unit += NGW) {
        const int blk = unit >> 3, h = unit & 7; const size_t tok = (size_t)blk * 32 + r32;
        const bf16* qrow = Q2 + tok * NQ2 + h * PQ + hi * 8;
        int top1[16], top2[16];
#pragma unroll
        for (int s = 0; s < 2; ++s) {
            bf16x8 qf[8];
#pragma unroll
            for (int ks = 0; ks < 8; ++ks) qf[ks] = *(const GAS bf16x8*)(qrow + s * 128 + ks * 16);
            f32x16 acc[4];
#pragma unroll
            for (int kt = 0; kt < 4; ++kt) { acc[kt] = (f32x16){0.f, 0.f, 0.f, 0.f, 0.f, 0.f, 0.f, 0.f, 0.f, 0.f, 0.f, 0.f, 0.f, 0.f, 0.f, 0.f};
                const int n = kt * 32 + r32;
#pragma unroll
                for (int ks = 0; ks < 8; ++ks) { const bf16x8 kf = *(const LAS bf16x8*)(kl + (s * 128 + n) * 256 + (((2 * ks + hi) ^ (n & 15)) << 4));
                    acc[kt] = __builtin_amdgcn_mfma_f32_32x32x16_bf16(kf, qf[ks], acc[kt], 0, 0, 0); } }
            if (s == 0) peer_topk_side(acc, hi, top1); else peer_topk_side(acc, hi, top2);
        }
        float v1[16], v2[16];
#pragma unroll
        for (int i = 0; i < 16; ++i) { v1[i] = ord2f(top1[i]); v2[i] = ord2f(top2[i]);
            look[i * 64 + lane] = __builtin_bit_cast(unsigned, v1[i]) & 0x7Fu; look[(16 + i) * 64 + lane] = __builtin_bit_cast(unsigned, v2[i]) & 0x7Fu; }
        int c[4][16]; int nc = 0;
#pragma unroll
        for (int i = 0; i < 16; ++i)
#pragma unroll
            for (int j = 0; j < 16; ++j) if ((i + 1) * (j + 1) <= 16) { const float sum = v1[i] + v2[j];
                c[nc >> 4][nc & 15] = f2ord(__builtin_bit_cast(float, (__builtin_bit_cast(unsigned, sum) & 0xFFFFFF00u) | (unsigned)(i * 16 + j))); ++nc; }
#pragma unroll
        for (int q = 50; q < 64; ++q) c[q >> 4][q & 15] = (int)0x80000000;
        sort16_desc(c[0]); sort16_desc(c[1]); sort16_desc(c[2]); sort16_desc(c[3]);
        merge16_desc(c[0], c[1]); merge16_desc(c[2], c[3]); merge16_desc(c[0], c[2]);
        float e[16], sum = 0.f;
        float cf[16];
#pragma unroll
        for (int k = 0; k < 16; ++k) cf[k] = ord2f(c[0][k]);
#pragma unroll
        for (int k = 0; k < 16; ++k) { e[k] = __expf(cf[k] - cf[0]); sum += e[k]; }
        const float inv = 1.f / sum;
        LDS_WAIT();
        int ex[8]; float gt[8];
#pragma unroll
        for (int k = 0; k < 8; ++k) { const float cv = hi ? cf[8 + k] : cf[k]; gt[k] = (hi ? e[8 + k] : e[k]) * inv;
            const unsigned pos = __builtin_bit_cast(unsigned, cv) & 0xFFu;
            ex[k] = (int)(look[(pos >> 4) * 64 + lane] * PK + look[(16 + (pos & 15)) * 64 + lane]); }
        int* eo = EIDX + (tok * PH + h) * 16 + hi * 8; float* go = EGATE + (tok * PH + h) * 16 + hi * 8;
        *(GAS v4u*)eo = (v4u){(unsigned)ex[0], (unsigned)ex[1], (unsigned)ex[2], (unsigned)ex[3]}; *(GAS v4u*)(eo + 4) = (v4u){(unsigned)ex[4], (unsigned)ex[5], (unsigned)ex[6], (unsigned)ex[7]};
        *(GAS f32x4*)go = (f32x4){gt[0], gt[1], gt[2], gt[3]}; *(GAS f32x4*)(go + 4) = (f32x4){gt[4], gt[5], gt[6], gt[7]};
        LDS_WAIT();
    }
}

__device__ __forceinline__ void peer_gather_phase(Frame& F) {
    const int gw = F.vcu * NWAVES + F.wave, NGW = F.G * NWAVES, lane = F.lane;
    const bf16* H1 = (const bf16*)(F.ws + WS_H); const bf16* PD = (const bf16*)(F.ws + WS_PD); const bf16* PU = (const bf16*)(F.ws + WS_PU);
    const int* EIDX = (const int*)(F.ws + WS_EIDX); const float* EGATE = (const float*)(F.ws + WS_EGATE);
    const int rep = ((lane >> 5) & 1) * 4 + ((lane >> 4) & 1) * 2 + ((lane >> 3) & 1);
    for (int tok = gw; tok < M; tok += NGW) {
        float x0[8], x1[8]; unpack8(*(const GAS v4u*)(H1 + (size_t)tok * D + lane * 8), x0); unpack8(*(const GAS v4u*)(H1 + (size_t)tok * D + 512 + lane * 8), x1);
        const int e0 = EIDX[(size_t)tok * 128 + lane], e1 = EIDX[(size_t)tok * 128 + 64 + lane];
        const float g0 = EGATE[(size_t)tok * 128 + lane], g1 = EGATE[(size_t)tok * 128 + 64 + lane];
        float o0[8], o1[8];
#pragma unroll
        for (int j = 0; j < 8; ++j) { o0[j] = 0.f; o1[j] = 0.f; }
#pragma unroll 1
        for (int bt = 0; bt < 16; ++bt) {
            const int ev = (bt < 8) ? e0 : e1; const float gv = (bt < 8) ? g0 : g1; const int lb8 = (bt & 7) * 8;
            v4u dw[8][2], uw[8][2];
#pragma unroll
            for (int i = 0; i < 8; ++i) { const int e = __builtin_amdgcn_readlane(ev, lb8 + i);
                const bf16* dr = PD + (size_t)e * D; const bf16* ur = PU + (size_t)e * D;
                dw[i][0] = *(const GAS v4u*)(dr + lane * 8); dw[i][1] = *(const GAS v4u*)(dr + 512 + lane * 8);
                uw[i][0] = *(const GAS v4u*)(ur + lane * 8); uw[i][1] = *(const GAS v4u*)(ur + 512 + lane * 8); }
            float p[8];
#pragma unroll
            for (int i = 0; i < 8; ++i) { float a[8], c[8]; unpack8(dw[i][0], a); unpack8(dw[i][1], c); float s = 0.f;
#pragma unroll
                for (int j = 0; j < 8; ++j) s += a[j] * x0[j] + c[j] * x1[j];
                p[i] = s; }
#pragma unroll
            for (int i = 0; i < 4; ++i) { const float keep = (lane & 32) ? p[i + 4] : p[i], send = (lane & 32) ? p[i] : p[i + 4]; p[i] = keep + __shfl_xor(send, 32); }
#pragma unroll
            for (int i = 0; i < 2; ++i) { const float keep = (lane & 16) ? p[i + 2] : p[i], send = (lane & 16) ? p[i] : p[i + 2]; p[i] = keep + __shfl_xor(send, 16); }
            { const float keep = (lane & 8) ? p[1] : p[0], send = (lane & 8) ? p[0] : p[1]; p[0] = keep + __shfl_xor(send, 8); }
            p[0] += __shfl_xor(p[0], 4); p[0] += __shfl_xor(p[0], 2); p[0] += __shfl_xor(p[0], 1);
            const float gate = __shfl(gv, lb8 + rep);
            const float act = gelu_tanh(p[0]) * gate;
#pragma unroll
            for (int i = 0; i < 8; ++i) { const float af = __builtin_bit_cast(float, __builtin_amdgcn_readlane(__builtin_bit_cast(int, act), ((i >> 2) & 1) * 32 + ((i >> 1) & 1) * 16 + (i & 1) * 8));
                float a[8], c[8]; unpack8(uw[i][0], a); unpack8(uw[i][1], c);
#pragma unroll
                for (int j = 0; j < 8; ++j) { o0[j] += af * a[j]; o1[j] += af * c[j]; } }
        }
        float s = 0.f;
#pragma unroll
        for (int j = 0; j < 8; ++j) { o0[j] += DN_ALPHA * x0[j]; o1[j] += DN_ALPHA * x1[j]; s += o0[j] + o1[j]; }
        const float mean = wave_sum(s) * (1.f / D); float s2 = 0.f;
#pragma unroll
        for (int j = 0; j < 8; ++j) { o0[j] -= mean; o1[j] -= mean; s2 += o0[j] * o0[j] + o1[j] * o1[j]; }
        const float rstd = 1.f / sqrtf(wave_sum(s2) * (1.f / D) + LN_EPS);
        const float* g = F.in[I_LN2G]; const float* b = F.in[I_LN2B];
        float* orow = F.out + (size_t)tok * D;
#pragma unroll
        for (int q = 0; q < 2; ++q) { const int c0 = lane * 8 + 4 * q;
            const f32x4 ga = *(const GAS f32x4*)(g + c0), ba = *(const GAS f32x4*)(b + c0), gb = *(const GAS f32x4*)(g + 512 + c0), bb = *(const GAS f32x4*)(b + 512 + c0);
            f32x4 ya, yb;
            ya.x = o0[4 * q + 0] * rstd * ga.x + ba.x; ya.y = o0[4 * q + 1] * rstd * ga.y + ba.y; ya.z = o0[4 * q + 2] * rstd * ga.z + ba.z; ya.w = o0[4 * q + 3] * rstd * ga.w + ba.w;
            yb.x = o1[4 * q + 0] * rstd * gb.x + bb.x; yb.y = o1[4 * q + 1] * rstd * gb.y + bb.y; yb.z = o1[4 * q + 2] * rstd * gb.z + bb.z; yb.w = o1[4 * q + 3] * rstd * gb.w + bb.w;
            *(GAS f32x4*)(orow + c0) = ya; *(GAS f32x4*)(orow + 512 + c0) = yb; }
    }
}

struct Args { const float* in[26]; float* out; unsigned char* ws; int ph_lo, ph_hi, li, pad; };
__global__ void __launch_bounds__(NWAVES * 64, 2) fwd_kernel(Args args) {
    extern __shared__ __attribute__((aligned(16))) unsigned char lds[];
    Frame F;
    F.lds = (LAS unsigned char*)lds;
    F.MISC = (volatile LAS unsigned*)(F.lds + MISC_OFF);
    F.tid = threadIdx.x; F.lane = F.tid & 63; F.wave = __builtin_amdgcn_readfirstlane(F.tid >> 6);
    F.G = gridDim.x; { const int bx = blockIdx.x; F.vcu = (F.G % 8 == 0) ? (bx % 8) * (F.G / 8) + bx / 8 : bx; }
#pragma unroll
    for (int i = 0; i < 26; ++i) F.in[i] = args.in[i];
    F.out = args.out; F.ws = args.ws;
    unsigned char* ws = args.ws;
    F.ctl = (gu32*)(ws + WS_CTL);
    for (int u = F.tid; u < (LDS_BYTES - LDSCTL_OFF) / 4; u += NWAVES * 64) ((LAS unsigned*)(F.lds + LDSCTL_OFF))[u] = 0u;
    __syncthreads();
    XcdBarrier bar; bar.bar = (unsigned*)(F.ctl + CW_BAR); bar.x = 0; bar.st = nullptr;
    if (N_LAUNCHES == 1) bar = xcd_barrier_post((unsigned*)(F.ctl + CW_BAR), F.MISC + 8);
#define GRID_BAR() do { if (N_LAUNCHES == 1) xcd_barrier(bar); } while (0)
    const int lo = args.ph_lo, hi = args.ph_hi;
#define IN(k) (lo <= (k) && (k) < hi)
#define BOTH(k) (IN(k) && IN((k) + 1))
    bf16* const Hb = (bf16*)(ws + WS_H);
    bf16* const PRJ = (bf16*)(ws + WS_PROJ);

    if (IN(0)) { p0_prologue(F); if (BOTH(0)) GRID_BAR(); }

    if (IN(1)) {
        pg8::Gemm g{Hb, (const bf16*)(ws + WS_WIN), M, NPROJ, D}; pg8::StaticOrder S; S.init(M, NPROJ, F.G, (int)blockIdx.x);
        pg8::EpiProj E{PRJ, PRJ + (size_t)M * 512, PRJ + (size_t)2 * M * 512, PRJ + (size_t)3 * M * 512, PRJ + (size_t)4 * M * 512, (const float*)(ws + WS_LB), M};
        pg8::gemm_phase<pg8::EpiProj, pg8::StaticOrder, true, true>(F.lds + RING_OFF, g, S, E);
        if (BOTH(1)) GRID_BAR();
    }

    if (IN(2)) {
        for (int rep = 0; rep < (PROBE_REP == 2 ? 2 : 1); ++rep) {
        if (F.vcu < 32) hgrn2_seq(F, F.vcu);
        else if (F.vcu < 64) s5_seq(F, (F.vcu - 32) * NWAVES + F.wave);
        }
        if (BOTH(2)) GRID_BAR();
    }

    if (IN(3)) {
        pg8::Gemm g{(const bf16*)(ws + WS_Z), (const bf16*)(ws + WS_WGLU), M, 512, 512}; pg8::StaticOrder S; S.init(M, 512, F.G, (int)blockIdx.x);
        pg8::EpiGlu E{(const bf16*)(ws + WS_Z), (bf16*)(ws + WS_MIX), F.in[I_BGLU]};
        pg8::gemm_phase<pg8::EpiGlu, pg8::StaticOrder, true, true>(F.lds + RING_OFF, g, S, E);
        if (BOTH(3)) GRID_BAR();
    }

    if (IN(4)) {
        pg8::Gemm g{(const bf16*)(ws + WS_MIX), (const bf16*)(ws + WS_WOUT), M, D, D}; pg8::StaticOrder S; S.init(M, D, F.G, (int)blockIdx.x);
        pg8::EpiOut E{Hb, DN_ALPHA};
        pg8::gemm_phase<pg8::EpiOut, pg8::StaticOrder, true, true>(F.lds + RING_OFF, g, S, E);
        if (BOTH(4)) GRID_BAR();
    }

    if (IN(5)) {
        const int gw = F.vcu * NWAVES + F.wave, NGW = F.G * NWAVES;
        for (int m = gw; m < M; m += NGW) ln1_row(Hb + (size_t)m * D, F.in[I_LN1G], F.in[I_LN1B], F.lane);
        if (BOTH(5)) GRID_BAR();
    }

    if (IN(6)) {
        pg8::Gemm g{Hb, (const bf16*)(ws + WS_WQ), M, NQ2, D}; pg8::StaticOrder S; S.init(M, NQ2, F.G, (int)blockIdx.x);
        pg8::EpiStore E{(bf16*)(ws + WS_Q2), NQ2};
        pg8::gemm_phase<pg8::EpiStore, pg8::StaticOrder, true, true>(F.lds + RING_OFF, g, S, E);
        if (BOTH(6)) GRID_BAR();
    }

    if (IN(7)) { for (int rep = 0; rep < (PROBE_REP == 7 ? 2 : 1); ++rep) peer_score_phase(F); if (BOTH(7)) GRID_BAR(); }

    if (IN(8)) { for (int rep = 0; rep < (PROBE_REP == 8 ? 2 : 1); ++rep) peer_gather_phase(F); }
#undef IN
#undef BOTH
}

extern "C" void kernel_launch(void* const* d_in, const int* in_sizes, int n_in, void* d_out, int out_size, void* d_ws, size_t ws_size, hipStream_t stream) {
    static int grid = 0;
    if (grid == 0) {
        if (n_in != 26 || in_sizes[0] != M * D || out_size != M * D || ws_size < WS_END) { fprintf(stderr, "kernel_launch: unexpected shapes: n_in %d in0 %d out %d ws %zu (need %zu)\n", n_in, n_in > 0 ? in_sizes[0] : -1, out_size, ws_size, (size_t)WS_END); grid = -1; return; }
        int dev = 0, cus = 0;
        if (hipGetDevice(&dev) != hipSuccess || hipDeviceGetAttribute(&cus, hipDeviceAttributeMultiprocessorCount, dev) != hipSuccess) { grid = -1; return; }
        if (hipFuncSetAttribute((const void*)fwd_kernel, hipFuncAttributeMaxDynamicSharedMemorySize, LDS_BYTES) != hipSuccess) { fprintf(stderr, "kernel_launch: hipFuncSetAttribute failed\n"); grid = -1; return; }
        (void)hipGetLastError();
        grid = cus;
    }
    if (grid < 0) return;
    if (hipMemsetAsync((char*)d_ws + WS_CTL, 0, CTL_ZERO_BYTES, stream) != hipSuccess) return;
    Args a{};
    for (int i = 0; i < 26; ++i) a.in[i] = (const float*)d_in[i];
    a.out = (float*)d_out; a.ws = (unsigned char*)d_ws;
    if (N_LAUNCHES == 1) { a.ph_lo = 0; a.ph_hi = NPH; a.li = 0; hipLaunchKernelGGL(fwd_kernel, dim3(grid), dim3(NWAVES * 64), LDS_BYTES, stream, a); }
    else for (int li = 0; li < NPH; ++li) { a.ph_lo = li; a.ph_hi = li + 1; a.li = li; hipLaunchKernelGGL(fwd_kernel, dim3(grid), dim3(NWAVES * 64), LDS_BYTES, stream, a); }
}
```

```cpp
#include <hip/hip_runtime.h>
#include <cstdio>
#include <cstdint>
namespace pg8 {
#define PG8_LAS __attribute__((address_space(3)))
typedef unsigned short bf16_t;
typedef short bf16x8 __attribute__((ext_vector_type(8)));
typedef float f32x4 __attribute__((ext_vector_type(4)));
typedef unsigned u32x4 __attribute__((ext_vector_type(4)));
constexpr int BM = 256, BK = 64, HALF = 128, HTB = HALF * BK * 2  , STAGE_BYTES = 8 * HTB, NXCD = 8, WGM = 8;

__host__ __device__ __forceinline__ int lds_byte(int r, int c) { const int st = (r >> 4) * 2 + (c >> 5), rr = r & 15, cc = c & 31, ob = rr * 64 + cc * 2; return st * 1024 + (ob ^ (((ob >> 9) & 1) << 5)); }
__host__ __device__ __forceinline__ void stage_rc(int b, int& R, int& C) { const int st = b / 1024, sb = b % 1024, swz = sb ^ (((sb >> 9) & 1) << 5); R = (st >> 1) * 16 + swz / 64; C = (st & 1) * 32 + (swz % 64) / 2; }
__host__ __device__ __forceinline__ int perm32(int rho) { const int n = rho >> 4, i = rho & 15; return 8 * (i >> 2) + 4 * n + (i & 3); }

struct Unit { int pm, pn; };
struct Gemm { const bf16_t* A; const bf16_t* Bt; int M, N, K, lda, ldb; };

struct StaticOrder {
    int nM, nN, nwg, G, c;
    __host__ __device__ void init(int M, int N, int G_, int c_) { nM = M / BM; nN = N / BM; nwg = nM * nN; G = G_; c = c_; }
    __host__ __device__ bool next(int i, Unit& u) const {
        const long L = (long)i * G + c; if (L >= nwg) return false;
        int wgid = (int)L; { const int q = nwg / NXCD, r = nwg % NXCD, xcd = wgid % NXCD, off = wgid / NXCD; wgid = (xcd < r ? xcd * (q + 1) : r * (q + 1) + (xcd - r) * q) + off; }
        const int nig = WGM * nN, gid = wgid / nig, fm = gid * WGM, gsz = (nM - fm) < WGM ? (nM - fm) : WGM;
        u.pm = fm + ((wgid % nig) % gsz); u.pn = (wgid % nig) / gsz; return true;
    }
    __device__ __forceinline__ void a_ready(const Unit&) const {}
    __device__ __forceinline__ void done(const Unit&) const {}
};

__device__ __forceinline__ unsigned cvt_pk_bf16(float lo, float hi) { unsigned r; asm volatile("v_cvt_pk_bf16_f32 %0, %1, %2" : "=v"(r) : "v"(lo), "v"(hi)); return r; }
__device__ __forceinline__ void unpack8(const u32x4 w, float (&f)[8]) {
    f[0] = __builtin_bit_cast(float, w.x << 16); f[1] = __builtin_bit_cast(float, w.x & 0xffff0000u);
    f[2] = __builtin_bit_cast(float, w.y << 16); f[3] = __builtin_bit_cast(float, w.y & 0xffff0000u);
    f[4] = __builtin_bit_cast(float, w.z << 16); f[5] = __builtin_bit_cast(float, w.z & 0xffff0000u);
    f[6] = __builtin_bit_cast(float, w.w << 16); f[7] = __builtin_bit_cast(float, w.w & 0xffff0000u);
}
__device__ __forceinline__ u32x4 pack8(const float (&f)[8]) { u32x4 w; w.x = cvt_pk_bf16(f[0], f[1]); w.y = cvt_pk_bf16(f[2], f[3]); w.z = cvt_pk_bf16(f[4], f[5]); w.w = cvt_pk_bf16(f[6], f[7]); return w; }

struct EpiStore {
    static constexpr bool PERM = true, AFTER_DRAIN = false;
    bf16_t* O; int ldc;
    __device__ __forceinline__ void operator()(const f32x4 (&acc)[2][2][4][2], const Unit& u, int wr, int wc, int fr, int fq) const {
        const int row0 = u.pm * BM + wr * 64 + fr, col0 = u.pn * BM + wc * 32 + 8 * fq;
#pragma unroll
        for (int ai = 0; ai < 2; ++ai)
#pragma unroll
            for (int m = 0; m < 4; ++m) { bf16_t* rowp = O + (size_t)(row0 + ai * HALF + m * 16) * ldc + col0;
#pragma unroll
                for (int bj = 0; bj < 2; ++bj) { const f32x4 v0 = acc[ai][bj][m][0], v1 = acc[ai][bj][m][1];
                    u32x4 w; w.x = cvt_pk_bf16(v0[0], v0[1]); w.y = cvt_pk_bf16(v0[2], v0[3]); w.z = cvt_pk_bf16(v1[0], v1[1]); w.w = cvt_pk_bf16(v1[2], v1[3]);
                    *(u32x4*)(rowp + bj * HALF) = w; } }
    }
};

struct EpiProj {
    static constexpr bool PERM = true, AFTER_DRAIN = false;
    bf16_t* Qb; bf16_t* LFb; bf16_t* Vb; bf16_t* Gb; bf16_t* Ub; const float* lb; int M;
    __device__ __forceinline__ void operator()(const f32x4 (&acc)[2][2][4][2], const Unit& u, int wr, int wc, int fr, int fq) const {
        const int row0 = u.pm * BM + wr * 64 + fr; const int colt = u.pn * BM; const int t = colt >> 9;
        const int cb = (colt & 511) + wc * 32 + 8 * fq;
        float lbv[2][8];
        if (t == 1) {
#pragma unroll
            for (int bj = 0; bj < 2; ++bj) { const f32x4 a = *(const f32x4*)(lb + cb + bj * HALF), b = *(const f32x4*)(lb + cb + bj * HALF + 4);
                lbv[bj][0] = a[0]; lbv[bj][1] = a[1]; lbv[bj][2] = a[2]; lbv[bj][3] = a[3]; lbv[bj][4] = b[0]; lbv[bj][5] = b[1]; lbv[bj][6] = b[2]; lbv[bj][7] = b[3]; }
        }
#pragma unroll
        for (int ai = 0; ai < 2; ++ai)
#pragma unroll
            for (int m = 0; m < 4; ++m) { const int row = row0 + ai * HALF + m * 16;
#pragma unroll
                for (int bj = 0; bj < 2; ++bj) { const f32x4 v0 = acc[ai][bj][m][0], v1 = acc[ai][bj][m][1]; const int c = cb + bj * HALF;
                    float f[8] = {v0[0], v0[1], v0[2], v0[3], v1[0], v1[1], v1[2], v1[3]};
                    if (t == 0) {
#pragma unroll
                        for (int j = 0; j < 8; ++j) f[j] *= 0.08838834764831845f;
                        *(u32x4*)(Qb + (size_t)row * 512 + c) = pack8(f);
                    } else if (t == 1) {
#pragma unroll
                        for (int j = 0; j < 8; ++j) { const float l = lbv[bj][j]; const float sg = 1.f / (1.f + __expf(-f[j])); f[j] = __logf(l + (1.f - l) * sg); }
                        *(u32x4*)(LFb + (size_t)row * 512 + c) = pack8(f);
                    } else if (t == 2) { *(u32x4*)(Vb + (size_t)row * 512 + c) = pack8(f);
                    } else if (t == 3) { *(u32x4*)(Gb + (size_t)row * 512 + c) = pack8(f);
                    } else { *(u32x4*)(Ub + ((size_t)(c >> 4) * (M / 32) + (row >> 5)) * 640 + (row & 31) * 16 + (c & 15)) = pack8(f); }
                } }
    }
};

struct EpiGlu {
    static constexpr bool PERM = true, AFTER_DRAIN = false;
    const bf16_t* Z; bf16_t* MIX; const float* bglu;
    __device__ __forceinline__ void operator()(const f32x4 (&acc)[2][2][4][2], const Unit& u, int wr, int wc, int fr, int fq) const {
        const int row0 = u.pm * BM + wr * 64 + fr, col0 = u.pn * BM + wc * 32 + 8 * fq;
#pragma unroll
        for (int bj = 0; bj < 2; ++bj) { const int c = col0 + bj * HALF;
            const f32x4 b0 = *(const f32x4*)(bglu + c), b1 = *(const f32x4*)(bglu + c + 4);
#pragma unroll
            for (int ai = 0; ai < 2; ++ai)
#pragma unroll
                for (int m = 0; m < 4; ++m) { const int row = row0 + ai * HALF + m * 16;
                    const f32x4 v0 = acc[ai][bj][m][0] + b0, v1 = acc[ai][bj][m][1] + b1;
                    float z[8]; unpack8(*(const u32x4*)(Z + (size_t)row * 512 + c), z);
                    float f[8] = {v0[0], v0[1], v0[2], v0[3], v1[0], v1[1], v1[2], v1[3]};
#pragma unroll
                    for (int j = 0; j < 8; ++j) f[j] = z[j] / (1.f + __expf(-f[j]));
                    *(u32x4*)(MIX + (size_t)row * 1024 + 512 + c) = pack8(f); } }
    }
};

struct EpiOut {
    static constexpr bool PERM = true, AFTER_DRAIN = false;
    bf16_t* H; float alpha;
    __device__ __forceinline__ void operator()(const f32x4 (&acc)[2][2][4][2], const Unit& u, int wr, int wc, int fr, int fq) const {
        const int row0 = u.pm * BM + wr * 64 + fr, col0 = u.pn * BM + wc * 32 + 8 * fq;
#pragma unroll
        for (int ai = 0; ai < 2; ++ai)
#pragma unroll
            for (int m = 0; m < 4; ++m) { bf16_t* rowp = H + (size_t)(row0 + ai * HALF + m * 16) * 1024 + col0;
#pragma unroll
                for (int bj = 0; bj < 2; ++bj) { const f32x4 v0 = acc[ai][bj][m][0], v1 = acc[ai][bj][m][1];
                    float h[8]; unpack8(*(const u32x4*)(rowp + bj * HALF), h);
                    float f[8] = {v0[0], v0[1], v0[2], v0[3], v1[0], v1[1], v1[2], v1[3]};
#pragma unroll
                    for (int j = 0; j < 8; ++j) f[j] = alpha * h[j] + f[j];
                    *(u32x4*)(rowp + bj * HALF) = pack8(f); } }
    }
};

struct GroupedOrder {
    int tm, tn, G, c;
    __device__ bool next(int i, Unit& u) const { const int L = i * G + c, per = tm * tn; if (c < 0 || L >= 32 * per) return false;
        const int g = L / per, r = L % per; u.pm = g * tm + r % tm; u.pn = g * tn + r / tm; return true; }
    __device__ __forceinline__ void a_ready(const Unit&) const {}
    __device__ __forceinline__ void done(const Unit&) const {}
};
struct EpiS5A {
    static constexpr bool PERM = true, AFTER_DRAIN = false;
    float* X;
    __device__ __forceinline__ void operator()(const f32x4 (&acc)[2][2][4][2], const Unit& u, int wr, int wc, int fr, int fq) const {
        const int g = u.pn, inst0 = (u.pm & 3) * BM + wr * 64 + fr, col = wc * 32 + 8 * fq;
#pragma unroll
        for (int ai = 0; ai < 2; ++ai)
#pragma unroll
            for (int m = 0; m < 4; ++m) { float* p = X + ((size_t)(inst0 + ai * HALF + m * 16) * 32 + g) * 128 + col;
                *(f32x4*)p = acc[ai][0][m][0]; *(f32x4*)(p + 4) = acc[ai][0][m][1]; }
    }
};
struct EpiS5C {
    static constexpr bool PERM = true, AFTER_DRAIN = false;
    bf16_t* Z;
    __device__ __forceinline__ void operator()(const f32x4 (&acc)[2][2][4][2], const Unit& u, int wr, int wc, int fr, int fq) const {
        const int g = u.pm >> 2, inst0 = (u.pm & 3) * BM + wr * 64 + fr, col0 = (u.pn & 1) * BM + wc * 32 + 8 * fq;
#pragma unroll
        for (int ai = 0; ai < 2; ++ai)
#pragma unroll
            for (int m = 0; m < 4; ++m) { const int inst = inst0 + ai * HALF + m * 16; const size_t tok0 = (size_t)(inst >> 7) * 4096 + (size_t)(inst & 127) * 32;
#pragma unroll
                for (int bj = 0; bj < 2; ++bj) { const int col = col0 + bj * HALF; const f32x4 v0 = acc[ai][bj][m][0], v1 = acc[ai][bj][m][1];
                    float f[8] = {v0[0], v0[1], v0[2], v0[3], v1[0], v1[1], v1[2], v1[3]};
#pragma unroll
                    for (int j = 0; j < 8; ++j) { const float x = f[j], y = 0.7978845608028654f * (x + 0.044715f * x * x * x); f[j] = x / (1.f + __expf(-2.f * y)); }
                    *(u32x4*)(Z + (tok0 + (col >> 4)) * 512 + g * 16 + (col & 15)) = pack8(f); } }
    }
};

template <class Epi, class Sched, bool ALIGN_EPI = false, bool SP2 = false>
__device__ __forceinline__ void gemm_phase(PG8_LAS unsigned char* lds, const Gemm g, const Sched& S, const Epi& E) {
    const int tid = threadIdx.x, wid = __builtin_amdgcn_readfirstlane(tid >> 6), lane = tid & 63, wr = wid >> 2, wc = wid & 3, fr = lane & 15, fq = lane >> 4;
    const int K = g.K, nt = K / BK;
    unsigned voffA[2], voffB[2];
#pragma unroll
    for (int i = 0; i < 2; ++i) { int R, C; stage_rc(tid * 16 + i * 8192, R, C); const int Rb = Epi::PERM ? ((R & ~31) + perm32(R & 31)) : R;
        voffA[i] = (unsigned)(R * g.lda + C) * 2u; voffB[i] = (unsigned)(Rb * g.ldb + C) * 2u; }
    const size_t kstep = (size_t)(BK * 2);
    const size_t hstepA = (size_t)HALF * g.lda * 2, hstepB = (size_t)HALF * g.ldb * 2;
    const size_t tstepA = 2 * hstepA, tstepB = 2 * hstepB;
    const unsigned ldsw = (unsigned)wid * 1024u;
    const int aoff = lds_byte(wr * 64 + fr, fq * 8), boff = lds_byte(wc * 32 + fr, fq * 8);
#define PG8_SA(b, h) (((b) * 2 + (h)) * HTB)
#define PG8_SB(b, h) ((4 + (b) * 2 + (h)) * HTB)
#define PG8_STAGE(bufoff, gbase, voff) do { _Pragma("unroll") for (int _i = 0; _i < 2; ++_i) \
        __builtin_amdgcn_global_load_lds((const unsigned*)((const char*)(gbase) + (voff)[_i]), (PG8_LAS unsigned*)(lds + (bufoff) + ldsw + _i * 8192), 16, 0, 0); } while (0)
#define PG8_LDA(dst, b, h) do { _Pragma("unroll") for (int m = 0; m < 4; ++m) _Pragma("unroll") for (int k = 0; k < 2; ++k) dst[m][k] = *(const PG8_LAS bf16x8*)(lds + PG8_SA(b, h) + aoff + m * 2048 + k * 1024); } while (0)
#define PG8_LDB(dst, b, h) do { _Pragma("unroll") for (int n = 0; n < 2; ++n) _Pragma("unroll") for (int k = 0; k < 2; ++k) dst[n][k] = *(const PG8_LAS bf16x8*)(lds + PG8_SB(b, h) + boff + n * 2048 + k * 1024); } while (0)
#define PG8_MMA(ai, bj, At, Bt) do { __builtin_amdgcn_s_setprio(1); _Pragma("unroll") for (int m = 0; m < 4; ++m) _Pragma("unroll") for (int n = 0; n < 2; ++n) _Pragma("unroll") for (int k = 0; k < 2; ++k) \
        acc[ai][bj][m][n] = __builtin_amdgcn_mfma_f32_16x16x32_bf16(Bt[n][k], At[m][k], acc[ai][bj][m][n], 0, 0, 0); __builtin_amdgcn_s_setprio(0); } while (0)
#define PG8_WAIT_V(n) asm volatile("s_waitcnt vmcnt(" #n ")" ::: "memory")
#define PG8_WAIT_L(n) asm volatile("s_waitcnt lgkmcnt(" #n ")" ::: "memory")
#define PG8_BAR __builtin_amdgcn_s_barrier()
#define PG8_SCHED __builtin_amdgcn_sched_barrier(0)
    Unit cur, nxt; int ui = 0;
    if (!S.next(0, cur)) return;
    f32x4 acc[2][2][4][2];
#pragma unroll
    for (int a = 0; a < 2; ++a)
#pragma unroll
        for (int b = 0; b < 2; ++b)
#pragma unroll
            for (int m = 0; m < 4; ++m)
#pragma unroll
                for (int n = 0; n < 2; ++n) acc[a][b][m][n] = (f32x4){0.f, 0.f, 0.f, 0.f};
    bf16x8 At[4][2], B0[2][2], B1[2][2];
    const char* cA = (const char*)g.A + (size_t)cur.pm * tstepA; const char* cB = (const char*)g.Bt + (size_t)cur.pn * tstepB;
    S.a_ready(cur);
    if constexpr (SP2) {
        PG8_STAGE(PG8_SB(0, 0), cB, voffB); PG8_STAGE(PG8_SB(0, 1), cB + hstepB, voffB); PG8_STAGE(PG8_SA(0, 0), cA, voffA); PG8_STAGE(PG8_SA(0, 1), cA + hstepA, voffA);
        if (wr == 1) PG8_BAR;
        PG8_WAIT_V(2); PG8_BAR;
        PG8_STAGE(PG8_SB(1, 0), cB + kstep, voffB); PG8_STAGE(PG8_SA(1, 0), cA + kstep, voffA); PG8_STAGE(PG8_SB(1, 1), cB + hstepB + kstep, voffB);
        PG8_WAIT_V(6); PG8_BAR;
    } else {
        PG8_STAGE(PG8_SB(0, 0), cB, voffB); PG8_STAGE(PG8_SA(0, 0), cA, voffA); PG8_STAGE(PG8_SB(0, 1), cB + hstepB, voffB); PG8_STAGE(PG8_SA(0, 1), cA + hstepA, voffA);
        if (wr == 1) PG8_BAR;
        PG8_WAIT_V(4); PG8_BAR;
        PG8_STAGE(PG8_SB(1, 0), cB + kstep, voffB); PG8_STAGE(PG8_SA(1, 0), cA + kstep, voffA); PG8_STAGE(PG8_SB(1, 1), cB + hstepB + kstep, voffB);
        PG8_WAIT_V(6); PG8_BAR;
    }
    for (;;) {
        const bool has_next = S.next(ui + 1, nxt);
        const char* nA = has_next ? (const char*)g.A + (size_t)nxt.pm * tstepA : cA; const char* nB = has_next ? (const char*)g.Bt + (size_t)nxt.pn * tstepB : cB;
        for (int t = 0; t < nt; t += 2) {
            const bool last = (t == nt - 2);
            const char* a1 = cA + (size_t)(t + 1) * kstep;
            const char* a2 = last ? nA : cA + (size_t)(t + 2) * kstep; const char* b2 = last ? nB : cB + (size_t)(t + 2) * kstep;
            const char* a3 = a2 + kstep; const char* b3 = b2 + kstep;
            if (last && has_next) S.a_ready(nxt);
            if constexpr (SP2) {
            PG8_LDB(B0, 0, 0); PG8_LDB(B1, 0, 1); PG8_SCHED; PG8_LDA(At, 0, 0); PG8_STAGE(PG8_SA(1, 1), a1 + hstepA, voffA);
            PG8_WAIT_V(8); PG8_WAIT_L(0); PG8_BAR; PG8_MMA(0, 0, At, B0); PG8_MMA(0, 1, At, B1); PG8_BAR; PG8_SCHED;
            PG8_LDA(At, 0, 1); PG8_STAGE(PG8_SB(0, 0), b2, voffB); PG8_STAGE(PG8_SB(0, 1), b2 + hstepB, voffB); PG8_STAGE(PG8_SA(0, 0), a2, voffA);
            PG8_WAIT_V(8); PG8_WAIT_L(0); PG8_BAR; PG8_MMA(1, 0, At, B0); PG8_MMA(1, 1, At, B1); PG8_BAR; PG8_SCHED;
            PG8_LDB(B0, 1, 0); PG8_LDB(B1, 1, 1); PG8_SCHED; PG8_LDA(At, 1, 0); PG8_STAGE(PG8_SA(0, 1), a2 + hstepA, voffA);
            PG8_WAIT_V(8); PG8_WAIT_L(0); PG8_BAR; PG8_MMA(0, 0, At, B0); PG8_MMA(0, 1, At, B1); PG8_BAR; PG8_SCHED;
            PG8_LDA(At, 1, 1); PG8_STAGE(PG8_SB(1, 0), b3, voffB); PG8_STAGE(PG8_SB(1, 1), b3 + hstepB, voffB); PG8_STAGE(PG8_SA(1, 0), a3, voffA);
            PG8_WAIT_V(8); PG8_WAIT_L(0); PG8_BAR; PG8_MMA(1, 0, At, B0); PG8_MMA(1, 1, At, B1); PG8_BAR; PG8_SCHED;
            } else {
            PG8_LDB(B0, 0, 0); PG8_SCHED; PG8_LDA(At, 0, 0); PG8_STAGE(PG8_SA(1, 1), a1 + hstepA, voffA);
            PG8_WAIT_L(8); PG8_BAR; PG8_WAIT_L(0); PG8_MMA(0, 0, At, B0); PG8_BAR; PG8_SCHED;
            PG8_LDB(B1, 0, 1); PG8_STAGE(PG8_SB(0, 0), b2, voffB);
            PG8_BAR; PG8_WAIT_L(0); PG8_MMA(0, 1, At, B1); PG8_BAR;
            PG8_LDA(At, 0, 1); PG8_STAGE(PG8_SA(0, 0), a2, voffA);
            PG8_BAR; PG8_WAIT_L(0); PG8_MMA(1, 0, At, B0); PG8_BAR; PG8_SCHED;
            PG8_STAGE(PG8_SB(0, 1), b2 + hstepB, voffB);
            PG8_WAIT_V(6); PG8_BAR; PG8_MMA(1, 1, At, B1); PG8_BAR;
            PG8_LDB(B0, 1, 0); PG8_SCHED; PG8_LDA(At, 1, 0); PG8_STAGE(PG8_SA(0, 1), a2 + hstepA, voffA);
            PG8_WAIT_L(8); PG8_BAR; PG8_WAIT_L(0); PG8_MMA(0, 0, At, B0); PG8_BAR; PG8_SCHED;
            PG8_LDB(B1, 1, 1); PG8_STAGE(PG8_SB(1, 0), b3, voffB);
            PG8_BAR; PG8_WAIT_L(0); PG8_MMA(0, 1, At, B1); PG8_BAR;
            PG8_LDA(At, 1, 1); PG8_STAGE(PG8_SA(1, 0), a3, voffA);
            PG8_BAR; PG8_WAIT_L(0); PG8_MMA(1, 0, At, B0); PG8_BAR; PG8_SCHED;
            PG8_STAGE(PG8_SB(1, 1), b3 + hstepB, voffB);
            PG8_WAIT_V(6); PG8_BAR; PG8_MMA(1, 1, At, B1); PG8_BAR;
            }
        }
        if constexpr (ALIGN_EPI) { if (wr == 0) PG8_BAR; }
        if constexpr (!Epi::AFTER_DRAIN) { E(acc, cur, wr, wc, fr, fq); S.done(cur); }
        if (!has_next) break;
#pragma unroll
        for (int a = 0; a < 2; ++a)
#pragma unroll
            for (int b = 0; b < 2; ++b)
#pragma unroll
                for (int m = 0; m < 4; ++m)
#pragma unroll
                    for (int n = 0; n < 2; ++n) acc[a][b][m][n] = (f32x4){0.f, 0.f, 0.f, 0.f};
        cur = nxt; cA = nA; cB = nB; ++ui;
        if constexpr (ALIGN_EPI) { if (wr == 1) PG8_BAR; }
    }
    PG8_WAIT_V(0);
    if constexpr (!ALIGN_EPI) { if (wr == 0) PG8_BAR; }
    PG8_BAR;
    if constexpr (Epi::AFTER_DRAIN) { E.fused(acc, cur, wr, wc, fr, fq, lds, wid, lane); S.done(cur); }
#undef PG8_SA
#undef PG8_SB
#undef PG8_STAGE
#undef PG8_LDA
#undef PG8_LDB
#undef PG8_MMA
#undef PG8_WAIT_V
#undef PG8_WAIT_L
#undef PG8_BAR
#undef PG8_SCHED
}
}

constexpr int NWAVES = 8;
#ifndef MK_N_LAUNCHES
#define MK_N_LAUNCHES 1
#endif
constexpr int N_LAUNCHES = MK_N_LAUNCHES;
constexpr int NPH = 11;
#ifndef PROBE_REP
#define PROBE_REP -1
#endif

constexpr int BATCH = 8, SEQ = 4096, D = 1024, M = BATCH * SEQ;
constexpr int HGW = 512, HGH = 4, HGK = 128;
constexpr int S5W = 512, S5G = 32, S5P = 16, S5N = 64;
constexpr int S5L = 32, S5I = M / S5L, S5K = S5L * S5P + 2 * S5N;
constexpr int NPROJ = 2560;
constexpr int PK = 128, PH = 8, PTOPK = 16, PQ = 256, PHALF = 128, PE = PK * PK, NQ2 = PH * PQ;
constexpr float LN_EPS = 1e-5f, RMS_EPS = 1e-6f;
constexpr float DN_ALPHA = 1.189207115002721f;

constexpr size_t MiB = 1u << 20;
constexpr size_t WS_CTL = 0, CTL_ZERO_BYTES = 1 * MiB;
constexpr size_t WS_WIN = 1 * MiB;
constexpr size_t WS_WGLU = 6 * MiB;
constexpr size_t WS_KEYS = 6 * MiB + 512 * 1024;
constexpr size_t WS_LB = 6 * MiB + 640 * 1024;
constexpr size_t WS_S5T = 6 * MiB + 704 * 1024;
constexpr size_t WS_WOUT = 7 * MiB + 512 * 1024;
constexpr size_t WS_WQ = 10 * MiB;
constexpr size_t WS_SST = 14 * MiB;
constexpr size_t WS_H = 78 * MiB;
constexpr size_t WS_PROJ = 142 * MiB;
constexpr size_t WS_Q2 = WS_PROJ;
constexpr size_t WS_A5 = 270 * MiB;
constexpr size_t WS_MIX = 310 * MiB;
constexpr size_t WS_PD = WS_MIX, WS_PU = WS_MIX + 32 * MiB;
constexpr size_t WS_Z = 374 * MiB;
constexpr size_t WS_EIDX = WS_Z, WS_EGATE = WS_Z + 16 * MiB;
constexpr size_t WS_T5 = 406 * MiB;
constexpr size_t WS_G5 = 426 * MiB;
constexpr size_t WS_XLOC = 434 * MiB;
constexpr size_t WS_KTAU = 450 * MiB;
constexpr size_t WS_PW = 451 * MiB;
constexpr size_t WS_END = 452 * MiB;
constexpr int CW_TMO = 0, CW_CODE = 1;
constexpr int CW_BAR = 4096;

constexpr int RING_OFF = 0, RING_BYTES = 131072;
constexpr int LDSCTL_OFF = RING_BYTES, MISC_OFF = LDSCTL_OFF + 320;
constexpr int LDS_BYTES = 147456;
static_assert(MISC_OFF + 128 <= LDS_BYTES, "LDS map");

#define GAS __attribute__((address_space(1)))
#define LAS __attribute__((address_space(3)))
typedef unsigned short bf16;
typedef unsigned v4u __attribute__((ext_vector_type(4)));
typedef float f32x4 __attribute__((ext_vector_type(4)));
typedef short bf16x8 __attribute__((ext_vector_type(8)));
typedef GAS unsigned gu32;
typedef GAS unsigned long long gu64;
#define RLX_AGENT __ATOMIC_RELAXED, __HIP_MEMORY_SCOPE_AGENT
#define LDS_WAIT() asm volatile("s_waitcnt lgkmcnt(0)" ::: "memory")
#define VM_WAIT() asm volatile("s_waitcnt vmcnt(0)" ::: "memory")
__device__ __forceinline__ unsigned long long rt() { return __builtin_amdgcn_s_memrealtime(); }
__device__ __forceinline__ unsigned f2bf(float f) { unsigned u = __builtin_bit_cast(unsigned, f); return (u + 0x7fffu + ((u >> 16) & 1u)) >> 16; }
__device__ __forceinline__ unsigned pk2(float lo, float hi) { return f2bf(lo) | (f2bf(hi) << 16); }

#define XB_TMO      128
#define XB_XCNT(j)  (256  + 64 * (j))
#define XB_XSUB(j)  (1280 + 64 * (j))
#define XB_XGEN(j)  (2304 + 64 * (j))
#define XB_TOP      3328
#define XB_TOPGEN   3392
#define XCD_BAR_WORDS 3456
#define XB_SPIN_CAP (1u << 18)

__device__ __forceinline__ unsigned xb_ld(unsigned* p)              { return __hip_atomic_load(p, __ATOMIC_RELAXED, __HIP_MEMORY_SCOPE_AGENT); }
__device__ __forceinline__ unsigned xb_add(unsigned* p, unsigned v) { return __hip_atomic_fetch_add(p, v, __ATOMIC_RELAXED, __HIP_MEMORY_SCOPE_AGENT); }
__device__ __forceinline__ unsigned xb_xcc_id() { return (unsigned)__builtin_amdgcn_s_getreg((3 << 11) | 20) & 0xFu; }
#define XB_SPIN(cond, bar) do { unsigned _sp = 0; while (cond) { __builtin_amdgcn_s_sleep(1); \
    if ((++_sp & 255u) == 0u) { if (xb_ld(&(bar)[XB_TMO])) break; if (_sp > XB_SPIN_CAP) { atomicAdd(&(bar)[XB_TMO], 1u); break; } } } } while (0)

struct XcdBarrier {
    unsigned* bar; unsigned x;
    volatile LAS unsigned* st;
};

__device__ __forceinline__ XcdBarrier xcd_barrier_post(unsigned* bar, volatile LAS unsigned* st) {
    XcdBarrier b; b.bar = bar; b.x = xb_xcc_id(); b.st = st;
    if (threadIdx.x == 0) (void)xb_add(&bar[XB_XCNT(b.x)], 1u);
    return b;
}
__device__ __forceinline__ void xcd_barrier_complete(unsigned* bar, unsigned x, unsigned& nloc, unsigned& nx) {
    const unsigned G = gridDim.x * gridDim.y * gridDim.z;
    unsigned sum, cnt, mine, sp = 0u;
    for (;;) {
        sum = 0u; cnt = 0u; mine = 0u;
#pragma unroll
        for (unsigned j = 0; j < 16; ++j) { const unsigned c = xb_ld(&bar[XB_XCNT(j)]); sum += c; cnt += (c > 0u) ? 1u : 0u; mine = (j == x) ? c : mine; }
        if (sum == G) break;
        __builtin_amdgcn_s_sleep(1);
        if ((++sp & 255u) == 0u) { if (xb_ld(&bar[XB_TMO])) break; if (sp > XB_SPIN_CAP) { atomicAdd(&bar[XB_TMO], 1u); break; } }
    }
    nloc = mine > 0u ? mine : 1u; nx = cnt > 0u ? cnt : 1u;
}

__device__ __forceinline__ void xcd_barrier(const XcdBarrier& b) {
    asm volatile("s_waitcnt vmcnt(0)" ::: "memory");
    __syncthreads();
    if (threadIdx.x == 0) {
        unsigned* bar = b.bar;
        __builtin_amdgcn_s_waitcnt(0);
        unsigned nloc = b.st[0], nx = b.st[1];
        if (nloc == 0u) { xcd_barrier_complete(bar, b.x, nloc, nx); b.st[0] = nloc; b.st[1] = nx; }
        const unsigned old = xb_add(&bar[XB_XSUB(b.x)], 1u);
        const unsigned gen = old / nloc;
        if (old + 1u == (gen + 1u) * nloc) {
            __builtin_amdgcn_fence(__ATOMIC_RELEASE, "agent");
            asm volatile("s_waitcnt vmcnt(0)" ::: "memory");
            const unsigned og = xb_add(&bar[XB_TOP], 1u);
            const unsigned tg = og / nx;
            if (og + 1u == (tg + 1u) * nx) xb_add(&bar[XB_TOPGEN], 1u);
            else XB_SPIN(xb_ld(&bar[XB_TOPGEN]) == tg, bar);
            __builtin_amdgcn_fence(__ATOMIC_ACQUIRE, "agent");
            xb_add(&bar[XB_XGEN(b.x)], 1u);
            asm volatile("s_waitcnt vmcnt(0)" ::: "memory");
        } else {
            XB_SPIN(xb_ld(&bar[XB_XGEN(b.x)]) == gen, bar);
            __builtin_amdgcn_fence(__ATOMIC_ACQUIRE, "agent");
            asm volatile("s_waitcnt vmcnt(0)" ::: "memory");
        }
    }
    __syncthreads();
}

struct Frame {
    LAS unsigned char* lds;
    volatile LAS unsigned* MISC;
    gu32* ctl;
    int tid, lane, wave;
    int vcu, G;
    const float* in[26]; float* out; unsigned char* ws;
};
enum { I_X = 0, I_LN0G, I_LN0B, I_WIN, I_LBL, I_HGNG, I_ARE, I_AIM, I_LSTEP, I_BRE, I_BIM, I_CRE, I_CIM, I_DSK, I_WGLU, I_BGLU, I_WOUT, I_LN1G, I_LN1B, I_WQ, I_K1, I_K2, I_PD, I_PU, I_LN2G, I_LN2B };

__device__ __forceinline__ float bf2f(bf16 v) { return __builtin_bit_cast(float, (unsigned)v << 16); }
__device__ __forceinline__ float wave_sum(float v) {
#pragma unroll
    for (int o = 1; o < 64; o <<= 1) v += __shfl_xor(v, o);
    return v;
}
__device__ __forceinline__ float wave_max(float v) {
#pragma unroll
    for (int o = 1; o < 64; o <<= 1) v = fmaxf(v, __shfl_xor(v, o));
    return v;
}
__device__ __forceinline__ float gelu_tanh(float x) { const float y = 0.7978845608028654f * (x + 0.044715f * x * x * x); return x / (1.f + __expf(-2.f * y)); }
__device__ __forceinline__ float silu_f(float x) { return x / (1.f + __expf(-x)); }
__device__ __forceinline__ void unpack8(const v4u w, float (&f)[8]) {
    f[0] = __builtin_bit_cast(float, w.x << 16); f[1] = __builtin_bit_cast(float, w.x & 0xffff0000u);
    f[2] = __builtin_bit_cast(float, w.y << 16); f[3] = __builtin_bit_cast(float, w.y & 0xffff0000u);
    f[4] = __builtin_bit_cast(float, w.z << 16); f[5] = __builtin_bit_cast(float, w.z & 0xffff0000u);
    f[6] = __builtin_bit_cast(float, w.w << 16); f[7] = __builtin_bit_cast(float, w.w & 0xffff0000u);
}
__device__ __forceinline__ v4u pack8(const float (&f)[8]) { v4u w; w.x = pk2(f[0], f[1]); w.y = pk2(f[2], f[3]); w.z = pk2(f[4], f[5]); w.w = pk2(f[6], f[7]); return w; }

__device__ __forceinline__ void p0_transpose_item(const float* W, int K, int N, bf16* WT, int row_off, LAS float* scr, int item, int lane) {
    const int nblk = N / 32, kb = item / nblk, nb = item % nblk, k0 = 64 * kb, n0 = 32 * nb;
#pragma unroll 8
    for (int i = 0; i < 32; ++i) { const int kk = 2 * i + (lane >> 5); scr[kk * 33 + (lane & 31)] = W[(size_t)(k0 + kk) * N + n0 + (lane & 31)]; }
    LDS_WAIT(); asm volatile("" ::: "memory");
    const int c = lane & 7;
#pragma unroll
    for (int j = 0; j < 4; ++j) { const int n = (lane >> 3) + 8 * j; const LAS float* s = scr + (8 * c) * 33 + n;
        v4u o; o.x = pk2(s[0 * 33], s[1 * 33]); o.y = pk2(s[2 * 33], s[3 * 33]); o.z = pk2(s[4 * 33], s[5 * 33]); o.w = pk2(s[6 * 33], s[7 * 33]);
        *(GAS v4u*)(WT + (size_t)(row_off + n0 + n) * K + k0 + 8 * c) = o; }
    LDS_WAIT(); asm volatile("" ::: "memory");
}
__device__ __forceinline__ void ln0_row(const float* xrow, const float* g, const float* b, bf16* orow, int lane) {
    const GAS f32x4* xr = (const GAS f32x4*)xrow + lane;
    f32x4 v[4]; float s = 0.f;
#pragma unroll
    for (int j = 0; j < 4; ++j) { v[j] = xr[64 * j]; s += (v[j].x + v[j].y) + (v[j].z + v[j].w); }
    const float mean = wave_sum(s) * (1.f / D); float s2 = 0.f;
#pragma unroll
    for (int j = 0; j < 4; ++j) { v[j] = v[j] - mean; s2 += (v[j].x * v[j].x + v[j].y * v[j].y) + (v[j].z * v[j].z + v[j].w * v[j].w); }
    const float rstd = 1.f / sqrtf(wave_sum(s2) * (1.f / D) + LN_EPS);
    GAS unsigned long long* o8 = (GAS unsigned long long*)orow + lane;
#pragma unroll
    for (int j = 0; j < 4; ++j) { const f32x4 gg = ((const GAS f32x4*)g)[lane + 64 * j], bb = ((const GAS f32x4*)b)[lane + 64 * j];
        const f32x4 o = v[j] * rstd * gg + bb;
        o8[64 * j] = (unsigned long long)pk2(o.x, o.y) | ((unsigned long long)pk2(o.z, o.w) << 32); }
}
__device__ __forceinline__ void p0_prologue(Frame& F) {
    LAS float* scr = (LAS float*)(F.lds + RING_OFF + F.wave * 16384);
    const int gw = F.vcu * NWAVES + F.wave, NGW = F.G * NWAVES;
    unsigned char* ws = F.ws;
    constexpr int I_IN = (D / 64) * (NPROJ / 32), I_GLU = (512 / 64) * (512 / 32), I_OUT = (1024 / 64) * (1024 / 32), I_Q = (1024 / 64) * (2048 / 32);
    constexpr int NITEMS = I_IN + I_GLU + I_OUT + I_Q;
    for (int it = gw; it < NITEMS; it += NGW) {
        int r = it;
        if (r < I_IN) { p0_transpose_item(F.in[I_WIN], D, NPROJ, (bf16*)(ws + WS_WIN), 0, scr, r, F.lane); continue; } r -= I_IN;
        if (r < I_GLU) { p0_transpose_item(F.in[I_WGLU], 512, 512, (bf16*)(ws + WS_WGLU), 0, scr, r, F.lane); continue; } r -= I_GLU;
        if (r < I_OUT) { p0_transpose_item(F.in[I_WOUT], 1024, 1024, (bf16*)(ws + WS_WOUT), 0, scr, r, F.lane); continue; } r -= I_OUT;
        p0_transpose_item(F.in[I_WQ], 1024, 2048, (bf16*)(ws + WS_WQ), 0, scr, r, F.lane);
    }
    const int gt = gw * 64 + F.lane, NGT = NGW * 64;
    for (int i = gt; i < 2 * PK * PHALF; i += NGT) { const float v = (i < PK * PHALF) ? F.in[I_K1][i] : F.in[I_K2][i - PK * PHALF]; ((bf16*)(ws + WS_KEYS))[i] = (bf16)f2bf(v); }
    for (int i = gt; i < HGW; i += NGT) { const float l0 = F.in[I_LBL][i], l1 = F.in[I_LBL][HGW + i]; ((float*)(ws + WS_LB))[i] = 1.f / (1.f + expf(l1 - l0)); }
    for (int i = gt; i < S5G * S5N; i += NGT) { const int g = i / S5N;
        const float are = F.in[I_ARE][i], aim = F.in[I_AIM][i], step = expf(F.in[I_LSTEP][g]);
        const float zr = step * are, zi = step * aim, mag = expf(zr), cz = cosf(zi), sz = sinf(zi), sh = sinf(0.5f * zi);
        const float abr = mag * cz, abi = mag * sz;
        const float nre = expm1f(zr) * cz - 2.f * sh * sh, nim = abi;
        const float den = are * are + aim * aim;
        const float cre = (nre * are + nim * aim) / den, cim = (nim * are - nre * aim) / den;
        float* t = (float*)(ws + WS_S5T) + (size_t)i * 40; t[0] = abr; t[1] = abi;
        for (int p = 0; p < S5P; ++p) { const float br = F.in[I_BRE][(size_t)i * S5P + p], bi = F.in[I_BIM][(size_t)i * S5P + p];
            t[2 + p] = cre * br - cim * bi; t[18 + p] = cre * bi + cim * br; } }
    for (int i = gt; i < S5G * S5N * 33; i += NGT) { const int gn = i / 33, tau = i % 33, g = gn / S5N;
        const float step = expf(F.in[I_LSTEP][g]), zr = step * F.in[I_ARE][gn] * (float)tau, zi = step * F.in[I_AIM][gn] * (float)tau, mag = expf(zr);
        float* p = (float*)(ws + WS_PW) + (size_t)i * 2; p[0] = mag * cosf(zi); p[1] = mag * sinf(zi); }
    for (int m = gw; m < M; m += NGW) ln0_row(F.in[I_X] + (size_t)m * D, F.in[I_LN0G], F.in[I_LN0B], (bf16*)(ws + WS_H) + (size_t)m * D, F.lane);
}

__device__ __forceinline__ void hgrn2_seq(Frame& F, int bh) {
    const int b = bh >> 2, h = bh & 3, tid = F.tid, kq = tid >> 7, j = tid & 127;
    LAS float* sF = (LAS float*)(F.lds + RING_OFF);
    LAS float* sK = sF + 8 * 128; LAS float* sQ = sK + 8 * 128;
    LAS float* sO = sQ + 8 * 128;
    const bf16* Qb = (const bf16*)(F.ws + WS_PROJ); const bf16* LFb = Qb + (size_t)M * 512; const bf16* Vb = LFb + (size_t)M * 512; const bf16* Gb = Vb + (size_t)M * 512;
    bf16* MIX = (bf16*)(F.ws + WS_MIX);
    const float ng0 = F.in[I_HGNG][F.lane], ng1 = F.in[I_HGNG][F.lane + 64];
    float S[32];
#pragma unroll
    for (int k = 0; k < 32; ++k) S[k] = 0.f;
    for (int t0 = 0; t0 < SEQ; t0 += 8) {
        const size_t tok0 = (size_t)b * SEQ + t0;
#pragma unroll
        for (int r = 0; r < 2; ++r) { const int item = tid + 512 * r, tt = item >> 7, kk = item & 127; const size_t off = (tok0 + tt) * 512 + h * 128 + kk;
            const float lf = bf2f(LFb[off]); sF[tt * 128 + kk] = __expf(lf); sK[tt * 128 + kk] = -expm1f(lf); sQ[tt * 128 + kk] = bf2f(Qb[off]); }
        __syncthreads();
#pragma unroll 1
        for (int tt = 0; tt < 8; ++tt) { const float v = bf2f(Vb[(tok0 + tt) * 512 + h * 128 + j]); float o = 0.f;
            const LAS float* f = sF + tt * 128 + kq * 32; const LAS float* kx = sK + tt * 128 + kq * 32; const LAS float* q = sQ + tt * 128 + kq * 32;
#pragma unroll
            for (int k = 0; k < 32; ++k) { S[k] = f[k] * S[k] + kx[k] * v; o += q[k] * S[k]; }
            sO[(tt * 4 + kq) * 128 + j] = o; }
        __syncthreads();
        { const int tt = F.wave; const size_t tok = tok0 + tt;
            const float o0 = (sO[(tt * 4 + 0) * 128 + F.lane] + sO[(tt * 4 + 1) * 128 + F.lane]) + (sO[(tt * 4 + 2) * 128 + F.lane] + sO[(tt * 4 + 3) * 128 + F.lane]);
            const float o1 = (sO[(tt * 4 + 0) * 128 + 64 + F.lane] + sO[(tt * 4 + 1) * 128 + 64 + F.lane]) + (sO[(tt * 4 + 2) * 128 + 64 + F.lane] + sO[(tt * 4 + 3) * 128 + 64 + F.lane]);
            const float ss = wave_sum(o0 * o0 + o1 * o1), r = 1.f / sqrtf(ss * (1.f / 128.f) + RMS_EPS);
            const float g0 = bf2f(Gb[tok * 512 + h * 128 + F.lane]), g1 = bf2f(Gb[tok * 512 + h * 128 + 64 + F.lane]);
            MIX[tok * 1024 + h * 128 + F.lane] = (bf16)f2bf(o0 * r * ng0 * silu_f(g0));
            MIX[tok * 1024 + h * 128 + 64 + F.lane] = (bf16)f2bf(o1 * r * ng1 * silu_f(g1)); }
    }
    __syncthreads();
}
__device__ __forceinline__ void s5_seq(Frame& F, int pair) {
    const int b = pair >> 5, g = pair & 31, lane = F.lane;
    const float* tb = (const float*)(F.ws + WS_S5T) + (size_t)(g * S5N + lane) * 40;
    const float abr = tb[0], abi = tb[1];
    float bbr[16], bbi[16], cr[16], ci[16], dsk[16];
#pragma unroll
    for (int p = 0; p < 16; ++p) { bbr[p] = tb[2 + p]; bbi[p] = tb[18 + p]; cr[p] = F.in[I_CRE][(size_t)(g * 16 + p) * S5N + lane]; ci[p] = F.in[I_CIM][(size_t)(g * 16 + p) * S5N + lane];
        dsk[p] = (lane == 0) ? F.in[I_DSK][g * 16 + p] : 0.f; }
    const bf16* Ub = (const bf16*)(F.ws + WS_PROJ) + (size_t)4 * M * 512 + ((size_t)g * M + (size_t)b * SEQ) * 16;
    bf16* Zb = (bf16*)(F.ws + WS_Z) + (size_t)b * SEQ * 512 + g * 16;
    const int pme = ((lane >> 5) & 1) * 8 + ((lane >> 4) & 1) * 4 + ((lane >> 3) & 1) * 2 + ((lane >> 2) & 1);
    float xr = 0.f, xi = 0.f;
    v4u nu0 = *(const GAS v4u*)(Ub + (size_t)lane * 16), nu1 = *(const GAS v4u*)(Ub + (size_t)lane * 16 + 8);
    for (int t0 = 0; t0 < SEQ; t0 += 64) {
        const v4u u0 = nu0, u1 = nu1;
        if (t0 + 64 < SEQ) { nu0 = *(const GAS v4u*)(Ub + (size_t)(t0 + 64 + lane) * 16); nu1 = *(const GAS v4u*)(Ub + (size_t)(t0 + 64 + lane) * 16 + 8); }
#pragma unroll 1
        for (int tt = 0; tt < 64; ++tt) {
            v4u a, c;
            a.x = __builtin_amdgcn_readlane(u0.x, tt); a.y = __builtin_amdgcn_readlane(u0.y, tt); a.z = __builtin_amdgcn_readlane(u0.z, tt); a.w = __builtin_amdgcn_readlane(u0.w, tt);
            c.x = __builtin_amdgcn_readlane(u1.x, tt); c.y = __builtin_amdgcn_readlane(u1.y, tt); c.z = __builtin_amdgcn_readlane(u1.z, tt); c.w = __builtin_amdgcn_readlane(u1.w, tt);
            float u[16]; { float f0[8], f1[8]; unpack8(a, f0); unpack8(c, f1);
#pragma unroll
                for (int p = 0; p < 8; ++p) { u[p] = f0[p]; u[8 + p] = f1[p]; } }
            float bur = 0.f, bui = 0.f;
#pragma unroll
            for (int p = 0; p < 16; ++p) { bur += bbr[p] * u[p]; bui += bbi[p] * u[p]; }
            const float nxr = abr * xr - abi * xi + bur, nxi = abr * xi + abi * xr + bui; xr = nxr; xi = nxi;
            float r[16];
#pragma unroll
            for (int p = 0; p < 16; ++p) r[p] = cr[p] * xr - ci[p] * xi + dsk[p] * u[p];
#pragma unroll
            for (int i = 0; i < 8; ++i) { const float keep = (lane & 32) ? r[i + 8] : r[i], send = (lane & 32) ? r[i] : r[i + 8]; r[i] = keep + __shfl_xor(send, 32); }
#pragma unroll
            for (int i = 0; i < 4; ++i) { const float keep = (lane & 16) ? r[i + 4] : r[i], send = (lane & 16) ? r[i] : r[i + 4]; r[i] = keep + __shfl_xor(send, 16); }
#pragma unroll
            for (int i = 0; i < 2; ++i) { const float keep = (lane & 8) ? r[i + 2] : r[i], send = (lane & 8) ? r[i] : r[i + 2]; r[i] = keep + __shfl_xor(send, 8); }
            { const float keep = (lane & 4) ? r[1] : r[0], send = (lane & 4) ? r[0] : r[1]; r[0] = keep + __shfl_xor(send, 4); }
            r[0] += __shfl_xor(r[0], 2); r[0] += __shfl_xor(r[0], 1);
            if ((lane & 3) == 0) Zb[(size_t)(t0 + tt) * 512 + pme] = (bf16)f2bf(gelu_tanh(r[0]));
        }
    }
}

__device__ __forceinline__ int t256(int r, int c) { return r * 256 + ((((c >> 3) ^ (r & 15))) << 4) + (c & 7) * 2; }
__device__ __forceinline__ int t128(int r, int c) { return r * 128 + ((((c >> 3) ^ (r & 7))) << 4) + (c & 7) * 2; }
typedef unsigned v2u __attribute__((ext_vector_type(2)));
__device__ __forceinline__ void hgrn2_state_pass(Frame& F, int item) {
    const int bh = item >> 2, vs = item & 3, b = bh >> 2, h = bh & 3, tid = F.tid, lane = F.lane, w = F.wave, fr = lane & 15, fq = lane >> 4;
    const int kcol = tid & 127, qtr = tid >> 7, vv = tid & 31, sg = tid >> 5;
    LAS unsigned char* L = F.lds + RING_OFF;
    const bf16* LFb = (const bf16*)(F.ws + WS_PROJ) + (size_t)M * 512 + (size_t)b * SEQ * 512 + h * 128 + kcol;
    const bf16* Vb = (const bf16*)(F.ws + WS_PROJ) + (size_t)2 * M * 512 + (size_t)b * SEQ * 512 + h * 128 + vs * 32 + vv;
    bf16* SST = (bf16*)(F.ws + WS_SST) + (size_t)bh * 64 * 128 * 128;
    float S[2][4];
#pragma unroll
    for (int i = 0; i < 2; ++i)
#pragma unroll
        for (int r = 0; r < 4; ++r) S[i][r] = 0.f;
    bf16 lfn[16], vn[4];
#pragma unroll
    for (int j = 0; j < 16; ++j) lfn[j] = LFb[(size_t)(qtr * 16 + j) * 512];
#pragma unroll
    for (int j = 0; j < 4; ++j) vn[j] = Vb[(size_t)(sg * 4 + j) * 512];
    for (int c = 0; c < 64; ++c) {
        LAS unsigned char* Lb = L + (c & 1) * 24576;
        LAS unsigned char* sKT = Lb; LAS unsigned char* sVT = Lb + 16384; LAS float* sTot = (LAS float*)(Lb + 20480); LAS float* sDec = (LAS float*)(Lb + 22528);
        float lf[16]; bf16 vc[4];
#pragma unroll
        for (int j = 0; j < 16; ++j) lf[j] = bf2f(lfn[j]);
#pragma unroll
        for (int j = 0; j < 4; ++j) vc[j] = vn[j];
        if (c + 1 < 64) {
#pragma unroll
            for (int j = 0; j < 16; ++j) lfn[j] = LFb[(size_t)((c + 1) * 64 + qtr * 16 + j) * 512];
#pragma unroll
            for (int j = 0; j < 4; ++j) vn[j] = Vb[(size_t)((c + 1) * 64 + sg * 4 + j) * 512];
        }
        float cl[16]; float run = 0.f;
#pragma unroll
        for (int j = 0; j < 16; ++j) { run += lf[j]; cl[j] = run; }
        sTot[qtr * 128 + kcol] = run;
        __syncthreads();
        const float t0 = sTot[kcol], t1 = sTot[128 + kcol], t2 = sTot[256 + kcol], t3 = sTot[384 + kcol];
        const float off = (qtr > 0 ? t0 : 0.f) + (qtr > 1 ? t1 : 0.f) + (qtr > 2 ? t2 : 0.f), last = (t0 + t1) + (t2 + t3);
        float kh[16];
#pragma unroll
        for (int j = 0; j < 16; ++j) kh[j] = -expm1f(lf[j]) * __expf(last - (off + cl[j]));
        { const float a[8] = {kh[0], kh[1], kh[2], kh[3], kh[4], kh[5], kh[6], kh[7]}, bq[8] = {kh[8], kh[9], kh[10], kh[11], kh[12], kh[13], kh[14], kh[15]};
          *(LAS v4u*)(sKT + kcol * 128 + (((qtr * 2) ^ (kcol & 7)) << 4)) = pack8(a); *(LAS v4u*)(sKT + kcol * 128 + (((qtr * 2 + 1) ^ (kcol & 7)) << 4)) = pack8(bq); }
        if (qtr == 0) sDec[kcol] = __expf(last);
        { v2u pv; pv.x = (unsigned)vc[0] | ((unsigned)vc[1] << 16); pv.y = (unsigned)vc[2] | ((unsigned)vc[3] << 16);
          *(LAS v2u*)(sVT + vv * 128 + ((((sg >> 1) ^ (vv & 7))) << 4) + (sg & 1) * 8) = pv; }
        __syncthreads();
        f32x4 acc[2] = {(f32x4){0.f, 0.f, 0.f, 0.f}, (f32x4){0.f, 0.f, 0.f, 0.f}};
#pragma unroll
        for (int ks = 0; ks < 2; ++ks) { const int ch = ks * 4 + fq, row = 16 * w + fr;
            const bf16x8 af = *(const LAS bf16x8*)(sKT + row * 128 + ((ch ^ (row & 7)) << 4));
#pragma unroll
            for (int nt = 0; nt < 2; ++nt) { const int vr = 16 * nt + fr; const bf16x8 bfm = *(const LAS bf16x8*)(sVT + vr * 128 + ((ch ^ (vr & 7)) << 4));
                acc[nt] = __builtin_amdgcn_mfma_f32_16x16x32_bf16(af, bfm, acc[nt], 0, 0, 0); } }
        const int k0 = 16 * w + fq * 4; const f32x4 dec = *(const LAS f32x4*)(sDec + k0);
#pragma unroll
        for (int nt = 0; nt < 2; ++nt) { const int vg = vs * 32 + 16 * nt + fr;
            v2u o; o.x = pk2(S[nt][0], S[nt][1]); o.y = pk2(S[nt][2], S[nt][3]);
            *(GAS v2u*)(SST + ((size_t)c * 128 + vg) * 128 + k0) = o;
            S[nt][0] = dec[0] * S[nt][0] + acc[nt][0]; S[nt][1] = dec[1] * S[nt][1] + acc[nt][1]; S[nt][2] = dec[2] * S[nt][2] + acc[nt][2]; S[nt][3] = dec[3] * S[nt][3] + acc[nt][3]; }
    }
    __syncthreads();
}
__device__ __forceinline__ void hgrn2_out_item(Frame& F, int item) {
    const int bh = item >> 6, c = item & 63, b = bh >> 2, h = bh & 3, tid = F.tid, lane = F.lane, w = F.wave, fr = lane & 15, fq = lane >> 4;
    const int kcol = tid & 127, qtr = tid >> 7;
    LAS unsigned char* L = F.lds + RING_OFF;
    LAS unsigned char* sQt = L; LAS unsigned char* sQm = L + 16384; LAS unsigned char* sKm = L + 32768; LAS unsigned char* sVT = L + 49152; LAS unsigned char* sST = L + 65536; LAS unsigned char* sP = L + 98304;
    LAS float* sTot = (LAS float*)(L + 106496); LAS float* sSS = (LAS float*)(L + 108544);
    const size_t tok0 = (size_t)b * SEQ + (size_t)c * 64;
    const bf16* Qb = (const bf16*)(F.ws + WS_PROJ) + tok0 * 512 + h * 128; const bf16* LFb = Qb + (size_t)M * 512; const bf16* Vb = Qb + (size_t)2 * M * 512; const bf16* Gb = Qb + (size_t)3 * M * 512;
    const bf16* SST = (const bf16*)(F.ws + WS_SST) + (size_t)item * 128 * 128;
    bf16* MIX = (bf16*)(F.ws + WS_MIX) + tok0 * 1024 + h * 128;
    float lf[16], q[16]; bf16 vraw[16];
#pragma unroll
    for (int j = 0; j < 16; ++j) { lf[j] = bf2f(LFb[(size_t)(qtr * 16 + j) * 512 + kcol]); q[j] = bf2f(Qb[(size_t)(qtr * 16 + j) * 512 + kcol]); vraw[j] = Vb[(size_t)(qtr * 16 + j) * 512 + kcol]; }
    v4u st[4];
#pragma unroll
    for (int i = 0; i < 4; ++i) { const int idx = tid + 512 * i; st[i] = *(const GAS v4u*)(SST + (size_t)(idx >> 4) * 128 + (idx & 15) * 8); }
    float cl[16]; float run = 0.f;
#pragma unroll
    for (int j = 0; j < 16; ++j) { run += lf[j]; cl[j] = run; }
    sTot[qtr * 128 + kcol] = run;
    __syncthreads();
    { const float t0 = sTot[kcol], t1 = sTot[128 + kcol], t2 = sTot[256 + kcol];
      const float off = (qtr > 0 ? t0 : 0.f) + (qtr > 1 ? t1 : 0.f) + (qtr > 2 ? t2 : 0.f), mid = t0 + t1;
#pragma unroll
      for (int j = 0; j < 16; ++j) { const int s = qtr * 16 + j; const float cum = off + cl[j];
          const int o = t256(s, kcol);
          *(LAS bf16*)(sQt + o) = (bf16)f2bf(q[j] * __expf(cum));
          *(LAS bf16*)(sQm + o) = (bf16)f2bf(q[j] * __expf(cum - mid));
          *(LAS bf16*)(sKm + o) = (bf16)f2bf(-expm1f(lf[j]) * __expf(mid - cum)); }
      v4u p0, p1;
      p0.x = (unsigned)vraw[0] | ((unsigned)vraw[1] << 16); p0.y = (unsigned)vraw[2] | ((unsigned)vraw[3] << 16); p0.z = (unsigned)vraw[4] | ((unsigned)vraw[5] << 16); p0.w = (unsigned)vraw[6] | ((unsigned)vraw[7] << 16);
      p1.x = (unsigned)vraw[8] | ((unsigned)vraw[9] << 16); p1.y = (unsigned)vraw[10] | ((unsigned)vraw[11] << 16); p1.z = (unsigned)vraw[12] | ((unsigned)vraw[13] << 16); p1.w = (unsigned)vraw[14] | ((unsigned)vraw[15] << 16);
      *(LAS v4u*)(sVT + kcol * 128 + (((qtr * 2) ^ (kcol & 7)) << 4)) = p0; *(LAS v4u*)(sVT + kcol * 128 + (((qtr * 2 + 1) ^ (kcol & 7)) << 4)) = p1;
#pragma unroll
      for (int i = 0; i < 4; ++i) { const int idx = tid + 512 * i, v = idx >> 4, kc = idx & 15; *(LAS v4u*)(sST + v * 256 + ((kc ^ (v & 15)) << 4)) = st[i]; } }
    __syncthreads();
    const int tt = w >> 1, trow = 16 * tt + fr;
#pragma unroll
    for (int sti = 0; sti < 2; ++sti) { const int stl = (w & 1) * 2 + sti; f32x4 acc = (f32x4){0.f, 0.f, 0.f, 0.f};
        if (stl <= tt) {
#pragma unroll
            for (int ks = 0; ks < 4; ++ks) { const int ch = ks * 4 + fq, srow = 16 * stl + fr;
                const bf16x8 af = *(const LAS bf16x8*)(sKm + srow * 256 + ((ch ^ (srow & 15)) << 4));
                const bf16x8 bfm = *(const LAS bf16x8*)(sQm + trow * 256 + ((ch ^ (trow & 15)) << 4));
                acc = __builtin_amdgcn_mfma_f32_16x16x32_bf16(af, bfm, acc, 0, 0, 0); } }
        const int s0 = 16 * stl + fq * 4;
        const float p0 = (s0 + 0 <= trow) ? acc[0] : 0.f, p1 = (s0 + 1 <= trow) ? acc[1] : 0.f, p2 = (s0 + 2 <= trow) ? acc[2] : 0.f, p3 = (s0 + 3 <= trow) ? acc[3] : 0.f;
        v2u o; o.x = pk2(p0, p1); o.y = pk2(p2, p3);
        *(LAS v2u*)(sP + trow * 128 + ((((s0 >> 3) ^ (trow & 7))) << 4) + (s0 & 7) * 2) = o; }
    __syncthreads();
    f32x4 oacc[4];
#pragma unroll
    for (int i = 0; i < 4; ++i) oacc[i] = (f32x4){0.f, 0.f, 0.f, 0.f};
#pragma unroll
    for (int ks = 0; ks < 4; ++ks) { const int ch = ks * 4 + fq;
        const bf16x8 bfm = *(const LAS bf16x8*)(sQt + trow * 256 + ((ch ^ (trow & 15)) << 4));
#pragma unroll
        for (int i = 0; i < 4; ++i) { const int vr = 16 * ((w & 1) * 4 + i) + fr; const bf16x8 af = *(const LAS bf16x8*)(sST + vr * 256 + ((ch ^ (vr & 15)) << 4));
            oacc[i] = __builtin_amdgcn_mfma_f32_16x16x32_bf16(af, bfm, oacc[i], 0, 0, 0); } }
#pragma unroll
    for (int ks = 0; ks < 2; ++ks) { const int ch = ks * 4 + fq;
        const bf16x8 bfm = *(const LAS bf16x8*)(sP + trow * 128 + ((ch ^ (trow & 7)) << 4));
#pragma unroll
        for (int i = 0; i < 4; ++i) { const int vr = 16 * ((w & 1) * 4 + i) + fr; const bf16x8 af = *(const LAS bf16x8*)(sVT + vr * 128 + ((ch ^ (vr & 7)) << 4));
            oacc[i] = __builtin_amdgcn_mfma_f32_16x16x32_bf16(af, bfm, oacc[i], 0, 0, 0); } }
    float ss = 0.f;
#pragma unroll
    for (int i = 0; i < 4; ++i) ss += (oacc[i][0] * oacc[i][0] + oacc[i][1] * oacc[i][1]) + (oacc[i][2] * oacc[i][2] + oacc[i][3] * oacc[i][3]);
    ss += __shfl_xor(ss, 16); ss += __shfl_xor(ss, 32);
    if (fq == 0) sSS[(w & 1) * 64 + trow] = ss;
    __syncthreads();
    const float rinv = 1.f / sqrtf((sSS[trow] + sSS[64 + trow]) * (1.f / 128.f) + RMS_EPS);
#pragma unroll
    for (int i = 0; i < 4; ++i) { const int v0 = 16 * ((w & 1) * 4 + i) + fq * 4;
        const v2u gw2 = *(const GAS v2u*)(Gb + (size_t)trow * 512 + v0); const f32x4 ng = *(const GAS f32x4*)(F.in[I_HGNG] + v0);
        const float g0 = __builtin_bit_cast(float, gw2.x << 16), g1 = __builtin_bit_cast(float, gw2.x & 0xffff0000u), g2 = __builtin_bit_cast(float, gw2.y << 16), g3 = __builtin_bit_cast(float, gw2.y & 0xffff0000u);
        v2u o; o.x = pk2(oacc[i][0] * rinv * ng[0] * silu_f(g0), oacc[i][1] * rinv * ng[1] * silu_f(g1)); o.y = pk2(oacc[i][2] * rinv * ng[2] * silu_f(g2), oacc[i][3] * rinv * ng[3] * silu_f(g3));
        *(GAS v2u*)(MIX + (size_t)trow * 1024 + v0) = o; }
}

__device__ __forceinline__ void s5_tables_stage1(Frame& F) {
    const int gt = (F.vcu * NWAVES + F.wave) * 64 + F.lane, NGT = F.G * NWAVES * 64;
    const float* S5T = (const float*)(F.ws + WS_S5T); const float* PW = (const float*)(F.ws + WS_PW);
    float* KT = (float*)(F.ws + WS_KTAU); bf16* G5 = (bf16*)(F.ws + WS_G5); bf16* T5 = (bf16*)(F.ws + WS_T5);
    for (int i = gt; i < S5G * 32 * 256; i += NGT) { const int g = i >> 13, tau = (i >> 8) & 31, p = (i >> 4) & 15, q = i & 15;
        float acc = (tau == 0 && p == q) ? F.in[I_DSK][g * 16 + p] : 0.f;
        for (int n = 0; n < S5N; ++n) { const int gn = g * S5N + n;
            const float cr = F.in[I_CRE][(size_t)(g * 16 + p) * S5N + n], ci = F.in[I_CIM][(size_t)(g * 16 + p) * S5N + n];
            const float wr = PW[((size_t)gn * 33 + tau) * 2], wi = PW[((size_t)gn * 33 + tau) * 2 + 1];
            const float br = S5T[(size_t)gn * 40 + 2 + q], bi = S5T[(size_t)gn * 40 + 18 + q];
            const float er = cr * wr - ci * wi, ei = cr * wi + ci * wr;
            acc += er * br - ei * bi; }
        KT[i] = acc; }
    for (int i = gt; i < S5G * 256 * 64; i += NGT) { const int g = i >> 14, r = (i >> 6) & 255, kc = i & 63, sdx = kc >> 1, q0 = (kc & 1) * 8;
        float f[8];
        if (r < 128) { const int n = r & 63, gn = g * S5N + n; const float wr = PW[((size_t)gn * 33 + (31 - sdx)) * 2], wi = PW[((size_t)gn * 33 + (31 - sdx)) * 2 + 1];
#pragma unroll
            for (int j = 0; j < 8; ++j) { const float br = S5T[(size_t)gn * 40 + 2 + q0 + j], bi = S5T[(size_t)gn * 40 + 18 + q0 + j]; f[j] = (r < 64) ? (wr * br - wi * bi) : (wr * bi + wi * br); }
        } else {
#pragma unroll
            for (int j = 0; j < 8; ++j) f[j] = 0.f; }
        *(GAS v4u*)(G5 + ((size_t)(g * 256 + r)) * 512 + kc * 8) = pack8(f); }
    for (int i = gt; i < S5G * 512 * 16; i += NGT) { const int g = i >> 13, row = (i >> 4) & 511, nc = i & 15, t = row >> 4, p = row & 15, im = nc >> 3, n0 = (nc & 7) * 8;
        float f[8];
#pragma unroll
        for (int j = 0; j < 8; ++j) { const int n = n0 + j, gn = g * S5N + n;
            const float cr = F.in[I_CRE][(size_t)(g * 16 + p) * S5N + n], ci = F.in[I_CIM][(size_t)(g * 16 + p) * S5N + n];
            const float wr = PW[((size_t)gn * 33 + t + 1) * 2], wi = PW[((size_t)gn * 33 + t + 1) * 2 + 1];
            f[j] = im ? -(cr * wi + ci * wr) : (cr * wr - ci * wi); }
        *(GAS v4u*)(T5 + ((size_t)(g * 512 + row)) * 640 + 512 + nc * 8) = pack8(f); }
}
__device__ __forceinline__ void s5_tables_stage2(Frame& F) {
    const int gt = (F.vcu * NWAVES + F.wave) * 64 + F.lane, NGT = F.G * NWAVES * 64;
    const float* KT = (const float*)(F.ws + WS_KTAU); bf16* T5 = (bf16*)(F.ws + WS_T5);
    for (int i = gt; i < S5G * 512 * 64; i += NGT) { const int g = i >> 15, row = (i >> 6) & 511, kc = i & 63, t = row >> 4, p = row & 15, sdx = kc >> 1, q0 = (kc & 1) * 8;
        float f[8];
        if (sdx <= t) { const float* k = KT + (((size_t)g * 32 + (t - sdx)) * 16 + p) * 16 + q0;
#pragma unroll
            for (int j = 0; j < 8; ++j) f[j] = k[j];
        } else {
#pragma unroll
            for (int j = 0; j < 8; ++j) f[j] = 0.f; }
        *(GAS v4u*)(T5 + ((size_t)(g * 512 + row)) * 640 + kc * 8) = pack8(f); }
}
__device__ __forceinline__ void s5_scan(Frame& F, int idx) {
    const int b = idx >> 11, g = (idx >> 6) & 31, n = idx & 63;
    const float* PW = (const float*)(F.ws + WS_PW); const float* XL = (const float*)(F.ws + WS_XLOC); bf16* A5 = (bf16*)(F.ws + WS_A5);
    const float ar = PW[((size_t)(g * S5N + n) * 33 + 32) * 2], ai = PW[((size_t)(g * S5N + n) * 33 + 32) * 2 + 1];
    float xr = 0.f, xi = 0.f;
    for (int c0 = 0; c0 < 128; c0 += 8) {
        float lr[8], li[8];
#pragma unroll
        for (int j = 0; j < 8; ++j) { const float* p = XL + ((size_t)(b * 128 + c0 + j) * 32 + g) * 128 + n; lr[j] = p[0]; li[j] = p[64]; }
#pragma unroll
        for (int j = 0; j < 8; ++j) { bf16* o = A5 + ((size_t)g * S5I + b * 128 + c0 + j) * 640 + 512 + n; o[0] = (bf16)f2bf(xr); o[64] = (bf16)f2bf(xi);
            const float nr = ar * xr - ai * xi + lr[j], ni = ar * xi + ai * xr + li[j]; xr = nr; xi = ni; }
    }
}

__device__ __forceinline__ void ln1_row(bf16* row, const float* g, const float* b, int lane) {
    const v4u w0 = *(const GAS v4u*)(row + lane * 8), w1 = *(const GAS v4u*)(row + 512 + lane * 8);
    float a[8], c[8]; unpack8(w0, a); unpack8(w1, c);
    float s = 0.f;
#pragma unroll
    for (int j = 0; j < 8; ++j) s += a[j] + c[j];
    const float mean = wave_sum(s) * (1.f / D); float s2 = 0.f;
#pragma unroll
    for (int j = 0; j < 8; ++j) { a[j] -= mean; c[j] -= mean; s2 += a[j] * a[j] + c[j] * c[j]; }
    const float rstd = 1.f / sqrtf(wave_sum(s2) * (1.f / D) + LN_EPS);
    const f32x4 g0 = *(const GAS f32x4*)(g + lane * 8), g1 = *(const GAS f32x4*)(g + lane * 8 + 4), g2 = *(const GAS f32x4*)(g + 512 + lane * 8), g3 = *(const GAS f32x4*)(g + 512 + lane * 8 + 4);
    const f32x4 b0 = *(const GAS f32x4*)(b + lane * 8), b1 = *(const GAS f32x4*)(b + lane * 8 + 4), b2 = *(const GAS f32x4*)(b + 512 + lane * 8), b3 = *(const GAS f32x4*)(b + 512 + lane * 8 + 4);
    const float gg0[8] = {g0.x, g0.y, g0.z, g0.w, g1.x, g1.y, g1.z, g1.w}, gg1[8] = {g2.x, g2.y, g2.z, g2.w, g3.x, g3.y, g3.z, g3.w};
    const float bb0[8] = {b0.x, b0.y, b0.z, b0.w, b1.x, b1.y, b1.z, b1.w}, bb1[8] = {b2.x, b2.y, b2.z, b2.w, b3.x, b3.y, b3.z, b3.w};
#pragma unroll
    for (int j = 0; j < 8; ++j) { a[j] = a[j] * rstd * gg0[j] + bb0[j]; c[j] = c[j] * rstd * gg1[j] + bb1[j]; }
    *(GAS v4u*)(row + lane * 8) = pack8(a); *(GAS v4u*)(row + 512 + lane * 8) = pack8(c);
}

typedef float f32x16 __attribute__((ext_vector_type(16)));
__device__ __forceinline__ int f2ord(float f) { const int x = __builtin_bit_cast(int, f); return x ^ ((x >> 31) & 0x7fffffff); }
__device__ __forceinline__ float ord2f(int x) { return __builtin_bit_cast(float, x ^ ((x >> 31) & 0x7fffffff)); }
#define CE_DESC(a, b) do { const int _h = max((a), (b)), _l = min((a), (b)); (a) = _h; (b) = _l; } while (0)
__device__ __forceinline__ void sort16_desc(int (&v)[16]) {
#pragma unroll
    for (int k = 2; k <= 16; k <<= 1)
#pragma unroll
        for (int j = k >> 1; j > 0; j >>= 1)
#pragma unroll
            for (int i = 0; i < 16; ++i) { const int l = i ^ j; if (l > i) { if ((i & k) == 0) CE_DESC(v[i], v[l]); else CE_DESC(v[l], v[i]); } }
}
__device__ __forceinline__ void merge16_desc(int (&a)[16], const int (&b)[16]) {
#pragma unroll
    for (int i = 0; i < 16; ++i) a[i] = max(a[i], b[15 - i]);
#pragma unroll
    for (int j = 8; j > 0; j >>= 1)
#pragma unroll
        for (int i = 0; i < 16; ++i) { const int l = i ^ j; if (l > i) CE_DESC(a[i], a[l]); }
}
__device__ __forceinline__ void peer_topk_side(const f32x16 (&acc)[4], int hi, int (&top)[16]) {
    int t[4][16];
#pragma unroll
    for (int kt = 0; kt < 4; ++kt)
#pragma unroll
        for (int j = 0; j < 16; ++j) { const unsigned key = (unsigned)(kt * 32 + (j & 3) + 8 * (j >> 2)) | (unsigned)(4 * hi);
            const float av = acc[kt][j];
            t[kt][j] = f2ord(__builtin_bit_cast(float, (__builtin_bit_cast(unsigned, av) & 0xFFFFFF80u) | key)); }
    sort16_desc(t[0]); sort16_desc(t[1]); sort16_desc(t[2]); sort16_desc(t[3]);
    merge16_desc(t[0], t[1]); merge16_desc(t[2], t[3]); merge16_desc(t[0], t[2]);
    int p[16];
#pragma unroll
    for (int i = 0; i < 16; ++i) p[i] = __shfl_xor(t[0][i], 32);
    merge16_desc(t[0], p);
#pragma unroll
    for (int i = 0; i < 16; ++i) top[i] = t[0][i];
}
__device__ __forceinline__ void peer_score_phase(Frame& F) {
    LAS unsigned char* kl = F.lds + RING_OFF;
    LAS unsigned* look = (LAS unsigned*)(F.lds + RING_OFF + 65536 + F.wave * 8192);
    const bf16* keys = (const bf16*)(F.ws + WS_KEYS);
    for (int i = F.tid; i < 2 * 128 * 16; i += NWAVES * 64) { const int sn = i >> 4, c = i & 15, n = sn & 127;
        *(LAS v4u*)(kl + sn * 256 + ((c ^ (n & 15)) << 4)) = *(const GAS v4u*)(keys + (size_t)sn * 128 + c * 8); }
    __syncthreads();
    const int gw = F.vcu * NWAVES + F.wave, NGW = F.G * NWAVES, lane = F.lane, r32 = lane & 31, hi = lane >> 5;
    const bf16* Q2 = (const bf16*)(F.ws + WS_Q2);
    int* EIDX = (int*)(F.ws + WS_EIDX); float* EGATE = (float*)(F.ws + WS_EGATE);
    for (int unit = gw; unit < (M / 32) * PH; unit += NGW) {
        const int blk = unit >> 3, h = unit & 7; const size_t tok = (size_t)blk * 32 + r32;
        const bf16* qrow = Q2 + tok * NQ2 + h * PQ + hi * 8;
        int top1[16], top2[16];
#pragma unroll
        for (int s = 0; s < 2; ++s) {
            bf16x8 qf[8];
#pragma unroll
            for (int ks = 0; ks < 8; ++ks) qf[ks] = *(const GAS bf16x8*)(qrow + s * 128 + ks * 16);
            f32x16 acc[4];
#pragma unroll
            for (int kt = 0; kt < 4; ++kt) { acc[kt] = (f32x16){0.f, 0.f, 0.f, 0.f, 0.f, 0.f, 0.f, 0.f, 0.f, 0.f, 0.f, 0.f, 0.f, 0.f, 0.f, 0.f};
                const int n = kt * 32 + r32;
#pragma unroll
                for (int ks = 0; ks < 8; ++ks) { const bf16x8 kf = *(const LAS bf16x8*)(kl + (s * 128 + n) * 256 + (((2 * ks + hi) ^ (n & 15)) << 4));
                    acc[kt] = __builtin_amdgcn_mfma_f32_32x32x16_bf16(kf, qf[ks], acc[kt], 0, 0, 0); } }
            if (s == 0) peer_topk_side(acc, hi, top1); else peer_topk_side(acc, hi, top2);
        }
        float v1[16], v2[16];
#pragma unroll
        for (int i = 0; i < 16; ++i) { v1[i] = ord2f(top1[i]); v2[i] = ord2f(top2[i]);
            look[i * 64 + lane] = __builtin_bit_cast(unsigned, v1[i]) & 0x7Fu; look[(16 + i) * 64 + lane] = __builtin_bit_cast(unsigned, v2[i]) & 0x7Fu; }
        int c[4][16]; int nc = 0;
#pragma unroll
        for (int i = 0; i < 16; ++i)
#pragma unroll
            for (int j = 0; j < 16; ++j) if ((i + 1) * (j + 1) <= 16) { const float sum = v1[i] + v2[j];
                c[nc >> 4][nc & 15] = f2ord(__builtin_bit_cast(float, (__builtin_bit_cast(unsigned, sum) & 0xFFFFFF00u) | (unsigned)(i * 16 + j))); ++nc; }
#pragma unroll
        for (int q = 50; q < 64; ++q) c[q >> 4][q & 15] = (int)0x80000000;
        sort16_desc(c[0]); sort16_desc(c[1]); sort16_desc(c[2]); sort16_desc(c[3]);
        merge16_desc(c[0], c[1]); merge16_desc(c[2], c[3]); merge16_desc(c[0], c[2]);
        float e[16], sum = 0.f;
        float cf[16];
#pragma unroll
        for (int k = 0; k < 16; ++k) cf[k] = ord2f(c[0][k]);
#pragma unroll
        for (int k = 0; k < 16; ++k) { e[k] = __expf(cf[k] - cf[0]); sum += e[k]; }
        const float inv = 1.f / sum;
        LDS_WAIT();
        int ex[8]; float gt[8];
#pragma unroll
        for (int k = 0; k < 8; ++k) { const float cv = hi ? cf[8 + k] : cf[k]; gt[k] = (hi ? e[8 + k] : e[k]) * inv;
            const unsigned pos = __builtin_bit_cast(unsigned, cv) & 0xFFu;
            ex[k] = (int)(look[(pos >> 4) * 64 + lane] * PK + look[(16 + (pos & 15)) * 64 + lane]); }
        int* eo = EIDX + (tok * PH + h) * 16 + hi * 8; float* go = EGATE + (tok * PH + h) * 16 + hi * 8;
        *(GAS v4u*)eo = (v4u){(unsigned)ex[0], (unsigned)ex[1], (unsigned)ex[2], (unsigned)ex[3]}; *(GAS v4u*)(eo + 4) = (v4u){(unsigned)ex[4], (unsigned)ex[5], (unsigned)ex[6], (unsigned)ex[7]};
        *(GAS f32x4*)go = (f32x4){gt[0], gt[1], gt[2], gt[3]}; *(GAS f32x4*)(go + 4) = (f32x4){gt[4], gt[5], gt[6], gt[7]};
        LDS_WAIT();
    }
}

__device__ __forceinline__ void peer_gather_phase(Frame& F) {
    const int gw = F.vcu * NWAVES + F.wave, NGW = F.G * NWAVES, lane = F.lane;
    const bf16* H1 = (const bf16*)(F.ws + WS_H); const bf16* PD = (const bf16*)(F.ws + WS_PD); const bf16* PU = (const bf16*)(F.ws + WS_PU);
    const int* EIDX = (const int*)(F.ws + WS_EIDX); const float* EGATE = (const float*)(F.ws + WS_EGATE);
    const int rep = ((lane >> 5) & 1) * 4 + ((lane >> 4) & 1) * 2 + ((lane >> 3) & 1);
    for (int tok = gw; tok < M; tok += NGW) {
        float x0[8], x1[8]; unpack8(*(const GAS v4u*)(H1 + (size_t)tok * D + lane * 8), x0); unpack8(*(const GAS v4u*)(H1 + (size_t)tok * D + 512 + lane * 8), x1);
        const int e0 = EIDX[(size_t)tok * 128 + lane], e1 = EIDX[(size_t)tok * 128 + 64 + lane];
        const float g0 = EGATE[(size_t)tok * 128 + lane], g1 = EGATE[(size_t)tok * 128 + 64 + lane];
        float o0[8], o1[8];
#pragma unroll
        for (int j = 0; j < 8; ++j) { o0[j] = 0.f; o1[j] = 0.f; }
#pragma unroll 1
        for (int bt = 0; bt < 16; ++bt) {
            const int ev = (bt < 8) ? e0 : e1; const float gv = (bt < 8) ? g0 : g1; const int lb8 = (bt & 7) * 8;
            v4u dw[8][2], uw[8][2];
#pragma unroll
            for (int i = 0; i < 8; ++i) { const int e = __builtin_amdgcn_readlane(ev, lb8 + i);
                const bf16* dr = PD + (size_t)e * D; const bf16* ur = PU + (size_t)e * D;
                dw[i][0] = *(const GAS v4u*)(dr + lane * 8); dw[i][1] = *(const GAS v4u*)(dr + 512 + lane * 8);
                uw[i][0] = *(const GAS v4u*)(ur + lane * 8); uw[i][1] = *(const GAS v4u*)(ur + 512 + lane * 8); }
            float p[8];
#pragma unroll
            for (int i = 0; i < 8; ++i) { float a[8], c[8]; unpack8(dw[i][0], a); unpack8(dw[i][1], c); float s = 0.f;
#pragma unroll
                for (int j = 0; j < 8; ++j) s += a[j] * x0[j] + c[j] * x1[j];
                p[i] = s; }
#pragma unroll
            for (int i = 0; i < 4; ++i) { const float keep = (lane & 32) ? p[i + 4] : p[i], send = (lane & 32) ? p[i] : p[i + 4]; p[i] = keep + __shfl_xor(send, 32); }
#pragma unroll
            for (int i = 0; i < 2; ++i) { const float keep = (lane & 16) ? p[i + 2] : p[i], send = (lane & 16) ? p[i] : p[i + 2]; p[i] = keep + __shfl_xor(send, 16); }
            { const float keep = (lane & 8) ? p[1] : p[0], send = (lane & 8) ? p[0] : p[1]; p[0] = keep + __shfl_xor(send, 8); }
            p[0] += __shfl_xor(p[0], 4); p[0] += __shfl_xor(p[0], 2); p[0] += __shfl_xor(p[0], 1);
            const float gate = __shfl(gv, lb8 + rep);
            const float act = gelu_tanh(p[0]) * gate;
#pragma unroll
            for (int i = 0; i < 8; ++i) { const float af = __builtin_bit_cast(float, __builtin_amdgcn_readlane(__builtin_bit_cast(int, act), ((i >> 2) & 1) * 32 + ((i >> 1) & 1) * 16 + (i & 1) * 8));
                float a[8], c[8]; unpack8(uw[i][0], a); unpack8(uw[i][1], c);
#pragma unroll
                for (int j = 0; j < 8; ++j) { o0[j] += af * a[j]; o1[j] += af * c[j]; } }
        }
        float s = 0.f;
#pragma unroll
        for (int j = 0; j < 8; ++j) { o0[j] += DN_ALPHA * x0[j]; o1[j] += DN_ALPHA * x1[j]; s += o0[j] + o1[j]; }
        const float mean = wave_sum(s) * (1.f / D); float s2 = 0.f;
#pragma unroll
        for (int j = 0; j < 8; ++j) { o0[j] -= mean; o1[j] -= mean; s2 += o0[j] * o0[j] + o1[j] * o1[j]; }
        const float rstd = 1.f / sqrtf(wave_sum(s2) * (1.f / D) + LN_EPS);
        const float* g = F.in[I_LN2G]; const float* b = F.in[I_LN2B];
        float* orow = F.out + (size_t)tok * D;
#pragma unroll
        for (int q = 0; q < 2; ++q) { const int c0 = lane * 8 + 4 * q;
            const f32x4 ga = *(const GAS f32x4*)(g + c0), ba = *(const GAS f32x4*)(b + c0), gb = *(const GAS f32x4*)(g + 512 + c0), bb = *(const GAS f32x4*)(b + 512 + c0);
            f32x4 ya, yb;
            ya.x = o0[4 * q + 0] * rstd * ga.x + ba.x; ya.y = o0[4 * q + 1] * rstd * ga.y + ba.y; ya.z = o0[4 * q + 2] * rstd * ga.z + ba.z; ya.w = o0[4 * q + 3] * rstd * ga.w + ba.w;
            yb.x = o1[4 * q + 0] * rstd * gb.x + bb.x; yb.y = o1[4 * q + 1] * rstd * gb.y + bb.y; yb.z = o1[4 * q + 2] * rstd * gb.z + bb.z; yb.w = o1[4 * q + 3] * rstd * gb.w + bb.w;
            *(GAS f32x4*)(orow + c0) = ya; *(GAS f32x4*)(orow + 512 + c0) = yb; }
    }
}

struct Args { const float* in[26]; float* out; unsigned char* ws; int ph_lo, ph_hi, li, pad; };
__global__ void __launch_bounds__(NWAVES * 64, 2) fwd_kernel(Args args) {
    extern __shared__ __attribute__((aligned(16))) unsigned char lds[];
    Frame F;
    F.lds = (LAS unsigned char*)lds;
    F.MISC = (volatile LAS unsigned*)(F.lds + MISC_OFF);
    F.tid = threadIdx.x; F.lane = F.tid & 63; F.wave = __builtin_amdgcn_readfirstlane(F.tid >> 6);
    F.G = gridDim.x; { const int bx = blockIdx.x; F.vcu = (F.G % 8 == 0) ? (bx % 8) * (F.G / 8) + bx / 8 : bx; }
#pragma unroll
    for (int i = 0; i < 26; ++i) F.in[i] = args.in[i];
    F.out = args.out; F.ws = args.ws;
    unsigned char* ws = args.ws;
    F.ctl = (gu32*)(ws + WS_CTL);
    for (int u = F.tid; u < (LDS_BYTES - LDSCTL_OFF) / 4; u += NWAVES * 64) ((LAS unsigned*)(F.lds + LDSCTL_OFF))[u] = 0u;
    __syncthreads();
    XcdBarrier bar; bar.bar = (unsigned*)(F.ctl + CW_BAR); bar.x = 0; bar.st = nullptr;
    if (N_LAUNCHES == 1) bar = xcd_barrier_post((unsigned*)(F.ctl + CW_BAR), F.MISC + 8);
#define GRID_BAR() do { if (N_LAUNCHES == 1) xcd_barrier(bar); } while (0)
    const int lo = args.ph_lo, hi = args.ph_hi;
#define IN(k) (lo <= (k) && (k) < hi)
#define BOTH(k) (IN(k) && IN((k) + 1))
    bf16* const Hb = (bf16*)(ws + WS_H);
    bf16* const PRJ = (bf16*)(ws + WS_PROJ);

    if (IN(0)) { p0_prologue(F); if (BOTH(0)) GRID_BAR(); }

    if (IN(1)) {
        s5_tables_stage1(F);
        pg8::Gemm g{Hb, (const bf16*)(ws + WS_WIN), M, NPROJ, D, D, D}; pg8::StaticOrder S; S.init(M, NPROJ, F.G, (int)blockIdx.x);
        pg8::EpiProj E{PRJ, PRJ + (size_t)M * 512, PRJ + (size_t)2 * M * 512, PRJ + (size_t)3 * M * 512, (bf16*)(ws + WS_A5), (const float*)(ws + WS_LB), M};
        pg8::gemm_phase<pg8::EpiProj, pg8::StaticOrder, true, true>(F.lds + RING_OFF, g, S, E);
        if (BOTH(1)) GRID_BAR();
    }

    if (IN(2)) {
        s5_tables_stage2(F);
        if (F.vcu < 128) hgrn2_state_pass(F, F.vcu);
        else { pg8::Gemm g{(const bf16*)(ws + WS_A5), (const bf16*)(ws + WS_G5), 32 * S5I, 32 * 256, 512, S5K, 512}; pg8::GroupedOrder S{4, 1, F.G - 128, F.vcu - 128};
            pg8::EpiS5A E{(float*)(ws + WS_XLOC)};
            pg8::gemm_phase<pg8::EpiS5A, pg8::GroupedOrder, true, true>(F.lds + RING_OFF, g, S, E); }
        if (BOTH(2)) GRID_BAR();
    }

    if (IN(3)) {
        if (F.vcu < 32) s5_scan(F, F.vcu * 512 + F.tid);
        for (int it = F.vcu; it < 32 * 64; it += F.G) { hgrn2_out_item(F, it); __syncthreads(); }
        if (BOTH(3)) GRID_BAR();
    }

    if (IN(4)) {
        pg8::Gemm g{(const bf16*)(ws + WS_A5), (const bf16*)(ws + WS_T5), 32 * S5I, 32 * 512, S5K, S5K, S5K}; pg8::GroupedOrder S{4, 2, F.G, F.vcu};
        pg8::EpiS5C E{(bf16*)(ws + WS_Z)};
        pg8::gemm_phase<pg8::EpiS5C, pg8::GroupedOrder, true, true>(F.lds + RING_OFF, g, S, E);
        if (BOTH(4)) GRID_BAR();
    }

    if (IN(5)) {
        pg8::Gemm g{(const bf16*)(ws + WS_Z), (const bf16*)(ws + WS_WGLU), M, 512, 512, 512, 512}; pg8::StaticOrder S; S.init(M, 512, F.G, (int)blockIdx.x);
        pg8::EpiGlu E{(const bf16*)(ws + WS_Z), (bf16*)(ws + WS_MIX), F.in[I_BGLU]};
        pg8::gemm_phase<pg8::EpiGlu, pg8::StaticOrder, true, true>(F.lds + RING_OFF, g, S, E);
        if (BOTH(5)) GRID_BAR();
    }

    if (IN(6)) {
        pg8::Gemm g{(const bf16*)(ws + WS_MIX), (const bf16*)(ws + WS_WOUT), M, D, D, D, D}; pg8::StaticOrder S; S.init(M, D, F.G, (int)blockIdx.x);
        pg8::EpiOut E{Hb, DN_ALPHA};
        pg8::gemm_phase<pg8::EpiOut, pg8::StaticOrder, true, true>(F.lds + RING_OFF, g, S, E);
        if (BOTH(6)) GRID_BAR();
    }

    if (IN(7)) {
        const int gw = F.vcu * NWAVES + F.wave, NGW = F.G * NWAVES;
        for (int m = gw; m < M; m += NGW) ln1_row(Hb + (size_t)m * D, F.in[I_LN1G], F.in[I_LN1B], F.lane);
        { const int gt = gw * 64 + F.lane, NGT = NGW * 64;
          constexpr int NTAB8 = PE * D / 8;
          for (int i = gt; i < 2 * NTAB8; i += NGT) { const bool up = i >= NTAB8; const int j = up ? i - NTAB8 : i; const float* src = (up ? F.in[I_PU] : F.in[I_PD]) + (size_t)j * 8;
        const f32x4 a = *(const GAS f32x4*)src, b = *(const GAS f32x4*)(src + 4);
        v4u o; o.x = pk2(a.x, a.y); o.y = pk2(a.z, a.w); o.z = pk2(b.x, b.y); o.w = pk2(b.z, b.w);
        *(GAS v4u*)((bf16*)(ws + (up ? WS_PU : WS_PD)) + (size_t)j * 8) = o; }
        }
        if (BOTH(7)) GRID_BAR();
    }

    if (IN(8)) {
        pg8::Gemm g{Hb, (const bf16*)(ws + WS_WQ), M, NQ2, D, D, D}; pg8::StaticOrder S; S.init(M, NQ2, F.G, (int)blockIdx.x);
        pg8::EpiStore E{(bf16*)(ws + WS_Q2), NQ2};
        pg8::gemm_phase<pg8::EpiStore, pg8::StaticOrder, true, true>(F.lds + RING_OFF, g, S, E);
        if (BOTH(8)) GRID_BAR();
    }

    if (IN(9)) { peer_score_phase(F); if (BOTH(9)) GRID_BAR(); }

    if (IN(10)) { peer_gather_phase(F); }
#undef IN
#undef BOTH
}

extern "C" void kernel_launch(void* const* d_in, const int* in_sizes, int n_in, void* d_out, int out_size, void* d_ws, size_t ws_size, hipStream_t stream) {
    static int grid = 0;
    if (grid == 0) {
        if (n_in != 26 || in_sizes[0] != M * D || out_size != M * D || ws_size < WS_END) { fprintf(stderr, "kernel_launch: unexpected shapes: n_in %d in0 %d out %d ws %zu (need %zu)\n", n_in, n_in > 0 ? in_sizes[0] : -1, out_size, ws_size, (size_t)WS_END); grid = -1; return; }
        int dev = 0, cus = 0;
        if (hipGetDevice(&dev) != hipSuccess || hipDeviceGetAttribute(&cus, hipDeviceAttributeMultiprocessorCount, dev) != hipSuccess) { grid = -1; return; }
        if (hipFuncSetAttribute((const void*)fwd_kernel, hipFuncAttributeMaxDynamicSharedMemorySize, LDS_BYTES) != hipSuccess) { fprintf(stderr, "kernel_launch: hipFuncSetAttribute failed\n"); grid = -1; return; }
        (void)hipGetLastError();
        grid = cus;
    }
    if (grid < 0) return;
    if (hipMemsetAsync((char*)d_ws + WS_CTL, 0, CTL_ZERO_BYTES, stream) != hipSuccess) return;
    Args a{};
    for (int i = 0; i < 26; ++i) a.in[i] = (const float*)d_in[i];
    a.out = (float*)d_out; a.ws = (unsigned char*)d_ws;
    if (N_LAUNCHES == 1) { a.ph_lo = 0; a.ph_hi = NPH; a.li = 0; hipLaunchKernelGGL(fwd_kernel, dim3(grid), dim3(NWAVES * 64), LDS_BYTES, stream, a); }
    else for (int li = 0; li < NPH; ++li) { a.ph_lo = li; a.ph_hi = li + 1; a.li = li; hipLaunchKernelGGL(fwd_kernel, dim3(grid), dim3(NWAVES * 64), LDS_BYTES, stream, a); }
}
```

```cpp
#include <hip/hip_runtime.h>
#include <cstdio>
#include <cstdint>
namespace pg8 {
#define PG8_LAS __attribute__((address_space(3)))
typedef unsigned short bf16_t;
typedef short bf16x8 __attribute__((ext_vector_type(8)));
typedef float f32x4 __attribute__((ext_vector_type(4)));
typedef unsigned u32x4 __attribute__((ext_vector_type(4)));
constexpr int BM = 256, BK = 64, HALF = 128, HTB = HALF * BK * 2  , STAGE_BYTES = 8 * HTB, NXCD = 8, WGM = 8;

__host__ __device__ __forceinline__ int lds_byte(int r, int c) { const int st = (r >> 4) * 2 + (c >> 5), rr = r & 15, cc = c & 31, ob = rr * 64 + cc * 2; return st * 1024 + (ob ^ (((ob >> 9) & 1) << 5)); }
__host__ __device__ __forceinline__ void stage_rc(int b, int& R, int& C) { const int st = b / 1024, sb = b % 1024, swz = sb ^ (((sb >> 9) & 1) << 5); R = (st >> 1) * 16 + swz / 64; C = (st & 1) * 32 + (swz % 64) / 2; }
__host__ __device__ __forceinline__ int perm32(int rho) { const int n = rho >> 4, i = rho & 15; return 8 * (i >> 2) + 4 * n + (i & 3); }

struct Unit { int pm, pn; };
struct Gemm { const bf16_t* A; const bf16_t* Bt; int M, N, K, lda, ldb; };

struct StaticOrder {
    int nM, nN, nwg, G, c;
    __host__ __device__ void init(int M, int N, int G_, int c_) { nM = M / BM; nN = N / BM; nwg = nM * nN; G = G_; c = c_; }
    __host__ __device__ bool next(int i, Unit& u) const {
        const long L = (long)i * G + c; if (L >= nwg) return false;
        int wgid = (int)L; { const int q = nwg / NXCD, r = nwg % NXCD, xcd = wgid % NXCD, off = wgid / NXCD; wgid = (xcd < r ? xcd * (q + 1) : r * (q + 1) + (xcd - r) * q) + off; }
        const int nig = WGM * nN, gid = wgid / nig, fm = gid * WGM, gsz = (nM - fm) < WGM ? (nM - fm) : WGM;
        u.pm = fm + ((wgid % nig) % gsz); u.pn = (wgid % nig) / gsz; return true;
    }
    __device__ __forceinline__ void a_ready(const Unit&) const {}
    __device__ __forceinline__ void done(const Unit&) const {}
};

__device__ __forceinline__ unsigned cvt_pk_bf16(float lo, float hi) { unsigned r; asm volatile("v_cvt_pk_bf16_f32 %0, %1, %2" : "=v"(r) : "v"(lo), "v"(hi)); return r; }
__device__ __forceinline__ void unpack8(const u32x4 w, float (&f)[8]) {
    f[0] = __builtin_bit_cast(float, w.x << 16); f[1] = __builtin_bit_cast(float, w.x & 0xffff0000u);
    f[2] = __builtin_bit_cast(float, w.y << 16); f[3] = __builtin_bit_cast(float, w.y & 0xffff0000u);
    f[4] = __builtin_bit_cast(float, w.z << 16); f[5] = __builtin_bit_cast(float, w.z & 0xffff0000u);
    f[6] = __builtin_bit_cast(float, w.w << 16); f[7] = __builtin_bit_cast(float, w.w & 0xffff0000u);
}
__device__ __forceinline__ u32x4 pack8(const float (&f)[8]) { u32x4 w; w.x = cvt_pk_bf16(f[0], f[1]); w.y = cvt_pk_bf16(f[2], f[3]); w.z = cvt_pk_bf16(f[4], f[5]); w.w = cvt_pk_bf16(f[6], f[7]); return w; }

struct EpiStore {
    static constexpr bool PERM = true, AFTER_DRAIN = false;
    bf16_t* O; int ldc;
    __device__ __forceinline__ void operator()(const f32x4 (&acc)[2][2][4][2], const Unit& u, int wr, int wc, int fr, int fq) const {
        const int row0 = u.pm * BM + wr * 64 + fr, col0 = u.pn * BM + wc * 32 + 8 * fq;
#pragma unroll
        for (int ai = 0; ai < 2; ++ai)
#pragma unroll
            for (int m = 0; m < 4; ++m) { bf16_t* rowp = O + (size_t)(row0 + ai * HALF + m * 16) * ldc + col0;
#pragma unroll
                for (int bj = 0; bj < 2; ++bj) { const f32x4 v0 = acc[ai][bj][m][0], v1 = acc[ai][bj][m][1];
                    u32x4 w; w.x = cvt_pk_bf16(v0[0], v0[1]); w.y = cvt_pk_bf16(v0[2], v0[3]); w.z = cvt_pk_bf16(v1[0], v1[1]); w.w = cvt_pk_bf16(v1[2], v1[3]);
                    *(u32x4*)(rowp + bj * HALF) = w; } }
    }
};

struct EpiProj {
    static constexpr bool PERM = true, AFTER_DRAIN = false;
    bf16_t* Qb; bf16_t* LFb; bf16_t* Vb; bf16_t* Gb; bf16_t* Ub; const float* lb; int M;
    __device__ __forceinline__ void operator()(const f32x4 (&acc)[2][2][4][2], const Unit& u, int wr, int wc, int fr, int fq) const {
        const int row0 = u.pm * BM + wr * 64 + fr; const int colt = u.pn * BM; const int t = colt >> 9;
        const int cb = (colt & 511) + wc * 32 + 8 * fq;
        float lbv[2][8];
        if (t == 1) {
#pragma unroll
            for (int bj = 0; bj < 2; ++bj) { const f32x4 a = *(const f32x4*)(lb + cb + bj * HALF), b = *(const f32x4*)(lb + cb + bj * HALF + 4);
                lbv[bj][0] = a[0]; lbv[bj][1] = a[1]; lbv[bj][2] = a[2]; lbv[bj][3] = a[3]; lbv[bj][4] = b[0]; lbv[bj][5] = b[1]; lbv[bj][6] = b[2]; lbv[bj][7] = b[3]; }
        }
#pragma unroll
        for (int ai = 0; ai < 2; ++ai)
#pragma unroll
            for (int m = 0; m < 4; ++m) { const int row = row0 + ai * HALF + m * 16;
#pragma unroll
                for (int bj = 0; bj < 2; ++bj) { const f32x4 v0 = acc[ai][bj][m][0], v1 = acc[ai][bj][m][1]; const int c = cb + bj * HALF;
                    float f[8] = {v0[0], v0[1], v0[2], v0[3], v1[0], v1[1], v1[2], v1[3]};
                    if (t == 0) {
#pragma unroll
                        for (int j = 0; j < 8; ++j) f[j] *= 0.08838834764831845f;
                        *(u32x4*)(Qb + (size_t)row * 512 + c) = pack8(f);
                    } else if (t == 1) {
#pragma unroll
                        for (int j = 0; j < 8; ++j) { const float l = lbv[bj][j]; const float sg = 1.f / (1.f + __expf(-f[j])); f[j] = __logf(l + (1.f - l) * sg); }
                        *(u32x4*)(LFb + (size_t)row * 512 + c) = pack8(f);
                    } else if (t == 2) { *(u32x4*)(Vb + (size_t)row * 512 + c) = pack8(f);
                    } else if (t == 3) { *(u32x4*)(Gb + (size_t)row * 512 + c) = pack8(f);
                    } else { *(u32x4*)(Ub + ((size_t)(c >> 4) * (M / 32) + (row >> 5)) * 640 + (row & 31) * 16 + (c & 15)) = pack8(f); }
                } }
    }
};

struct EpiGlu {
    static constexpr bool PERM = true, AFTER_DRAIN = false;
    const bf16_t* Z; bf16_t* MIX; const float* bglu;
    __device__ __forceinline__ void operator()(const f32x4 (&acc)[2][2][4][2], const Unit& u, int wr, int wc, int fr, int fq) const {
        const int row0 = u.pm * BM + wr * 64 + fr, col0 = u.pn * BM + wc * 32 + 8 * fq;
#pragma unroll
        for (int bj = 0; bj < 2; ++bj) { const int c = col0 + bj * HALF;
            const f32x4 b0 = *(const f32x4*)(bglu + c), b1 = *(const f32x4*)(bglu + c + 4);
#pragma unroll
            for (int ai = 0; ai < 2; ++ai)
#pragma unroll
                for (int m = 0; m < 4; ++m) { const int row = row0 + ai * HALF + m * 16;
                    const f32x4 v0 = acc[ai][bj][m][0] + b0, v1 = acc[ai][bj][m][1] + b1;
                    float z[8]; unpack8(*(const u32x4*)(Z + (size_t)row * 512 + c), z);
                    float f[8] = {v0[0], v0[1], v0[2], v0[3], v1[0], v1[1], v1[2], v1[3]};
#pragma unroll
                    for (int j = 0; j < 8; ++j) f[j] = z[j] / (1.f + __expf(-f[j]));
                    *(u32x4*)(MIX + (size_t)row * 1024 + 512 + c) = pack8(f); } }
    }
};

struct EpiOut {
    static constexpr bool PERM = true, AFTER_DRAIN = false;
    bf16_t* H; float alpha;
    __device__ __forceinline__ void operator()(const f32x4 (&acc)[2][2][4][2], const Unit& u, int wr, int wc, int fr, int fq) const {
        const int row0 = u.pm * BM + wr * 64 + fr, col0 = u.pn * BM + wc * 32 + 8 * fq;
#pragma unroll
        for (int ai = 0; ai < 2; ++ai)
#pragma unroll
            for (int m = 0; m < 4; ++m) { bf16_t* rowp = H + (size_t)(row0 + ai * HALF + m * 16) * 1024 + col0;
#pragma unroll
                for (int bj = 0; bj < 2; ++bj) { const f32x4 v0 = acc[ai][bj][m][0], v1 = acc[ai][bj][m][1];
                    float h[8]; unpack8(*(const u32x4*)(rowp + bj * HALF), h);
                    float f[8] = {v0[0], v0[1], v0[2], v0[3], v1[0], v1[1], v1[2], v1[3]};
#pragma unroll
                    for (int j = 0; j < 8; ++j) f[j] = alpha * h[j] + f[j];
                    *(u32x4*)(rowp + bj * HALF) = pack8(f); } }
    }
};

struct GroupedOrder {
    int tm, tn, G, c;
    __device__ bool next(int i, Unit& u) const { const int L = i * G + c, per = tm * tn; if (c < 0 || L >= 32 * per) return false;
        const int g = L / per, r = L % per; u.pm = g * tm + r % tm; u.pn = g * tn + r / tm; return true; }
    __device__ __forceinline__ void a_ready(const Unit&) const {}
    __device__ __forceinline__ void done(const Unit&) const {}
};
struct EpiS5A {
    static constexpr bool PERM = true, AFTER_DRAIN = false;
    float* X;
    __device__ __forceinline__ void operator()(const f32x4 (&acc)[2][2][4][2], const Unit& u, int wr, int wc, int fr, int fq) const {
        const int g = u.pn, inst0 = (u.pm & 3) * BM + wr * 64 + fr, col = wc * 32 + 8 * fq;
#pragma unroll
        for (int ai = 0; ai < 2; ++ai)
#pragma unroll
            for (int m = 0; m < 4; ++m) { float* p = X + ((size_t)(inst0 + ai * HALF + m * 16) * 32 + g) * 128 + col;
                *(f32x4*)p = acc[ai][0][m][0]; *(f32x4*)(p + 4) = acc[ai][0][m][1]; }
    }
};
struct EpiS5C {
    static constexpr bool PERM = true, AFTER_DRAIN = false;
    bf16_t* Z;
    __device__ __forceinline__ void operator()(const f32x4 (&acc)[2][2][4][2], const Unit& u, int wr, int wc, int fr, int fq) const {
        const int g = u.pm >> 2, inst0 = (u.pm & 3) * BM + wr * 64 + fr, col0 = (u.pn & 1) * BM + wc * 32 + 8 * fq;
#pragma unroll
        for (int ai = 0; ai < 2; ++ai)
#pragma unroll
            for (int m = 0; m < 4; ++m) { const int inst = inst0 + ai * HALF + m * 16; const size_t tok0 = (size_t)(inst >> 7) * 4096 + (size_t)(inst & 127) * 32;
#pragma unroll
                for (int bj = 0; bj < 2; ++bj) { const int col = col0 + bj * HALF; const f32x4 v0 = acc[ai][bj][m][0], v1 = acc[ai][bj][m][1];
                    float f[8] = {v0[0], v0[1], v0[2], v0[3], v1[0], v1[1], v1[2], v1[3]};
#pragma unroll
                    for (int j = 0; j < 8; ++j) { const float x = f[j], y = 0.7978845608028654f * (x + 0.044715f * x * x * x); f[j] = x / (1.f + __expf(-2.f * y)); }
                    *(u32x4*)(Z + (tok0 + (col >> 4)) * 512 + g * 16 + (col & 15)) = pack8(f); } }
    }
};

template <class Epi, class Sched, bool ALIGN_EPI = false, bool SP2 = false>
__device__ __forceinline__ void gemm_phase(PG8_LAS unsigned char* lds, const Gemm g, const Sched& S, const Epi& E) {
    const int tid = threadIdx.x, wid = __builtin_amdgcn_readfirstlane(tid >> 6), lane = tid & 63, wr = wid >> 2, wc = wid & 3, fr = lane & 15, fq = lane >> 4;
    const int K = g.K, nt = K / BK;
    unsigned voffA[2], voffB[2];
#pragma unroll
    for (int i = 0; i < 2; ++i) { int R, C; stage_rc(tid * 16 + i * 8192, R, C); const int Rb = Epi::PERM ? ((R & ~31) + perm32(R & 31)) : R;
        voffA[i] = (unsigned)(R * g.lda + C) * 2u; voffB[i] = (unsigned)(Rb * g.ldb + C) * 2u; }
    const size_t kstep = (size_t)(BK * 2);
    const size_t hstepA = (size_t)HALF * g.lda * 2, hstepB = (size_t)HALF * g.ldb * 2;
    const size_t tstepA = 2 * hstepA, tstepB = 2 * hstepB;
    const unsigned ldsw = (unsigned)wid * 1024u;
    const int aoff = lds_byte(wr * 64 + fr, fq * 8), boff = lds_byte(wc * 32 + fr, fq * 8);
#define PG8_SA(b, h) (((b) * 2 + (h)) * HTB)
#define PG8_SB(b, h) ((4 + (b) * 2 + (h)) * HTB)
#define PG8_STAGE(bufoff, gbase, voff) do { _Pragma("unroll") for (int _i = 0; _i < 2; ++_i) \
        __builtin_amdgcn_global_load_lds((const unsigned*)((const char*)(gbase) + (voff)[_i]), (PG8_LAS unsigned*)(lds + (bufoff) + ldsw + _i * 8192), 16, 0, 0); } while (0)
#define PG8_LDA(dst, b, h) do { _Pragma("unroll") for (int m = 0; m < 4; ++m) _Pragma("unroll") for (int k = 0; k < 2; ++k) dst[m][k] = *(const PG8_LAS bf16x8*)(lds + PG8_SA(b, h) + aoff + m * 2048 + k * 1024); } while (0)
#define PG8_LDB(dst, b, h) do { _Pragma("unroll") for (int n = 0; n < 2; ++n) _Pragma("unroll") for (int k = 0; k < 2; ++k) dst[n][k] = *(const PG8_LAS bf16x8*)(lds + PG8_SB(b, h) + boff + n * 2048 + k * 1024); } while (0)
#define PG8_MMA(ai, bj, At, Bt) do { __builtin_amdgcn_s_setprio(1); _Pragma("unroll") for (int m = 0; m < 4; ++m) _Pragma("unroll") for (int n = 0; n < 2; ++n) _Pragma("unroll") for (int k = 0; k < 2; ++k) \
        acc[ai][bj][m][n] = __builtin_amdgcn_mfma_f32_16x16x32_bf16(Bt[n][k], At[m][k], acc[ai][bj][m][n], 0, 0, 0); __builtin_amdgcn_s_setprio(0); } while (0)
#define PG8_WAIT_V(n) asm volatile("s_waitcnt vmcnt(" #n ")" ::: "memory")
#define PG8_WAIT_L(n) asm volatile("s_waitcnt lgkmcnt(" #n ")" ::: "memory")
#define PG8_BAR __builtin_amdgcn_s_barrier()
#define PG8_SCHED __builtin_amdgcn_sched_barrier(0)
    Unit cur, nxt; int ui = 0;
    if (!S.next(0, cur)) return;
    f32x4 acc[2][2][4][2];
#pragma unroll
    for (int a = 0; a < 2; ++a)
#pragma unroll
        for (int b = 0; b < 2; ++b)
#pragma unroll
            for (int m = 0; m < 4; ++m)
#pragma unroll
                for (int n = 0; n < 2; ++n) acc[a][b][m][n] = (f32x4){0.f, 0.f, 0.f, 0.f};
    bf16x8 At[4][2], B0[2][2], B1[2][2];
    const char* cA = (const char*)g.A + (size_t)cur.pm * tstepA; const char* cB = (const char*)g.Bt + (size_t)cur.pn * tstepB;
    S.a_ready(cur);
    if constexpr (SP2) {
        PG8_STAGE(PG8_SB(0, 0), cB, voffB); PG8_STAGE(PG8_SB(0, 1), cB + hstepB, voffB); PG8_STAGE(PG8_SA(0, 0), cA, voffA); PG8_STAGE(PG8_SA(0, 1), cA + hstepA, voffA);
        if (wr == 1) PG8_BAR;
        PG8_WAIT_V(2); PG8_BAR;
        PG8_STAGE(PG8_SB(1, 0), cB + kstep, voffB); PG8_STAGE(PG8_SA(1, 0), cA + kstep, voffA); PG8_STAGE(PG8_SB(1, 1), cB + hstepB + kstep, voffB);
        PG8_WAIT_V(6); PG8_BAR;
    } else {
        PG8_STAGE(PG8_SB(0, 0), cB, voffB); PG8_STAGE(PG8_SA(0, 0), cA, voffA); PG8_STAGE(PG8_SB(0, 1), cB + hstepB, voffB); PG8_STAGE(PG8_SA(0, 1), cA + hstepA, voffA);
        if (wr == 1) PG8_BAR;
        PG8_WAIT_V(4); PG8_BAR;
        PG8_STAGE(PG8_SB(1, 0), cB + kstep, voffB); PG8_STAGE(PG8_SA(1, 0), cA + kstep, voffA); PG8_STAGE(PG8_SB(1, 1), cB + hstepB + kstep, voffB);
        PG8_WAIT_V(6); PG8_BAR;
    }
    for (;;) {
        const bool has_next = S.next(ui + 1, nxt);
        const char* nA = has_next ? (const char*)g.A + (size_t)nxt.pm * tstepA : cA; const char* nB = has_next ? (const char*)g.Bt + (size_t)nxt.pn * tstepB : cB;
        for (int t = 0; t < nt; t += 2) {
            const bool last = (t == nt - 2);
            const char* a1 = cA + (size_t)(t + 1) * kstep;
            const char* a2 = last ? nA : cA + (size_t)(t + 2) * kstep; const char* b2 = last ? nB : cB + (size_t)(t + 2) * kstep;
            const char* a3 = a2 + kstep; const char* b3 = b2 + kstep;
            if (last && has_next) S.a_ready(nxt);
            if constexpr (SP2) {
            PG8_LDB(B0, 0, 0); PG8_LDB(B1, 0, 1); PG8_SCHED; PG8_LDA(At, 0, 0); PG8_STAGE(PG8_SA(1, 1), a1 + hstepA, voffA);
            PG8_WAIT_V(8); PG8_WAIT_L(0); PG8_BAR; PG8_MMA(0, 0, At, B0); PG8_MMA(0, 1, At, B1); PG8_BAR; PG8_SCHED;
            PG8_LDA(At, 0, 1); PG8_STAGE(PG8_SB(0, 0), b2, voffB); PG8_STAGE(PG8_SB(0, 1), b2 + hstepB, voffB); PG8_STAGE(PG8_SA(0, 0), a2, voffA);
            PG8_WAIT_V(8); PG8_WAIT_L(0); PG8_BAR; PG8_MMA(1, 0, At, B0); PG8_MMA(1, 1, At, B1); PG8_BAR; PG8_SCHED;
            PG8_LDB(B0, 1, 0); PG8_LDB(B1, 1, 1); PG8_SCHED; PG8_LDA(At, 1, 0); PG8_STAGE(PG8_SA(0, 1), a2 + hstepA, voffA);
            PG8_WAIT_V(8); PG8_WAIT_L(0); PG8_BAR; PG8_MMA(0, 0, At, B0); PG8_MMA(0, 1, At, B1); PG8_BAR; PG8_SCHED;
            PG8_LDA(At, 1, 1); PG8_STAGE(PG8_SB(1, 0), b3, voffB); PG8_STAGE(PG8_SB(1, 1), b3 + hstepB, voffB); PG8_STAGE(PG8_SA(1, 0), a3, voffA);
            PG8_WAIT_V(8); PG8_WAIT_L(0); PG8_BAR; PG8_MMA(1, 0, At, B0); PG8_MMA(1, 1, At, B1); PG8_BAR; PG8_SCHED;
            } else {
            PG8_LDB(B0, 0, 0); PG8_SCHED; PG8_LDA(At, 0, 0); PG8_STAGE(PG8_SA(1, 1), a1 + hstepA, voffA);
            PG8_WAIT_L(8); PG8_BAR; PG8_WAIT_L(0); PG8_MMA(0, 0, At, B0); PG8_BAR; PG8_SCHED;
            PG8_LDB(B1, 0, 1); PG8_STAGE(PG8_SB(0, 0), b2, voffB);
            PG8_BAR; PG8_WAIT_L(0); PG8_MMA(0, 1, At, B1); PG8_BAR;
            PG8_LDA(At, 0, 1); PG8_STAGE(PG8_SA(0, 0), a2, voffA);
            PG8_BAR; PG8_WAIT_L(0); PG8_MMA(1, 0, At, B0); PG8_BAR; PG8_SCHED;
            PG8_STAGE(PG8_SB(0, 1), b2 + hstepB, voffB);
            PG8_WAIT_V(6); PG8_BAR; PG8_MMA(1, 1, At, B1); PG8_BAR;
            PG8_LDB(B0, 1, 0); PG8_SCHED; PG8_LDA(At, 1, 0); PG8_STAGE(PG8_SA(0, 1), a2 + hstepA, voffA);
            PG8_WAIT_L(8); PG8_BAR; PG8_WAIT_L(0); PG8_MMA(0, 0, At, B0); PG8_BAR; PG8_SCHED;
            PG8_LDB(B1, 1, 1); PG8_STAGE(PG8_SB(1, 0), b3, voffB);
            PG8_BAR; PG8_WAIT_L(0); PG8_MMA(0, 1, At, B1); PG8_BAR;
            PG8_LDA(At, 1, 1); PG8_STAGE(PG8_SA(1, 0), a3, voffA);
            PG8_BAR; PG8_WAIT_L(0); PG8_MMA(1, 0, At, B0); PG8_BAR; PG8_SCHED;
            PG8_STAGE(PG8_SB(1, 1), b3 + hstepB, voffB);
            PG8_WAIT_V(6); PG8_BAR; PG8_MMA(1, 1, At, B1); PG8_BAR;
            }
        }
        if constexpr (ALIGN_EPI) { if (wr == 0) PG8_BAR; }
        if constexpr (!Epi::AFTER_DRAIN) { E(acc, cur, wr, wc, fr, fq); S.done(cur); }
        if (!has_next) break;
#pragma unroll
        for (int a = 0; a < 2; ++a)
#pragma unroll
            for (int b = 0; b < 2; ++b)
#pragma unroll
                for (int m = 0; m < 4; ++m)
#pragma unroll
                    for (int n = 0; n < 2; ++n) acc[a][b][m][n] = (f32x4){0.f, 0.f, 0.f, 0.f};
        cur = nxt; cA = nA; cB = nB; ++ui;
        if constexpr (ALIGN_EPI) { if (wr == 1) PG8_BAR; }
    }
    PG8_WAIT_V(0);
    if constexpr (!ALIGN_EPI) { if (wr == 0) PG8_BAR; }
    PG8_BAR;
    if constexpr (Epi::AFTER_DRAIN) { E.fused(acc, cur, wr, wc, fr, fq, lds, wid, lane); S.done(cur); }
#undef PG8_SA
#undef PG8_SB
#undef PG8_STAGE
#undef PG8_LDA
#undef PG8_LDB
#undef PG8_MMA
#undef PG8_WAIT_V
#undef PG8_WAIT_L
#undef PG8_BAR
#undef PG8_SCHED
}
}

constexpr int NWAVES = 8;
#ifndef MK_N_LAUNCHES
#define MK_N_LAUNCHES 1
#endif
constexpr int N_LAUNCHES = MK_N_LAUNCHES;
constexpr int NPH = 11;
#ifndef PROBE_REP
#define PROBE_REP -1
#endif

constexpr int BATCH = 8, SEQ = 4096, D = 1024, M = BATCH * SEQ;
constexpr int HGW = 512, HGH = 4, HGK = 128;
constexpr int S5W = 512, S5G = 32, S5P = 16, S5N = 64;
constexpr int S5L = 32, S5I = M / S5L, S5K = S5L * S5P + 2 * S5N;
constexpr int NPROJ = 2560;
constexpr int PK = 128, PH = 8, PTOPK = 16, PQ = 256, PHALF = 128, PE = PK * PK, NQ2 = PH * PQ;
constexpr float LN_EPS = 1e-5f, RMS_EPS = 1e-6f;
constexpr float DN_ALPHA = 1.189207115002721f;

constexpr size_t MiB = 1u << 20;
constexpr size_t WS_CTL = 0, CTL_ZERO_BYTES = 1 * MiB;
constexpr size_t WS_WIN = 1 * MiB;
constexpr size_t WS_WGLU = 6 * MiB;
constexpr size_t WS_KEYS = 6 * MiB + 512 * 1024;
constexpr size_t WS_LB = 6 * MiB + 640 * 1024;
constexpr size_t WS_S5T = 6 * MiB + 704 * 1024;
constexpr size_t WS_WOUT = 7 * MiB + 512 * 1024;
constexpr size_t WS_WQ = 10 * MiB;
constexpr size_t WS_SST = 14 * MiB;
constexpr size_t WS_H = 78 * MiB;
constexpr size_t WS_PROJ = 142 * MiB;
constexpr size_t WS_Q2 = WS_PROJ;
constexpr size_t WS_A5 = 270 * MiB;
constexpr size_t WS_MIX = 310 * MiB;
constexpr size_t WS_PD = WS_MIX, WS_PU = WS_MIX + 16 * MiB;
constexpr size_t WS_Z = 374 * MiB;
constexpr size_t WS_EIDX = WS_Z, WS_EGATE = WS_Z + 16 * MiB;
constexpr size_t WS_T5 = 406 * MiB;
constexpr size_t WS_G5 = 426 * MiB;
constexpr size_t WS_XLOC = 434 * MiB;
constexpr size_t WS_KTAU = 450 * MiB;
constexpr size_t WS_PW = 451 * MiB;
constexpr size_t WS_END = 452 * MiB;
constexpr int CW_TMO = 0, CW_CODE = 1;
constexpr int CW_BAR = 4096;

constexpr int RING_OFF = 0, RING_BYTES = 131072;
constexpr int LDSCTL_OFF = RING_BYTES, MISC_OFF = LDSCTL_OFF + 320;
constexpr int LDS_BYTES = 147456;
static_assert(MISC_OFF + 128 <= LDS_BYTES, "LDS map");

#define GAS __attribute__((address_space(1)))
#define LAS __attribute__((address_space(3)))
typedef unsigned short bf16;
typedef unsigned v4u __attribute__((ext_vector_type(4)));
typedef float f32x4 __attribute__((ext_vector_type(4)));
typedef short bf16x8 __attribute__((ext_vector_type(8)));
typedef GAS unsigned gu32;
typedef GAS unsigned long long gu64;
#define RLX_AGENT __ATOMIC_RELAXED, __HIP_MEMORY_SCOPE_AGENT
#define LDS_WAIT() asm volatile("s_waitcnt lgkmcnt(0)" ::: "memory")
#define VM_WAIT() asm volatile("s_waitcnt vmcnt(0)" ::: "memory")
__device__ __forceinline__ unsigned long long rt() { return __builtin_amdgcn_s_memrealtime(); }
__device__ __forceinline__ unsigned f2bf(float f) { unsigned u = __builtin_bit_cast(unsigned, f); return (u + 0x7fffu + ((u >> 16) & 1u)) >> 16; }
__device__ __forceinline__ unsigned pk2(float lo, float hi) { return f2bf(lo) | (f2bf(hi) << 16); }

#define XB_TMO      128
#define XB_XCNT(j)  (256  + 64 * (j))
#define XB_XSUB(j)  (1280 + 64 * (j))
#define XB_XGEN(j)  (2304 + 64 * (j))
#define XB_TOP      3328
#define XB_TOPGEN   3392
#define XCD_BAR_WORDS 3456
#define XB_SPIN_CAP (1u << 18)

__device__ __forceinline__ unsigned xb_ld(unsigned* p)              { return __hip_atomic_load(p, __ATOMIC_RELAXED, __HIP_MEMORY_SCOPE_AGENT); }
__device__ __forceinline__ unsigned xb_add(unsigned* p, unsigned v) { return __hip_atomic_fetch_add(p, v, __ATOMIC_RELAXED, __HIP_MEMORY_SCOPE_AGENT); }
__device__ __forceinline__ unsigned xb_xcc_id() { return (unsigned)__builtin_amdgcn_s_getreg((3 << 11) | 20) & 0xFu; }
#define XB_SPIN(cond, bar) do { unsigned _sp = 0; while (cond) { __builtin_amdgcn_s_sleep(1); \
    if ((++_sp & 255u) == 0u) { if (xb_ld(&(bar)[XB_TMO])) break; if (_sp > XB_SPIN_CAP) { atomicAdd(&(bar)[XB_TMO], 1u); break; } } } } while (0)

struct XcdBarrier {
    unsigned* bar; unsigned x;
    volatile LAS unsigned* st;
};

__device__ __forceinline__ XcdBarrier xcd_barrier_post(unsigned* bar, volatile LAS unsigned* st) {
    XcdBarrier b; b.bar = bar; b.x = xb_xcc_id(); b.st = st;
    if (threadIdx.x == 0) (void)xb_add(&bar[XB_XCNT(b.x)], 1u);
    return b;
}
__device__ __forceinline__ void xcd_barrier_complete(unsigned* bar, unsigned x, unsigned& nloc, unsigned& nx) {
    const unsigned G = gridDim.x * gridDim.y * gridDim.z;
    unsigned sum, cnt, mine, sp = 0u;
    for (;;) {
        sum = 0u; cnt = 0u; mine = 0u;
#pragma unroll
        for (unsigned j = 0; j < 16; ++j) { const unsigned c = xb_ld(&bar[XB_XCNT(j)]); sum += c; cnt += (c > 0u) ? 1u : 0u; mine = (j == x) ? c : mine; }
        if (sum == G) break;
        __builtin_amdgcn_s_sleep(1);
        if ((++sp & 255u) == 0u) { if (xb_ld(&bar[XB_TMO])) break; if (sp > XB_SPIN_CAP) { atomicAdd(&bar[XB_TMO], 1u); break; } }
    }
    nloc = mine > 0u ? mine : 1u; nx = cnt > 0u ? cnt : 1u;
}

__device__ __forceinline__ void xcd_barrier(const XcdBarrier& b) {
    asm volatile("s_waitcnt vmcnt(0)" ::: "memory");
    __syncthreads();
    if (threadIdx.x == 0) {
        unsigned* bar = b.bar;
        __builtin_amdgcn_s_waitcnt(0);
        unsigned nloc = b.st[0], nx = b.st[1];
        if (nloc == 0u) { xcd_barrier_complete(bar, b.x, nloc, nx); b.st[0] = nloc; b.st[1] = nx; }
        const unsigned old = xb_add(&bar[XB_XSUB(b.x)], 1u);
        const unsigned gen = old / nloc;
        if (old + 1u == (gen + 1u) * nloc) {
            __builtin_amdgcn_fence(__ATOMIC_RELEASE, "agent");
            asm volatile("s_waitcnt vmcnt(0)" ::: "memory");
            const unsigned og = xb_add(&bar[XB_TOP], 1u);
            const unsigned tg = og / nx;
            if (og + 1u == (tg + 1u) * nx) xb_add(&bar[XB_TOPGEN], 1u);
            else XB_SPIN(xb_ld(&bar[XB_TOPGEN]) == tg, bar);
            __builtin_amdgcn_fence(__ATOMIC_ACQUIRE, "agent");
            xb_add(&bar[XB_XGEN(b.x)], 1u);
            asm volatile("s_waitcnt vmcnt(0)" ::: "memory");
        } else {
            XB_SPIN(xb_ld(&bar[XB_XGEN(b.x)]) == gen, bar);
            __builtin_amdgcn_fence(__ATOMIC_ACQUIRE, "agent");
            asm volatile("s_waitcnt vmcnt(0)" ::: "memory");
        }
    }
    __syncthreads();
}

struct Frame {
    LAS unsigned char* lds;
    volatile LAS unsigned* MISC;
    gu32* ctl;
    int tid, lane, wave;
    int vcu, G;
    const float* in[26]; float* out; unsigned char* ws;
};
enum { I_X = 0, I_LN0G, I_LN0B, I_WIN, I_LBL, I_HGNG, I_ARE, I_AIM, I_LSTEP, I_BRE, I_BIM, I_CRE, I_CIM, I_DSK, I_WGLU, I_BGLU, I_WOUT, I_LN1G, I_LN1B, I_WQ, I_K1, I_K2, I_PD, I_PU, I_LN2G, I_LN2B };

__device__ __forceinline__ float bf2f(bf16 v) { return __builtin_bit_cast(float, (unsigned)v << 16); }
__device__ __forceinline__ float wave_sum(float v) {
#pragma unroll
    for (int o = 1; o < 64; o <<= 1) v += __shfl_xor(v, o);
    return v;
}
__device__ __forceinline__ float wave_max(float v) {
#pragma unroll
    for (int o = 1; o < 64; o <<= 1) v = fmaxf(v, __shfl_xor(v, o));
    return v;
}
__device__ __forceinline__ float gelu_tanh(float x) { const float y = 0.7978845608028654f * (x + 0.044715f * x * x * x); return x / (1.f + __expf(-2.f * y)); }
__device__ __forceinline__ float silu_f(float x) { return x / (1.f + __expf(-x)); }
__device__ __forceinline__ void unpack8(const v4u w, float (&f)[8]) {
    f[0] = __builtin_bit_cast(float, w.x << 16); f[1] = __builtin_bit_cast(float, w.x & 0xffff0000u);
    f[2] = __builtin_bit_cast(float, w.y << 16); f[3] = __builtin_bit_cast(float, w.y & 0xffff0000u);
    f[4] = __builtin_bit_cast(float, w.z << 16); f[5] = __builtin_bit_cast(float, w.z & 0xffff0000u);
    f[6] = __builtin_bit_cast(float, w.w << 16); f[7] = __builtin_bit_cast(float, w.w & 0xffff0000u);
}
__device__ __forceinline__ v4u pack8(const float (&f)[8]) { v4u w; w.x = pk2(f[0], f[1]); w.y = pk2(f[2], f[3]); w.z = pk2(f[4], f[5]); w.w = pk2(f[6], f[7]); return w; }

__device__ __forceinline__ void p0_transpose_item(const float* W, int K, int N, bf16* WT, int row_off, LAS float* scr, int item, int lane) {
    const int nblk = N / 32, kb = item / nblk, nb = item % nblk, k0 = 64 * kb, n0 = 32 * nb;
#pragma unroll 8
    for (int i = 0; i < 32; ++i) { const int kk = 2 * i + (lane >> 5); scr[kk * 33 + (lane & 31)] = W[(size_t)(k0 + kk) * N + n0 + (lane & 31)]; }
    LDS_WAIT(); asm volatile("" ::: "memory");
    const int c = lane & 7;
#pragma unroll
    for (int j = 0; j < 4; ++j) { const int n = (lane >> 3) + 8 * j; const LAS float* s = scr + (8 * c) * 33 + n;
        v4u o; o.x = pk2(s[0 * 33], s[1 * 33]); o.y = pk2(s[2 * 33], s[3 * 33]); o.z = pk2(s[4 * 33], s[5 * 33]); o.w = pk2(s[6 * 33], s[7 * 33]);
        *(GAS v4u*)(WT + (size_t)(row_off + n0 + n) * K + k0 + 8 * c) = o; }
    LDS_WAIT(); asm volatile("" ::: "memory");
}
__device__ __forceinline__ void ln0_row(const float* xrow, const float* g, const float* b, bf16* orow, int lane) {
    const GAS f32x4* xr = (const GAS f32x4*)xrow + lane;
    f32x4 v[4]; float s = 0.f;
#pragma unroll
    for (int j = 0; j < 4; ++j) { v[j] = xr[64 * j]; s += (v[j].x + v[j].y) + (v[j].z + v[j].w); }
    const float mean = wave_sum(s) * (1.f / D); float s2 = 0.f;
#pragma unroll
    for (int j = 0; j < 4; ++j) { v[j] = v[j] - mean; s2 += (v[j].x * v[j].x + v[j].y * v[j].y) + (v[j].z * v[j].z + v[j].w * v[j].w); }
    const float rstd = 1.f / sqrtf(wave_sum(s2) * (1.f / D) + LN_EPS);
    GAS unsigned long long* o8 = (GAS unsigned long long*)orow + lane;
#pragma unroll
    for (int j = 0; j < 4; ++j) { const f32x4 gg = ((const GAS f32x4*)g)[lane + 64 * j], bb = ((const GAS f32x4*)b)[lane + 64 * j];
        const f32x4 o = v[j] * rstd * gg + bb;
        o8[64 * j] = (unsigned long long)pk2(o.x, o.y) | ((unsigned long long)pk2(o.z, o.w) << 32); }
}
__device__ __forceinline__ void p0_prologue(Frame& F) {
    LAS float* scr = (LAS float*)(F.lds + RING_OFF + F.wave * 16384);
    const int gw = F.vcu * NWAVES + F.wave, NGW = F.G * NWAVES;
    unsigned char* ws = F.ws;
    constexpr int I_IN = (D / 64) * (NPROJ / 32), I_GLU = (512 / 64) * (512 / 32), I_OUT = (1024 / 64) * (1024 / 32), I_Q = (1024 / 64) * (2048 / 32);
    constexpr int NITEMS = I_IN + I_GLU + I_OUT + I_Q;
    for (int it = gw; it < NITEMS; it += NGW) {
        int r = it;
        if (r < I_IN) { p0_transpose_item(F.in[I_WIN], D, NPROJ, (bf16*)(ws + WS_WIN), 0, scr, r, F.lane); continue; } r -= I_IN;
        if (r < I_GLU) { p0_transpose_item(F.in[I_WGLU], 512, 512, (bf16*)(ws + WS_WGLU), 0, scr, r, F.lane); continue; } r -= I_GLU;
        if (r < I_OUT) { p0_transpose_item(F.in[I_WOUT], 1024, 1024, (bf16*)(ws + WS_WOUT), 0, scr, r, F.lane); continue; } r -= I_OUT;
        p0_transpose_item(F.in[I_WQ], 1024, 2048, (bf16*)(ws + WS_WQ), 0, scr, r, F.lane);
    }
    const int gt = gw * 64 + F.lane, NGT = NGW * 64;
    for (int i = gt; i < 2 * PK * PHALF; i += NGT) { const float v = (i < PK * PHALF) ? F.in[I_K1][i] : F.in[I_K2][i - PK * PHALF]; ((bf16*)(ws + WS_KEYS))[i] = (bf16)f2bf(v); }
    for (int i = gt; i < HGW; i += NGT) { const float l0 = F.in[I_LBL][i], l1 = F.in[I_LBL][HGW + i]; ((float*)(ws + WS_LB))[i] = 1.f / (1.f + expf(l1 - l0)); }
    for (int i = gt; i < S5G * S5N; i += NGT) { const int g = i / S5N;
        const float are = F.in[I_ARE][i], aim = F.in[I_AIM][i], step = expf(F.in[I_LSTEP][g]);
        const float zr = step * are, zi = step * aim, mag = expf(zr), cz = cosf(zi), sz = sinf(zi), sh = sinf(0.5f * zi);
        const float abr = mag * cz, abi = mag * sz;
        const float nre = expm1f(zr) * cz - 2.f * sh * sh, nim = abi;
        const float den = are * are + aim * aim;
        const float cre = (nre * are + nim * aim) / den, cim = (nim * are - nre * aim) / den;
        float* t = (float*)(ws + WS_S5T) + (size_t)i * 40; t[0] = abr; t[1] = abi;
        for (int p = 0; p < S5P; ++p) { const float br = F.in[I_BRE][(size_t)i * S5P + p], bi = F.in[I_BIM][(size_t)i * S5P + p];
            t[2 + p] = cre * br - cim * bi; t[18 + p] = cre * bi + cim * br; } }
    for (int i = gt; i < S5G * S5N * 33; i += NGT) { const int gn = i / 33, tau = i % 33, g = gn / S5N;
        const float step = expf(F.in[I_LSTEP][g]), zr = step * F.in[I_ARE][gn] * (float)tau, zi = step * F.in[I_AIM][gn] * (float)tau, mag = expf(zr);
        float* p = (float*)(ws + WS_PW) + (size_t)i * 2; p[0] = mag * cosf(zi); p[1] = mag * sinf(zi); }
    for (int m = gw; m < M; m += NGW) ln0_row(F.in[I_X] + (size_t)m * D, F.in[I_LN0G], F.in[I_LN0B], (bf16*)(ws + WS_H) + (size_t)m * D, F.lane);
}

__device__ __forceinline__ void hgrn2_seq(Frame& F, int bh) {
    const int b = bh >> 2, h = bh & 3, tid = F.tid, kq = tid >> 7, j = tid & 127;
    LAS float* sF = (LAS float*)(F.lds + RING_OFF);
    LAS float* sK = sF + 8 * 128; LAS float* sQ = sK + 8 * 128;
    LAS float* sO = sQ + 8 * 128;
    const bf16* Qb = (const bf16*)(F.ws + WS_PROJ); const bf16* LFb = Qb + (size_t)M * 512; const bf16* Vb = LFb + (size_t)M * 512; const bf16* Gb = Vb + (size_t)M * 512;
    bf16* MIX = (bf16*)(F.ws + WS_MIX);
    const float ng0 = F.in[I_HGNG][F.lane], ng1 = F.in[I_HGNG][F.lane + 64];
    float S[32];
#pragma unroll
    for (int k = 0; k < 32; ++k) S[k] = 0.f;
    for (int t0 = 0; t0 < SEQ; t0 += 8) {
        const size_t tok0 = (size_t)b * SEQ + t0;
#pragma unroll
        for (int r = 0; r < 2; ++r) { const int item = tid + 512 * r, tt = item >> 7, kk = item & 127; const size_t off = (tok0 + tt) * 512 + h * 128 + kk;
            const float lf = bf2f(LFb[off]); sF[tt * 128 + kk] = __expf(lf); sK[tt * 128 + kk] = -expm1f(lf); sQ[tt * 128 + kk] = bf2f(Qb[off]); }
        __syncthreads();
#pragma unroll 1
        for (int tt = 0; tt < 8; ++tt) { const float v = bf2f(Vb[(tok0 + tt) * 512 + h * 128 + j]); float o = 0.f;
            const LAS float* f = sF + tt * 128 + kq * 32; const LAS float* kx = sK + tt * 128 + kq * 32; const LAS float* q = sQ + tt * 128 + kq * 32;
#pragma unroll
            for (int k = 0; k < 32; ++k) { S[k] = f[k] * S[k] + kx[k] * v; o += q[k] * S[k]; }
            sO[(tt * 4 + kq) * 128 + j] = o; }
        __syncthreads();
        { const int tt = F.wave; const size_t tok = tok0 + tt;
            const float o0 = (sO[(tt * 4 + 0) * 128 + F.lane] + sO[(tt * 4 + 1) * 128 + F.lane]) + (sO[(tt * 4 + 2) * 128 + F.lane] + sO[(tt * 4 + 3) * 128 + F.lane]);
            const float o1 = (sO[(tt * 4 + 0) * 128 + 64 + F.lane] + sO[(tt * 4 + 1) * 128 + 64 + F.lane]) + (sO[(tt * 4 + 2) * 128 + 64 + F.lane] + sO[(tt * 4 + 3) * 128 + 64 + F.lane]);
            const float ss = wave_sum(o0 * o0 + o1 * o1), r = 1.f / sqrtf(ss * (1.f / 128.f) + RMS_EPS);
            const float g0 = bf2f(Gb[tok * 512 + h * 128 + F.lane]), g1 = bf2f(Gb[tok * 512 + h * 128 + 64 + F.lane]);
            MIX[tok * 1024 + h * 128 + F.lane] = (bf16)f2bf(o0 * r * ng0 * silu_f(g0));
            MIX[tok * 1024 + h * 128 + 64 + F.lane] = (bf16)f2bf(o1 * r * ng1 * silu_f(g1)); }
    }
    __syncthreads();
}
__device__ __forceinline__ void s5_seq(Frame& F, int pair) {
    const int b = pair >> 5, g = pair & 31, lane = F.lane;
    const float* tb = (const float*)(F.ws + WS_S5T) + (size_t)(g * S5N + lane) * 40;
    const float abr = tb[0], abi = tb[1];
    float bbr[16], bbi[16], cr[16], ci[16], dsk[16];
#pragma unroll
    for (int p = 0; p < 16; ++p) { bbr[p] = tb[2 + p]; bbi[p] = tb[18 + p]; cr[p] = F.in[I_CRE][(size_t)(g * 16 + p) * S5N + lane]; ci[p] = F.in[I_CIM][(size_t)(g * 16 + p) * S5N + lane];
        dsk[p] = (lane == 0) ? F.in[I_DSK][g * 16 + p] : 0.f; }
    const bf16* Ub = (const bf16*)(F.ws + WS_PROJ) + (size_t)4 * M * 512 + ((size_t)g * M + (size_t)b * SEQ) * 16;
    bf16* Zb = (bf16*)(F.ws + WS_Z) + (size_t)b * SEQ * 512 + g * 16;
    const int pme = ((lane >> 5) & 1) * 8 + ((lane >> 4) & 1) * 4 + ((lane >> 3) & 1) * 2 + ((lane >> 2) & 1);
    float xr = 0.f, xi = 0.f;
    v4u nu0 = *(const GAS v4u*)(Ub + (size_t)lane * 16), nu1 = *(const GAS v4u*)(Ub + (size_t)lane * 16 + 8);
    for (int t0 = 0; t0 < SEQ; t0 += 64) {
        const v4u u0 = nu0, u1 = nu1;
        if (t0 + 64 < SEQ) { nu0 = *(const GAS v4u*)(Ub + (size_t)(t0 + 64 + lane) * 16); nu1 = *(const GAS v4u*)(Ub + (size_t)(t0 + 64 + lane) * 16 + 8); }
#pragma unroll 1
        for (int tt = 0; tt < 64; ++tt) {
            v4u a, c;
            a.x = __builtin_amdgcn_readlane(u0.x, tt); a.y = __builtin_amdgcn_readlane(u0.y, tt); a.z = __builtin_amdgcn_readlane(u0.z, tt); a.w = __builtin_amdgcn_readlane(u0.w, tt);
            c.x = __builtin_amdgcn_readlane(u1.x, tt); c.y = __builtin_amdgcn_readlane(u1.y, tt); c.z = __builtin_amdgcn_readlane(u1.z, tt); c.w = __builtin_amdgcn_readlane(u1.w, tt);
            float u[16]; { float f0[8], f1[8]; unpack8(a, f0); unpack8(c, f1);
#pragma unroll
                for (int p = 0; p < 8; ++p) { u[p] = f0[p]; u[8 + p] = f1[p]; } }
            float bur = 0.f, bui = 0.f;
#pragma unroll
            for (int p = 0; p < 16; ++p) { bur += bbr[p] * u[p]; bui += bbi[p] * u[p]; }
            const float nxr = abr * xr - abi * xi + bur, nxi = abr * xi + abi * xr + bui; xr = nxr; xi = nxi;
            float r[16];
#pragma unroll
            for (int p = 0; p < 16; ++p) r[p] = cr[p] * xr - ci[p] * xi + dsk[p] * u[p];
#pragma unroll
            for (int i = 0; i < 8; ++i) { const float keep = (lane & 32) ? r[i + 8] : r[i], send = (lane & 32) ? r[i] : r[i + 8]; r[i] = keep + __shfl_xor(send, 32); }
#pragma unroll
            for (int i = 0; i < 4; ++i) { const float keep = (lane & 16) ? r[i + 4] : r[i], send = (lane & 16) ? r[i] : r[i + 4]; r[i] = keep + __shfl_xor(send, 16); }
#pragma unroll
            for (int i = 0; i < 2; ++i) { const float keep = (lane & 8) ? r[i + 2] : r[i], send = (lane & 8) ? r[i] : r[i + 2]; r[i] = keep + __shfl_xor(send, 8); }
            { const float keep = (lane & 4) ? r[1] : r[0], send = (lane & 4) ? r[0] : r[1]; r[0] = keep + __shfl_xor(send, 4); }
            r[0] += __shfl_xor(r[0], 2); r[0] += __shfl_xor(r[0], 1);
            if ((lane & 3) == 0) Zb[(size_t)(t0 + tt) * 512 + pme] = (bf16)f2bf(gelu_tanh(r[0]));
        }
    }
}

__device__ __forceinline__ int t256(int r, int c) { return r * 256 + ((((c >> 3) ^ (r & 15))) << 4) + (c & 7) * 2; }
__device__ __forceinline__ int t128(int r, int c) { return r * 128 + ((((c >> 3) ^ (r & 7))) << 4) + (c & 7) * 2; }
typedef unsigned v2u __attribute__((ext_vector_type(2)));
__device__ __forceinline__ void hgrn2_state_pass(Frame& F, int item) {
    const int bh = item >> 2, vs = item & 3, b = bh >> 2, h = bh & 3, tid = F.tid, lane = F.lane, w = F.wave, fr = lane & 15, fq = lane >> 4;
    const int kcol = tid & 127, qtr = tid >> 7, vv = tid & 31, sg = tid >> 5;
    LAS unsigned char* L = F.lds + RING_OFF;
    const bf16* LFb = (const bf16*)(F.ws + WS_PROJ) + (size_t)M * 512 + (size_t)b * SEQ * 512 + h * 128 + kcol;
    const bf16* Vb = (const bf16*)(F.ws + WS_PROJ) + (size_t)2 * M * 512 + (size_t)b * SEQ * 512 + h * 128 + vs * 32 + vv;
    bf16* SST = (bf16*)(F.ws + WS_SST) + (size_t)bh * 64 * 128 * 128;
    float S[2][4];
#pragma unroll
    for (int i = 0; i < 2; ++i)
#pragma unroll
        for (int r = 0; r < 4; ++r) S[i][r] = 0.f;
    bf16 lfn[16], vn[4];
#pragma unroll
    for (int j = 0; j < 16; ++j) lfn[j] = LFb[(size_t)(qtr * 16 + j) * 512];
#pragma unroll
    for (int j = 0; j < 4; ++j) vn[j] = Vb[(size_t)(sg * 4 + j) * 512];
    for (int c = 0; c < 64; ++c) {
        LAS unsigned char* Lb = L + (c & 1) * 24576;
        LAS unsigned char* sKT = Lb; LAS unsigned char* sVT = Lb + 16384; LAS float* sTot = (LAS float*)(Lb + 20480); LAS float* sDec = (LAS float*)(Lb + 22528);
        float lf[16]; bf16 vc[4];
#pragma unroll
        for (int j = 0; j < 16; ++j) lf[j] = bf2f(lfn[j]);
#pragma unroll
        for (int j = 0; j < 4; ++j) vc[j] = vn[j];
        if (c + 1 < 64) {
#pragma unroll
            for (int j = 0; j < 16; ++j) lfn[j] = LFb[(size_t)((c + 1) * 64 + qtr * 16 + j) * 512];
#pragma unroll
            for (int j = 0; j < 4; ++j) vn[j] = Vb[(size_t)((c + 1) * 64 + sg * 4 + j) * 512];
        }
        float cl[16]; float run = 0.f;
#pragma unroll
        for (int j = 0; j < 16; ++j) { run += lf[j]; cl[j] = run; }
        sTot[qtr * 128 + kcol] = run;
        __syncthreads();
        const float t0 = sTot[kcol], t1 = sTot[128 + kcol], t2 = sTot[256 + kcol], t3 = sTot[384 + kcol];
        const float off = (qtr > 0 ? t0 : 0.f) + (qtr > 1 ? t1 : 0.f) + (qtr > 2 ? t2 : 0.f), last = (t0 + t1) + (t2 + t3);
        float kh[16];
#pragma unroll
        for (int j = 0; j < 16; ++j) kh[j] = -expm1f(lf[j]) * __expf(last - (off + cl[j]));
        { const float a[8] = {kh[0], kh[1], kh[2], kh[3], kh[4], kh[5], kh[6], kh[7]}, bq[8] = {kh[8], kh[9], kh[10], kh[11], kh[12], kh[13], kh[14], kh[15]};
          *(LAS v4u*)(sKT + kcol * 128 + (((qtr * 2) ^ (kcol & 7)) << 4)) = pack8(a); *(LAS v4u*)(sKT + kcol * 128 + (((qtr * 2 + 1) ^ (kcol & 7)) << 4)) = pack8(bq); }
        if (qtr == 0) sDec[kcol] = __expf(last);
        { v2u pv; pv.x = (unsigned)vc[0] | ((unsigned)vc[1] << 16); pv.y = (unsigned)vc[2] | ((unsigned)vc[3] << 16);
          *(LAS v2u*)(sVT + vv * 128 + ((((sg >> 1) ^ (vv & 7))) << 4) + (sg & 1) * 8) = pv; }
        __syncthreads();
        f32x4 acc[2] = {(f32x4){0.f, 0.f, 0.f, 0.f}, (f32x4){0.f, 0.f, 0.f, 0.f}};
#pragma unroll
        for (int ks = 0; ks < 2; ++ks) { const int ch = ks * 4 + fq, row = 16 * w + fr;
            const bf16x8 af = *(const LAS bf16x8*)(sKT + row * 128 + ((ch ^ (row & 7)) << 4));
#pragma unroll
            for (int nt = 0; nt < 2; ++nt) { const int vr = 16 * nt + fr; const bf16x8 bfm = *(const LAS bf16x8*)(sVT + vr * 128 + ((ch ^ (vr & 7)) << 4));
                acc[nt] = __builtin_amdgcn_mfma_f32_16x16x32_bf16(af, bfm, acc[nt], 0, 0, 0); } }
        const int k0 = 16 * w + fq * 4; const f32x4 dec = *(const LAS f32x4*)(sDec + k0);
#pragma unroll
        for (int nt = 0; nt < 2; ++nt) { const int vg = vs * 32 + 16 * nt + fr;
            v2u o; o.x = pk2(S[nt][0], S[nt][1]); o.y = pk2(S[nt][2], S[nt][3]);
            *(GAS v2u*)(SST + ((size_t)c * 128 + vg) * 128 + k0) = o;
            S[nt][0] = dec[0] * S[nt][0] + acc[nt][0]; S[nt][1] = dec[1] * S[nt][1] + acc[nt][1]; S[nt][2] = dec[2] * S[nt][2] + acc[nt][2]; S[nt][3] = dec[3] * S[nt][3] + acc[nt][3]; }
    }
    __syncthreads();
}
__device__ __forceinline__ void hgrn2_out_item(Frame& F, int item) {
    const int bh = item >> 6, c = item & 63, b = bh >> 2, h = bh & 3, tid = F.tid, lane = F.lane, w = F.wave, fr = lane & 15, fq = lane >> 4;
    const int kcol = tid & 127, qtr = tid >> 7;
    LAS unsigned char* L = F.lds + RING_OFF;
    LAS unsigned char* sQt = L; LAS unsigned char* sQm = L + 16384; LAS unsigned char* sKm = L + 32768; LAS unsigned char* sVT = L + 49152; LAS unsigned char* sST = L + 65536; LAS unsigned char* sP = L + 98304;
    LAS float* sTot = (LAS float*)(L + 106496); LAS float* sSS = (LAS float*)(L + 108544);
    const size_t tok0 = (size_t)b * SEQ + (size_t)c * 64;
    const bf16* Qb = (const bf16*)(F.ws + WS_PROJ) + tok0 * 512 + h * 128; const bf16* LFb = Qb + (size_t)M * 512; const bf16* Vb = Qb + (size_t)2 * M * 512; const bf16* Gb = Qb + (size_t)3 * M * 512;
    const bf16* SST = (const bf16*)(F.ws + WS_SST) + (size_t)item * 128 * 128;
    bf16* MIX = (bf16*)(F.ws + WS_MIX) + tok0 * 1024 + h * 128;
    float lf[16], q[16]; bf16 vraw[16];
#pragma unroll
    for (int j = 0; j < 16; ++j) { lf[j] = bf2f(LFb[(size_t)(qtr * 16 + j) * 512 + kcol]); q[j] = bf2f(Qb[(size_t)(qtr * 16 + j) * 512 + kcol]); vraw[j] = Vb[(size_t)(qtr * 16 + j) * 512 + kcol]; }
    v4u st[4];
#pragma unroll
    for (int i = 0; i < 4; ++i) { const int idx = tid + 512 * i; st[i] = *(const GAS v4u*)(SST + (size_t)(idx >> 4) * 128 + (idx & 15) * 8); }
    float cl[16]; float run = 0.f;
#pragma unroll
    for (int j = 0; j < 16; ++j) { run += lf[j]; cl[j] = run; }
    sTot[qtr * 128 + kcol] = run;
    __syncthreads();
    { const float t0 = sTot[kcol], t1 = sTot[128 + kcol], t2 = sTot[256 + kcol];
      const float off = (qtr > 0 ? t0 : 0.f) + (qtr > 1 ? t1 : 0.f) + (qtr > 2 ? t2 : 0.f), mid = t0 + t1;
#pragma unroll
      for (int j = 0; j < 16; ++j) { const int s = qtr * 16 + j; const float cum = off + cl[j];
          const int o = t256(s, kcol);
          *(LAS bf16*)(sQt + o) = (bf16)f2bf(q[j] * __expf(cum));
          *(LAS bf16*)(sQm + o) = (bf16)f2bf(q[j] * __expf(cum - mid));
          *(LAS bf16*)(sKm + o) = (bf16)f2bf(-expm1f(lf[j]) * __expf(mid - cum)); }
      v4u p0, p1;
      p0.x = (unsigned)vraw[0] | ((unsigned)vraw[1] << 16); p0.y = (unsigned)vraw[2] | ((unsigned)vraw[3] << 16); p0.z = (unsigned)vraw[4] | ((unsigned)vraw[5] << 16); p0.w = (unsigned)vraw[6] | ((unsigned)vraw[7] << 16);
      p1.x = (unsigned)vraw[8] | ((unsigned)vraw[9] << 16); p1.y = (unsigned)vraw[10] | ((unsigned)vraw[11] << 16); p1.z = (unsigned)vraw[12] | ((unsigned)vraw[13] << 16); p1.w = (unsigned)vraw[14] | ((unsigned)vraw[15] << 16);
      *(LAS v4u*)(sVT + kcol * 128 + (((qtr * 2) ^ (kcol & 7)) << 4)) = p0; *(LAS v4u*)(sVT + kcol * 128 + (((qtr * 2 + 1) ^ (kcol & 7)) << 4)) = p1;
#pragma unroll
      for (int i = 0; i < 4; ++i) { const int idx = tid + 512 * i, v = idx >> 4, kc = idx & 15; *(LAS v4u*)(sST + v * 256 + ((kc ^ (v & 15)) << 4)) = st[i]; } }
    __syncthreads();
    const int tt = w >> 1, trow = 16 * tt + fr;
#pragma unroll
    for (int sti = 0; sti < 2; ++sti) { const int stl = (w & 1) * 2 + sti; f32x4 acc = (f32x4){0.f, 0.f, 0.f, 0.f};
        if (stl <= tt) {
#pragma unroll
            for (int ks = 0; ks < 4; ++ks) { const int ch = ks * 4 + fq, srow = 16 * stl + fr;
                const bf16x8 af = *(const LAS bf16x8*)(sKm + srow * 256 + ((ch ^ (srow & 15)) << 4));
                const bf16x8 bfm = *(const LAS bf16x8*)(sQm + trow * 256 + ((ch ^ (trow & 15)) << 4));
                acc = __builtin_amdgcn_mfma_f32_16x16x32_bf16(af, bfm, acc, 0, 0, 0); } }
        const int s0 = 16 * stl + fq * 4;
        const float p0 = (s0 + 0 <= trow) ? acc[0] : 0.f, p1 = (s0 + 1 <= trow) ? acc[1] : 0.f, p2 = (s0 + 2 <= trow) ? acc[2] : 0.f, p3 = (s0 + 3 <= trow) ? acc[3] : 0.f;
        v2u o; o.x = pk2(p0, p1); o.y = pk2(p2, p3);
        *(LAS v2u*)(sP + trow * 128 + ((((s0 >> 3) ^ (trow & 7))) << 4) + (s0 & 7) * 2) = o; }
    __syncthreads();
    f32x4 oacc[4];
#pragma unroll
    for (int i = 0; i < 4; ++i) oacc[i] = (f32x4){0.f, 0.f, 0.f, 0.f};
#pragma unroll
    for (int ks = 0; ks < 4; ++ks) { const int ch = ks * 4 + fq;
        const bf16x8 bfm = *(const LAS bf16x8*)(sQt + trow * 256 + ((ch ^ (trow & 15)) << 4));
#pragma unroll
        for (int i = 0; i < 4; ++i) { const int vr = 16 * ((w & 1) * 4 + i) + fr; const bf16x8 af = *(const LAS bf16x8*)(sST + vr * 256 + ((ch ^ (vr & 15)) << 4));
            oacc[i] = __builtin_amdgcn_mfma_f32_16x16x32_bf16(af, bfm, oacc[i], 0, 0, 0); } }
#pragma unroll
    for (int ks = 0; ks < 2; ++ks) { const int ch = ks * 4 + fq;
        const bf16x8 bfm = *(const LAS bf16x8*)(sP + trow * 128 + ((ch ^ (trow & 7)) << 4));
#pragma unroll
        for (int i = 0; i < 4; ++i) { const int vr = 16 * ((w & 1) * 4 + i) + fr; const bf16x8 af = *(const LAS bf16x8*)(sVT + vr * 128 + ((ch ^ (vr & 7)) << 4));
            oacc[i] = __builtin_amdgcn_mfma_f32_16x16x32_bf16(af, bfm, oacc[i], 0, 0, 0); } }
    float ss = 0.f;
#pragma unroll
    for (int i = 0; i < 4; ++i) ss += (oacc[i][0] * oacc[i][0] + oacc[i][1] * oacc[i][1]) + (oacc[i][2] * oacc[i][2] + oacc[i][3] * oacc[i][3]);
    ss += __shfl_xor(ss, 16); ss += __shfl_xor(ss, 32);
    if (fq == 0) sSS[(w & 1) * 64 + trow] = ss;
    __syncthreads();
    const float rinv = 1.f / sqrtf((sSS[trow] + sSS[64 + trow]) * (1.f / 128.f) + RMS_EPS);
#pragma unroll
    for (int i = 0; i < 4; ++i) { const int v0 = 16 * ((w & 1) * 4 + i) + fq * 4;
        const v2u gw2 = *(const GAS v2u*)(Gb + (size_t)trow * 512 + v0); const f32x4 ng = *(const GAS f32x4*)(F.in[I_HGNG] + v0);
        const float g0 = __builtin_bit_cast(float, gw2.x << 16), g1 = __builtin_bit_cast(float, gw2.x & 0xffff0000u), g2 = __builtin_bit_cast(float, gw2.y << 16), g3 = __builtin_bit_cast(float, gw2.y & 0xffff0000u);
        v2u o; o.x = pk2(oacc[i][0] * rinv * ng[0] * silu_f(g0), oacc[i][1] * rinv * ng[1] * silu_f(g1)); o.y = pk2(oacc[i][2] * rinv * ng[2] * silu_f(g2), oacc[i][3] * rinv * ng[3] * silu_f(g3));
        *(GAS v2u*)(MIX + (size_t)trow * 1024 + v0) = o; }
}

__device__ __forceinline__ void s5_tables_stage1(Frame& F) {
    const int gt = (F.vcu * NWAVES + F.wave) * 64 + F.lane, NGT = F.G * NWAVES * 64;
    const float* S5T = (const float*)(F.ws + WS_S5T); const float* PW = (const float*)(F.ws + WS_PW);
    float* KT = (float*)(F.ws + WS_KTAU); bf16* G5 = (bf16*)(F.ws + WS_G5); bf16* T5 = (bf16*)(F.ws + WS_T5);
    for (int i = gt; i < S5G * 32 * 256; i += NGT) { const int g = i >> 13, tau = (i >> 8) & 31, p = (i >> 4) & 15, q = i & 15;
        float acc = (tau == 0 && p == q) ? F.in[I_DSK][g * 16 + p] : 0.f;
        for (int n = 0; n < S5N; ++n) { const int gn = g * S5N + n;
            const float cr = F.in[I_CRE][(size_t)(g * 16 + p) * S5N + n], ci = F.in[I_CIM][(size_t)(g * 16 + p) * S5N + n];
            const float wr = PW[((size_t)gn * 33 + tau) * 2], wi = PW[((size_t)gn * 33 + tau) * 2 + 1];
            const float br = S5T[(size_t)gn * 40 + 2 + q], bi = S5T[(size_t)gn * 40 + 18 + q];
            const float er = cr * wr - ci * wi, ei = cr * wi + ci * wr;
            acc += er * br - ei * bi; }
        KT[i] = acc; }
    for (int i = gt; i < S5G * 256 * 64; i += NGT) { const int g = i >> 14, r = (i >> 6) & 255, kc = i & 63, sdx = kc >> 1, q0 = (kc & 1) * 8;
        float f[8];
        if (r < 128) { const int n = r & 63, gn = g * S5N + n; const float wr = PW[((size_t)gn * 33 + (31 - sdx)) * 2], wi = PW[((size_t)gn * 33 + (31 - sdx)) * 2 + 1];
#pragma unroll
            for (int j = 0; j < 8; ++j) { const float br = S5T[(size_t)gn * 40 + 2 + q0 + j], bi = S5T[(size_t)gn * 40 + 18 + q0 + j]; f[j] = (r < 64) ? (wr * br - wi * bi) : (wr * bi + wi * br); }
        } else {
#pragma unroll
            for (int j = 0; j < 8; ++j) f[j] = 0.f; }
        *(GAS v4u*)(G5 + ((size_t)(g * 256 + r)) * 512 + kc * 8) = pack8(f); }
    for (int i = gt; i < S5G * 512 * 16; i += NGT) { const int g = i >> 13, row = (i >> 4) & 511, nc = i & 15, t = row >> 4, p = row & 15, im = nc >> 3, n0 = (nc & 7) * 8;
        float f[8];
#pragma unroll
        for (int j = 0; j < 8; ++j) { const int n = n0 + j, gn = g * S5N + n;
            const float cr = F.in[I_CRE][(size_t)(g * 16 + p) * S5N + n], ci = F.in[I_CIM][(size_t)(g * 16 + p) * S5N + n];
            const float wr = PW[((size_t)gn * 33 + t + 1) * 2], wi = PW[((size_t)gn * 33 + t + 1) * 2 + 1];
            f[j] = im ? -(cr * wi + ci * wr) : (cr * wr - ci * wi); }
        *(GAS v4u*)(T5 + ((size_t)(g * 512 + row)) * 640 + 512 + nc * 8) = pack8(f); }
}
__device__ __forceinline__ void s5_tables_stage2(Frame& F) {
    const int gt = (F.vcu * NWAVES + F.wave) * 64 + F.lane, NGT = F.G * NWAVES * 64;
    const float* KT = (const float*)(F.ws + WS_KTAU); bf16* T5 = (bf16*)(F.ws + WS_T5);
    for (int i = gt; i < S5G * 512 * 64; i += NGT) { const int g = i >> 15, row = (i >> 6) & 511, kc = i & 63, t = row >> 4, p = row & 15, sdx = kc >> 1, q0 = (kc & 1) * 8;
        float f[8];
        if (sdx <= t) { const float* k = KT + (((size_t)g * 32 + (t - sdx)) * 16 + p) * 16 + q0;
#pragma unroll
            for (int j = 0; j < 8; ++j) f[j] = k[j];
        } else {
#pragma unroll
            for (int j = 0; j < 8; ++j) f[j] = 0.f; }
        *(GAS v4u*)(T5 + ((size_t)(g * 512 + row)) * 640 + kc * 8) = pack8(f); }
}
__device__ __forceinline__ void s5_scan(Frame& F, int idx) {
    const int b = idx >> 11, g = (idx >> 6) & 31, n = idx & 63;
    const float* PW = (const float*)(F.ws + WS_PW); const float* XL = (const float*)(F.ws + WS_XLOC); bf16* A5 = (bf16*)(F.ws + WS_A5);
    const float ar = PW[((size_t)(g * S5N + n) * 33 + 32) * 2], ai = PW[((size_t)(g * S5N + n) * 33 + 32) * 2 + 1];
    float xr = 0.f, xi = 0.f;
    for (int c0 = 0; c0 < 128; c0 += 8) {
        float lr[8], li[8];
#pragma unroll
        for (int j = 0; j < 8; ++j) { const float* p = XL + ((size_t)(b * 128 + c0 + j) * 32 + g) * 128 + n; lr[j] = p[0]; li[j] = p[64]; }
#pragma unroll
        for (int j = 0; j < 8; ++j) { bf16* o = A5 + ((size_t)g * S5I + b * 128 + c0 + j) * 640 + 512 + n; o[0] = (bf16)f2bf(xr); o[64] = (bf16)f2bf(xi);
            const float nr = ar * xr - ai * xi + lr[j], ni = ar * xi + ai * xr + li[j]; xr = nr; xi = ni; }
    }
}

__device__ __forceinline__ void ln1_row(bf16* row, const float* g, const float* b, int lane) {
    const v4u w0 = *(const GAS v4u*)(row + lane * 8), w1 = *(const GAS v4u*)(row + 512 + lane * 8);
    float a[8], c[8]; unpack8(w0, a); unpack8(w1, c);
    float s = 0.f;
#pragma unroll
    for (int j = 0; j < 8; ++j) s += a[j] + c[j];
    const float mean = wave_sum(s) * (1.f / D); float s2 = 0.f;
#pragma unroll
    for (int j = 0; j < 8; ++j) { a[j] -= mean; c[j] -= mean; s2 += a[j] * a[j] + c[j] * c[j]; }
    const float rstd = 1.f / sqrtf(wave_sum(s2) * (1.f / D) + LN_EPS);
    const f32x4 g0 = *(const GAS f32x4*)(g + lane * 8), g1 = *(const GAS f32x4*)(g + lane * 8 + 4), g2 = *(const GAS f32x4*)(g + 512 + lane * 8), g3 = *(const GAS f32x4*)(g + 512 + lane * 8 + 4);
    const f32x4 b0 = *(const GAS f32x4*)(b + lane * 8), b1 = *(const GAS f32x4*)(b + lane * 8 + 4), b2 = *(const GAS f32x4*)(b + 512 + lane * 8), b3 = *(const GAS f32x4*)(b + 512 + lane * 8 + 4);
    const float gg0[8] = {g0.x, g0.y, g0.z, g0.w, g1.x, g1.y, g1.z, g1.w}, gg1[8] = {g2.x, g2.y, g2.z, g2.w, g3.x, g3.y, g3.z, g3.w};
    const float bb0[8] = {b0.x, b0.y, b0.z, b0.w, b1.x, b1.y, b1.z, b1.w}, bb1[8] = {b2.x, b2.y, b2.z, b2.w, b3.x, b3.y, b3.z, b3.w};
#pragma unroll
    for (int j = 0; j < 8; ++j) { a[j] = a[j] * rstd * gg0[j] + bb0[j]; c[j] = c[j] * rstd * gg1[j] + bb1[j]; }
    *(GAS v4u*)(row + lane * 8) = pack8(a); *(GAS v4u*)(row + 512 + lane * 8) = pack8(c);
}

typedef float f32x16 __attribute__((ext_vector_type(16)));
__device__ __forceinline__ int f2ord(float f) { const int x = __builtin_bit_cast(int, f); return x ^ ((x >> 31) & 0x7fffffff); }
__device__ __forceinline__ float ord2f(int x) { return __builtin_bit_cast(float, x ^ ((x >> 31) & 0x7fffffff)); }
#define CE_DESC(a, b) do { const int _h = max((a), (b)), _l = min((a), (b)); (a) = _h; (b) = _l; } while (0)
__device__ __forceinline__ void sort16_desc(int (&v)[16]) {
#pragma unroll
    for (int k = 2; k <= 16; k <<= 1)
#pragma unroll
        for (int j = k >> 1; j > 0; j >>= 1)
#pragma unroll
            for (int i = 0; i < 16; ++i) { const int l = i ^ j; if (l > i) { if ((i & k) == 0) CE_DESC(v[i], v[l]); else CE_DESC(v[l], v[i]); } }
}
__device__ __forceinline__ void merge16_desc(int (&a)[16], const int (&b)[16]) {
#pragma unroll
    for (int i = 0; i < 16; ++i) a[i] = max(a[i], b[15 - i]);
#pragma unroll
    for (int j = 8; j > 0; j >>= 1)
#pragma unroll
        for (int i = 0; i < 16; ++i) { const int l = i ^ j; if (l > i) CE_DESC(a[i], a[l]); }
}
__device__ __forceinline__ void peer_topk_side(const f32x16 (&acc)[4], int hi, int (&top)[16]) {
    int t[4][16];
#pragma unroll
    for (int kt = 0; kt < 4; ++kt)
#pragma unroll
        for (int j = 0; j < 16; ++j) { const unsigned key = (unsigned)(kt * 32 + (j & 3) + 8 * (j >> 2)) | (unsigned)(4 * hi);
            const float av = acc[kt][j];
            t[kt][j] = f2ord(__builtin_bit_cast(float, (__builtin_bit_cast(unsigned, av) & 0xFFFFFF80u) | key)); }
    sort16_desc(t[0]); sort16_desc(t[1]); sort16_desc(t[2]); sort16_desc(t[3]);
    merge16_desc(t[0], t[1]); merge16_desc(t[2], t[3]); merge16_desc(t[0], t[2]);
    int p[16];
#pragma unroll
    for (int i = 0; i < 16; ++i) p[i] = __shfl_xor(t[0][i], 32);
    merge16_desc(t[0], p);
#pragma unroll
    for (int i = 0; i < 16; ++i) top[i] = t[0][i];
}
__device__ __forceinline__ void peer_score_phase(Frame& F) {
    LAS unsigned char* kl = F.lds + RING_OFF;
    LAS unsigned* look = (LAS unsigned*)(F.lds + RING_OFF + 65536 + F.wave * 8192);
    const bf16* keys = (const bf16*)(F.ws + WS_KEYS);
    for (int i = F.tid; i < 2 * 128 * 16; i += NWAVES * 64) { const int sn = i >> 4, c = i & 15, n = sn & 127;
        *(LAS v4u*)(kl + sn * 256 + ((c ^ (n & 15)) << 4)) = *(const GAS v4u*)(keys + (size_t)sn * 128 + c * 8); }
    __syncthreads();
    const int gw = F.vcu * NWAVES + F.wave, NGW = F.G * NWAVES, lane = F.lane, r32 = lane & 31, hi = lane >> 5;
    const bf16* Q2 = (const bf16*)(F.ws + WS_Q2);
    int* EIDX = (int*)(F.ws + WS_EIDX); float* EGATE = (float*)(F.ws + WS_EGATE);
    for (int unit = gw; unit < (M / 32) * PH; unit += NGW) {
        const int blk = unit >> 3, h = unit & 7; const size_t tok = (size_t)blk * 32 + r32;
        const bf16* qrow = Q2 + tok * NQ2 + h * PQ + hi * 8;
        int top1[16], top2[16];
#pragma unroll
        for (int s = 0; s < 2; ++s) {
            bf16x8 qf[8];
#pragma unroll
            for (int ks = 0; ks < 8; ++ks) qf[ks] = *(const GAS bf16x8*)(qrow + s * 128 + ks * 16);
            f32x16 acc[4];
#pragma unroll
            for (int kt = 0; kt < 4; ++kt) { acc[kt] = (f32x16){0.f, 0.f, 0.f, 0.f, 0.f, 0.f, 0.f, 0.f, 0.f, 0.f, 0.f, 0.f, 0.f, 0.f, 0.f, 0.f};
                const int n = kt * 32 + r32;
#pragma unroll
                for (int ks = 0; ks < 8; ++ks) { const bf16x8 kf = *(const LAS bf16x8*)(kl + (s * 128 + n) * 256 + (((2 * ks + hi) ^ (n & 15)) << 4));
                    acc[kt] = __builtin_amdgcn_mfma_f32_32x32x16_bf16(kf, qf[ks], acc[kt], 0, 0, 0); } }
            if (s == 0) peer_topk_side(acc, hi, top1); else peer_topk_side(acc, hi, top2);
        }
        float v1[16], v2[16];
#pragma unroll
        for (int i = 0; i < 16; ++i) { v1[i] = ord2f(top1[i]); v2[i] = ord2f(top2[i]);
            look[i * 64 + lane] = __builtin_bit_cast(unsigned, v1[i]) & 0x7Fu; look[(16 + i) * 64 + lane] = __builtin_bit_cast(unsigned, v2[i]) & 0x7Fu; }
        int c[4][16]; int nc = 0;
#pragma unroll
        for (int i = 0; i < 16; ++i)
#pragma unroll
            for (int j = 0; j < 16; ++j) if ((i + 1) * (j + 1) <= 16) { const float sum = v1[i] + v2[j];
                c[nc >> 4][nc & 15] = f2ord(__builtin_bit_cast(float, (__builtin_bit_cast(unsigned, sum) & 0xFFFFFF00u) | (unsigned)(i * 16 + j))); ++nc; }
#pragma unroll
        for (int q = 50; q < 64; ++q) c[q >> 4][q & 15] = (int)0x80000000;
        sort16_desc(c[0]); sort16_desc(c[1]); sort16_desc(c[2]); sort16_desc(c[3]);
        merge16_desc(c[0], c[1]); merge16_desc(c[2], c[3]); merge16_desc(c[0], c[2]);
        float e[16], sum = 0.f;
        float cf[16];
#pragma unroll
        for (int k = 0; k < 16; ++k) cf[k] = ord2f(c[0][k]);
#pragma unroll
        for (int k = 0; k < 16; ++k) { e[k] = __expf(cf[k] - cf[0]); sum += e[k]; }
        const float inv = 1.f / sum;
        LDS_WAIT();
        int ex[8]; float gt[8];
#pragma unroll
        for (int k = 0; k < 8; ++k) { const float cv = hi ? cf[8 + k] : cf[k]; gt[k] = (hi ? e[8 + k] : e[k]) * inv;
            const unsigned pos = __builtin_bit_cast(unsigned, cv) & 0xFFu;
            ex[k] = (int)(look[(pos >> 4) * 64 + lane] * PK + look[(16 + (pos & 15)) * 64 + lane]); }
        int* eo = EIDX + (tok * PH + h) * 16 + hi * 8; float* go = EGATE + (tok * PH + h) * 16 + hi * 8;
        *(GAS v4u*)eo = (v4u){(unsigned)ex[0], (unsigned)ex[1], (unsigned)ex[2], (unsigned)ex[3]}; *(GAS v4u*)(eo + 4) = (v4u){(unsigned)ex[4], (unsigned)ex[5], (unsigned)ex[6], (unsigned)ex[7]};
        *(GAS f32x4*)go = (f32x4){gt[0], gt[1], gt[2], gt[3]}; *(GAS f32x4*)(go + 4) = (f32x4){gt[4], gt[5], gt[6], gt[7]};
        LDS_WAIT();
    }
}

typedef float f32x2 __attribute__((ext_vector_type(2)));
constexpr float PD_SCALE = 256.f, PU_SCALE = 32.f;
__device__ __forceinline__ void unpack_fp8x16(const v4u w, float (&f)[16]) {
    const unsigned ww[4] = {w.x, w.y, w.z, w.w};
#pragma unroll
    for (int i = 0; i < 4; ++i) { const f32x2 lo = __builtin_amdgcn_cvt_pk_f32_fp8((int)ww[i], false), hi = __builtin_amdgcn_cvt_pk_f32_fp8((int)ww[i], true);
        f[4 * i] = lo[0]; f[4 * i + 1] = lo[1]; f[4 * i + 2] = hi[0]; f[4 * i + 3] = hi[1]; }
}
__device__ __forceinline__ void peer_gather_phase(Frame& F) {
    const int gw = F.vcu * NWAVES + F.wave, NGW = F.G * NWAVES, lane = F.lane;
    const bf16* H1 = (const bf16*)(F.ws + WS_H); const unsigned char* PD = F.ws + WS_PD; const unsigned char* PU = F.ws + WS_PU;
    const int* EIDX = (const int*)(F.ws + WS_EIDX); const float* EGATE = (const float*)(F.ws + WS_EGATE);
    const int rep = ((lane >> 5) & 1) * 4 + ((lane >> 4) & 1) * 2 + ((lane >> 3) & 1);
    for (int tok = gw; tok < M; tok += NGW) {
        float x[16]; { float a[8], c[8]; unpack8(*(const GAS v4u*)(H1 + (size_t)tok * D + lane * 16), a); unpack8(*(const GAS v4u*)(H1 + (size_t)tok * D + lane * 16 + 8), c);
#pragma unroll
            for (int j = 0; j < 8; ++j) { x[j] = a[j]; x[8 + j] = c[j]; } }
        const int e0 = EIDX[(size_t)tok * 128 + lane], e1 = EIDX[(size_t)tok * 128 + 64 + lane];
        const float g0 = EGATE[(size_t)tok * 128 + lane], g1 = EGATE[(size_t)tok * 128 + 64 + lane];
        float o[16];
#pragma unroll
        for (int j = 0; j < 16; ++j) o[j] = 0.f;
#pragma unroll 1
        for (int bt = 0; bt < 16; ++bt) {
            const int ev = (bt < 8) ? e0 : e1; const float gv = (bt < 8) ? g0 : g1; const int lb8 = (bt & 7) * 8;
            v4u dw[8], uw[8];
#pragma unroll
            for (int i = 0; i < 8; ++i) { const int e = __builtin_amdgcn_readlane(ev, lb8 + i);
                dw[i] = *(const GAS v4u*)(PD + (size_t)e * D + lane * 16); uw[i] = *(const GAS v4u*)(PU + (size_t)e * D + lane * 16); }
            float p[8];
#pragma unroll
            for (int i = 0; i < 8; ++i) { float a[16]; unpack_fp8x16(dw[i], a); float s = 0.f;
#pragma unroll
                for (int j = 0; j < 16; ++j) s += a[j] * x[j];
                p[i] = s; }
#pragma unroll
            for (int i = 0; i < 4; ++i) { const float keep = (lane & 32) ? p[i + 4] : p[i], send = (lane & 32) ? p[i] : p[i + 4]; p[i] = keep + __shfl_xor(send, 32); }
#pragma unroll
            for (int i = 0; i < 2; ++i) { const float keep = (lane & 16) ? p[i + 2] : p[i], send = (lane & 16) ? p[i] : p[i + 2]; p[i] = keep + __shfl_xor(send, 16); }
            { const float keep = (lane & 8) ? p[1] : p[0], send = (lane & 8) ? p[0] : p[1]; p[0] = keep + __shfl_xor(send, 8); }
            p[0] += __shfl_xor(p[0], 4); p[0] += __shfl_xor(p[0], 2); p[0] += __shfl_xor(p[0], 1);
            const float gate = __shfl(gv, lb8 + rep);
            const float act = gelu_tanh(p[0] * (1.f / PD_SCALE)) * gate * (1.f / PU_SCALE);
#pragma unroll
            for (int i = 0; i < 8; ++i) { const float af = __builtin_bit_cast(float, __builtin_amdgcn_readlane(__builtin_bit_cast(int, act), ((i >> 2) & 1) * 32 + ((i >> 1) & 1) * 16 + (i & 1) * 8));
                float a[16]; unpack_fp8x16(uw[i], a);
#pragma unroll
                for (int j = 0; j < 16; ++j) o[j] += af * a[j]; }
        }
        float s = 0.f;
#pragma unroll
        for (int j = 0; j < 16; ++j) { o[j] += DN_ALPHA * x[j]; s += o[j]; }
        const float mean = wave_sum(s) * (1.f / D); float s2 = 0.f;
#pragma unroll
        for (int j = 0; j < 16; ++j) { o[j] -= mean; s2 += o[j] * o[j]; }
        const float rstd = 1.f / sqrtf(wave_sum(s2) * (1.f / D) + LN_EPS);
        const float* g = F.in[I_LN2G] + lane * 16; const float* b = F.in[I_LN2B] + lane * 16;
        float* orow = F.out + (size_t)tok * D + lane * 16;
#pragma unroll
        for (int q = 0; q < 4; ++q) { const f32x4 ga = *(const GAS f32x4*)(g + 4 * q), ba = *(const GAS f32x4*)(b + 4 * q);
            f32x4 y; y.x = o[4 * q + 0] * rstd * ga.x + ba.x; y.y = o[4 * q + 1] * rstd * ga.y + ba.y; y.z = o[4 * q + 2] * rstd * ga.z + ba.z; y.w = o[4 * q + 3] * rstd * ga.w + ba.w;
            *(GAS f32x4*)(orow + 4 * q) = y; }
    }
}

struct Args { const float* in[26]; float* out; unsigned char* ws; int ph_lo, ph_hi, li, pad; };
__global__ void __launch_bounds__(NWAVES * 64, 2) fwd_kernel(Args args) {
    extern __shared__ __attribute__((aligned(16))) unsigned char lds[];
    Frame F;
    F.lds = (LAS unsigned char*)lds;
    F.MISC = (volatile LAS unsigned*)(F.lds + MISC_OFF);
    F.tid = threadIdx.x; F.lane = F.tid & 63; F.wave = __builtin_amdgcn_readfirstlane(F.tid >> 6);
    F.G = gridDim.x; { const int bx = blockIdx.x; F.vcu = (F.G % 8 == 0) ? (bx % 8) * (F.G / 8) + bx / 8 : bx; }
#pragma unroll
    for (int i = 0; i < 26; ++i) F.in[i] = args.in[i];
    F.out = args.out; F.ws = args.ws;
    unsigned char* ws = args.ws;
    F.ctl = (gu32*)(ws + WS_CTL);
    for (int u = F.tid; u < (LDS_BYTES - LDSCTL_OFF) / 4; u += NWAVES * 64) ((LAS unsigned*)(F.lds + LDSCTL_OFF))[u] = 0u;
    __syncthreads();
    XcdBarrier bar; bar.bar = (unsigned*)(F.ctl + CW_BAR); bar.x = 0; bar.st = nullptr;
    if (N_LAUNCHES == 1) bar = xcd_barrier_post((unsigned*)(F.ctl + CW_BAR), F.MISC + 8);
#define GRID_BAR() do { if (N_LAUNCHES == 1) xcd_barrier(bar); } while (0)
    const int lo = args.ph_lo, hi = args.ph_hi;
#define IN(k) (lo <= (k) && (k) < hi)
#define BOTH(k) (IN(k) && IN((k) + 1))
    bf16* const Hb = (bf16*)(ws + WS_H);
    bf16* const PRJ = (bf16*)(ws + WS_PROJ);

    if (IN(0)) { p0_prologue(F); if (BOTH(0)) GRID_BAR(); }

    if (IN(1)) {
        s5_tables_stage1(F);
        pg8::Gemm g{Hb, (const bf16*)(ws + WS_WIN), M, NPROJ, D, D, D}; pg8::StaticOrder S; S.init(M, NPROJ, F.G, (int)blockIdx.x);
        pg8::EpiProj E{PRJ, PRJ + (size_t)M * 512, PRJ + (size_t)2 * M * 512, PRJ + (size_t)3 * M * 512, (bf16*)(ws + WS_A5), (const float*)(ws + WS_LB), M};
        pg8::gemm_phase<pg8::EpiProj, pg8::StaticOrder, true, true>(F.lds + RING_OFF, g, S, E);
        if (BOTH(1)) GRID_BAR();
    }

    if (IN(2)) {
        s5_tables_stage2(F);
        if (F.vcu < 128) hgrn2_state_pass(F, F.vcu);
        else { pg8::Gemm g{(const bf16*)(ws + WS_A5), (const bf16*)(ws + WS_G5), 32 * S5I, 32 * 256, 512, S5K, 512}; pg8::GroupedOrder S{4, 1, F.G - 128, F.vcu - 128};
            pg8::EpiS5A E{(float*)(ws + WS_XLOC)};
            pg8::gemm_phase<pg8::EpiS5A, pg8::GroupedOrder, true, true>(F.lds + RING_OFF, g, S, E); }
        if (BOTH(2)) GRID_BAR();
    }

    if (IN(3)) {
        if (F.vcu < 32) s5_scan(F, F.vcu * 512 + F.tid);
        for (int it = F.vcu; it < 32 * 64; it += F.G) { hgrn2_out_item(F, it); __syncthreads(); }
        if (BOTH(3)) GRID_BAR();
    }

    if (IN(4)) {
        pg8::Gemm g{(const bf16*)(ws + WS_A5), (const bf16*)(ws + WS_T5), 32 * S5I, 32 * 512, S5K, S5K, S5K}; pg8::GroupedOrder S{4, 2, F.G, F.vcu};
        pg8::EpiS5C E{(bf16*)(ws + WS_Z)};
        pg8::gemm_phase<pg8::EpiS5C, pg8::GroupedOrder, true, true>(F.lds + RING_OFF, g, S, E);
        if (BOTH(4)) GRID_BAR();
    }

    if (IN(5)) {
        pg8::Gemm g{(const bf16*)(ws + WS_Z), (const bf16*)(ws + WS_WGLU), M, 512, 512, 512, 512}; pg8::StaticOrder S; S.init(M, 512, F.G, (int)blockIdx.x);
        pg8::EpiGlu E{(const bf16*)(ws + WS_Z), (bf16*)(ws + WS_MIX), F.in[I_BGLU]};
        pg8::gemm_phase<pg8::EpiGlu, pg8::StaticOrder, true, true>(F.lds + RING_OFF, g, S, E);
        if (BOTH(5)) GRID_BAR();
    }

    if (IN(6)) {
        pg8::Gemm g{(const bf16*)(ws + WS_MIX), (const bf16*)(ws + WS_WOUT), M, D, D, D, D}; pg8::StaticOrder S; S.init(M, D, F.G, (int)blockIdx.x);
        pg8::EpiOut E{Hb, DN_ALPHA};
        pg8::gemm_phase<pg8::EpiOut, pg8::StaticOrder, true, true>(F.lds + RING_OFF, g, S, E);
        if (BOTH(6)) GRID_BAR();
    }

    if (IN(7)) {
        const int gw = F.vcu * NWAVES + F.wave, NGW = F.G * NWAVES;
        for (int m = gw; m < M; m += NGW) ln1_row(Hb + (size_t)m * D, F.in[I_LN1G], F.in[I_LN1B], F.lane);
        { const int gt = gw * 64 + F.lane, NGT = NGW * 64;
          constexpr int NTAB16 = PE * D / 16;
          for (int i = gt; i < 2 * NTAB16; i += NGT) { const bool up = i >= NTAB16; const int j = up ? i - NTAB16 : i; const float* src = (up ? F.in[I_PU] : F.in[I_PD]) + (size_t)j * 16; const float sc = up ? PU_SCALE : PD_SCALE;
              v4u o; unsigned ow[4];
#pragma unroll
              for (int q = 0; q < 4; ++q) { const f32x4 a = *(const GAS f32x4*)(src + 4 * q); int pk = __builtin_amdgcn_cvt_pk_fp8_f32(a.x * sc, a.y * sc, 0, false); pk = __builtin_amdgcn_cvt_pk_fp8_f32(a.z * sc, a.w * sc, pk, true); ow[q] = (unsigned)pk; }
              o.x = ow[0]; o.y = ow[1]; o.z = ow[2]; o.w = ow[3];
              *(GAS v4u*)(ws + (up ? WS_PU : WS_PD) + (size_t)j * 16) = o; }
        }
        if (BOTH(7)) GRID_BAR();
    }

    if (IN(8)) {
        pg8::Gemm g{Hb, (const bf16*)(ws + WS_WQ), M, NQ2, D, D, D}; pg8::StaticOrder S; S.init(M, NQ2, F.G, (int)blockIdx.x);
        pg8::EpiStore E{(bf16*)(ws + WS_Q2), NQ2};
        pg8::gemm_phase<pg8::EpiStore, pg8::StaticOrder, true, true>(F.lds + RING_OFF, g, S, E);
        if (BOTH(8)) GRID_BAR();
    }

    if (IN(9)) { peer_score_phase(F); if (BOTH(9)) GRID_BAR(); }

    if (IN(10)) { peer_gather_phase(F); }
#undef IN
#undef BOTH
}

extern "C" void kernel_launch(void* const* d_in, const int* in_sizes, int n_in, void* d_out, int out_size, void* d_ws, size_t ws_size, hipStream_t stream) {
    static int grid = 0;
    if (grid == 0) {
        if (n_in != 26 || in_sizes[0] != M * D || out_size != M * D || ws_size < WS_END) { fprintf(stderr, "kernel_launch: unexpected shapes: n_in %d in0 %d out %d ws %zu (need %zu)\n", n_in, n_in > 0 ? in_sizes[0] : -1, out_size, ws_size, (size_t)WS_END); grid = -1; return; }
        int dev = 0, cus = 0;
        if (hipGetDevice(&dev) != hipSuccess || hipDeviceGetAttribute(&cus, hipDeviceAttributeMultiprocessorCount, dev) != hipSuccess) { grid = -1; return; }
        if (hipFuncSetAttribute((const void*)fwd_kernel, hipFuncAttributeMaxDynamicSharedMemorySize, LDS_BYTES) != hipSuccess) { fprintf(stderr, "kernel_launch: hipFuncSetAttribute failed\n"); grid = -1; return; }
        (void)hipGetLastError();
        grid = cus;
    }
    if (grid < 0) return;
    if (hipMemsetAsync((char*)d_ws + WS_CTL, 0, CTL_ZERO_BYTES, stream) != hipSuccess) return;
    Args a{};
    for (int i = 0; i < 26; ++i) a.in[i] = (const float*)d_in[i];
    a.out = (float*)d_out; a.ws = (unsigned char*)d_ws;
    if (N_LAUNCHES == 1) { a.ph_lo = 0; a.ph_hi = NPH; a.li = 0; hipLaunchKernelGGL(fwd_kernel, dim3(grid), dim3(NWAVES * 64), LDS_BYTES, stream, a); }
    else for (int li = 0; li < NPH; ++li) { a.ph_lo = li; a.ph_hi = li + 1; a.li = li; hipLaunchKernelGGL(fwd_kernel, dim3(grid), dim3(NWAVES * 64), LDS_BYTES, stream, a); }
}
```

```cpp
#include <hip/hip_runtime.h>
#include <cstdio>
#include <cstdint>
namespace pg8 {
#define PG8_LAS __attribute__((address_space(3)))
typedef unsigned short bf16_t;
typedef short bf16x8 __attribute__((ext_vector_type(8)));
typedef float f32x4 __attribute__((ext_vector_type(4)));
typedef unsigned u32x4 __attribute__((ext_vector_type(4)));
constexpr int BM = 256, BK = 64, HALF = 128, HTB = HALF * BK * 2  , STAGE_BYTES = 8 * HTB, NXCD = 8, WGM = 8;

__host__ __device__ __forceinline__ int lds_byte(int r, int c) { const int st = (r >> 4) * 2 + (c >> 5), rr = r & 15, cc = c & 31, ob = rr * 64 + cc * 2; return st * 1024 + (ob ^ (((ob >> 9) & 1) << 5)); }
__host__ __device__ __forceinline__ void stage_rc(int b, int& R, int& C) { const int st = b / 1024, sb = b % 1024, swz = sb ^ (((sb >> 9) & 1) << 5); R = (st >> 1) * 16 + swz / 64; C = (st & 1) * 32 + (swz % 64) / 2; }
__host__ __device__ __forceinline__ int perm32(int rho) { const int n = rho >> 4, i = rho & 15; return 8 * (i >> 2) + 4 * n + (i & 3); }

struct Unit { int pm, pn; };
struct Gemm { const bf16_t* A; const bf16_t* Bt; int M, N, K, lda, ldb; };

struct StaticOrder {
    int nM, nN, nwg, G, c;
    __host__ __device__ void init(int M, int N, int G_, int c_) { nM = M / BM; nN = N / BM; nwg = nM * nN; G = G_; c = c_; }
    __host__ __device__ bool next(int i, Unit& u) const {
        const long L = (long)i * G + c; if (L >= nwg) return false;
        int wgid = (int)L; { const int q = nwg / NXCD, r = nwg % NXCD, xcd = wgid % NXCD, off = wgid / NXCD; wgid = (xcd < r ? xcd * (q + 1) : r * (q + 1) + (xcd - r) * q) + off; }
        const int nig = WGM * nN, gid = wgid / nig, fm = gid * WGM, gsz = (nM - fm) < WGM ? (nM - fm) : WGM;
        u.pm = fm + ((wgid % nig) % gsz); u.pn = (wgid % nig) / gsz; return true;
    }
    __device__ __forceinline__ void a_ready(const Unit&) const {}
    __device__ __forceinline__ void done(const Unit&) const {}
};

__device__ __forceinline__ unsigned cvt_pk_bf16(float lo, float hi) { unsigned r; asm volatile("v_cvt_pk_bf16_f32 %0, %1, %2" : "=v"(r) : "v"(lo), "v"(hi)); return r; }
__device__ __forceinline__ void unpack8(const u32x4 w, float (&f)[8]) {
    f[0] = __builtin_bit_cast(float, w.x << 16); f[1] = __builtin_bit_cast(float, w.x & 0xffff0000u);
    f[2] = __builtin_bit_cast(float, w.y << 16); f[3] = __builtin_bit_cast(float, w.y & 0xffff0000u);
    f[4] = __builtin_bit_cast(float, w.z << 16); f[5] = __builtin_bit_cast(float, w.z & 0xffff0000u);
    f[6] = __builtin_bit_cast(float, w.w << 16); f[7] = __builtin_bit_cast(float, w.w & 0xffff0000u);
}
__device__ __forceinline__ u32x4 pack8(const float (&f)[8]) { u32x4 w; w.x = cvt_pk_bf16(f[0], f[1]); w.y = cvt_pk_bf16(f[2], f[3]); w.z = cvt_pk_bf16(f[4], f[5]); w.w = cvt_pk_bf16(f[6], f[7]); return w; }

struct EpiStore {
    static constexpr bool PERM = true, AFTER_DRAIN = false;
    bf16_t* O; int ldc;
    __device__ __forceinline__ void operator()(const f32x4 (&acc)[2][2][4][2], const Unit& u, int wr, int wc, int fr, int fq) const {
        const int row0 = u.pm * BM + wr * 64 + fr, col0 = u.pn * BM + wc * 32 + 8 * fq;
#pragma unroll
        for (int ai = 0; ai < 2; ++ai)
#pragma unroll
            for (int m = 0; m < 4; ++m) { bf16_t* rowp = O + (size_t)(row0 + ai * HALF + m * 16) * ldc + col0;
#pragma unroll
                for (int bj = 0; bj < 2; ++bj) { const f32x4 v0 = acc[ai][bj][m][0], v1 = acc[ai][bj][m][1];
                    u32x4 w; w.x = cvt_pk_bf16(v0[0], v0[1]); w.y = cvt_pk_bf16(v0[2], v0[3]); w.z = cvt_pk_bf16(v1[0], v1[1]); w.w = cvt_pk_bf16(v1[2], v1[3]);
                    *(u32x4*)(rowp + bj * HALF) = w; } }
    }
};

struct EpiProj {
    static constexpr bool PERM = true, AFTER_DRAIN = false;
    bf16_t* Qb; bf16_t* LFb; bf16_t* Vb; bf16_t* Gb; bf16_t* Ub; const float* lb; int M;
    __device__ __forceinline__ void operator()(const f32x4 (&acc)[2][2][4][2], const Unit& u, int wr, int wc, int fr, int fq) const {
        const int row0 = u.pm * BM + wr * 64 + fr; const int colt = u.pn * BM; const int t = colt >> 9;
        const int cb = (colt & 511) + wc * 32 + 8 * fq;
        float lbv[2][8];
        if (t == 1) {
#pragma unroll
            for (int bj = 0; bj < 2; ++bj) { const f32x4 a = *(const f32x4*)(lb + cb + bj * HALF), b = *(const f32x4*)(lb + cb + bj * HALF + 4);
                lbv[bj][0] = a[0]; lbv[bj][1] = a[1]; lbv[bj][2] = a[2]; lbv[bj][3] = a[3]; lbv[bj][4] = b[0]; lbv[bj][5] = b[1]; lbv[bj][6] = b[2]; lbv[bj][7] = b[3]; }
        }
#pragma unroll
        for (int ai = 0; ai < 2; ++ai)
#pragma unroll
            for (int m = 0; m < 4; ++m) { const int row = row0 + ai * HALF + m * 16;
#pragma unroll
                for (int bj = 0; bj < 2; ++bj) { const f32x4 v0 = acc[ai][bj][m][0], v1 = acc[ai][bj][m][1]; const int c = cb + bj * HALF;
                    float f[8] = {v0[0], v0[1], v0[2], v0[3], v1[0], v1[1], v1[2], v1[3]};
                    if (t == 0) {
#pragma unroll
                        for (int j = 0; j < 8; ++j) f[j] *= 0.08838834764831845f;
                        *(u32x4*)(Qb + (size_t)row * 512 + c) = pack8(f);
                    } else if (t == 1) {
#pragma unroll
                        for (int j = 0; j < 8; ++j) { const float l = lbv[bj][j]; const float sg = 1.f / (1.f + __expf(-f[j])); f[j] = __logf(l + (1.f - l) * sg); }
                        *(u32x4*)(LFb + (size_t)row * 512 + c) = pack8(f);
                    } else if (t == 2) { *(u32x4*)(Vb + (size_t)row * 512 + c) = pack8(f);
                    } else if (t == 3) { *(u32x4*)(Gb + (size_t)row * 512 + c) = pack8(f);
                    } else { *(u32x4*)(Ub + ((size_t)(c >> 4) * (M / 32) + (row >> 5)) * 640 + (row & 31) * 16 + (c & 15)) = pack8(f); }
                } }
    }
};

struct EpiGlu {
    static constexpr bool PERM = true, AFTER_DRAIN = false;
    const bf16_t* Z; bf16_t* MIX; const float* bglu;
    __device__ __forceinline__ void operator()(const f32x4 (&acc)[2][2][4][2], const Unit& u, int wr, int wc, int fr, int fq) const {
        const int row0 = u.pm * BM + wr * 64 + fr, col0 = u.pn * BM + wc * 32 + 8 * fq;
#pragma unroll
        for (int bj = 0; bj < 2; ++bj) { const int c = col0 + bj * HALF;
            const f32x4 b0 = *(const f32x4*)(bglu + c), b1 = *(const f32x4*)(bglu + c + 4);
#pragma unroll
            for (int ai = 0; ai < 2; ++ai)
#pragma unroll
                for (int m = 0; m < 4; ++m) { const int row = row0 + ai * HALF + m * 16;
                    const f32x4 v0 = acc[ai][bj][m][0] + b0, v1 = acc[ai][bj][m][1] + b1;
                    float z[8]; unpack8(*(const u32x4*)(Z + (size_t)row * 512 + c), z);
                    float f[8] = {v0[0], v0[1], v0[2], v0[3], v1[0], v1[1], v1[2], v1[3]};
#pragma unroll
                    for (int j = 0; j < 8; ++j) f[j] = z[j] / (1.f + __expf(-f[j]));
                    *(u32x4*)(MIX + (size_t)row * 1024 + 512 + c) = pack8(f); } }
    }
};

struct EpiOut {
    static constexpr bool PERM = true, AFTER_DRAIN = false;
    bf16_t* H; float alpha;
    __device__ __forceinline__ void operator()(const f32x4 (&acc)[2][2][4][2], const Unit& u, int wr, int wc, int fr, int fq) const {
        const int row0 = u.pm * BM + wr * 64 + fr, col0 = u.pn * BM + wc * 32 + 8 * fq;
#pragma unroll
        for (int ai = 0; ai < 2; ++ai)
#pragma unroll
            for (int m = 0; m < 4; ++m) { bf16_t* rowp = H + (size_t)(row0 + ai * HALF + m * 16) * 1024 + col0;
#pragma unroll
                for (int bj = 0; bj < 2; ++bj) { const f32x4 v0 = acc[ai][bj][m][0], v1 = acc[ai][bj][m][1];
                    float h[8]; unpack8(*(const u32x4*)(rowp + bj * HALF), h);
                    float f[8] = {v0[0], v0[1], v0[2], v0[3], v1[0], v1[1], v1[2], v1[3]};
#pragma unroll
                    for (int j = 0; j < 8; ++j) f[j] = alpha * h[j] + f[j];
                    *(u32x4*)(rowp + bj * HALF) = pack8(f); } }
    }
};

struct GroupedOrder {
    int tm, tn, G, c;
    __device__ bool next(int i, Unit& u) const { const int L = i * G + c, per = tm * tn; if (c < 0 || L >= 32 * per) return false;
        const int g = L / per, r = L % per; u.pm = g * tm + r % tm; u.pn = g * tn + r / tm; return true; }
    __device__ __forceinline__ void a_ready(const Unit&) const {}
    __device__ __forceinline__ void done(const Unit&) const {}
};
struct EpiS5A {
    static constexpr bool PERM = true, AFTER_DRAIN = false;
    float* X;
    __device__ __forceinline__ void operator()(const f32x4 (&acc)[2][2][4][2], const Unit& u, int wr, int wc, int fr, int fq) const {
        const int g = u.pn, inst0 = (u.pm & 3) * BM + wr * 64 + fr, col = wc * 32 + 8 * fq;
#pragma unroll
        for (int ai = 0; ai < 2; ++ai)
#pragma unroll
            for (int m = 0; m < 4; ++m) { float* p = X + ((size_t)(inst0 + ai * HALF + m * 16) * 32 + g) * 128 + col;
                *(f32x4*)p = acc[ai][0][m][0]; *(f32x4*)(p + 4) = acc[ai][0][m][1]; }
    }
};
struct EpiS5C {
    static constexpr bool PERM = true, AFTER_DRAIN = false;
    bf16_t* Z;
    __device__ __forceinline__ void operator()(const f32x4 (&acc)[2][2][4][2], const Unit& u, int wr, int wc, int fr, int fq) const {
        const int g = u.pm >> 2, inst0 = (u.pm & 3) * BM + wr * 64 + fr, col0 = (u.pn & 1) * BM + wc * 32 + 8 * fq;
#pragma unroll
        for (int ai = 0; ai < 2; ++ai)
#pragma unroll
            for (int m = 0; m < 4; ++m) { const int inst = inst0 + ai * HALF + m * 16; const size_t tok0 = (size_t)(inst >> 7) * 4096 + (size_t)(inst & 127) * 32;
#pragma unroll
                for (int bj = 0; bj < 2; ++bj) { const int col = col0 + bj * HALF; const f32x4 v0 = acc[ai][bj][m][0], v1 = acc[ai][bj][m][1];
                    float f[8] = {v0[0], v0[1], v0[2], v0[3], v1[0], v1[1], v1[2], v1[3]};
#pragma unroll
                    for (int j = 0; j < 8; ++j) { const float x = f[j], y = 0.7978845608028654f * (x + 0.044715f * x * x * x); f[j] = x / (1.f + __expf(-2.f * y)); }
                    *(u32x4*)(Z + (tok0 + (col >> 4)) * 512 + g * 16 + (col & 15)) = pack8(f); } }
    }
};

template <class Epi, class Sched, bool ALIGN_EPI = false, bool SP2 = false>
__device__ __forceinline__ void gemm_phase(PG8_LAS unsigned char* lds, const Gemm g, const Sched& S, const Epi& E) {
    const int tid = threadIdx.x, wid = __builtin_amdgcn_readfirstlane(tid >> 6), lane = tid & 63, wr = wid >> 2, wc = wid & 3, fr = lane & 15, fq = lane >> 4;
    const int K = g.K, nt = K / BK;
    unsigned voffA[2], voffB[2];
#pragma unroll
    for (int i = 0; i < 2; ++i) { int R, C; stage_rc(tid * 16 + i * 8192, R, C); const int Rb = Epi::PERM ? ((R & ~31) + perm32(R & 31)) : R;
        voffA[i] = (unsigned)(R * g.lda + C) * 2u; voffB[i] = (unsigned)(Rb * g.ldb + C) * 2u; }
    const size_t kstep = (size_t)(BK * 2);
    const size_t hstepA = (size_t)HALF * g.lda * 2, hstepB = (size_t)HALF * g.ldb * 2;
    const size_t tstepA = 2 * hstepA, tstepB = 2 * hstepB;
    const unsigned ldsw = (unsigned)wid * 1024u;
    const int aoff = lds_byte(wr * 64 + fr, fq * 8), boff = lds_byte(wc * 32 + fr, fq * 8);
#define PG8_SA(b, h) (((b) * 2 + (h)) * HTB)
#define PG8_SB(b, h) ((4 + (b) * 2 + (h)) * HTB)
#define PG8_STAGE(bufoff, gbase, voff) do { _Pragma("unroll") for (int _i = 0; _i < 2; ++_i) \
        __builtin_amdgcn_global_load_lds((const unsigned*)((const char*)(gbase) + (voff)[_i]), (PG8_LAS unsigned*)(lds + (bufoff) + ldsw + _i * 8192), 16, 0, 0); } while (0)
#define PG8_LDA(dst, b, h) do { _Pragma("unroll") for (int m = 0; m < 4; ++m) _Pragma("unroll") for (int k = 0; k < 2; ++k) dst[m][k] = *(const PG8_LAS bf16x8*)(lds + PG8_SA(b, h) + aoff + m * 2048 + k * 1024); } while (0)
#define PG8_LDB(dst, b, h) do { _Pragma("unroll") for (int n = 0; n < 2; ++n) _Pragma("unroll") for (int k = 0; k < 2; ++k) dst[n][k] = *(const PG8_LAS bf16x8*)(lds + PG8_SB(b, h) + boff + n * 2048 + k * 1024); } while (0)
#define PG8_MMA(ai, bj, At, Bt) do { __builtin_amdgcn_s_setprio(1); _Pragma("unroll") for (int m = 0; m < 4; ++m) _Pragma("unroll") for (int n = 0; n < 2; ++n) _Pragma("unroll") for (int k = 0; k < 2; ++k) \
        acc[ai][bj][m][n] = __builtin_amdgcn_mfma_f32_16x16x32_bf16(Bt[n][k], At[m][k], acc[ai][bj][m][n], 0, 0, 0); __builtin_amdgcn_s_setprio(0); } while (0)
#define PG8_WAIT_V(n) asm volatile("s_waitcnt vmcnt(" #n ")" ::: "memory")
#define PG8_WAIT_L(n) asm volatile("s_waitcnt lgkmcnt(" #n ")" ::: "memory")
#define PG8_BAR __builtin_amdgcn_s_barrier()
#define PG8_SCHED __builtin_amdgcn_sched_barrier(0)
    Unit cur, nxt; int ui = 0;
    if (!S.next(0, cur)) return;
    f32x4 acc[2][2][4][2];
#pragma unroll
    for (int a = 0; a < 2; ++a)
#pragma unroll
        for (int b = 0; b < 2; ++b)
#pragma unroll
            for (int m = 0; m < 4; ++m)
#pragma unroll
                for (int n = 0; n < 2; ++n) acc[a][b][m][n] = (f32x4){0.f, 0.f, 0.f, 0.f};
    bf16x8 At[4][2], B0[2][2], B1[2][2];
    const char* cA = (const char*)g.A + (size_t)cur.pm * tstepA; const char* cB = (const char*)g.Bt + (size_t)cur.pn * tstepB;
    S.a_ready(cur);
    if constexpr (SP2) {
        PG8_STAGE(PG8_SB(0, 0), cB, voffB); PG8_STAGE(PG8_SB(0, 1), cB + hstepB, voffB); PG8_STAGE(PG8_SA(0, 0), cA, voffA); PG8_STAGE(PG8_SA(0, 1), cA + hstepA, voffA);
        if (wr == 1) PG8_BAR;
        PG8_WAIT_V(2); PG8_BAR;
        PG8_STAGE(PG8_SB(1, 0), cB + kstep, voffB); PG8_STAGE(PG8_SA(1, 0), cA + kstep, voffA); PG8_STAGE(PG8_SB(1, 1), cB + hstepB + kstep, voffB);
        PG8_WAIT_V(6); PG8_BAR;
    } else {
        PG8_STAGE(PG8_SB(0, 0), cB, voffB); PG8_STAGE(PG8_SA(0, 0), cA, voffA); PG8_STAGE(PG8_SB(0, 1), cB + hstepB, voffB); PG8_STAGE(PG8_SA(0, 1), cA + hstepA, voffA);
        if (wr == 1) PG8_BAR;
        PG8_WAIT_V(4); PG8_BAR;
        PG8_STAGE(PG8_SB(1, 0), cB + kstep, voffB); PG8_STAGE(PG8_SA(1, 0), cA + kstep, voffA); PG8_STAGE(PG8_SB(1, 1), cB + hstepB + kstep, voffB);
        PG8_WAIT_V(6); PG8_BAR;
    }
    for (;;) {
        const bool has_next = S.next(ui + 1, nxt);
        const char* nA = has_next ? (const char*)g.A + (size_t)nxt.pm * tstepA : cA; const char* nB = has_next ? (const char*)g.Bt + (size_t)nxt.pn * tstepB : cB;
        for (int t = 0; t < nt; t += 2) {
            const bool last = (t == nt - 2);
            const char* a1 = cA + (size_t)(t + 1) * kstep;
            const char* a2 = last ? nA : cA + (size_t)(t + 2) * kstep; const char* b2 = last ? nB : cB + (size_t)(t + 2) * kstep;
            const char* a3 = a2 + kstep; const char* b3 = b2 + kstep;
            if (last && has_next) S.a_ready(nxt);
            if constexpr (SP2) {
            PG8_LDB(B0, 0, 0); PG8_LDB(B1, 0, 1); PG8_SCHED; PG8_LDA(At, 0, 0); PG8_STAGE(PG8_SA(1, 1), a1 + hstepA, voffA);
            PG8_WAIT_V(8); PG8_WAIT_L(0); PG8_BAR; PG8_MMA(0, 0, At, B0); PG8_MMA(0, 1, At, B1); PG8_BAR; PG8_SCHED;
            PG8_LDA(At, 0, 1); PG8_STAGE(PG8_SB(0, 0), b2, voffB); PG8_STAGE(PG8_SB(0, 1), b2 + hstepB, voffB); PG8_STAGE(PG8_SA(0, 0), a2, voffA);
            PG8_WAIT_V(8); PG8_WAIT_L(0); PG8_BAR; PG8_MMA(1, 0, At, B0); PG8_MMA(1, 1, At, B1); PG8_BAR; PG8_SCHED;
            PG8_LDB(B0, 1, 0); PG8_LDB(B1, 1, 1); PG8_SCHED; PG8_LDA(At, 1, 0); PG8_STAGE(PG8_SA(0, 1), a2 + hstepA, voffA);
            PG8_WAIT_V(8); PG8_WAIT_L(0); PG8_BAR; PG8_MMA(0, 0, At, B0); PG8_MMA(0, 1, At, B1); PG8_BAR; PG8_SCHED;
            PG8_LDA(At, 1, 1); PG8_STAGE(PG8_SB(1, 0), b3, voffB); PG8_STAGE(PG8_SB(1, 1), b3 + hstepB, voffB); PG8_STAGE(PG8_SA(1, 0), a3, voffA);
            PG8_WAIT_V(8); PG8_WAIT_L(0); PG8_BAR; PG8_MMA(1, 0, At, B0); PG8_MMA(1, 1, At, B1); PG8_BAR; PG8_SCHED;
            } else {
            PG8_LDB(B0, 0, 0); PG8_SCHED; PG8_LDA(At, 0, 0); PG8_STAGE(PG8_SA(1, 1), a1 + hstepA, voffA);
            PG8_WAIT_L(8); PG8_BAR; PG8_WAIT_L(0); PG8_MMA(0, 0, At, B0); PG8_BAR; PG8_SCHED;
            PG8_LDB(B1, 0, 1); PG8_STAGE(PG8_SB(0, 0), b2, voffB);
            PG8_BAR; PG8_WAIT_L(0); PG8_MMA(0, 1, At, B1); PG8_BAR;
            PG8_LDA(At, 0, 1); PG8_STAGE(PG8_SA(0, 0), a2, voffA);
            PG8_BAR; PG8_WAIT_L(0); PG8_MMA(1, 0, At, B0); PG8_BAR; PG8_SCHED;
            PG8_STAGE(PG8_SB(0, 1), b2 + hstepB, voffB);
            PG8_WAIT_V(6); PG8_BAR; PG8_MMA(1, 1, At, B1); PG8_BAR;
            PG8_LDB(B0, 1, 0); PG8_SCHED; PG8_LDA(At, 1, 0); PG8_STAGE(PG8_SA(0, 1), a2 + hstepA, voffA);
            PG8_WAIT_L(8); PG8_BAR; PG8_WAIT_L(0); PG8_MMA(0, 0, At, B0); PG8_BAR; PG8_SCHED;
            PG8_LDB(B1, 1, 1); PG8_STAGE(PG8_SB(1, 0), b3, voffB);
            PG8_BAR; PG8_WAIT_L(0); PG8_MMA(0, 1, At, B1); PG8_BAR;
            PG8_LDA(At, 1, 1); PG8_STAGE(PG8_SA(1, 0), a3, voffA);
            PG8_BAR; PG8_WAIT_L(0); PG8_MMA(1, 0, At, B0); PG8_BAR; PG8_SCHED;
            PG8_STAGE(PG8_SB(1, 1), b3 + hstepB, voffB);
            PG8_WAIT_V(6); PG8_BAR; PG8_MMA(1, 1, At, B1); PG8_BAR;
            }
        }
        if constexpr (ALIGN_EPI) { if (wr == 0) PG8_BAR; }
        if constexpr (!Epi::AFTER_DRAIN) { E(acc, cur, wr, wc, fr, fq); S.done(cur); }
        if (!has_next) break;
#pragma unroll
        for (int a = 0; a < 2; ++a)
#pragma unroll
            for (int b = 0; b < 2; ++b)
#pragma unroll
                for (int m = 0; m < 4; ++m)
#pragma unroll
                    for (int n = 0; n < 2; ++n) acc[a][b][m][n] = (f32x4){0.f, 0.f, 0.f, 0.f};
        cur = nxt; cA = nA; cB = nB; ++ui;
        if constexpr (ALIGN_EPI) { if (wr == 1) PG8_BAR; }
    }
    PG8_WAIT_V(0);
    if constexpr (!ALIGN_EPI) { if (wr == 0) PG8_BAR; }
    PG8_BAR;
    if constexpr (Epi::AFTER_DRAIN) { E.fused(acc, cur, wr, wc, fr, fq, lds, wid, lane); S.done(cur); }
#undef PG8_SA
#undef PG8_SB
#undef PG8_STAGE
#undef PG8_LDA
#undef PG8_LDB
#undef PG8_MMA
#undef PG8_WAIT_V
#undef PG8_WAIT_L
#undef PG8_BAR
#undef PG8_SCHED
}
}

constexpr int NWAVES = 8;
#ifndef MK_N_LAUNCHES
#define MK_N_LAUNCHES 1
#endif
constexpr int N_LAUNCHES = MK_N_LAUNCHES;
constexpr int NPH = 11;
#ifndef PROBE_REP
#define PROBE_REP -1
#endif

constexpr int BATCH = 8, SEQ = 4096, D = 1024, M = BATCH * SEQ;
constexpr int HGW = 512, HGH = 4, HGK = 128;
constexpr int S5W = 512, S5G = 32, S5P = 16, S5N = 64;
constexpr int S5L = 32, S5I = M / S5L, S5K = S5L * S5P + 2 * S5N;
constexpr int NPROJ = 2560;
constexpr int PK = 128, PH = 8, PTOPK = 16, PQ = 256, PHALF = 128, PE = PK * PK, NQ2 = PH * PQ;
constexpr float LN_EPS = 1e-5f, RMS_EPS = 1e-6f;
constexpr float DN_ALPHA = 1.189207115002721f;

constexpr size_t MiB = 1u << 20;
constexpr size_t WS_CTL = 0, CTL_ZERO_BYTES = 1 * MiB;
constexpr size_t WS_WIN = 1 * MiB;
constexpr size_t WS_WGLU = 6 * MiB;
constexpr size_t WS_KEYS = 6 * MiB + 512 * 1024;
constexpr size_t WS_LB = 6 * MiB + 640 * 1024;
constexpr size_t WS_S5T = 6 * MiB + 704 * 1024;
constexpr size_t WS_WOUT = 7 * MiB + 512 * 1024;
constexpr size_t WS_WQ = 10 * MiB;
constexpr size_t WS_SST = 14 * MiB;
constexpr size_t WS_H = 78 * MiB;
constexpr size_t WS_PROJ = 142 * MiB;
constexpr size_t WS_Q2 = WS_PROJ;
constexpr size_t WS_A5 = 270 * MiB;
constexpr size_t WS_MIX = 310 * MiB;
constexpr size_t WS_PD = WS_MIX, WS_PU = WS_MIX + 16 * MiB;
constexpr size_t WS_Z = 374 * MiB;
constexpr size_t WS_EIDX = WS_Z, WS_EGATE = WS_Z + 16 * MiB;
constexpr size_t WS_T5 = 406 * MiB;
constexpr size_t WS_G5 = 426 * MiB;
constexpr size_t WS_XLOC = 434 * MiB;
constexpr size_t WS_KTAU = 450 * MiB;
constexpr size_t WS_PW = 451 * MiB;
constexpr size_t WS_END = 452 * MiB;
constexpr int CW_TMO = 0, CW_CODE = 1;
constexpr int CW_BAR = 4096;

constexpr int RING_OFF = 0, RING_BYTES = 131072;
constexpr int LDSCTL_OFF = RING_BYTES, MISC_OFF = LDSCTL_OFF + 320;
constexpr int LDS_BYTES = 147456;
static_assert(MISC_OFF + 128 <= LDS_BYTES, "LDS map");

#define GAS __attribute__((address_space(1)))
#define LAS __attribute__((address_space(3)))
typedef unsigned short bf16;
typedef unsigned v4u __attribute__((ext_vector_type(4)));
typedef float f32x4 __attribute__((ext_vector_type(4)));
typedef short bf16x8 __attribute__((ext_vector_type(8)));
typedef GAS unsigned gu32;
typedef GAS unsigned long long gu64;
#define RLX_AGENT __ATOMIC_RELAXED, __HIP_MEMORY_SCOPE_AGENT
#define LDS_WAIT() asm volatile("s_waitcnt lgkmcnt(0)" ::: "memory")
#define VM_WAIT() asm volatile("s_waitcnt vmcnt(0)" ::: "memory")
__device__ __forceinline__ unsigned long long rt() { return __builtin_amdgcn_s_memrealtime(); }
__device__ __forceinline__ unsigned f2bf(float f) { unsigned u = __builtin_bit_cast(unsigned, f); return (u + 0x7fffu + ((u >> 16) & 1u)) >> 16; }
__device__ __forceinline__ unsigned pk2(float lo, float hi) { return f2bf(lo) | (f2bf(hi) << 16); }

#define XB_TMO      128
#define XB_XCNT(j)  (256  + 64 * (j))
#define XB_XSUB(j)  (1280 + 64 * (j))
#define XB_XGEN(j)  (2304 + 64 * (j))
#define XB_TOP      3328
#define XB_TOPGEN   3392
#define XCD_BAR_WORDS 3456
#define XB_SPIN_CAP (1u << 18)

__device__ __forceinline__ unsigned xb_ld(unsigned* p)              { return __hip_atomic_load(p, __ATOMIC_RELAXED, __HIP_MEMORY_SCOPE_AGENT); }
__device__ __forceinline__ unsigned xb_add(unsigned* p, unsigned v) { return __hip_atomic_fetch_add(p, v, __ATOMIC_RELAXED, __HIP_MEMORY_SCOPE_AGENT); }
__device__ __forceinline__ unsigned xb_xcc_id() { return (unsigned)__builtin_amdgcn_s_getreg((3 << 11) | 20) & 0xFu; }
#define XB_SPIN(cond, bar) do { unsigned _sp = 0; while (cond) { __builtin_amdgcn_s_sleep(1); \
    if ((++_sp & 255u) == 0u) { if (xb_ld(&(bar)[XB_TMO])) break; if (_sp > XB_SPIN_CAP) { atomicAdd(&(bar)[XB_TMO], 1u); break; } } } } while (0)

struct XcdBarrier {
    unsigned* bar; unsigned x;
    volatile LAS unsigned* st;
};

__device__ __forceinline__ XcdBarrier xcd_barrier_post(unsigned* bar, volatile LAS unsigned* st) {
    XcdBarrier b; b.bar = bar; b.x = xb_xcc_id(); b.st = st;
    if (threadIdx.x == 0) (void)xb_add(&bar[XB_XCNT(b.x)], 1u);
    return b;
}
__device__ __forceinline__ void xcd_barrier_complete(unsigned* bar, unsigned x, unsigned& nloc, unsigned& nx) {
    const unsigned G = gridDim.x * gridDim.y * gridDim.z;
    unsigned sum, cnt, mine, sp = 0u;
    for (;;) {
        sum = 0u; cnt = 0u; mine = 0u;
#pragma unroll
        for (unsigned j = 0; j < 16; ++j) { const unsigned c = xb_ld(&bar[XB_XCNT(j)]); sum += c; cnt += (c > 0u) ? 1u : 0u; mine = (j == x) ? c : mine; }
        if (sum == G) break;
        __builtin_amdgcn_s_sleep(1);
        if ((++sp & 255u) == 0u) { if (xb_ld(&bar[XB_TMO])) break; if (sp > XB_SPIN_CAP) { atomicAdd(&bar[XB_TMO], 1u); break; } }
    }
    nloc = mine > 0u ? mine : 1u; nx = cnt > 0u ? cnt : 1u;
}

__device__ __forceinline__ void xcd_barrier(const XcdBarrier& b) {
    asm volatile("s_waitcnt vmcnt(0)" ::: "memory");
    __syncthreads();
    if (threadIdx.x == 0) {
        unsigned* bar = b.bar;
        __builtin_amdgcn_s_waitcnt(0);
        unsigned nloc = b.st[0], nx = b.st[1];
        if (nloc == 0u) { xcd_barrier_complete(bar, b.x, nloc, nx); b.st[0] = nloc; b.st[1] = nx; }
        const unsigned old = xb_add(&bar[XB_XSUB(b.x)], 1u);
        const unsigned gen = old / nloc;
        if (old + 1u == (gen + 1u) * nloc) {
            __builtin_amdgcn_fence(__ATOMIC_RELEASE, "agent");
            asm volatile("s_waitcnt vmcnt(0)" ::: "memory");
            const unsigned og = xb_add(&bar[XB_TOP], 1u);
            const unsigned tg = og / nx;
            if (og + 1u == (tg + 1u) * nx) xb_add(&bar[XB_TOPGEN], 1u);
            else XB_SPIN(xb_ld(&bar[XB_TOPGEN]) == tg, bar);
            __builtin_amdgcn_fence(__ATOMIC_ACQUIRE, "agent");
            xb_add(&bar[XB_XGEN(b.x)], 1u);
            asm volatile("s_waitcnt vmcnt(0)" ::: "memory");
        } else {
            XB_SPIN(xb_ld(&bar[XB_XGEN(b.x)]) == gen, bar);
            __builtin_amdgcn_fence(__ATOMIC_ACQUIRE, "agent");
            asm volatile("s_waitcnt vmcnt(0)" ::: "memory");
        }
    }
    __syncthreads();
}

struct Frame {
    LAS unsigned char* lds;
    volatile LAS unsigned* MISC;
    gu32* ctl;
    int tid, lane, wave;
    int vcu, G;
    const float* in[26]; float* out; unsigned char* ws;
};
enum { I_X = 0, I_LN0G, I_LN0B, I_WIN, I_LBL, I_HGNG, I_ARE, I_AIM, I_LSTEP, I_BRE, I_BIM, I_CRE, I_CIM, I_DSK, I_WGLU, I_BGLU, I_WOUT, I_LN1G, I_LN1B, I_WQ, I_K1, I_K2, I_PD, I_PU, I_LN2G, I_LN2B };

__device__ __forceinline__ float bf2f(bf16 v) { return __builtin_bit_cast(float, (unsigned)v << 16); }
__device__ __forceinline__ float wave_sum(float v) {
#pragma unroll
    for (int o = 1; o < 64; o <<= 1) v += __shfl_xor(v, o);
    return v;
}
__device__ __forceinline__ float wave_max(float v) {
#pragma unroll
    for (int o = 1; o < 64; o <<= 1) v = fmaxf(v, __shfl_xor(v, o));
    return v;
}
__device__ __forceinline__ float gelu_tanh(float x) { const float y = 0.7978845608028654f * (x + 0.044715f * x * x * x); return x / (1.f + __expf(-2.f * y)); }
__device__ __forceinline__ float silu_f(float x) { return x / (1.f + __expf(-x)); }
__device__ __forceinline__ void unpack8(const v4u w, float (&f)[8]) {
    f[0] = __builtin_bit_cast(float, w.x << 16); f[1] = __builtin_bit_cast(float, w.x & 0xffff0000u);
    f[2] = __builtin_bit_cast(float, w.y << 16); f[3] = __builtin_bit_cast(float, w.y & 0xffff0000u);
    f[4] = __builtin_bit_cast(float, w.z << 16); f[5] = __builtin_bit_cast(float, w.z & 0xffff0000u);
    f[6] = __builtin_bit_cast(float, w.w << 16); f[7] = __builtin_bit_cast(float, w.w & 0xffff0000u);
}
__device__ __forceinline__ v4u pack8(const float (&f)[8]) { v4u w; w.x = pk2(f[0], f[1]); w.y = pk2(f[2], f[3]); w.z = pk2(f[4], f[5]); w.w = pk2(f[6], f[7]); return w; }

__device__ __forceinline__ void p0_transpose_item(const float* W, int K, int N, bf16* WT, int row_off, LAS float* scr, int item, int lane) {
    const int nblk = N / 32, kb = item / nblk, nb = item % nblk, k0 = 64 * kb, n0 = 32 * nb;
#pragma unroll 8
    for (int i = 0; i < 32; ++i) { const int kk = 2 * i + (lane >> 5); scr[kk * 33 + (lane & 31)] = W[(size_t)(k0 + kk) * N + n0 + (lane & 31)]; }
    LDS_WAIT(); asm volatile("" ::: "memory");
    const int c = lane & 7;
#pragma unroll
    for (int j = 0; j < 4; ++j) { const int n = (lane >> 3) + 8 * j; const LAS float* s = scr + (8 * c) * 33 + n;
        v4u o; o.x = pk2(s[0 * 33], s[1 * 33]); o.y = pk2(s[2 * 33], s[3 * 33]); o.z = pk2(s[4 * 33], s[5 * 33]); o.w = pk2(s[6 * 33], s[7 * 33]);
        *(GAS v4u*)(WT + (size_t)(row_off + n0 + n) * K + k0 + 8 * c) = o; }
    LDS_WAIT(); asm volatile("" ::: "memory");
}
__device__ __forceinline__ void ln0_row(const float* xrow, const float* g, const float* b, bf16* orow, int lane) {
    const GAS f32x4* xr = (const GAS f32x4*)xrow + lane;
    f32x4 v[4]; float s = 0.f;
#pragma unroll
    for (int j = 0; j < 4; ++j) { v[j] = xr[64 * j]; s += (v[j].x + v[j].y) + (v[j].z + v[j].w); }
    const float mean = wave_sum(s) * (1.f / D); float s2 = 0.f;
#pragma unroll
    for (int j = 0; j < 4; ++j) { v[j] = v[j] - mean; s2 += (v[j].x * v[j].x + v[j].y * v[j].y) + (v[j].z * v[j].z + v[j].w * v[j].w); }
    const float rstd = 1.f / sqrtf(wave_sum(s2) * (1.f / D) + LN_EPS);
    GAS unsigned long long* o8 = (GAS unsigned long long*)orow + lane;
#pragma unroll
    for (int j = 0; j < 4; ++j) { const f32x4 gg = ((const GAS f32x4*)g)[lane + 64 * j], bb = ((const GAS f32x4*)b)[lane + 64 * j];
        const f32x4 o = v[j] * rstd * gg + bb;
        o8[64 * j] = (unsigned long long)pk2(o.x, o.y) | ((unsigned long long)pk2(o.z, o.w) << 32); }
}
__device__ __forceinline__ void p0_prologue(Frame& F) {
    LAS float* scr = (LAS float*)(F.lds + RING_OFF + F.wave * 16384);
    const int gw = F.vcu * NWAVES + F.wave, NGW = F.G * NWAVES;
    unsigned char* ws = F.ws;
    constexpr int I_IN = (D / 64) * (NPROJ / 32), I_GLU = (512 / 64) * (512 / 32), I_OUT = (1024 / 64) * (1024 / 32), I_Q = (1024 / 64) * (2048 / 32);
    constexpr int NITEMS = I_IN + I_GLU + I_OUT + I_Q;
    for (int it = gw; it < NITEMS; it += NGW) {
        int r = it;
        if (r < I_IN) { p0_transpose_item(F.in[I_WIN], D, NPROJ, (bf16*)(ws + WS_WIN), 0, scr, r, F.lane); continue; } r -= I_IN;
        if (r < I_GLU) { p0_transpose_item(F.in[I_WGLU], 512, 512, (bf16*)(ws + WS_WGLU), 0, scr, r, F.lane); continue; } r -= I_GLU;
        if (r < I_OUT) { p0_transpose_item(F.in[I_WOUT], 1024, 1024, (bf16*)(ws + WS_WOUT), 0, scr, r, F.lane); continue; } r -= I_OUT;
        p0_transpose_item(F.in[I_WQ], 1024, 2048, (bf16*)(ws + WS_WQ), 0, scr, r, F.lane);
    }
    const int gt = gw * 64 + F.lane, NGT = NGW * 64;
    for (int i = gt; i < 2 * PK * PHALF; i += NGT) { const float v = (i < PK * PHALF) ? F.in[I_K1][i] : F.in[I_K2][i - PK * PHALF]; ((bf16*)(ws + WS_KEYS))[i] = (bf16)f2bf(v); }
    for (int i = gt; i < HGW; i += NGT) { const float l0 = F.in[I_LBL][i], l1 = F.in[I_LBL][HGW + i]; ((float*)(ws + WS_LB))[i] = 1.f / (1.f + expf(l1 - l0)); }
    for (int i = gt; i < S5G * S5N; i += NGT) { const int g = i / S5N;
        const float are = F.in[I_ARE][i], aim = F.in[I_AIM][i], step = expf(F.in[I_LSTEP][g]);
        const float zr = step * are, zi = step * aim, mag = expf(zr), cz = cosf(zi), sz = sinf(zi), sh = sinf(0.5f * zi);
        const float abr = mag * cz, abi = mag * sz;
        const float nre = expm1f(zr) * cz - 2.f * sh * sh, nim = abi;
        const float den = are * are + aim * aim;
        const float cre = (nre * are + nim * aim) / den, cim = (nim * are - nre * aim) / den;
        float* t = (float*)(ws + WS_S5T) + (size_t)i * 40; t[0] = abr; t[1] = abi;
        for (int p = 0; p < S5P; ++p) { const float br = F.in[I_BRE][(size_t)i * S5P + p], bi = F.in[I_BIM][(size_t)i * S5P + p];
            t[2 + p] = cre * br - cim * bi; t[18 + p] = cre * bi + cim * br; } }
    for (int i = gt; i < S5G * S5N * 33; i += NGT) { const int gn = i / 33, tau = i % 33, g = gn / S5N;
        const float step = expf(F.in[I_LSTEP][g]), zr = step * F.in[I_ARE][gn] * (float)tau, zi = step * F.in[I_AIM][gn] * (float)tau, mag = expf(zr);
        float* p = (float*)(ws + WS_PW) + (size_t)i * 2; p[0] = mag * cosf(zi); p[1] = mag * sinf(zi); }
    for (int m = gw; m < M; m += NGW) ln0_row(F.in[I_X] + (size_t)m * D, F.in[I_LN0G], F.in[I_LN0B], (bf16*)(ws + WS_H) + (size_t)m * D, F.lane);
}

__device__ __forceinline__ void hgrn2_seq(Frame& F, int bh) {
    const int b = bh >> 2, h = bh & 3, tid = F.tid, kq = tid >> 7, j = tid & 127;
    LAS float* sF = (LAS float*)(F.lds + RING_OFF);
    LAS float* sK = sF + 8 * 128; LAS float* sQ = sK + 8 * 128;
    LAS float* sO = sQ + 8 * 128;
    const bf16* Qb = (const bf16*)(F.ws + WS_PROJ); const bf16* LFb = Qb + (size_t)M * 512; const bf16* Vb = LFb + (size_t)M * 512; const bf16* Gb = Vb + (size_t)M * 512;
    bf16* MIX = (bf16*)(F.ws + WS_MIX);
    const float ng0 = F.in[I_HGNG][F.lane], ng1 = F.in[I_HGNG][F.lane + 64];
    float S[32];
#pragma unroll
    for (int k = 0; k < 32; ++k) S[k] = 0.f;
    for (int t0 = 0; t0 < SEQ; t0 += 8) {
        const size_t tok0 = (size_t)b * SEQ + t0;
#pragma unroll
        for (int r = 0; r < 2; ++r) { const int item = tid + 512 * r, tt = item >> 7, kk = item & 127; const size_t off = (tok0 + tt) * 512 + h * 128 + kk;
            const float lf = bf2f(LFb[off]); sF[tt * 128 + kk] = __expf(lf); sK[tt * 128 + kk] = -expm1f(lf); sQ[tt * 128 + kk] = bf2f(Qb[off]); }
        __syncthreads();
#pragma unroll 1
        for (int tt = 0; tt < 8; ++tt) { const float v = bf2f(Vb[(tok0 + tt) * 512 + h * 128 + j]); float o = 0.f;
            const LAS float* f = sF + tt * 128 + kq * 32; const LAS float* kx = sK + tt * 128 + kq * 32; const LAS float* q = sQ + tt * 128 + kq * 32;
#pragma unroll
            for (int k = 0; k < 32; ++k) { S[k] = f[k] * S[k] + kx[k] * v; o += q[k] * S[k]; }
            sO[(tt * 4 + kq) * 128 + j] = o; }
        __syncthreads();
        { const int tt = F.wave; const size_t tok = tok0 + tt;
            const float o0 = (sO[(tt * 4 + 0) * 128 + F.lane] + sO[(tt * 4 + 1) * 128 + F.lane]) + (sO[(tt * 4 + 2) * 128 + F.lane] + sO[(tt * 4 + 3) * 128 + F.lane]);
            const float o1 = (sO[(tt * 4 + 0) * 128 + 64 + F.lane] + sO[(tt * 4 + 1) * 128 + 64 + F.lane]) + (sO[(tt * 4 + 2) * 128 + 64 + F.lane] + sO[(tt * 4 + 3) * 128 + 64 + F.lane]);
            const float ss = wave_sum(o0 * o0 + o1 * o1), r = 1.f / sqrtf(ss * (1.f / 128.f) + RMS_EPS);
            const float g0 = bf2f(Gb[tok * 512 + h * 128 + F.lane]), g1 = bf2f(Gb[tok * 512 + h * 128 + 64 + F.lane]);
            MIX[tok * 1024 + h * 128 + F.lane] = (bf16)f2bf(o0 * r * ng0 * silu_f(g0));
            MIX[tok * 1024 + h * 128 + 64 + F.lane] = (bf16)f2bf(o1 * r * ng1 * silu_f(g1)); }
    }
    __syncthreads();
}
__device__ __forceinline__ void s5_seq(Frame& F, int pair) {
    const int b = pair >> 5, g = pair & 31, lane = F.lane;
    const float* tb = (const float*)(F.ws + WS_S5T) + (size_t)(g * S5N + lane) * 40;
    const float abr = tb[0], abi = tb[1];
    float bbr[16], bbi[16], cr[16], ci[16], dsk[16];
#pragma unroll
    for (int p = 0; p < 16; ++p) { bbr[p] = tb[2 + p]; bbi[p] = tb[18 + p]; cr[p] = F.in[I_CRE][(size_t)(g * 16 + p) * S5N + lane]; ci[p] = F.in[I_CIM][(size_t)(g * 16 + p) * S5N + lane];
        dsk[p] = (lane == 0) ? F.in[I_DSK][g * 16 + p] : 0.f; }
    const bf16* Ub = (const bf16*)(F.ws + WS_PROJ) + (size_t)4 * M * 512 + ((size_t)g * M + (size_t)b * SEQ) * 16;
    bf16* Zb = (bf16*)(F.ws + WS_Z) + (size_t)b * SEQ * 512 + g * 16;
    const int pme = ((lane >> 5) & 1) * 8 + ((lane >> 4) & 1) * 4 + ((lane >> 3) & 1) * 2 + ((lane >> 2) & 1);
    float xr = 0.f, xi = 0.f;
    v4u nu0 = *(const GAS v4u*)(Ub + (size_t)lane * 16), nu1 = *(const GAS v4u*)(Ub + (size_t)lane * 16 + 8);
    for (int t0 = 0; t0 < SEQ; t0 += 64) {
        const v4u u0 = nu0, u1 = nu1;
        if (t0 + 64 < SEQ) { nu0 = *(const GAS v4u*)(Ub + (size_t)(t0 + 64 + lane) * 16); nu1 = *(const GAS v4u*)(Ub + (size_t)(t0 + 64 + lane) * 16 + 8); }
#pragma unroll 1
        for (int tt = 0; tt < 64; ++tt) {
            v4u a, c;
            a.x = __builtin_amdgcn_readlane(u0.x, tt); a.y = __builtin_amdgcn_readlane(u0.y, tt); a.z = __builtin_amdgcn_readlane(u0.z, tt); a.w = __builtin_amdgcn_readlane(u0.w, tt);
            c.x = __builtin_amdgcn_readlane(u1.x, tt); c.y = __builtin_amdgcn_readlane(u1.y, tt); c.z = __builtin_amdgcn_readlane(u1.z, tt); c.w = __builtin_amdgcn_readlane(u1.w, tt);
            float u[16]; { float f0[8], f1[8]; unpack8(a, f0); unpack8(c, f1);
#pragma unroll
                for (int p = 0; p < 8; ++p) { u[p] = f0[p]; u[8 + p] = f1[p]; } }
            float bur = 0.f, bui = 0.f;
#pragma unroll
            for (int p = 0; p < 16; ++p) { bur += bbr[p] * u[p]; bui += bbi[p] * u[p]; }
            const float nxr = abr * xr - abi * xi + bur, nxi = abr * xi + abi * xr + bui; xr = nxr; xi = nxi;
            float r[16];
#pragma unroll
            for (int p = 0; p < 16; ++p) r[p] = cr[p] * xr - ci[p] * xi + dsk[p] * u[p];
#pragma unroll
            for (int i = 0; i < 8; ++i) { const float keep = (lane & 32) ? r[i + 8] : r[i], send = (lane & 32) ? r[i] : r[i + 8]; r[i] = keep + __shfl_xor(send, 32); }
#pragma unroll
            for (int i = 0; i < 4; ++i) { const float keep = (lane & 16) ? r[i + 4] : r[i], send = (lane & 16) ? r[i] : r[i + 4]; r[i] = keep + __shfl_xor(send, 16); }
#pragma unroll
            for (int i = 0; i < 2; ++i) { const float keep = (lane & 8) ? r[i + 2] : r[i], send = (lane & 8) ? r[i] : r[i + 2]; r[i] = keep + __shfl_xor(send, 8); }
            { const float keep = (lane & 4) ? r[1] : r[0], send = (lane & 4) ? r[0] : r[1]; r[0] = keep + __shfl_xor(send, 4); }
            r[0] += __shfl_xor(r[0], 2); r[0] += __shfl_xor(r[0], 1);
            if ((lane & 3) == 0) Zb[(size_t)(t0 + tt) * 512 + pme] = (bf16)f2bf(gelu_tanh(r[0]));
        }
    }
}

__device__ __forceinline__ int t256(int r, int c) { return r * 256 + ((((c >> 3) ^ (r & 15))) << 4) + (c & 7) * 2; }
__device__ __forceinline__ int t128(int r, int c) { return r * 128 + ((((c >> 3) ^ (r & 7))) << 4) + (c & 7) * 2; }
typedef unsigned v2u __attribute__((ext_vector_type(2)));
__device__ __forceinline__ void hgrn2_state_pass(Frame& F, int item) {
    const int bh = item >> 2, vs = item & 3, b = bh >> 2, h = bh & 3, tid = F.tid, lane = F.lane, w = F.wave, fr = lane & 15, fq = lane >> 4;
    const int kcol = tid & 127, qtr = tid >> 7, vv = tid & 31, sg = tid >> 5;
    LAS unsigned char* L = F.lds + RING_OFF;
    const bf16* LFb = (const bf16*)(F.ws + WS_PROJ) + (size_t)M * 512 + (size_t)b * SEQ * 512 + h * 128 + kcol;
    const bf16* Vb = (const bf16*)(F.ws + WS_PROJ) + (size_t)2 * M * 512 + (size_t)b * SEQ * 512 + h * 128 + vs * 32 + vv;
    bf16* SST = (bf16*)(F.ws + WS_SST) + (size_t)bh * 64 * 128 * 128;
    float S[2][4];
#pragma unroll
    for (int i = 0; i < 2; ++i)
#pragma unroll
        for (int r = 0; r < 4; ++r) S[i][r] = 0.f;
    bf16 lfn[16], vn[4];
#pragma unroll
    for (int j = 0; j < 16; ++j) lfn[j] = LFb[(size_t)(qtr * 16 + j) * 512];
#pragma unroll
    for (int j = 0; j < 4; ++j) vn[j] = Vb[(size_t)(sg * 4 + j) * 512];
    for (int c = 0; c < 64; ++c) {
        LAS unsigned char* Lb = L + (c & 1) * 24576;
        LAS unsigned char* sKT = Lb; LAS unsigned char* sVT = Lb + 16384; LAS float* sTot = (LAS float*)(Lb + 20480); LAS float* sDec = (LAS float*)(Lb + 22528);
        float lf[16]; bf16 vc[4];
#pragma unroll
        for (int j = 0; j < 16; ++j) lf[j] = bf2f(lfn[j]);
#pragma unroll
        for (int j = 0; j < 4; ++j) vc[j] = vn[j];
        if (c + 1 < 64) {
#pragma unroll
            for (int j = 0; j < 16; ++j) lfn[j] = LFb[(size_t)((c + 1) * 64 + qtr * 16 + j) * 512];
#pragma unroll
            for (int j = 0; j < 4; ++j) vn[j] = Vb[(size_t)((c + 1) * 64 + sg * 4 + j) * 512];
        }
        float cl[16]; float run = 0.f;
#pragma unroll
        for (int j = 0; j < 16; ++j) { run += lf[j]; cl[j] = run; }
        sTot[qtr * 128 + kcol] = run;
        __syncthreads();
        const float t0 = sTot[kcol], t1 = sTot[128 + kcol], t2 = sTot[256 + kcol], t3 = sTot[384 + kcol];
        const float off = (qtr > 0 ? t0 : 0.f) + (qtr > 1 ? t1 : 0.f) + (qtr > 2 ? t2 : 0.f), last = (t0 + t1) + (t2 + t3);
        float kh[16];
#pragma unroll
        for (int j = 0; j < 16; ++j) kh[j] = -expm1f(lf[j]) * __expf(last - (off + cl[j]));
        { const float a[8] = {kh[0], kh[1], kh[2], kh[3], kh[4], kh[5], kh[6], kh[7]}, bq[8] = {kh[8], kh[9], kh[10], kh[11], kh[12], kh[13], kh[14], kh[15]};
          *(LAS v4u*)(sKT + kcol * 128 + (((qtr * 2) ^ (kcol & 7)) << 4)) = pack8(a); *(LAS v4u*)(sKT + kcol * 128 + (((qtr * 2 + 1) ^ (kcol & 7)) << 4)) = pack8(bq); }
        if (qtr == 0) sDec[kcol] = __expf(last);
        { v2u pv; pv.x = (unsigned)vc[0] | ((unsigned)vc[1] << 16); pv.y = (unsigned)vc[2] | ((unsigned)vc[3] << 16);
          *(LAS v2u*)(sVT + vv * 128 + ((((sg >> 1) ^ (vv & 7))) << 4) + (sg & 1) * 8) = pv; }
        __syncthreads();
        f32x4 acc[2] = {(f32x4){0.f, 0.f, 0.f, 0.f}, (f32x4){0.f, 0.f, 0.f, 0.f}};
#pragma unroll
        for (int ks = 0; ks < 2; ++ks) { const int ch = ks * 4 + fq, row = 16 * w + fr;
            const bf16x8 af = *(const LAS bf16x8*)(sKT + row * 128 + ((ch ^ (row & 7)) << 4));
#pragma unroll
            for (int nt = 0; nt < 2; ++nt) { const int vr = 16 * nt + fr; const bf16x8 bfm = *(const LAS bf16x8*)(sVT + vr * 128 + ((ch ^ (vr & 7)) << 4));
                acc[nt] = __builtin_amdgcn_mfma_f32_16x16x32_bf16(af, bfm, acc[nt], 0, 0, 0); } }
        const int k0 = 16 * w + fq * 4; const f32x4 dec = *(const LAS f32x4*)(sDec + k0);
#pragma unroll
        for (int nt = 0; nt < 2; ++nt) { const int vg = vs * 32 + 16 * nt + fr;
            v2u o; o.x = pk2(S[nt][0], S[nt][1]); o.y = pk2(S[nt][2], S[nt][3]);
            *(GAS v2u*)(SST + ((size_t)c * 128 + vg) * 128 + k0) = o;
            S[nt][0] = dec[0] * S[nt][0] + acc[nt][0]; S[nt][1] = dec[1] * S[nt][1] + acc[nt][1]; S[nt][2] = dec[2] * S[nt][2] + acc[nt][2]; S[nt][3] = dec[3] * S[nt][3] + acc[nt][3]; }
    }
    __syncthreads();
}
__device__ __forceinline__ void hgrn2_out_item(Frame& F, int item) {
    const int bh = item >> 6, c = item & 63, b = bh >> 2, h = bh & 3, tid = F.tid, lane = F.lane, w = F.wave, fr = lane & 15, fq = lane >> 4;
    const int kcol = tid & 127, qtr = tid >> 7;
    LAS unsigned char* L = F.lds + RING_OFF;
    LAS unsigned char* sQt = L; LAS unsigned char* sQm = L + 16384; LAS unsigned char* sKm = L + 32768; LAS unsigned char* sVT = L + 49152; LAS unsigned char* sST = L + 65536; LAS unsigned char* sP = L + 98304;
    LAS float* sTot = (LAS float*)(L + 106496); LAS float* sSS = (LAS float*)(L + 108544);
    const size_t tok0 = (size_t)b * SEQ + (size_t)c * 64;
    const bf16* Qb = (const bf16*)(F.ws + WS_PROJ) + tok0 * 512 + h * 128; const bf16* LFb = Qb + (size_t)M * 512; const bf16* Vb = Qb + (size_t)2 * M * 512; const bf16* Gb = Qb + (size_t)3 * M * 512;
    const bf16* SST = (const bf16*)(F.ws + WS_SST) + (size_t)item * 128 * 128;
    bf16* MIX = (bf16*)(F.ws + WS_MIX) + tok0 * 1024 + h * 128;
    float lf[16], q[16]; bf16 vraw[16];
#pragma unroll
    for (int j = 0; j < 16; ++j) { lf[j] = bf2f(LFb[(size_t)(qtr * 16 + j) * 512 + kcol]); q[j] = bf2f(Qb[(size_t)(qtr * 16 + j) * 512 + kcol]); vraw[j] = Vb[(size_t)(qtr * 16 + j) * 512 + kcol]; }
    v4u st[4];
#pragma unroll
    for (int i = 0; i < 4; ++i) { const int idx = tid + 512 * i; st[i] = *(const GAS v4u*)(SST + (size_t)(idx >> 4) * 128 + (idx & 15) * 8); }
    float cl[16]; float run = 0.f;
#pragma unroll
    for (int j = 0; j < 16; ++j) { run += lf[j]; cl[j] = run; }
    sTot[qtr * 128 + kcol] = run;
    __syncthreads();
    { const float t0 = sTot[kcol], t1 = sTot[128 + kcol], t2 = sTot[256 + kcol];
      const float off = (qtr > 0 ? t0 : 0.f) + (qtr > 1 ? t1 : 0.f) + (qtr > 2 ? t2 : 0.f), mid = t0 + t1;
#pragma unroll
      for (int j = 0; j < 16; ++j) { const int s = qtr * 16 + j; const float cum = off + cl[j];
          const int o = t256(s, kcol);
          *(LAS bf16*)(sQt + o) = (bf16)f2bf(q[j] * __expf(cum));
          *(LAS bf16*)(sQm + o) = (bf16)f2bf(q[j] * __expf(cum - mid));
          *(LAS bf16*)(sKm + o) = (bf16)f2bf(-expm1f(lf[j]) * __expf(mid - cum)); }
      v4u p0, p1;
      p0.x = (unsigned)vraw[0] | ((unsigned)vraw[1] << 16); p0.y = (unsigned)vraw[2] | ((unsigned)vraw[3] << 16); p0.z = (unsigned)vraw[4] | ((unsigned)vraw[5] << 16); p0.w = (unsigned)vraw[6] | ((unsigned)vraw[7] << 16);
      p1.x = (unsigned)vraw[8] | ((unsigned)vraw[9] << 16); p1.y = (unsigned)vraw[10] | ((unsigned)vraw[11] << 16); p1.z = (unsigned)vraw[12] | ((unsigned)vraw[13] << 16); p1.w = (unsigned)vraw[14] | ((unsigned)vraw[15] << 16);
      *(LAS v4u*)(sVT + kcol * 128 + (((qtr * 2) ^ (kcol & 7)) << 4)) = p0; *(LAS v4u*)(sVT + kcol * 128 + (((qtr * 2 + 1) ^ (kcol & 7)) << 4)) = p1;
#pragma unroll
      for (int i = 0; i < 4; ++i) { const int idx = tid + 512 * i, v = idx >> 4, kc = idx & 15; *(LAS v4u*)(sST + v * 256 + ((kc ^ (v & 15)) << 4)) = st[i]; } }
    __syncthreads();
    const int tt = w >> 1, trow = 16 * tt + fr;
#pragma unroll
    for (int sti = 0; sti < 2; ++sti) { const int stl = (w & 1) * 2 + sti; f32x4 acc = (f32x4){0.f, 0.f, 0.f, 0.f};
        if (stl <= tt) {
#pragma unroll
            for (int ks = 0; ks < 4; ++ks) { const int ch = ks * 4 + fq, srow = 16 * stl + fr;
                const bf16x8 af = *(const LAS bf16x8*)(sKm + srow * 256 + ((ch ^ (srow & 15)) << 4));
                const bf16x8 bfm = *(const LAS bf16x8*)(sQm + trow * 256 + ((ch ^ (trow & 15)) << 4));
                acc = __builtin_amdgcn_mfma_f32_16x16x32_bf16(af, bfm, acc, 0, 0, 0); } }
        const int s0 = 16 * stl + fq * 4;
        const float p0 = (s0 + 0 <= trow) ? acc[0] : 0.f, p1 = (s0 + 1 <= trow) ? acc[1] : 0.f, p2 = (s0 + 2 <= trow) ? acc[2] : 0.f, p3 = (s0 + 3 <= trow) ? acc[3] : 0.f;
        v2u o; o.x = pk2(p0, p1); o.y = pk2(p2, p3);
        *(LAS v2u*)(sP + trow * 128 + ((((s0 >> 3) ^ (trow & 7))) << 4) + (s0 & 7) * 2) = o; }
    __syncthreads();
    f32x4 oacc[4];
#pragma unroll
    for (int i = 0; i < 4; ++i) oacc[i] = (f32x4){0.f, 0.f, 0.f, 0.f};
#pragma unroll
    for (int ks = 0; ks < 4; ++ks) { const int ch = ks * 4 + fq;
        const bf16x8 bfm = *(const LAS bf16x8*)(sQt + trow * 256 + ((ch ^ (trow & 15)) << 4));
#pragma unroll
        for (int i = 0; i < 4; ++i) { const int vr = 16 * ((w & 1) * 4 + i) + fr; const bf16x8 af = *(const LAS bf16x8*)(sST + vr * 256 + ((ch ^ (vr & 15)) << 4));
            oacc[i] = __builtin_amdgcn_mfma_f32_16x16x32_bf16(af, bfm, oacc[i], 0, 0, 0); } }
#pragma unroll
    for (int ks = 0; ks < 2; ++ks) { const int ch = ks * 4 + fq;
        const bf16x8 bfm = *(const LAS bf16x8*)(sP + trow * 128 + ((ch ^ (trow & 7)) << 4));
#pragma unroll
        for (int i = 0; i < 4; ++i) { const int vr = 16 * ((w & 1) * 4 + i) + fr; const bf16x8 af = *(const LAS bf16x8*)(sVT + vr * 128 + ((ch ^ (vr & 7)) << 4));
            oacc[i] = __builtin_amdgcn_mfma_f32_16x16x32_bf16(af, bfm, oacc[i], 0, 0, 0); } }
    float ss = 0.f;
#pragma unroll
    for (int i = 0; i < 4; ++i) ss += (oacc[i][0] * oacc[i][0] + oacc[i][1] * oacc[i][1]) + (oacc[i][2] * oacc[i][2] + oacc[i][3] * oacc[i][3]);
    ss += __shfl_xor(ss, 16); ss += __shfl_xor(ss, 32);
    if (fq == 0) sSS[(w & 1) * 64 + trow] = ss;
    __syncthreads();
    const float rinv = 1.f / sqrtf((sSS[trow] + sSS[64 + trow]) * (1.f / 128.f) + RMS_EPS);
#pragma unroll
    for (int i = 0; i < 4; ++i) { const int v0 = 16 * ((w & 1) * 4 + i) + fq * 4;
        const v2u gw2 = *(const GAS v2u*)(Gb + (size_t)trow * 512 + v0); const f32x4 ng = *(const GAS f32x4*)(F.in[I_HGNG] + v0);
        const float g0 = __builtin_bit_cast(float, gw2.x << 16), g1 = __builtin_bit_cast(float, gw2.x & 0xffff0000u), g2 = __builtin_bit_cast(float, gw2.y << 16), g3 = __builtin_bit_cast(float, gw2.y & 0xffff0000u);
        v2u o; o.x = pk2(oacc[i][0] * rinv * ng[0] * silu_f(g0), oacc[i][1] * rinv * ng[1] * silu_f(g1)); o.y = pk2(oacc[i][2] * rinv * ng[2] * silu_f(g2), oacc[i][3] * rinv * ng[3] * silu_f(g3));
        *(GAS v2u*)(MIX + (size_t)trow * 1024 + v0) = o; }
}

__device__ __forceinline__ void s5_tables_stage1(Frame& F) {
    const int gt = (F.vcu * NWAVES + F.wave) * 64 + F.lane, NGT = F.G * NWAVES * 64;
    const float* S5T = (const float*)(F.ws + WS_S5T); const float* PW = (const float*)(F.ws + WS_PW);
    float* KT = (float*)(F.ws + WS_KTAU); bf16* G5 = (bf16*)(F.ws + WS_G5); bf16* T5 = (bf16*)(F.ws + WS_T5);
    for (int i = gt; i < S5G * 32 * 256; i += NGT) { const int g = i >> 13, tau = (i >> 8) & 31, p = (i >> 4) & 15, q = i & 15;
        float acc = (tau == 0 && p == q) ? F.in[I_DSK][g * 16 + p] : 0.f;
        for (int n = 0; n < S5N; ++n) { const int gn = g * S5N + n;
            const float cr = F.in[I_CRE][(size_t)(g * 16 + p) * S5N + n], ci = F.in[I_CIM][(size_t)(g * 16 + p) * S5N + n];
            const float wr = PW[((size_t)gn * 33 + tau) * 2], wi = PW[((size_t)gn * 33 + tau) * 2 + 1];
            const float br = S5T[(size_t)gn * 40 + 2 + q], bi = S5T[(size_t)gn * 40 + 18 + q];
            const float er = cr * wr - ci * wi, ei = cr * wi + ci * wr;
            acc += er * br - ei * bi; }
        KT[i] = acc; }
    for (int i = gt; i < S5G * 256 * 64; i += NGT) { const int g = i >> 14, r = (i >> 6) & 255, kc = i & 63, sdx = kc >> 1, q0 = (kc & 1) * 8;
        float f[8];
        if (r < 128) { const int n = r & 63, gn = g * S5N + n; const float wr = PW[((size_t)gn * 33 + (31 - sdx)) * 2], wi = PW[((size_t)gn * 33 + (31 - sdx)) * 2 + 1];
#pragma unroll
            for (int j = 0; j < 8; ++j) { const float br = S5T[(size_t)gn * 40 + 2 + q0 + j], bi = S5T[(size_t)gn * 40 + 18 + q0 + j]; f[j] = (r < 64) ? (wr * br - wi * bi) : (wr * bi + wi * br); }
        } else {
#pragma unroll
            for (int j = 0; j < 8; ++j) f[j] = 0.f; }
        *(GAS v4u*)(G5 + ((size_t)(g * 256 + r)) * 512 + kc * 8) = pack8(f); }
    for (int i = gt; i < S5G * 512 * 16; i += NGT) { const int g = i >> 13, row = (i >> 4) & 511, nc = i & 15, t = row >> 4, p = row & 15, im = nc >> 3, n0 = (nc & 7) * 8;
        float f[8];
#pragma unroll
        for (int j = 0; j < 8; ++j) { const int n = n0 + j, gn = g * S5N + n;
            const float cr = F.in[I_CRE][(size_t)(g * 16 + p) * S5N + n], ci = F.in[I_CIM][(size_t)(g * 16 + p) * S5N + n];
            const float wr = PW[((size_t)gn * 33 + t + 1) * 2], wi = PW[((size_t)gn * 33 + t + 1) * 2 + 1];
            f[j] = im ? -(cr * wi + ci * wr) : (cr * wr - ci * wi); }
        *(GAS v4u*)(T5 + ((size_t)(g * 512 + row)) * 640 + 512 + nc * 8) = pack8(f); }
}
__device__ __forceinline__ void s5_tables_stage2(Frame& F) {
    const int gt = (F.vcu * NWAVES + F.wave) * 64 + F.lane, NGT = F.G * NWAVES * 64;
    const float* KT = (const float*)(F.ws + WS_KTAU); bf16* T5 = (bf16*)(F.ws + WS_T5);
    for (int i = gt; i < S5G * 512 * 64; i += NGT) { const int g = i >> 15, row = (i >> 6) & 511, kc = i & 63, t = row >> 4, p = row & 15, sdx = kc >> 1, q0 = (kc & 1) * 8;
        float f[8];
        if (sdx <= t) { const float* k = KT + (((size_t)g * 32 + (t - sdx)) * 16 + p) * 16 + q0;
#pragma unroll
            for (int j = 0; j < 8; ++j) f[j] = k[j];
        } else {
#pragma unroll
            for (int j = 0; j < 8; ++j) f[j] = 0.f; }
        *(GAS v4u*)(T5 + ((size_t)(g * 512 + row)) * 640 + kc * 8) = pack8(f); }
}
__device__ __forceinline__ void s5_scan(Frame& F, int idx) {
    const int b = idx >> 11, g = (idx >> 6) & 31, n = idx & 63;
    const float* PW = (const float*)(F.ws + WS_PW); const float* XL = (const float*)(F.ws + WS_XLOC); bf16* A5 = (bf16*)(F.ws + WS_A5);
    const float ar = PW[((size_t)(g * S5N + n) * 33 + 32) * 2], ai = PW[((size_t)(g * S5N + n) * 33 + 32) * 2 + 1];
    float xr = 0.f, xi = 0.f;
    for (int c0 = 0; c0 < 128; c0 += 8) {
        float lr[8], li[8];
#pragma unroll
        for (int j = 0; j < 8; ++j) { const float* p = XL + ((size_t)(b * 128 + c0 + j) * 32 + g) * 128 + n; lr[j] = p[0]; li[j] = p[64]; }
#pragma unroll
        for (int j = 0; j < 8; ++j) { bf16* o = A5 + ((size_t)g * S5I + b * 128 + c0 + j) * 640 + 512 + n; o[0] = (bf16)f2bf(xr); o[64] = (bf16)f2bf(xi);
            const float nr = ar * xr - ai * xi + lr[j], ni = ar * xi + ai * xr + li[j]; xr = nr; xi = ni; }
    }
}

__device__ __forceinline__ void ln1_row(bf16* row, const float* g, const float* b, int lane) {
    const v4u w0 = *(const GAS v4u*)(row + lane * 8), w1 = *(const GAS v4u*)(row + 512 + lane * 8);
    float a[8], c[8]; unpack8(w0, a); unpack8(w1, c);
    float s = 0.f;
#pragma unroll
    for (int j = 0; j < 8; ++j) s += a[j] + c[j];
    const float mean = wave_sum(s) * (1.f / D); float s2 = 0.f;
#pragma unroll
    for (int j = 0; j < 8; ++j) { a[j] -= mean; c[j] -= mean; s2 += a[j] * a[j] + c[j] * c[j]; }
    const float rstd = 1.f / sqrtf(wave_sum(s2) * (1.f / D) + LN_EPS);
    const f32x4 g0 = *(const GAS f32x4*)(g + lane * 8), g1 = *(const GAS f32x4*)(g + lane * 8 + 4), g2 = *(const GAS f32x4*)(g + 512 + lane * 8), g3 = *(const GAS f32x4*)(g + 512 + lane * 8 + 4);
    const f32x4 b0 = *(const GAS f32x4*)(b + lane * 8), b1 = *(const GAS f32x4*)(b + lane * 8 + 4), b2 = *(const GAS f32x4*)(b + 512 + lane * 8), b3 = *(const GAS f32x4*)(b + 512 + lane * 8 + 4);
    const float gg0[8] = {g0.x, g0.y, g0.z, g0.w, g1.x, g1.y, g1.z, g1.w}, gg1[8] = {g2.x, g2.y, g2.z, g2.w, g3.x, g3.y, g3.z, g3.w};
    const float bb0[8] = {b0.x, b0.y, b0.z, b0.w, b1.x, b1.y, b1.z, b1.w}, bb1[8] = {b2.x, b2.y, b2.z, b2.w, b3.x, b3.y, b3.z, b3.w};
#pragma unroll
    for (int j = 0; j < 8; ++j) { a[j] = a[j] * rstd * gg0[j] + bb0[j]; c[j] = c[j] * rstd * gg1[j] + bb1[j]; }
    *(GAS v4u*)(row + lane * 8) = pack8(a); *(GAS v4u*)(row + 512 + lane * 8) = pack8(c);
}

typedef float f32x16 __attribute__((ext_vector_type(16)));
__device__ __forceinline__ int f2ord(float f) { const int x = __builtin_bit_cast(int, f); return x ^ ((x >> 31) & 0x7fffffff); }
__device__ __forceinline__ float ord2f(int x) { return __builtin_bit_cast(float, x ^ ((x >> 31) & 0x7fffffff)); }
#define CE_DESC(a, b) do { const int _h = max((a), (b)), _l = min((a), (b)); (a) = _h; (b) = _l; } while (0)
__device__ __forceinline__ void sort16_desc(int (&v)[16]) {
#pragma unroll
    for (int k = 2; k <= 16; k <<= 1)
#pragma unroll
        for (int j = k >> 1; j > 0; j >>= 1)
#pragma unroll
            for (int i = 0; i < 16; ++i) { const int l = i ^ j; if (l > i) { if ((i & k) == 0) CE_DESC(v[i], v[l]); else CE_DESC(v[l], v[i]); } }
}
__device__ __forceinline__ void merge16_desc(int (&a)[16], const int (&b)[16]) {
#pragma unroll
    for (int i = 0; i < 16; ++i) a[i] = max(a[i], b[15 - i]);
#pragma unroll
    for (int j = 8; j > 0; j >>= 1)
#pragma unroll
        for (int i = 0; i < 16; ++i) { const int l = i ^ j; if (l > i) CE_DESC(a[i], a[l]); }
}
__device__ __forceinline__ void peer_topk_side(const f32x16 (&acc)[4], int hi, int (&top)[16]) {
    int t[4][16];
#pragma unroll
    for (int kt = 0; kt < 4; ++kt)
#pragma unroll
        for (int j = 0; j < 16; ++j) { const unsigned key = (unsigned)(kt * 32 + (j & 3) + 8 * (j >> 2)) | (unsigned)(4 * hi);
            const float av = acc[kt][j];
            t[kt][j] = f2ord(__builtin_bit_cast(float, (__builtin_bit_cast(unsigned, av) & 0xFFFFFF80u) | key)); }
    sort16_desc(t[0]); sort16_desc(t[1]); sort16_desc(t[2]); sort16_desc(t[3]);
    merge16_desc(t[0], t[1]); merge16_desc(t[2], t[3]); merge16_desc(t[0], t[2]);
    int p[16];
#pragma unroll
    for (int i = 0; i < 16; ++i) p[i] = __shfl_xor(t[0][i], 32);
    merge16_desc(t[0], p);
#pragma unroll
    for (int i = 0; i < 16; ++i) top[i] = t[0][i];
}
__device__ __forceinline__ void peer_score_phase(Frame& F) {
    LAS unsigned char* kl = F.lds + RING_OFF;
    LAS unsigned* look = (LAS unsigned*)(F.lds + RING_OFF + 65536 + F.wave * 8192);
    const bf16* keys = (const bf16*)(F.ws + WS_KEYS);
    for (int i = F.tid; i < 2 * 128 * 16; i += NWAVES * 64) { const int sn = i >> 4, c = i & 15, n = sn & 127;
        *(LAS v4u*)(kl + sn * 256 + ((c ^ (n & 15)) << 4)) = *(const GAS v4u*)(keys + (size_t)sn * 128 + c * 8); }
    __syncthreads();
    const int gw = F.vcu * NWAVES + F.wave, NGW = F.G * NWAVES, lane = F.lane, r32 = lane & 31, hi = lane >> 5;
    const bf16* Q2 = (const bf16*)(F.ws + WS_Q2);
    int* EIDX = (int*)(F.ws + WS_EIDX); float* EGATE = (float*)(F.ws + WS_EGATE);
    for (int unit = gw; unit < (M / 32) * PH; unit += NGW) {
        const int blk = unit >> 3, h = unit & 7; const size_t tok = (size_t)blk * 32 + r32;
        const bf16* qrow = Q2 + tok * NQ2 + h * PQ + hi * 8;
        int top1[16], top2[16];
#pragma unroll
        for (int s = 0; s < 2; ++s) {
            bf16x8 qf[8];
#pragma unroll
            for (int ks = 0; ks < 8; ++ks) qf[ks] = *(const GAS bf16x8*)(qrow + s * 128 + ks * 16);
            f32x16 acc[4];
#pragma unroll
            for (int kt = 0; kt < 4; ++kt) { acc[kt] = (f32x16){0.f, 0.f, 0.f, 0.f, 0.f, 0.f, 0.f, 0.f, 0.f, 0.f, 0.f, 0.f, 0.f, 0.f, 0.f, 0.f};
                const int n = kt * 32 + r32;
#pragma unroll
                for (int ks = 0; ks < 8; ++ks) { const bf16x8 kf = *(const LAS bf16x8*)(kl + (s * 128 + n) * 256 + (((2 * ks + hi) ^ (n & 15)) << 4));
                    acc[kt] = __builtin_amdgcn_mfma_f32_32x32x16_bf16(kf, qf[ks], acc[kt], 0, 0, 0); } }
            if (s == 0) peer_topk_side(acc, hi, top1); else peer_topk_side(acc, hi, top2);
        }
        float v1[16], v2[16];
#pragma unroll
        for (int i = 0; i < 16; ++i) { v1[i] = ord2f(top1[i]); v2[i] = ord2f(top2[i]);
            look[i * 64 + lane] = __builtin_bit_cast(unsigned, v1[i]) & 0x7Fu; look[(16 + i) * 64 + lane] = __builtin_bit_cast(unsigned, v2[i]) & 0x7Fu; }
        int c[4][16]; int nc = 0;
#pragma unroll
        for (int i = 0; i < 16; ++i)
#pragma unroll
            for (int j = 0; j < 16; ++j) if ((i + 1) * (j + 1) <= 16) { const float sum = v1[i] + v2[j];
                c[nc >> 4][nc & 15] = f2ord(__builtin_bit_cast(float, (__builtin_bit_cast(unsigned, sum) & 0xFFFFFF00u) | (unsigned)(i * 16 + j))); ++nc; }
#pragma unroll
        for (int q = 50; q < 64; ++q) c[q >> 4][q & 15] = (int)0x80000000;
        sort16_desc(c[0]); sort16_desc(c[1]); sort16_desc(c[2]); sort16_desc(c[3]);
        merge16_desc(c[0], c[1]); merge16_desc(c[2], c[3]); merge16_desc(c[0], c[2]);
        float e[16], sum = 0.f;
        float cf[16];
#pragma unroll
        for (int k = 0; k < 16; ++k) cf[k] = ord2f(c[0][k]);
#pragma unroll
        for (int k = 0; k < 16; ++k) { e[k] = __expf(cf[k] - cf[0]); sum += e[k]; }
        const float inv = 1.f / sum;
        LDS_WAIT();
        int ex[8]; float gt[8];
#pragma unroll
        for (int k = 0; k < 8; ++k) { const float cv = hi ? cf[8 + k] : cf[k]; gt[k] = (hi ? e[8 + k] : e[k]) * inv;
            const unsigned pos = __builtin_bit_cast(unsigned, cv) & 0xFFu;
            ex[k] = (int)(look[(pos >> 4) * 64 + lane] * PK + look[(16 + (pos & 15)) * 64 + lane]); }
        int* eo = EIDX + (tok * PH + h) * 16 + hi * 8; float* go = EGATE + (tok * PH + h) * 16 + hi * 8;
        *(GAS v4u*)eo = (v4u){(unsigned)ex[0], (unsigned)ex[1], (unsigned)ex[2], (unsigned)ex[3]}; *(GAS v4u*)(eo + 4) = (v4u){(unsigned)ex[4], (unsigned)ex[5], (unsigned)ex[6], (unsigned)ex[7]};
        *(GAS f32x4*)go = (f32x4){gt[0], gt[1], gt[2], gt[3]}; *(GAS f32x4*)(go + 4) = (f32x4){gt[4], gt[5], gt[6], gt[7]};
        LDS_WAIT();
    }
}

typedef float f32x2 __attribute__((ext_vector_type(2)));
constexpr float PD_SCALE = 256.f, PU_SCALE = 32.f;
__device__ __forceinline__ void unpack_fp8x16(const v4u w, float (&f)[16]) {
    const unsigned ww[4] = {w.x, w.y, w.z, w.w};
#pragma unroll
    for (int i = 0; i < 4; ++i) { const f32x2 lo = __builtin_amdgcn_cvt_pk_f32_fp8((int)ww[i], false), hi = __builtin_amdgcn_cvt_pk_f32_fp8((int)ww[i], true);
        f[4 * i] = lo[0]; f[4 * i + 1] = lo[1]; f[4 * i + 2] = hi[0]; f[4 * i + 3] = hi[1]; }
}
__device__ __forceinline__ void peer_sort_experts(int& e0, int& e1, float& g0, float& g1, int lane) {
    int k0 = e0 * 128 + lane, k1 = e1 * 128 + 64 + lane;
#pragma unroll
    for (int k = 2; k <= 128; k <<= 1)
#pragma unroll
        for (int j = k >> 1; j > 0; j >>= 1) {
            if (j == 64) { const int lo = min(k0, k1), hi = max(k0, k1); k0 = lo; k1 = hi; }
            else { const int p0 = __shfl_xor(k0, j), p1 = __shfl_xor(k1, j); const bool lower = (lane & j) == 0;
                const bool asc0 = (lane & k) == 0, asc1 = ((64 + lane) & k) == 0;
                k0 = (lower == asc0) ? min(k0, p0) : max(k0, p0); k1 = (lower == asc1) ? min(k1, p1) : max(k1, p1); }
        }
    const int s0 = k0 & 127, s1 = k1 & 127;
    const float a0 = __shfl(g0, s0 & 63), b0 = __shfl(g1, s0 & 63), a1 = __shfl(g0, s1 & 63), b1 = __shfl(g1, s1 & 63);
    g0 = (s0 < 64) ? a0 : b0; g1 = (s1 < 64) ? a1 : b1; e0 = k0 >> 7; e1 = k1 >> 7;
}
__device__ __forceinline__ void peer_gather_phase(Frame& F) {
    const int gw = F.vcu * NWAVES + F.wave, NGW = F.G * NWAVES, lane = F.lane;
    const bf16* H1 = (const bf16*)(F.ws + WS_H); const unsigned char* PD = F.ws + WS_PD; const unsigned char* PU = F.ws + WS_PU;
    const int* EIDX = (const int*)(F.ws + WS_EIDX); const float* EGATE = (const float*)(F.ws + WS_EGATE);
    const int rep = ((lane >> 5) & 1) * 4 + ((lane >> 4) & 1) * 2 + ((lane >> 3) & 1);
    for (int tok = gw; tok < M; tok += NGW) {
        float x[16]; { float a[8], c[8]; unpack8(*(const GAS v4u*)(H1 + (size_t)tok * D + lane * 16), a); unpack8(*(const GAS v4u*)(H1 + (size_t)tok * D + lane * 16 + 8), c);
#pragma unroll
            for (int j = 0; j < 8; ++j) { x[j] = a[j]; x[8 + j] = c[j]; } }
        int e0 = EIDX[(size_t)tok * 128 + lane], e1 = EIDX[(size_t)tok * 128 + 64 + lane];
        float g0 = EGATE[(size_t)tok * 128 + lane]; float g1 = EGATE[(size_t)tok * 128 + 64 + lane];
        peer_sort_experts(e0, e1, g0, g1, lane);
        float o[16];
#pragma unroll
        for (int j = 0; j < 16; ++j) o[j] = 0.f;
#pragma unroll 1
        for (int bt = 0; bt < 16; ++bt) {
            const int ev = (bt < 8) ? e0 : e1; const float gv = (bt < 8) ? g0 : g1; const int lb8 = (bt & 7) * 8;
            v4u dw[8], uw[8];
#pragma unroll
            for (int i = 0; i < 8; ++i) { const int e = __builtin_amdgcn_readlane(ev, lb8 + i);
                dw[i] = *(const GAS v4u*)(PD + (size_t)e * D + lane * 16); uw[i] = *(const GAS v4u*)(PU + (size_t)e * D + lane * 16); }
            float p[8];
#pragma unroll
            for (int i = 0; i < 8; ++i) { float a[16]; unpack_fp8x16(dw[i], a); float s = 0.f;
#pragma unroll
                for (int j = 0; j < 16; ++j) s += a[j] * x[j];
                p[i] = s; }
#pragma unroll
            for (int i = 0; i < 4; ++i) { const float keep = (lane & 32) ? p[i + 4] : p[i], send = (lane & 32) ? p[i] : p[i + 4]; p[i] = keep + __shfl_xor(send, 32); }
#pragma unroll
            for (int i = 0; i < 2; ++i) { const float keep = (lane & 16) ? p[i + 2] : p[i], send = (lane & 16) ? p[i] : p[i + 2]; p[i] = keep + __shfl_xor(send, 16); }
            { const float keep = (lane & 8) ? p[1] : p[0], send = (lane & 8) ? p[0] : p[1]; p[0] = keep + __shfl_xor(send, 8); }
            p[0] += __shfl_xor(p[0], 4); p[0] += __shfl_xor(p[0], 2); p[0] += __shfl_xor(p[0], 1);
            const float gate = __shfl(gv, lb8 + rep);
            const float act = gelu_tanh(p[0] * (1.f / PD_SCALE)) * gate * (1.f / PU_SCALE);
#pragma unroll
            for (int i = 0; i < 8; ++i) { const float af = __builtin_bit_cast(float, __builtin_amdgcn_readlane(__builtin_bit_cast(int, act), ((i >> 2) & 1) * 32 + ((i >> 1) & 1) * 16 + (i & 1) * 8));
                float a[16]; unpack_fp8x16(uw[i], a);
#pragma unroll
                for (int j = 0; j < 16; ++j) o[j] += af * a[j]; }
        }
        float s = 0.f;
#pragma unroll
        for (int j = 0; j < 16; ++j) { o[j] += DN_ALPHA * x[j]; s += o[j]; }
        const float mean = wave_sum(s) * (1.f / D); float s2 = 0.f;
#pragma unroll
        for (int j = 0; j < 16; ++j) { o[j] -= mean; s2 += o[j] * o[j]; }
        const float rstd = 1.f / sqrtf(wave_sum(s2) * (1.f / D) + LN_EPS);
        const float* g = F.in[I_LN2G] + lane * 16; const float* b = F.in[I_LN2B] + lane * 16;
        float* orow = F.out + (size_t)tok * D + lane * 16;
#pragma unroll
        for (int q = 0; q < 4; ++q) { const f32x4 ga = *(const GAS f32x4*)(g + 4 * q), ba = *(const GAS f32x4*)(b + 4 * q);
            f32x4 y; y.x = o[4 * q + 0] * rstd * ga.x + ba.x; y.y = o[4 * q + 1] * rstd * ga.y + ba.y; y.z = o[4 * q + 2] * rstd * ga.z + ba.z; y.w = o[4 * q + 3] * rstd * ga.w + ba.w;
            *(GAS f32x4*)(orow + 4 * q) = y; }
    }
}

struct Args { const float* in[26]; float* out; unsigned char* ws; int ph_lo, ph_hi, li, pad; };
__global__ void __launch_bounds__(NWAVES * 64, 2) fwd_kernel(Args args) {
    extern __shared__ __attribute__((aligned(16))) unsigned char lds[];
    Frame F;
    F.lds = (LAS unsigned char*)lds;
    F.MISC = (volatile LAS unsigned*)(F.lds + MISC_OFF);
    F.tid = threadIdx.x; F.lane = F.tid & 63; F.wave = __builtin_amdgcn_readfirstlane(F.tid >> 6);
    F.G = gridDim.x; { const int bx = blockIdx.x; F.vcu = (F.G % 8 == 0) ? (bx % 8) * (F.G / 8) + bx / 8 : bx; }
#pragma unroll
    for (int i = 0; i < 26; ++i) F.in[i] = args.in[i];
    F.out = args.out; F.ws = args.ws;
    unsigned char* ws = args.ws;
    F.ctl = (gu32*)(ws + WS_CTL);
    for (int u = F.tid; u < (LDS_BYTES - LDSCTL_OFF) / 4; u += NWAVES * 64) ((LAS unsigned*)(F.lds + LDSCTL_OFF))[u] = 0u;
    __syncthreads();
    XcdBarrier bar; bar.bar = (unsigned*)(F.ctl + CW_BAR); bar.x = 0; bar.st = nullptr;
    if (N_LAUNCHES == 1) bar = xcd_barrier_post((unsigned*)(F.ctl + CW_BAR), F.MISC + 8);
#define GRID_BAR() do { if (N_LAUNCHES == 1) xcd_barrier(bar); } while (0)
    const int lo = args.ph_lo, hi = args.ph_hi;
#define IN(k) (lo <= (k) && (k) < hi)
#define BOTH(k) (IN(k) && IN((k) + 1))
    bf16* const Hb = (bf16*)(ws + WS_H);
    bf16* const PRJ = (bf16*)(ws + WS_PROJ);

    if (IN(0)) { p0_prologue(F); if (BOTH(0)) GRID_BAR(); }

    if (IN(1)) {
        s5_tables_stage1(F);
        pg8::Gemm g{Hb, (const bf16*)(ws + WS_WIN), M, NPROJ, D, D, D}; pg8::StaticOrder S; S.init(M, NPROJ, F.G, (int)blockIdx.x);
        pg8::EpiProj E{PRJ, PRJ + (size_t)M * 512, PRJ + (size_t)2 * M * 512, PRJ + (size_t)3 * M * 512, (bf16*)(ws + WS_A5), (const float*)(ws + WS_LB), M};
        pg8::gemm_phase<pg8::EpiProj, pg8::StaticOrder, true, true>(F.lds + RING_OFF, g, S, E);
        if (BOTH(1)) GRID_BAR();
    }

    if (IN(2)) {
        s5_tables_stage2(F);
        if (F.vcu < 128) hgrn2_state_pass(F, F.vcu);
        else { pg8::Gemm g{(const bf16*)(ws + WS_A5), (const bf16*)(ws + WS_G5), 32 * S5I, 32 * 256, 512, S5K, 512}; pg8::GroupedOrder S{4, 1, F.G - 128, F.vcu - 128};
            pg8::EpiS5A E{(float*)(ws + WS_XLOC)};
            pg8::gemm_phase<pg8::EpiS5A, pg8::GroupedOrder, true, true>(F.lds + RING_OFF, g, S, E); }
        if (BOTH(2)) GRID_BAR();
    }

    if (IN(3)) {
        if (F.vcu < 32) s5_scan(F, F.vcu * 512 + F.tid);
        for (int it = F.vcu; it < 32 * 64; it += F.G) { hgrn2_out_item(F, it); __syncthreads(); }
        if (BOTH(3)) GRID_BAR();
    }

    if (IN(4)) {
        pg8::Gemm g{(const bf16*)(ws + WS_A5), (const bf16*)(ws + WS_T5), 32 * S5I, 32 * 512, S5K, S5K, S5K}; pg8::GroupedOrder S{4, 2, F.G, F.vcu};
        pg8::EpiS5C E{(bf16*)(ws + WS_Z)};
        pg8::gemm_phase<pg8::EpiS5C, pg8::GroupedOrder, true, true>(F.lds + RING_OFF, g, S, E);
        if (BOTH(4)) GRID_BAR();
    }

    if (IN(5)) {
        pg8::Gemm g{(const bf16*)(ws + WS_Z), (const bf16*)(ws + WS_WGLU), M, 512, 512, 512, 512}; pg8::StaticOrder S; S.init(M, 512, F.G, (int)blockIdx.x);
        pg8::EpiGlu E{(const bf16*)(ws + WS_Z), (bf16*)(ws + WS_MIX), F.in[I_BGLU]};
        pg8::gemm_phase<pg8::EpiGlu, pg8::StaticOrder, true, true>(F.lds + RING_OFF, g, S, E);
        if (BOTH(5)) GRID_BAR();
    }

    if (IN(6)) {
        pg8::Gemm g{(const bf16*)(ws + WS_MIX), (const bf16*)(ws + WS_WOUT), M, D, D, D, D}; pg8::StaticOrder S; S.init(M, D, F.G, (int)blockIdx.x);
        pg8::EpiOut E{Hb, DN_ALPHA};
        pg8::gemm_phase<pg8::EpiOut, pg8::StaticOrder, true, true>(F.lds + RING_OFF, g, S, E);
        if (BOTH(6)) GRID_BAR();
    }

    if (IN(7)) {
        const int gw = F.vcu * NWAVES + F.wave, NGW = F.G * NWAVES;
        for (int m = gw; m < M; m += NGW) ln1_row(Hb + (size_t)m * D, F.in[I_LN1G], F.in[I_LN1B], F.lane);
        { const int gt = gw * 64 + F.lane, NGT = NGW * 64;
          constexpr int NTAB16 = PE * D / 16;
          for (int i = gt; i < 2 * NTAB16; i += NGT) { const bool up = i >= NTAB16; const int j = up ? i - NTAB16 : i; const float* src = (up ? F.in[I_PU] : F.in[I_PD]) + (size_t)j * 16; const float sc = up ? PU_SCALE : PD_SCALE;
              v4u o; unsigned ow[4];
#pragma unroll
              for (int q = 0; q < 4; ++q) { const f32x4 a = *(const GAS f32x4*)(src + 4 * q); int pk = __builtin_amdgcn_cvt_pk_fp8_f32(a.x * sc, a.y * sc, 0, false); pk = __builtin_amdgcn_cvt_pk_fp8_f32(a.z * sc, a.w * sc, pk, true); ow[q] = (unsigned)pk; }
              o.x = ow[0]; o.y = ow[1]; o.z = ow[2]; o.w = ow[3];
              *(GAS v4u*)(ws + (up ? WS_PU : WS_PD) + (size_t)j * 16) = o; }
        }
        if (BOTH(7)) GRID_BAR();
    }

    if (IN(8)) {
        pg8::Gemm g{Hb, (const bf16*)(ws + WS_WQ), M, NQ2, D, D, D}; pg8::StaticOrder S; S.init(M, NQ2, F.G, (int)blockIdx.x);
        pg8::EpiStore E{(bf16*)(ws + WS_Q2), NQ2};
        pg8::gemm_phase<pg8::EpiStore, pg8::StaticOrder, true, true>(F.lds + RING_OFF, g, S, E);
        if (BOTH(8)) GRID_BAR();
    }

    if (IN(9)) { peer_score_phase(F); if (BOTH(9)) GRID_BAR(); }

    if (IN(10)) { peer_gather_phase(F); }
#undef IN
#undef BOTH
}

extern "C" void kernel_launch(void* const* d_in, const int* in_sizes, int n_in, void* d_out, int out_size, void* d_ws, size_t ws_size, hipStream_t stream) {
    static int grid = 0;
    if (grid == 0) {
        if (n_in != 26 || in_sizes[0] != M * D || out_size != M * D || ws_size < WS_END) { fprintf(stderr, "kernel_launch: unexpected shapes: n_in %d in0 %d out %d ws %zu (need %zu)\n", n_in, n_in > 0 ? in_sizes[0] : -1, out_size, ws_size, (size_t)WS_END); grid = -1; return; }
        int dev = 0, cus = 0;
        if (hipGetDevice(&dev) != hipSuccess || hipDeviceGetAttribute(&cus, hipDeviceAttributeMultiprocessorCount, dev) != hipSuccess) { grid = -1; return; }
        if (hipFuncSetAttribute((const void*)fwd_kernel, hipFuncAttributeMaxDynamicSharedMemorySize, LDS_BYTES) != hipSuccess) { fprintf(stderr, "kernel_launch: hipFuncSetAttribute failed\n"); grid = -1; return; }
        (void)hipGetLastError();
        grid = cus;
    }
    if (grid < 0) return;
    if (hipMemsetAsync((char*)d_ws + WS_CTL, 0, CTL_ZERO_BYTES, stream) != hipSuccess) return;
    Args a{};
    for (int i = 0; i < 26; ++i) a.in[i] = (const float*)d_in[i];
    a.out = (float*)d_out; a.ws = (unsigned char*)d_ws;
    if (N_LAUNCHES == 1) { a.ph_lo = 0; a.ph_hi = NPH; a.li = 0; hipLaunchKernelGGL(fwd_kernel, dim3(grid), dim3(NWAVES * 64), LDS_BYTES, stream, a); }
    else for (int li = 0; li < NPH; ++li) { a.ph_lo = li; a.ph_hi = li + 1; a.li = li; hipLaunchKernelGGL(fwd_kernel, dim3(grid), dim3(NWAVES * 64), LDS_BYTES, stream, a); }
}
```

```cpp
#include <hip/hip_runtime.h>
#include <cstdio>
#include <cstdint>
namespace pg8 {
#define PG8_LAS __attribute__((address_space(3)))
typedef unsigned short bf16_t;
typedef short bf16x8 __attribute__((ext_vector_type(8)));
typedef float f32x4 __attribute__((ext_vector_type(4)));
typedef unsigned u32x4 __attribute__((ext_vector_type(4)));
constexpr int BM = 256, BK = 64, HALF = 128, HTB = HALF * BK * 2  , STAGE_BYTES = 8 * HTB, NXCD = 8, WGM = 8;

__host__ __device__ __forceinline__ int lds_byte(int r, int c) { const int st = (r >> 4) * 2 + (c >> 5), rr = r & 15, cc = c & 31, ob = rr * 64 + cc * 2; return st * 1024 + (ob ^ (((ob >> 9) & 1) << 5)); }
__host__ __device__ __forceinline__ void stage_rc(int b, int& R, int& C) { const int st = b / 1024, sb = b % 1024, swz = sb ^ (((sb >> 9) & 1) << 5); R = (st >> 1) * 16 + swz / 64; C = (st & 1) * 32 + (swz % 64) / 2; }
__host__ __device__ __forceinline__ int perm32(int rho) { const int n = rho >> 4, i = rho & 15; return 8 * (i >> 2) + 4 * n + (i & 3); }

struct Unit { int pm, pn; };
struct Gemm { const bf16_t* A; const bf16_t* Bt; int M, N, K, lda, ldb; };

struct StaticOrder {
    int nM, nN, nwg, G, c;
    __host__ __device__ void init(int M, int N, int G_, int c_) { nM = M / BM; nN = N / BM; nwg = nM * nN; G = G_; c = c_; }
    __host__ __device__ bool next(int i, Unit& u) const {
        const long L = (long)i * G + c; if (L >= nwg) return false;
        int wgid = (int)L; { const int q = nwg / NXCD, r = nwg % NXCD, xcd = wgid % NXCD, off = wgid / NXCD; wgid = (xcd < r ? xcd * (q + 1) : r * (q + 1) + (xcd - r) * q) + off; }
        const int nig = WGM * nN, gid = wgid / nig, fm = gid * WGM, gsz = (nM - fm) < WGM ? (nM - fm) : WGM;
        u.pm = fm + ((wgid % nig) % gsz); u.pn = (wgid % nig) / gsz; return true;
    }
    __device__ __forceinline__ void a_ready(const Unit&) const {}
    __device__ __forceinline__ void done(const Unit&) const {}
};

__device__ __forceinline__ unsigned cvt_pk_bf16(float lo, float hi) { unsigned r; asm volatile("v_cvt_pk_bf16_f32 %0, %1, %2" : "=v"(r) : "v"(lo), "v"(hi)); return r; }
__device__ __forceinline__ void unpack8(const u32x4 w, float (&f)[8]) {
    f[0] = __builtin_bit_cast(float, w.x << 16); f[1] = __builtin_bit_cast(float, w.x & 0xffff0000u);
    f[2] = __builtin_bit_cast(float, w.y << 16); f[3] = __builtin_bit_cast(float, w.y & 0xffff0000u);
    f[4] = __builtin_bit_cast(float, w.z << 16); f[5] = __builtin_bit_cast(float, w.z & 0xffff0000u);
    f[6] = __builtin_bit_cast(float, w.w << 16); f[7] = __builtin_bit_cast(float, w.w & 0xffff0000u);
}
__device__ __forceinline__ u32x4 pack8(const float (&f)[8]) { u32x4 w; w.x = cvt_pk_bf16(f[0], f[1]); w.y = cvt_pk_bf16(f[2], f[3]); w.z = cvt_pk_bf16(f[4], f[5]); w.w = cvt_pk_bf16(f[6], f[7]); return w; }

struct EpiStore {
    static constexpr bool PERM = true, AFTER_DRAIN = false;
    bf16_t* O; int ldc;
    __device__ __forceinline__ void operator()(const f32x4 (&acc)[2][2][4][2], const Unit& u, int wr, int wc, int fr, int fq) const {
        const int row0 = u.pm * BM + wr * 64 + fr, col0 = u.pn * BM + wc * 32 + 8 * fq;
#pragma unroll
        for (int ai = 0; ai < 2; ++ai)
#pragma unroll
            for (int m = 0; m < 4; ++m) { bf16_t* rowp = O + (size_t)(row0 + ai * HALF + m * 16) * ldc + col0;
#pragma unroll
                for (int bj = 0; bj < 2; ++bj) { const f32x4 v0 = acc[ai][bj][m][0], v1 = acc[ai][bj][m][1];
                    u32x4 w; w.x = cvt_pk_bf16(v0[0], v0[1]); w.y = cvt_pk_bf16(v0[2], v0[3]); w.z = cvt_pk_bf16(v1[0], v1[1]); w.w = cvt_pk_bf16(v1[2], v1[3]);
                    *(u32x4*)(rowp + bj * HALF) = w; } }
    }
};

struct EpiProj {
    static constexpr bool PERM = true, AFTER_DRAIN = false;
    bf16_t* Qb; bf16_t* LFb; bf16_t* Vb; bf16_t* Gb; bf16_t* Ub; const float* lb; int M;
    __device__ __forceinline__ void operator()(const f32x4 (&acc)[2][2][4][2], const Unit& u, int wr, int wc, int fr, int fq) const {
        const int row0 = u.pm * BM + wr * 64 + fr; const int colt = u.pn * BM; const int t = colt >> 9;
        const int cb = (colt & 511) + wc * 32 + 8 * fq;
        float lbv[2][8];
        if (t == 1) {
#pragma unroll
            for (int bj = 0; bj < 2; ++bj) { const f32x4 a = *(const f32x4*)(lb + cb + bj * HALF), b = *(const f32x4*)(lb + cb + bj * HALF + 4);
                lbv[bj][0] = a[0]; lbv[bj][1] = a[1]; lbv[bj][2] = a[2]; lbv[bj][3] = a[3]; lbv[bj][4] = b[0]; lbv[bj][5] = b[1]; lbv[bj][6] = b[2]; lbv[bj][7] = b[3]; }
        }
#pragma unroll
        for (int ai = 0; ai < 2; ++ai)
#pragma unroll
            for (int m = 0; m < 4; ++m) { const int row = row0 + ai * HALF + m * 16;
#pragma unroll
                for (int bj = 0; bj < 2; ++bj) { const f32x4 v0 = acc[ai][bj][m][0], v1 = acc[ai][bj][m][1]; const int c = cb + bj * HALF;
                    float f[8] = {v0[0], v0[1], v0[2], v0[3], v1[0], v1[1], v1[2], v1[3]};
                    if (t == 0) {
#pragma unroll
                        for (int j = 0; j < 8; ++j) f[j] *= 0.08838834764831845f;
                        *(u32x4*)(Qb + (size_t)row * 512 + c) = pack8(f);
                    } else if (t == 1) {
#pragma unroll
                        for (int j = 0; j < 8; ++j) { const float l = lbv[bj][j]; const float sg = 1.f / (1.f + __expf(-f[j])); f[j] = __logf(l + (1.f - l) * sg); }
                        *(u32x4*)(LFb + (size_t)row * 512 + c) = pack8(f);
                    } else if (t == 2) { *(u32x4*)(Vb + (size_t)row * 512 + c) = pack8(f);
                    } else if (t == 3) { *(u32x4*)(Gb + (size_t)row * 512 + c) = pack8(f);
                    } else { *(u32x4*)(Ub + ((size_t)(c >> 4) * (M / 32) + (row >> 5)) * 640 + (row & 31) * 16 + (c & 15)) = pack8(f); }
                } }
    }
};

struct EpiGlu {
    static constexpr bool PERM = true, AFTER_DRAIN = false;
    const bf16_t* Z; bf16_t* MIX; const float* bglu;
    __device__ __forceinline__ void operator()(const f32x4 (&acc)[2][2][4][2], const Unit& u, int wr, int wc, int fr, int fq) const {
        const int row0 = u.pm * BM + wr * 64 + fr, col0 = u.pn * BM + wc * 32 + 8 * fq;
#pragma unroll
        for (int bj = 0; bj < 2; ++bj) { const int c = col0 + bj * HALF;
            const f32x4 b0 = *(const f32x4*)(bglu + c), b1 = *(const f32x4*)(bglu + c + 4);
#pragma unroll
            for (int ai = 0; ai < 2; ++ai)
#pragma unroll
                for (int m = 0; m < 4; ++m) { const int row = row0 + ai * HALF + m * 16;
                    const f32x4 v0 = acc[ai][bj][m][0] + b0, v1 = acc[ai][bj][m][1] + b1;
                    float z[8]; unpack8(*(const u32x4*)(Z + (size_t)row * 512 + c), z);
                    float f[8] = {v0[0], v0[1], v0[2], v0[3], v1[0], v1[1], v1[2], v1[3]};
#pragma unroll
                    for (int j = 0; j < 8; ++j) f[j] = z[j] / (1.f + __expf(-f[j]));
                    *(u32x4*)(MIX + (size_t)row * 1024 + 512 + c) = pack8(f); } }
    }
};

struct EpiOut {
    static constexpr bool PERM = true, AFTER_DRAIN = false;
    bf16_t* H; float alpha;
    __device__ __forceinline__ void operator()(const f32x4 (&acc)[2][2][4][2], const Unit& u, int wr, int wc, int fr, int fq) const {
        const int row0 = u.pm * BM + wr * 64 + fr, col0 = u.pn * BM + wc * 32 + 8 * fq;
#pragma unroll
        for (int ai = 0; ai < 2; ++ai)
#pragma unroll
            for (int m = 0; m < 4; ++m) { bf16_t* rowp = H + (size_t)(row0 + ai * HALF + m * 16) * 1024 + col0;
#pragma unroll
                for (int bj = 0; bj < 2; ++bj) { const f32x4 v0 = acc[ai][bj][m][0], v1 = acc[ai][bj][m][1];
                    float h[8]; unpack8(*(const u32x4*)(rowp + bj * HALF), h);
                    float f[8] = {v0[0], v0[1], v0[2], v0[3], v1[0], v1[1], v1[2], v1[3]};
#pragma unroll
                    for (int j = 0; j < 8; ++j) f[j] = alpha * h[j] + f[j];
                    *(u32x4*)(rowp + bj * HALF) = pack8(f); } }
    }
};

struct GroupedOrder {
    int tm, tn, G, c;
    __device__ bool next(int i, Unit& u) const { const int L = i * G + c, per = tm * tn; if (c < 0 || L >= 32 * per) return false;
        const int g = L / per, r = L % per; u.pm = g * tm + r % tm; u.pn = g * tn + r / tm; return true; }
    __device__ __forceinline__ void a_ready(const Unit&) const {}
    __device__ __forceinline__ void done(const Unit&) const {}
};
struct EpiS5A {
    static constexpr bool PERM = true, AFTER_DRAIN = false;
    float* X;
    __device__ __forceinline__ void operator()(const f32x4 (&acc)[2][2][4][2], const Unit& u, int wr, int wc, int fr, int fq) const {
        const int g = u.pn, inst0 = (u.pm & 3) * BM + wr * 64 + fr, col = wc * 32 + 8 * fq;
#pragma unroll
        for (int ai = 0; ai < 2; ++ai)
#pragma unroll
            for (int m = 0; m < 4; ++m) { float* p = X + ((size_t)(inst0 + ai * HALF + m * 16) * 32 + g) * 128 + col;
                *(f32x4*)p = acc[ai][0][m][0]; *(f32x4*)(p + 4) = acc[ai][0][m][1]; }
    }
};
struct EpiS5C {
    static constexpr bool PERM = true, AFTER_DRAIN = false;
    bf16_t* Z;
    __device__ __forceinline__ void operator()(const f32x4 (&acc)[2][2][4][2], const Unit& u, int wr, int wc, int fr, int fq) const {
        const int g = u.pm >> 2, inst0 = (u.pm & 3) * BM + wr * 64 + fr, col0 = (u.pn & 1) * BM + wc * 32 + 8 * fq;
#pragma unroll
        for (int ai = 0; ai < 2; ++ai)
#pragma unroll
            for (int m = 0; m < 4; ++m) { const int inst = inst0 + ai * HALF + m * 16; const size_t tok0 = (size_t)(inst >> 7) * 4096 + (size_t)(inst & 127) * 32;
#pragma unroll
                for (int bj = 0; bj < 2; ++bj) { const int col = col0 + bj * HALF; const f32x4 v0 = acc[ai][bj][m][0], v1 = acc[ai][bj][m][1];
                    float f[8] = {v0[0], v0[1], v0[2], v0[3], v1[0], v1[1], v1[2], v1[3]};
#pragma unroll
                    for (int j = 0; j < 8; ++j) { const float x = f[j], y = 0.7978845608028654f * (x + 0.044715f * x * x * x); f[j] = x / (1.f + __expf(-2.f * y)); }
                    *(u32x4*)(Z + (tok0 + (col >> 4)) * 512 + g * 16 + (col & 15)) = pack8(f); } }
    }
};

template <class Epi, class Sched, bool ALIGN_EPI = false, bool SP2 = false>
__device__ __forceinline__ void gemm_phase(PG8_LAS unsigned char* lds, const Gemm g, const Sched& S, const Epi& E) {
    const int tid = threadIdx.x, wid = __builtin_amdgcn_readfirstlane(tid >> 6), lane = tid & 63, wr = wid >> 2, wc = wid & 3, fr = lane & 15, fq = lane >> 4;
    const int K = g.K, nt = K / BK;
    unsigned voffA[2], voffB[2];
#pragma unroll
    for (int i = 0; i < 2; ++i) { int R, C; stage_rc(tid * 16 + i * 8192, R, C); const int Rb = Epi::PERM ? ((R & ~31) + perm32(R & 31)) : R;
        voffA[i] = (unsigned)(R * g.lda + C) * 2u; voffB[i] = (unsigned)(Rb * g.ldb + C) * 2u; }
    const size_t kstep = (size_t)(BK * 2);
    const size_t hstepA = (size_t)HALF * g.lda * 2, hstepB = (size_t)HALF * g.ldb * 2;
    const size_t tstepA = 2 * hstepA, tstepB = 2 * hstepB;
    const unsigned ldsw = (unsigned)wid * 1024u;
    const int aoff = lds_byte(wr * 64 + fr, fq * 8), boff = lds_byte(wc * 32 + fr, fq * 8);
#define PG8_SA(b, h) (((b) * 2 + (h)) * HTB)
#define PG8_SB(b, h) ((4 + (b) * 2 + (h)) * HTB)
#define PG8_STAGE(bufoff, gbase, voff) do { _Pragma("unroll") for (int _i = 0; _i < 2; ++_i) \
        __builtin_amdgcn_global_load_lds((const unsigned*)((const char*)(gbase) + (voff)[_i]), (PG8_LAS unsigned*)(lds + (bufoff) + ldsw + _i * 8192), 16, 0, 0); } while (0)
#define PG8_LDA(dst, b, h) do { _Pragma("unroll") for (int m = 0; m < 4; ++m) _Pragma("unroll") for (int k = 0; k < 2; ++k) dst[m][k] = *(const PG8_LAS bf16x8*)(lds + PG8_SA(b, h) + aoff + m * 2048 + k * 1024); } while (0)
#define PG8_LDB(dst, b, h) do { _Pragma("unroll") for (int n = 0; n < 2; ++n) _Pragma("unroll") for (int k = 0; k < 2; ++k) dst[n][k] = *(const PG8_LAS bf16x8*)(lds + PG8_SB(b, h) + boff + n * 2048 + k * 1024); } while (0)
#define PG8_MMA(ai, bj, At, Bt) do { __builtin_amdgcn_s_setprio(1); _Pragma("unroll") for (int m = 0; m < 4; ++m) _Pragma("unroll") for (int n = 0; n < 2; ++n) _Pragma("unroll") for (int k = 0; k < 2; ++k) \
        acc[ai][bj][m][n] = __builtin_amdgcn_mfma_f32_16x16x32_bf16(Bt[n][k], At[m][k], acc[ai][bj][m][n], 0, 0, 0); __builtin_amdgcn_s_setprio(0); } while (0)
#define PG8_WAIT_V(n) asm volatile("s_waitcnt vmcnt(" #n ")" ::: "memory")
#define PG8_WAIT_L(n) asm volatile("s_waitcnt lgkmcnt(" #n ")" ::: "memory")
#define PG8_BAR __builtin_amdgcn_s_barrier()
#define PG8_SCHED __builtin_amdgcn_sched_barrier(0)
    Unit cur, nxt; int ui = 0;
    if (!S.next(0, cur)) return;
    f32x4 acc[2][2][4][2];
#pragma unroll
    for (int a = 0; a < 2; ++a)
#pragma unroll
        for (int b = 0; b < 2; ++b)
#pragma unroll
            for (int m = 0; m < 4; ++m)
#pragma unroll
                for (int n = 0; n < 2; ++n) acc[a][b][m][n] = (f32x4){0.f, 0.f, 0.f, 0.f};
    bf16x8 At[4][2], B0[2][2], B1[2][2];
    const char* cA = (const char*)g.A + (size_t)cur.pm * tstepA; const char* cB = (const char*)g.Bt + (size_t)cur.pn * tstepB;
    S.a_ready(cur);
    if constexpr (SP2) {
        PG8_STAGE(PG8_SB(0, 0), cB, voffB); PG8_STAGE(PG8_SB(0, 1), cB + hstepB, voffB); PG8_STAGE(PG8_SA(0, 0), cA, voffA); PG8_STAGE(PG8_SA(0, 1), cA + hstepA, voffA);
        if (wr == 1) PG8_BAR;
        PG8_WAIT_V(2); PG8_BAR;
        PG8_STAGE(PG8_SB(1, 0), cB + kstep, voffB); PG8_STAGE(PG8_SA(1, 0), cA + kstep, voffA); PG8_STAGE(PG8_SB(1, 1), cB + hstepB + kstep, voffB);
        PG8_WAIT_V(6); PG8_BAR;
    } else {
        PG8_STAGE(PG8_SB(0, 0), cB, voffB); PG8_STAGE(PG8_SA(0, 0), cA, voffA); PG8_STAGE(PG8_SB(0, 1), cB + hstepB, voffB); PG8_STAGE(PG8_SA(0, 1), cA + hstepA, voffA);
        if (wr == 1) PG8_BAR;
        PG8_WAIT_V(4); PG8_BAR;
        PG8_STAGE(PG8_SB(1, 0), cB + kstep, voffB); PG8_STAGE(PG8_SA(1, 0), cA + kstep, voffA); PG8_STAGE(PG8_SB(1, 1), cB + hstepB + kstep, voffB);
        PG8_WAIT_V(6); PG8_BAR;
    }
    for (;;) {
        const bool has_next = S.next(ui + 1, nxt);
        const char* nA = has_next ? (const char*)g.A + (size_t)nxt.pm * tstepA : cA; const char* nB = has_next ? (const char*)g.Bt + (size_t)nxt.pn * tstepB : cB;
        for (int t = 0; t < nt; t += 2) {
            const bool last = (t == nt - 2);
            const char* a1 = cA + (size_t)(t + 1) * kstep;
            const char* a2 = last ? nA : cA + (size_t)(t + 2) * kstep; const char* b2 = last ? nB : cB + (size_t)(t + 2) * kstep;
            const char* a3 = a2 + kstep; const char* b3 = b2 + kstep;
            if (last && has_next) S.a_ready(nxt);
            if constexpr (SP2) {
            PG8_LDB(B0, 0, 0); PG8_LDB(B1, 0, 1); PG8_SCHED; PG8_LDA(At, 0, 0); PG8_STAGE(PG8_SA(1, 1), a1 + hstepA, voffA);
            PG8_WAIT_V(8); PG8_WAIT_L(0); PG8_BAR; PG8_MMA(0, 0, At, B0); PG8_MMA(0, 1, At, B1); PG8_BAR; PG8_SCHED;
            PG8_LDA(At, 0, 1); PG8_STAGE(PG8_SB(0, 0), b2, voffB); PG8_STAGE(PG8_SB(0, 1), b2 + hstepB, voffB); PG8_STAGE(PG8_SA(0, 0), a2, voffA);
            PG8_WAIT_V(8); PG8_WAIT_L(0); PG8_BAR; PG8_MMA(1, 0, At, B0); PG8_MMA(1, 1, At, B1); PG8_BAR; PG8_SCHED;
            PG8_LDB(B0, 1, 0); PG8_LDB(B1, 1, 1); PG8_SCHED; PG8_LDA(At, 1, 0); PG8_STAGE(PG8_SA(0, 1), a2 + hstepA, voffA);
            PG8_WAIT_V(8); PG8_WAIT_L(0); PG8_BAR; PG8_MMA(0, 0, At, B0); PG8_MMA(0, 1, At, B1); PG8_BAR; PG8_SCHED;
            PG8_LDA(At, 1, 1); PG8_STAGE(PG8_SB(1, 0), b3, voffB); PG8_STAGE(PG8_SB(1, 1), b3 + hstepB, voffB); PG8_STAGE(PG8_SA(1, 0), a3, voffA);
            PG8_WAIT_V(8); PG8_WAIT_L(0); PG8_BAR; PG8_MMA(1, 0, At, B0); PG8_MMA(1, 1, At, B1); PG8_BAR; PG8_SCHED;
            } else {
            PG8_LDB(B0, 0, 0); PG8_SCHED; PG8_LDA(At, 0, 0); PG8_STAGE(PG8_SA(1, 1), a1 + hstepA, voffA);
            PG8_WAIT_L(8); PG8_BAR; PG8_WAIT_L(0); PG8_MMA(0, 0, At, B0); PG8_BAR; PG8_SCHED;
            PG8_LDB(B1, 0, 1); PG8_STAGE(PG8_SB(0, 0), b2, voffB);
            PG8_BAR; PG8_WAIT_L(0); PG8_MMA(0, 1, At, B1); PG8_BAR;
            PG8_LDA(At, 0, 1); PG8_STAGE(PG8_SA(0, 0), a2, voffA);
            PG8_BAR; PG8_WAIT_L(0); PG8_MMA(1, 0, At, B0); PG8_BAR; PG8_SCHED;
            PG8_STAGE(PG8_SB(0, 1), b2 + hstepB, voffB);
            PG8_WAIT_V(6); PG8_BAR; PG8_MMA(1, 1, At, B1); PG8_BAR;
            PG8_LDB(B0, 1, 0); PG8_SCHED; PG8_LDA(At, 1, 0); PG8_STAGE(PG8_SA(0, 1), a2 + hstepA, voffA);
            PG8_WAIT_L(8); PG8_BAR; PG8_WAIT_L(0); PG8_MMA(0, 0, At, B0); PG8_BAR; PG8_SCHED;
            PG8_LDB(B1, 1, 1); PG8_STAGE(PG8_SB(1, 0), b3, voffB);
            PG8_BAR; PG8_WAIT_L(0); PG8_MMA(0, 1, At, B1); PG8_BAR;
            PG8_LDA(At, 1, 1); PG8_STAGE(PG8_SA(1, 0), a3, voffA);
            PG8_BAR; PG8_WAIT_L(0); PG8_MMA(1, 0, At, B0); PG8_BAR; PG8_SCHED;
            PG8_STAGE(PG8_SB(1, 1), b3 + hstepB, voffB);
            PG8_WAIT_V(6); PG8_BAR; PG8_MMA(1, 1, At, B1); PG8_BAR;
            }
        }
        if constexpr (ALIGN_EPI) { if (wr == 0) PG8_BAR; }
        if constexpr (!Epi::AFTER_DRAIN) { E(acc, cur, wr, wc, fr, fq); S.done(cur); }
        if (!has_next) break;
#pragma unroll
        for (int a = 0; a < 2; ++a)
#pragma unroll
            for (int b = 0; b < 2; ++b)
#pragma unroll
                for (int m = 0; m < 4; ++m)
#pragma unroll
                    for (int n = 0; n < 2; ++n) acc[a][b][m][n] = (f32x4){0.f, 0.f, 0.f, 0.f};
        cur = nxt; cA = nA; cB = nB; ++ui;
        if constexpr (ALIGN_EPI) { if (wr == 1) PG8_BAR; }
    }
    PG8_WAIT_V(0);
    if constexpr (!ALIGN_EPI) { if (wr == 0) PG8_BAR; }
    PG8_BAR;
    if constexpr (Epi::AFTER_DRAIN) { E.fused(acc, cur, wr, wc, fr, fq, lds, wid, lane); S.done(cur); }
#undef PG8_SA
#undef PG8_SB
#undef PG8_STAGE
#undef PG8_LDA
#undef PG8_LDB
#undef PG8_MMA
#undef PG8_WAIT_V
#undef PG8_WAIT_L
#undef PG8_BAR
#undef PG8_SCHED
}
}

constexpr int NWAVES = 8;
#ifndef MK_N_LAUNCHES
#define MK_N_LAUNCHES 1
#endif
constexpr int N_LAUNCHES = MK_N_LAUNCHES;
constexpr int NPH = 11;
#ifndef PROBE_REP
#define PROBE_REP -1
#endif

constexpr int BATCH = 8, SEQ = 4096, D = 1024, M = BATCH * SEQ;
constexpr int HGW = 512, HGH = 4, HGK = 128;
constexpr int S5W = 512, S5G = 32, S5P = 16, S5N = 64;
constexpr int S5L = 32, S5I = M / S5L, S5K = S5L * S5P + 2 * S5N;
constexpr int NPROJ = 2560;
constexpr int PK = 128, PH = 8, PTOPK = 16, PQ = 256, PHALF = 128, PE = PK * PK, NQ2 = PH * PQ;
constexpr float LN_EPS = 1e-5f, RMS_EPS = 1e-6f;
constexpr float DN_ALPHA = 1.189207115002721f;

constexpr size_t MiB = 1u << 20;
constexpr size_t WS_CTL = 0, CTL_ZERO_BYTES = 1 * MiB;
constexpr size_t WS_WIN = 1 * MiB;
constexpr size_t WS_WGLU = 6 * MiB;
constexpr size_t WS_KEYS = 6 * MiB + 512 * 1024;
constexpr size_t WS_LB = 6 * MiB + 640 * 1024;
constexpr size_t WS_S5T = 6 * MiB + 704 * 1024;
constexpr size_t WS_WOUT = 7 * MiB + 512 * 1024;
constexpr size_t WS_WQ = 10 * MiB;
constexpr size_t WS_SST = 14 * MiB;
constexpr size_t WS_H = 78 * MiB;
constexpr size_t WS_PROJ = 142 * MiB;
constexpr size_t WS_Q2 = WS_PROJ;
constexpr size_t WS_A5 = 270 * MiB;
constexpr size_t WS_MIX = 310 * MiB;
constexpr size_t WS_PD = 452 * MiB, WS_PU = 468 * MiB;
constexpr size_t WS_Z = 374 * MiB;
constexpr size_t WS_EIDX = WS_Z, WS_EGATE = WS_Z + 16 * MiB;
constexpr size_t WS_T5 = 406 * MiB;
constexpr size_t WS_G5 = 426 * MiB;
constexpr size_t WS_XLOC = 434 * MiB;
constexpr size_t WS_KTAU = 450 * MiB;
constexpr size_t WS_PW = 451 * MiB;
constexpr size_t WS_END = 484 * MiB;
constexpr int CW_TMO = 0, CW_CODE = 1;
constexpr int CW_BAR = 4096;

constexpr int RING_OFF = 0, RING_BYTES = 131072;
constexpr int LDSCTL_OFF = RING_BYTES, MISC_OFF = LDSCTL_OFF + 320;
constexpr int LDS_BYTES = 147456;
static_assert(MISC_OFF + 128 <= LDS_BYTES, "LDS map");

#define GAS __attribute__((address_space(1)))
#define LAS __attribute__((address_space(3)))
typedef unsigned short bf16;
typedef unsigned v4u __attribute__((ext_vector_type(4)));
typedef float f32x4 __attribute__((ext_vector_type(4)));
typedef short bf16x8 __attribute__((ext_vector_type(8)));
typedef GAS unsigned gu32;
typedef GAS unsigned long long gu64;
#define RLX_AGENT __ATOMIC_RELAXED, __HIP_MEMORY_SCOPE_AGENT
#define LDS_WAIT() asm volatile("s_waitcnt lgkmcnt(0)" ::: "memory")
#define VM_WAIT() asm volatile("s_waitcnt vmcnt(0)" ::: "memory")
__device__ __forceinline__ unsigned long long rt() { return __builtin_amdgcn_s_memrealtime(); }
__device__ __forceinline__ unsigned f2bf(float f) { unsigned u = __builtin_bit_cast(unsigned, f); return (u + 0x7fffu + ((u >> 16) & 1u)) >> 16; }
__device__ __forceinline__ unsigned pk2(float lo, float hi) { return f2bf(lo) | (f2bf(hi) << 16); }

#define XB_TMO      128
#define XB_XCNT(j)  (256  + 64 * (j))
#define XB_XSUB(j)  (1280 + 64 * (j))
#define XB_XGEN(j)  (2304 + 64 * (j))
#define XB_TOP      3328
#define XB_TOPGEN   3392
#define XCD_BAR_WORDS 3456
#define XB_SPIN_CAP (1u << 18)

__device__ __forceinline__ unsigned xb_ld(unsigned* p)              { return __hip_atomic_load(p, __ATOMIC_RELAXED, __HIP_MEMORY_SCOPE_AGENT); }
__device__ __forceinline__ unsigned xb_add(unsigned* p, unsigned v) { return __hip_atomic_fetch_add(p, v, __ATOMIC_RELAXED, __HIP_MEMORY_SCOPE_AGENT); }
__device__ __forceinline__ unsigned xb_xcc_id() { return (unsigned)__builtin_amdgcn_s_getreg((3 << 11) | 20) & 0xFu; }
#define XB_SPIN(cond, bar) do { unsigned _sp = 0; while (cond) { __builtin_amdgcn_s_sleep(1); \
    if ((++_sp & 255u) == 0u) { if (xb_ld(&(bar)[XB_TMO])) break; if (_sp > XB_SPIN_CAP) { atomicAdd(&(bar)[XB_TMO], 1u); break; } } } } while (0)

struct XcdBarrier {
    unsigned* bar; unsigned x;
    volatile LAS unsigned* st;
};

__device__ __forceinline__ XcdBarrier xcd_barrier_post(unsigned* bar, volatile LAS unsigned* st) {
    XcdBarrier b; b.bar = bar; b.x = xb_xcc_id(); b.st = st;
    if (threadIdx.x == 0) (void)xb_add(&bar[XB_XCNT(b.x)], 1u);
    return b;
}
__device__ __forceinline__ void xcd_barrier_complete(unsigned* bar, unsigned x, unsigned& nloc, unsigned& nx) {
    const unsigned G = gridDim.x * gridDim.y * gridDim.z;
    unsigned sum, cnt, mine, sp = 0u;
    for (;;) {
        sum = 0u; cnt = 0u; mine = 0u;
#pragma unroll
        for (unsigned j = 0; j < 16; ++j) { const unsigned c = xb_ld(&bar[XB_XCNT(j)]); sum += c; cnt += (c > 0u) ? 1u : 0u; mine = (j == x) ? c : mine; }
        if (sum == G) break;
        __builtin_amdgcn_s_sleep(1);
        if ((++sp & 255u) == 0u) { if (xb_ld(&bar[XB_TMO])) break; if (sp > XB_SPIN_CAP) { atomicAdd(&bar[XB_TMO], 1u); break; } }
    }
    nloc = mine > 0u ? mine : 1u; nx = cnt > 0u ? cnt : 1u;
}

__device__ __forceinline__ void xcd_barrier(const XcdBarrier& b) {
    asm volatile("s_waitcnt vmcnt(0)" ::: "memory");
    __syncthreads();
    if (threadIdx.x == 0) {
        unsigned* bar = b.bar;
        __builtin_amdgcn_s_waitcnt(0);
        unsigned nloc = b.st[0], nx = b.st[1];
        if (nloc == 0u) { xcd_barrier_complete(bar, b.x, nloc, nx); b.st[0] = nloc; b.st[1] = nx; }
        const unsigned old = xb_add(&bar[XB_XSUB(b.x)], 1u);
        const unsigned gen = old / nloc;
        if (old + 1u == (gen + 1u) * nloc) {
            __builtin_amdgcn_fence(__ATOMIC_RELEASE, "agent");
            asm volatile("s_waitcnt vmcnt(0)" ::: "memory");
            const unsigned og = xb_add(&bar[XB_TOP], 1u);
            const unsigned tg = og / nx;
            if (og + 1u == (tg + 1u) * nx) xb_add(&bar[XB_TOPGEN], 1u);
            else XB_SPIN(xb_ld(&bar[XB_TOPGEN]) == tg, bar);
            __builtin_amdgcn_fence(__ATOMIC_ACQUIRE, "agent");
            xb_add(&bar[XB_XGEN(b.x)], 1u);
            asm volatile("s_waitcnt vmcnt(0)" ::: "memory");
        } else {
            XB_SPIN(xb_ld(&bar[XB_XGEN(b.x)]) == gen, bar);
            __builtin_amdgcn_fence(__ATOMIC_ACQUIRE, "agent");
            asm volatile("s_waitcnt vmcnt(0)" ::: "memory");
        }
    }
    __syncthreads();
}

struct Frame {
    LAS unsigned char* lds;
    volatile LAS unsigned* MISC;
    gu32* ctl;
    int tid, lane, wave;
    int vcu, G;
    const float* in[26]; float* out; unsigned char* ws;
};
enum { I_X = 0, I_LN0G, I_LN0B, I_WIN, I_LBL, I_HGNG, I_ARE, I_AIM, I_LSTEP, I_BRE, I_BIM, I_CRE, I_CIM, I_DSK, I_WGLU, I_BGLU, I_WOUT, I_LN1G, I_LN1B, I_WQ, I_K1, I_K2, I_PD, I_PU, I_LN2G, I_LN2B };

__device__ __forceinline__ float bf2f(bf16 v) { return __builtin_bit_cast(float, (unsigned)v << 16); }
__device__ __forceinline__ float wave_sum(float v) {
#pragma unroll
    for (int o = 1; o < 64; o <<= 1) v += __shfl_xor(v, o);
    return v;
}
__device__ __forceinline__ float wave_max(float v) {
#pragma unroll
    for (int o = 1; o < 64; o <<= 1) v = fmaxf(v, __shfl_xor(v, o));
    return v;
}
__device__ __forceinline__ float gelu_tanh(float x) { const float y = 0.7978845608028654f * (x + 0.044715f * x * x * x); return x / (1.f + __expf(-2.f * y)); }
__device__ __forceinline__ float silu_f(float x) { return x / (1.f + __expf(-x)); }
__device__ __forceinline__ void unpack8(const v4u w, float (&f)[8]) {
    f[0] = __builtin_bit_cast(float, w.x << 16); f[1] = __builtin_bit_cast(float, w.x & 0xffff0000u);
    f[2] = __builtin_bit_cast(float, w.y << 16); f[3] = __builtin_bit_cast(float, w.y & 0xffff0000u);
    f[4] = __builtin_bit_cast(float, w.z << 16); f[5] = __builtin_bit_cast(float, w.z & 0xffff0000u);
    f[6] = __builtin_bit_cast(float, w.w << 16); f[7] = __builtin_bit_cast(float, w.w & 0xffff0000u);
}
__device__ __forceinline__ v4u pack8(const float (&f)[8]) { v4u w; w.x = pk2(f[0], f[1]); w.y = pk2(f[2], f[3]); w.z = pk2(f[4], f[5]); w.w = pk2(f[6], f[7]); return w; }

__device__ __forceinline__ void p0_transpose_item(const float* W, int K, int N, bf16* WT, int row_off, LAS float* scr, int item, int lane) {
    const int nblk = N / 32, kb = item / nblk, nb = item % nblk, k0 = 64 * kb, n0 = 32 * nb;
#pragma unroll 8
    for (int i = 0; i < 32; ++i) { const int kk = 2 * i + (lane >> 5); scr[kk * 33 + (lane & 31)] = W[(size_t)(k0 + kk) * N + n0 + (lane & 31)]; }
    LDS_WAIT(); asm volatile("" ::: "memory");
    const int c = lane & 7;
#pragma unroll
    for (int j = 0; j < 4; ++j) { const int n = (lane >> 3) + 8 * j; const LAS float* s = scr + (8 * c) * 33 + n;
        v4u o; o.x = pk2(s[0 * 33], s[1 * 33]); o.y = pk2(s[2 * 33], s[3 * 33]); o.z = pk2(s[4 * 33], s[5 * 33]); o.w = pk2(s[6 * 33], s[7 * 33]);
        *(GAS v4u*)(WT + (size_t)(row_off + n0 + n) * K + k0 + 8 * c) = o; }
    LDS_WAIT(); asm volatile("" ::: "memory");
}
__device__ __forceinline__ void ln0_row(const float* xrow, const float* g, const float* b, bf16* orow, int lane) {
    const GAS f32x4* xr = (const GAS f32x4*)xrow + lane;
    f32x4 v[4]; float s = 0.f;
#pragma unroll
    for (int j = 0; j < 4; ++j) { v[j] = xr[64 * j]; s += (v[j].x + v[j].y) + (v[j].z + v[j].w); }
    const float mean = wave_sum(s) * (1.f / D); float s2 = 0.f;
#pragma unroll
    for (int j = 0; j < 4; ++j) { v[j] = v[j] - mean; s2 += (v[j].x * v[j].x + v[j].y * v[j].y) + (v[j].z * v[j].z + v[j].w * v[j].w); }
    const float rstd = 1.f / sqrtf(wave_sum(s2) * (1.f / D) + LN_EPS);
    GAS unsigned long long* o8 = (GAS unsigned long long*)orow + lane;
#pragma unroll
    for (int j = 0; j < 4; ++j) { const f32x4 gg = ((const GAS f32x4*)g)[lane + 64 * j], bb = ((const GAS f32x4*)b)[lane + 64 * j];
        const f32x4 o = v[j] * rstd * gg + bb;
        o8[64 * j] = (unsigned long long)pk2(o.x, o.y) | ((unsigned long long)pk2(o.z, o.w) << 32); }
}
__device__ __forceinline__ void p0_prologue(Frame& F) {
    LAS float* scr = (LAS float*)(F.lds + RING_OFF + F.wave * 16384);
    const int gw = F.vcu * NWAVES + F.wave, NGW = F.G * NWAVES;
    unsigned char* ws = F.ws;
    constexpr int I_IN = (D / 64) * (NPROJ / 32), I_GLU = (512 / 64) * (512 / 32), I_OUT = (1024 / 64) * (1024 / 32), I_Q = (1024 / 64) * (2048 / 32);
    constexpr int NITEMS = I_IN + I_GLU + I_OUT + I_Q;
    for (int it = gw; it < NITEMS; it += NGW) {
        int r = it;
        if (r < I_IN) { p0_transpose_item(F.in[I_WIN], D, NPROJ, (bf16*)(ws + WS_WIN), 0, scr, r, F.lane); continue; } r -= I_IN;
        if (r < I_GLU) { p0_transpose_item(F.in[I_WGLU], 512, 512, (bf16*)(ws + WS_WGLU), 0, scr, r, F.lane); continue; } r -= I_GLU;
        if (r < I_OUT) { p0_transpose_item(F.in[I_WOUT], 1024, 1024, (bf16*)(ws + WS_WOUT), 0, scr, r, F.lane); continue; } r -= I_OUT;
        p0_transpose_item(F.in[I_WQ], 1024, 2048, (bf16*)(ws + WS_WQ), 0, scr, r, F.lane);
    }
    const int gt = gw * 64 + F.lane, NGT = NGW * 64;
    for (int i = gt; i < 2 * PK * PHALF; i += NGT) { const float v = (i < PK * PHALF) ? F.in[I_K1][i] : F.in[I_K2][i - PK * PHALF]; ((bf16*)(ws + WS_KEYS))[i] = (bf16)f2bf(v); }
    for (int i = gt; i < HGW; i += NGT) { const float l0 = F.in[I_LBL][i], l1 = F.in[I_LBL][HGW + i]; ((float*)(ws + WS_LB))[i] = 1.f / (1.f + expf(l1 - l0)); }
    for (int i = gt; i < S5G * S5N; i += NGT) { const int g = i / S5N;
        const float are = F.in[I_ARE][i], aim = F.in[I_AIM][i], step = expf(F.in[I_LSTEP][g]);
        const float zr = step * are, zi = step * aim, mag = expf(zr), cz = cosf(zi), sz = sinf(zi), sh = sinf(0.5f * zi);
        const float abr = mag * cz, abi = mag * sz;
        const float nre = expm1f(zr) * cz - 2.f * sh * sh, nim = abi;
        const float den = are * are + aim * aim;
        const float cre = (nre * are + nim * aim) / den, cim = (nim * are - nre * aim) / den;
        float* t = (float*)(ws + WS_S5T) + (size_t)i * 40; t[0] = abr; t[1] = abi;
        for (int p = 0; p < S5P; ++p) { const float br = F.in[I_BRE][(size_t)i * S5P + p], bi = F.in[I_BIM][(size_t)i * S5P + p];
            t[2 + p] = cre * br - cim * bi; t[18 + p] = cre * bi + cim * br; } }
    for (int i = gt; i < S5G * S5N * 33; i += NGT) { const int gn = i / 33, tau = i % 33, g = gn / S5N;
        const float step = expf(F.in[I_LSTEP][g]), zr = step * F.in[I_ARE][gn] * (float)tau, zi = step * F.in[I_AIM][gn] * (float)tau, mag = expf(zr);
        float* p = (float*)(ws + WS_PW) + (size_t)i * 2; p[0] = mag * cosf(zi); p[1] = mag * sinf(zi); }
    for (int m = gw; m < M; m += NGW) ln0_row(F.in[I_X] + (size_t)m * D, F.in[I_LN0G], F.in[I_LN0B], (bf16*)(ws + WS_H) + (size_t)m * D, F.lane);
}

__device__ __forceinline__ void hgrn2_seq(Frame& F, int bh) {
    const int b = bh >> 2, h = bh & 3, tid = F.tid, kq = tid >> 7, j = tid & 127;
    LAS float* sF = (LAS float*)(F.lds + RING_OFF);
    LAS float* sK = sF + 8 * 128; LAS float* sQ = sK + 8 * 128;
    LAS float* sO = sQ + 8 * 128;
    const bf16* Qb = (const bf16*)(F.ws + WS_PROJ); const bf16* LFb = Qb + (size_t)M * 512; const bf16* Vb = LFb + (size_t)M * 512; const bf16* Gb = Vb + (size_t)M * 512;
    bf16* MIX = (bf16*)(F.ws + WS_MIX);
    const float ng0 = F.in[I_HGNG][F.lane], ng1 = F.in[I_HGNG][F.lane + 64];
    float S[32];
#pragma unroll
    for (int k = 0; k < 32; ++k) S[k] = 0.f;
    for (int t0 = 0; t0 < SEQ; t0 += 8) {
        const size_t tok0 = (size_t)b * SEQ + t0;
#pragma unroll
        for (int r = 0; r < 2; ++r) { const int item = tid + 512 * r, tt = item >> 7, kk = item & 127; const size_t off = (tok0 + tt) * 512 + h * 128 + kk;
            const float lf = bf2f(LFb[off]); sF[tt * 128 + kk] = __expf(lf); sK[tt * 128 + kk] = -expm1f(lf); sQ[tt * 128 + kk] = bf2f(Qb[off]); }
        __syncthreads();
#pragma unroll 1
        for (int tt = 0; tt < 8; ++tt) { const float v = bf2f(Vb[(tok0 + tt) * 512 + h * 128 + j]); float o = 0.f;
            const LAS float* f = sF + tt * 128 + kq * 32; const LAS float* kx = sK + tt * 128 + kq * 32; const LAS float* q = sQ + tt * 128 + kq * 32;
#pragma unroll
            for (int k = 0; k < 32; ++k) { S[k] = f[k] * S[k] + kx[k] * v; o += q[k] * S[k]; }
            sO[(tt * 4 + kq) * 128 + j] = o; }
        __syncthreads();
        { const int tt = F.wave; const size_t tok = tok0 + tt;
            const float o0 = (sO[(tt * 4 + 0) * 128 + F.lane] + sO[(tt * 4 + 1) * 128 + F.lane]) + (sO[(tt * 4 + 2) * 128 + F.lane] + sO[(tt * 4 + 3) * 128 + F.lane]);
            const float o1 = (sO[(tt * 4 + 0) * 128 + 64 + F.lane] + sO[(tt * 4 + 1) * 128 + 64 + F.lane]) + (sO[(tt * 4 + 2) * 128 + 64 + F.lane] + sO[(tt * 4 + 3) * 128 + 64 + F.lane]);
            const float ss = wave_sum(o0 * o0 + o1 * o1), r = 1.f / sqrtf(ss * (1.f / 128.f) + RMS_EPS);
            const float g0 = bf2f(Gb[tok * 512 + h * 128 + F.lane]), g1 = bf2f(Gb[tok * 512 + h * 128 + 64 + F.lane]);
            MIX[tok * 1024 + h * 128 + F.lane] = (bf16)f2bf(o0 * r * ng0 * silu_f(g0));
            MIX[tok * 1024 + h * 128 + 64 + F.lane] = (bf16)f2bf(o1 * r * ng1 * silu_f(g1)); }
    }
    __syncthreads();
}
__device__ __forceinline__ void s5_seq(Frame& F, int pair) {
    const int b = pair >> 5, g = pair & 31, lane = F.lane;
    const float* tb = (const float*)(F.ws + WS_S5T) + (size_t)(g * S5N + lane) * 40;
    const float abr = tb[0], abi = tb[1];
    float bbr[16], bbi[16], cr[16], ci[16], dsk[16];
#pragma unroll
    for (int p = 0; p < 16; ++p) { bbr[p] = tb[2 + p]; bbi[p] = tb[18 + p]; cr[p] = F.in[I_CRE][(size_t)(g * 16 + p) * S5N + lane]; ci[p] = F.in[I_CIM][(size_t)(g * 16 + p) * S5N + lane];
        dsk[p] = (lane == 0) ? F.in[I_DSK][g * 16 + p] : 0.f; }
    const bf16* Ub = (const bf16*)(F.ws + WS_PROJ) + (size_t)4 * M * 512 + ((size_t)g * M + (size_t)b * SEQ) * 16;
    bf16* Zb = (bf16*)(F.ws + WS_Z) + (size_t)b * SEQ * 512 + g * 16;
    const int pme = ((lane >> 5) & 1) * 8 + ((lane >> 4) & 1) * 4 + ((lane >> 3) & 1) * 2 + ((lane >> 2) & 1);
    float xr = 0.f, xi = 0.f;
    v4u nu0 = *(const GAS v4u*)(Ub + (size_t)lane * 16), nu1 = *(const GAS v4u*)(Ub + (size_t)lane * 16 + 8);
    for (int t0 = 0; t0 < SEQ; t0 += 64) {
        const v4u u0 = nu0, u1 = nu1;
        if (t0 + 64 < SEQ) { nu0 = *(const GAS v4u*)(Ub + (size_t)(t0 + 64 + lane) * 16); nu1 = *(const GAS v4u*)(Ub + (size_t)(t0 + 64 + lane) * 16 + 8); }
#pragma unroll 1
        for (int tt = 0; tt < 64; ++tt) {
            v4u a, c;
            a.x = __builtin_amdgcn_readlane(u0.x, tt); a.y = __builtin_amdgcn_readlane(u0.y, tt); a.z = __builtin_amdgcn_readlane(u0.z, tt); a.w = __builtin_amdgcn_readlane(u0.w, tt);
            c.x = __builtin_amdgcn_readlane(u1.x, tt); c.y = __builtin_amdgcn_readlane(u1.y, tt); c.z = __builtin_amdgcn_readlane(u1.z, tt); c.w = __builtin_amdgcn_readlane(u1.w, tt);
            float u[16]; { float f0[8], f1[8]; unpack8(a, f0); unpack8(c, f1);
#pragma unroll
                for (int p = 0; p < 8; ++p) { u[p] = f0[p]; u[8 + p] = f1[p]; } }
            float bur = 0.f, bui = 0.f;
#pragma unroll
            for (int p = 0; p < 16; ++p) { bur += bbr[p] * u[p]; bui += bbi[p] * u[p]; }
            const float nxr = abr * xr - abi * xi + bur, nxi = abr * xi + abi * xr + bui; xr = nxr; xi = nxi;
            float r[16];
#pragma unroll
            for (int p = 0; p < 16; ++p) r[p] = cr[p] * xr - ci[p] * xi + dsk[p] * u[p];
#pragma unroll
            for (int i = 0; i < 8; ++i) { const float keep = (lane & 32) ? r[i + 8] : r[i], send = (lane & 32) ? r[i] : r[i + 8]; r[i] = keep + __shfl_xor(send, 32); }
#pragma unroll
            for (int i = 0; i < 4; ++i) { const float keep = (lane & 16) ? r[i + 4] : r[i], send = (lane & 16) ? r[i] : r[i + 4]; r[i] = keep + __shfl_xor(send, 16); }
#pragma unroll
            for (int i = 0; i < 2; ++i) { const float keep = (lane & 8) ? r[i + 2] : r[i], send = (lane & 8) ? r[i] : r[i + 2]; r[i] = keep + __shfl_xor(send, 8); }
            { const float keep = (lane & 4) ? r[1] : r[0], send = (lane & 4) ? r[0] : r[1]; r[0] = keep + __shfl_xor(send, 4); }
            r[0] += __shfl_xor(r[0], 2); r[0] += __shfl_xor(r[0], 1);
            if ((lane & 3) == 0) Zb[(size_t)(t0 + tt) * 512 + pme] = (bf16)f2bf(gelu_tanh(r[0]));
        }
    }
}

__device__ __forceinline__ int t256(int r, int c) { return r * 256 + ((((c >> 3) ^ (r & 15))) << 4) + (c & 7) * 2; }
__device__ __forceinline__ int t128(int r, int c) { return r * 128 + ((((c >> 3) ^ (r & 7))) << 4) + (c & 7) * 2; }
typedef unsigned v2u __attribute__((ext_vector_type(2)));
__device__ __forceinline__ void hgrn2_state_pass(Frame& F, int item) {
    const int bh = item >> 2, vs = item & 3, b = bh >> 2, h = bh & 3, tid = F.tid, lane = F.lane, w = F.wave, fr = lane & 15, fq = lane >> 4;
    const int kcol = tid & 127, qtr = tid >> 7;
    LAS unsigned char* L = F.lds + RING_OFF;
    LAS unsigned char* sRaw = L + 49152;
    const bf16* LFg = (const bf16*)(F.ws + WS_PROJ) + (size_t)M * 512 + (size_t)b * SEQ * 512 + h * 128;
    const bf16* Vg = (const bf16*)(F.ws + WS_PROJ) + (size_t)2 * M * 512 + (size_t)b * SEQ * 512 + h * 128 + vs * 32;
    bf16* SST = (bf16*)(F.ws + WS_SST) + (size_t)bh * 64 * 128 * 128;
    float S[2][4];
#pragma unroll
    for (int i = 0; i < 2; ++i)
#pragma unroll
        for (int r = 0; r < 4; ++r) S[i][r] = 0.f;
    const int ls0 = tid >> 4, lkg = tid & 15;
    const int vsr = (tid & 255) >> 2, vvg = tid & 3;
    v4u nlf0 = *(const GAS v4u*)(LFg + (size_t)ls0 * 512 + lkg * 8), nlf1 = *(const GAS v4u*)(LFg + (size_t)(32 + ls0) * 512 + lkg * 8);
    v4u nv = *(const GAS v4u*)(Vg + (size_t)vsr * 512 + vvg * 8);
    for (int c = 0; c < 64; ++c) {
        LAS unsigned char* Lb = L + (c & 1) * 24576;
        LAS unsigned char* sKT = Lb; LAS unsigned char* sVT = Lb + 16384; LAS float* sTot = (LAS float*)(Lb + 20480); LAS float* sDec = (LAS float*)(Lb + 22528);
        *(LAS v4u*)(sRaw + ls0 * 256 + lkg * 16) = nlf0; *(LAS v4u*)(sRaw + (32 + ls0) * 256 + lkg * 16) = nlf1;
        if (tid < 256) { const unsigned vw[4] = {nv.x, nv.y, nv.z, nv.w};
#pragma unroll
            for (int j = 0; j < 8; ++j) { const int vr = vvg * 8 + j; *(LAS bf16*)(sVT + vr * 128 + ((((vsr >> 3) ^ (vr & 7))) << 4) + (vsr & 7) * 2) = (bf16)((vw[j >> 1] >> ((j & 1) * 16)) & 0xffffu); } }
        if (c + 1 < 64) { const size_t t1 = (size_t)(c + 1) * 64;
            nlf0 = *(const GAS v4u*)(LFg + (t1 + ls0) * 512 + lkg * 8); nlf1 = *(const GAS v4u*)(LFg + (t1 + 32 + ls0) * 512 + lkg * 8); nv = *(const GAS v4u*)(Vg + (t1 + vsr) * 512 + vvg * 8); }
        __syncthreads();
        float lf[16];
#pragma unroll
        for (int j = 0; j < 16; ++j) lf[j] = bf2f(*(const LAS bf16*)(sRaw + (qtr * 16 + j) * 256 + kcol * 2));
        float cl[16]; float run = 0.f;
#pragma unroll
        for (int j = 0; j < 16; ++j) { run += lf[j]; cl[j] = run; }
        sTot[qtr * 128 + kcol] = run;
        __syncthreads();
        const float t0 = sTot[kcol], t1 = sTot[128 + kcol], t2 = sTot[256 + kcol], t3 = sTot[384 + kcol];
        const float off = (qtr > 0 ? t0 : 0.f) + (qtr > 1 ? t1 : 0.f) + (qtr > 2 ? t2 : 0.f), last = (t0 + t1) + (t2 + t3);
        float kh[16];
#pragma unroll
        for (int j = 0; j < 16; ++j) kh[j] = (1.f - __expf(lf[j])) * __expf(last - (off + cl[j]));
        { const float a[8] = {kh[0], kh[1], kh[2], kh[3], kh[4], kh[5], kh[6], kh[7]}, bq[8] = {kh[8], kh[9], kh[10], kh[11], kh[12], kh[13], kh[14], kh[15]};
          *(LAS v4u*)(sKT + kcol * 128 + (((qtr * 2) ^ (kcol & 7)) << 4)) = pack8(a); *(LAS v4u*)(sKT + kcol * 128 + (((qtr * 2 + 1) ^ (kcol & 7)) << 4)) = pack8(bq); }
        if (qtr == 0) sDec[kcol] = __expf(last);
        __syncthreads();
        f32x4 acc[2] = {(f32x4){0.f, 0.f, 0.f, 0.f}, (f32x4){0.f, 0.f, 0.f, 0.f}};
#pragma unroll
        for (int ks = 0; ks < 2; ++ks) { const int ch = ks * 4 + fq, row = 16 * w + fr;
            const bf16x8 af = *(const LAS bf16x8*)(sKT + row * 128 + ((ch ^ (row & 7)) << 4));
#pragma unroll
            for (int nt = 0; nt < 2; ++nt) { const int vr = 16 * nt + fr; const bf16x8 bfm = *(const LAS bf16x8*)(sVT + vr * 128 + ((ch ^ (vr & 7)) << 4));
                acc[nt] = __builtin_amdgcn_mfma_f32_16x16x32_bf16(af, bfm, acc[nt], 0, 0, 0); } }
        const int k0 = 16 * w + fq * 4; const f32x4 dec = *(const LAS f32x4*)(sDec + k0);
#pragma unroll
        for (int nt = 0; nt < 2; ++nt) { const int vg = vs * 32 + 16 * nt + fr;
            v2u o; o.x = pk2(S[nt][0], S[nt][1]); o.y = pk2(S[nt][2], S[nt][3]);
            *(GAS v2u*)(SST + ((size_t)c * 128 + vg) * 128 + k0) = o;
            S[nt][0] = dec[0] * S[nt][0] + acc[nt][0]; S[nt][1] = dec[1] * S[nt][1] + acc[nt][1]; S[nt][2] = dec[2] * S[nt][2] + acc[nt][2]; S[nt][3] = dec[3] * S[nt][3] + acc[nt][3]; }
    }
    __syncthreads();
}
__device__ __forceinline__ void hgrn2_out_item(Frame& F, int item) {
    const int bh = item >> 6, c = item & 63, b = bh >> 2, h = bh & 3, tid = F.tid, lane = F.lane, w = F.wave, fr = lane & 15, fq = lane >> 4;
    const int kcol = tid & 127, qtr = tid >> 7;
    LAS unsigned char* L = F.lds + RING_OFF;
    LAS unsigned char* sQt = L; LAS unsigned char* sQm = L + 16384; LAS unsigned char* sKm = L + 32768; LAS unsigned char* sVT = L + 49152; LAS unsigned char* sST = L + 65536; LAS unsigned char* sP = L + 98304;
    LAS float* sTot = (LAS float*)(L + 106496); LAS float* sSS = (LAS float*)(L + 108544);
    const size_t tok0 = (size_t)b * SEQ + (size_t)c * 64;
    const bf16* Qb = (const bf16*)(F.ws + WS_PROJ) + tok0 * 512 + h * 128; const bf16* LFb = Qb + (size_t)M * 512; const bf16* Vb = Qb + (size_t)2 * M * 512; const bf16* Gb = Qb + (size_t)3 * M * 512;
    const bf16* SST = (const bf16*)(F.ws + WS_SST) + (size_t)item * 128 * 128;
    bf16* MIX = (bf16*)(F.ws + WS_MIX) + tok0 * 1024 + h * 128;
    float lf[16], q[16]; bf16 vraw[16];
#pragma unroll
    for (int j = 0; j < 16; ++j) { lf[j] = bf2f(LFb[(size_t)(qtr * 16 + j) * 512 + kcol]); q[j] = bf2f(Qb[(size_t)(qtr * 16 + j) * 512 + kcol]); vraw[j] = Vb[(size_t)(qtr * 16 + j) * 512 + kcol]; }
    v4u st[4];
#pragma unroll
    for (int i = 0; i < 4; ++i) { const int idx = tid + 512 * i; st[i] = *(const GAS v4u*)(SST + (size_t)(idx >> 4) * 128 + (idx & 15) * 8); }
    float cl[16]; float run = 0.f;
#pragma unroll
    for (int j = 0; j < 16; ++j) { run += lf[j]; cl[j] = run; }
    sTot[qtr * 128 + kcol] = run;
    __syncthreads();
    { const float t0 = sTot[kcol], t1 = sTot[128 + kcol], t2 = sTot[256 + kcol];
      const float off = (qtr > 0 ? t0 : 0.f) + (qtr > 1 ? t1 : 0.f) + (qtr > 2 ? t2 : 0.f), mid = t0 + t1;
#pragma unroll
      for (int j = 0; j < 16; ++j) { const int s = qtr * 16 + j; const float cum = off + cl[j];
          const int o = t256(s, kcol);
          *(LAS bf16*)(sQt + o) = (bf16)f2bf(q[j] * __expf(cum));
          *(LAS bf16*)(sQm + o) = (bf16)f2bf(q[j] * __expf(cum - mid));
          *(LAS bf16*)(sKm + o) = (bf16)f2bf((1.f - __expf(lf[j])) * __expf(mid - cum)); }
      v4u p0, p1;
      p0.x = (unsigned)vraw[0] | ((unsigned)vraw[1] << 16); p0.y = (unsigned)vraw[2] | ((unsigned)vraw[3] << 16); p0.z = (unsigned)vraw[4] | ((unsigned)vraw[5] << 16); p0.w = (unsigned)vraw[6] | ((unsigned)vraw[7] << 16);
      p1.x = (unsigned)vraw[8] | ((unsigned)vraw[9] << 16); p1.y = (unsigned)vraw[10] | ((unsigned)vraw[11] << 16); p1.z = (unsigned)vraw[12] | ((unsigned)vraw[13] << 16); p1.w = (unsigned)vraw[14] | ((unsigned)vraw[15] << 16);
      *(LAS v4u*)(sVT + kcol * 128 + (((qtr * 2) ^ (kcol & 7)) << 4)) = p0; *(LAS v4u*)(sVT + kcol * 128 + (((qtr * 2 + 1) ^ (kcol & 7)) << 4)) = p1;
#pragma unroll
      for (int i = 0; i < 4; ++i) { const int idx = tid + 512 * i, v = idx >> 4, kc = idx & 15; *(LAS v4u*)(sST + v * 256 + ((kc ^ (v & 15)) << 4)) = st[i]; } }
    __syncthreads();
    const int tt = w >> 1, trow = 16 * tt + fr;
#pragma unroll
    for (int sti = 0; sti < 2; ++sti) { const int stl = (w & 1) * 2 + sti; f32x4 acc = (f32x4){0.f, 0.f, 0.f, 0.f};
        if (stl <= tt) {
#pragma unroll
            for (int ks = 0; ks < 4; ++ks) { const int ch = ks * 4 + fq, srow = 16 * stl + fr;
                const bf16x8 af = *(const LAS bf16x8*)(sKm + srow * 256 + ((ch ^ (srow & 15)) << 4));
                const bf16x8 bfm = *(const LAS bf16x8*)(sQm + trow * 256 + ((ch ^ (trow & 15)) << 4));
                acc = __builtin_amdgcn_mfma_f32_16x16x32_bf16(af, bfm, acc, 0, 0, 0); } }
        const int s0 = 16 * stl + fq * 4;
        const float p0 = (s0 + 0 <= trow) ? acc[0] : 0.f, p1 = (s0 + 1 <= trow) ? acc[1] : 0.f, p2 = (s0 + 2 <= trow) ? acc[2] : 0.f, p3 = (s0 + 3 <= trow) ? acc[3] : 0.f;
        v2u o; o.x = pk2(p0, p1); o.y = pk2(p2, p3);
        *(LAS v2u*)(sP + trow * 128 + ((((s0 >> 3) ^ (trow & 7))) << 4) + (s0 & 7) * 2) = o; }
    __syncthreads();
    f32x4 oacc[4];
#pragma unroll
    for (int i = 0; i < 4; ++i) oacc[i] = (f32x4){0.f, 0.f, 0.f, 0.f};
#pragma unroll
    for (int ks = 0; ks < 4; ++ks) { const int ch = ks * 4 + fq;
        const bf16x8 bfm = *(const LAS bf16x8*)(sQt + trow * 256 + ((ch ^ (trow & 15)) << 4));
#pragma unroll
        for (int i = 0; i < 4; ++i) { const int vr = 16 * ((w & 1) * 4 + i) + fr; const bf16x8 af = *(const LAS bf16x8*)(sST + vr * 256 + ((ch ^ (vr & 15)) << 4));
            oacc[i] = __builtin_amdgcn_mfma_f32_16x16x32_bf16(af, bfm, oacc[i], 0, 0, 0); } }
#pragma unroll
    for (int ks = 0; ks < 2; ++ks) { const int ch = ks * 4 + fq;
        const bf16x8 bfm = *(const LAS bf16x8*)(sP + trow * 128 + ((ch ^ (trow & 7)) << 4));
#pragma unroll
        for (int i = 0; i < 4; ++i) { const int vr = 16 * ((w & 1) * 4 + i) + fr; const bf16x8 af = *(const LAS bf16x8*)(sVT + vr * 128 + ((ch ^ (vr & 7)) << 4));
            oacc[i] = __builtin_amdgcn_mfma_f32_16x16x32_bf16(af, bfm, oacc[i], 0, 0, 0); } }
    float ss = 0.f;
#pragma unroll
    for (int i = 0; i < 4; ++i) ss += (oacc[i][0] * oacc[i][0] + oacc[i][1] * oacc[i][1]) + (oacc[i][2] * oacc[i][2] + oacc[i][3] * oacc[i][3]);
    ss += __shfl_xor(ss, 16); ss += __shfl_xor(ss, 32);
    if (fq == 0) sSS[(w & 1) * 64 + trow] = ss;
    __syncthreads();
    const float rinv = 1.f / sqrtf((sSS[trow] + sSS[64 + trow]) * (1.f / 128.f) + RMS_EPS);
#pragma unroll
    for (int i = 0; i < 4; ++i) { const int v0 = 16 * ((w & 1) * 4 + i) + fq * 4;
        const v2u gw2 = *(const GAS v2u*)(Gb + (size_t)trow * 512 + v0); const f32x4 ng = *(const GAS f32x4*)(F.in[I_HGNG] + v0);
        const float g0 = __builtin_bit_cast(float, gw2.x << 16), g1 = __builtin_bit_cast(float, gw2.x & 0xffff0000u), g2 = __builtin_bit_cast(float, gw2.y << 16), g3 = __builtin_bit_cast(float, gw2.y & 0xffff0000u);
        v2u o; o.x = pk2(oacc[i][0] * rinv * ng[0] * silu_f(g0), oacc[i][1] * rinv * ng[1] * silu_f(g1)); o.y = pk2(oacc[i][2] * rinv * ng[2] * silu_f(g2), oacc[i][3] * rinv * ng[3] * silu_f(g3));
        *(GAS v2u*)(MIX + (size_t)trow * 1024 + v0) = o; }
}

__device__ __forceinline__ void s5_tables_stage1(Frame& F) {
    const int gt = (F.vcu * NWAVES + F.wave) * 64 + F.lane, NGT = F.G * NWAVES * 64;
    const float* S5T = (const float*)(F.ws + WS_S5T); const float* PW = (const float*)(F.ws + WS_PW);
    float* KT = (float*)(F.ws + WS_KTAU); bf16* G5 = (bf16*)(F.ws + WS_G5); bf16* T5 = (bf16*)(F.ws + WS_T5);
    for (int i = gt; i < S5G * 32 * 256; i += NGT) { const int g = i >> 13, tau = (i >> 8) & 31, p = (i >> 4) & 15, q = i & 15;
        float acc = (tau == 0 && p == q) ? F.in[I_DSK][g * 16 + p] : 0.f;
        for (int n = 0; n < S5N; ++n) { const int gn = g * S5N + n;
            const float cr = F.in[I_CRE][(size_t)(g * 16 + p) * S5N + n], ci = F.in[I_CIM][(size_t)(g * 16 + p) * S5N + n];
            const float wr = PW[((size_t)gn * 33 + tau) * 2], wi = PW[((size_t)gn * 33 + tau) * 2 + 1];
            const float br = S5T[(size_t)gn * 40 + 2 + q], bi = S5T[(size_t)gn * 40 + 18 + q];
            const float er = cr * wr - ci * wi, ei = cr * wi + ci * wr;
            acc += er * br - ei * bi; }
        KT[i] = acc; }
    for (int i = gt; i < S5G * 256 * 64; i += NGT) { const int g = i >> 14, r = (i >> 6) & 255, kc = i & 63, sdx = kc >> 1, q0 = (kc & 1) * 8;
        float f[8];
        if (r < 128) { const int n = r & 63, gn = g * S5N + n; const float wr = PW[((size_t)gn * 33 + (31 - sdx)) * 2], wi = PW[((size_t)gn * 33 + (31 - sdx)) * 2 + 1];
#pragma unroll
            for (int j = 0; j < 8; ++j) { const float br = S5T[(size_t)gn * 40 + 2 + q0 + j], bi = S5T[(size_t)gn * 40 + 18 + q0 + j]; f[j] = (r < 64) ? (wr * br - wi * bi) : (wr * bi + wi * br); }
        } else {
#pragma unroll
            for (int j = 0; j < 8; ++j) f[j] = 0.f; }
        *(GAS v4u*)(G5 + ((size_t)(g * 256 + r)) * 512 + kc * 8) = pack8(f); }
    for (int i = gt; i < S5G * 512 * 16; i += NGT) { const int g = i >> 13, row = (i >> 4) & 511, nc = i & 15, t = row >> 4, p = row & 15, im = nc >> 3, n0 = (nc & 7) * 8;
        float f[8];
#pragma unroll
        for (int j = 0; j < 8; ++j) { const int n = n0 + j, gn = g * S5N + n;
            const float cr = F.in[I_CRE][(size_t)(g * 16 + p) * S5N + n], ci = F.in[I_CIM][(size_t)(g * 16 + p) * S5N + n];
            const float wr = PW[((size_t)gn * 33 + t + 1) * 2], wi = PW[((size_t)gn * 33 + t + 1) * 2 + 1];
            f[j] = im ? -(cr * wi + ci * wr) : (cr * wr - ci * wi); }
        *(GAS v4u*)(T5 + ((size_t)(g * 512 + row)) * 640 + 512 + nc * 8) = pack8(f); }
}
__device__ __forceinline__ void s5_tables_stage2(Frame& F) {
    const int gt = (F.vcu * NWAVES + F.wave) * 64 + F.lane, NGT = F.G * NWAVES * 64;
    const float* KT = (const float*)(F.ws + WS_KTAU); bf16* T5 = (bf16*)(F.ws + WS_T5);
    for (int i = gt; i < S5G * 512 * 64; i += NGT) { const int g = i >> 15, row = (i >> 6) & 511, kc = i & 63, t = row >> 4, p = row & 15, sdx = kc >> 1, q0 = (kc & 1) * 8;
        float f[8];
        if (sdx <= t) { const float* k = KT + (((size_t)g * 32 + (t - sdx)) * 16 + p) * 16 + q0;
#pragma unroll
            for (int j = 0; j < 8; ++j) f[j] = k[j];
        } else {
#pragma unroll
            for (int j = 0; j < 8; ++j) f[j] = 0.f; }
        *(GAS v4u*)(T5 + ((size_t)(g * 512 + row)) * 640 + kc * 8) = pack8(f); }
}
__device__ __forceinline__ void s5_scan(Frame& F, int idx) {
    const int b = idx >> 11, g = (idx >> 6) & 31, n = idx & 63;
    const float* PW = (const float*)(F.ws + WS_PW); const float* XL = (const float*)(F.ws + WS_XLOC); bf16* A5 = (bf16*)(F.ws + WS_A5);
    const float ar = PW[((size_t)(g * S5N + n) * 33 + 32) * 2], ai = PW[((size_t)(g * S5N + n) * 33 + 32) * 2 + 1];
    float xr = 0.f, xi = 0.f;
    for (int c0 = 0; c0 < 128; c0 += 8) {
        float lr[8], li[8];
#pragma unroll
        for (int j = 0; j < 8; ++j) { const float* p = XL + ((size_t)(b * 128 + c0 + j) * 32 + g) * 128 + n; lr[j] = p[0]; li[j] = p[64]; }
#pragma unroll
        for (int j = 0; j < 8; ++j) { bf16* o = A5 + ((size_t)g * S5I + b * 128 + c0 + j) * 640 + 512 + n; o[0] = (bf16)f2bf(xr); o[64] = (bf16)f2bf(xi);
            const float nr = ar * xr - ai * xi + lr[j], ni = ar * xi + ai * xr + li[j]; xr = nr; xi = ni; }
    }
}

__device__ __forceinline__ void ln1_row(bf16* row, const float* g, const float* b, int lane) {
    const v4u w0 = *(const GAS v4u*)(row + lane * 8), w1 = *(const GAS v4u*)(row + 512 + lane * 8);
    float a[8], c[8]; unpack8(w0, a); unpack8(w1, c);
    float s = 0.f;
#pragma unroll
    for (int j = 0; j < 8; ++j) s += a[j] + c[j];
    const float mean = wave_sum(s) * (1.f / D); float s2 = 0.f;
#pragma unroll
    for (int j = 0; j < 8; ++j) { a[j] -= mean; c[j] -= mean; s2 += a[j] * a[j] + c[j] * c[j]; }
    const float rstd = 1.f / sqrtf(wave_sum(s2) * (1.f / D) + LN_EPS);
    const f32x4 g0 = *(const GAS f32x4*)(g + lane * 8), g1 = *(const GAS f32x4*)(g + lane * 8 + 4), g2 = *(const GAS f32x4*)(g + 512 + lane * 8), g3 = *(const GAS f32x4*)(g + 512 + lane * 8 + 4);
    const f32x4 b0 = *(const GAS f32x4*)(b + lane * 8), b1 = *(const GAS f32x4*)(b + lane * 8 + 4), b2 = *(const GAS f32x4*)(b + 512 + lane * 8), b3 = *(const GAS f32x4*)(b + 512 + lane * 8 + 4);
    const float gg0[8] = {g0.x, g0.y, g0.z, g0.w, g1.x, g1.y, g1.z, g1.w}, gg1[8] = {g2.x, g2.y, g2.z, g2.w, g3.x, g3.y, g3.z, g3.w};
    const float bb0[8] = {b0.x, b0.y, b0.z, b0.w, b1.x, b1.y, b1.z, b1.w}, bb1[8] = {b2.x, b2.y, b2.z, b2.w, b3.x, b3.y, b3.z, b3.w};
#pragma unroll
    for (int j = 0; j < 8; ++j) { a[j] = a[j] * rstd * gg0[j] + bb0[j]; c[j] = c[j] * rstd * gg1[j] + bb1[j]; }
    *(GAS v4u*)(row + lane * 8) = pack8(a); *(GAS v4u*)(row + 512 + lane * 8) = pack8(c);
}

typedef float f32x16 __attribute__((ext_vector_type(16)));
__device__ __forceinline__ int f2ord(float f) { const int x = __builtin_bit_cast(int, f); return x ^ ((x >> 31) & 0x7fffffff); }
__device__ __forceinline__ float ord2f(int x) { return __builtin_bit_cast(float, x ^ ((x >> 31) & 0x7fffffff)); }
#define CE_DESC(a, b) do { const int _h = max((a), (b)), _l = min((a), (b)); (a) = _h; (b) = _l; } while (0)
__device__ __forceinline__ void sort16_desc(int (&v)[16]) {
#pragma unroll
    for (int k = 2; k <= 16; k <<= 1)
#pragma unroll
        for (int j = k >> 1; j > 0; j >>= 1)
#pragma unroll
            for (int i = 0; i < 16; ++i) { const int l = i ^ j; if (l > i) { if ((i & k) == 0) CE_DESC(v[i], v[l]); else CE_DESC(v[l], v[i]); } }
}
__device__ __forceinline__ void merge16_desc(int (&a)[16], const int (&b)[16]) {
#pragma unroll
    for (int i = 0; i < 16; ++i) a[i] = max(a[i], b[15 - i]);
#pragma unroll
    for (int j = 8; j > 0; j >>= 1)
#pragma unroll
        for (int i = 0; i < 16; ++i) { const int l = i ^ j; if (l > i) CE_DESC(a[i], a[l]); }
}
__device__ __forceinline__ void peer_topk_side(const f32x16 (&acc)[4], int hi, int (&top)[16]) {
    int t[4][16];
#pragma unroll
    for (int kt = 0; kt < 4; ++kt)
#pragma unroll
        for (int j = 0; j < 16; ++j) { const unsigned key = (unsigned)(kt * 32 + (j & 3) + 8 * (j >> 2)) | (unsigned)(4 * hi);
            const float av = acc[kt][j];
            t[kt][j] = f2ord(__builtin_bit_cast(float, (__builtin_bit_cast(unsigned, av) & 0xFFFFFF80u) | key)); }
    sort16_desc(t[0]); sort16_desc(t[1]); sort16_desc(t[2]); sort16_desc(t[3]);
    merge16_desc(t[0], t[1]); merge16_desc(t[2], t[3]); merge16_desc(t[0], t[2]);
    int p[16];
#pragma unroll
    for (int i = 0; i < 16; ++i) p[i] = __shfl_xor(t[0][i], 32);
    merge16_desc(t[0], p);
#pragma unroll
    for (int i = 0; i < 16; ++i) top[i] = t[0][i];
}
__device__ __forceinline__ void peer_score_phase(Frame& F) {
    LAS unsigned char* kl = F.lds + RING_OFF;
    LAS unsigned* look = (LAS unsigned*)(F.lds + RING_OFF + 65536 + F.wave * 8192);
    const bf16* keys = (const bf16*)(F.ws + WS_KEYS);
    for (int i = F.tid; i < 2 * 128 * 16; i += NWAVES * 64) { const int sn = i >> 4, c = i & 15, n = sn & 127;
        *(LAS v4u*)(kl + sn * 256 + ((c ^ (n & 15)) << 4)) = *(const GAS v4u*)(keys + (size_t)sn * 128 + c * 8); }
    __syncthreads();
    const int gw = F.vcu * NWAVES + F.wave, NGW = F.G * NWAVES, lane = F.lane, r32 = lane & 31, hi = lane >> 5;
    const bf16* Q2 = (const bf16*)(F.ws + WS_Q2);
    int* EIDX = (int*)(F.ws + WS_EIDX); float* EGATE = (float*)(F.ws + WS_EGATE);
    for (int unit = gw; unit < (M / 32) * PH; unit += NGW) {
        const int blk = unit >> 3, h = unit & 7; const size_t tok = (size_t)blk * 32 + r32;
        const bf16* qrow = Q2 + tok * NQ2 + h * PQ + hi * 8;
        int top1[16], top2[16];
#pragma unroll
        for (int s = 0; s < 2; ++s) {
            bf16x8 qf[8];
#pragma unroll
            for (int ks = 0; ks < 8; ++ks) qf[ks] = *(const GAS bf16x8*)(qrow + s * 128 + ks * 16);
            f32x16 acc[4];
#pragma unroll
            for (int kt = 0; kt < 4; ++kt) { acc[kt] = (f32x16){0.f, 0.f, 0.f, 0.f, 0.f, 0.f, 0.f, 0.f, 0.f, 0.f, 0.f, 0.f, 0.f, 0.f, 0.f, 0.f};
                const int n = kt * 32 + r32;
#pragma unroll
                for (int ks = 0; ks < 8; ++ks) { const bf16x8 kf = *(const LAS bf16x8*)(kl + (s * 128 + n) * 256 + (((2 * ks + hi) ^ (n & 15)) << 4));
                    acc[kt] = __builtin_amdgcn_mfma_f32_32x32x16_bf16(kf, qf[ks], acc[kt], 0, 0, 0); } }
            if (s == 0) peer_topk_side(acc, hi, top1); else peer_topk_side(acc, hi, top2);
        }
        float v1[16], v2[16];
#pragma unroll
        for (int i = 0; i < 16; ++i) { v1[i] = ord2f(top1[i]); v2[i] = ord2f(top2[i]);
            look[i * 64 + lane] = __builtin_bit_cast(unsigned, v1[i]) & 0x7Fu; look[(16 + i) * 64 + lane] = __builtin_bit_cast(unsigned, v2[i]) & 0x7Fu; }
        int c[4][16]; int nc = 0;
#pragma unroll
        for (int i = 0; i < 16; ++i)
#pragma unroll
            for (int j = 0; j < 16; ++j) if ((i + 1) * (j + 1) <= 16) { const float sum = v1[i] + v2[j];
                c[nc >> 4][nc & 15] = f2ord(__builtin_bit_cast(float, (__builtin_bit_cast(unsigned, sum) & 0xFFFFFF00u) | (unsigned)(i * 16 + j))); ++nc; }
#pragma unroll
        for (int q = 50; q < 64; ++q) c[q >> 4][q & 15] = (int)0x80000000;
        sort16_desc(c[0]); sort16_desc(c[1]); sort16_desc(c[2]); sort16_desc(c[3]);
        merge16_desc(c[0], c[1]); merge16_desc(c[2], c[3]); merge16_desc(c[0], c[2]);
        float e[16], sum = 0.f;
        float cf[16];
#pragma unroll
        for (int k = 0; k < 16; ++k) cf[k] = ord2f(c[0][k]);
#pragma unroll
        for (int k = 0; k < 16; ++k) { e[k] = __expf(cf[k] - cf[0]); sum += e[k]; }
        const float inv = 1.f / sum;
        LDS_WAIT();
        int ex[8]; float gt[8];
#pragma unroll
        for (int k = 0; k < 8; ++k) { const float cv = hi ? cf[8 + k] : cf[k]; gt[k] = (hi ? e[8 + k] : e[k]) * inv;
            const unsigned pos = __builtin_bit_cast(unsigned, cv) & 0xFFu;
            ex[k] = (int)(look[(pos >> 4) * 64 + lane] * PK + look[(16 + (pos & 15)) * 64 + lane]); }
        int* eo = EIDX + (tok * PH + h) * 16 + hi * 8; float* go = EGATE + (tok * PH + h) * 16 + hi * 8;
        *(GAS v4u*)eo = (v4u){(unsigned)ex[0], (unsigned)ex[1], (unsigned)ex[2], (unsigned)ex[3]}; *(GAS v4u*)(eo + 4) = (v4u){(unsigned)ex[4], (unsigned)ex[5], (unsigned)ex[6], (unsigned)ex[7]};
        *(GAS f32x4*)go = (f32x4){gt[0], gt[1], gt[2], gt[3]}; *(GAS f32x4*)(go + 4) = (f32x4){gt[4], gt[5], gt[6], gt[7]};
        LDS_WAIT();
    }
}

typedef float f32x2 __attribute__((ext_vector_type(2)));
constexpr float PD_SCALE = 256.f, PU_SCALE = 32.f;
__device__ __forceinline__ void unpack_fp8x16(const v4u w, float (&f)[16]) {
    const unsigned ww[4] = {w.x, w.y, w.z, w.w};
#pragma unroll
    for (int i = 0; i < 4; ++i) { const f32x2 lo = __builtin_amdgcn_cvt_pk_f32_fp8((int)ww[i], false), hi = __builtin_amdgcn_cvt_pk_f32_fp8((int)ww[i], true);
        f[4 * i] = lo[0]; f[4 * i + 1] = lo[1]; f[4 * i + 2] = hi[0]; f[4 * i + 3] = hi[1]; }
}
__device__ __forceinline__ void peer_sort_experts(int& e0, int& e1, float& g0, float& g1, int lane) {
    int k0 = e0 * 128 + lane, k1 = e1 * 128 + 64 + lane;
#pragma unroll
    for (int k = 2; k <= 128; k <<= 1)
#pragma unroll
        for (int j = k >> 1; j > 0; j >>= 1) {
            if (j == 64) { const int lo = min(k0, k1), hi = max(k0, k1); k0 = lo; k1 = hi; }
            else { const int p0 = __shfl_xor(k0, j), p1 = __shfl_xor(k1, j); const bool lower = (lane & j) == 0;
                const bool asc0 = (lane & k) == 0, asc1 = ((64 + lane) & k) == 0;
                k0 = (lower == asc0) ? min(k0, p0) : max(k0, p0); k1 = (lower == asc1) ? min(k1, p1) : max(k1, p1); }
        }
    const int s0 = k0 & 127, s1 = k1 & 127;
    const float a0 = __shfl(g0, s0 & 63), b0 = __shfl(g1, s0 & 63), a1 = __shfl(g0, s1 & 63), b1 = __shfl(g1, s1 & 63);
    g0 = (s0 < 64) ? a0 : b0; g1 = (s1 < 64) ? a1 : b1; e0 = k0 >> 7; e1 = k1 >> 7;
}
__device__ __forceinline__ void peer_gather_phase(Frame& F) {
    const int gw = F.vcu * NWAVES + F.wave, NGW = F.G * NWAVES, lane = F.lane;
    const bf16* H1 = (const bf16*)(F.ws + WS_H); const unsigned char* PD = F.ws + WS_PD; const unsigned char* PU = F.ws + WS_PU;
    const int* EIDX = (const int*)(F.ws + WS_EIDX); const float* EGATE = (const float*)(F.ws + WS_EGATE);
    const int rep = ((lane >> 5) & 1) * 4 + ((lane >> 4) & 1) * 2 + ((lane >> 3) & 1);
    for (int pr = gw; pr < M / 2; pr += NGW) {
        __syncthreads();
        const size_t tokA = (size_t)pr * 2, tokB = tokA + 1;
        float xA[16], xB[16];
        { float a[8], c[8]; unpack8(*(const GAS v4u*)(H1 + tokA * D + lane * 16), a); unpack8(*(const GAS v4u*)(H1 + tokA * D + lane * 16 + 8), c);
#pragma unroll
          for (int j = 0; j < 8; ++j) { xA[j] = a[j]; xA[8 + j] = c[j]; }
          unpack8(*(const GAS v4u*)(H1 + tokB * D + lane * 16), a); unpack8(*(const GAS v4u*)(H1 + tokB * D + lane * 16 + 8), c);
#pragma unroll
          for (int j = 0; j < 8; ++j) { xB[j] = a[j]; xB[8 + j] = c[j]; } }
        int eA0 = EIDX[tokA * 128 + lane], eA1 = EIDX[tokA * 128 + 64 + lane], eB0 = EIDX[tokB * 128 + lane], eB1 = EIDX[tokB * 128 + 64 + lane];
        float gA0 = EGATE[tokA * 128 + lane], gA1 = EGATE[tokA * 128 + 64 + lane], gB0 = EGATE[tokB * 128 + lane], gB1 = EGATE[tokB * 128 + 64 + lane];
        peer_sort_experts(eA0, eA1, gA0, gA1, lane); peer_sort_experts(eB0, eB1, gB0, gB1, lane);
        float oA[16], oB[16];
#pragma unroll
        for (int j = 0; j < 16; ++j) { oA[j] = 0.f; oB[j] = 0.f; }
#define GATHER_BATCH(E0, E1, G0, G1, X, O) do { const int ev = (bt < 8) ? E0 : E1; const float gv = (bt < 8) ? G0 : G1; const int lb8 = (bt & 7) * 8; v4u dw[8], uw[8]; \
            _Pragma("unroll") for (int i = 0; i < 8; ++i) { const int e = __builtin_amdgcn_readlane(ev, lb8 + i); dw[i] = *(const GAS v4u*)(PD + (size_t)e * D + lane * 16); uw[i] = *(const GAS v4u*)(PU + (size_t)e * D + lane * 16); } \
            float p[8]; \
            _Pragma("unroll") for (int i = 0; i < 8; ++i) { float a[16]; unpack_fp8x16(dw[i], a); float sacc = 0.f; _Pragma("unroll") for (int j = 0; j < 16; ++j) sacc += a[j] * X[j]; p[i] = sacc; } \
            _Pragma("unroll") for (int i = 0; i < 4; ++i) { const float keep = (lane & 32) ? p[i + 4] : p[i], send = (lane & 32) ? p[i] : p[i + 4]; p[i] = keep + __shfl_xor(send, 32); } \
            _Pragma("unroll") for (int i = 0; i < 2; ++i) { const float keep = (lane & 16) ? p[i + 2] : p[i], send = (lane & 16) ? p[i] : p[i + 2]; p[i] = keep + __shfl_xor(send, 16); } \
            { const float keep = (lane & 8) ? p[1] : p[0], send = (lane & 8) ? p[0] : p[1]; p[0] = keep + __shfl_xor(send, 8); } \
            p[0] += __shfl_xor(p[0], 4); p[0] += __shfl_xor(p[0], 2); p[0] += __shfl_xor(p[0], 1); \
            const float gate = __shfl(gv, lb8 + rep); const float act = gelu_tanh(p[0] * (1.f / PD_SCALE)) * gate * (1.f / PU_SCALE); \
            _Pragma("unroll") for (int i = 0; i < 8; ++i) { const float af = __builtin_bit_cast(float, __builtin_amdgcn_readlane(__builtin_bit_cast(int, act), ((i >> 2) & 1) * 32 + ((i >> 1) & 1) * 16 + (i & 1) * 8)); \
                float a[16]; unpack_fp8x16(uw[i], a); _Pragma("unroll") for (int j = 0; j < 16; ++j) O[j] += af * a[j]; } } while (0)
#pragma unroll 1
        for (int bt = 0; bt < 16; ++bt) { if ((bt & 3) == 0) __syncthreads(); GATHER_BATCH(eA0, eA1, gA0, gA1, xA, oA); GATHER_BATCH(eB0, eB1, gB0, gB1, xB, oB); }
#undef GATHER_BATCH
        const float* g = F.in[I_LN2G] + lane * 16; const float* bsh = F.in[I_LN2B] + lane * 16;
#pragma unroll
        for (int t = 0; t < 2; ++t) {
            float o[16]; float s = 0.f;
#pragma unroll
            for (int j = 0; j < 16; ++j) { o[j] = (t ? oB[j] : oA[j]) + DN_ALPHA * (t ? xB[j] : xA[j]); s += o[j]; }
            const float mean = wave_sum(s) * (1.f / D); float s2 = 0.f;
#pragma unroll
            for (int j = 0; j < 16; ++j) { o[j] -= mean; s2 += o[j] * o[j]; }
            const float rstd = 1.f / sqrtf(wave_sum(s2) * (1.f / D) + LN_EPS);
            float* orow = F.out + (tokA + t) * D + lane * 16;
#pragma unroll
            for (int q = 0; q < 4; ++q) { const f32x4 ga = *(const GAS f32x4*)(g + 4 * q), ba = *(const GAS f32x4*)(bsh + 4 * q);
                f32x4 y; y.x = o[4 * q + 0] * rstd * ga.x + ba.x; y.y = o[4 * q + 1] * rstd * ga.y + ba.y; y.z = o[4 * q + 2] * rstd * ga.z + ba.z; y.w = o[4 * q + 3] * rstd * ga.w + ba.w;
                *(GAS f32x4*)(orow + 4 * q) = y; }
        }
    }
}

struct Args { const float* in[26]; float* out; unsigned char* ws; int ph_lo, ph_hi, li, pad; };
__global__ void __launch_bounds__(NWAVES * 64, 2) fwd_kernel(Args args) {
    extern __shared__ __attribute__((aligned(16))) unsigned char lds[];
    Frame F;
    F.lds = (LAS unsigned char*)lds;
    F.MISC = (volatile LAS unsigned*)(F.lds + MISC_OFF);
    F.tid = threadIdx.x; F.lane = F.tid & 63; F.wave = __builtin_amdgcn_readfirstlane(F.tid >> 6);
    F.G = gridDim.x; { const int bx = blockIdx.x; F.vcu = (F.G % 8 == 0) ? (bx % 8) * (F.G / 8) + bx / 8 : bx; }
#pragma unroll
    for (int i = 0; i < 26; ++i) F.in[i] = args.in[i];
    F.out = args.out; F.ws = args.ws;
    unsigned char* ws = args.ws;
    F.ctl = (gu32*)(ws + WS_CTL);
    for (int u = F.tid; u < (LDS_BYTES - LDSCTL_OFF) / 4; u += NWAVES * 64) ((LAS unsigned*)(F.lds + LDSCTL_OFF))[u] = 0u;
    __syncthreads();
    XcdBarrier bar; bar.bar = (unsigned*)(F.ctl + CW_BAR); bar.x = 0; bar.st = nullptr;
    if (N_LAUNCHES == 1) bar = xcd_barrier_post((unsigned*)(F.ctl + CW_BAR), F.MISC + 8);
#define GRID_BAR() do { if (N_LAUNCHES == 1) xcd_barrier(bar); } while (0)
    const int lo = args.ph_lo, hi = args.ph_hi;
#define IN(k) (lo <= (k) && (k) < hi)
#define BOTH(k) (IN(k) && IN((k) + 1))
    bf16* const Hb = (bf16*)(ws + WS_H);
    bf16* const PRJ = (bf16*)(ws + WS_PROJ);

    if (IN(0)) { p0_prologue(F); if (BOTH(0)) GRID_BAR(); }

    if (IN(1)) {
        s5_tables_stage1(F);
        pg8::Gemm g{Hb, (const bf16*)(ws + WS_WIN), M, NPROJ, D, D, D}; pg8::StaticOrder S; S.init(M, NPROJ, F.G, (int)blockIdx.x);
        pg8::EpiProj E{PRJ, PRJ + (size_t)M * 512, PRJ + (size_t)2 * M * 512, PRJ + (size_t)3 * M * 512, (bf16*)(ws + WS_A5), (const float*)(ws + WS_LB), M};
        pg8::gemm_phase<pg8::EpiProj, pg8::StaticOrder, true, true>(F.lds + RING_OFF, g, S, E);
        if (BOTH(1)) GRID_BAR();
    }

    if (IN(2)) {
        s5_tables_stage2(F);
        if (F.vcu < 128) hgrn2_state_pass(F, F.vcu);
        else { pg8::Gemm g{(const bf16*)(ws + WS_A5), (const bf16*)(ws + WS_G5), 32 * S5I, 32 * 256, 512, S5K, 512}; pg8::GroupedOrder S{4, 1, F.G - 128, F.vcu - 128};
            pg8::EpiS5A E{(float*)(ws + WS_XLOC)};
            pg8::gemm_phase<pg8::EpiS5A, pg8::GroupedOrder, true, true>(F.lds + RING_OFF, g, S, E);
            { const int gt = ((F.vcu - 128) * NWAVES + F.wave) * 64 + F.lane, NGT = (F.G - 128) * NWAVES * 64;
          constexpr int NTAB16 = PE * D / 16;
          for (int i = gt; i < 2 * NTAB16; i += NGT) { const bool up = i >= NTAB16; const int j = up ? i - NTAB16 : i; const float* src = (up ? F.in[I_PU] : F.in[I_PD]) + (size_t)j * 16; const float sc = up ? PU_SCALE : PD_SCALE;
              v4u o; unsigned ow[4];
#pragma unroll
              for (int q = 0; q < 4; ++q) { const f32x4 a = *(const GAS f32x4*)(src + 4 * q); int pk = __builtin_amdgcn_cvt_pk_fp8_f32(a.x * sc, a.y * sc, 0, false); pk = __builtin_amdgcn_cvt_pk_fp8_f32(a.z * sc, a.w * sc, pk, true); ow[q] = (unsigned)pk; }
              o.x = ow[0]; o.y = ow[1]; o.z = ow[2]; o.w = ow[3];
              *(GAS v4u*)(ws + (up ? WS_PU : WS_PD) + (size_t)j * 16) = o; }
        }
        }
        if (BOTH(2)) GRID_BAR();
    }

    if (IN(3)) {
        if (F.vcu < 32) s5_scan(F, F.vcu * 512 + F.tid);
        for (int it = F.vcu; it < 32 * 64; it += F.G) { hgrn2_out_item(F, it); __syncthreads(); }
        if (BOTH(3)) GRID_BAR();
    }

    if (IN(4)) {
        pg8::Gemm g{(const bf16*)(ws + WS_A5), (const bf16*)(ws + WS_T5), 32 * S5I, 32 * 512, S5K, S5K, S5K}; pg8::GroupedOrder S{4, 2, F.G, F.vcu};
        pg8::EpiS5C E{(bf16*)(ws + WS_Z)};
        pg8::gemm_phase<pg8::EpiS5C, pg8::GroupedOrder, true, true>(F.lds + RING_OFF, g, S, E);
        if (BOTH(4)) GRID_BAR();
    }

    if (IN(5)) {
        pg8::Gemm g{(const bf16*)(ws + WS_Z), (const bf16*)(ws + WS_WGLU), M, 512, 512, 512, 512}; pg8::StaticOrder S; S.init(M, 512, F.G, (int)blockIdx.x);
        pg8::EpiGlu E{(const bf16*)(ws + WS_Z), (bf16*)(ws + WS_MIX), F.in[I_BGLU]};
        pg8::gemm_phase<pg8::EpiGlu, pg8::StaticOrder, true, true>(F.lds + RING_OFF, g, S, E);
        if (BOTH(5)) GRID_BAR();
    }

    if (IN(6)) {
        pg8::Gemm g{(const bf16*)(ws + WS_MIX), (const bf16*)(ws + WS_WOUT), M, D, D, D, D}; pg8::StaticOrder S; S.init(M, D, F.G, (int)blockIdx.x);
        pg8::EpiOut E{Hb, DN_ALPHA};
        pg8::gemm_phase<pg8::EpiOut, pg8::StaticOrder, true, true>(F.lds + RING_OFF, g, S, E);
        if (BOTH(6)) GRID_BAR();
    }

    if (IN(7)) {
        const int gw = F.vcu * NWAVES + F.wave, NGW = F.G * NWAVES;
        for (int m = gw; m < M; m += NGW) ln1_row(Hb + (size_t)m * D, F.in[I_LN1G], F.in[I_LN1B], F.lane);
        if (BOTH(7)) GRID_BAR();
    }

    if (IN(8)) {
        pg8::Gemm g{Hb, (const bf16*)(ws + WS_WQ), M, NQ2, D, D, D}; pg8::StaticOrder S; S.init(M, NQ2, F.G, (int)blockIdx.x);
        pg8::EpiStore E{(bf16*)(ws + WS_Q2), NQ2};
        pg8::gemm_phase<pg8::EpiStore, pg8::StaticOrder, true, true>(F.lds + RING_OFF, g, S, E);
        if (BOTH(8)) GRID_BAR();
    }

    if (IN(9)) { peer_score_phase(F); if (BOTH(9)) GRID_BAR(); }

    if (IN(10)) { peer_gather_phase(F); }
#undef IN
#undef BOTH
}

extern "C" void kernel_launch(void* const* d_in, const int* in_sizes, int n_in, void* d_out, int out_size, void* d_ws, size_t ws_size, hipStream_t stream) {
    static int grid = 0;
    if (grid == 0) {
        if (n_in != 26 || in_sizes[0] != M * D || out_size != M * D || ws_size < WS_END) { fprintf(stderr, "kernel_launch: unexpected shapes: n_in %d in0 %d out %d ws %zu (need %zu)\n", n_in, n_in > 0 ? in_sizes[0] : -1, out_size, ws_size, (size_t)WS_END); grid = -1; return; }
        int dev = 0, cus = 0;
        if (hipGetDevice(&dev) != hipSuccess || hipDeviceGetAttribute(&cus, hipDeviceAttributeMultiprocessorCount, dev) != hipSuccess) { grid = -1; return; }
        if (hipFuncSetAttribute((const void*)fwd_kernel, hipFuncAttributeMaxDynamicSharedMemorySize, LDS_BYTES) != hipSuccess) { fprintf(stderr, "kernel_launch: hipFuncSetAttribute failed\n"); grid = -1; return; }
        (void)hipGetLastError();
        grid = cus;
    }
    if (grid < 0) return;
    if (hipMemsetAsync((char*)d_ws + WS_CTL, 0, CTL_ZERO_BYTES, stream) != hipSuccess) return;
    Args a{};
    for (int i = 0; i < 26; ++i) a.in[i] = (const float*)d_in[i];
    a.out = (float*)d_out; a.ws = (unsigned char*)d_ws;
    if (N_LAUNCHES == 1) { a.ph_lo = 0; a.ph_hi = NPH; a.li = 0; hipLaunchKernelGGL(fwd_kernel, dim3(grid), dim3(NWAVES * 64), LDS_BYTES, stream, a); }
    else for (int li = 0; li < NPH; ++li) { a.ph_lo = li; a.ph_hi = li + 1; a.li = li; hipLaunchKernelGGL(fwd_kernel, dim3(grid), dim3(NWAVES * 64), LDS_BYTES, stream, a); }
}
```

```cpp
#include <hip/hip_runtime.h>
#include <cstdio>
#include <cstdint>
namespace pg8 {
#define PG8_LAS __attribute__((address_space(3)))
typedef unsigned short bf16_t;
typedef short bf16x8 __attribute__((ext_vector_type(8)));
typedef float f32x4 __attribute__((ext_vector_type(4)));
typedef unsigned u32x4 __attribute__((ext_vector_type(4)));
constexpr int BM = 256, BK = 64, HALF = 128, HTB = HALF * BK * 2  , STAGE_BYTES = 8 * HTB, NXCD = 8, WGM = 8;

__host__ __device__ __forceinline__ int lds_byte(int r, int c) { const int st = (r >> 4) * 2 + (c >> 5), rr = r & 15, cc = c & 31, ob = rr * 64 + cc * 2; return st * 1024 + (ob ^ (((ob >> 9) & 1) << 5)); }
__host__ __device__ __forceinline__ void stage_rc(int b, int& R, int& C) { const int st = b / 1024, sb = b % 1024, swz = sb ^ (((sb >> 9) & 1) << 5); R = (st >> 1) * 16 + swz / 64; C = (st & 1) * 32 + (swz % 64) / 2; }
__host__ __device__ __forceinline__ int perm32(int rho) { const int n = rho >> 4, i = rho & 15; return 8 * (i >> 2) + 4 * n + (i & 3); }

struct Unit { int pm, pn; };
struct Gemm { const bf16_t* A; const bf16_t* Bt; int M, N, K, lda, ldb; };

struct StaticOrder {
    int nM, nN, nwg, G, c;
    __host__ __device__ void init(int M, int N, int G_, int c_) { nM = M / BM; nN = N / BM; nwg = nM * nN; G = G_; c = c_; }
    __host__ __device__ bool next(int i, Unit& u) const {
        const long L = (long)i * G + c; if (L >= nwg) return false;
        int wgid = (int)L; { const int q = nwg / NXCD, r = nwg % NXCD, xcd = wgid % NXCD, off = wgid / NXCD; wgid = (xcd < r ? xcd * (q + 1) : r * (q + 1) + (xcd - r) * q) + off; }
        const int nig = WGM * nN, gid = wgid / nig, fm = gid * WGM, gsz = (nM - fm) < WGM ? (nM - fm) : WGM;
        u.pm = fm + ((wgid % nig) % gsz); u.pn = (wgid % nig) / gsz; return true;
    }
    __device__ __forceinline__ void a_ready(const Unit&) const {}
    __device__ __forceinline__ void done(const Unit&) const {}
};

__device__ __forceinline__ unsigned cvt_pk_bf16(float lo, float hi) { unsigned r; asm volatile("v_cvt_pk_bf16_f32 %0, %1, %2" : "=v"(r) : "v"(lo), "v"(hi)); return r; }
__device__ __forceinline__ void unpack8(const u32x4 w, float (&f)[8]) {
    f[0] = __builtin_bit_cast(float, w.x << 16); f[1] = __builtin_bit_cast(float, w.x & 0xffff0000u);
    f[2] = __builtin_bit_cast(float, w.y << 16); f[3] = __builtin_bit_cast(float, w.y & 0xffff0000u);
    f[4] = __builtin_bit_cast(float, w.z << 16); f[5] = __builtin_bit_cast(float, w.z & 0xffff0000u);
    f[6] = __builtin_bit_cast(float, w.w << 16); f[7] = __builtin_bit_cast(float, w.w & 0xffff0000u);
}
__device__ __forceinline__ u32x4 pack8(const float (&f)[8]) { u32x4 w; w.x = cvt_pk_bf16(f[0], f[1]); w.y = cvt_pk_bf16(f[2], f[3]); w.z = cvt_pk_bf16(f[4], f[5]); w.w = cvt_pk_bf16(f[6], f[7]); return w; }

struct EpiStore {
    static constexpr bool PERM = true, AFTER_DRAIN = false;
    bf16_t* O; int ldc;
    __device__ __forceinline__ void operator()(const f32x4 (&acc)[2][2][4][2], const Unit& u, int wr, int wc, int fr, int fq) const {
        const int row0 = u.pm * BM + wr * 64 + fr, col0 = u.pn * BM + wc * 32 + 8 * fq;
#pragma unroll
        for (int ai = 0; ai < 2; ++ai)
#pragma unroll
            for (int m = 0; m < 4; ++m) { bf16_t* rowp = O + (size_t)(row0 + ai * HALF + m * 16) * ldc + col0;
#pragma unroll
                for (int bj = 0; bj < 2; ++bj) { const f32x4 v0 = acc[ai][bj][m][0], v1 = acc[ai][bj][m][1];
                    u32x4 w; w.x = cvt_pk_bf16(v0[0], v0[1]); w.y = cvt_pk_bf16(v0[2], v0[3]); w.z = cvt_pk_bf16(v1[0], v1[1]); w.w = cvt_pk_bf16(v1[2], v1[3]);
                    *(u32x4*)(rowp + bj * HALF) = w; } }
    }
};

struct EpiProj {
    static constexpr bool PERM = true, AFTER_DRAIN = false;
    bf16_t* Qb; bf16_t* LFb; bf16_t* Vb; bf16_t* Gb; bf16_t* Ub; const float* lb; int M;
    __device__ __forceinline__ void operator()(const f32x4 (&acc)[2][2][4][2], const Unit& u, int wr, int wc, int fr, int fq) const {
        const int row0 = u.pm * BM + wr * 64 + fr; const int colt = u.pn * BM; const int t = colt >> 9;
        const int cb = (colt & 511) + wc * 32 + 8 * fq;
        float lbv[2][8];
        if (t == 1) {
#pragma unroll
            for (int bj = 0; bj < 2; ++bj) { const f32x4 a = *(const f32x4*)(lb + cb + bj * HALF), b = *(const f32x4*)(lb + cb + bj * HALF + 4);
                lbv[bj][0] = a[0]; lbv[bj][1] = a[1]; lbv[bj][2] = a[2]; lbv[bj][3] = a[3]; lbv[bj][4] = b[0]; lbv[bj][5] = b[1]; lbv[bj][6] = b[2]; lbv[bj][7] = b[3]; }
        }
#pragma unroll
        for (int ai = 0; ai < 2; ++ai)
#pragma unroll
            for (int m = 0; m < 4; ++m) { const int row = row0 + ai * HALF + m * 16;
#pragma unroll
                for (int bj = 0; bj < 2; ++bj) { const f32x4 v0 = acc[ai][bj][m][0], v1 = acc[ai][bj][m][1]; const int c = cb + bj * HALF;
                    float f[8] = {v0[0], v0[1], v0[2], v0[3], v1[0], v1[1], v1[2], v1[3]};
                    if (t == 0) {
#pragma unroll
                        for (int j = 0; j < 8; ++j) f[j] *= 0.08838834764831845f;
                        *(u32x4*)(Qb + (size_t)row * 512 + c) = pack8(f);
                    } else if (t == 1) {
#pragma unroll
                        for (int j = 0; j < 8; ++j) { const float l = lbv[bj][j]; const float sg = 1.f / (1.f + __expf(-f[j])); f[j] = __logf(l + (1.f - l) * sg); }
                        *(u32x4*)(LFb + (size_t)row * 512 + c) = pack8(f);
                    } else if (t == 2) { *(u32x4*)(Vb + (size_t)row * 512 + c) = pack8(f);
                    } else if (t == 3) { *(u32x4*)(Gb + (size_t)row * 512 + c) = pack8(f);
                    } else { *(u32x4*)(Ub + ((size_t)(c >> 4) * (M / 32) + (row >> 5)) * 640 + (row & 31) * 16 + (c & 15)) = pack8(f); }
                } }
    }
};

struct EpiGlu {
    static constexpr bool PERM = true, AFTER_DRAIN = false;
    const bf16_t* Z; bf16_t* MIX; const float* bglu;
    __device__ __forceinline__ void operator()(const f32x4 (&acc)[2][2][4][2], const Unit& u, int wr, int wc, int fr, int fq) const {
        const int row0 = u.pm * BM + wr * 64 + fr, col0 = u.pn * BM + wc * 32 + 8 * fq;
#pragma unroll
        for (int bj = 0; bj < 2; ++bj) { const int c = col0 + bj * HALF;
            const f32x4 b0 = *(const f32x4*)(bglu + c), b1 = *(const f32x4*)(bglu + c + 4);
#pragma unroll
            for (int ai = 0; ai < 2; ++ai)
#pragma unroll
                for (int m = 0; m < 4; ++m) { const int row = row0 + ai * HALF + m * 16;
                    const f32x4 v0 = acc[ai][bj][m][0] + b0, v1 = acc[ai][bj][m][1] + b1;
                    float z[8]; unpack8(*(const u32x4*)(Z + (size_t)row * 512 + c), z);
                    float f[8] = {v0[0], v0[1], v0[2], v0[3], v1[0], v1[1], v1[2], v1[3]};
#pragma unroll
                    for (int j = 0; j < 8; ++j) f[j] = z[j] / (1.f + __expf(-f[j]));
                    *(u32x4*)(MIX + (size_t)row * 1024 + 512 + c) = pack8(f); } }
    }
};

struct EpiOut {
    static constexpr bool PERM = true, AFTER_DRAIN = false;
    bf16_t* H; float alpha;
    __device__ __forceinline__ void operator()(const f32x4 (&acc)[2][2][4][2], const Unit& u, int wr, int wc, int fr, int fq) const {
        const int row0 = u.pm * BM + wr * 64 + fr, col0 = u.pn * BM + wc * 32 + 8 * fq;
#pragma unroll
        for (int ai = 0; ai < 2; ++ai)
#pragma unroll
            for (int m = 0; m < 4; ++m) { bf16_t* rowp = H + (size_t)(row0 + ai * HALF + m * 16) * 1024 + col0;
#pragma unroll
                for (int bj = 0; bj < 2; ++bj) { const f32x4 v0 = acc[ai][bj][m][0], v1 = acc[ai][bj][m][1];
                    float h[8]; unpack8(*(const u32x4*)(rowp + bj * HALF), h);
                    float f[8] = {v0[0], v0[1], v0[2], v0[3], v1[0], v1[1], v1[2], v1[3]};
#pragma unroll
                    for (int j = 0; j < 8; ++j) f[j] = alpha * h[j] + f[j];
                    *(u32x4*)(rowp + bj * HALF) = pack8(f); } }
    }
};

struct GroupedOrder {
    int tm, tn, G, c;
    __device__ bool next(int i, Unit& u) const { const int L = i * G + c, per = tm * tn; if (c < 0 || L >= 32 * per) return false;
        const int g = L / per, r = L % per; u.pm = g * tm + r % tm; u.pn = g * tn + r / tm; return true; }
    __device__ __forceinline__ void a_ready(const Unit&) const {}
    __device__ __forceinline__ void done(const Unit&) const {}
};
struct EpiS5A {
    static constexpr bool PERM = true, AFTER_DRAIN = false;
    float* X;
    __device__ __forceinline__ void operator()(const f32x4 (&acc)[2][2][4][2], const Unit& u, int wr, int wc, int fr, int fq) const {
        const int g = u.pn, inst0 = (u.pm & 3) * BM + wr * 64 + fr, col = wc * 32 + 8 * fq;
#pragma unroll
        for (int ai = 0; ai < 2; ++ai)
#pragma unroll
            for (int m = 0; m < 4; ++m) { float* p = X + ((size_t)(inst0 + ai * HALF + m * 16) * 32 + g) * 128 + col;
                *(f32x4*)p = acc[ai][0][m][0]; *(f32x4*)(p + 4) = acc[ai][0][m][1]; }
    }
};
struct EpiS5C {
    static constexpr bool PERM = true, AFTER_DRAIN = false;
    bf16_t* Z;
    __device__ __forceinline__ void operator()(const f32x4 (&acc)[2][2][4][2], const Unit& u, int wr, int wc, int fr, int fq) const {
        const int g = u.pm >> 2, inst0 = (u.pm & 3) * BM + wr * 64 + fr, col0 = (u.pn & 1) * BM + wc * 32 + 8 * fq;
#pragma unroll
        for (int ai = 0; ai < 2; ++ai)
#pragma unroll
            for (int m = 0; m < 4; ++m) { const int inst = inst0 + ai * HALF + m * 16; const size_t tok0 = (size_t)(inst >> 7) * 4096 + (size_t)(inst & 127) * 32;
#pragma unroll
                for (int bj = 0; bj < 2; ++bj) { const int col = col0 + bj * HALF; const f32x4 v0 = acc[ai][bj][m][0], v1 = acc[ai][bj][m][1];
                    float f[8] = {v0[0], v0[1], v0[2], v0[3], v1[0], v1[1], v1[2], v1[3]};
#pragma unroll
                    for (int j = 0; j < 8; ++j) { const float x = f[j], y = 0.7978845608028654f * (x + 0.044715f * x * x * x); f[j] = x / (1.f + __expf(-2.f * y)); }
                    *(u32x4*)(Z + (tok0 + (col >> 4)) * 512 + g * 16 + (col & 15)) = pack8(f); } }
    }
};

template <class Epi, class Sched, bool ALIGN_EPI = false, bool SP2 = false>
__device__ __forceinline__ void gemm_phase(PG8_LAS unsigned char* lds, const Gemm g, const Sched& S, const Epi& E) {
    const int tid = threadIdx.x, wid = __builtin_amdgcn_readfirstlane(tid >> 6), lane = tid & 63, wr = wid >> 2, wc = wid & 3, fr = lane & 15, fq = lane >> 4;
    const int K = g.K, nt = K / BK;
    unsigned voffA[2], voffB[2];
#pragma unroll
    for (int i = 0; i < 2; ++i) { int R, C; stage_rc(tid * 16 + i * 8192, R, C); const int Rb = Epi::PERM ? ((R & ~31) + perm32(R & 31)) : R;
        voffA[i] = (unsigned)(R * g.lda + C) * 2u; voffB[i] = (unsigned)(Rb * g.ldb + C) * 2u; }
    const size_t kstep = (size_t)(BK * 2);
    const size_t hstepA = (size_t)HALF * g.lda * 2, hstepB = (size_t)HALF * g.ldb * 2;
    const size_t tstepA = 2 * hstepA, tstepB = 2 * hstepB;
    const unsigned ldsw = (unsigned)wid * 1024u;
    const int aoff = lds_byte(wr * 64 + fr, fq * 8), boff = lds_byte(wc * 32 + fr, fq * 8);
#define PG8_SA(b, h) (((b) * 2 + (h)) * HTB)
#define PG8_SB(b, h) ((4 + (b) * 2 + (h)) * HTB)
#define PG8_STAGE(bufoff, gbase, voff) do { _Pragma("unroll") for (int _i = 0; _i < 2; ++_i) \
        __builtin_amdgcn_global_load_lds((const unsigned*)((const char*)(gbase) + (voff)[_i]), (PG8_LAS unsigned*)(lds + (bufoff) + ldsw + _i * 8192), 16, 0, 0); } while (0)
#define PG8_LDA(dst, b, h) do { _Pragma("unroll") for (int m = 0; m < 4; ++m) _Pragma("unroll") for (int k = 0; k < 2; ++k) dst[m][k] = *(const PG8_LAS bf16x8*)(lds + PG8_SA(b, h) + aoff + m * 2048 + k * 1024); } while (0)
#define PG8_LDB(dst, b, h) do { _Pragma("unroll") for (int n = 0; n < 2; ++n) _Pragma("unroll") for (int k = 0; k < 2; ++k) dst[n][k] = *(const PG8_LAS bf16x8*)(lds + PG8_SB(b, h) + boff + n * 2048 + k * 1024); } while (0)
#define PG8_MMA(ai, bj, At, Bt) do { __builtin_amdgcn_s_setprio(1); _Pragma("unroll") for (int m = 0; m < 4; ++m) _Pragma("unroll") for (int n = 0; n < 2; ++n) _Pragma("unroll") for (int k = 0; k < 2; ++k) \
        acc[ai][bj][m][n] = __builtin_amdgcn_mfma_f32_16x16x32_bf16(Bt[n][k], At[m][k], acc[ai][bj][m][n], 0, 0, 0); __builtin_amdgcn_s_setprio(0); } while (0)
#define PG8_WAIT_V(n) asm volatile("s_waitcnt vmcnt(" #n ")" ::: "memory")
#define PG8_WAIT_L(n) asm volatile("s_waitcnt lgkmcnt(" #n ")" ::: "memory")
#define PG8_BAR __builtin_amdgcn_s_barrier()
#define PG8_SCHED __builtin_amdgcn_sched_barrier(0)
    Unit cur, nxt; int ui = 0;
    if (!S.next(0, cur)) return;
    f32x4 acc[2][2][4][2];
#pragma unroll
    for (int a = 0; a < 2; ++a)
#pragma unroll
        for (int b = 0; b < 2; ++b)
#pragma unroll
            for (int m = 0; m < 4; ++m)
#pragma unroll
                for (int n = 0; n < 2; ++n) acc[a][b][m][n] = (f32x4){0.f, 0.f, 0.f, 0.f};
    bf16x8 At[4][2], B0[2][2], B1[2][2];
    const char* cA = (const char*)g.A + (size_t)cur.pm * tstepA; const char* cB = (const char*)g.Bt + (size_t)cur.pn * tstepB;
    S.a_ready(cur);
    if constexpr (SP2) {
        PG8_STAGE(PG8_SB(0, 0), cB, voffB); PG8_STAGE(PG8_SB(0, 1), cB + hstepB, voffB); PG8_STAGE(PG8_SA(0, 0), cA, voffA); PG8_STAGE(PG8_SA(0, 1), cA + hstepA, voffA);
        if (wr == 1) PG8_BAR;
        PG8_WAIT_V(2); PG8_BAR;
        PG8_STAGE(PG8_SB(1, 0), cB + kstep, voffB); PG8_STAGE(PG8_SA(1, 0), cA + kstep, voffA); PG8_STAGE(PG8_SB(1, 1), cB + hstepB + kstep, voffB);
        PG8_WAIT_V(6); PG8_BAR;
    } else {
        PG8_STAGE(PG8_SB(0, 0), cB, voffB); PG8_STAGE(PG8_SA(0, 0), cA, voffA); PG8_STAGE(PG8_SB(0, 1), cB + hstepB, voffB); PG8_STAGE(PG8_SA(0, 1), cA + hstepA, voffA);
        if (wr == 1) PG8_BAR;
        PG8_WAIT_V(4); PG8_BAR;
        PG8_STAGE(PG8_SB(1, 0), cB + kstep, voffB); PG8_STAGE(PG8_SA(1, 0), cA + kstep, voffA); PG8_STAGE(PG8_SB(1, 1), cB + hstepB + kstep, voffB);
        PG8_WAIT_V(6); PG8_BAR;
    }
    for (;;) {
        const bool has_next = S.next(ui + 1, nxt);
        const char* nA = has_next ? (const char*)g.A + (size_t)nxt.pm * tstepA : cA; const char* nB = has_next ? (const char*)g.Bt + (size_t)nxt.pn * tstepB : cB;
        for (int t = 0; t < nt; t += 2) {
            const bool last = (t == nt - 2);
            const char* a1 = cA + (size_t)(t + 1) * kstep;
            const char* a2 = last ? nA : cA + (size_t)(t + 2) * kstep; const char* b2 = last ? nB : cB + (size_t)(t + 2) * kstep;
            const char* a3 = a2 + kstep; const char* b3 = b2 + kstep;
            if (last && has_next) S.a_ready(nxt);
            if constexpr (SP2) {
            PG8_LDB(B0, 0, 0); PG8_LDB(B1, 0, 1); PG8_SCHED; PG8_LDA(At, 0, 0); PG8_STAGE(PG8_SA(1, 1), a1 + hstepA, voffA);
            PG8_WAIT_V(8); PG8_WAIT_L(0); PG8_BAR; PG8_MMA(0, 0, At, B0); PG8_MMA(0, 1, At, B1); PG8_BAR; PG8_SCHED;
            PG8_LDA(At, 0, 1); PG8_STAGE(PG8_SB(0, 0), b2, voffB); PG8_STAGE(PG8_SB(0, 1), b2 + hstepB, voffB); PG8_STAGE(PG8_SA(0, 0), a2, voffA);
            PG8_WAIT_V(8); PG8_WAIT_L(0); PG8_BAR; PG8_MMA(1, 0, At, B0); PG8_MMA(1, 1, At, B1); PG8_BAR; PG8_SCHED;
            PG8_LDB(B0, 1, 0); PG8_LDB(B1, 1, 1); PG8_SCHED; PG8_LDA(At, 1, 0); PG8_STAGE(PG8_SA(0, 1), a2 + hstepA, voffA);
            PG8_WAIT_V(8); PG8_WAIT_L(0); PG8_BAR; PG8_MMA(0, 0, At, B0); PG8_MMA(0, 1, At, B1); PG8_BAR; PG8_SCHED;
            PG8_LDA(At, 1, 1); PG8_STAGE(PG8_SB(1, 0), b3, voffB); PG8_STAGE(PG8_SB(1, 1), b3 + hstepB, voffB); PG8_STAGE(PG8_SA(1, 0), a3, voffA);
            PG8_WAIT_V(8); PG8_WAIT_L(0); PG8_BAR; PG8_MMA(1, 0, At, B0); PG8_MMA(1, 1, At, B1); PG8_BAR; PG8_SCHED;
            } else {
            PG8_LDB(B0, 0, 0); PG8_SCHED; PG8_LDA(At, 0, 0); PG8_STAGE(PG8_SA(1, 1), a1 + hstepA, voffA);
            PG8_WAIT_L(8); PG8_BAR; PG8_WAIT_L(0); PG8_MMA(0, 0, At, B0); PG8_BAR; PG8_SCHED;
            PG8_LDB(B1, 0, 1); PG8_STAGE(PG8_SB(0, 0), b2, voffB);
            PG8_BAR; PG8_WAIT_L(0); PG8_MMA(0, 1, At, B1); PG8_BAR;
            PG8_LDA(At, 0, 1); PG8_STAGE(PG8_SA(0, 0), a2, voffA);
            PG8_BAR; PG8_WAIT_L(0); PG8_MMA(1, 0, At, B0); PG8_BAR; PG8_SCHED;
            PG8_STAGE(PG8_SB(0, 1), b2 + hstepB, voffB);
            PG8_WAIT_V(6); PG8_BAR; PG8_MMA(1, 1, At, B1); PG8_BAR;
            PG8_LDB(B0, 1, 0); PG8_SCHED; PG8_LDA(At, 1, 0); PG8_STAGE(PG8_SA(0, 1), a2 + hstepA, voffA);
            PG8_WAIT_L(8); PG8_BAR; PG8_WAIT_L(0); PG8_MMA(0, 0, At, B0); PG8_BAR; PG8_SCHED;
            PG8_LDB(B1, 1, 1); PG8_STAGE(PG8_SB(1, 0), b3, voffB);
            PG8_BAR; PG8_WAIT_L(0); PG8_MMA(0, 1, At, B1); PG8_BAR;
            PG8_LDA(At, 1, 1); PG8_STAGE(PG8_SA(1, 0), a3, voffA);
            PG8_BAR; PG8_WAIT_L(0); PG8_MMA(1, 0, At, B0); PG8_BAR; PG8_SCHED;
            PG8_STAGE(PG8_SB(1, 1), b3 + hstepB, voffB);
            PG8_WAIT_V(6); PG8_BAR; PG8_MMA(1, 1, At, B1); PG8_BAR;
            }
        }
        if constexpr (ALIGN_EPI) { if (wr == 0) PG8_BAR; }
        if constexpr (!Epi::AFTER_DRAIN) { E(acc, cur, wr, wc, fr, fq); S.done(cur); }
        if (!has_next) break;
#pragma unroll
        for (int a = 0; a < 2; ++a)
#pragma unroll
            for (int b = 0; b < 2; ++b)
#pragma unroll
                for (int m = 0; m < 4; ++m)
#pragma unroll
                    for (int n = 0; n < 2; ++n) acc[a][b][m][n] = (f32x4){0.f, 0.f, 0.f, 0.f};
        cur = nxt; cA = nA; cB = nB; ++ui;
        if constexpr (ALIGN_EPI) { if (wr == 1) PG8_BAR; }
    }
    PG8_WAIT_V(0);
    if constexpr (!ALIGN_EPI) { if (wr == 0) PG8_BAR; }
    PG8_BAR;
    if constexpr (Epi::AFTER_DRAIN) { E.fused(acc, cur, wr, wc, fr, fq, lds, wid, lane); S.done(cur); }
#undef PG8_SA
#undef PG8_SB
#undef PG8_STAGE
#undef PG8_LDA
#undef PG8_LDB
#undef PG8_MMA
#undef PG8_WAIT_V
#undef PG8_WAIT_L
#undef PG8_BAR
#undef PG8_SCHED
}
}

constexpr int NWAVES = 8;
#ifndef MK_N_LAUNCHES
#define MK_N_LAUNCHES 1
#endif
constexpr int N_LAUNCHES = MK_N_LAUNCHES;
constexpr int NPH = 10;
#ifndef PROBE_REP
#define PROBE_REP -1
#endif

constexpr int BATCH = 8, SEQ = 4096, D = 1024, M = BATCH * SEQ;
constexpr int HGW = 512, HGH = 4, HGK = 128;
constexpr int S5W = 512, S5G = 32, S5P = 16, S5N = 64;
constexpr int S5L = 32, S5I = M / S5L, S5K = S5L * S5P + 2 * S5N;
constexpr int NPROJ = 2560;
constexpr int PK = 128, PH = 8, PTOPK = 16, PQ = 256, PHALF = 128, PE = PK * PK, NQ2 = PH * PQ;
constexpr float LN_EPS = 1e-5f, RMS_EPS = 1e-6f;
constexpr float DN_ALPHA = 1.189207115002721f;

constexpr size_t MiB = 1u << 20;
constexpr size_t WS_CTL = 0, CTL_ZERO_BYTES = 1 * MiB;
constexpr size_t WS_WIN = 1 * MiB;
constexpr size_t WS_WGLU = 6 * MiB;
constexpr size_t WS_KEYS = 6 * MiB + 512 * 1024;
constexpr size_t WS_LB = 6 * MiB + 640 * 1024;
constexpr size_t WS_S5T = 6 * MiB + 704 * 1024;
constexpr size_t WS_WOUT = 7 * MiB + 512 * 1024;
constexpr size_t WS_WQ = 10 * MiB;
constexpr size_t WS_SST = 14 * MiB;
constexpr size_t WS_H = 78 * MiB;
constexpr size_t WS_PROJ = 142 * MiB;
constexpr size_t WS_Q2 = WS_PROJ;
constexpr size_t WS_A5 = 270 * MiB;
constexpr size_t WS_MIX = 310 * MiB;
constexpr size_t WS_PD = 452 * MiB, WS_PU = 468 * MiB;
constexpr size_t WS_Z = 374 * MiB;
constexpr size_t WS_EIDX = WS_Z, WS_EGATE = WS_Z + 16 * MiB;
constexpr size_t WS_T5 = 406 * MiB;
constexpr size_t WS_G5 = 426 * MiB;
constexpr size_t WS_XLOC = 434 * MiB;
constexpr size_t WS_KTAU = 450 * MiB;
constexpr size_t WS_PW = 451 * MiB;
constexpr size_t WS_END = 484 * MiB;
constexpr int CW_TMO = 0, CW_CODE = 1;
constexpr int CW_BAR = 4096;
constexpr int CW_CONV = 65536;

constexpr int RING_OFF = 0, RING_BYTES = 147456;
constexpr int LDSCTL_OFF = RING_BYTES, MISC_OFF = LDSCTL_OFF + 320;
constexpr int LDS_BYTES = 151552;
static_assert(MISC_OFF + 128 <= LDS_BYTES, "LDS map");

#define GAS __attribute__((address_space(1)))
#define LAS __attribute__((address_space(3)))
typedef unsigned short bf16;
typedef unsigned v4u __attribute__((ext_vector_type(4)));
typedef float f32x4 __attribute__((ext_vector_type(4)));
typedef short bf16x8 __attribute__((ext_vector_type(8)));
typedef GAS unsigned gu32;
typedef GAS unsigned long long gu64;
#define RLX_AGENT __ATOMIC_RELAXED, __HIP_MEMORY_SCOPE_AGENT
#define LDS_WAIT() asm volatile("s_waitcnt lgkmcnt(0)" ::: "memory")
#define VM_WAIT() asm volatile("s_waitcnt vmcnt(0)" ::: "memory")
__device__ __forceinline__ unsigned long long rt() { return __builtin_amdgcn_s_memrealtime(); }
__device__ __forceinline__ unsigned f2bf(float f) { unsigned u = __builtin_bit_cast(unsigned, f); return (u + 0x7fffu + ((u >> 16) & 1u)) >> 16; }
__device__ __forceinline__ unsigned pk2(float lo, float hi) { return f2bf(lo) | (f2bf(hi) << 16); }

#define XB_TMO      128
#define XB_XCNT(j)  (256  + 64 * (j))
#define XB_XSUB(j)  (1280 + 64 * (j))
#define XB_XGEN(j)  (2304 + 64 * (j))
#define XB_TOP      3328
#define XB_TOPGEN   3392
#define XCD_BAR_WORDS 3456
#define XB_SPIN_CAP (1u << 18)

__device__ __forceinline__ unsigned xb_ld(unsigned* p)              { return __hip_atomic_load(p, __ATOMIC_RELAXED, __HIP_MEMORY_SCOPE_AGENT); }
__device__ __forceinline__ unsigned xb_add(unsigned* p, unsigned v) { return __hip_atomic_fetch_add(p, v, __ATOMIC_RELAXED, __HIP_MEMORY_SCOPE_AGENT); }
__device__ __forceinline__ unsigned xb_xcc_id() { return (unsigned)__builtin_amdgcn_s_getreg((3 << 11) | 20) & 0xFu; }
#define XB_SPIN(cond, bar) do { unsigned _sp = 0; while (cond) { __builtin_amdgcn_s_sleep(1); \
    if ((++_sp & 255u) == 0u) { if (xb_ld(&(bar)[XB_TMO])) break; if (_sp > XB_SPIN_CAP) { atomicAdd(&(bar)[XB_TMO], 1u); break; } } } } while (0)

struct XcdBarrier {
    unsigned* bar; unsigned x;
    volatile LAS unsigned* st;
};

__device__ __forceinline__ XcdBarrier xcd_barrier_post(unsigned* bar, volatile LAS unsigned* st) {
    XcdBarrier b; b.bar = bar; b.x = xb_xcc_id(); b.st = st;
    if (threadIdx.x == 0) (void)xb_add(&bar[XB_XCNT(b.x)], 1u);
    return b;
}
__device__ __forceinline__ void xcd_barrier_complete(unsigned* bar, unsigned x, unsigned& nloc, unsigned& nx) {
    const unsigned G = gridDim.x * gridDim.y * gridDim.z;
    unsigned sum, cnt, mine, sp = 0u;
    for (;;) {
        sum = 0u; cnt = 0u; mine = 0u;
#pragma unroll
        for (unsigned j = 0; j < 16; ++j) { const unsigned c = xb_ld(&bar[XB_XCNT(j)]); sum += c; cnt += (c > 0u) ? 1u : 0u; mine = (j == x) ? c : mine; }
        if (sum == G) break;
        __builtin_amdgcn_s_sleep(1);
        if ((++sp & 255u) == 0u) { if (xb_ld(&bar[XB_TMO])) break; if (sp > XB_SPIN_CAP) { atomicAdd(&bar[XB_TMO], 1u); break; } }
    }
    nloc = mine > 0u ? mine : 1u; nx = cnt > 0u ? cnt : 1u;
}

__device__ __forceinline__ void xcd_barrier(const XcdBarrier& b) {
    asm volatile("s_waitcnt vmcnt(0)" ::: "memory");
    __syncthreads();
    if (threadIdx.x == 0) {
        unsigned* bar = b.bar;
        __builtin_amdgcn_s_waitcnt(0);
        unsigned nloc = b.st[0], nx = b.st[1];
        if (nloc == 0u) { xcd_barrier_complete(bar, b.x, nloc, nx); b.st[0] = nloc; b.st[1] = nx; }
        const unsigned old = xb_add(&bar[XB_XSUB(b.x)], 1u);
        const unsigned gen = old / nloc;
        if (old + 1u == (gen + 1u) * nloc) {
            __builtin_amdgcn_fence(__ATOMIC_RELEASE, "agent");
            asm volatile("s_waitcnt vmcnt(0)" ::: "memory");
            const unsigned og = xb_add(&bar[XB_TOP], 1u);
            const unsigned tg = og / nx;
            if (og + 1u == (tg + 1u) * nx) xb_add(&bar[XB_TOPGEN], 1u);
            else XB_SPIN(xb_ld(&bar[XB_TOPGEN]) == tg, bar);
            __builtin_amdgcn_fence(__ATOMIC_ACQUIRE, "agent");
            xb_add(&bar[XB_XGEN(b.x)], 1u);
            asm volatile("s_waitcnt vmcnt(0)" ::: "memory");
        } else {
            XB_SPIN(xb_ld(&bar[XB_XGEN(b.x)]) == gen, bar);
            __builtin_amdgcn_fence(__ATOMIC_ACQUIRE, "agent");
            asm volatile("s_waitcnt vmcnt(0)" ::: "memory");
        }
    }
    __syncthreads();
}

struct Frame {
    LAS unsigned char* lds;
    volatile LAS unsigned* MISC;
    gu32* ctl;
    int tid, lane, wave;
    int vcu, G;
    const float* in[26]; float* out; unsigned char* ws;
};
enum { I_X = 0, I_LN0G, I_LN0B, I_WIN, I_LBL, I_HGNG, I_ARE, I_AIM, I_LSTEP, I_BRE, I_BIM, I_CRE, I_CIM, I_DSK, I_WGLU, I_BGLU, I_WOUT, I_LN1G, I_LN1B, I_WQ, I_K1, I_K2, I_PD, I_PU, I_LN2G, I_LN2B };

__device__ __forceinline__ float bf2f(bf16 v) { return __builtin_bit_cast(float, (unsigned)v << 16); }
__device__ __forceinline__ float wave_sum(float v) {
#pragma unroll
    for (int o = 1; o < 64; o <<= 1) v += __shfl_xor(v, o);
    return v;
}
__device__ __forceinline__ float wave_max(float v) {
#pragma unroll
    for (int o = 1; o < 64; o <<= 1) v = fmaxf(v, __shfl_xor(v, o));
    return v;
}
__device__ __forceinline__ float gelu_tanh(float x) { const float y = 0.7978845608028654f * (x + 0.044715f * x * x * x); return x / (1.f + __expf(-2.f * y)); }
__device__ __forceinline__ float silu_f(float x) { return x / (1.f + __expf(-x)); }
__device__ __forceinline__ void unpack8(const v4u w, float (&f)[8]) {
    f[0] = __builtin_bit_cast(float, w.x << 16); f[1] = __builtin_bit_cast(float, w.x & 0xffff0000u);
    f[2] = __builtin_bit_cast(float, w.y << 16); f[3] = __builtin_bit_cast(float, w.y & 0xffff0000u);
    f[4] = __builtin_bit_cast(float, w.z << 16); f[5] = __builtin_bit_cast(float, w.z & 0xffff0000u);
    f[6] = __builtin_bit_cast(float, w.w << 16); f[7] = __builtin_bit_cast(float, w.w & 0xffff0000u);
}
__device__ __forceinline__ v4u pack8(const float (&f)[8]) { v4u w; w.x = pk2(f[0], f[1]); w.y = pk2(f[2], f[3]); w.z = pk2(f[4], f[5]); w.w = pk2(f[6], f[7]); return w; }

__device__ __forceinline__ void p0_transpose_item(const float* W, int K, int N, bf16* WT, int row_off, LAS float* scr, int item, int lane) {
    const int nblk = N / 32, kb = item / nblk, nb = item % nblk, k0 = 64 * kb, n0 = 32 * nb;
#pragma unroll 8
    for (int i = 0; i < 32; ++i) { const int kk = 2 * i + (lane >> 5); scr[kk * 33 + (lane & 31)] = W[(size_t)(k0 + kk) * N + n0 + (lane & 31)]; }
    LDS_WAIT(); asm volatile("" ::: "memory");
    const int c = lane & 7;
#pragma unroll
    for (int j = 0; j < 4; ++j) { const int n = (lane >> 3) + 8 * j; const LAS float* s = scr + (8 * c) * 33 + n;
        v4u o; o.x = pk2(s[0 * 33], s[1 * 33]); o.y = pk2(s[2 * 33], s[3 * 33]); o.z = pk2(s[4 * 33], s[5 * 33]); o.w = pk2(s[6 * 33], s[7 * 33]);
        *(GAS v4u*)(WT + (size_t)(row_off + n0 + n) * K + k0 + 8 * c) = o; }
    LDS_WAIT(); asm volatile("" ::: "memory");
}
__device__ __forceinline__ void ln0_row(const float* xrow, const float* g, const float* b, bf16* orow, int lane) {
    const GAS f32x4* xr = (const GAS f32x4*)xrow + lane;
    f32x4 v[4]; float s = 0.f;
#pragma unroll
    for (int j = 0; j < 4; ++j) { v[j] = xr[64 * j]; s += (v[j].x + v[j].y) + (v[j].z + v[j].w); }
    const float mean = wave_sum(s) * (1.f / D); float s2 = 0.f;
#pragma unroll
    for (int j = 0; j < 4; ++j) { v[j] = v[j] - mean; s2 += (v[j].x * v[j].x + v[j].y * v[j].y) + (v[j].z * v[j].z + v[j].w * v[j].w); }
    const float rstd = 1.f / sqrtf(wave_sum(s2) * (1.f / D) + LN_EPS);
    GAS unsigned long long* o8 = (GAS unsigned long long*)orow + lane;
#pragma unroll
    for (int j = 0; j < 4; ++j) { const f32x4 gg = ((const GAS f32x4*)g)[lane + 64 * j], bb = ((const GAS f32x4*)b)[lane + 64 * j];
        const f32x4 o = v[j] * rstd * gg + bb;
        o8[64 * j] = (unsigned long long)pk2(o.x, o.y) | ((unsigned long long)pk2(o.z, o.w) << 32); }
}
__device__ __forceinline__ void p0_prologue(Frame& F) {
    LAS float* scr = (LAS float*)(F.lds + RING_OFF + F.wave * 16384);
    const int gw = F.vcu * NWAVES + F.wave, NGW = F.G * NWAVES;
    unsigned char* ws = F.ws;
    constexpr int I_IN = (D / 64) * (NPROJ / 32), I_GLU = (512 / 64) * (512 / 32), I_OUT = (1024 / 64) * (1024 / 32), I_Q = (1024 / 64) * (2048 / 32);
    constexpr int NITEMS = I_IN + I_GLU + I_OUT + I_Q;
    for (int it = gw; it < NITEMS; it += NGW) {
        int r = it;
        if (r < I_IN) { p0_transpose_item(F.in[I_WIN], D, NPROJ, (bf16*)(ws + WS_WIN), 0, scr, r, F.lane); continue; } r -= I_IN;
        if (r < I_GLU) { p0_transpose_item(F.in[I_WGLU], 512, 512, (bf16*)(ws + WS_WGLU), 0, scr, r, F.lane); continue; } r -= I_GLU;
        if (r < I_OUT) { p0_transpose_item(F.in[I_WOUT], 1024, 1024, (bf16*)(ws + WS_WOUT), 0, scr, r, F.lane); continue; } r -= I_OUT;
        p0_transpose_item(F.in[I_WQ], 1024, 2048, (bf16*)(ws + WS_WQ), 0, scr, r, F.lane);
    }
    const int gt = gw * 64 + F.lane, NGT = NGW * 64;
    for (int i = gt; i < 2 * PK * PHALF; i += NGT) { const float v = (i < PK * PHALF) ? F.in[I_K1][i] : F.in[I_K2][i - PK * PHALF]; ((bf16*)(ws + WS_KEYS))[i] = (bf16)f2bf(v); }
    for (int i = gt; i < HGW; i += NGT) { const float l0 = F.in[I_LBL][i], l1 = F.in[I_LBL][HGW + i]; ((float*)(ws + WS_LB))[i] = 1.f / (1.f + expf(l1 - l0)); }
    for (int i = gt; i < S5G * S5N; i += NGT) { const int g = i / S5N;
        const float are = F.in[I_ARE][i], aim = F.in[I_AIM][i], step = expf(F.in[I_LSTEP][g]);
        const float zr = step * are, zi = step * aim, mag = expf(zr), cz = cosf(zi), sz = sinf(zi), sh = sinf(0.5f * zi);
        const float abr = mag * cz, abi = mag * sz;
        const float nre = expm1f(zr) * cz - 2.f * sh * sh, nim = abi;
        const float den = are * are + aim * aim;
        const float cre = (nre * are + nim * aim) / den, cim = (nim * are - nre * aim) / den;
        float* t = (float*)(ws + WS_S5T) + (size_t)i * 40; t[0] = abr; t[1] = abi;
        for (int p = 0; p < S5P; ++p) { const float br = F.in[I_BRE][(size_t)i * S5P + p], bi = F.in[I_BIM][(size_t)i * S5P + p];
            t[2 + p] = cre * br - cim * bi; t[18 + p] = cre * bi + cim * br; } }
    for (int i = gt; i < S5G * S5N * 33; i += NGT) { const int gn = i / 33, tau = i % 33, g = gn / S5N;
        const float step = expf(F.in[I_LSTEP][g]), zr = step * F.in[I_ARE][gn] * (float)tau, zi = step * F.in[I_AIM][gn] * (float)tau, mag = expf(zr);
        float* p = (float*)(ws + WS_PW) + (size_t)i * 2; p[0] = mag * cosf(zi); p[1] = mag * sinf(zi); }
    for (int m = gw; m < M; m += NGW) ln0_row(F.in[I_X] + (size_t)m * D, F.in[I_LN0G], F.in[I_LN0B], (bf16*)(ws + WS_H) + (size_t)m * D, F.lane);
}

__device__ __forceinline__ void hgrn2_seq(Frame& F, int bh) {
    const int b = bh >> 2, h = bh & 3, tid = F.tid, kq = tid >> 7, j = tid & 127;
    LAS float* sF = (LAS float*)(F.lds + RING_OFF);
    LAS float* sK = sF + 8 * 128; LAS float* sQ = sK + 8 * 128;
    LAS float* sO = sQ + 8 * 128;
    const bf16* Qb = (const bf16*)(F.ws + WS_PROJ); const bf16* LFb = Qb + (size_t)M * 512; const bf16* Vb = LFb + (size_t)M * 512; const bf16* Gb = Vb + (size_t)M * 512;
    bf16* MIX = (bf16*)(F.ws + WS_MIX);
    const float ng0 = F.in[I_HGNG][F.lane], ng1 = F.in[I_HGNG][F.lane + 64];
    float S[32];
#pragma unroll
    for (int k = 0; k < 32; ++k) S[k] = 0.f;
    for (int t0 = 0; t0 < SEQ; t0 += 8) {
        const size_t tok0 = (size_t)b * SEQ + t0;
#pragma unroll
        for (int r = 0; r < 2; ++r) { const int item = tid + 512 * r, tt = item >> 7, kk = item & 127; const size_t off = (tok0 + tt) * 512 + h * 128 + kk;
            const float lf = bf2f(LFb[off]); sF[tt * 128 + kk] = __expf(lf); sK[tt * 128 + kk] = -expm1f(lf); sQ[tt * 128 + kk] = bf2f(Qb[off]); }
        __syncthreads();
#pragma unroll 1
        for (int tt = 0; tt < 8; ++tt) { const float v = bf2f(Vb[(tok0 + tt) * 512 + h * 128 + j]); float o = 0.f;
            const LAS float* f = sF + tt * 128 + kq * 32; const LAS float* kx = sK + tt * 128 + kq * 32; const LAS float* q = sQ + tt * 128 + kq * 32;
#pragma unroll
            for (int k = 0; k < 32; ++k) { S[k] = f[k] * S[k] + kx[k] * v; o += q[k] * S[k]; }
            sO[(tt * 4 + kq) * 128 + j] = o; }
        __syncthreads();
        { const int tt = F.wave; const size_t tok = tok0 + tt;
            const float o0 = (sO[(tt * 4 + 0) * 128 + F.lane] + sO[(tt * 4 + 1) * 128 + F.lane]) + (sO[(tt * 4 + 2) * 128 + F.lane] + sO[(tt * 4 + 3) * 128 + F.lane]);
            const float o1 = (sO[(tt * 4 + 0) * 128 + 64 + F.lane] + sO[(tt * 4 + 1) * 128 + 64 + F.lane]) + (sO[(tt * 4 + 2) * 128 + 64 + F.lane] + sO[(tt * 4 + 3) * 128 + 64 + F.lane]);
            const float ss = wave_sum(o0 * o0 + o1 * o1), r = 1.f / sqrtf(ss * (1.f / 128.f) + RMS_EPS);
            const float g0 = bf2f(Gb[tok * 512 + h * 128 + F.lane]), g1 = bf2f(Gb[tok * 512 + h * 128 + 64 + F.lane]);
            MIX[tok * 1024 + h * 128 + F.lane] = (bf16)f2bf(o0 * r * ng0 * silu_f(g0));
            MIX[tok * 1024 + h * 128 + 64 + F.lane] = (bf16)f2bf(o1 * r * ng1 * silu_f(g1)); }
    }
    __syncthreads();
}
__device__ __forceinline__ void s5_seq(Frame& F, int pair) {
    const int b = pair >> 5, g = pair & 31, lane = F.lane;
    const float* tb = (const float*)(F.ws + WS_S5T) + (size_t)(g * S5N + lane) * 40;
    const float abr = tb[0], abi = tb[1];
    float bbr[16], bbi[16], cr[16], ci[16], dsk[16];
#pragma unroll
    for (int p = 0; p < 16; ++p) { bbr[p] = tb[2 + p]; bbi[p] = tb[18 + p]; cr[p] = F.in[I_CRE][(size_t)(g * 16 + p) * S5N + lane]; ci[p] = F.in[I_CIM][(size_t)(g * 16 + p) * S5N + lane];
        dsk[p] = (lane == 0) ? F.in[I_DSK][g * 16 + p] : 0.f; }
    const bf16* Ub = (const bf16*)(F.ws + WS_PROJ) + (size_t)4 * M * 512 + ((size_t)g * M + (size_t)b * SEQ) * 16;
    bf16* Zb = (bf16*)(F.ws + WS_Z) + (size_t)b * SEQ * 512 + g * 16;
    const int pme = ((lane >> 5) & 1) * 8 + ((lane >> 4) & 1) * 4 + ((lane >> 3) & 1) * 2 + ((lane >> 2) & 1);
    float xr = 0.f, xi = 0.f;
    v4u nu0 = *(const GAS v4u*)(Ub + (size_t)lane * 16), nu1 = *(const GAS v4u*)(Ub + (size_t)lane * 16 + 8);
    for (int t0 = 0; t0 < SEQ; t0 += 64) {
        const v4u u0 = nu0, u1 = nu1;
        if (t0 + 64 < SEQ) { nu0 = *(const GAS v4u*)(Ub + (size_t)(t0 + 64 + lane) * 16); nu1 = *(const GAS v4u*)(Ub + (size_t)(t0 + 64 + lane) * 16 + 8); }
#pragma unroll 1
        for (int tt = 0; tt < 64; ++tt) {
            v4u a, c;
            a.x = __builtin_amdgcn_readlane(u0.x, tt); a.y = __builtin_amdgcn_readlane(u0.y, tt); a.z = __builtin_amdgcn_readlane(u0.z, tt); a.w = __builtin_amdgcn_readlane(u0.w, tt);
            c.x = __builtin_amdgcn_readlane(u1.x, tt); c.y = __builtin_amdgcn_readlane(u1.y, tt); c.z = __builtin_amdgcn_readlane(u1.z, tt); c.w = __builtin_amdgcn_readlane(u1.w, tt);
            float u[16]; { float f0[8], f1[8]; unpack8(a, f0); unpack8(c, f1);
#pragma unroll
                for (int p = 0; p < 8; ++p) { u[p] = f0[p]; u[8 + p] = f1[p]; } }
            float bur = 0.f, bui = 0.f;
#pragma unroll
            for (int p = 0; p < 16; ++p) { bur += bbr[p] * u[p]; bui += bbi[p] * u[p]; }
            const float nxr = abr * xr - abi * xi + bur, nxi = abr * xi + abi * xr + bui; xr = nxr; xi = nxi;
            float r[16];
#pragma unroll
            for (int p = 0; p < 16; ++p) r[p] = cr[p] * xr - ci[p] * xi + dsk[p] * u[p];
#pragma unroll
            for (int i = 0; i < 8; ++i) { const float keep = (lane & 32) ? r[i + 8] : r[i], send = (lane & 32) ? r[i] : r[i + 8]; r[i] = keep + __shfl_xor(send, 32); }
#pragma unroll
            for (int i = 0; i < 4; ++i) { const float keep = (lane & 16) ? r[i + 4] : r[i], send = (lane & 16) ? r[i] : r[i + 4]; r[i] = keep + __shfl_xor(send, 16); }
#pragma unroll
            for (int i = 0; i < 2; ++i) { const float keep = (lane & 8) ? r[i + 2] : r[i], send = (lane & 8) ? r[i] : r[i + 2]; r[i] = keep + __shfl_xor(send, 8); }
            { const float keep = (lane & 4) ? r[1] : r[0], send = (lane & 4) ? r[0] : r[1]; r[0] = keep + __shfl_xor(send, 4); }
            r[0] += __shfl_xor(r[0], 2); r[0] += __shfl_xor(r[0], 1);
            if ((lane & 3) == 0) Zb[(size_t)(t0 + tt) * 512 + pme] = (bf16)f2bf(gelu_tanh(r[0]));
        }
    }
}

__device__ __forceinline__ int t256(int r, int c) { return r * 256 + ((((c >> 3) ^ (r & 15))) << 4) + (c & 7) * 2; }
__device__ __forceinline__ int t128(int r, int c) { return r * 128 + ((((c >> 3) ^ (r & 7))) << 4) + (c & 7) * 2; }
typedef unsigned v2u __attribute__((ext_vector_type(2)));
__device__ __forceinline__ unsigned offb(unsigned row, unsigned ch) { return 256u * row + 16u * (ch ^ (((row & 3u) << 2) | ((row >> 2) & 3u))); }
typedef short v4i16_t __attribute__((ext_vector_type(4)));
__device__ __forceinline__ bf16x8 tr_frag16(LAS unsigned char* tile, int lane, int c, int ks) {
    const unsigned g = lane >> 4, q = (lane & 15) >> 2, p = lane & 3;
    const v4i16_t lo = __builtin_amdgcn_ds_read_tr16_b64_v4i16((LAS v4i16_t*)(tile + offb(32 * ks + 8 * g + q, 2 * c + (p >> 1)) + 8 * (p & 1)));
    const v4i16_t hi = __builtin_amdgcn_ds_read_tr16_b64_v4i16((LAS v4i16_t*)(tile + offb(32 * ks + 8 * g + 4 + q, 2 * c + (p >> 1)) + 8 * (p & 1)));
    bf16x8 r; r[0] = lo[0]; r[1] = lo[1]; r[2] = lo[2]; r[3] = lo[3]; r[4] = hi[0]; r[5] = hi[1]; r[6] = hi[2]; r[7] = hi[3]; return r;
}
__device__ __forceinline__ void hgrn2_state_pass(Frame& F, int item) {
    const int bh = item >> 2, ksl = item & 3, b = bh >> 2, h = bh & 3, tid = F.tid, lane = F.lane, w = F.wave, fr = lane & 15, fq = lane >> 4;
    const int kcol = tid & 31, sg = tid >> 5;
    LAS unsigned char* L = F.lds + RING_OFF;
    LAS unsigned char* sRaw = L + 49152;
    const bf16* LFg = (const bf16*)(F.ws + WS_PROJ) + (size_t)M * 512 + (size_t)b * SEQ * 512 + h * 128 + ksl * 32;
    const bf16* Vg = (const bf16*)(F.ws + WS_PROJ) + (size_t)2 * M * 512 + (size_t)b * SEQ * 512 + h * 128;
    bf16* SST = (bf16*)(F.ws + WS_SST) + (size_t)bh * 64 * 128 * 128 + ksl * 32;
    float S[2][4];
#pragma unroll
    for (int i = 0; i < 2; ++i)
#pragma unroll
        for (int r = 0; r < 4; ++r) S[i][r] = 0.f;
    const int ls = (tid & 255) >> 2, lkg = tid & 3;
    const int vs0 = tid >> 4, vch = tid & 15;
    v4u nlf = *(const GAS v4u*)(LFg + (size_t)ls * 512 + lkg * 8);
    v4u nv0 = *(const GAS v4u*)(Vg + (size_t)vs0 * 512 + vch * 8), nv1 = *(const GAS v4u*)(Vg + (size_t)(32 + vs0) * 512 + vch * 8);
    for (int c = 0; c < 64; ++c) {
        LAS unsigned char* Lb = L + (c & 1) * 24576;
        LAS unsigned char* sKT = Lb; LAS unsigned char* sVT = Lb + 4096; LAS float* sTot = (LAS float*)(Lb + 20480); LAS float* sDec = (LAS float*)(Lb + 22528);
        if (tid < 256) *(LAS v4u*)(sRaw + ls * 64 + lkg * 16) = nlf;
        *(LAS v4u*)(sVT + offb(vs0, vch)) = nv0; *(LAS v4u*)(sVT + offb(32 + vs0, vch)) = nv1;
        if (c + 1 < 64) { const size_t t1 = (size_t)(c + 1) * 64;
            nlf = *(const GAS v4u*)(LFg + (t1 + ls) * 512 + lkg * 8); nv0 = *(const GAS v4u*)(Vg + (t1 + vs0) * 512 + vch * 8); nv1 = *(const GAS v4u*)(Vg + (t1 + 32 + vs0) * 512 + vch * 8); }
        __syncthreads();
        float lf[4];
#pragma unroll
        for (int j = 0; j < 4; ++j) lf[j] = bf2f(*(const LAS bf16*)(sRaw + (sg * 4 + j) * 64 + kcol * 2));
        float cl[4]; float run = 0.f;
#pragma unroll
        for (int j = 0; j < 4; ++j) { run += lf[j]; cl[j] = run; }
        sTot[sg * 32 + kcol] = run;
        __syncthreads();
        float off = 0.f, last = 0.f;
#pragma unroll
        for (int q = 0; q < 16; ++q) { const float tq = sTot[q * 32 + kcol]; off += (q < sg) ? tq : 0.f; last += tq; }
        float kh[4];
#pragma unroll
        for (int j = 0; j < 4; ++j) kh[j] = (1.f - __expf(lf[j])) * __expf(last - (off + cl[j]));
        { v2u pk; pk.x = pk2(kh[0], kh[1]); pk.y = pk2(kh[2], kh[3]);
          *(LAS v2u*)(sKT + kcol * 128 + ((((sg >> 1) ^ (kcol & 7))) << 4) + (sg & 1) * 8) = pk; }
        if (sg == 0) sDec[kcol] = __expf(last);
        __syncthreads();
        f32x4 acc[2] = {(f32x4){0.f, 0.f, 0.f, 0.f}, (f32x4){0.f, 0.f, 0.f, 0.f}};
        const int mt = w & 1, nt0 = (w >> 1) * 2;
#pragma unroll
        for (int ks = 0; ks < 2; ++ks) { const int ch = ks * 4 + fq, row = 16 * mt + fr;
            const bf16x8 af = *(const LAS bf16x8*)(sKT + row * 128 + ((ch ^ (row & 7)) << 4));
#pragma unroll
            for (int nt = 0; nt < 2; ++nt) { const bf16x8 bfm = tr_frag16(sVT, lane, nt0 + nt, ks);
                acc[nt] = __builtin_amdgcn_mfma_f32_16x16x32_bf16(af, bfm, acc[nt], 0, 0, 0); } }
        const int k0 = 16 * mt + fq * 4; const f32x4 dec = *(const LAS f32x4*)(sDec + k0);
#pragma unroll
        for (int nt = 0; nt < 2; ++nt) { const int vg = 16 * (nt0 + nt) + fr;
            v2u o; o.x = pk2(S[nt][0], S[nt][1]); o.y = pk2(S[nt][2], S[nt][3]);
            *(GAS v2u*)(SST + ((size_t)c * 128 + vg) * 128 + k0) = o;
            S[nt][0] = dec[0] * S[nt][0] + acc[nt][0]; S[nt][1] = dec[1] * S[nt][1] + acc[nt][1]; S[nt][2] = dec[2] * S[nt][2] + acc[nt][2]; S[nt][3] = dec[3] * S[nt][3] + acc[nt][3]; }
    }
    __syncthreads();
}
struct HgOutRegs { v4u lf[2], q[2], v[2], st[4]; };
__device__ __forceinline__ void hgrn2_out_load(Frame& F, int item, HgOutRegs& R) {
    const int bh = item >> 6, c = item & 63, b = bh >> 2, h = bh & 3, tid = F.tid;
    const size_t tok0 = (size_t)b * SEQ + (size_t)c * 64;
    const bf16* Qb = (const bf16*)(F.ws + WS_PROJ) + tok0 * 512 + h * 128; const bf16* LFb = Qb + (size_t)M * 512; const bf16* Vb = Qb + (size_t)2 * M * 512;
    const bf16* SST = (const bf16*)(F.ws + WS_SST) + (size_t)item * 128 * 128;
#pragma unroll
    for (int i = 0; i < 2; ++i) { const int idx = tid + 512 * i, sr = idx >> 4, ch = idx & 15;
        R.lf[i] = *(const GAS v4u*)(LFb + (size_t)sr * 512 + ch * 8); R.q[i] = *(const GAS v4u*)(Qb + (size_t)sr * 512 + ch * 8); R.v[i] = *(const GAS v4u*)(Vb + (size_t)sr * 512 + ch * 8); }
#pragma unroll
    for (int i = 0; i < 4; ++i) { const int idx = tid + 512 * i; R.st[i] = *(const GAS v4u*)(SST + (size_t)(idx >> 4) * 128 + (idx & 15) * 8); }
}
__device__ __forceinline__ void hgrn2_out_phase(Frame& F) {
    const int tid = F.tid, lane = F.lane, w = F.wave, fr = lane & 15, fq = lane >> 4;
    const int kcol = tid & 127, qtr = tid >> 7;
    LAS unsigned char* L = F.lds + RING_OFF;
    LAS unsigned char* sQt = L; LAS unsigned char* sQm = L + 16384; LAS unsigned char* sKm = L + 32768; LAS unsigned char* sV = L + 49152; LAS unsigned char* sST = L + 65536; LAS unsigned char* sP = L + 98304;
    LAS float* sTot = (LAS float*)(L + 106496); LAS float* sSS = (LAS float*)(L + 108544);
    LAS unsigned char* rLF = L + 110592; LAS unsigned char* rQ = L + 126976;
    HgOutRegs R;
    int item = F.vcu;
    if (item < 32 * 64) hgrn2_out_load(F, item, R);
    for (; item < 32 * 64; item += F.G) {
        const int bh = item >> 6, c = item & 63, b = bh >> 2, h = bh & 3;
        const size_t tok0 = (size_t)b * SEQ + (size_t)c * 64;
        const bf16* Gb = (const bf16*)(F.ws + WS_PROJ) + (size_t)3 * M * 512 + tok0 * 512 + h * 128;
        bf16* MIX = (bf16*)(F.ws + WS_MIX) + tok0 * 1024 + h * 128;
#pragma unroll
        for (int i = 0; i < 2; ++i) { const int idx = tid + 512 * i, sr = idx >> 4, ch = idx & 15;
            *(LAS v4u*)(rLF + sr * 256 + ch * 16) = R.lf[i]; *(LAS v4u*)(rQ + sr * 256 + ch * 16) = R.q[i]; *(LAS v4u*)(sV + offb(sr, ch)) = R.v[i]; }
#pragma unroll
        for (int i = 0; i < 4; ++i) { const int idx = tid + 512 * i, v = idx >> 4, kc = idx & 15; *(LAS v4u*)(sST + v * 256 + ((kc ^ (v & 15)) << 4)) = R.st[i]; }
        if (item + F.G < 32 * 64) hgrn2_out_load(F, item + F.G, R);
        __syncthreads();
        float lf[16], q[16];
#pragma unroll
        for (int j = 0; j < 16; ++j) { lf[j] = bf2f(*(const LAS bf16*)(rLF + (qtr * 16 + j) * 256 + kcol * 2)); q[j] = bf2f(*(const LAS bf16*)(rQ + (qtr * 16 + j) * 256 + kcol * 2)); }
        float cl[16]; float run = 0.f;
#pragma unroll
        for (int j = 0; j < 16; ++j) { run += lf[j]; cl[j] = run; }
        sTot[qtr * 128 + kcol] = run;
        __syncthreads();
        { const float t0 = sTot[kcol], t1 = sTot[128 + kcol], t2 = sTot[256 + kcol];
          const float off = (qtr > 0 ? t0 : 0.f) + (qtr > 1 ? t1 : 0.f) + (qtr > 2 ? t2 : 0.f), mid = t0 + t1;
#pragma unroll
          for (int j = 0; j < 16; ++j) { const int sdx = qtr * 16 + j; const float cum = off + cl[j];
              const int o = t256(sdx, kcol);
              *(LAS bf16*)(sQt + o) = (bf16)f2bf(q[j] * __expf(cum));
              *(LAS bf16*)(sQm + o) = (bf16)f2bf(q[j] * __expf(cum - mid));
              *(LAS bf16*)(sKm + o) = (bf16)f2bf((1.f - __expf(lf[j])) * __expf(mid - cum)); } }
        __syncthreads();
        const int tt = w >> 1, trow = 16 * tt + fr;
#pragma unroll
        for (int sti = 0; sti < 2; ++sti) { const int stl = (w & 1) * 2 + sti; f32x4 acc = (f32x4){0.f, 0.f, 0.f, 0.f};
            if (stl <= tt) {
#pragma unroll
                for (int ks = 0; ks < 4; ++ks) { const int ch = ks * 4 + fq, srow = 16 * stl + fr;
                    const bf16x8 af = *(const LAS bf16x8*)(sKm + srow * 256 + ((ch ^ (srow & 15)) << 4));
                    const bf16x8 bfm = *(const LAS bf16x8*)(sQm + trow * 256 + ((ch ^ (trow & 15)) << 4));
                    acc = __builtin_amdgcn_mfma_f32_16x16x32_bf16(af, bfm, acc, 0, 0, 0); } }
            const int s0 = 16 * stl + fq * 4;
            const float p0 = (s0 + 0 <= trow) ? acc[0] : 0.f, p1 = (s0 + 1 <= trow) ? acc[1] : 0.f, p2 = (s0 + 2 <= trow) ? acc[2] : 0.f, p3 = (s0 + 3 <= trow) ? acc[3] : 0.f;
            v2u o; o.x = pk2(p0, p1); o.y = pk2(p2, p3);
            *(LAS v2u*)(sP + trow * 128 + ((((s0 >> 3) ^ (trow & 7))) << 4) + (s0 & 7) * 2) = o; }
        __syncthreads();
        f32x4 oacc[4];
#pragma unroll
        for (int i = 0; i < 4; ++i) oacc[i] = (f32x4){0.f, 0.f, 0.f, 0.f};
#pragma unroll
        for (int ks = 0; ks < 4; ++ks) { const int ch = ks * 4 + fq;
            const bf16x8 bfm = *(const LAS bf16x8*)(sQt + trow * 256 + ((ch ^ (trow & 15)) << 4));
#pragma unroll
            for (int i = 0; i < 4; ++i) { const int vr = 16 * ((w & 1) * 4 + i) + fr; const bf16x8 af = *(const LAS bf16x8*)(sST + vr * 256 + ((ch ^ (vr & 15)) << 4));
                oacc[i] = __builtin_amdgcn_mfma_f32_16x16x32_bf16(af, bfm, oacc[i], 0, 0, 0); } }
#pragma unroll
        for (int ks = 0; ks < 2; ++ks) { const int ch = ks * 4 + fq;
            const bf16x8 bfm = *(const LAS bf16x8*)(sP + trow * 128 + ((ch ^ (trow & 7)) << 4));
#pragma unroll
            for (int i = 0; i < 4; ++i) { const bf16x8 af = tr_frag16(sV, lane, (w & 1) * 4 + i, ks);
                oacc[i] = __builtin_amdgcn_mfma_f32_16x16x32_bf16(af, bfm, oacc[i], 0, 0, 0); } }
        float ss = 0.f;
#pragma unroll
        for (int i = 0; i < 4; ++i) ss += (oacc[i][0] * oacc[i][0] + oacc[i][1] * oacc[i][1]) + (oacc[i][2] * oacc[i][2] + oacc[i][3] * oacc[i][3]);
        ss += __shfl_xor(ss, 16); ss += __shfl_xor(ss, 32);
        if (fq == 0) sSS[(w & 1) * 64 + trow] = ss;
        __syncthreads();
        const float rinv = 1.f / sqrtf((sSS[trow] + sSS[64 + trow]) * (1.f / 128.f) + RMS_EPS);
#pragma unroll
        for (int i = 0; i < 4; ++i) { const int v0 = 16 * ((w & 1) * 4 + i) + fq * 4;
            const v2u gw2 = *(const GAS v2u*)(Gb + (size_t)trow * 512 + v0); const f32x4 ng = *(const GAS f32x4*)(F.in[I_HGNG] + v0);
            const float g0 = __builtin_bit_cast(float, gw2.x << 16), g1 = __builtin_bit_cast(float, gw2.x & 0xffff0000u), g2 = __builtin_bit_cast(float, gw2.y << 16), g3 = __builtin_bit_cast(float, gw2.y & 0xffff0000u);
            v2u o; o.x = pk2(oacc[i][0] * rinv * ng[0] * silu_f(g0), oacc[i][1] * rinv * ng[1] * silu_f(g1)); o.y = pk2(oacc[i][2] * rinv * ng[2] * silu_f(g2), oacc[i][3] * rinv * ng[3] * silu_f(g3));
            *(GAS v2u*)(MIX + (size_t)trow * 1024 + v0) = o; }
        __syncthreads();
    }
}

__device__ __forceinline__ void s5_tables_stage1(Frame& F) {
    const int gt = (F.vcu * NWAVES + F.wave) * 64 + F.lane, NGT = F.G * NWAVES * 64;
    const float* S5T = (const float*)(F.ws + WS_S5T); const float* PW = (const float*)(F.ws + WS_PW);
    float* KT = (float*)(F.ws + WS_KTAU); bf16* G5 = (bf16*)(F.ws + WS_G5); bf16* T5 = (bf16*)(F.ws + WS_T5);
    for (int i = gt; i < S5G * 32 * 256; i += NGT) { const int g = i >> 13, tau = (i >> 8) & 31, p = (i >> 4) & 15, q = i & 15;
        float acc = (tau == 0 && p == q) ? F.in[I_DSK][g * 16 + p] : 0.f;
        for (int n = 0; n < S5N; ++n) { const int gn = g * S5N + n;
            const float cr = F.in[I_CRE][(size_t)(g * 16 + p) * S5N + n], ci = F.in[I_CIM][(size_t)(g * 16 + p) * S5N + n];
            const float wr = PW[((size_t)gn * 33 + tau) * 2], wi = PW[((size_t)gn * 33 + tau) * 2 + 1];
            const float br = S5T[(size_t)gn * 40 + 2 + q], bi = S5T[(size_t)gn * 40 + 18 + q];
            const float er = cr * wr - ci * wi, ei = cr * wi + ci * wr;
            acc += er * br - ei * bi; }
        KT[i] = acc; }
    for (int i = gt; i < S5G * 256 * 64; i += NGT) { const int g = i >> 14, r = (i >> 6) & 255, kc = i & 63, sdx = kc >> 1, q0 = (kc & 1) * 8;
        float f[8];
        if (r < 128) { const int n = r & 63, gn = g * S5N + n; const float wr = PW[((size_t)gn * 33 + (31 - sdx)) * 2], wi = PW[((size_t)gn * 33 + (31 - sdx)) * 2 + 1];
#pragma unroll
            for (int j = 0; j < 8; ++j) { const float br = S5T[(size_t)gn * 40 + 2 + q0 + j], bi = S5T[(size_t)gn * 40 + 18 + q0 + j]; f[j] = (r < 64) ? (wr * br - wi * bi) : (wr * bi + wi * br); }
        } else {
#pragma unroll
            for (int j = 0; j < 8; ++j) f[j] = 0.f; }
        *(GAS v4u*)(G5 + ((size_t)(g * 256 + r)) * 512 + kc * 8) = pack8(f); }
    for (int i = gt; i < S5G * 512 * 16; i += NGT) { const int g = i >> 13, row = (i >> 4) & 511, nc = i & 15, t = row >> 4, p = row & 15, im = nc >> 3, n0 = (nc & 7) * 8;
        float f[8];
#pragma unroll
        for (int j = 0; j < 8; ++j) { const int n = n0 + j, gn = g * S5N + n;
            const float cr = F.in[I_CRE][(size_t)(g * 16 + p) * S5N + n], ci = F.in[I_CIM][(size_t)(g * 16 + p) * S5N + n];
            const float wr = PW[((size_t)gn * 33 + t + 1) * 2], wi = PW[((size_t)gn * 33 + t + 1) * 2 + 1];
            f[j] = im ? -(cr * wi + ci * wr) : (cr * wr - ci * wi); }
        *(GAS v4u*)(T5 + ((size_t)(g * 512 + row)) * 640 + 512 + nc * 8) = pack8(f); }
}
__device__ __forceinline__ void s5_tables_stage2(Frame& F) {
    const int gt = (F.vcu * NWAVES + F.wave) * 64 + F.lane, NGT = F.G * NWAVES * 64;
    const float* KT = (const float*)(F.ws + WS_KTAU); bf16* T5 = (bf16*)(F.ws + WS_T5);
    for (int i = gt; i < S5G * 512 * 64; i += NGT) { const int g = i >> 15, row = (i >> 6) & 511, kc = i & 63, t = row >> 4, p = row & 15, sdx = kc >> 1, q0 = (kc & 1) * 8;
        float f[8];
        if (sdx <= t) { const float* k = KT + (((size_t)g * 32 + (t - sdx)) * 16 + p) * 16 + q0;
#pragma unroll
            for (int j = 0; j < 8; ++j) f[j] = k[j];
        } else {
#pragma unroll
            for (int j = 0; j < 8; ++j) f[j] = 0.f; }
        *(GAS v4u*)(T5 + ((size_t)(g * 512 + row)) * 640 + kc * 8) = pack8(f); }
}
__device__ __forceinline__ void s5_scan(Frame& F, int idx) {
    const int b = idx >> 11, g = (idx >> 6) & 31, n = idx & 63;
    const float* PW = (const float*)(F.ws + WS_PW); const float* XL = (const float*)(F.ws + WS_XLOC); bf16* A5 = (bf16*)(F.ws + WS_A5);
    const float ar = PW[((size_t)(g * S5N + n) * 33 + 32) * 2], ai = PW[((size_t)(g * S5N + n) * 33 + 32) * 2 + 1];
    float xr = 0.f, xi = 0.f;
    for (int c0 = 0; c0 < 128; c0 += 8) {
        float lr[8], li[8];
#pragma unroll
        for (int j = 0; j < 8; ++j) { const float* p = XL + ((size_t)(b * 128 + c0 + j) * 32 + g) * 128 + n; lr[j] = p[0]; li[j] = p[64]; }
#pragma unroll
        for (int j = 0; j < 8; ++j) { bf16* o = A5 + ((size_t)g * S5I + b * 128 + c0 + j) * 640 + 512 + n; o[0] = (bf16)f2bf(xr); o[64] = (bf16)f2bf(xi);
            const float nr = ar * xr - ai * xi + lr[j], ni = ar * xi + ai * xr + li[j]; xr = nr; xi = ni; }
    }
}

__device__ __forceinline__ void ln1_row(bf16* row, const float* g, const float* b, int lane) {
    const v4u w0 = *(const GAS v4u*)(row + lane * 8), w1 = *(const GAS v4u*)(row + 512 + lane * 8);
    float a[8], c[8]; unpack8(w0, a); unpack8(w1, c);
    float s = 0.f;
#pragma unroll
    for (int j = 0; j < 8; ++j) s += a[j] + c[j];
    const float mean = wave_sum(s) * (1.f / D); float s2 = 0.f;
#pragma unroll
    for (int j = 0; j < 8; ++j) { a[j] -= mean; c[j] -= mean; s2 += a[j] * a[j] + c[j] * c[j]; }
    const float rstd = 1.f / sqrtf(wave_sum(s2) * (1.f / D) + LN_EPS);
    const f32x4 g0 = *(const GAS f32x4*)(g + lane * 8), g1 = *(const GAS f32x4*)(g + lane * 8 + 4), g2 = *(const GAS f32x4*)(g + 512 + lane * 8), g3 = *(const GAS f32x4*)(g + 512 + lane * 8 + 4);
    const f32x4 b0 = *(const GAS f32x4*)(b + lane * 8), b1 = *(const GAS f32x4*)(b + lane * 8 + 4), b2 = *(const GAS f32x4*)(b + 512 + lane * 8), b3 = *(const GAS f32x4*)(b + 512 + lane * 8 + 4);
    const float gg0[8] = {g0.x, g0.y, g0.z, g0.w, g1.x, g1.y, g1.z, g1.w}, gg1[8] = {g2.x, g2.y, g2.z, g2.w, g3.x, g3.y, g3.z, g3.w};
    const float bb0[8] = {b0.x, b0.y, b0.z, b0.w, b1.x, b1.y, b1.z, b1.w}, bb1[8] = {b2.x, b2.y, b2.z, b2.w, b3.x, b3.y, b3.z, b3.w};
#pragma unroll
    for (int j = 0; j < 8; ++j) { a[j] = a[j] * rstd * gg0[j] + bb0[j]; c[j] = c[j] * rstd * gg1[j] + bb1[j]; }
    *(GAS v4u*)(row + lane * 8) = pack8(a); *(GAS v4u*)(row + 512 + lane * 8) = pack8(c);
}

typedef float f32x16 __attribute__((ext_vector_type(16)));
__device__ __forceinline__ int f2ord(float f) { const int x = __builtin_bit_cast(int, f); return x ^ ((x >> 31) & 0x7fffffff); }
__device__ __forceinline__ float ord2f(int x) { return __builtin_bit_cast(float, x ^ ((x >> 31) & 0x7fffffff)); }
#define CE_DESC(a, b) do { const int _h = max((a), (b)), _l = min((a), (b)); (a) = _h; (b) = _l; } while (0)
__device__ __forceinline__ void sort16_desc(int (&v)[16]) {
#pragma unroll
    for (int k = 2; k <= 16; k <<= 1)
#pragma unroll
        for (int j = k >> 1; j > 0; j >>= 1)
#pragma unroll
            for (int i = 0; i < 16; ++i) { const int l = i ^ j; if (l > i) { if ((i & k) == 0) CE_DESC(v[i], v[l]); else CE_DESC(v[l], v[i]); } }
}
__device__ __forceinline__ void merge16_desc(int (&a)[16], const int (&b)[16]) {
#pragma unroll
    for (int i = 0; i < 16; ++i) a[i] = max(a[i], b[15 - i]);
#pragma unroll
    for (int j = 8; j > 0; j >>= 1)
#pragma unroll
        for (int i = 0; i < 16; ++i) { const int l = i ^ j; if (l > i) CE_DESC(a[i], a[l]); }
}
__device__ __forceinline__ void peer_topk_side(const f32x16 (&acc)[4], int hi, int (&top)[16]) {
    int t[4][16];
#pragma unroll
    for (int kt = 0; kt < 4; ++kt)
#pragma unroll
        for (int j = 0; j < 16; ++j) { const unsigned key = (unsigned)(kt * 32 + (j & 3) + 8 * (j >> 2)) | (unsigned)(4 * hi);
            const float av = acc[kt][j];
            t[kt][j] = f2ord(__builtin_bit_cast(float, (__builtin_bit_cast(unsigned, av) & 0xFFFFFF80u) | key)); }
    sort16_desc(t[0]); sort16_desc(t[1]); sort16_desc(t[2]); sort16_desc(t[3]);
    merge16_desc(t[0], t[1]); merge16_desc(t[2], t[3]); merge16_desc(t[0], t[2]);
    int p[16];
#pragma unroll
    for (int i = 0; i < 16; ++i) p[i] = __shfl_xor(t[0][i], 32);
    merge16_desc(t[0], p);
#pragma unroll
    for (int i = 0; i < 16; ++i) top[i] = t[0][i];
}
__device__ __forceinline__ void peer_score_phase(Frame& F, const pg8::StaticOrder& SO) {
    LAS unsigned char* kl = F.lds + RING_OFF;
    LAS unsigned* look = (LAS unsigned*)(F.lds + RING_OFF + 65536 + F.wave * 8192);
    const bf16* keys = (const bf16*)(F.ws + WS_KEYS);
    for (int i = F.tid; i < 2 * 128 * 16; i += NWAVES * 64) { const int sn = i >> 4, c = i & 15, n = sn & 127;
        *(LAS v4u*)(kl + sn * 256 + ((c ^ (n & 15)) << 4)) = *(const GAS v4u*)(keys + (size_t)sn * 128 + c * 8); }
    __syncthreads();
    const int lane = F.lane, r32 = lane & 31, hi = lane >> 5;
    const bf16* Q2 = (const bf16*)(F.ws + WS_Q2);
    int* EIDX = (int*)(F.ws + WS_EIDX); float* EGATE = (float*)(F.ws + WS_EGATE);
    for (int ui = 0;; ++ui) { pg8::Unit gu; if (!SO.next(ui, gu)) break;
        const int blk = gu.pm * 8 + F.wave, h = gu.pn; const size_t tok = (size_t)blk * 32 + r32;
        const bf16* qrow = Q2 + tok * NQ2 + h * PQ + hi * 8;
        int top1[16], top2[16];
#pragma unroll
        for (int s = 0; s < 2; ++s) {
            bf16x8 qf[8];
#pragma unroll
            for (int ks = 0; ks < 8; ++ks) qf[ks] = *(const GAS bf16x8*)(qrow + s * 128 + ks * 16);
            f32x16 acc[4];
#pragma unroll
            for (int kt = 0; kt < 4; ++kt) { acc[kt] = (f32x16){0.f, 0.f, 0.f, 0.f, 0.f, 0.f, 0.f, 0.f, 0.f, 0.f, 0.f, 0.f, 0.f, 0.f, 0.f, 0.f};
                const int n = kt * 32 + r32;
#pragma unroll
                for (int ks = 0; ks < 8; ++ks) { const bf16x8 kf = *(const LAS bf16x8*)(kl + (s * 128 + n) * 256 + (((2 * ks + hi) ^ (n & 15)) << 4));
                    acc[kt] = __builtin_amdgcn_mfma_f32_32x32x16_bf16(kf, qf[ks], acc[kt], 0, 0, 0); } }
            if (s == 0) peer_topk_side(acc, hi, top1); else peer_topk_side(acc, hi, top2);
        }
        float v1[16], v2[16];
#pragma unroll
        for (int i = 0; i < 16; ++i) { v1[i] = ord2f(top1[i]); v2[i] = ord2f(top2[i]);
            look[i * 64 + lane] = __builtin_bit_cast(unsigned, v1[i]) & 0x7Fu; look[(16 + i) * 64 + lane] = __builtin_bit_cast(unsigned, v2[i]) & 0x7Fu; }
        int c[4][16]; int nc = 0;
#pragma unroll
        for (int i = 0; i < 16; ++i)
#pragma unroll
            for (int j = 0; j < 16; ++j) if ((i + 1) * (j + 1) <= 16) { const float sum = v1[i] + v2[j];
                c[nc >> 4][nc & 15] = f2ord(__builtin_bit_cast(float, (__builtin_bit_cast(unsigned, sum) & 0xFFFFFF00u) | (unsigned)(i * 16 + j))); ++nc; }
#pragma unroll
        for (int q = 50; q < 64; ++q) c[q >> 4][q & 15] = (int)0x80000000;
        sort16_desc(c[0]); sort16_desc(c[1]); sort16_desc(c[2]); sort16_desc(c[3]);
        merge16_desc(c[0], c[1]); merge16_desc(c[2], c[3]); merge16_desc(c[0], c[2]);
        float e[16], sum = 0.f;
        float cf[16];
#pragma unroll
        for (int k = 0; k < 16; ++k) cf[k] = ord2f(c[0][k]);
#pragma unroll
        for (int k = 0; k < 16; ++k) { e[k] = __expf(cf[k] - cf[0]); sum += e[k]; }
        const float inv = 1.f / sum;
        LDS_WAIT();
        int ex[8]; float gt[8];
#pragma unroll
        for (int k = 0; k < 8; ++k) { const float cv = hi ? cf[8 + k] : cf[k]; gt[k] = (hi ? e[8 + k] : e[k]) * inv;
            const unsigned pos = __builtin_bit_cast(unsigned, cv) & 0xFFu;
            ex[k] = (int)(look[(pos >> 4) * 64 + lane] * PK + look[(16 + (pos & 15)) * 64 + lane]); }
        int* eo = EIDX + (tok * PH + h) * 16 + hi * 8; float* go = EGATE + (tok * PH + h) * 16 + hi * 8;
        *(GAS v4u*)eo = (v4u){(unsigned)ex[0], (unsigned)ex[1], (unsigned)ex[2], (unsigned)ex[3]}; *(GAS v4u*)(eo + 4) = (v4u){(unsigned)ex[4], (unsigned)ex[5], (unsigned)ex[6], (unsigned)ex[7]};
        *(GAS f32x4*)go = (f32x4){gt[0], gt[1], gt[2], gt[3]}; *(GAS f32x4*)(go + 4) = (f32x4){gt[4], gt[5], gt[6], gt[7]};
        LDS_WAIT();
    }
}

typedef float f32x2 __attribute__((ext_vector_type(2)));
constexpr float PD_SCALE = 256.f, PU_SCALE = 32.f;
__device__ __forceinline__ void unpack_fp8x16(const v4u w, float (&f)[16]) {
    const unsigned ww[4] = {w.x, w.y, w.z, w.w};
#pragma unroll
    for (int i = 0; i < 4; ++i) { const f32x2 lo = __builtin_amdgcn_cvt_pk_f32_fp8((int)ww[i], false), hi = __builtin_amdgcn_cvt_pk_f32_fp8((int)ww[i], true);
        f[4 * i] = lo[0]; f[4 * i + 1] = lo[1]; f[4 * i + 2] = hi[0]; f[4 * i + 3] = hi[1]; }
}
__device__ __forceinline__ void peer_sort_experts(int& e0, int& e1, float& g0, float& g1, int lane) {
    int k0 = e0 * 128 + lane, k1 = e1 * 128 + 64 + lane;
#pragma unroll
    for (int k = 2; k <= 128; k <<= 1)
#pragma unroll
        for (int j = k >> 1; j > 0; j >>= 1) {
            if (j == 64) { const int lo = min(k0, k1), hi = max(k0, k1); k0 = lo; k1 = hi; }
            else { const int p0 = __shfl_xor(k0, j), p1 = __shfl_xor(k1, j); const bool lower = (lane & j) == 0;
                const bool asc0 = (lane & k) == 0, asc1 = ((64 + lane) & k) == 0;
                k0 = (lower == asc0) ? min(k0, p0) : max(k0, p0); k1 = (lower == asc1) ? min(k1, p1) : max(k1, p1); }
        }
    const int s0 = k0 & 127, s1 = k1 & 127;
    const float a0 = __shfl(g0, s0 & 63), b0 = __shfl(g1, s0 & 63), a1 = __shfl(g0, s1 & 63), b1 = __shfl(g1, s1 & 63);
    g0 = (s0 < 64) ? a0 : b0; g1 = (s1 < 64) ? a1 : b1; e0 = k0 >> 7; e1 = k1 >> 7;
}
typedef long i64_t;
__device__ __forceinline__ void peer_gather_phase(Frame& F) {
    const int gw = F.vcu * NWAVES + F.wave, NGW = F.G * NWAVES, lane = F.lane;
    const bf16* H1 = (const bf16*)(F.ws + WS_H); const unsigned char* PD = F.ws + WS_PD; const unsigned char* PU = F.ws + WS_PU;
    const int* EIDX = (const int*)(F.ws + WS_EIDX); const float* EGATE = (const float*)(F.ws + WS_EGATE);
    const int rep = ((lane >> 5) & 1) * 4 + ((lane >> 4) & 1) * 2 + ((lane >> 3) & 1);
    const bool diag = ((lane & 15) >> 2) == (lane >> 4); const int dr = lane & 3;
    const float m0 = (diag && dr == 0) ? 1.f : 0.f, m1 = (diag && dr == 1) ? 1.f : 0.f, m2 = (diag && dr == 2) ? 1.f : 0.f, m3 = (diag && dr == 3) ? 1.f : 0.f;
    constexpr int GT = 4; constexpr float XS = 16.f, AS = 128.f;
    const int si = lane & 15, sq = lane >> 4;
    const unsigned sb = 0xFFu << (8 * (si & 3));
    const unsigned m0lo = (sq == (si >> 3) && (si & 7) < 4) ? sb : 0u, m0hi = (sq == (si >> 3) && (si & 7) >= 4) ? sb : 0u;
    const unsigned m1lo = (sq == 2 + (si >> 3) && (si & 7) < 4) ? sb : 0u, m1hi = (sq == 2 + (si >> 3) && (si & 7) >= 4) ? sb : 0u;
    for (int pr = gw; pr < M / GT; pr += NGW) {
        __syncthreads();
        const size_t tokA = (size_t)pr * GT;
        int e0[GT], e1[GT]; float g0[GT], g1[GT]; f32x4 os[GT][4]; i64_t xb0[GT], xb1[GT];
#pragma unroll
        for (int t = 0; t < GT; ++t) { float a[8], c[8]; unpack8(*(const GAS v4u*)(H1 + (tokA + t) * D + lane * 16), a); unpack8(*(const GAS v4u*)(H1 + (tokA + t) * D + lane * 16 + 8), c);
            unsigned q0, q1, q2, q3; int pk;
            pk = __builtin_amdgcn_cvt_pk_fp8_f32(a[0] * XS, a[1] * XS, 0, false); pk = __builtin_amdgcn_cvt_pk_fp8_f32(a[2] * XS, a[3] * XS, pk, true); q0 = (unsigned)pk;
            pk = __builtin_amdgcn_cvt_pk_fp8_f32(a[4] * XS, a[5] * XS, 0, false); pk = __builtin_amdgcn_cvt_pk_fp8_f32(a[6] * XS, a[7] * XS, pk, true); q1 = (unsigned)pk;
            pk = __builtin_amdgcn_cvt_pk_fp8_f32(c[0] * XS, c[1] * XS, 0, false); pk = __builtin_amdgcn_cvt_pk_fp8_f32(c[2] * XS, c[3] * XS, pk, true); q2 = (unsigned)pk;
            pk = __builtin_amdgcn_cvt_pk_fp8_f32(c[4] * XS, c[5] * XS, 0, false); pk = __builtin_amdgcn_cvt_pk_fp8_f32(c[6] * XS, c[7] * XS, pk, true); q3 = (unsigned)pk;
            xb0[t] = (i64_t)(((unsigned long long)q1 << 32) | q0); xb1[t] = (i64_t)(((unsigned long long)q3 << 32) | q2);
            e0[t] = EIDX[(tokA + t) * 128 + lane]; e1[t] = EIDX[(tokA + t) * 128 + 64 + lane]; g0[t] = EGATE[(tokA + t) * 128 + lane]; g1[t] = EGATE[(tokA + t) * 128 + 64 + lane];
            peer_sort_experts(e0[t], e1[t], g0[t], g1[t], lane);
#pragma unroll
            for (int j = 0; j < 4; ++j) os[t][j] = (f32x4){0.f, 0.f, 0.f, 0.f}; }
#define GATHER_BATCH(E0, E1, G0, G1, XB0, XB1, O) do { const int ev = (bt < 8) ? E0 : E1; const float gv = (bt < 8) ? G0 : G1; const int lb8 = (bt & 7) * 8; v4u dw[8], uw[8]; \
            _Pragma("unroll") for (int i = 0; i < 8; ++i) { const int e = __builtin_amdgcn_readlane(ev, lb8 + i); dw[i] = *(const GAS v4u*)(PD + (size_t)e * D + lane * 16); uw[i] = *(const GAS v4u*)(PU + (size_t)e * D + lane * 16); } \
            float p[8]; \
            _Pragma("unroll") for (int i = 0; i < 8; ++i) { f32x4 dacc = (f32x4){0.f, 0.f, 0.f, 0.f}; \
                dacc = __builtin_amdgcn_mfma_f32_16x16x32_fp8_fp8((i64_t)(((unsigned long long)dw[i].y << 32) | dw[i].x), XB0, dacc, 0, 0, 0); \
                dacc = __builtin_amdgcn_mfma_f32_16x16x32_fp8_fp8((i64_t)(((unsigned long long)dw[i].w << 32) | dw[i].z), XB1, dacc, 0, 0, 0); \
                const float d0 = dacc[0] * m0, d1 = dacc[1] * m1, d2 = dacc[2] * m2, d3 = dacc[3] * m3; p[i] = (d0 + d1) + (d2 + d3); } \
            _Pragma("unroll") for (int i = 0; i < 4; ++i) { const float keep = (lane & 32) ? p[i + 4] : p[i], send = (lane & 32) ? p[i] : p[i + 4]; p[i] = keep + __shfl_xor(send, 32); } \
            _Pragma("unroll") for (int i = 0; i < 2; ++i) { const float keep = (lane & 16) ? p[i + 2] : p[i], send = (lane & 16) ? p[i] : p[i + 2]; p[i] = keep + __shfl_xor(send, 16); } \
            { const float keep = (lane & 8) ? p[1] : p[0], send = (lane & 8) ? p[0] : p[1]; p[0] = keep + __shfl_xor(send, 8); } \
            p[0] += __shfl_xor(p[0], 4); p[0] += __shfl_xor(p[0], 2); p[0] += __shfl_xor(p[0], 1); \
            const float gate = __shfl(gv, lb8 + rep); const float act = gelu_tanh(p[0] * (1.f / (PD_SCALE * XS))) * gate * AS; \
            const int act8 = __builtin_amdgcn_cvt_pk_fp8_f32(act, 0.f, 0, false) & 0xff; \
            _Pragma("unroll") for (int i = 0; i < 8; ++i) { const unsigned a8 = (unsigned)__builtin_amdgcn_readlane(act8, ((i >> 2) & 1) * 32 + ((i >> 1) & 1) * 16 + (i & 1) * 8) * 0x01010101u; \
                const i64_t A0 = (i64_t)(((unsigned long long)(a8 & m0hi) << 32) | (a8 & m0lo)), A1 = (i64_t)(((unsigned long long)(a8 & m1hi) << 32) | (a8 & m1lo)); \
                const i64_t B0 = (i64_t)(((unsigned long long)uw[i].y << 32) | uw[i].x), B1 = (i64_t)(((unsigned long long)uw[i].w << 32) | uw[i].z); \
                O[0] = __builtin_amdgcn_mfma_f32_16x16x32_fp8_fp8(A0, B0, O[0], 0, 0, 0); O[1] = __builtin_amdgcn_mfma_f32_16x16x32_fp8_fp8(A1, B0, O[1], 0, 0, 0); \
                O[2] = __builtin_amdgcn_mfma_f32_16x16x32_fp8_fp8(A0, B1, O[2], 0, 0, 0); O[3] = __builtin_amdgcn_mfma_f32_16x16x32_fp8_fp8(A1, B1, O[3], 0, 0, 0); } } while (0)
#pragma unroll 1
        for (int bt = 0; bt < 16; ++bt) { if ((bt & 3) == 0) __syncthreads();
#pragma unroll
            for (int t = 0; t < GT; ++t) { GATHER_BATCH(e0[t], e1[t], g0[t], g1[t], xb0[t], xb1[t], os[t]); __builtin_amdgcn_sched_barrier(0); } }
#undef GATHER_BATCH
#pragma unroll
        for (int t = 0; t < GT; ++t) {
            float o[16]; float s = 0.f;
#pragma unroll
            for (int a4 = 0; a4 < 4; ++a4) { const int hf = a4 >> 1, kh = a4 & 1, c0 = 16 * si + 256 * ((sq >> 1) + 2 * kh) + 8 * hf + 4 * (sq & 1);
                const v2u hw = *(const GAS v2u*)(H1 + (tokA + t) * D + c0);
                const float x0 = __builtin_bit_cast(float, hw.x << 16), x1 = __builtin_bit_cast(float, hw.x & 0xffff0000u), x2 = __builtin_bit_cast(float, hw.y << 16), x3 = __builtin_bit_cast(float, hw.y & 0xffff0000u);
                const f32x4 ov = os[t][a4];
                o[4 * a4 + 0] = ov[0] * (1.f / (AS * PU_SCALE)) + DN_ALPHA * x0; o[4 * a4 + 1] = ov[1] * (1.f / (AS * PU_SCALE)) + DN_ALPHA * x1;
                o[4 * a4 + 2] = ov[2] * (1.f / (AS * PU_SCALE)) + DN_ALPHA * x2; o[4 * a4 + 3] = ov[3] * (1.f / (AS * PU_SCALE)) + DN_ALPHA * x3;
                s += (o[4 * a4 + 0] + o[4 * a4 + 1]) + (o[4 * a4 + 2] + o[4 * a4 + 3]); }
            const float mean = wave_sum(s) * (1.f / D); float s2 = 0.f;
#pragma unroll
            for (int j = 0; j < 16; ++j) { o[j] -= mean; s2 += o[j] * o[j]; }
            const float rstd = 1.f / sqrtf(wave_sum(s2) * (1.f / D) + LN_EPS);
#pragma unroll
            for (int a4 = 0; a4 < 4; ++a4) { const int hf = a4 >> 1, kh = a4 & 1, c0 = 16 * si + 256 * ((sq >> 1) + 2 * kh) + 8 * hf + 4 * (sq & 1);
                const f32x4 ga = *(const GAS f32x4*)(F.in[I_LN2G] + c0), ba = *(const GAS f32x4*)(F.in[I_LN2B] + c0);
                f32x4 y; y.x = o[4 * a4 + 0] * rstd * ga.x + ba.x; y.y = o[4 * a4 + 1] * rstd * ga.y + ba.y; y.z = o[4 * a4 + 2] * rstd * ga.z + ba.z; y.w = o[4 * a4 + 3] * rstd * ga.w + ba.w;
                *(GAS f32x4*)(F.out + (tokA + t) * D + c0) = y; }
        }
    }
}

struct Args { const float* in[26]; float* out; unsigned char* ws; int ph_lo, ph_hi, li, pad; };
__global__ void __launch_bounds__(NWAVES * 64, 2) fwd_kernel(Args args) {
    extern __shared__ __attribute__((aligned(16))) unsigned char lds[];
    Frame F;
    F.lds = (LAS unsigned char*)lds;
    F.MISC = (volatile LAS unsigned*)(F.lds + MISC_OFF);
    F.tid = threadIdx.x; F.lane = F.tid & 63; F.wave = __builtin_amdgcn_readfirstlane(F.tid >> 6);
    F.G = gridDim.x; { const int bx = blockIdx.x; F.vcu = (F.G % 8 == 0) ? (bx % 8) * (F.G / 8) + bx / 8 : bx; }
#pragma unroll
    for (int i = 0; i < 26; ++i) F.in[i] = args.in[i];
    F.out = args.out; F.ws = args.ws;
    unsigned char* ws = args.ws;
    F.ctl = (gu32*)(ws + WS_CTL);
    for (int u = F.tid; u < (LDS_BYTES - LDSCTL_OFF) / 4; u += NWAVES * 64) ((LAS unsigned*)(F.lds + LDSCTL_OFF))[u] = 0u;
    __syncthreads();
    XcdBarrier bar; bar.bar = (unsigned*)(F.ctl + CW_BAR); bar.x = 0; bar.st = nullptr;
    if (N_LAUNCHES == 1) bar = xcd_barrier_post((unsigned*)(F.ctl + CW_BAR), F.MISC + 8);
#define GRID_BAR() do { if (N_LAUNCHES == 1) xcd_barrier(bar); } while (0)
    const int lo = args.ph_lo, hi = args.ph_hi;
#define IN(k) (lo <= (k) && (k) < hi)
#define BOTH(k) (IN(k) && IN((k) + 1))
    bf16* const Hb = (bf16*)(ws + WS_H);
    bf16* const PRJ = (bf16*)(ws + WS_PROJ);

    if (IN(0)) { p0_prologue(F); if (BOTH(0)) GRID_BAR(); }

    if (IN(1)) {
        s5_tables_stage1(F);
        pg8::Gemm g{Hb, (const bf16*)(ws + WS_WIN), M, NPROJ, D, D, D}; pg8::StaticOrder S; S.init(M, NPROJ, F.G, (int)blockIdx.x);
        pg8::EpiProj E{PRJ, PRJ + (size_t)M * 512, PRJ + (size_t)2 * M * 512, PRJ + (size_t)3 * M * 512, (bf16*)(ws + WS_A5), (const float*)(ws + WS_LB), M};
        pg8::gemm_phase<pg8::EpiProj, pg8::StaticOrder, true, true>(F.lds + RING_OFF, g, S, E);
        if (BOTH(1)) GRID_BAR();
    }

    if (IN(2)) {
        s5_tables_stage2(F);
        if (F.vcu < 128) hgrn2_state_pass(F, F.vcu);
        else { pg8::Gemm g{(const bf16*)(ws + WS_A5), (const bf16*)(ws + WS_G5), 32 * S5I, 32 * 256, 512, S5K, 512}; pg8::GroupedOrder S{4, 1, F.G - 128, F.vcu - 128};
            pg8::EpiS5A E{(float*)(ws + WS_XLOC)};
            pg8::gemm_phase<pg8::EpiS5A, pg8::GroupedOrder, true, true>(F.lds + RING_OFF, g, S, E);
        }
        { constexpr int NTAB16 = PE * D / 16, NCHUNK = 2 * NTAB16 / 4096;
          for (;;) {
              if (F.tid == 0) F.MISC[4] = xb_add((unsigned*)(F.ctl + CW_CONV), 1u);
              __syncthreads();
              const int ch = (int)F.MISC[4];
              __syncthreads();
              if (ch >= NCHUNK) break;
#pragma unroll 2
              for (int q8 = 0; q8 < 8; ++q8) { const int i = ch * 4096 + q8 * 512 + F.tid; const bool up = i >= NTAB16; const int j = up ? i - NTAB16 : i; const float* src = (up ? F.in[I_PU] : F.in[I_PD]) + (size_t)j * 16; const float sc = up ? PU_SCALE : PD_SCALE;
                  v4u o; unsigned ow[4];
#pragma unroll
                  for (int q = 0; q < 4; ++q) { const f32x4 a = *(const GAS f32x4*)(src + 4 * q); int pk = __builtin_amdgcn_cvt_pk_fp8_f32(a.x * sc, a.y * sc, 0, false); pk = __builtin_amdgcn_cvt_pk_fp8_f32(a.z * sc, a.w * sc, pk, true); ow[q] = (unsigned)pk; }
                  o.x = ow[0]; o.y = ow[1]; o.z = ow[2]; o.w = ow[3];
                  *(GAS v4u*)(ws + (up ? WS_PU : WS_PD) + (size_t)j * 16) = o; }
          } }
        if (BOTH(2)) GRID_BAR();
    }

    if (IN(3)) {
        if (F.vcu < 32) s5_scan(F, F.vcu * 512 + F.tid);
        hgrn2_out_phase(F);
        if (BOTH(3)) GRID_BAR();
    }

    if (IN(4)) {
        pg8::Gemm g{(const bf16*)(ws + WS_A5), (const bf16*)(ws + WS_T5), 32 * S5I, 32 * 512, S5K, S5K, S5K}; pg8::GroupedOrder S{4, 2, F.G, F.vcu};
        pg8::EpiS5C E{(bf16*)(ws + WS_Z)};
        pg8::gemm_phase<pg8::EpiS5C, pg8::GroupedOrder, true, true>(F.lds + RING_OFF, g, S, E);
        if (BOTH(4)) GRID_BAR();
    }

    if (IN(5)) {
        pg8::Gemm g{(const bf16*)(ws + WS_Z), (const bf16*)(ws + WS_WGLU), M, 512, 512, 512, 512}; pg8::StaticOrder S; S.init(M, 512, F.G, (int)blockIdx.x);
        pg8::EpiGlu E{(const bf16*)(ws + WS_Z), (bf16*)(ws + WS_MIX), F.in[I_BGLU]};
        pg8::gemm_phase<pg8::EpiGlu, pg8::StaticOrder, true, true>(F.lds + RING_OFF, g, S, E);
        if (BOTH(5)) GRID_BAR();
    }

    if (IN(6)) {
        pg8::Gemm g{(const bf16*)(ws + WS_MIX), (const bf16*)(ws + WS_WOUT), M, D, D, D, D}; pg8::StaticOrder S; S.init(M, D, F.G, (int)blockIdx.x);
        pg8::EpiOut E{Hb, DN_ALPHA};
        pg8::gemm_phase<pg8::EpiOut, pg8::StaticOrder, true, true>(F.lds + RING_OFF, g, S, E);
        if (BOTH(6)) GRID_BAR();
    }

    if (IN(7)) {
        const int gw = F.vcu * NWAVES + F.wave, NGW = F.G * NWAVES;
        for (int m = gw; m < M; m += NGW) ln1_row(Hb + (size_t)m * D, F.in[I_LN1G], F.in[I_LN1B], F.lane);
        if (BOTH(7)) GRID_BAR();
    }

    if (IN(8)) {
        pg8::Gemm g{Hb, (const bf16*)(ws + WS_WQ), M, NQ2, D, D, D}; pg8::StaticOrder S; S.init(M, NQ2, F.G, (int)blockIdx.x);
        pg8::EpiStore E{(bf16*)(ws + WS_Q2), NQ2};
        pg8::gemm_phase<pg8::EpiStore, pg8::StaticOrder, true, true>(F.lds + RING_OFF, g, S, E);
        VM_WAIT(); __syncthreads();
        if (F.tid == 0) { __builtin_amdgcn_fence(__ATOMIC_ACQUIRE, "agent"); VM_WAIT(); }
        __syncthreads();
        peer_score_phase(F, S);
        if (BOTH(8)) GRID_BAR();
    }

    if (IN(9)) { peer_gather_phase(F); }
#undef IN
#undef BOTH
}

extern "C" void kernel_launch(void* const* d_in, const int* in_sizes, int n_in, void* d_out, int out_size, void* d_ws, size_t ws_size, hipStream_t stream) {
    static int grid = 0;
    if (grid == 0) {
        if (n_in != 26 || in_sizes[0] != M * D || out_size != M * D || ws_size < WS_END) { fprintf(stderr, "kernel_launch: unexpected shapes: n_in %d in0 %d out %d ws %zu (need %zu)\n", n_in, n_in > 0 ? in_sizes[0] : -1, out_size, ws_size, (size_t)WS_END); grid = -1; return; }
        int dev = 0, cus = 0;
        if (hipGetDevice(&dev) != hipSuccess || hipDeviceGetAttribute(&cus, hipDeviceAttributeMultiprocessorCount, dev) != hipSuccess) { grid = -1; return; }
        if (hipFuncSetAttribute((const void*)fwd_kernel, hipFuncAttributeMaxDynamicSharedMemorySize, LDS_BYTES) != hipSuccess) { fprintf(stderr, "kernel_launch: hipFuncSetAttribute failed\n"); grid = -1; return; }
        (void)hipGetLastError();
        grid = cus;
    }
    if (grid < 0) return;
    if (hipMemsetAsync((char*)d_ws + WS_CTL, 0, CTL_ZERO_BYTES, stream) != hipSuccess) return;
    Args a{};
    for (int i = 0; i < 26; ++i) a.in[i] = (const float*)d_in[i];
    a.out = (float*)d_out; a.ws = (unsigned char*)d_ws;
    if (N_LAUNCHES == 1) { a.ph_lo = 0; a.ph_hi = NPH; a.li = 0; hipLaunchKernelGGL(fwd_kernel, dim3(grid), dim3(NWAVES * 64), LDS_BYTES, stream, a); }
    else for (int li = 0; li < NPH; ++li) { a.ph_lo = li; a.ph_hi = li + 1; a.li = li; hipLaunchKernelGGL(fwd_kernel, dim3(grid), dim3(NWAVES * 64), LDS_BYTES, stream, a); }
}
```

```cpp
#include <hip/hip_runtime.h>
#include <cstdio>
#include <cstdint>
namespace pg8 {
#define PG8_LAS __attribute__((address_space(3)))
typedef unsigned short bf16_t;
typedef short bf16x8 __attribute__((ext_vector_type(8)));
typedef float f32x4 __attribute__((ext_vector_type(4)));
typedef unsigned u32x4 __attribute__((ext_vector_type(4)));
constexpr int BM = 256, BK = 64, HALF = 128, HTB = HALF * BK * 2  , STAGE_BYTES = 8 * HTB, NXCD = 8, WGM = 8;

__host__ __device__ __forceinline__ int lds_byte(int r, int c) { const int st = (r >> 4) * 2 + (c >> 5), rr = r & 15, cc = c & 31, ob = rr * 64 + cc * 2; return st * 1024 + (ob ^ (((ob >> 9) & 1) << 5)); }
__host__ __device__ __forceinline__ void stage_rc(int b, int& R, int& C) { const int st = b / 1024, sb = b % 1024, swz = sb ^ (((sb >> 9) & 1) << 5); R = (st >> 1) * 16 + swz / 64; C = (st & 1) * 32 + (swz % 64) / 2; }
__host__ __device__ __forceinline__ int perm32(int rho) { const int n = rho >> 4, i = rho & 15; return 8 * (i >> 2) + 4 * n + (i & 3); }

struct Unit { int pm, pn; };
struct Gemm { const bf16_t* A; const bf16_t* Bt; int M, N, K, lda, ldb; };

struct StaticOrder {
    int nM, nN, nwg, G, c;
    __host__ __device__ void init(int M, int N, int G_, int c_) { nM = M / BM; nN = N / BM; nwg = nM * nN; G = G_; c = c_; }
    __host__ __device__ bool next(int i, Unit& u) const {
        const long L = (long)i * G + c; if (L >= nwg) return false;
        int wgid = (int)L; { const int q = nwg / NXCD, r = nwg % NXCD, xcd = wgid % NXCD, off = wgid / NXCD; wgid = (xcd < r ? xcd * (q + 1) : r * (q + 1) + (xcd - r) * q) + off; }
        const int nig = WGM * nN, gid = wgid / nig, fm = gid * WGM, gsz = (nM - fm) < WGM ? (nM - fm) : WGM;
        u.pm = fm + ((wgid % nig) % gsz); u.pn = (wgid % nig) / gsz; return true;
    }
    __device__ __forceinline__ void a_ready(const Unit&) const {}
    __device__ __forceinline__ void done(const Unit&) const {}
};

__device__ __forceinline__ unsigned cvt_pk_bf16(float lo, float hi) { unsigned r; asm volatile("v_cvt_pk_bf16_f32 %0, %1, %2" : "=v"(r) : "v"(lo), "v"(hi)); return r; }
__device__ __forceinline__ void unpack8(const u32x4 w, float (&f)[8]) {
    f[0] = __builtin_bit_cast(float, w.x << 16); f[1] = __builtin_bit_cast(float, w.x & 0xffff0000u);
    f[2] = __builtin_bit_cast(float, w.y << 16); f[3] = __builtin_bit_cast(float, w.y & 0xffff0000u);
    f[4] = __builtin_bit_cast(float, w.z << 16); f[5] = __builtin_bit_cast(float, w.z & 0xffff0000u);
    f[6] = __builtin_bit_cast(float, w.w << 16); f[7] = __builtin_bit_cast(float, w.w & 0xffff0000u);
}
__device__ __forceinline__ u32x4 pack8(const float (&f)[8]) { u32x4 w; w.x = cvt_pk_bf16(f[0], f[1]); w.y = cvt_pk_bf16(f[2], f[3]); w.z = cvt_pk_bf16(f[4], f[5]); w.w = cvt_pk_bf16(f[6], f[7]); return w; }

struct EpiStore {
    static constexpr bool PERM = true, AFTER_DRAIN = false;
    bf16_t* O; int ldc;
    __device__ __forceinline__ void operator()(const f32x4 (&acc)[2][2][4][2], const Unit& u, int wr, int wc, int fr, int fq) const {
        const int row0 = u.pm * BM + wr * 64 + fr, col0 = u.pn * BM + wc * 32 + 8 * fq;
#pragma unroll
        for (int ai = 0; ai < 2; ++ai)
#pragma unroll
            for (int m = 0; m < 4; ++m) { bf16_t* rowp = O + (size_t)(row0 + ai * HALF + m * 16) * ldc + col0;
#pragma unroll
                for (int bj = 0; bj < 2; ++bj) { const f32x4 v0 = acc[ai][bj][m][0], v1 = acc[ai][bj][m][1];
                    u32x4 w; w.x = cvt_pk_bf16(v0[0], v0[1]); w.y = cvt_pk_bf16(v0[2], v0[3]); w.z = cvt_pk_bf16(v1[0], v1[1]); w.w = cvt_pk_bf16(v1[2], v1[3]);
                    *(u32x4*)(rowp + bj * HALF) = w; } }
    }
};

struct EpiProj {
    static constexpr bool PERM = true, AFTER_DRAIN = false;
    bf16_t* Qb; bf16_t* LFb; bf16_t* Vb; bf16_t* Gb; bf16_t* Ub; const float* lb; int M;
    __device__ __forceinline__ void operator()(const f32x4 (&acc)[2][2][4][2], const Unit& u, int wr, int wc, int fr, int fq) const {
        const int row0 = u.pm * BM + wr * 64 + fr; const int colt = u.pn * BM; const int t = colt >> 9;
        const int cb = (colt & 511) + wc * 32 + 8 * fq;
        float lbv[2][8];
        if (t == 1) {
#pragma unroll
            for (int bj = 0; bj < 2; ++bj) { const f32x4 a = *(const f32x4*)(lb + cb + bj * HALF), b = *(const f32x4*)(lb + cb + bj * HALF + 4);
                lbv[bj][0] = a[0]; lbv[bj][1] = a[1]; lbv[bj][2] = a[2]; lbv[bj][3] = a[3]; lbv[bj][4] = b[0]; lbv[bj][5] = b[1]; lbv[bj][6] = b[2]; lbv[bj][7] = b[3]; }
        }
#pragma unroll
        for (int ai = 0; ai < 2; ++ai)
#pragma unroll
            for (int m = 0; m < 4; ++m) { const int row = row0 + ai * HALF + m * 16;
#pragma unroll
                for (int bj = 0; bj < 2; ++bj) { const f32x4 v0 = acc[ai][bj][m][0], v1 = acc[ai][bj][m][1]; const int c = cb + bj * HALF;
                    float f[8] = {v0[0], v0[1], v0[2], v0[3], v1[0], v1[1], v1[2], v1[3]};
                    if (t == 0) {
#pragma unroll
                        for (int j = 0; j < 8; ++j) f[j] *= 0.08838834764831845f;
                        *(u32x4*)(Qb + (size_t)row * 512 + c) = pack8(f);
                    } else if (t == 1) {
#pragma unroll
                        for (int j = 0; j < 8; ++j) { const float l = lbv[bj][j]; const float sg = 1.f / (1.f + __expf(-f[j])); f[j] = __logf(l + (1.f - l) * sg); }
                        *(u32x4*)(LFb + (size_t)row * 512 + c) = pack8(f);
                    } else if (t == 2) { *(u32x4*)(Vb + (size_t)row * 512 + c) = pack8(f);
                    } else if (t == 3) { *(u32x4*)(Gb + (size_t)row * 512 + c) = pack8(f);
                    } else { *(u32x4*)(Ub + ((size_t)(c >> 4) * (M / 32) + (row >> 5)) * 640 + (row & 31) * 16 + (c & 15)) = pack8(f); }
                } }
    }
};

struct EpiGlu {
    static constexpr bool PERM = true, AFTER_DRAIN = false;
    const bf16_t* Z; bf16_t* MIX; const float* bglu;
    __device__ __forceinline__ void operator()(const f32x4 (&acc)[2][2][4][2], const Unit& u, int wr, int wc, int fr, int fq) const {
        const int row0 = u.pm * BM + wr * 64 + fr, col0 = u.pn * BM + wc * 32 + 8 * fq;
#pragma unroll
        for (int bj = 0; bj < 2; ++bj) { const int c = col0 + bj * HALF;
            const f32x4 b0 = *(const f32x4*)(bglu + c), b1 = *(const f32x4*)(bglu + c + 4);
#pragma unroll
            for (int ai = 0; ai < 2; ++ai)
#pragma unroll
                for (int m = 0; m < 4; ++m) { const int row = row0 + ai * HALF + m * 16;
                    const f32x4 v0 = acc[ai][bj][m][0] + b0, v1 = acc[ai][bj][m][1] + b1;
                    float z[8]; unpack8(*(const u32x4*)(Z + (size_t)row * 512 + c), z);
                    float f[8] = {v0[0], v0[1], v0[2], v0[3], v1[0], v1[1], v1[2], v1[3]};
#pragma unroll
                    for (int j = 0; j < 8; ++j) f[j] = z[j] / (1.f + __expf(-f[j]));
                    *(u32x4*)(MIX + (size_t)row * 1024 + 512 + c) = pack8(f); } }
    }
};

struct EpiOut {
    static constexpr bool PERM = true, AFTER_DRAIN = false;
    bf16_t* H; float alpha;
    __device__ __forceinline__ void operator()(const f32x4 (&acc)[2][2][4][2], const Unit& u, int wr, int wc, int fr, int fq) const {
        const int row0 = u.pm * BM + wr * 64 + fr, col0 = u.pn * BM + wc * 32 + 8 * fq;
#pragma unroll
        for (int ai = 0; ai < 2; ++ai)
#pragma unroll
            for (int m = 0; m < 4; ++m) { bf16_t* rowp = H + (size_t)(row0 + ai * HALF + m * 16) * 1024 + col0;
#pragma unroll
                for (int bj = 0; bj < 2; ++bj) { const f32x4 v0 = acc[ai][bj][m][0], v1 = acc[ai][bj][m][1];
                    float h[8]; unpack8(*(const u32x4*)(rowp + bj * HALF), h);
                    float f[8] = {v0[0], v0[1], v0[2], v0[3], v1[0], v1[1], v1[2], v1[3]};
#pragma unroll
                    for (int j = 0; j < 8; ++j) f[j] = alpha * h[j] + f[j];
                    *(u32x4*)(rowp + bj * HALF) = pack8(f); } }
    }
};

struct GroupedOrder {
    int tm, tn, G, c;
    __device__ bool next(int i, Unit& u) const { const int L = i * G + c, per = tm * tn; if (c < 0 || L >= 32 * per) return false;
        const int g = L / per, r = L % per; u.pm = g * tm + r % tm; u.pn = g * tn + r / tm; return true; }
    __device__ __forceinline__ void a_ready(const Unit&) const {}
    __device__ __forceinline__ void done(const Unit&) const {}
};
struct EpiS5A {
    static constexpr bool PERM = true, AFTER_DRAIN = false;
    float* X;
    __device__ __forceinline__ void operator()(const f32x4 (&acc)[2][2][4][2], const Unit& u, int wr, int wc, int fr, int fq) const {
        const int g = u.pn, inst0 = (u.pm & 3) * BM + wr * 64 + fr, col = wc * 32 + 8 * fq;
#pragma unroll
        for (int ai = 0; ai < 2; ++ai)
#pragma unroll
            for (int m = 0; m < 4; ++m) { float* p = X + ((size_t)(inst0 + ai * HALF + m * 16) * 32 + g) * 128 + col;
                *(f32x4*)p = acc[ai][0][m][0]; *(f32x4*)(p + 4) = acc[ai][0][m][1]; }
    }
};
struct EpiS5C {
    static constexpr bool PERM = true, AFTER_DRAIN = false;
    bf16_t* Z;
    __device__ __forceinline__ void operator()(const f32x4 (&acc)[2][2][4][2], const Unit& u, int wr, int wc, int fr, int fq) const {
        const int g = u.pm >> 2, inst0 = (u.pm & 3) * BM + wr * 64 + fr, col0 = (u.pn & 1) * BM + wc * 32 + 8 * fq;
#pragma unroll
        for (int ai = 0; ai < 2; ++ai)
#pragma unroll
            for (int m = 0; m < 4; ++m) { const int inst = inst0 + ai * HALF + m * 16; const size_t tok0 = (size_t)(inst >> 7) * 4096 + (size_t)(inst & 127) * 32;
#pragma unroll
                for (int bj = 0; bj < 2; ++bj) { const int col = col0 + bj * HALF; const f32x4 v0 = acc[ai][bj][m][0], v1 = acc[ai][bj][m][1];
                    float f[8] = {v0[0], v0[1], v0[2], v0[3], v1[0], v1[1], v1[2], v1[3]};
#pragma unroll
                    for (int j = 0; j < 8; ++j) { const float x = f[j], y = 0.7978845608028654f * (x + 0.044715f * x * x * x); f[j] = x / (1.f + __expf(-2.f * y)); }
                    *(u32x4*)(Z + (tok0 + (col >> 4)) * 512 + g * 16 + (col & 15)) = pack8(f); } }
    }
};

template <class Epi, class Sched, bool ALIGN_EPI = false, bool SP2 = false>
__device__ __forceinline__ void gemm_phase(PG8_LAS unsigned char* lds, const Gemm g, const Sched& S, const Epi& E) {
    const int tid = threadIdx.x, wid = __builtin_amdgcn_readfirstlane(tid >> 6), lane = tid & 63, wr = wid >> 2, wc = wid & 3, fr = lane & 15, fq = lane >> 4;
    const int K = g.K, nt = K / BK;
    unsigned voffA[2], voffB[2];
#pragma unroll
    for (int i = 0; i < 2; ++i) { int R, C; stage_rc(tid * 16 + i * 8192, R, C); const int Rb = Epi::PERM ? ((R & ~31) + perm32(R & 31)) : R;
        voffA[i] = (unsigned)(R * g.lda + C) * 2u; voffB[i] = (unsigned)(Rb * g.ldb + C) * 2u; }
    const size_t kstep = (size_t)(BK * 2);
    const size_t hstepA = (size_t)HALF * g.lda * 2, hstepB = (size_t)HALF * g.ldb * 2;
    const size_t tstepA = 2 * hstepA, tstepB = 2 * hstepB;
    const unsigned ldsw = (unsigned)wid * 1024u;
    const int aoff = lds_byte(wr * 64 + fr, fq * 8), boff = lds_byte(wc * 32 + fr, fq * 8);
#define PG8_SA(b, h) (((b) * 2 + (h)) * HTB)
#define PG8_SB(b, h) ((4 + (b) * 2 + (h)) * HTB)
#define PG8_STAGE(bufoff, gbase, voff) do { _Pragma("unroll") for (int _i = 0; _i < 2; ++_i) \
        __builtin_amdgcn_global_load_lds((const unsigned*)((const char*)(gbase) + (voff)[_i]), (PG8_LAS unsigned*)(lds + (bufoff) + ldsw + _i * 8192), 16, 0, 0); } while (0)
#define PG8_LDA(dst, b, h) do { _Pragma("unroll") for (int m = 0; m < 4; ++m) _Pragma("unroll") for (int k = 0; k < 2; ++k) dst[m][k] = *(const PG8_LAS bf16x8*)(lds + PG8_SA(b, h) + aoff + m * 2048 + k * 1024); } while (0)
#define PG8_LDB(dst, b, h) do { _Pragma("unroll") for (int n = 0; n < 2; ++n) _Pragma("unroll") for (int k = 0; k < 2; ++k) dst[n][k] = *(const PG8_LAS bf16x8*)(lds + PG8_SB(b, h) + boff + n * 2048 + k * 1024); } while (0)
#define PG8_MMA(ai, bj, At, Bt) do { __builtin_amdgcn_s_setprio(1); _Pragma("unroll") for (int m = 0; m < 4; ++m) _Pragma("unroll") for (int n = 0; n < 2; ++n) _Pragma("unroll") for (int k = 0; k < 2; ++k) \
        acc[ai][bj][m][n] = __builtin_amdgcn_mfma_f32_16x16x32_bf16(Bt[n][k], At[m][k], acc[ai][bj][m][n], 0, 0, 0); __builtin_amdgcn_s_setprio(0); } while (0)
#define PG8_WAIT_V(n) asm volatile("s_waitcnt vmcnt(" #n ")" ::: "memory")
#define PG8_WAIT_L(n) asm volatile("s_waitcnt lgkmcnt(" #n ")" ::: "memory")
#define PG8_BAR __builtin_amdgcn_s_barrier()
#define PG8_SCHED __builtin_amdgcn_sched_barrier(0)
    Unit cur, nxt; int ui = 0;
    if (!S.next(0, cur)) return;
    f32x4 acc[2][2][4][2];
#pragma unroll
    for (int a = 0; a < 2; ++a)
#pragma unroll
        for (int b = 0; b < 2; ++b)
#pragma unroll
            for (int m = 0; m < 4; ++m)
#pragma unroll
                for (int n = 0; n < 2; ++n) acc[a][b][m][n] = (f32x4){0.f, 0.f, 0.f, 0.f};
    bf16x8 At[4][2], B0[2][2], B1[2][2];
    const char* cA = (const char*)g.A + (size_t)cur.pm * tstepA; const char* cB = (const char*)g.Bt + (size_t)cur.pn * tstepB;
    S.a_ready(cur);
    if constexpr (SP2) {
        PG8_STAGE(PG8_SB(0, 0), cB, voffB); PG8_STAGE(PG8_SB(0, 1), cB + hstepB, voffB); PG8_STAGE(PG8_SA(0, 0), cA, voffA); PG8_STAGE(PG8_SA(0, 1), cA + hstepA, voffA);
        if (wr == 1) PG8_BAR;
        PG8_WAIT_V(2); PG8_BAR;
        PG8_STAGE(PG8_SB(1, 0), cB + kstep, voffB); PG8_STAGE(PG8_SA(1, 0), cA + kstep, voffA); PG8_STAGE(PG8_SB(1, 1), cB + hstepB + kstep, voffB);
        PG8_WAIT_V(6); PG8_BAR;
    } else {
        PG8_STAGE(PG8_SB(0, 0), cB, voffB); PG8_STAGE(PG8_SA(0, 0), cA, voffA); PG8_STAGE(PG8_SB(0, 1), cB + hstepB, voffB); PG8_STAGE(PG8_SA(0, 1), cA + hstepA, voffA);
        if (wr == 1) PG8_BAR;
        PG8_WAIT_V(4); PG8_BAR;
        PG8_STAGE(PG8_SB(1, 0), cB + kstep, voffB); PG8_STAGE(PG8_SA(1, 0), cA + kstep, voffA); PG8_STAGE(PG8_SB(1, 1), cB + hstepB + kstep, voffB);
        PG8_WAIT_V(6); PG8_BAR;
    }
    for (;;) {
        const bool has_next = S.next(ui + 1, nxt);
        const char* nA = has_next ? (const char*)g.A + (size_t)nxt.pm * tstepA : cA; const char* nB = has_next ? (const char*)g.Bt + (size_t)nxt.pn * tstepB : cB;
        for (int t = 0; t < nt; t += 2) {
            const bool last = (t == nt - 2);
            const char* a1 = cA + (size_t)(t + 1) * kstep;
            const char* a2 = last ? nA : cA + (size_t)(t + 2) * kstep; const char* b2 = last ? nB : cB + (size_t)(t + 2) * kstep;
            const char* a3 = a2 + kstep; const char* b3 = b2 + kstep;
            if (last && has_next) S.a_ready(nxt);
            if constexpr (SP2) {
            PG8_LDB(B0, 0, 0); PG8_LDB(B1, 0, 1); PG8_SCHED; PG8_LDA(At, 0, 0); PG8_STAGE(PG8_SA(1, 1), a1 + hstepA, voffA);
            PG8_WAIT_V(8); PG8_WAIT_L(0); PG8_BAR; PG8_MMA(0, 0, At, B0); PG8_MMA(0, 1, At, B1); PG8_BAR; PG8_SCHED;
            PG8_LDA(At, 0, 1); PG8_STAGE(PG8_SB(0, 0), b2, voffB); PG8_STAGE(PG8_SB(0, 1), b2 + hstepB, voffB); PG8_STAGE(PG8_SA(0, 0), a2, voffA);
            PG8_WAIT_V(8); PG8_WAIT_L(0); PG8_BAR; PG8_MMA(1, 0, At, B0); PG8_MMA(1, 1, At, B1); PG8_BAR; PG8_SCHED;
            PG8_LDB(B0, 1, 0); PG8_LDB(B1, 1, 1); PG8_SCHED; PG8_LDA(At, 1, 0); PG8_STAGE(PG8_SA(0, 1), a2 + hstepA, voffA);
            PG8_WAIT_V(8); PG8_WAIT_L(0); PG8_BAR; PG8_MMA(0, 0, At, B0); PG8_MMA(0, 1, At, B1); PG8_BAR; PG8_SCHED;
            PG8_LDA(At, 1, 1); PG8_STAGE(PG8_SB(1, 0), b3, voffB); PG8_STAGE(PG8_SB(1, 1), b3 + hstepB, voffB); PG8_STAGE(PG8_SA(1, 0), a3, voffA);
            PG8_WAIT_V(8); PG8_WAIT_L(0); PG8_BAR; PG8_MMA(1, 0, At, B0); PG8_MMA(1, 1, At, B1); PG8_BAR; PG8_SCHED;
            } else {
            PG8_LDB(B0, 0, 0); PG8_SCHED; PG8_LDA(At, 0, 0); PG8_STAGE(PG8_SA(1, 1), a1 + hstepA, voffA);
            PG8_WAIT_L(8); PG8_BAR; PG8_WAIT_L(0); PG8_MMA(0, 0, At, B0); PG8_BAR; PG8_SCHED;
            PG8_LDB(B1, 0, 1); PG8_STAGE(PG8_SB(0, 0), b2, voffB);
            PG8_BAR; PG8_WAIT_L(0); PG8_MMA(0, 1, At, B1); PG8_BAR;
            PG8_LDA(At, 0, 1); PG8_STAGE(PG8_SA(0, 0), a2, voffA);
            PG8_BAR; PG8_WAIT_L(0); PG8_MMA(1, 0, At, B0); PG8_BAR; PG8_SCHED;
            PG8_STAGE(PG8_SB(0, 1), b2 + hstepB, voffB);
            PG8_WAIT_V(6); PG8_BAR; PG8_MMA(1, 1, At, B1); PG8_BAR;
            PG8_LDB(B0, 1, 0); PG8_SCHED; PG8_LDA(At, 1, 0); PG8_STAGE(PG8_SA(0, 1), a2 + hstepA, voffA);
            PG8_WAIT_L(8); PG8_BAR; PG8_WAIT_L(0); PG8_MMA(0, 0, At, B0); PG8_BAR; PG8_SCHED;
            PG8_LDB(B1, 1, 1); PG8_STAGE(PG8_SB(1, 0), b3, voffB);
            PG8_BAR; PG8_WAIT_L(0); PG8_MMA(0, 1, At, B1); PG8_BAR;
            PG8_LDA(At, 1, 1); PG8_STAGE(PG8_SA(1, 0), a3, voffA);
            PG8_BAR; PG8_WAIT_L(0); PG8_MMA(1, 0, At, B0); PG8_BAR; PG8_SCHED;
            PG8_STAGE(PG8_SB(1, 1), b3 + hstepB, voffB);
            PG8_WAIT_V(6); PG8_BAR; PG8_MMA(1, 1, At, B1); PG8_BAR;
            }
        }
        if constexpr (ALIGN_EPI) { if (wr == 0) PG8_BAR; }
        if constexpr (!Epi::AFTER_DRAIN) { E(acc, cur, wr, wc, fr, fq); S.done(cur); }
        if (!has_next) break;
#pragma unroll
        for (int a = 0; a < 2; ++a)
#pragma unroll
            for (int b = 0; b < 2; ++b)
#pragma unroll
                for (int m = 0; m < 4; ++m)
#pragma unroll
                    for (int n = 0; n < 2; ++n) acc[a][b][m][n] = (f32x4){0.f, 0.f, 0.f, 0.f};
        cur = nxt; cA = nA; cB = nB; ++ui;
        if constexpr (ALIGN_EPI) { if (wr == 1) PG8_BAR; }
    }
    PG8_WAIT_V(0);
    if constexpr (!ALIGN_EPI) { if (wr == 0) PG8_BAR; }
    PG8_BAR;
    if constexpr (Epi::AFTER_DRAIN) { E.fused(acc, cur, wr, wc, fr, fq, lds, wid, lane); S.done(cur); }
#undef PG8_SA
#undef PG8_SB
#undef PG8_STAGE
#undef PG8_LDA
#undef PG8_LDB
#undef PG8_MMA
#undef PG8_WAIT_V
#undef PG8_WAIT_L
#undef PG8_BAR
#undef PG8_SCHED
}
}

constexpr int NWAVES = 8;
#ifndef MK_N_LAUNCHES
#define MK_N_LAUNCHES 1
#endif
constexpr int N_LAUNCHES = MK_N_LAUNCHES;
constexpr int NPH = 10;
#ifndef PROBE_REP
#define PROBE_REP -1
#endif

constexpr int BATCH = 8, SEQ = 4096, D = 1024, M = BATCH * SEQ;
constexpr int HGW = 512, HGH = 4, HGK = 128;
constexpr int S5W = 512, S5G = 32, S5P = 16, S5N = 64;
constexpr int S5L = 32, S5I = M / S5L, S5K = S5L * S5P + 2 * S5N;
constexpr int NPROJ = 2560;
constexpr int PK = 128, PH = 8, PTOPK = 16, PQ = 256, PHALF = 128, PE = PK * PK, NQ2 = PH * PQ;
constexpr float LN_EPS = 1e-5f, RMS_EPS = 1e-6f;
constexpr float DN_ALPHA = 1.189207115002721f;

constexpr size_t MiB = 1u << 20;
constexpr size_t WS_CTL = 0, CTL_ZERO_BYTES = 1 * MiB;
constexpr size_t WS_WIN = 1 * MiB;
constexpr size_t WS_WGLU = 6 * MiB;
constexpr size_t WS_KEYS = 6 * MiB + 512 * 1024;
constexpr size_t WS_LB = 6 * MiB + 640 * 1024;
constexpr size_t WS_S5T = 6 * MiB + 704 * 1024;
constexpr size_t WS_WOUT = 7 * MiB + 512 * 1024;
constexpr size_t WS_WQ = 10 * MiB;
constexpr size_t WS_SST = 14 * MiB;
constexpr size_t WS_H = 78 * MiB;
constexpr size_t WS_PROJ = 142 * MiB;
constexpr size_t WS_Q2 = WS_PROJ;
constexpr size_t WS_A5 = 270 * MiB;
constexpr size_t WS_MIX = 310 * MiB;
constexpr size_t WS_PD = 452 * MiB, WS_PU = 468 * MiB;
constexpr size_t WS_Z = 374 * MiB;
constexpr size_t WS_EIDX = WS_Z, WS_EGATE = WS_Z + 16 * MiB;
constexpr size_t WS_T5 = 406 * MiB;
constexpr size_t WS_G5 = 426 * MiB;
constexpr size_t WS_XLOC = 434 * MiB;
constexpr size_t WS_KTAU = 450 * MiB;
constexpr size_t WS_PW = 451 * MiB;
constexpr size_t WS_END = 484 * MiB;
constexpr int CW_TMO = 0, CW_CODE = 1;
constexpr int CW_BAR = 4096;
constexpr int CW_CONV = 65536;

constexpr int RING_OFF = 0, RING_BYTES = 147456;
constexpr int LDSCTL_OFF = RING_BYTES, MISC_OFF = LDSCTL_OFF + 320;
constexpr int LDS_BYTES = 151552;
static_assert(MISC_OFF + 128 <= LDS_BYTES, "LDS map");

#define GAS __attribute__((address_space(1)))
#define LAS __attribute__((address_space(3)))
typedef unsigned short bf16;
typedef unsigned v4u __attribute__((ext_vector_type(4)));
typedef float f32x4 __attribute__((ext_vector_type(4)));
typedef short bf16x8 __attribute__((ext_vector_type(8)));
typedef GAS unsigned gu32;
typedef GAS unsigned long long gu64;
#define RLX_AGENT __ATOMIC_RELAXED, __HIP_MEMORY_SCOPE_AGENT
#define LDS_WAIT() asm volatile("s_waitcnt lgkmcnt(0)" ::: "memory")
#define VM_WAIT() asm volatile("s_waitcnt vmcnt(0)" ::: "memory")
__device__ __forceinline__ unsigned long long rt() { return __builtin_amdgcn_s_memrealtime(); }
__device__ __forceinline__ unsigned f2bf(float f) { unsigned u = __builtin_bit_cast(unsigned, f); return (u + 0x7fffu + ((u >> 16) & 1u)) >> 16; }
__device__ __forceinline__ unsigned pk2(float lo, float hi) { return f2bf(lo) | (f2bf(hi) << 16); }

#define XB_TMO      128
#define XB_XCNT(j)  (256  + 64 * (j))
#define XB_XSUB(j)  (1280 + 64 * (j))
#define XB_XGEN(j)  (2304 + 64 * (j))
#define XB_TOP      3328
#define XB_TOPGEN   3392
#define XCD_BAR_WORDS 3456
#define XB_SPIN_CAP (1u << 18)

__device__ __forceinline__ unsigned xb_ld(unsigned* p)              { return __hip_atomic_load(p, __ATOMIC_RELAXED, __HIP_MEMORY_SCOPE_AGENT); }
__device__ __forceinline__ unsigned xb_add(unsigned* p, unsigned v) { return __hip_atomic_fetch_add(p, v, __ATOMIC_RELAXED, __HIP_MEMORY_SCOPE_AGENT); }
__device__ __forceinline__ unsigned xb_xcc_id() { return (unsigned)__builtin_amdgcn_s_getreg((3 << 11) | 20) & 0xFu; }
#define XB_SPIN(cond, bar) do { unsigned _sp = 0; while (cond) { __builtin_amdgcn_s_sleep(1); \
    if ((++_sp & 255u) == 0u) { if (xb_ld(&(bar)[XB_TMO])) break; if (_sp > XB_SPIN_CAP) { atomicAdd(&(bar)[XB_TMO], 1u); break; } } } } while (0)

struct XcdBarrier {
    unsigned* bar; unsigned x;
    volatile LAS unsigned* st;
};

__device__ __forceinline__ XcdBarrier xcd_barrier_post(unsigned* bar, volatile LAS unsigned* st) {
    XcdBarrier b; b.bar = bar; b.x = xb_xcc_id(); b.st = st;
    if (threadIdx.x == 0) (void)xb_add(&bar[XB_XCNT(b.x)], 1u);
    return b;
}
__device__ __forceinline__ void xcd_barrier_complete(unsigned* bar, unsigned x, unsigned& nloc, unsigned& nx) {
    const unsigned G = gridDim.x * gridDim.y * gridDim.z;
    unsigned sum, cnt, mine, sp = 0u;
    for (;;) {
        sum = 0u; cnt = 0u; mine = 0u;
#pragma unroll
        for (unsigned j = 0; j < 16; ++j) { const unsigned c = xb_ld(&bar[XB_XCNT(j)]); sum += c; cnt += (c > 0u) ? 1u : 0u; mine = (j == x) ? c : mine; }
        if (sum == G) break;
        __builtin_amdgcn_s_sleep(1);
        if ((++sp & 255u) == 0u) { if (xb_ld(&bar[XB_TMO])) break; if (sp > XB_SPIN_CAP) { atomicAdd(&bar[XB_TMO], 1u); break; } }
    }
    nloc = mine > 0u ? mine : 1u; nx = cnt > 0u ? cnt : 1u;
}

__device__ __forceinline__ void xcd_barrier(const XcdBarrier& b) {
    asm volatile("s_waitcnt vmcnt(0)" ::: "memory");
    __syncthreads();
    if (threadIdx.x == 0) {
        unsigned* bar = b.bar;
        __builtin_amdgcn_s_waitcnt(0);
        unsigned nloc = b.st[0], nx = b.st[1];
        if (nloc == 0u) { xcd_barrier_complete(bar, b.x, nloc, nx); b.st[0] = nloc; b.st[1] = nx; }
        const unsigned old = xb_add(&bar[XB_XSUB(b.x)], 1u);
        const unsigned gen = old / nloc;
        if (old + 1u == (gen + 1u) * nloc) {
            __builtin_amdgcn_fence(__ATOMIC_RELEASE, "agent");
            asm volatile("s_waitcnt vmcnt(0)" ::: "memory");
            const unsigned og = xb_add(&bar[XB_TOP], 1u);
            const unsigned tg = og / nx;
            if (og + 1u == (tg + 1u) * nx) xb_add(&bar[XB_TOPGEN], 1u);
            else XB_SPIN(xb_ld(&bar[XB_TOPGEN]) == tg, bar);
            __builtin_amdgcn_fence(__ATOMIC_ACQUIRE, "agent");
            xb_add(&bar[XB_XGEN(b.x)], 1u);
            asm volatile("s_waitcnt vmcnt(0)" ::: "memory");
        } else {
            XB_SPIN(xb_ld(&bar[XB_XGEN(b.x)]) == gen, bar);
            __builtin_amdgcn_fence(__ATOMIC_ACQUIRE, "agent");
            asm volatile("s_waitcnt vmcnt(0)" ::: "memory");
        }
    }
    __syncthreads();
}

struct Frame {
    LAS unsigned char* lds;
    volatile LAS unsigned* MISC;
    gu32* ctl;
    int tid, lane, wave;
    int vcu, G;
    const float* in[26]; float* out; unsigned char* ws;
};
enum { I_X = 0, I_LN0G, I_LN0B, I_WIN, I_LBL, I_HGNG, I_ARE, I_AIM, I_LSTEP, I_BRE, I_BIM, I_CRE, I_CIM, I_DSK, I_WGLU, I_BGLU, I_WOUT, I_LN1G, I_LN1B, I_WQ, I_K1, I_K2, I_PD, I_PU, I_LN2G, I_LN2B };

__device__ __forceinline__ float bf2f(bf16 v) { return __builtin_bit_cast(float, (unsigned)v << 16); }
__device__ __forceinline__ float wave_sum(float v) {
#pragma unroll
    for (int o = 1; o < 64; o <<= 1) v += __shfl_xor(v, o);
    return v;
}
__device__ __forceinline__ float wave_max(float v) {
#pragma unroll
    for (int o = 1; o < 64; o <<= 1) v = fmaxf(v, __shfl_xor(v, o));
    return v;
}
__device__ __forceinline__ float gelu_tanh(float x) { const float y = 0.7978845608028654f * (x + 0.044715f * x * x * x); return x / (1.f + __expf(-2.f * y)); }
__device__ __forceinline__ float silu_f(float x) { return x / (1.f + __expf(-x)); }
__device__ __forceinline__ void unpack8(const v4u w, float (&f)[8]) {
    f[0] = __builtin_bit_cast(float, w.x << 16); f[1] = __builtin_bit_cast(float, w.x & 0xffff0000u);
    f[2] = __builtin_bit_cast(float, w.y << 16); f[3] = __builtin_bit_cast(float, w.y & 0xffff0000u);
    f[4] = __builtin_bit_cast(float, w.z << 16); f[5] = __builtin_bit_cast(float, w.z & 0xffff0000u);
    f[6] = __builtin_bit_cast(float, w.w << 16); f[7] = __builtin_bit_cast(float, w.w & 0xffff0000u);
}
__device__ __forceinline__ v4u pack8(const float (&f)[8]) { v4u w; w.x = pk2(f[0], f[1]); w.y = pk2(f[2], f[3]); w.z = pk2(f[4], f[5]); w.w = pk2(f[6], f[7]); return w; }

__device__ __forceinline__ void p0_transpose_item(const float* W, int K, int N, bf16* WT, int row_off, LAS float* scr, int item, int lane) {
    const int nblk = N / 32, kb = item / nblk, nb = item % nblk, k0 = 64 * kb, n0 = 32 * nb;
#pragma unroll 8
    for (int i = 0; i < 32; ++i) { const int kk = 2 * i + (lane >> 5); scr[kk * 33 + (lane & 31)] = W[(size_t)(k0 + kk) * N + n0 + (lane & 31)]; }
    LDS_WAIT(); asm volatile("" ::: "memory");
    const int c = lane & 7;
#pragma unroll
    for (int j = 0; j < 4; ++j) { const int n = (lane >> 3) + 8 * j; const LAS float* s = scr + (8 * c) * 33 + n;
        v4u o; o.x = pk2(s[0 * 33], s[1 * 33]); o.y = pk2(s[2 * 33], s[3 * 33]); o.z = pk2(s[4 * 33], s[5 * 33]); o.w = pk2(s[6 * 33], s[7 * 33]);
        *(GAS v4u*)(WT + (size_t)(row_off + n0 + n) * K + k0 + 8 * c) = o; }
    LDS_WAIT(); asm volatile("" ::: "memory");
}
__device__ __forceinline__ void ln0_row(const float* xrow, const float* g, const float* b, bf16* orow, int lane) {
    const GAS f32x4* xr = (const GAS f32x4*)xrow + lane;
    f32x4 v[4]; float s = 0.f;
#pragma unroll
    for (int j = 0; j < 4; ++j) { v[j] = xr[64 * j]; s += (v[j].x + v[j].y) + (v[j].z + v[j].w); }
    const float mean = wave_sum(s) * (1.f / D); float s2 = 0.f;
#pragma unroll
    for (int j = 0; j < 4; ++j) { v[j] = v[j] - mean; s2 += (v[j].x * v[j].x + v[j].y * v[j].y) + (v[j].z * v[j].z + v[j].w * v[j].w); }
    const float rstd = 1.f / sqrtf(wave_sum(s2) * (1.f / D) + LN_EPS);
    GAS unsigned long long* o8 = (GAS unsigned long long*)orow + lane;
#pragma unroll
    for (int j = 0; j < 4; ++j) { const f32x4 gg = ((const GAS f32x4*)g)[lane + 64 * j], bb = ((const GAS f32x4*)b)[lane + 64 * j];
        const f32x4 o = v[j] * rstd * gg + bb;
        o8[64 * j] = (unsigned long long)pk2(o.x, o.y) | ((unsigned long long)pk2(o.z, o.w) << 32); }
}
__device__ __forceinline__ void p0_prologue(Frame& F) {
    LAS float* scr = (LAS float*)(F.lds + RING_OFF + F.wave * 16384);
    const int gw = F.vcu * NWAVES + F.wave, NGW = F.G * NWAVES;
    unsigned char* ws = F.ws;
    constexpr int I_IN = (D / 64) * (NPROJ / 32), I_GLU = (512 / 64) * (512 / 32), I_OUT = (1024 / 64) * (1024 / 32), I_Q = (1024 / 64) * (2048 / 32);
    constexpr int NITEMS = I_IN + I_GLU + I_OUT + I_Q;
    for (int it = gw; it < NITEMS; it += NGW) {
        int r = it;
        if (r < I_IN) { p0_transpose_item(F.in[I_WIN], D, NPROJ, (bf16*)(ws + WS_WIN), 0, scr, r, F.lane); continue; } r -= I_IN;
        if (r < I_GLU) { p0_transpose_item(F.in[I_WGLU], 512, 512, (bf16*)(ws + WS_WGLU), 0, scr, r, F.lane); continue; } r -= I_GLU;
        if (r < I_OUT) { p0_transpose_item(F.in[I_WOUT], 1024, 1024, (bf16*)(ws + WS_WOUT), 0, scr, r, F.lane); continue; } r -= I_OUT;
        p0_transpose_item(F.in[I_WQ], 1024, 2048, (bf16*)(ws + WS_WQ), 0, scr, r, F.lane);
    }
    const int gt = gw * 64 + F.lane, NGT = NGW * 64;
    for (int i = gt; i < 2 * PK * PHALF; i += NGT) { const float v = (i < PK * PHALF) ? F.in[I_K1][i] : F.in[I_K2][i - PK * PHALF]; ((bf16*)(ws + WS_KEYS))[i] = (bf16)f2bf(v); }
    for (int i = gt; i < HGW; i += NGT) { const float l0 = F.in[I_LBL][i], l1 = F.in[I_LBL][HGW + i]; ((float*)(ws + WS_LB))[i] = 1.f / (1.f + expf(l1 - l0)); }
    for (int i = gt; i < S5G * S5N; i += NGT) { const int g = i / S5N;
        const float are = F.in[I_ARE][i], aim = F.in[I_AIM][i], step = expf(F.in[I_LSTEP][g]);
        const float zr = step * are, zi = step * aim, mag = expf(zr), cz = cosf(zi), sz = sinf(zi), sh = sinf(0.5f * zi);
        const float abr = mag * cz, abi = mag * sz;
        const float nre = expm1f(zr) * cz - 2.f * sh * sh, nim = abi;
        const float den = are * are + aim * aim;
        const float cre = (nre * are + nim * aim) / den, cim = (nim * are - nre * aim) / den;
        float* t = (float*)(ws + WS_S5T) + (size_t)i * 40; t[0] = abr; t[1] = abi;
        for (int p = 0; p < S5P; ++p) { const float br = F.in[I_BRE][(size_t)i * S5P + p], bi = F.in[I_BIM][(size_t)i * S5P + p];
            t[2 + p] = cre * br - cim * bi; t[18 + p] = cre * bi + cim * br; } }
    for (int i = gt; i < S5G * S5N * 33; i += NGT) { const int gn = i / 33, tau = i % 33, g = gn / S5N;
        const float step = expf(F.in[I_LSTEP][g]), zr = step * F.in[I_ARE][gn] * (float)tau, zi = step * F.in[I_AIM][gn] * (float)tau, mag = expf(zr);
        float* p = (float*)(ws + WS_PW) + (size_t)i * 2; p[0] = mag * cosf(zi); p[1] = mag * sinf(zi); }
    for (int m0 = gw * 4; m0 < M; m0 += NGW * 4) {
        f32x4 v[4][4];
#pragma unroll
        for (int r = 0; r < 4; ++r)
#pragma unroll
            for (int j = 0; j < 4; ++j) v[r][j] = ((const GAS f32x4*)(F.in[I_X] + (size_t)(m0 + r) * D))[F.lane + 64 * j];
        f32x4 gg[4], bb[4];
#pragma unroll
        for (int j = 0; j < 4; ++j) { gg[j] = ((const GAS f32x4*)F.in[I_LN0G])[F.lane + 64 * j]; bb[j] = ((const GAS f32x4*)F.in[I_LN0B])[F.lane + 64 * j]; }
#pragma unroll
        for (int r = 0; r < 4; ++r) { float sm = 0.f;
#pragma unroll
            for (int j = 0; j < 4; ++j) sm += (v[r][j].x + v[r][j].y) + (v[r][j].z + v[r][j].w);
            const float mean = wave_sum(sm) * (1.f / D); float s2 = 0.f;
#pragma unroll
            for (int j = 0; j < 4; ++j) { v[r][j] = v[r][j] - mean; s2 += (v[r][j].x * v[r][j].x + v[r][j].y * v[r][j].y) + (v[r][j].z * v[r][j].z + v[r][j].w * v[r][j].w); }
            const float rstd = 1.f / sqrtf(wave_sum(s2) * (1.f / D) + LN_EPS);
            GAS unsigned long long* o8 = (GAS unsigned long long*)((bf16*)(ws + WS_H) + (size_t)(m0 + r) * D) + F.lane;
#pragma unroll
            for (int j = 0; j < 4; ++j) { const f32x4 o = v[r][j] * rstd * gg[j] + bb[j]; o8[64 * j] = (unsigned long long)pk2(o.x, o.y) | ((unsigned long long)pk2(o.z, o.w) << 32); } }
    }
}

__device__ __forceinline__ void hgrn2_seq(Frame& F, int bh) {
    const int b = bh >> 2, h = bh & 3, tid = F.tid, kq = tid >> 7, j = tid & 127;
    LAS float* sF = (LAS float*)(F.lds + RING_OFF);
    LAS float* sK = sF + 8 * 128; LAS float* sQ = sK + 8 * 128;
    LAS float* sO = sQ + 8 * 128;
    const bf16* Qb = (const bf16*)(F.ws + WS_PROJ); const bf16* LFb = Qb + (size_t)M * 512; const bf16* Vb = LFb + (size_t)M * 512; const bf16* Gb = Vb + (size_t)M * 512;
    bf16* MIX = (bf16*)(F.ws + WS_MIX);
    const float ng0 = F.in[I_HGNG][F.lane], ng1 = F.in[I_HGNG][F.lane + 64];
    float S[32];
#pragma unroll
    for (int k = 0; k < 32; ++k) S[k] = 0.f;
    for (int t0 = 0; t0 < SEQ; t0 += 8) {
        const size_t tok0 = (size_t)b * SEQ + t0;
#pragma unroll
        for (int r = 0; r < 2; ++r) { const int item = tid + 512 * r, tt = item >> 7, kk = item & 127; const size_t off = (tok0 + tt) * 512 + h * 128 + kk;
            const float lf = bf2f(LFb[off]); sF[tt * 128 + kk] = __expf(lf); sK[tt * 128 + kk] = -expm1f(lf); sQ[tt * 128 + kk] = bf2f(Qb[off]); }
        __syncthreads();
#pragma unroll 1
        for (int tt = 0; tt < 8; ++tt) { const float v = bf2f(Vb[(tok0 + tt) * 512 + h * 128 + j]); float o = 0.f;
            const LAS float* f = sF + tt * 128 + kq * 32; const LAS float* kx = sK + tt * 128 + kq * 32; const LAS float* q = sQ + tt * 128 + kq * 32;
#pragma unroll
            for (int k = 0; k < 32; ++k) { S[k] = f[k] * S[k] + kx[k] * v; o += q[k] * S[k]; }
            sO[(tt * 4 + kq) * 128 + j] = o; }
        __syncthreads();
        { const int tt = F.wave; const size_t tok = tok0 + tt;
            const float o0 = (sO[(tt * 4 + 0) * 128 + F.lane] + sO[(tt * 4 + 1) * 128 + F.lane]) + (sO[(tt * 4 + 2) * 128 + F.lane] + sO[(tt * 4 + 3) * 128 + F.lane]);
            const float o1 = (sO[(tt * 4 + 0) * 128 + 64 + F.lane] + sO[(tt * 4 + 1) * 128 + 64 + F.lane]) + (sO[(tt * 4 + 2) * 128 + 64 + F.lane] + sO[(tt * 4 + 3) * 128 + 64 + F.lane]);
            const float ss = wave_sum(o0 * o0 + o1 * o1), r = 1.f / sqrtf(ss * (1.f / 128.f) + RMS_EPS);
            const float g0 = bf2f(Gb[tok * 512 + h * 128 + F.lane]), g1 = bf2f(Gb[tok * 512 + h * 128 + 64 + F.lane]);
            MIX[tok * 1024 + h * 128 + F.lane] = (bf16)f2bf(o0 * r * ng0 * silu_f(g0));
            MIX[tok * 1024 + h * 128 + 64 + F.lane] = (bf16)f2bf(o1 * r * ng1 * silu_f(g1)); }
    }
    __syncthreads();
}
__device__ __forceinline__ void s5_seq(Frame& F, int pair) {
    const int b = pair >> 5, g = pair & 31, lane = F.lane;
    const float* tb = (const float*)(F.ws + WS_S5T) + (size_t)(g * S5N + lane) * 40;
    const float abr = tb[0], abi = tb[1];
    float bbr[16], bbi[16], cr[16], ci[16], dsk[16];
#pragma unroll
    for (int p = 0; p < 16; ++p) { bbr[p] = tb[2 + p]; bbi[p] = tb[18 + p]; cr[p] = F.in[I_CRE][(size_t)(g * 16 + p) * S5N + lane]; ci[p] = F.in[I_CIM][(size_t)(g * 16 + p) * S5N + lane];
        dsk[p] = (lane == 0) ? F.in[I_DSK][g * 16 + p] : 0.f; }
    const bf16* Ub = (const bf16*)(F.ws + WS_PROJ) + (size_t)4 * M * 512 + ((size_t)g * M + (size_t)b * SEQ) * 16;
    bf16* Zb = (bf16*)(F.ws + WS_Z) + (size_t)b * SEQ * 512 + g * 16;
    const int pme = ((lane >> 5) & 1) * 8 + ((lane >> 4) & 1) * 4 + ((lane >> 3) & 1) * 2 + ((lane >> 2) & 1);
    float xr = 0.f, xi = 0.f;
    v4u nu0 = *(const GAS v4u*)(Ub + (size_t)lane * 16), nu1 = *(const GAS v4u*)(Ub + (size_t)lane * 16 + 8);
    for (int t0 = 0; t0 < SEQ; t0 += 64) {
        const v4u u0 = nu0, u1 = nu1;
        if (t0 + 64 < SEQ) { nu0 = *(const GAS v4u*)(Ub + (size_t)(t0 + 64 + lane) * 16); nu1 = *(const GAS v4u*)(Ub + (size_t)(t0 + 64 + lane) * 16 + 8); }
#pragma unroll 1
        for (int tt = 0; tt < 64; ++tt) {
            v4u a, c;
            a.x = __builtin_amdgcn_readlane(u0.x, tt); a.y = __builtin_amdgcn_readlane(u0.y, tt); a.z = __builtin_amdgcn_readlane(u0.z, tt); a.w = __builtin_amdgcn_readlane(u0.w, tt);
            c.x = __builtin_amdgcn_readlane(u1.x, tt); c.y = __builtin_amdgcn_readlane(u1.y, tt); c.z = __builtin_amdgcn_readlane(u1.z, tt); c.w = __builtin_amdgcn_readlane(u1.w, tt);
            float u[16]; { float f0[8], f1[8]; unpack8(a, f0); unpack8(c, f1);
#pragma unroll
                for (int p = 0; p < 8; ++p) { u[p] = f0[p]; u[8 + p] = f1[p]; } }
            float bur = 0.f, bui = 0.f;
#pragma unroll
            for (int p = 0; p < 16; ++p) { bur += bbr[p] * u[p]; bui += bbi[p] * u[p]; }
            const float nxr = abr * xr - abi * xi + bur, nxi = abr * xi + abi * xr + bui; xr = nxr; xi = nxi;
            float r[16];
#pragma unroll
            for (int p = 0; p < 16; ++p) r[p] = cr[p] * xr - ci[p] * xi + dsk[p] * u[p];
#pragma unroll
            for (int i = 0; i < 8; ++i) { const float keep = (lane & 32) ? r[i + 8] : r[i], send = (lane & 32) ? r[i] : r[i + 8]; r[i] = keep + __shfl_xor(send, 32); }
#pragma unroll
            for (int i = 0; i < 4; ++i) { const float keep = (lane & 16) ? r[i + 4] : r[i], send = (lane & 16) ? r[i] : r[i + 4]; r[i] = keep + __shfl_xor(send, 16); }
#pragma unroll
            for (int i = 0; i < 2; ++i) { const float keep = (lane & 8) ? r[i + 2] : r[i], send = (lane & 8) ? r[i] : r[i + 2]; r[i] = keep + __shfl_xor(send, 8); }
            { const float keep = (lane & 4) ? r[1] : r[0], send = (lane & 4) ? r[0] : r[1]; r[0] = keep + __shfl_xor(send, 4); }
            r[0] += __shfl_xor(r[0], 2); r[0] += __shfl_xor(r[0], 1);
            if ((lane & 3) == 0) Zb[(size_t)(t0 + tt) * 512 + pme] = (bf16)f2bf(gelu_tanh(r[0]));
        }
    }
}

__device__ __forceinline__ int t256(int r, int c) { return r * 256 + ((((c >> 3) ^ (r & 15))) << 4) + (c & 7) * 2; }
__device__ __forceinline__ int t128(int r, int c) { return r * 128 + ((((c >> 3) ^ (r & 7))) << 4) + (c & 7) * 2; }
typedef unsigned v2u __attribute__((ext_vector_type(2)));
__device__ __forceinline__ unsigned offb(unsigned row, unsigned ch) { return 256u * row + 16u * (ch ^ (((row & 3u) << 2) | ((row >> 2) & 3u))); }
typedef short v4i16_t __attribute__((ext_vector_type(4)));
__device__ __forceinline__ bf16x8 tr_frag16(LAS unsigned char* tile, int lane, int c, int ks) {
    const unsigned g = lane >> 4, q = (lane & 15) >> 2, p = lane & 3;
    const v4i16_t lo = __builtin_amdgcn_ds_read_tr16_b64_v4i16((LAS v4i16_t*)(tile + offb(32 * ks + 8 * g + q, 2 * c + (p >> 1)) + 8 * (p & 1)));
    const v4i16_t hi = __builtin_amdgcn_ds_read_tr16_b64_v4i16((LAS v4i16_t*)(tile + offb(32 * ks + 8 * g + 4 + q, 2 * c + (p >> 1)) + 8 * (p & 1)));
    bf16x8 r; r[0] = lo[0]; r[1] = lo[1]; r[2] = lo[2]; r[3] = lo[3]; r[4] = hi[0]; r[5] = hi[1]; r[6] = hi[2]; r[7] = hi[3]; return r;
}
__device__ __forceinline__ void hgrn2_state_pass(Frame& F, int item) {
    const int bh = item >> 2, ksl = item & 3, b = bh >> 2, h = bh & 3, tid = F.tid, lane = F.lane, w = F.wave, fr = lane & 15, fq = lane >> 4;
    const int kcol = tid & 31, sg = tid >> 5;
    LAS unsigned char* L = F.lds + RING_OFF;
    LAS unsigned char* sRaw = L + 49152;
    const bf16* LFg = (const bf16*)(F.ws + WS_PROJ) + (size_t)M * 512 + (size_t)b * SEQ * 512 + h * 128 + ksl * 32;
    const bf16* Vg = (const bf16*)(F.ws + WS_PROJ) + (size_t)2 * M * 512 + (size_t)b * SEQ * 512 + h * 128;
    bf16* SST = (bf16*)(F.ws + WS_SST) + (size_t)bh * 64 * 128 * 128 + ksl * 32;
    float S[2][4];
#pragma unroll
    for (int i = 0; i < 2; ++i)
#pragma unroll
        for (int r = 0; r < 4; ++r) S[i][r] = 0.f;
    const int ls = (tid & 255) >> 2, lkg = tid & 3;
    const int vs0 = tid >> 4, vch = tid & 15;
    v4u nlf = *(const GAS v4u*)(LFg + (size_t)ls * 512 + lkg * 8);
    v4u nv0 = *(const GAS v4u*)(Vg + (size_t)vs0 * 512 + vch * 8), nv1 = *(const GAS v4u*)(Vg + (size_t)(32 + vs0) * 512 + vch * 8);
    v4u n2lf = *(const GAS v4u*)(LFg + (size_t)(64 + ls) * 512 + lkg * 8);
    v4u n2v0 = *(const GAS v4u*)(Vg + (size_t)(64 + vs0) * 512 + vch * 8), n2v1 = *(const GAS v4u*)(Vg + (size_t)(96 + vs0) * 512 + vch * 8);
    v4u n3lf = *(const GAS v4u*)(LFg + (size_t)(128 + ls) * 512 + lkg * 8);
    v4u n3v0 = *(const GAS v4u*)(Vg + (size_t)(128 + vs0) * 512 + vch * 8), n3v1 = *(const GAS v4u*)(Vg + (size_t)(160 + vs0) * 512 + vch * 8);
    for (int c = 0; c < 64; ++c) {
        LAS unsigned char* Lb = L + (c & 1) * 24576;
        LAS unsigned char* sKT = Lb; LAS unsigned char* sVT = Lb + 4096; LAS float* sTot = (LAS float*)(Lb + 20480); LAS float* sDec = (LAS float*)(Lb + 22528);
        if (tid < 256) *(LAS v4u*)(sRaw + ls * 64 + lkg * 16) = nlf;
        *(LAS v4u*)(sVT + offb(vs0, vch)) = nv0; *(LAS v4u*)(sVT + offb(32 + vs0, vch)) = nv1;
        nlf = n2lf; nv0 = n2v0; nv1 = n2v1; n2lf = n3lf; n2v0 = n3v0; n2v1 = n3v1;
        if (c + 3 < 64) { const size_t t3 = (size_t)(c + 3) * 64;
            n3lf = *(const GAS v4u*)(LFg + (t3 + ls) * 512 + lkg * 8); n3v0 = *(const GAS v4u*)(Vg + (t3 + vs0) * 512 + vch * 8); n3v1 = *(const GAS v4u*)(Vg + (t3 + 32 + vs0) * 512 + vch * 8); }
        __syncthreads();
        float lf[4];
#pragma unroll
        for (int j = 0; j < 4; ++j) lf[j] = bf2f(*(const LAS bf16*)(sRaw + (sg * 4 + j) * 64 + kcol * 2));
        float cl[4]; float run = 0.f;
#pragma unroll
        for (int j = 0; j < 4; ++j) { run += lf[j]; cl[j] = run; }
        sTot[sg * 32 + kcol] = run;
        __syncthreads();
        float off = 0.f, last = 0.f;
#pragma unroll
        for (int q = 0; q < 16; ++q) { const float tq = sTot[q * 32 + kcol]; off += (q < sg) ? tq : 0.f; last += tq; }
        float kh[4];
#pragma unroll
        for (int j = 0; j < 4; ++j) kh[j] = (1.f - __expf(lf[j])) * __expf(last - (off + cl[j]));
        { v2u pk; pk.x = pk2(kh[0], kh[1]); pk.y = pk2(kh[2], kh[3]);
          *(LAS v2u*)(sKT + kcol * 128 + ((((sg >> 1) ^ (kcol & 7))) << 4) + (sg & 1) * 8) = pk; }
        if (sg == 0) sDec[kcol] = __expf(last);
        __syncthreads();
        f32x4 acc[2] = {(f32x4){0.f, 0.f, 0.f, 0.f}, (f32x4){0.f, 0.f, 0.f, 0.f}};
        const int mt = w & 1, nt0 = (w >> 1) * 2;
#pragma unroll
        for (int ks = 0; ks < 2; ++ks) { const int ch = ks * 4 + fq, row = 16 * mt + fr;
            const bf16x8 af = *(const LAS bf16x8*)(sKT + row * 128 + ((ch ^ (row & 7)) << 4));
#pragma unroll
            for (int nt = 0; nt < 2; ++nt) { const bf16x8 bfm = tr_frag16(sVT, lane, nt0 + nt, ks);
                acc[nt] = __builtin_amdgcn_mfma_f32_16x16x32_bf16(af, bfm, acc[nt], 0, 0, 0); } }
        const int k0 = 16 * mt + fq * 4; const f32x4 dec = *(const LAS f32x4*)(sDec + k0);
#pragma unroll
        for (int nt = 0; nt < 2; ++nt) { const int vg = 16 * (nt0 + nt) + fr;
            v2u o; o.x = pk2(S[nt][0], S[nt][1]); o.y = pk2(S[nt][2], S[nt][3]);
            *(GAS v2u*)(SST + ((size_t)c * 128 + vg) * 128 + k0) = o;
            S[nt][0] = dec[0] * S[nt][0] + acc[nt][0]; S[nt][1] = dec[1] * S[nt][1] + acc[nt][1]; S[nt][2] = dec[2] * S[nt][2] + acc[nt][2]; S[nt][3] = dec[3] * S[nt][3] + acc[nt][3]; }
    }
    __syncthreads();
}
struct HgOutRegs { v4u lf[2], q[2], v[2], st[4]; };
__device__ __forceinline__ void hgrn2_out_load(Frame& F, int item, HgOutRegs& R) {
    const int bh = item >> 6, c = item & 63, b = bh >> 2, h = bh & 3, tid = F.tid;
    const size_t tok0 = (size_t)b * SEQ + (size_t)c * 64;
    const bf16* Qb = (const bf16*)(F.ws + WS_PROJ) + tok0 * 512 + h * 128; const bf16* LFb = Qb + (size_t)M * 512; const bf16* Vb = Qb + (size_t)2 * M * 512;
    const bf16* SST = (const bf16*)(F.ws + WS_SST) + (size_t)item * 128 * 128;
#pragma unroll
    for (int i = 0; i < 2; ++i) { const int idx = tid + 512 * i, sr = idx >> 4, ch = idx & 15;
        R.lf[i] = *(const GAS v4u*)(LFb + (size_t)sr * 512 + ch * 8); R.q[i] = *(const GAS v4u*)(Qb + (size_t)sr * 512 + ch * 8); R.v[i] = *(const GAS v4u*)(Vb + (size_t)sr * 512 + ch * 8); }
#pragma unroll
    for (int i = 0; i < 4; ++i) { const int idx = tid + 512 * i; R.st[i] = *(const GAS v4u*)(SST + (size_t)(idx >> 4) * 128 + (idx & 15) * 8); }
}
__device__ __forceinline__ void hgrn2_out_phase(Frame& F) {
    const int tid = F.tid, lane = F.lane, w = F.wave, fr = lane & 15, fq = lane >> 4;
    const int kcol = tid & 127, qtr = tid >> 7;
    LAS unsigned char* L = F.lds + RING_OFF;
    LAS unsigned char* sQt = L; LAS unsigned char* sQm = L + 16384; LAS unsigned char* sKm = L + 32768; LAS unsigned char* sV = L + 49152; LAS unsigned char* sST = L + 65536; LAS unsigned char* sP = L + 98304;
    LAS float* sTot = (LAS float*)(L + 106496); LAS float* sSS = (LAS float*)(L + 108544);
    LAS unsigned char* rLF = L + 110592; LAS unsigned char* rQ = L + 126976;
    HgOutRegs R;
    int item = F.vcu;
    if (item < 32 * 64) hgrn2_out_load(F, item, R);
    for (; item < 32 * 64; item += F.G) {
        const int bh = item >> 6, c = item & 63, b = bh >> 2, h = bh & 3;
        const size_t tok0 = (size_t)b * SEQ + (size_t)c * 64;
        const bf16* Gb = (const bf16*)(F.ws + WS_PROJ) + (size_t)3 * M * 512 + tok0 * 512 + h * 128;
        bf16* MIX = (bf16*)(F.ws + WS_MIX) + tok0 * 1024 + h * 128;
#pragma unroll
        for (int i = 0; i < 2; ++i) { const int idx = tid + 512 * i, sr = idx >> 4, ch = idx & 15;
            *(LAS v4u*)(rLF + sr * 256 + ch * 16) = R.lf[i]; *(LAS v4u*)(rQ + sr * 256 + ch * 16) = R.q[i]; *(LAS v4u*)(sV + offb(sr, ch)) = R.v[i]; }
#pragma unroll
        for (int i = 0; i < 4; ++i) { const int idx = tid + 512 * i, v = idx >> 4, kc = idx & 15; *(LAS v4u*)(sST + v * 256 + ((kc ^ (v & 15)) << 4)) = R.st[i]; }
        if (item + F.G < 32 * 64) hgrn2_out_load(F, item + F.G, R);
        __syncthreads();
        float lf[16], q[16];
#pragma unroll
        for (int j = 0; j < 16; ++j) { lf[j] = bf2f(*(const LAS bf16*)(rLF + (qtr * 16 + j) * 256 + kcol * 2)); q[j] = bf2f(*(const LAS bf16*)(rQ + (qtr * 16 + j) * 256 + kcol * 2)); }
        float cl[16]; float run = 0.f;
#pragma unroll
        for (int j = 0; j < 16; ++j) { run += lf[j]; cl[j] = run; }
        sTot[qtr * 128 + kcol] = run;
        __syncthreads();
        { const float t0 = sTot[kcol], t1 = sTot[128 + kcol], t2 = sTot[256 + kcol];
          const float off = (qtr > 0 ? t0 : 0.f) + (qtr > 1 ? t1 : 0.f) + (qtr > 2 ? t2 : 0.f), mid = t0 + t1;
#pragma unroll
          for (int j = 0; j < 16; ++j) { const int sdx = qtr * 16 + j; const float cum = off + cl[j];
              const int o = t256(sdx, kcol);
              *(LAS bf16*)(sQt + o) = (bf16)f2bf(q[j] * __expf(cum));
              *(LAS bf16*)(sQm + o) = (bf16)f2bf(q[j] * __expf(cum - mid));
              *(LAS bf16*)(sKm + o) = (bf16)f2bf((1.f - __expf(lf[j])) * __expf(mid - cum)); } }
        __syncthreads();
        const int tt = w >> 1, trow = 16 * tt + fr;
#pragma unroll
        for (int sti = 0; sti < 2; ++sti) { const int stl = (w & 1) * 2 + sti; f32x4 acc = (f32x4){0.f, 0.f, 0.f, 0.f};
            if (stl <= tt) {
#pragma unroll
                for (int ks = 0; ks < 4; ++ks) { const int ch = ks * 4 + fq, srow = 16 * stl + fr;
                    const bf16x8 af = *(const LAS bf16x8*)(sKm + srow * 256 + ((ch ^ (srow & 15)) << 4));
                    const bf16x8 bfm = *(const LAS bf16x8*)(sQm + trow * 256 + ((ch ^ (trow & 15)) << 4));
                    acc = __builtin_amdgcn_mfma_f32_16x16x32_bf16(af, bfm, acc, 0, 0, 0); } }
            const int s0 = 16 * stl + fq * 4;
            const float p0 = (s0 + 0 <= trow) ? acc[0] : 0.f, p1 = (s0 + 1 <= trow) ? acc[1] : 0.f, p2 = (s0 + 2 <= trow) ? acc[2] : 0.f, p3 = (s0 + 3 <= trow) ? acc[3] : 0.f;
            v2u o; o.x = pk2(p0, p1); o.y = pk2(p2, p3);
            *(LAS v2u*)(sP + trow * 128 + ((((s0 >> 3) ^ (trow & 7))) << 4) + (s0 & 7) * 2) = o; }
        __syncthreads();
        f32x4 oacc[4];
#pragma unroll
        for (int i = 0; i < 4; ++i) oacc[i] = (f32x4){0.f, 0.f, 0.f, 0.f};
#pragma unroll
        for (int ks = 0; ks < 4; ++ks) { const int ch = ks * 4 + fq;
            const bf16x8 bfm = *(const LAS bf16x8*)(sQt + trow * 256 + ((ch ^ (trow & 15)) << 4));
#pragma unroll
            for (int i = 0; i < 4; ++i) { const int vr = 16 * ((w & 1) * 4 + i) + fr; const bf16x8 af = *(const LAS bf16x8*)(sST + vr * 256 + ((ch ^ (vr & 15)) << 4));
                oacc[i] = __builtin_amdgcn_mfma_f32_16x16x32_bf16(af, bfm, oacc[i], 0, 0, 0); } }
#pragma unroll
        for (int ks = 0; ks < 2; ++ks) { const int ch = ks * 4 + fq;
            const bf16x8 bfm = *(const LAS bf16x8*)(sP + trow * 128 + ((ch ^ (trow & 7)) << 4));
#pragma unroll
            for (int i = 0; i < 4; ++i) { const bf16x8 af = tr_frag16(sV, lane, (w & 1) * 4 + i, ks);
                oacc[i] = __builtin_amdgcn_mfma_f32_16x16x32_bf16(af, bfm, oacc[i], 0, 0, 0); } }
        float ss = 0.f;
#pragma unroll
        for (int i = 0; i < 4; ++i) ss += (oacc[i][0] * oacc[i][0] + oacc[i][1] * oacc[i][1]) + (oacc[i][2] * oacc[i][2] + oacc[i][3] * oacc[i][3]);
        ss += __shfl_xor(ss, 16); ss += __shfl_xor(ss, 32);
        if (fq == 0) sSS[(w & 1) * 64 + trow] = ss;
        __syncthreads();
        const float rinv = 1.f / sqrtf((sSS[trow] + sSS[64 + trow]) * (1.f / 128.f) + RMS_EPS);
#pragma unroll
        for (int i = 0; i < 4; ++i) { const int v0 = 16 * ((w & 1) * 4 + i) + fq * 4;
            const v2u gw2 = *(const GAS v2u*)(Gb + (size_t)trow * 512 + v0); const f32x4 ng = *(const GAS f32x4*)(F.in[I_HGNG] + v0);
            const float g0 = __builtin_bit_cast(float, gw2.x << 16), g1 = __builtin_bit_cast(float, gw2.x & 0xffff0000u), g2 = __builtin_bit_cast(float, gw2.y << 16), g3 = __builtin_bit_cast(float, gw2.y & 0xffff0000u);
            v2u o; o.x = pk2(oacc[i][0] * rinv * ng[0] * silu_f(g0), oacc[i][1] * rinv * ng[1] * silu_f(g1)); o.y = pk2(oacc[i][2] * rinv * ng[2] * silu_f(g2), oacc[i][3] * rinv * ng[3] * silu_f(g3));
            *(GAS v2u*)(MIX + (size_t)trow * 1024 + v0) = o; }
        __syncthreads();
    }
}

__device__ __forceinline__ void s5_tables_stage1(Frame& F) {
    const int gt = (F.vcu * NWAVES + F.wave) * 64 + F.lane, NGT = F.G * NWAVES * 64;
    const float* S5T = (const float*)(F.ws + WS_S5T); const float* PW = (const float*)(F.ws + WS_PW);
    float* KT = (float*)(F.ws + WS_KTAU); bf16* G5 = (bf16*)(F.ws + WS_G5); bf16* T5 = (bf16*)(F.ws + WS_T5);
    for (int i = gt; i < S5G * 32 * 256; i += NGT) { const int g = i >> 13, tau = (i >> 8) & 31, p = (i >> 4) & 15, q = i & 15;
        float acc = (tau == 0 && p == q) ? F.in[I_DSK][g * 16 + p] : 0.f;
#pragma unroll 16
        for (int n = 0; n < S5N; ++n) { const int gn = g * S5N + n;
            const float cr = F.in[I_CRE][(size_t)(g * 16 + p) * S5N + n], ci = F.in[I_CIM][(size_t)(g * 16 + p) * S5N + n];
            const float wr = PW[((size_t)gn * 33 + tau) * 2], wi = PW[((size_t)gn * 33 + tau) * 2 + 1];
            const float br = S5T[(size_t)gn * 40 + 2 + q], bi = S5T[(size_t)gn * 40 + 18 + q];
            const float er = cr * wr - ci * wi, ei = cr * wi + ci * wr;
            acc += er * br - ei * bi; }
        KT[i] = acc; }
    for (int i = gt; i < S5G * 256 * 64; i += NGT) { const int g = i >> 14, r = (i >> 6) & 255, kc = i & 63, sdx = kc >> 1, q0 = (kc & 1) * 8;
        float f[8];
        if (r < 128) { const int n = r & 63, gn = g * S5N + n; const float wr = PW[((size_t)gn * 33 + (31 - sdx)) * 2], wi = PW[((size_t)gn * 33 + (31 - sdx)) * 2 + 1];
#pragma unroll
            for (int j = 0; j < 8; ++j) { const float br = S5T[(size_t)gn * 40 + 2 + q0 + j], bi = S5T[(size_t)gn * 40 + 18 + q0 + j]; f[j] = (r < 64) ? (wr * br - wi * bi) : (wr * bi + wi * br); }
        } else {
#pragma unroll
            for (int j = 0; j < 8; ++j) f[j] = 0.f; }
        *(GAS v4u*)(G5 + ((size_t)(g * 256 + r)) * 512 + kc * 8) = pack8(f); }
    for (int i = gt; i < S5G * 512 * 16; i += NGT) { const int g = i >> 13, row = (i >> 4) & 511, nc = i & 15, t = row >> 4, p = row & 15, im = nc >> 3, n0 = (nc & 7) * 8;
        float f[8];
#pragma unroll
        for (int j = 0; j < 8; ++j) { const int n = n0 + j, gn = g * S5N + n;
            const float cr = F.in[I_CRE][(size_t)(g * 16 + p) * S5N + n], ci = F.in[I_CIM][(size_t)(g * 16 + p) * S5N + n];
            const float wr = PW[((size_t)gn * 33 + t + 1) * 2], wi = PW[((size_t)gn * 33 + t + 1) * 2 + 1];
            f[j] = im ? -(cr * wi + ci * wr) : (cr * wr - ci * wi); }
        *(GAS v4u*)(T5 + ((size_t)(g * 512 + row)) * 640 + 512 + nc * 8) = pack8(f); }
}
__device__ __forceinline__ void s5_tables_stage2(Frame& F) {
    const int gt = (F.vcu * NWAVES + F.wave) * 64 + F.lane, NGT = F.G * NWAVES * 64;
    const float* KT = (const float*)(F.ws + WS_KTAU); bf16* T5 = (bf16*)(F.ws + WS_T5);
    for (int i = gt; i < S5G * 512 * 64; i += NGT) { const int g = i >> 15, row = (i >> 6) & 511, kc = i & 63, t = row >> 4, p = row & 15, sdx = kc >> 1, q0 = (kc & 1) * 8;
        float f[8];
        if (sdx <= t) { const float* k = KT + (((size_t)g * 32 + (t - sdx)) * 16 + p) * 16 + q0;
#pragma unroll
            for (int j = 0; j < 8; ++j) f[j] = k[j];
        } else {
#pragma unroll
            for (int j = 0; j < 8; ++j) f[j] = 0.f; }
        *(GAS v4u*)(T5 + ((size_t)(g * 512 + row)) * 640 + kc * 8) = pack8(f); }
}
__device__ __forceinline__ void s5_scan(Frame& F, int idx) {
    const int b = idx >> 11, g = (idx >> 6) & 31, n = idx & 63;
    const float* PW = (const float*)(F.ws + WS_PW); const float* XL = (const float*)(F.ws + WS_XLOC); bf16* A5 = (bf16*)(F.ws + WS_A5);
    const float ar = PW[((size_t)(g * S5N + n) * 33 + 32) * 2], ai = PW[((size_t)(g * S5N + n) * 33 + 32) * 2 + 1];
    float xr = 0.f, xi = 0.f;
    for (int c0 = 0; c0 < 128; c0 += 32) {
        float lr[32], li[32];
#pragma unroll
        for (int j = 0; j < 32; ++j) { const float* p = XL + ((size_t)(b * 128 + c0 + j) * 32 + g) * 128 + n; lr[j] = p[0]; li[j] = p[64]; }
#pragma unroll
        for (int j = 0; j < 32; ++j) { bf16* o = A5 + ((size_t)g * S5I + b * 128 + c0 + j) * 640 + 512 + n; o[0] = (bf16)f2bf(xr); o[64] = (bf16)f2bf(xi);
            const float nr = ar * xr - ai * xi + lr[j], ni = ar * xi + ai * xr + li[j]; xr = nr; xi = ni; }
    }
}

__device__ __forceinline__ void ln1_row(bf16* row, const float* g, const float* b, int lane) {
    const v4u w0 = *(const GAS v4u*)(row + lane * 8), w1 = *(const GAS v4u*)(row + 512 + lane * 8);
    float a[8], c[8]; unpack8(w0, a); unpack8(w1, c);
    float s = 0.f;
#pragma unroll
    for (int j = 0; j < 8; ++j) s += a[j] + c[j];
    const float mean = wave_sum(s) * (1.f / D); float s2 = 0.f;
#pragma unroll
    for (int j = 0; j < 8; ++j) { a[j] -= mean; c[j] -= mean; s2 += a[j] * a[j] + c[j] * c[j]; }
    const float rstd = 1.f / sqrtf(wave_sum(s2) * (1.f / D) + LN_EPS);
    const f32x4 g0 = *(const GAS f32x4*)(g + lane * 8), g1 = *(const GAS f32x4*)(g + lane * 8 + 4), g2 = *(const GAS f32x4*)(g + 512 + lane * 8), g3 = *(const GAS f32x4*)(g + 512 + lane * 8 + 4);
    const f32x4 b0 = *(const GAS f32x4*)(b + lane * 8), b1 = *(const GAS f32x4*)(b + lane * 8 + 4), b2 = *(const GAS f32x4*)(b + 512 + lane * 8), b3 = *(const GAS f32x4*)(b + 512 + lane * 8 + 4);
    const float gg0[8] = {g0.x, g0.y, g0.z, g0.w, g1.x, g1.y, g1.z, g1.w}, gg1[8] = {g2.x, g2.y, g2.z, g2.w, g3.x, g3.y, g3.z, g3.w};
    const float bb0[8] = {b0.x, b0.y, b0.z, b0.w, b1.x, b1.y, b1.z, b1.w}, bb1[8] = {b2.x, b2.y, b2.z, b2.w, b3.x, b3.y, b3.z, b3.w};
#pragma unroll
    for (int j = 0; j < 8; ++j) { a[j] = a[j] * rstd * gg0[j] + bb0[j]; c[j] = c[j] * rstd * gg1[j] + bb1[j]; }
    *(GAS v4u*)(row + lane * 8) = pack8(a); *(GAS v4u*)(row + 512 + lane * 8) = pack8(c);
}

typedef float f32x16 __attribute__((ext_vector_type(16)));
__device__ __forceinline__ int f2ord(float f) { const int x = __builtin_bit_cast(int, f); return x ^ ((x >> 31) & 0x7fffffff); }
__device__ __forceinline__ float ord2f(int x) { return __builtin_bit_cast(float, x ^ ((x >> 31) & 0x7fffffff)); }
#define CE_DESC(a, b) do { const int _h = max((a), (b)), _l = min((a), (b)); (a) = _h; (b) = _l; } while (0)
__device__ __forceinline__ void sort16_desc(int (&v)[16]) {
#pragma unroll
    for (int k = 2; k <= 16; k <<= 1)
#pragma unroll
        for (int j = k >> 1; j > 0; j >>= 1)
#pragma unroll
            for (int i = 0; i < 16; ++i) { const int l = i ^ j; if (l > i) { if ((i & k) == 0) CE_DESC(v[i], v[l]); else CE_DESC(v[l], v[i]); } }
}
__device__ __forceinline__ void merge16_desc(int (&a)[16], const int (&b)[16]) {
#pragma unroll
    for (int i = 0; i < 16; ++i) a[i] = max(a[i], b[15 - i]);
#pragma unroll
    for (int j = 8; j > 0; j >>= 1)
#pragma unroll
        for (int i = 0; i < 16; ++i) { const int l = i ^ j; if (l > i) CE_DESC(a[i], a[l]); }
}
__device__ __forceinline__ void peer_topk_side(const f32x16 (&acc)[4], int hi, int (&top)[16]) {
    int t[4][16];
#pragma unroll
    for (int kt = 0; kt < 4; ++kt)
#pragma unroll
        for (int j = 0; j < 16; ++j) { const unsigned key = (unsigned)(kt * 32 + (j & 3) + 8 * (j >> 2)) | (unsigned)(4 * hi);
            const float av = acc[kt][j];
            t[kt][j] = f2ord(__builtin_bit_cast(float, (__builtin_bit_cast(unsigned, av) & 0xFFFFFF80u) | key)); }
    sort16_desc(t[0]); sort16_desc(t[1]); sort16_desc(t[2]); sort16_desc(t[3]);
    merge16_desc(t[0], t[1]); merge16_desc(t[2], t[3]); merge16_desc(t[0], t[2]);
    int p[16];
#pragma unroll
    for (int i = 0; i < 16; ++i) p[i] = __shfl_xor(t[0][i], 32);
    merge16_desc(t[0], p);
#pragma unroll
    for (int i = 0; i < 16; ++i) top[i] = t[0][i];
}
__device__ __forceinline__ void peer_score_phase(Frame& F, const pg8::StaticOrder& SO) {
    LAS unsigned char* kl = F.lds + RING_OFF;
    LAS unsigned* look = (LAS unsigned*)(F.lds + RING_OFF + 65536 + F.wave * 8192);
    const bf16* keys = (const bf16*)(F.ws + WS_KEYS);
    for (int i = F.tid; i < 2 * 128 * 16; i += NWAVES * 64) { const int sn = i >> 4, c = i & 15, n = sn & 127;
        *(LAS v4u*)(kl + sn * 256 + ((c ^ (n & 15)) << 4)) = *(const GAS v4u*)(keys + (size_t)sn * 128 + c * 8); }
    __syncthreads();
    const int lane = F.lane, r32 = lane & 31, hi = lane >> 5;
    const bf16* Q2 = (const bf16*)(F.ws + WS_Q2);
    int* EIDX = (int*)(F.ws + WS_EIDX); float* EGATE = (float*)(F.ws + WS_EGATE);
    for (int ui = 0;; ++ui) { pg8::Unit gu; if (!SO.next(ui, gu)) break;
        const int blk = gu.pm * 8 + F.wave, h = gu.pn; const size_t tok = (size_t)blk * 32 + r32;
        const bf16* qrow = Q2 + tok * NQ2 + h * PQ + hi * 8;
        int top1[16], top2[16];
        bf16x8 qfs[2][8];
#pragma unroll
        for (int s = 0; s < 2; ++s)
#pragma unroll
            for (int ks = 0; ks < 8; ++ks) qfs[s][ks] = *(const GAS bf16x8*)(qrow + s * 128 + ks * 16);
#pragma unroll
        for (int s = 0; s < 2; ++s) {
            f32x16 acc[4];
#pragma unroll
            for (int kt = 0; kt < 4; ++kt) { acc[kt] = (f32x16){0.f, 0.f, 0.f, 0.f, 0.f, 0.f, 0.f, 0.f, 0.f, 0.f, 0.f, 0.f, 0.f, 0.f, 0.f, 0.f};
                const int n = kt * 32 + r32;
#pragma unroll
                for (int ks = 0; ks < 8; ++ks) { const bf16x8 kf = *(const LAS bf16x8*)(kl + (s * 128 + n) * 256 + (((2 * ks + hi) ^ (n & 15)) << 4));
                    acc[kt] = __builtin_amdgcn_mfma_f32_32x32x16_bf16(kf, qfs[s][ks], acc[kt], 0, 0, 0); } }
            if (s == 0) peer_topk_side(acc, hi, top1); else peer_topk_side(acc, hi, top2);
        }
        float v1[16], v2[16];
#pragma unroll
        for (int i = 0; i < 16; ++i) { v1[i] = ord2f(top1[i]); v2[i] = ord2f(top2[i]);
            look[i * 64 + lane] = __builtin_bit_cast(unsigned, v1[i]) & 0x7Fu; look[(16 + i) * 64 + lane] = __builtin_bit_cast(unsigned, v2[i]) & 0x7Fu; }
        int c[4][16]; int nc = 0;
#pragma unroll
        for (int i = 0; i < 16; ++i)
#pragma unroll
            for (int j = 0; j < 16; ++j) if ((i + 1) * (j + 1) <= 16) { const float sum = v1[i] + v2[j];
                c[nc >> 4][nc & 15] = f2ord(__builtin_bit_cast(float, (__builtin_bit_cast(unsigned, sum) & 0xFFFFFF00u) | (unsigned)(i * 16 + j))); ++nc; }
#pragma unroll
        for (int q = 50; q < 64; ++q) c[q >> 4][q & 15] = (int)0x80000000;
        sort16_desc(c[0]); sort16_desc(c[1]); sort16_desc(c[2]); sort16_desc(c[3]);
        merge16_desc(c[0], c[1]); merge16_desc(c[2], c[3]); merge16_desc(c[0], c[2]);
        float e[16], sum = 0.f;
        float cf[16];
#pragma unroll
        for (int k = 0; k < 16; ++k) cf[k] = ord2f(c[0][k]);
#pragma unroll
        for (int k = 0; k < 16; ++k) { e[k] = __expf(cf[k] - cf[0]); sum += e[k]; }
        const float inv = 1.f / sum;
        LDS_WAIT();
        int ex[8]; float gt[8];
#pragma unroll
        for (int k = 0; k < 8; ++k) { const float cv = hi ? cf[8 + k] : cf[k]; gt[k] = (hi ? e[8 + k] : e[k]) * inv;
            const unsigned pos = __builtin_bit_cast(unsigned, cv) & 0xFFu;
            ex[k] = (int)(look[(pos >> 4) * 64 + lane] * PK + look[(16 + (pos & 15)) * 64 + lane]); }
        int* eo = EIDX + (tok * PH + h) * 16 + hi * 8; float* go = EGATE + (tok * PH + h) * 16 + hi * 8;
        *(GAS v4u*)eo = (v4u){(unsigned)ex[0], (unsigned)ex[1], (unsigned)ex[2], (unsigned)ex[3]}; *(GAS v4u*)(eo + 4) = (v4u){(unsigned)ex[4], (unsigned)ex[5], (unsigned)ex[6], (unsigned)ex[7]};
        *(GAS f32x4*)go = (f32x4){gt[0], gt[1], gt[2], gt[3]}; *(GAS f32x4*)(go + 4) = (f32x4){gt[4], gt[5], gt[6], gt[7]};
        LDS_WAIT();
    }
}

typedef float f32x2 __attribute__((ext_vector_type(2)));
constexpr float PD_SCALE = 256.f, PU_SCALE = 32.f;
__device__ __forceinline__ void unpack_fp8x16(const v4u w, float (&f)[16]) {
    const unsigned ww[4] = {w.x, w.y, w.z, w.w};
#pragma unroll
    for (int i = 0; i < 4; ++i) { const f32x2 lo = __builtin_amdgcn_cvt_pk_f32_fp8((int)ww[i], false), hi = __builtin_amdgcn_cvt_pk_f32_fp8((int)ww[i], true);
        f[4 * i] = lo[0]; f[4 * i + 1] = lo[1]; f[4 * i + 2] = hi[0]; f[4 * i + 3] = hi[1]; }
}
__device__ __forceinline__ void peer_sort_experts(int& e0, int& e1, float& g0, float& g1, int lane) {
    int k0 = e0 * 128 + lane, k1 = e1 * 128 + 64 + lane;
#pragma unroll
    for (int k = 2; k <= 128; k <<= 1)
#pragma unroll
        for (int j = k >> 1; j > 0; j >>= 1) {
            if (j == 64) { const int lo = min(k0, k1), hi = max(k0, k1); k0 = lo; k1 = hi; }
            else { const int p0 = __shfl_xor(k0, j), p1 = __shfl_xor(k1, j); const bool lower = (lane & j) == 0;
                const bool asc0 = (lane & k) == 0, asc1 = ((64 + lane) & k) == 0;
                k0 = (lower == asc0) ? min(k0, p0) : max(k0, p0); k1 = (lower == asc1) ? min(k1, p1) : max(k1, p1); }
        }
    const int s0 = k0 & 127, s1 = k1 & 127;
    const float a0 = __shfl(g0, s0 & 63), b0 = __shfl(g1, s0 & 63), a1 = __shfl(g0, s1 & 63), b1 = __shfl(g1, s1 & 63);
    g0 = (s0 < 64) ? a0 : b0; g1 = (s1 < 64) ? a1 : b1; e0 = k0 >> 7; e1 = k1 >> 7;
}
typedef long i64_t;
__device__ __forceinline__ void peer_gather_phase(Frame& F) {
    const int gw = F.vcu * NWAVES + F.wave, NGW = F.G * NWAVES, lane = F.lane;
    const bf16* H1 = (const bf16*)(F.ws + WS_H); const unsigned char* PD = F.ws + WS_PD; const unsigned char* PU = F.ws + WS_PU;
    const int* EIDX = (const int*)(F.ws + WS_EIDX); const float* EGATE = (const float*)(F.ws + WS_EGATE);
    const int rep = ((lane >> 5) & 1) * 4 + ((lane >> 4) & 1) * 2 + ((lane >> 3) & 1);
    const bool diag = ((lane & 15) >> 2) == (lane >> 4); const int dr = lane & 3;
    const float m0 = (diag && dr == 0) ? 1.f : 0.f, m1 = (diag && dr == 1) ? 1.f : 0.f, m2 = (diag && dr == 2) ? 1.f : 0.f, m3 = (diag && dr == 3) ? 1.f : 0.f;
    constexpr int GT = 4; constexpr float XS = 16.f, AS = 32.f;
    const int si = lane & 15, sq = lane >> 4;
    const unsigned sb = 0xFFu << (8 * (si & 3));
    const unsigned m0lo = (sq == (si >> 3) && (si & 7) < 4) ? sb : 0u, m0hi = (sq == (si >> 3) && (si & 7) >= 4) ? sb : 0u;
    const unsigned m1lo = (sq == 2 + (si >> 3) && (si & 7) < 4) ? sb : 0u, m1hi = (sq == 2 + (si >> 3) && (si & 7) >= 4) ? sb : 0u;
    for (int pr = gw; pr < M / GT; pr += NGW) {
        __syncthreads();
        const size_t tokA = (size_t)pr * GT;
        int e0[GT], e1[GT]; float g0[GT], g1[GT]; f32x4 os[GT][4]; i64_t xb0[GT], xb1[GT];
#pragma unroll
        for (int t = 0; t < GT; ++t) { float a[8], c[8]; unpack8(*(const GAS v4u*)(H1 + (tokA + t) * D + lane * 16), a); unpack8(*(const GAS v4u*)(H1 + (tokA + t) * D + lane * 16 + 8), c);
            unsigned q0, q1, q2, q3; int pk;
            pk = __builtin_amdgcn_cvt_pk_fp8_f32(a[0] * XS, a[1] * XS, 0, false); pk = __builtin_amdgcn_cvt_pk_fp8_f32(a[2] * XS, a[3] * XS, pk, true); q0 = (unsigned)pk;
            pk = __builtin_amdgcn_cvt_pk_fp8_f32(a[4] * XS, a[5] * XS, 0, false); pk = __builtin_amdgcn_cvt_pk_fp8_f32(a[6] * XS, a[7] * XS, pk, true); q1 = (unsigned)pk;
            pk = __builtin_amdgcn_cvt_pk_fp8_f32(c[0] * XS, c[1] * XS, 0, false); pk = __builtin_amdgcn_cvt_pk_fp8_f32(c[2] * XS, c[3] * XS, pk, true); q2 = (unsigned)pk;
            pk = __builtin_amdgcn_cvt_pk_fp8_f32(c[4] * XS, c[5] * XS, 0, false); pk = __builtin_amdgcn_cvt_pk_fp8_f32(c[6] * XS, c[7] * XS, pk, true); q3 = (unsigned)pk;
            xb0[t] = (i64_t)(((unsigned long long)q1 << 32) | q0); xb1[t] = (i64_t)(((unsigned long long)q3 << 32) | q2);
            e0[t] = EIDX[(tokA + t) * 128 + lane]; e1[t] = EIDX[(tokA + t) * 128 + 64 + lane]; g0[t] = EGATE[(tokA + t) * 128 + lane]; g1[t] = EGATE[(tokA + t) * 128 + 64 + lane];
            peer_sort_experts(e0[t], e1[t], g0[t], g1[t], lane);
#pragma unroll
            for (int j = 0; j < 4; ++j) os[t][j] = (f32x4){0.f, 0.f, 0.f, 0.f}; }
#define GATHER_BATCH(E0, E1, G0, G1, XB0, XB1, O) do { const int ev = (bt < 8) ? E0 : E1; const float gv = (bt < 8) ? G0 : G1; const int lb8 = (bt & 7) * 8; v4u dw[8], uw[8]; \
            _Pragma("unroll") for (int i = 0; i < 8; ++i) { const int e = __builtin_amdgcn_readlane(ev, lb8 + i); dw[i] = *(const GAS v4u*)(PD + (size_t)e * D + lane * 16); uw[i] = *(const GAS v4u*)(PU + (size_t)e * D + lane * 16); } \
            float p[8]; \
            _Pragma("unroll") for (int i = 0; i < 8; ++i) { f32x4 dacc = (f32x4){0.f, 0.f, 0.f, 0.f}; \
                dacc = __builtin_amdgcn_mfma_f32_16x16x32_fp8_fp8((i64_t)(((unsigned long long)dw[i].y << 32) | dw[i].x), XB0, dacc, 0, 0, 0); \
                dacc = __builtin_amdgcn_mfma_f32_16x16x32_fp8_fp8((i64_t)(((unsigned long long)dw[i].w << 32) | dw[i].z), XB1, dacc, 0, 0, 0); \
                const float d0 = dacc[0] * m0, d1 = dacc[1] * m1, d2 = dacc[2] * m2, d3 = dacc[3] * m3; p[i] = (d0 + d1) + (d2 + d3); } \
            _Pragma("unroll") for (int i = 0; i < 4; ++i) { const float keep = (lane & 32) ? p[i + 4] : p[i], send = (lane & 32) ? p[i] : p[i + 4]; p[i] = keep + __shfl_xor(send, 32); } \
            _Pragma("unroll") for (int i = 0; i < 2; ++i) { const float keep = (lane & 16) ? p[i + 2] : p[i], send = (lane & 16) ? p[i] : p[i + 2]; p[i] = keep + __shfl_xor(send, 16); } \
            { const float keep = (lane & 8) ? p[1] : p[0], send = (lane & 8) ? p[0] : p[1]; p[0] = keep + __shfl_xor(send, 8); } \
            p[0] += __shfl_xor(p[0], 4); p[0] += __shfl_xor(p[0], 2); p[0] += __shfl_xor(p[0], 1); \
            const float gate = __shfl(gv, lb8 + rep); const float act = gelu_tanh(p[0] * (1.f / (PD_SCALE * XS))) * gate * AS; \
            const int act8 = __builtin_amdgcn_cvt_pk_fp8_f32(act, 0.f, 0, false) & 0xff; \
            _Pragma("unroll") for (int i = 0; i < 8; ++i) { const unsigned a8 = (unsigned)__builtin_amdgcn_readlane(act8, ((i >> 2) & 1) * 32 + ((i >> 1) & 1) * 16 + (i & 1) * 8) * 0x01010101u; \
                const i64_t A0 = (i64_t)(((unsigned long long)(a8 & m0hi) << 32) | (a8 & m0lo)), A1 = (i64_t)(((unsigned long long)(a8 & m1hi) << 32) | (a8 & m1lo)); \
                const i64_t B0 = (i64_t)(((unsigned long long)uw[i].y << 32) | uw[i].x), B1 = (i64_t)(((unsigned long long)uw[i].w << 32) | uw[i].z); \
                O[0] = __builtin_amdgcn_mfma_f32_16x16x32_fp8_fp8(A0, B0, O[0], 0, 0, 0); O[1] = __builtin_amdgcn_mfma_f32_16x16x32_fp8_fp8(A1, B0, O[1], 0, 0, 0); \
                O[2] = __builtin_amdgcn_mfma_f32_16x16x32_fp8_fp8(A0, B1, O[2], 0, 0, 0); O[3] = __builtin_amdgcn_mfma_f32_16x16x32_fp8_fp8(A1, B1, O[3], 0, 0, 0); } } while (0)
#pragma unroll 1
        for (int bt = 0; bt < 16; ++bt) { if ((bt & 3) == 0) __syncthreads();
#pragma unroll
            for (int t = 0; t < GT; ++t) { GATHER_BATCH(e0[t], e1[t], g0[t], g1[t], xb0[t], xb1[t], os[t]); __builtin_amdgcn_sched_barrier(0); } }
#undef GATHER_BATCH
#pragma unroll
        for (int t = 0; t < GT; ++t) {
            float o[16]; float s = 0.f;
#pragma unroll
            for (int a4 = 0; a4 < 4; ++a4) { const int hf = a4 >> 1, kh = a4 & 1, c0 = 16 * si + 256 * ((sq >> 1) + 2 * kh) + 8 * hf + 4 * (sq & 1);
                const v2u hw = *(const GAS v2u*)(H1 + (tokA + t) * D + c0);
                const float x0 = __builtin_bit_cast(float, hw.x << 16), x1 = __builtin_bit_cast(float, hw.x & 0xffff0000u), x2 = __builtin_bit_cast(float, hw.y << 16), x3 = __builtin_bit_cast(float, hw.y & 0xffff0000u);
                const f32x4 ov = os[t][a4];
                o[4 * a4 + 0] = ov[0] * (1.f / (AS * PU_SCALE)) + DN_ALPHA * x0; o[4 * a4 + 1] = ov[1] * (1.f / (AS * PU_SCALE)) + DN_ALPHA * x1;
                o[4 * a4 + 2] = ov[2] * (1.f / (AS * PU_SCALE)) + DN_ALPHA * x2; o[4 * a4 + 3] = ov[3] * (1.f / (AS * PU_SCALE)) + DN_ALPHA * x3;
                s += (o[4 * a4 + 0] + o[4 * a4 + 1]) + (o[4 * a4 + 2] + o[4 * a4 + 3]); }
            const float mean = wave_sum(s) * (1.f / D); float s2 = 0.f;
#pragma unroll
            for (int j = 0; j < 16; ++j) { o[j] -= mean; s2 += o[j] * o[j]; }
            const float rstd = 1.f / sqrtf(wave_sum(s2) * (1.f / D) + LN_EPS);
#pragma unroll
            for (int a4 = 0; a4 < 4; ++a4) { const int hf = a4 >> 1, kh = a4 & 1, c0 = 16 * si + 256 * ((sq >> 1) + 2 * kh) + 8 * hf + 4 * (sq & 1);
                const f32x4 ga = *(const GAS f32x4*)(F.in[I_LN2G] + c0), ba = *(const GAS f32x4*)(F.in[I_LN2B] + c0);
                f32x4 y; y.x = o[4 * a4 + 0] * rstd * ga.x + ba.x; y.y = o[4 * a4 + 1] * rstd * ga.y + ba.y; y.z = o[4 * a4 + 2] * rstd * ga.z + ba.z; y.w = o[4 * a4 + 3] * rstd * ga.w + ba.w;
                *(GAS f32x4*)(F.out + (tokA + t) * D + c0) = y; }
        }
    }
}

struct Args { const float* in[26]; float* out; unsigned char* ws; int ph_lo, ph_hi, li, pad; };
__global__ void __launch_bounds__(NWAVES * 64, 2) fwd_kernel(Args args) {
    extern __shared__ __attribute__((aligned(16))) unsigned char lds[];
    Frame F;
    F.lds = (LAS unsigned char*)lds;
    F.MISC = (volatile LAS unsigned*)(F.lds + MISC_OFF);
    F.tid = threadIdx.x; F.lane = F.tid & 63; F.wave = __builtin_amdgcn_readfirstlane(F.tid >> 6);
    F.G = gridDim.x; { const int bx = blockIdx.x; F.vcu = (F.G % 8 == 0) ? (bx % 8) * (F.G / 8) + bx / 8 : bx; }
#pragma unroll
    for (int i = 0; i < 26; ++i) F.in[i] = args.in[i];
    F.out = args.out; F.ws = args.ws;
    unsigned char* ws = args.ws;
    F.ctl = (gu32*)(ws + WS_CTL);
    for (int u = F.tid; u < (LDS_BYTES - LDSCTL_OFF) / 4; u += NWAVES * 64) ((LAS unsigned*)(F.lds + LDSCTL_OFF))[u] = 0u;
    __syncthreads();
    XcdBarrier bar; bar.bar = (unsigned*)(F.ctl + CW_BAR); bar.x = 0; bar.st = nullptr;
    if (N_LAUNCHES == 1) bar = xcd_barrier_post((unsigned*)(F.ctl + CW_BAR), F.MISC + 8);
#define GRID_BAR() do { if (N_LAUNCHES == 1) xcd_barrier(bar); } while (0)
    const int lo = args.ph_lo, hi = args.ph_hi;
#define IN(k) (lo <= (k) && (k) < hi)
#define BOTH(k) (IN(k) && IN((k) + 1))
    bf16* const Hb = (bf16*)(ws + WS_H);
    bf16* const PRJ = (bf16*)(ws + WS_PROJ);

    if (IN(0)) { p0_prologue(F); if (BOTH(0)) GRID_BAR(); }

    if (IN(1)) {
        s5_tables_stage1(F);
        pg8::Gemm g{Hb, (const bf16*)(ws + WS_WIN), M, NPROJ, D, D, D}; pg8::StaticOrder S; S.init(M, NPROJ, F.G, (int)blockIdx.x);
        pg8::EpiProj E{PRJ, PRJ + (size_t)M * 512, PRJ + (size_t)2 * M * 512, PRJ + (size_t)3 * M * 512, (bf16*)(ws + WS_A5), (const float*)(ws + WS_LB), M};
        pg8::gemm_phase<pg8::EpiProj, pg8::StaticOrder, true, true>(F.lds + RING_OFF, g, S, E);
        if (BOTH(1)) GRID_BAR();
    }

    if (IN(2)) {
        s5_tables_stage2(F);
        if (F.vcu < 128) hgrn2_state_pass(F, F.vcu);
        else { pg8::Gemm g{(const bf16*)(ws + WS_A5), (const bf16*)(ws + WS_G5), 32 * S5I, 32 * 256, 512, S5K, 512}; pg8::GroupedOrder S{4, 1, F.G - 128, F.vcu - 128};
            pg8::EpiS5A E{(float*)(ws + WS_XLOC)};
            pg8::gemm_phase<pg8::EpiS5A, pg8::GroupedOrder, true, true>(F.lds + RING_OFF, g, S, E);
        }
        { constexpr int NTAB16 = PE * D / 16, NCHUNK = 2 * NTAB16 / 4096;
          for (;;) {
              if (F.tid == 0) F.MISC[4] = xb_add((unsigned*)(F.ctl + CW_CONV), 1u);
              __syncthreads();
              const int ch = (int)F.MISC[4];
              __syncthreads();
              if (ch >= NCHUNK) break;
#pragma unroll 2
              for (int q8 = 0; q8 < 8; ++q8) { const int i = ch * 4096 + q8 * 512 + F.tid; const bool up = i >= NTAB16; const int j = up ? i - NTAB16 : i; const float* src = (up ? F.in[I_PU] : F.in[I_PD]) + (size_t)j * 16; const float sc = up ? PU_SCALE : PD_SCALE;
                  v4u o; unsigned ow[4];
#pragma unroll
                  for (int q = 0; q < 4; ++q) { const f32x4 a = *(const GAS f32x4*)(src + 4 * q); int pk = __builtin_amdgcn_cvt_pk_fp8_f32(a.x * sc, a.y * sc, 0, false); pk = __builtin_amdgcn_cvt_pk_fp8_f32(a.z * sc, a.w * sc, pk, true); ow[q] = (unsigned)pk; }
                  o.x = ow[0]; o.y = ow[1]; o.z = ow[2]; o.w = ow[3];
                  *(GAS v4u*)(ws + (up ? WS_PU : WS_PD) + (size_t)j * 16) = o; }
          } }
        if (BOTH(2)) GRID_BAR();
    }

    if (IN(3)) {
        if (F.vcu < 32) s5_scan(F, F.vcu * 512 + F.tid);
        hgrn2_out_phase(F);
        if (BOTH(3)) GRID_BAR();
    }

    if (IN(4)) {
        pg8::Gemm g{(const bf16*)(ws + WS_A5), (const bf16*)(ws + WS_T5), 32 * S5I, 32 * 512, S5K, S5K, S5K}; pg8::GroupedOrder S{4, 2, F.G, F.vcu};
        pg8::EpiS5C E{(bf16*)(ws + WS_Z)};
        pg8::gemm_phase<pg8::EpiS5C, pg8::GroupedOrder, true, true>(F.lds + RING_OFF, g, S, E);
        if (BOTH(4)) GRID_BAR();
    }

    if (IN(5)) {
        pg8::Gemm g{(const bf16*)(ws + WS_Z), (const bf16*)(ws + WS_WGLU), M, 512, 512, 512, 512}; pg8::StaticOrder S; S.init(M, 512, F.G, (int)blockIdx.x);
        pg8::EpiGlu E{(const bf16*)(ws + WS_Z), (bf16*)(ws + WS_MIX), F.in[I_BGLU]};
        pg8::gemm_phase<pg8::EpiGlu, pg8::StaticOrder, true, true>(F.lds + RING_OFF, g, S, E);
        if (BOTH(5)) GRID_BAR();
    }

    if (IN(6)) {
        pg8::Gemm g{(const bf16*)(ws + WS_MIX), (const bf16*)(ws + WS_WOUT), M, D, D, D, D}; pg8::StaticOrder S; S.init(M, D, F.G, (int)blockIdx.x);
        pg8::EpiOut E{Hb, DN_ALPHA};
        pg8::gemm_phase<pg8::EpiOut, pg8::StaticOrder, true, true>(F.lds + RING_OFF, g, S, E);
        if (BOTH(6)) GRID_BAR();
    }

    if (IN(7)) {
        const int gw = F.vcu * NWAVES + F.wave, NGW = F.G * NWAVES;
        for (int m = gw; m < M; m += NGW) ln1_row(Hb + (size_t)m * D, F.in[I_LN1G], F.in[I_LN1B], F.lane);
        if (BOTH(7)) GRID_BAR();
    }

    if (IN(8)) {
        pg8::Gemm g{Hb, (const bf16*)(ws + WS_WQ), M, NQ2, D, D, D}; pg8::StaticOrder S; S.init(M, NQ2, F.G, (int)blockIdx.x);
        pg8::EpiStore E{(bf16*)(ws + WS_Q2), NQ2};
        pg8::gemm_phase<pg8::EpiStore, pg8::StaticOrder, true, true>(F.lds + RING_OFF, g, S, E);
        VM_WAIT(); __syncthreads();
        if (F.tid == 0) { __builtin_amdgcn_fence(__ATOMIC_ACQUIRE, "agent"); VM_WAIT(); }
        __syncthreads();
        peer_score_phase(F, S);
        if (BOTH(8)) GRID_BAR();
    }

    if (IN(9)) { peer_gather_phase(F); }
#undef IN
#undef BOTH
}

extern "C" void kernel_launch(void* const* d_in, const int* in_sizes, int n_in, void* d_out, int out_size, void* d_ws, size_t ws_size, hipStream_t stream) {
    static int grid = 0;
    if (grid == 0) {
        if (n_in != 26 || in_sizes[0] != M * D || out_size != M * D || ws_size < WS_END) { fprintf(stderr, "kernel_launch: unexpected shapes: n_in %d in0 %d out %d ws %zu (need %zu)\n", n_in, n_in > 0 ? in_sizes[0] : -1, out_size, ws_size, (size_t)WS_END); grid = -1; return; }
        int dev = 0, cus = 0;
        if (hipGetDevice(&dev) != hipSuccess || hipDeviceGetAttribute(&cus, hipDeviceAttributeMultiprocessorCount, dev) != hipSuccess) { grid = -1; return; }
        if (hipFuncSetAttribute((const void*)fwd_kernel, hipFuncAttributeMaxDynamicSharedMemorySize, LDS_BYTES) != hipSuccess) { fprintf(stderr, "kernel_launch: hipFuncSetAttribute failed\n"); grid = -1; return; }
        (void)hipGetLastError();
        grid = cus;
    }
    if (grid < 0) return;
    if (hipMemsetAsync((char*)d_ws + WS_CTL, 0, CTL_ZERO_BYTES, stream) != hipSuccess) return;
    Args a{};
    for (int i = 0; i < 26; ++i) a.in[i] = (const float*)d_in[i];
    a.out = (float*)d_out; a.ws = (unsigned char*)d_ws;
    if (N_LAUNCHES == 1) { a.ph_lo = 0; a.ph_hi = NPH; a.li = 0; hipLaunchKernelGGL(fwd_kernel, dim3(grid), dim3(NWAVES * 64), LDS_BYTES, stream, a); }
    else for (int li = 0; li < NPH; ++li) { a.ph_lo = li; a.ph_hi = li + 1; a.li = li; hipLaunchKernelGGL(fwd_kernel, dim3(grid), dim3(NWAVES * 64), LDS_BYTES, stream, a); }
}
```

```cpp
#include <hip/hip_runtime.h>
#include <cstdio>
#include <cstdint>
namespace pg8 {
#define PG8_LAS __attribute__((address_space(3)))
typedef unsigned short bf16_t;
typedef short bf16x8 __attribute__((ext_vector_type(8)));
typedef float f32x4 __attribute__((ext_vector_type(4)));
typedef unsigned u32x4 __attribute__((ext_vector_type(4)));
constexpr int BM = 256, BK = 64, HALF = 128, HTB = HALF * BK * 2  , STAGE_BYTES = 8 * HTB, NXCD = 8, WGM = 8;

__host__ __device__ __forceinline__ int lds_byte(int r, int c) { const int st = (r >> 4) * 2 + (c >> 5), rr = r & 15, cc = c & 31, ob = rr * 64 + cc * 2; return st * 1024 + (ob ^ (((ob >> 9) & 1) << 5)); }
__host__ __device__ __forceinline__ void stage_rc(int b, int& R, int& C) { const int st = b / 1024, sb = b % 1024, swz = sb ^ (((sb >> 9) & 1) << 5); R = (st >> 1) * 16 + swz / 64; C = (st & 1) * 32 + (swz % 64) / 2; }
__host__ __device__ __forceinline__ int perm32(int rho) { const int n = rho >> 4, i = rho & 15; return 8 * (i >> 2) + 4 * n + (i & 3); }

struct Unit { int pm, pn; };
struct Gemm { const bf16_t* A; const bf16_t* Bt; int M, N, K, lda, ldb; };

struct StaticOrder {
    int nM, nN, nwg, G, c;
    __host__ __device__ void init(int M, int N, int G_, int c_) { nM = M / BM; nN = N / BM; nwg = nM * nN; G = G_; c = c_; }
    __host__ __device__ bool next(int i, Unit& u) const {
        const long L = (long)i * G + c; if (L >= nwg) return false;
        int wgid = (int)L; { const int q = nwg / NXCD, r = nwg % NXCD, xcd = wgid % NXCD, off = wgid / NXCD; wgid = (xcd < r ? xcd * (q + 1) : r * (q + 1) + (xcd - r) * q) + off; }
        const int nig = WGM * nN, gid = wgid / nig, fm = gid * WGM, gsz = (nM - fm) < WGM ? (nM - fm) : WGM;
        u.pm = fm + ((wgid % nig) % gsz); u.pn = (wgid % nig) / gsz; return true;
    }
    __device__ __forceinline__ void a_ready(const Unit&) const {}
    __device__ __forceinline__ void done(const Unit&) const {}
};

__device__ __forceinline__ unsigned cvt_pk_bf16(float lo, float hi) { unsigned r; asm volatile("v_cvt_pk_bf16_f32 %0, %1, %2" : "=v"(r) : "v"(lo), "v"(hi)); return r; }
__device__ __forceinline__ void unpack8(const u32x4 w, float (&f)[8]) {
    f[0] = __builtin_bit_cast(float, w.x << 16); f[1] = __builtin_bit_cast(float, w.x & 0xffff0000u);
    f[2] = __builtin_bit_cast(float, w.y << 16); f[3] = __builtin_bit_cast(float, w.y & 0xffff0000u);
    f[4] = __builtin_bit_cast(float, w.z << 16); f[5] = __builtin_bit_cast(float, w.z & 0xffff0000u);
    f[6] = __builtin_bit_cast(float, w.w << 16); f[7] = __builtin_bit_cast(float, w.w & 0xffff0000u);
}
__device__ __forceinline__ u32x4 pack8(const float (&f)[8]) { u32x4 w; w.x = cvt_pk_bf16(f[0], f[1]); w.y = cvt_pk_bf16(f[2], f[3]); w.z = cvt_pk_bf16(f[4], f[5]); w.w = cvt_pk_bf16(f[6], f[7]); return w; }

struct EpiStore {
    static constexpr bool PERM = true, AFTER_DRAIN = false;
    bf16_t* O; int ldc;
    __device__ __forceinline__ void operator()(const f32x4 (&acc)[2][2][4][2], const Unit& u, int wr, int wc, int fr, int fq) const {
        const int row0 = u.pm * BM + wr * 64 + fr, col0 = u.pn * BM + wc * 32 + 8 * fq;
#pragma unroll
        for (int ai = 0; ai < 2; ++ai)
#pragma unroll
            for (int m = 0; m < 4; ++m) { bf16_t* rowp = O + (size_t)(row0 + ai * HALF + m * 16) * ldc + col0;
#pragma unroll
                for (int bj = 0; bj < 2; ++bj) { const f32x4 v0 = acc[ai][bj][m][0], v1 = acc[ai][bj][m][1];
                    u32x4 w; w.x = cvt_pk_bf16(v0[0], v0[1]); w.y = cvt_pk_bf16(v0[2], v0[3]); w.z = cvt_pk_bf16(v1[0], v1[1]); w.w = cvt_pk_bf16(v1[2], v1[3]);
                    *(u32x4*)(rowp + bj * HALF) = w; } }
    }
};

struct EpiProj {
    static constexpr bool PERM = true, AFTER_DRAIN = false;
    bf16_t* Qb; bf16_t* LFb; bf16_t* Vb; bf16_t* Gb; bf16_t* Ub; const float* lb; int M;
    __device__ __forceinline__ void operator()(const f32x4 (&acc)[2][2][4][2], const Unit& u, int wr, int wc, int fr, int fq) const {
        const int row0 = u.pm * BM + wr * 64 + fr; const int colt = u.pn * BM; const int t = colt >> 9;
        const int cb = (colt & 511) + wc * 32 + 8 * fq;
        float lbv[2][8];
        if (t == 1) {
#pragma unroll
            for (int bj = 0; bj < 2; ++bj) { const f32x4 a = *(const f32x4*)(lb + cb + bj * HALF), b = *(const f32x4*)(lb + cb + bj * HALF + 4);
                lbv[bj][0] = a[0]; lbv[bj][1] = a[1]; lbv[bj][2] = a[2]; lbv[bj][3] = a[3]; lbv[bj][4] = b[0]; lbv[bj][5] = b[1]; lbv[bj][6] = b[2]; lbv[bj][7] = b[3]; }
        }
#pragma unroll
        for (int ai = 0; ai < 2; ++ai)
#pragma unroll
            for (int m = 0; m < 4; ++m) { const int row = row0 + ai * HALF + m * 16;
#pragma unroll
                for (int bj = 0; bj < 2; ++bj) { const f32x4 v0 = acc[ai][bj][m][0], v1 = acc[ai][bj][m][1]; const int c = cb + bj * HALF;
                    float f[8] = {v0[0], v0[1], v0[2], v0[3], v1[0], v1[1], v1[2], v1[3]};
                    if (t == 0) {
#pragma unroll
                        for (int j = 0; j < 8; ++j) f[j] *= 0.08838834764831845f;
                        *(u32x4*)(Qb + (size_t)row * 512 + c) = pack8(f);
                    } else if (t == 1) {
#pragma unroll
                        for (int j = 0; j < 8; ++j) { const float l = lbv[bj][j]; const float sg = 1.f / (1.f + __expf(-f[j])); f[j] = __logf(l + (1.f - l) * sg); }
                        *(u32x4*)(LFb + (size_t)row * 512 + c) = pack8(f);
                    } else if (t == 2) { *(u32x4*)(Vb + (size_t)row * 512 + c) = pack8(f);
                    } else if (t == 3) { *(u32x4*)(Gb + (size_t)row * 512 + c) = pack8(f);
                    } else { *(u32x4*)(Ub + ((size_t)(c >> 4) * (M / 32) + (row >> 5)) * 640 + (row & 31) * 16 + (c & 15)) = pack8(f); }
                } }
    }
};

struct EpiGlu {
    static constexpr bool PERM = true, AFTER_DRAIN = false;
    const bf16_t* Z; bf16_t* MIX; const float* bglu;
    __device__ __forceinline__ void operator()(const f32x4 (&acc)[2][2][4][2], const Unit& u, int wr, int wc, int fr, int fq) const {
        const int row0 = u.pm * BM + wr * 64 + fr, col0 = u.pn * BM + wc * 32 + 8 * fq;
#pragma unroll
        for (int bj = 0; bj < 2; ++bj) { const int c = col0 + bj * HALF;
            const f32x4 b0 = *(const f32x4*)(bglu + c), b1 = *(const f32x4*)(bglu + c + 4);
#pragma unroll
            for (int ai = 0; ai < 2; ++ai)
#pragma unroll
                for (int m = 0; m < 4; ++m) { const int row = row0 + ai * HALF + m * 16;
                    const f32x4 v0 = acc[ai][bj][m][0] + b0, v1 = acc[ai][bj][m][1] + b1;
                    float z[8]; unpack8(*(const u32x4*)(Z + (size_t)row * 512 + c), z);
                    float f[8] = {v0[0], v0[1], v0[2], v0[3], v1[0], v1[1], v1[2], v1[3]};
#pragma unroll
                    for (int j = 0; j < 8; ++j) f[j] = z[j] / (1.f + __expf(-f[j]));
                    *(u32x4*)(MIX + (size_t)row * 1024 + 512 + c) = pack8(f); } }
    }
};

struct EpiOut {
    static constexpr bool PERM = true, AFTER_DRAIN = false;
    bf16_t* H; float alpha;
    __device__ __forceinline__ void operator()(const f32x4 (&acc)[2][2][4][2], const Unit& u, int wr, int wc, int fr, int fq) const {
        const int row0 = u.pm * BM + wr * 64 + fr, col0 = u.pn * BM + wc * 32 + 8 * fq;
#pragma unroll
        for (int ai = 0; ai < 2; ++ai)
#pragma unroll
            for (int m = 0; m < 4; ++m) { bf16_t* rowp = H + (size_t)(row0 + ai * HALF + m * 16) * 1024 + col0;
#pragma unroll
                for (int bj = 0; bj < 2; ++bj) { const f32x4 v0 = acc[ai][bj][m][0], v1 = acc[ai][bj][m][1];
                    float h[8]; unpack8(*(const u32x4*)(rowp + bj * HALF), h);
                    float f[8] = {v0[0], v0[1], v0[2], v0[3], v1[0], v1[1], v1[2], v1[3]};
#pragma unroll
                    for (int j = 0; j < 8; ++j) f[j] = alpha * h[j] + f[j];
                    *(u32x4*)(rowp + bj * HALF) = pack8(f); } }
    }
};

struct GroupedOrder {
    int tm, tn, G, c;
    __device__ bool next(int i, Unit& u) const { const int L = i * G + c, per = tm * tn; if (c < 0 || L >= 32 * per) return false;
        const int g = L / per, r = L % per; u.pm = g * tm + r % tm; u.pn = g * tn + r / tm; return true; }
    __device__ __forceinline__ void a_ready(const Unit&) const {}
    __device__ __forceinline__ void done(const Unit&) const {}
};
struct EpiS5A {
    static constexpr bool PERM = true, AFTER_DRAIN = false;
    float* X;
    __device__ __forceinline__ void operator()(const f32x4 (&acc)[2][2][4][2], const Unit& u, int wr, int wc, int fr, int fq) const {
        const int g = u.pn, inst0 = (u.pm & 3) * BM + wr * 64 + fr, col = wc * 32 + 8 * fq;
#pragma unroll
        for (int ai = 0; ai < 2; ++ai)
#pragma unroll
            for (int m = 0; m < 4; ++m) { float* p = X + ((size_t)(inst0 + ai * HALF + m * 16) * 32 + g) * 128 + col;
                *(f32x4*)p = acc[ai][0][m][0]; *(f32x4*)(p + 4) = acc[ai][0][m][1]; }
    }
};
struct EpiS5C {
    static constexpr bool PERM = true, AFTER_DRAIN = false;
    bf16_t* Z;
    __device__ __forceinline__ void operator()(const f32x4 (&acc)[2][2][4][2], const Unit& u, int wr, int wc, int fr, int fq) const {
        const int g = u.pm >> 2, inst0 = (u.pm & 3) * BM + wr * 64 + fr, col0 = (u.pn & 1) * BM + wc * 32 + 8 * fq;
#pragma unroll
        for (int ai = 0; ai < 2; ++ai)
#pragma unroll
            for (int m = 0; m < 4; ++m) { const int inst = inst0 + ai * HALF + m * 16; const size_t tok0 = (size_t)(inst >> 7) * 4096 + (size_t)(inst & 127) * 32;
#pragma unroll
                for (int bj = 0; bj < 2; ++bj) { const int col = col0 + bj * HALF; const f32x4 v0 = acc[ai][bj][m][0], v1 = acc[ai][bj][m][1];
                    float f[8] = {v0[0], v0[1], v0[2], v0[3], v1[0], v1[1], v1[2], v1[3]};
#pragma unroll
                    for (int j = 0; j < 8; ++j) { const float x = f[j], y = 0.7978845608028654f * (x + 0.044715f * x * x * x); f[j] = x / (1.f + __expf(-2.f * y)); }
                    *(u32x4*)(Z + (tok0 + (col >> 4)) * 512 + g * 16 + (col & 15)) = pack8(f); } }
    }
};

template <class Epi, class Sched, bool ALIGN_EPI = false, bool SP2 = false>
__device__ __forceinline__ void gemm_phase(PG8_LAS unsigned char* lds, const Gemm g, const Sched& S, const Epi& E) {
    const int tid = threadIdx.x, wid = __builtin_amdgcn_readfirstlane(tid >> 6), lane = tid & 63, wr = wid >> 2, wc = wid & 3, fr = lane & 15, fq = lane >> 4;
    const int K = g.K, nt = K / BK;
    unsigned voffA[2], voffB[2];
#pragma unroll
    for (int i = 0; i < 2; ++i) { int R, C; stage_rc(tid * 16 + i * 8192, R, C); const int Rb = Epi::PERM ? ((R & ~31) + perm32(R & 31)) : R;
        voffA[i] = (unsigned)(R * g.lda + C) * 2u; voffB[i] = (unsigned)(Rb * g.ldb + C) * 2u; }
    const size_t kstep = (size_t)(BK * 2);
    const size_t hstepA = (size_t)HALF * g.lda * 2, hstepB = (size_t)HALF * g.ldb * 2;
    const size_t tstepA = 2 * hstepA, tstepB = 2 * hstepB;
    const unsigned ldsw = (unsigned)wid * 1024u;
    const int aoff = lds_byte(wr * 64 + fr, fq * 8), boff = lds_byte(wc * 32 + fr, fq * 8);
#define PG8_SA(b, h) (((b) * 2 + (h)) * HTB)
#define PG8_SB(b, h) ((4 + (b) * 2 + (h)) * HTB)
#define PG8_STAGE(bufoff, gbase, voff) do { _Pragma("unroll") for (int _i = 0; _i < 2; ++_i) \
        __builtin_amdgcn_global_load_lds((const unsigned*)((const char*)(gbase) + (voff)[_i]), (PG8_LAS unsigned*)(lds + (bufoff) + ldsw + _i * 8192), 16, 0, 0); } while (0)
#define PG8_LDA(dst, b, h) do { _Pragma("unroll") for (int m = 0; m < 4; ++m) _Pragma("unroll") for (int k = 0; k < 2; ++k) dst[m][k] = *(const PG8_LAS bf16x8*)(lds + PG8_SA(b, h) + aoff + m * 2048 + k * 1024); } while (0)
#define PG8_LDB(dst, b, h) do { _Pragma("unroll") for (int n = 0; n < 2; ++n) _Pragma("unroll") for (int k = 0; k < 2; ++k) dst[n][k] = *(const PG8_LAS bf16x8*)(lds + PG8_SB(b, h) + boff + n * 2048 + k * 1024); } while (0)
#define PG8_MMA(ai, bj, At, Bt) do { __builtin_amdgcn_s_setprio(1); _Pragma("unroll") for (int m = 0; m < 4; ++m) _Pragma("unroll") for (int n = 0; n < 2; ++n) _Pragma("unroll") for (int k = 0; k < 2; ++k) \
        acc[ai][bj][m][n] = __builtin_amdgcn_mfma_f32_16x16x32_bf16(Bt[n][k], At[m][k], acc[ai][bj][m][n], 0, 0, 0); __builtin_amdgcn_s_setprio(0); } while (0)
#define PG8_WAIT_V(n) asm volatile("s_waitcnt vmcnt(" #n ")" ::: "memory")
#define PG8_WAIT_L(n) asm volatile("s_waitcnt lgkmcnt(" #n ")" ::: "memory")
#define PG8_BAR __builtin_amdgcn_s_barrier()
#define PG8_SCHED __builtin_amdgcn_sched_barrier(0)
    Unit cur, nxt; int ui = 0;
    if (!S.next(0, cur)) return;
    f32x4 acc[2][2][4][2];
#pragma unroll
    for (int a = 0; a < 2; ++a)
#pragma unroll
        for (int b = 0; b < 2; ++b)
#pragma unroll
            for (int m = 0; m < 4; ++m)
#pragma unroll
                for (int n = 0; n < 2; ++n) acc[a][b][m][n] = (f32x4){0.f, 0.f, 0.f, 0.f};
    bf16x8 At[4][2], B0[2][2], B1[2][2];
    const char* cA = (const char*)g.A + (size_t)cur.pm * tstepA; const char* cB = (const char*)g.Bt + (size_t)cur.pn * tstepB;
    S.a_ready(cur);
    if constexpr (SP2) {
        PG8_STAGE(PG8_SB(0, 0), cB, voffB); PG8_STAGE(PG8_SB(0, 1), cB + hstepB, voffB); PG8_STAGE(PG8_SA(0, 0), cA, voffA); PG8_STAGE(PG8_SA(0, 1), cA + hstepA, voffA);
        if (wr == 1) PG8_BAR;
        PG8_WAIT_V(2); PG8_BAR;
        PG8_STAGE(PG8_SB(1, 0), cB + kstep, voffB); PG8_STAGE(PG8_SA(1, 0), cA + kstep, voffA); PG8_STAGE(PG8_SB(1, 1), cB + hstepB + kstep, voffB);
        PG8_WAIT_V(6); PG8_BAR;
    } else {
        PG8_STAGE(PG8_SB(0, 0), cB, voffB); PG8_STAGE(PG8_SA(0, 0), cA, voffA); PG8_STAGE(PG8_SB(0, 1), cB + hstepB, voffB); PG8_STAGE(PG8_SA(0, 1), cA + hstepA, voffA);
        if (wr == 1) PG8_BAR;
        PG8_WAIT_V(4); PG8_BAR;
        PG8_STAGE(PG8_SB(1, 0), cB + kstep, voffB); PG8_STAGE(PG8_SA(1, 0), cA + kstep, voffA); PG8_STAGE(PG8_SB(1, 1), cB + hstepB + kstep, voffB);
        PG8_WAIT_V(6); PG8_BAR;
    }
    for (;;) {
        const bool has_next = S.next(ui + 1, nxt);
        const char* nA = has_next ? (const char*)g.A + (size_t)nxt.pm * tstepA : cA; const char* nB = has_next ? (const char*)g.Bt + (size_t)nxt.pn * tstepB : cB;
        for (int t = 0; t < nt; t += 2) {
            const bool last = (t == nt - 2);
            const char* a1 = cA + (size_t)(t + 1) * kstep;
            const char* a2 = last ? nA : cA + (size_t)(t + 2) * kstep; const char* b2 = last ? nB : cB + (size_t)(t + 2) * kstep;
            const char* a3 = a2 + kstep; const char* b3 = b2 + kstep;
            if (last && has_next) S.a_ready(nxt);
            if constexpr (SP2) {
            PG8_LDB(B0, 0, 0); PG8_LDB(B1, 0, 1); PG8_SCHED; PG8_LDA(At, 0, 0); PG8_STAGE(PG8_SA(1, 1), a1 + hstepA, voffA);
            PG8_WAIT_V(8); PG8_WAIT_L(0); PG8_BAR; PG8_MMA(0, 0, At, B0); PG8_MMA(0, 1, At, B1); PG8_BAR; PG8_SCHED;
            PG8_LDA(At, 0, 1); PG8_STAGE(PG8_SB(0, 0), b2, voffB); PG8_STAGE(PG8_SB(0, 1), b2 + hstepB, voffB); PG8_STAGE(PG8_SA(0, 0), a2, voffA);
            PG8_WAIT_V(8); PG8_WAIT_L(0); PG8_BAR; PG8_MMA(1, 0, At, B0); PG8_MMA(1, 1, At, B1); PG8_BAR; PG8_SCHED;
            PG8_LDB(B0, 1, 0); PG8_LDB(B1, 1, 1); PG8_SCHED; PG8_LDA(At, 1, 0); PG8_STAGE(PG8_SA(0, 1), a2 + hstepA, voffA);
            PG8_WAIT_V(8); PG8_WAIT_L(0); PG8_BAR; PG8_MMA(0, 0, At, B0); PG8_MMA(0, 1, At, B1); PG8_BAR; PG8_SCHED;
            PG8_LDA(At, 1, 1); PG8_STAGE(PG8_SB(1, 0), b3, voffB); PG8_STAGE(PG8_SB(1, 1), b3 + hstepB, voffB); PG8_STAGE(PG8_SA(1, 0), a3, voffA);
            PG8_WAIT_V(8); PG8_WAIT_L(0); PG8_BAR; PG8_MMA(1, 0, At, B0); PG8_MMA(1, 1, At, B1); PG8_BAR; PG8_SCHED;
            } else {
            PG8_LDB(B0, 0, 0); PG8_SCHED; PG8_LDA(At, 0, 0); PG8_STAGE(PG8_SA(1, 1), a1 + hstepA, voffA);
            PG8_WAIT_L(8); PG8_BAR; PG8_WAIT_L(0); PG8_MMA(0, 0, At, B0); PG8_BAR; PG8_SCHED;
            PG8_LDB(B1, 0, 1); PG8_STAGE(PG8_SB(0, 0), b2, voffB);
            PG8_BAR; PG8_WAIT_L(0); PG8_MMA(0, 1, At, B1); PG8_BAR;
            PG8_LDA(At, 0, 1); PG8_STAGE(PG8_SA(0, 0), a2, voffA);
            PG8_BAR; PG8_WAIT_L(0); PG8_MMA(1, 0, At, B0); PG8_BAR; PG8_SCHED;
            PG8_STAGE(PG8_SB(0, 1), b2 + hstepB, voffB);
            PG8_WAIT_V(6); PG8_BAR; PG8_MMA(1, 1, At, B1); PG8_BAR;
            PG8_LDB(B0, 1, 0); PG8_SCHED; PG8_LDA(At, 1, 0); PG8_STAGE(PG8_SA(0, 1), a2 + hstepA, voffA);
            PG8_WAIT_L(8); PG8_BAR; PG8_WAIT_L(0); PG8_MMA(0, 0, At, B0); PG8_BAR; PG8_SCHED;
            PG8_LDB(B1, 1, 1); PG8_STAGE(PG8_SB(1, 0), b3, voffB);
            PG8_BAR; PG8_WAIT_L(0); PG8_MMA(0, 1, At, B1); PG8_BAR;
            PG8_LDA(At, 1, 1); PG8_STAGE(PG8_SA(1, 0), a3, voffA);
            PG8_BAR; PG8_WAIT_L(0); PG8_MMA(1, 0, At, B0); PG8_BAR; PG8_SCHED;
            PG8_STAGE(PG8_SB(1, 1), b3 + hstepB, voffB);
            PG8_WAIT_V(6); PG8_BAR; PG8_MMA(1, 1, At, B1); PG8_BAR;
            }
        }
        if constexpr (ALIGN_EPI) { if (wr == 0) PG8_BAR; }
        if constexpr (!Epi::AFTER_DRAIN) { E(acc, cur, wr, wc, fr, fq); S.done(cur); }
        if (!has_next) break;
#pragma unroll
        for (int a = 0; a < 2; ++a)
#pragma unroll
            for (int b = 0; b < 2; ++b)
#pragma unroll
                for (int m = 0; m < 4; ++m)
#pragma unroll
                    for (int n = 0; n < 2; ++n) acc[a][b][m][n] = (f32x4){0.f, 0.f, 0.f, 0.f};
        cur = nxt; cA = nA; cB = nB; ++ui;
        if constexpr (ALIGN_EPI) { if (wr == 1) PG8_BAR; }
    }
    PG8_WAIT_V(0);
    if constexpr (!ALIGN_EPI) { if (wr == 0) PG8_BAR; }
    PG8_BAR;
    if constexpr (Epi::AFTER_DRAIN) { E.fused(acc, cur, wr, wc, fr, fq, lds, wid, lane); S.done(cur); }
#undef PG8_SA
#undef PG8_SB
#undef PG8_STAGE
#undef PG8_LDA
#undef PG8_LDB
#undef PG8_MMA
#undef PG8_WAIT_V
#undef PG8_WAIT_L
#undef PG8_BAR
#undef PG8_SCHED
}
}

constexpr int NWAVES = 8;
#ifndef MK_N_LAUNCHES
#define MK_N_LAUNCHES 1
#endif
constexpr int N_LAUNCHES = MK_N_LAUNCHES;
constexpr int NPH = 9;
#ifndef PROBE_REP
#define PROBE_REP -1
#endif

constexpr int BATCH = 8, SEQ = 4096, D = 1024, M = BATCH * SEQ;
constexpr int HGW = 512, HGH = 4, HGK = 128;
constexpr int S5W = 512, S5G = 32, S5P = 16, S5N = 64;
constexpr int S5L = 32, S5I = M / S5L, S5K = S5L * S5P + 2 * S5N;
constexpr int NPROJ = 2560;
constexpr int PK = 128, PH = 8, PTOPK = 16, PQ = 256, PHALF = 128, PE = PK * PK, NQ2 = PH * PQ;
constexpr float LN_EPS = 1e-5f, RMS_EPS = 1e-6f;
constexpr float DN_ALPHA = 1.189207115002721f;

constexpr size_t MiB = 1u << 20;
constexpr size_t WS_CTL = 0, CTL_ZERO_BYTES = 1 * MiB;
constexpr size_t WS_WIN = 1 * MiB;
constexpr size_t WS_WGLU = 6 * MiB;
constexpr size_t WS_KEYS = 6 * MiB + 512 * 1024;
constexpr size_t WS_LB = 6 * MiB + 640 * 1024;
constexpr size_t WS_S5T = 6 * MiB + 704 * 1024;
constexpr size_t WS_WOUT = 7 * MiB + 512 * 1024;
constexpr size_t WS_WQ = 10 * MiB;
constexpr size_t WS_SST = 14 * MiB;
constexpr size_t WS_H = 78 * MiB;
constexpr size_t WS_PROJ = 142 * MiB;
constexpr size_t WS_Q2 = WS_PROJ;
constexpr size_t WS_A5 = 270 * MiB;
constexpr size_t WS_MIX = 310 * MiB;
constexpr size_t WS_PD = 452 * MiB, WS_PU = 468 * MiB;
constexpr size_t WS_Z = 374 * MiB;
constexpr size_t WS_EIDX = WS_Z, WS_EGATE = WS_Z + 16 * MiB;
constexpr size_t WS_T5 = 406 * MiB;
constexpr size_t WS_G5 = 426 * MiB;
constexpr size_t WS_XLOC = 434 * MiB;
constexpr size_t WS_KTAU = 450 * MiB;
constexpr size_t WS_PW = 451 * MiB;
constexpr size_t WS_END = 484 * MiB;
constexpr int CW_TMO = 0, CW_CODE = 1;
constexpr int CW_BAR = 4096, CW_BAR2 = 8192;
constexpr int CW_CONV = 65536;

constexpr int RING_OFF = 0, RING_BYTES = 147456;
constexpr int LDSCTL_OFF = RING_BYTES, MISC_OFF = LDSCTL_OFF + 320;
constexpr int LDS_BYTES = 151552;
static_assert(MISC_OFF + 128 <= LDS_BYTES, "LDS map");

#define GAS __attribute__((address_space(1)))
#define LAS __attribute__((address_space(3)))
typedef unsigned short bf16;
typedef unsigned v4u __attribute__((ext_vector_type(4)));
typedef float f32x4 __attribute__((ext_vector_type(4)));
typedef short bf16x8 __attribute__((ext_vector_type(8)));
typedef GAS unsigned gu32;
typedef GAS unsigned long long gu64;
#define RLX_AGENT __ATOMIC_RELAXED, __HIP_MEMORY_SCOPE_AGENT
#define LDS_WAIT() asm volatile("s_waitcnt lgkmcnt(0)" ::: "memory")
#define VM_WAIT() asm volatile("s_waitcnt vmcnt(0)" ::: "memory")
__device__ __forceinline__ unsigned long long rt() { return __builtin_amdgcn_s_memrealtime(); }
__device__ __forceinline__ unsigned f2bf(float f) { unsigned u = __builtin_bit_cast(unsigned, f); return (u + 0x7fffu + ((u >> 16) & 1u)) >> 16; }
__device__ __forceinline__ unsigned pk2(float lo, float hi) { return f2bf(lo) | (f2bf(hi) << 16); }

#define XB_TMO      128
#define XB_XCNT(j)  (256  + 64 * (j))
#define XB_XSUB(j)  (1280 + 64 * (j))
#define XB_XGEN(j)  (2304 + 64 * (j))
#define XB_TOP      3328
#define XB_TOPGEN   3392
#define XCD_BAR_WORDS 3456
#define XB_SPIN_CAP (1u << 18)

__device__ __forceinline__ unsigned xb_ld(unsigned* p)              { return __hip_atomic_load(p, __ATOMIC_RELAXED, __HIP_MEMORY_SCOPE_AGENT); }
__device__ __forceinline__ unsigned xb_add(unsigned* p, unsigned v) { return __hip_atomic_fetch_add(p, v, __ATOMIC_RELAXED, __HIP_MEMORY_SCOPE_AGENT); }
__device__ __forceinline__ unsigned xb_xcc_id() { return (unsigned)__builtin_amdgcn_s_getreg((3 << 11) | 20) & 0xFu; }
#define XB_SPIN(cond, bar) do { unsigned _sp = 0; while (cond) { __builtin_amdgcn_s_sleep(1); \
    if ((++_sp & 255u) == 0u) { if (xb_ld(&(bar)[XB_TMO])) break; if (_sp > XB_SPIN_CAP) { atomicAdd(&(bar)[XB_TMO], 1u); break; } } } } while (0)

struct XcdBarrier {
    unsigned* bar; unsigned x; unsigned G;
    volatile LAS unsigned* st;
};

__device__ __forceinline__ XcdBarrier xcd_barrier_post(unsigned* bar, volatile LAS unsigned* st, unsigned G) {
    XcdBarrier b; b.bar = bar; b.x = xb_xcc_id(); b.st = st; b.G = G;
    if (threadIdx.x == 0) (void)xb_add(&bar[XB_XCNT(b.x)], 1u);
    return b;
}
__device__ __forceinline__ void xcd_barrier_complete(unsigned* bar, unsigned x, unsigned G, unsigned& nloc, unsigned& nx) {
    unsigned sum, cnt, mine, sp = 0u;
    for (;;) {
        sum = 0u; cnt = 0u; mine = 0u;
#pragma unroll
        for (unsigned j = 0; j < 16; ++j) { const unsigned c = xb_ld(&bar[XB_XCNT(j)]); sum += c; cnt += (c > 0u) ? 1u : 0u; mine = (j == x) ? c : mine; }
        if (sum == G) break;
        __builtin_amdgcn_s_sleep(1);
        if ((++sp & 255u) == 0u) { if (xb_ld(&bar[XB_TMO])) break; if (sp > XB_SPIN_CAP) { atomicAdd(&bar[XB_TMO], 1u); break; } }
    }
    nloc = mine > 0u ? mine : 1u; nx = cnt > 0u ? cnt : 1u;
}

__device__ __forceinline__ void xcd_barrier(const XcdBarrier& b) {
    asm volatile("s_waitcnt vmcnt(0)" ::: "memory");
    __syncthreads();
    if (threadIdx.x == 0) {
        unsigned* bar = b.bar;
        __builtin_amdgcn_s_waitcnt(0);
        unsigned nloc = b.st[0], nx = b.st[1];
        if (nloc == 0u) { xcd_barrier_complete(bar, b.x, b.G, nloc, nx); b.st[0] = nloc; b.st[1] = nx; }
        const unsigned old = xb_add(&bar[XB_XSUB(b.x)], 1u);
        const unsigned gen = old / nloc;
        if (old + 1u == (gen + 1u) * nloc) {
            __builtin_amdgcn_fence(__ATOMIC_RELEASE, "agent");
            asm volatile("s_waitcnt vmcnt(0)" ::: "memory");
            const unsigned og = xb_add(&bar[XB_TOP], 1u);
            const unsigned tg = og / nx;
            if (og + 1u == (tg + 1u) * nx) xb_add(&bar[XB_TOPGEN], 1u);
            else XB_SPIN(xb_ld(&bar[XB_TOPGEN]) == tg, bar);
            __builtin_amdgcn_fence(__ATOMIC_ACQUIRE, "agent");
            xb_add(&bar[XB_XGEN(b.x)], 1u);
            asm volatile("s_waitcnt vmcnt(0)" ::: "memory");
        } else {
            XB_SPIN(xb_ld(&bar[XB_XGEN(b.x)]) == gen, bar);
            __builtin_amdgcn_fence(__ATOMIC_ACQUIRE, "agent");
            asm volatile("s_waitcnt vmcnt(0)" ::: "memory");
        }
    }
    __syncthreads();
}

struct Frame {
    LAS unsigned char* lds;
    volatile LAS unsigned* MISC;
    gu32* ctl;
    int tid, lane, wave;
    int vcu, G;
    const float* in[26]; float* out; unsigned char* ws;
};
enum { I_X = 0, I_LN0G, I_LN0B, I_WIN, I_LBL, I_HGNG, I_ARE, I_AIM, I_LSTEP, I_BRE, I_BIM, I_CRE, I_CIM, I_DSK, I_WGLU, I_BGLU, I_WOUT, I_LN1G, I_LN1B, I_WQ, I_K1, I_K2, I_PD, I_PU, I_LN2G, I_LN2B };

__device__ __forceinline__ float bf2f(bf16 v) { return __builtin_bit_cast(float, (unsigned)v << 16); }
__device__ __forceinline__ float wave_sum(float v) {
#pragma unroll
    for (int o = 1; o < 64; o <<= 1) v += __shfl_xor(v, o);
    return v;
}
__device__ __forceinline__ float wave_max(float v) {
#pragma unroll
    for (int o = 1; o < 64; o <<= 1) v = fmaxf(v, __shfl_xor(v, o));
    return v;
}
__device__ __forceinline__ float gelu_tanh(float x) { const float y = 0.7978845608028654f * (x + 0.044715f * x * x * x); return x / (1.f + __expf(-2.f * y)); }
__device__ __forceinline__ float silu_f(float x) { return x / (1.f + __expf(-x)); }
__device__ __forceinline__ void unpack8(const v4u w, float (&f)[8]) {
    f[0] = __builtin_bit_cast(float, w.x << 16); f[1] = __builtin_bit_cast(float, w.x & 0xffff0000u);
    f[2] = __builtin_bit_cast(float, w.y << 16); f[3] = __builtin_bit_cast(float, w.y & 0xffff0000u);
    f[4] = __builtin_bit_cast(float, w.z << 16); f[5] = __builtin_bit_cast(float, w.z & 0xffff0000u);
    f[6] = __builtin_bit_cast(float, w.w << 16); f[7] = __builtin_bit_cast(float, w.w & 0xffff0000u);
}
__device__ __forceinline__ v4u pack8(const float (&f)[8]) { v4u w; w.x = pk2(f[0], f[1]); w.y = pk2(f[2], f[3]); w.z = pk2(f[4], f[5]); w.w = pk2(f[6], f[7]); return w; }

__device__ __forceinline__ void p0_transpose_item(const float* W, int K, int N, bf16* WT, int row_off, LAS float* scr, int item, int lane) {
    const int nblk = N / 32, kb = item / nblk, nb = item % nblk, k0 = 64 * kb, n0 = 32 * nb;
#pragma unroll 8
    for (int i = 0; i < 32; ++i) { const int kk = 2 * i + (lane >> 5); scr[kk * 33 + (lane & 31)] = W[(size_t)(k0 + kk) * N + n0 + (lane & 31)]; }
    LDS_WAIT(); asm volatile("" ::: "memory");
    const int c = lane & 7;
#pragma unroll
    for (int j = 0; j < 4; ++j) { const int n = (lane >> 3) + 8 * j; const LAS float* s = scr + (8 * c) * 33 + n;
        v4u o; o.x = pk2(s[0 * 33], s[1 * 33]); o.y = pk2(s[2 * 33], s[3 * 33]); o.z = pk2(s[4 * 33], s[5 * 33]); o.w = pk2(s[6 * 33], s[7 * 33]);
        *(GAS v4u*)(WT + (size_t)(row_off + n0 + n) * K + k0 + 8 * c) = o; }
    LDS_WAIT(); asm volatile("" ::: "memory");
}
__device__ __forceinline__ void ln0_row(const float* xrow, const float* g, const float* b, bf16* orow, int lane) {
    const GAS f32x4* xr = (const GAS f32x4*)xrow + lane;
    f32x4 v[4]; float s = 0.f;
#pragma unroll
    for (int j = 0; j < 4; ++j) { v[j] = xr[64 * j]; s += (v[j].x + v[j].y) + (v[j].z + v[j].w); }
    const float mean = wave_sum(s) * (1.f / D); float s2 = 0.f;
#pragma unroll
    for (int j = 0; j < 4; ++j) { v[j] = v[j] - mean; s2 += (v[j].x * v[j].x + v[j].y * v[j].y) + (v[j].z * v[j].z + v[j].w * v[j].w); }
    const float rstd = 1.f / sqrtf(wave_sum(s2) * (1.f / D) + LN_EPS);
    GAS unsigned long long* o8 = (GAS unsigned long long*)orow + lane;
#pragma unroll
    for (int j = 0; j < 4; ++j) { const f32x4 gg = ((const GAS f32x4*)g)[lane + 64 * j], bb = ((const GAS f32x4*)b)[lane + 64 * j];
        const f32x4 o = v[j] * rstd * gg + bb;
        o8[64 * j] = (unsigned long long)pk2(o.x, o.y) | ((unsigned long long)pk2(o.z, o.w) << 32); }
}
__device__ __forceinline__ void p0_prologue(Frame& F) {
    LAS float* scr = (LAS float*)(F.lds + RING_OFF + F.wave * 16384);
    const int gw = F.vcu * NWAVES + F.wave, NGW = F.G * NWAVES;
    unsigned char* ws = F.ws;
    constexpr int I_IN = (D / 64) * (NPROJ / 32), I_GLU = (512 / 64) * (512 / 32), I_OUT = (1024 / 64) * (1024 / 32), I_Q = (1024 / 64) * (2048 / 32);
    constexpr int NITEMS = I_IN + I_GLU + I_OUT + I_Q;
    for (int it = gw; it < NITEMS; it += NGW) {
        int r = it;
        if (r < I_IN) { p0_transpose_item(F.in[I_WIN], D, NPROJ, (bf16*)(ws + WS_WIN), 0, scr, r, F.lane); continue; } r -= I_IN;
        if (r < I_GLU) { p0_transpose_item(F.in[I_WGLU], 512, 512, (bf16*)(ws + WS_WGLU), 0, scr, r, F.lane); continue; } r -= I_GLU;
        if (r < I_OUT) { p0_transpose_item(F.in[I_WOUT], 1024, 1024, (bf16*)(ws + WS_WOUT), 0, scr, r, F.lane); continue; } r -= I_OUT;
        p0_transpose_item(F.in[I_WQ], 1024, 2048, (bf16*)(ws + WS_WQ), 0, scr, r, F.lane);
    }
    const int gt = gw * 64 + F.lane, NGT = NGW * 64;
    for (int i = gt; i < 2 * PK * PHALF; i += NGT) { const float v = (i < PK * PHALF) ? F.in[I_K1][i] : F.in[I_K2][i - PK * PHALF]; ((bf16*)(ws + WS_KEYS))[i] = (bf16)f2bf(v); }
    for (int i = gt; i < HGW; i += NGT) { const float l0 = F.in[I_LBL][i], l1 = F.in[I_LBL][HGW + i]; ((float*)(ws + WS_LB))[i] = 1.f / (1.f + expf(l1 - l0)); }
    for (int i = gt; i < S5G * S5N; i += NGT) { const int g = i / S5N;
        const float are = F.in[I_ARE][i], aim = F.in[I_AIM][i], step = expf(F.in[I_LSTEP][g]);
        const float zr = step * are, zi = step * aim, mag = expf(zr), cz = cosf(zi), sz = sinf(zi), sh = sinf(0.5f * zi);
        const float abr = mag * cz, abi = mag * sz;
        const float nre = expm1f(zr) * cz - 2.f * sh * sh, nim = abi;
        const float den = are * are + aim * aim;
        const float cre = (nre * are + nim * aim) / den, cim = (nim * are - nre * aim) / den;
        float* t = (float*)(ws + WS_S5T) + (size_t)i * 40; t[0] = abr; t[1] = abi;
        for (int p = 0; p < S5P; ++p) { const float br = F.in[I_BRE][(size_t)i * S5P + p], bi = F.in[I_BIM][(size_t)i * S5P + p];
            t[2 + p] = cre * br - cim * bi; t[18 + p] = cre * bi + cim * br; } }
    for (int i = gt; i < S5G * S5N * 33; i += NGT) { const int gn = i / 33, tau = i % 33, g = gn / S5N;
        const float step = expf(F.in[I_LSTEP][g]), zr = step * F.in[I_ARE][gn] * (float)tau, zi = step * F.in[I_AIM][gn] * (float)tau, mag = expf(zr);
        float* p = (float*)(ws + WS_PW) + (size_t)i * 2; p[0] = mag * cosf(zi); p[1] = mag * sinf(zi); }
    for (int m0 = gw * 4; m0 < M; m0 += NGW * 4) {
        f32x4 v[4][4];
#pragma unroll
        for (int r = 0; r < 4; ++r)
#pragma unroll
            for (int j = 0; j < 4; ++j) v[r][j] = ((const GAS f32x4*)(F.in[I_X] + (size_t)(m0 + r) * D))[F.lane + 64 * j];
        f32x4 gg[4], bb[4];
#pragma unroll
        for (int j = 0; j < 4; ++j) { gg[j] = ((const GAS f32x4*)F.in[I_LN0G])[F.lane + 64 * j]; bb[j] = ((const GAS f32x4*)F.in[I_LN0B])[F.lane + 64 * j]; }
#pragma unroll
        for (int r = 0; r < 4; ++r) { float sm = 0.f;
#pragma unroll
            for (int j = 0; j < 4; ++j) sm += (v[r][j].x + v[r][j].y) + (v[r][j].z + v[r][j].w);
            const float mean = wave_sum(sm) * (1.f / D); float s2 = 0.f;
#pragma unroll
            for (int j = 0; j < 4; ++j) { v[r][j] = v[r][j] - mean; s2 += (v[r][j].x * v[r][j].x + v[r][j].y * v[r][j].y) + (v[r][j].z * v[r][j].z + v[r][j].w * v[r][j].w); }
            const float rstd = 1.f / sqrtf(wave_sum(s2) * (1.f / D) + LN_EPS);
            GAS unsigned long long* o8 = (GAS unsigned long long*)((bf16*)(ws + WS_H) + (size_t)(m0 + r) * D) + F.lane;
#pragma unroll
            for (int j = 0; j < 4; ++j) { const f32x4 o = v[r][j] * rstd * gg[j] + bb[j]; o8[64 * j] = (unsigned long long)pk2(o.x, o.y) | ((unsigned long long)pk2(o.z, o.w) << 32); } }
    }
}

__device__ __forceinline__ void hgrn2_seq(Frame& F, int bh) {
    const int b = bh >> 2, h = bh & 3, tid = F.tid, kq = tid >> 7, j = tid & 127;
    LAS float* sF = (LAS float*)(F.lds + RING_OFF);
    LAS float* sK = sF + 8 * 128; LAS float* sQ = sK + 8 * 128;
    LAS float* sO = sQ + 8 * 128;
    const bf16* Qb = (const bf16*)(F.ws + WS_PROJ); const bf16* LFb = Qb + (size_t)M * 512; const bf16* Vb = LFb + (size_t)M * 512; const bf16* Gb = Vb + (size_t)M * 512;
    bf16* MIX = (bf16*)(F.ws + WS_MIX);
    const float ng0 = F.in[I_HGNG][F.lane], ng1 = F.in[I_HGNG][F.lane + 64];
    float S[32];
#pragma unroll
    for (int k = 0; k < 32; ++k) S[k] = 0.f;
    for (int t0 = 0; t0 < SEQ; t0 += 8) {
        const size_t tok0 = (size_t)b * SEQ + t0;
#pragma unroll
        for (int r = 0; r < 2; ++r) { const int item = tid + 512 * r, tt = item >> 7, kk = item & 127; const size_t off = (tok0 + tt) * 512 + h * 128 + kk;
            const float lf = bf2f(LFb[off]); sF[tt * 128 + kk] = __expf(lf); sK[tt * 128 + kk] = -expm1f(lf); sQ[tt * 128 + kk] = bf2f(Qb[off]); }
        __syncthreads();
#pragma unroll 1
        for (int tt = 0; tt < 8; ++tt) { const float v = bf2f(Vb[(tok0 + tt) * 512 + h * 128 + j]); float o = 0.f;
            const LAS float* f = sF + tt * 128 + kq * 32; const LAS float* kx = sK + tt * 128 + kq * 32; const LAS float* q = sQ + tt * 128 + kq * 32;
#pragma unroll
            for (int k = 0; k < 32; ++k) { S[k] = f[k] * S[k] + kx[k] * v; o += q[k] * S[k]; }
            sO[(tt * 4 + kq) * 128 + j] = o; }
        __syncthreads();
        { const int tt = F.wave; const size_t tok = tok0 + tt;
            const float o0 = (sO[(tt * 4 + 0) * 128 + F.lane] + sO[(tt * 4 + 1) * 128 + F.lane]) + (sO[(tt * 4 + 2) * 128 + F.lane] + sO[(tt * 4 + 3) * 128 + F.lane]);
            const float o1 = (sO[(tt * 4 + 0) * 128 + 64 + F.lane] + sO[(tt * 4 + 1) * 128 + 64 + F.lane]) + (sO[(tt * 4 + 2) * 128 + 64 + F.lane] + sO[(tt * 4 + 3) * 128 + 64 + F.lane]);
            const float ss = wave_sum(o0 * o0 + o1 * o1), r = 1.f / sqrtf(ss * (1.f / 128.f) + RMS_EPS);
            const float g0 = bf2f(Gb[tok * 512 + h * 128 + F.lane]), g1 = bf2f(Gb[tok * 512 + h * 128 + 64 + F.lane]);
            MIX[tok * 1024 + h * 128 + F.lane] = (bf16)f2bf(o0 * r * ng0 * silu_f(g0));
            MIX[tok * 1024 + h * 128 + 64 + F.lane] = (bf16)f2bf(o1 * r * ng1 * silu_f(g1)); }
    }
    __syncthreads();
}
__device__ __forceinline__ void s5_seq(Frame& F, int pair) {
    const int b = pair >> 5, g = pair & 31, lane = F.lane;
    const float* tb = (const float*)(F.ws + WS_S5T) + (size_t)(g * S5N + lane) * 40;
    const float abr = tb[0], abi = tb[1];
    float bbr[16], bbi[16], cr[16], ci[16], dsk[16];
#pragma unroll
    for (int p = 0; p < 16; ++p) { bbr[p] = tb[2 + p]; bbi[p] = tb[18 + p]; cr[p] = F.in[I_CRE][(size_t)(g * 16 + p) * S5N + lane]; ci[p] = F.in[I_CIM][(size_t)(g * 16 + p) * S5N + lane];
        dsk[p] = (lane == 0) ? F.in[I_DSK][g * 16 + p] : 0.f; }
    const bf16* Ub = (const bf16*)(F.ws + WS_PROJ) + (size_t)4 * M * 512 + ((size_t)g * M + (size_t)b * SEQ) * 16;
    bf16* Zb = (bf16*)(F.ws + WS_Z) + (size_t)b * SEQ * 512 + g * 16;
    const int pme = ((lane >> 5) & 1) * 8 + ((lane >> 4) & 1) * 4 + ((lane >> 3) & 1) * 2 + ((lane >> 2) & 1);
    float xr = 0.f, xi = 0.f;
    v4u nu0 = *(const GAS v4u*)(Ub + (size_t)lane * 16), nu1 = *(const GAS v4u*)(Ub + (size_t)lane * 16 + 8);
    for (int t0 = 0; t0 < SEQ; t0 += 64) {
        const v4u u0 = nu0, u1 = nu1;
        if (t0 + 64 < SEQ) { nu0 = *(const GAS v4u*)(Ub + (size_t)(t0 + 64 + lane) * 16); nu1 = *(const GAS v4u*)(Ub + (size_t)(t0 + 64 + lane) * 16 + 8); }
#pragma unroll 1
        for (int tt = 0; tt < 64; ++tt) {
            v4u a, c;
            a.x = __builtin_amdgcn_readlane(u0.x, tt); a.y = __builtin_amdgcn_readlane(u0.y, tt); a.z = __builtin_amdgcn_readlane(u0.z, tt); a.w = __builtin_amdgcn_readlane(u0.w, tt);
            c.x = __builtin_amdgcn_readlane(u1.x, tt); c.y = __builtin_amdgcn_readlane(u1.y, tt); c.z = __builtin_amdgcn_readlane(u1.z, tt); c.w = __builtin_amdgcn_readlane(u1.w, tt);
            float u[16]; { float f0[8], f1[8]; unpack8(a, f0); unpack8(c, f1);
#pragma unroll
                for (int p = 0; p < 8; ++p) { u[p] = f0[p]; u[8 + p] = f1[p]; } }
            float bur = 0.f, bui = 0.f;
#pragma unroll
            for (int p = 0; p < 16; ++p) { bur += bbr[p] * u[p]; bui += bbi[p] * u[p]; }
            const float nxr = abr * xr - abi * xi + bur, nxi = abr * xi + abi * xr + bui; xr = nxr; xi = nxi;
            float r[16];
#pragma unroll
            for (int p = 0; p < 16; ++p) r[p] = cr[p] * xr - ci[p] * xi + dsk[p] * u[p];
#pragma unroll
            for (int i = 0; i < 8; ++i) { const float keep = (lane & 32) ? r[i + 8] : r[i], send = (lane & 32) ? r[i] : r[i + 8]; r[i] = keep + __shfl_xor(send, 32); }
#pragma unroll
            for (int i = 0; i < 4; ++i) { const float keep = (lane & 16) ? r[i + 4] : r[i], send = (lane & 16) ? r[i] : r[i + 4]; r[i] = keep + __shfl_xor(send, 16); }
#pragma unroll
            for (int i = 0; i < 2; ++i) { const float keep = (lane & 8) ? r[i + 2] : r[i], send = (lane & 8) ? r[i] : r[i + 2]; r[i] = keep + __shfl_xor(send, 8); }
            { const float keep = (lane & 4) ? r[1] : r[0], send = (lane & 4) ? r[0] : r[1]; r[0] = keep + __shfl_xor(send, 4); }
            r[0] += __shfl_xor(r[0], 2); r[0] += __shfl_xor(r[0], 1);
            if ((lane & 3) == 0) Zb[(size_t)(t0 + tt) * 512 + pme] = (bf16)f2bf(gelu_tanh(r[0]));
        }
    }
}

__device__ __forceinline__ int t256(int r, int c) { return r * 256 + ((((c >> 3) ^ (r & 15))) << 4) + (c & 7) * 2; }
__device__ __forceinline__ int t128(int r, int c) { return r * 128 + ((((c >> 3) ^ (r & 7))) << 4) + (c & 7) * 2; }
typedef unsigned v2u __attribute__((ext_vector_type(2)));
__device__ __forceinline__ unsigned offb(unsigned row, unsigned ch) { return 256u * row + 16u * (ch ^ (((row & 3u) << 2) | ((row >> 2) & 3u))); }
typedef short v4i16_t __attribute__((ext_vector_type(4)));
__device__ __forceinline__ bf16x8 tr_frag16(LAS unsigned char* tile, int lane, int c, int ks) {
    const unsigned g = lane >> 4, q = (lane & 15) >> 2, p = lane & 3;
    const v4i16_t lo = __builtin_amdgcn_ds_read_tr16_b64_v4i16((LAS v4i16_t*)(tile + offb(32 * ks + 8 * g + q, 2 * c + (p >> 1)) + 8 * (p & 1)));
    const v4i16_t hi = __builtin_amdgcn_ds_read_tr16_b64_v4i16((LAS v4i16_t*)(tile + offb(32 * ks + 8 * g + 4 + q, 2 * c + (p >> 1)) + 8 * (p & 1)));
    bf16x8 r; r[0] = lo[0]; r[1] = lo[1]; r[2] = lo[2]; r[3] = lo[3]; r[4] = hi[0]; r[5] = hi[1]; r[6] = hi[2]; r[7] = hi[3]; return r;
}
__device__ __forceinline__ void hgrn2_state_pass(Frame& F, int item) {
    const int bh = item >> 2, ksl = item & 3, b = bh >> 2, h = bh & 3, tid = F.tid, lane = F.lane, w = F.wave, fr = lane & 15, fq = lane >> 4;
    const int kcol = tid & 31, sg = tid >> 5;
    LAS unsigned char* L = F.lds + RING_OFF;
    LAS unsigned char* sRaw = L + 49152;
    const bf16* LFg = (const bf16*)(F.ws + WS_PROJ) + (size_t)M * 512 + (size_t)b * SEQ * 512 + h * 128 + ksl * 32;
    const bf16* Vg = (const bf16*)(F.ws + WS_PROJ) + (size_t)2 * M * 512 + (size_t)b * SEQ * 512 + h * 128;
    bf16* SST = (bf16*)(F.ws + WS_SST) + (size_t)bh * 64 * 128 * 128 + ksl * 32;
    float S[2][4];
#pragma unroll
    for (int i = 0; i < 2; ++i)
#pragma unroll
        for (int r = 0; r < 4; ++r) S[i][r] = 0.f;
    const int ls = (tid & 255) >> 2, lkg = tid & 3;
    const int vs0 = tid >> 4, vch = tid & 15;
    v4u nlf = *(const GAS v4u*)(LFg + (size_t)ls * 512 + lkg * 8);
    v4u nv0 = *(const GAS v4u*)(Vg + (size_t)vs0 * 512 + vch * 8), nv1 = *(const GAS v4u*)(Vg + (size_t)(32 + vs0) * 512 + vch * 8);
    v4u n2lf = *(const GAS v4u*)(LFg + (size_t)(64 + ls) * 512 + lkg * 8);
    v4u n2v0 = *(const GAS v4u*)(Vg + (size_t)(64 + vs0) * 512 + vch * 8), n2v1 = *(const GAS v4u*)(Vg + (size_t)(96 + vs0) * 512 + vch * 8);
    v4u n3lf = *(const GAS v4u*)(LFg + (size_t)(128 + ls) * 512 + lkg * 8);
    v4u n3v0 = *(const GAS v4u*)(Vg + (size_t)(128 + vs0) * 512 + vch * 8), n3v1 = *(const GAS v4u*)(Vg + (size_t)(160 + vs0) * 512 + vch * 8);
    for (int c = 0; c < 64; ++c) {
        LAS unsigned char* Lb = L + (c & 1) * 24576;
        LAS unsigned char* sKT = Lb; LAS unsigned char* sVT = Lb + 4096; LAS float* sTot = (LAS float*)(Lb + 20480); LAS float* sDec = (LAS float*)(Lb + 22528);
        if (tid < 256) *(LAS v4u*)(sRaw + ls * 64 + lkg * 16) = nlf;
        *(LAS v4u*)(sVT + offb(vs0, vch)) = nv0; *(LAS v4u*)(sVT + offb(32 + vs0, vch)) = nv1;
        nlf = n2lf; nv0 = n2v0; nv1 = n2v1; n2lf = n3lf; n2v0 = n3v0; n2v1 = n3v1;
        if (c + 3 < 64) { const size_t t3 = (size_t)(c + 3) * 64;
            n3lf = *(const GAS v4u*)(LFg + (t3 + ls) * 512 + lkg * 8); n3v0 = *(const GAS v4u*)(Vg + (t3 + vs0) * 512 + vch * 8); n3v1 = *(const GAS v4u*)(Vg + (t3 + 32 + vs0) * 512 + vch * 8); }
        __syncthreads();
        float lf[4];
#pragma unroll
        for (int j = 0; j < 4; ++j) lf[j] = bf2f(*(const LAS bf16*)(sRaw + (sg * 4 + j) * 64 + kcol * 2));
        float cl[4]; float run = 0.f;
#pragma unroll
        for (int j = 0; j < 4; ++j) { run += lf[j]; cl[j] = run; }
        sTot[sg * 32 + kcol] = run;
        __syncthreads();
        float off = 0.f, last = 0.f;
#pragma unroll
        for (int q = 0; q < 16; ++q) { const float tq = sTot[q * 32 + kcol]; off += (q < sg) ? tq : 0.f; last += tq; }
        float kh[4];
#pragma unroll
        for (int j = 0; j < 4; ++j) kh[j] = (1.f - __expf(lf[j])) * __expf(last - (off + cl[j]));
        { v2u pk; pk.x = pk2(kh[0], kh[1]); pk.y = pk2(kh[2], kh[3]);
          *(LAS v2u*)(sKT + kcol * 128 + ((((sg >> 1) ^ (kcol & 7))) << 4) + (sg & 1) * 8) = pk; }
        if (sg == 0) sDec[kcol] = __expf(last);
        __syncthreads();
        f32x4 acc[2] = {(f32x4){0.f, 0.f, 0.f, 0.f}, (f32x4){0.f, 0.f, 0.f, 0.f}};
        const int mt = w & 1, nt0 = (w >> 1) * 2;
#pragma unroll
        for (int ks = 0; ks < 2; ++ks) { const int ch = ks * 4 + fq, row = 16 * mt + fr;
            const bf16x8 af = *(const LAS bf16x8*)(sKT + row * 128 + ((ch ^ (row & 7)) << 4));
#pragma unroll
            for (int nt = 0; nt < 2; ++nt) { const bf16x8 bfm = tr_frag16(sVT, lane, nt0 + nt, ks);
                acc[nt] = __builtin_amdgcn_mfma_f32_16x16x32_bf16(af, bfm, acc[nt], 0, 0, 0); } }
        const int k0 = 16 * mt + fq * 4; const f32x4 dec = *(const LAS f32x4*)(sDec + k0);
#pragma unroll
        for (int nt = 0; nt < 2; ++nt) { const int vg = 16 * (nt0 + nt) + fr;
            v2u o; o.x = pk2(S[nt][0], S[nt][1]); o.y = pk2(S[nt][2], S[nt][3]);
            *(GAS v2u*)(SST + ((size_t)c * 128 + vg) * 128 + k0) = o;
            S[nt][0] = dec[0] * S[nt][0] + acc[nt][0]; S[nt][1] = dec[1] * S[nt][1] + acc[nt][1]; S[nt][2] = dec[2] * S[nt][2] + acc[nt][2]; S[nt][3] = dec[3] * S[nt][3] + acc[nt][3]; }
    }
    __syncthreads();
}
struct HgOutRegs { v4u lf[2], q[2], v[2], st[4]; };
__device__ __forceinline__ void hgrn2_out_load(Frame& F, int item, HgOutRegs& R) {
    const int bh = item >> 6, c = item & 63, b = bh >> 2, h = bh & 3, tid = F.tid;
    const size_t tok0 = (size_t)b * SEQ + (size_t)c * 64;
    const bf16* Qb = (const bf16*)(F.ws + WS_PROJ) + tok0 * 512 + h * 128; const bf16* LFb = Qb + (size_t)M * 512; const bf16* Vb = Qb + (size_t)2 * M * 512;
    const bf16* SST = (const bf16*)(F.ws + WS_SST) + (size_t)item * 128 * 128;
#pragma unroll
    for (int i = 0; i < 2; ++i) { const int idx = tid + 512 * i, sr = idx >> 4, ch = idx & 15;
        R.lf[i] = *(const GAS v4u*)(LFb + (size_t)sr * 512 + ch * 8); R.q[i] = *(const GAS v4u*)(Qb + (size_t)sr * 512 + ch * 8); R.v[i] = *(const GAS v4u*)(Vb + (size_t)sr * 512 + ch * 8); }
#pragma unroll
    for (int i = 0; i < 4; ++i) { const int idx = tid + 512 * i; R.st[i] = *(const GAS v4u*)(SST + (size_t)(idx >> 4) * 128 + (idx & 15) * 8); }
}
__device__ __forceinline__ void hgrn2_out_phase(Frame& F) {
    const int tid = F.tid, lane = F.lane, w = F.wave, fr = lane & 15, fq = lane >> 4;
    const int kcol = tid & 127, qtr = tid >> 7;
    LAS unsigned char* L = F.lds + RING_OFF;
    LAS unsigned char* sQt = L; LAS unsigned char* sQm = L + 16384; LAS unsigned char* sKm = L + 32768; LAS unsigned char* sV = L + 49152; LAS unsigned char* sST = L + 65536; LAS unsigned char* sP = L + 98304;
    LAS float* sTot = (LAS float*)(L + 106496); LAS float* sSS = (LAS float*)(L + 108544);
    LAS unsigned char* rLF = L + 110592; LAS unsigned char* rQ = L + 126976;
    HgOutRegs R;
    int item = F.vcu;
    if (item < 32 * 64) hgrn2_out_load(F, item, R);
    for (; item < 32 * 64; item += F.G) {
        const int bh = item >> 6, c = item & 63, b = bh >> 2, h = bh & 3;
        const size_t tok0 = (size_t)b * SEQ + (size_t)c * 64;
        const bf16* Gb = (const bf16*)(F.ws + WS_PROJ) + (size_t)3 * M * 512 + tok0 * 512 + h * 128;
        bf16* MIX = (bf16*)(F.ws + WS_MIX) + tok0 * 1024 + h * 128;
#pragma unroll
        for (int i = 0; i < 2; ++i) { const int idx = tid + 512 * i, sr = idx >> 4, ch = idx & 15;
            *(LAS v4u*)(rLF + sr * 256 + ch * 16) = R.lf[i]; *(LAS v4u*)(rQ + sr * 256 + ch * 16) = R.q[i]; *(LAS v4u*)(sV + offb(sr, ch)) = R.v[i]; }
#pragma unroll
        for (int i = 0; i < 4; ++i) { const int idx = tid + 512 * i, v = idx >> 4, kc = idx & 15; *(LAS v4u*)(sST + v * 256 + ((kc ^ (v & 15)) << 4)) = R.st[i]; }
        if (item + F.G < 32 * 64) hgrn2_out_load(F, item + F.G, R);
        __syncthreads();
        float lf[16], q[16];
#pragma unroll
        for (int j = 0; j < 16; ++j) { lf[j] = bf2f(*(const LAS bf16*)(rLF + (qtr * 16 + j) * 256 + kcol * 2)); q[j] = bf2f(*(const LAS bf16*)(rQ + (qtr * 16 + j) * 256 + kcol * 2)); }
        float cl[16]; float run = 0.f;
#pragma unroll
        for (int j = 0; j < 16; ++j) { run += lf[j]; cl[j] = run; }
        sTot[qtr * 128 + kcol] = run;
        __syncthreads();
        { const float t0 = sTot[kcol], t1 = sTot[128 + kcol], t2 = sTot[256 + kcol];
          const float off = (qtr > 0 ? t0 : 0.f) + (qtr > 1 ? t1 : 0.f) + (qtr > 2 ? t2 : 0.f), mid = t0 + t1;
#pragma unroll
          for (int j = 0; j < 16; ++j) { const int sdx = qtr * 16 + j; const float cum = off + cl[j];
              const int o = t256(sdx, kcol);
              *(LAS bf16*)(sQt + o) = (bf16)f2bf(q[j] * __expf(cum));
              *(LAS bf16*)(sQm + o) = (bf16)f2bf(q[j] * __expf(cum - mid));
              *(LAS bf16*)(sKm + o) = (bf16)f2bf((1.f - __expf(lf[j])) * __expf(mid - cum)); } }
        __syncthreads();
        const int tt = w >> 1, trow = 16 * tt + fr;
#pragma unroll
        for (int sti = 0; sti < 2; ++sti) { const int stl = (w & 1) * 2 + sti; f32x4 acc = (f32x4){0.f, 0.f, 0.f, 0.f};
            if (stl <= tt) {
#pragma unroll
                for (int ks = 0; ks < 4; ++ks) { const int ch = ks * 4 + fq, srow = 16 * stl + fr;
                    const bf16x8 af = *(const LAS bf16x8*)(sKm + srow * 256 + ((ch ^ (srow & 15)) << 4));
                    const bf16x8 bfm = *(const LAS bf16x8*)(sQm + trow * 256 + ((ch ^ (trow & 15)) << 4));
                    acc = __builtin_amdgcn_mfma_f32_16x16x32_bf16(af, bfm, acc, 0, 0, 0); } }
            const int s0 = 16 * stl + fq * 4;
            const float p0 = (s0 + 0 <= trow) ? acc[0] : 0.f, p1 = (s0 + 1 <= trow) ? acc[1] : 0.f, p2 = (s0 + 2 <= trow) ? acc[2] : 0.f, p3 = (s0 + 3 <= trow) ? acc[3] : 0.f;
            v2u o; o.x = pk2(p0, p1); o.y = pk2(p2, p3);
            *(LAS v2u*)(sP + trow * 128 + ((((s0 >> 3) ^ (trow & 7))) << 4) + (s0 & 7) * 2) = o; }
        __syncthreads();
        f32x4 oacc[4];
#pragma unroll
        for (int i = 0; i < 4; ++i) oacc[i] = (f32x4){0.f, 0.f, 0.f, 0.f};
#pragma unroll
        for (int ks = 0; ks < 4; ++ks) { const int ch = ks * 4 + fq;
            const bf16x8 bfm = *(const LAS bf16x8*)(sQt + trow * 256 + ((ch ^ (trow & 15)) << 4));
#pragma unroll
            for (int i = 0; i < 4; ++i) { const int vr = 16 * ((w & 1) * 4 + i) + fr; const bf16x8 af = *(const LAS bf16x8*)(sST + vr * 256 + ((ch ^ (vr & 15)) << 4));
                oacc[i] = __builtin_amdgcn_mfma_f32_16x16x32_bf16(af, bfm, oacc[i], 0, 0, 0); } }
#pragma unroll
        for (int ks = 0; ks < 2; ++ks) { const int ch = ks * 4 + fq;
            const bf16x8 bfm = *(const LAS bf16x8*)(sP + trow * 128 + ((ch ^ (trow & 7)) << 4));
#pragma unroll
            for (int i = 0; i < 4; ++i) { const bf16x8 af = tr_frag16(sV, lane, (w & 1) * 4 + i, ks);
                oacc[i] = __builtin_amdgcn_mfma_f32_16x16x32_bf16(af, bfm, oacc[i], 0, 0, 0); } }
        float ss = 0.f;
#pragma unroll
        for (int i = 0; i < 4; ++i) ss += (oacc[i][0] * oacc[i][0] + oacc[i][1] * oacc[i][1]) + (oacc[i][2] * oacc[i][2] + oacc[i][3] * oacc[i][3]);
        ss += __shfl_xor(ss, 16); ss += __shfl_xor(ss, 32);
        if (fq == 0) sSS[(w & 1) * 64 + trow] = ss;
        __syncthreads();
        const float rinv = 1.f / sqrtf((sSS[trow] + sSS[64 + trow]) * (1.f / 128.f) + RMS_EPS);
#pragma unroll
        for (int i = 0; i < 4; ++i) { const int v0 = 16 * ((w & 1) * 4 + i) + fq * 4;
            const v2u gw2 = *(const GAS v2u*)(Gb + (size_t)trow * 512 + v0); const f32x4 ng = *(const GAS f32x4*)(F.in[I_HGNG] + v0);
            const float g0 = __builtin_bit_cast(float, gw2.x << 16), g1 = __builtin_bit_cast(float, gw2.x & 0xffff0000u), g2 = __builtin_bit_cast(float, gw2.y << 16), g3 = __builtin_bit_cast(float, gw2.y & 0xffff0000u);
            v2u o; o.x = pk2(oacc[i][0] * rinv * ng[0] * silu_f(g0), oacc[i][1] * rinv * ng[1] * silu_f(g1)); o.y = pk2(oacc[i][2] * rinv * ng[2] * silu_f(g2), oacc[i][3] * rinv * ng[3] * silu_f(g3));
            *(GAS v2u*)(MIX + (size_t)trow * 1024 + v0) = o; }
        __syncthreads();
    }
}

__device__ __forceinline__ void s5_tables_stage1(Frame& F) {
    const int gt = (F.vcu * NWAVES + F.wave) * 64 + F.lane, NGT = F.G * NWAVES * 64;
    const float* S5T = (const float*)(F.ws + WS_S5T); const float* PW = (const float*)(F.ws + WS_PW);
    float* KT = (float*)(F.ws + WS_KTAU); bf16* G5 = (bf16*)(F.ws + WS_G5); bf16* T5 = (bf16*)(F.ws + WS_T5);
    for (int i = gt; i < S5G * 32 * 256; i += NGT) { const int g = i >> 13, tau = (i >> 8) & 31, p = (i >> 4) & 15, q = i & 15;
        float acc = (tau == 0 && p == q) ? F.in[I_DSK][g * 16 + p] : 0.f;
#pragma unroll 16
        for (int n = 0; n < S5N; ++n) { const int gn = g * S5N + n;
            const float cr = F.in[I_CRE][(size_t)(g * 16 + p) * S5N + n], ci = F.in[I_CIM][(size_t)(g * 16 + p) * S5N + n];
            const float wr = PW[((size_t)gn * 33 + tau) * 2], wi = PW[((size_t)gn * 33 + tau) * 2 + 1];
            const float br = S5T[(size_t)gn * 40 + 2 + q], bi = S5T[(size_t)gn * 40 + 18 + q];
            const float er = cr * wr - ci * wi, ei = cr * wi + ci * wr;
            acc += er * br - ei * bi; }
        KT[i] = acc; }
    for (int i = gt; i < S5G * 256 * 64; i += NGT) { const int g = i >> 14, r = (i >> 6) & 255, kc = i & 63, sdx = kc >> 1, q0 = (kc & 1) * 8;
        float f[8];
        if (r < 128) { const int n = r & 63, gn = g * S5N + n; const float wr = PW[((size_t)gn * 33 + (31 - sdx)) * 2], wi = PW[((size_t)gn * 33 + (31 - sdx)) * 2 + 1];
#pragma unroll
            for (int j = 0; j < 8; ++j) { const float br = S5T[(size_t)gn * 40 + 2 + q0 + j], bi = S5T[(size_t)gn * 40 + 18 + q0 + j]; f[j] = (r < 64) ? (wr * br - wi * bi) : (wr * bi + wi * br); }
        } else {
#pragma unroll
            for (int j = 0; j < 8; ++j) f[j] = 0.f; }
        *(GAS v4u*)(G5 + ((size_t)(g * 256 + r)) * 512 + kc * 8) = pack8(f); }
    for (int i = gt; i < S5G * 512 * 16; i += NGT) { const int g = i >> 13, row = (i >> 4) & 511, nc = i & 15, t = row >> 4, p = row & 15, im = nc >> 3, n0 = (nc & 7) * 8;
        float f[8];
#pragma unroll
        for (int j = 0; j < 8; ++j) { const int n = n0 + j, gn = g * S5N + n;
            const float cr = F.in[I_CRE][(size_t)(g * 16 + p) * S5N + n], ci = F.in[I_CIM][(size_t)(g * 16 + p) * S5N + n];
            const float wr = PW[((size_t)gn * 33 + t + 1) * 2], wi = PW[((size_t)gn * 33 + t + 1) * 2 + 1];
            f[j] = im ? -(cr * wi + ci * wr) : (cr * wr - ci * wi); }
        *(GAS v4u*)(T5 + ((size_t)(g * 512 + row)) * 640 + 512 + nc * 8) = pack8(f); }
}
__device__ __forceinline__ void s5_tables_stage2(Frame& F) {
    const int gt = (F.vcu * NWAVES + F.wave) * 64 + F.lane, NGT = F.G * NWAVES * 64;
    const float* KT = (const float*)(F.ws + WS_KTAU); bf16* T5 = (bf16*)(F.ws + WS_T5);
    for (int i = gt; i < S5G * 512 * 64; i += NGT) { const int g = i >> 15, row = (i >> 6) & 511, kc = i & 63, t = row >> 4, p = row & 15, sdx = kc >> 1, q0 = (kc & 1) * 8;
        float f[8];
        if (sdx <= t) { const float* k = KT + (((size_t)g * 32 + (t - sdx)) * 16 + p) * 16 + q0;
#pragma unroll
            for (int j = 0; j < 8; ++j) f[j] = k[j];
        } else {
#pragma unroll
            for (int j = 0; j < 8; ++j) f[j] = 0.f; }
        *(GAS v4u*)(T5 + ((size_t)(g * 512 + row)) * 640 + kc * 8) = pack8(f); }
}
__device__ __forceinline__ void s5_scan(Frame& F, int idx) {
    const int b = idx >> 11, g = (idx >> 6) & 31, n = idx & 63;
    const float* PW = (const float*)(F.ws + WS_PW); const float* XL = (const float*)(F.ws + WS_XLOC); bf16* A5 = (bf16*)(F.ws + WS_A5);
    const float ar = PW[((size_t)(g * S5N + n) * 33 + 32) * 2], ai = PW[((size_t)(g * S5N + n) * 33 + 32) * 2 + 1];
    float xr = 0.f, xi = 0.f;
    for (int c0 = 0; c0 < 128; c0 += 32) {
        float lr[32], li[32];
#pragma unroll
        for (int j = 0; j < 32; ++j) { const float* p = XL + ((size_t)(b * 128 + c0 + j) * 32 + g) * 128 + n; lr[j] = p[0]; li[j] = p[64]; }
#pragma unroll
        for (int j = 0; j < 32; ++j) { bf16* o = A5 + ((size_t)g * S5I + b * 128 + c0 + j) * 640 + 512 + n; o[0] = (bf16)f2bf(xr); o[64] = (bf16)f2bf(xi);
            const float nr = ar * xr - ai * xi + lr[j], ni = ar * xi + ai * xr + li[j]; xr = nr; xi = ni; }
    }
}

__device__ __forceinline__ void ln1_row(bf16* row, const float* g, const float* b, int lane) {
    const v4u w0 = *(const GAS v4u*)(row + lane * 8), w1 = *(const GAS v4u*)(row + 512 + lane * 8);
    float a[8], c[8]; unpack8(w0, a); unpack8(w1, c);
    float s = 0.f;
#pragma unroll
    for (int j = 0; j < 8; ++j) s += a[j] + c[j];
    const float mean = wave_sum(s) * (1.f / D); float s2 = 0.f;
#pragma unroll
    for (int j = 0; j < 8; ++j) { a[j] -= mean; c[j] -= mean; s2 += a[j] * a[j] + c[j] * c[j]; }
    const float rstd = 1.f / sqrtf(wave_sum(s2) * (1.f / D) + LN_EPS);
    const f32x4 g0 = *(const GAS f32x4*)(g + lane * 8), g1 = *(const GAS f32x4*)(g + lane * 8 + 4), g2 = *(const GAS f32x4*)(g + 512 + lane * 8), g3 = *(const GAS f32x4*)(g + 512 + lane * 8 + 4);
    const f32x4 b0 = *(const GAS f32x4*)(b + lane * 8), b1 = *(const GAS f32x4*)(b + lane * 8 + 4), b2 = *(const GAS f32x4*)(b + 512 + lane * 8), b3 = *(const GAS f32x4*)(b + 512 + lane * 8 + 4);
    const float gg0[8] = {g0.x, g0.y, g0.z, g0.w, g1.x, g1.y, g1.z, g1.w}, gg1[8] = {g2.x, g2.y, g2.z, g2.w, g3.x, g3.y, g3.z, g3.w};
    const float bb0[8] = {b0.x, b0.y, b0.z, b0.w, b1.x, b1.y, b1.z, b1.w}, bb1[8] = {b2.x, b2.y, b2.z, b2.w, b3.x, b3.y, b3.z, b3.w};
#pragma unroll
    for (int j = 0; j < 8; ++j) { a[j] = a[j] * rstd * gg0[j] + bb0[j]; c[j] = c[j] * rstd * gg1[j] + bb1[j]; }
    *(GAS v4u*)(row + lane * 8) = pack8(a); *(GAS v4u*)(row + 512 + lane * 8) = pack8(c);
}

typedef float f32x16 __attribute__((ext_vector_type(16)));
__device__ __forceinline__ int f2ord(float f) { const int x = __builtin_bit_cast(int, f); return x ^ ((x >> 31) & 0x7fffffff); }
__device__ __forceinline__ float ord2f(int x) { return __builtin_bit_cast(float, x ^ ((x >> 31) & 0x7fffffff)); }
#define CE_DESC(a, b) do { const int _h = max((a), (b)), _l = min((a), (b)); (a) = _h; (b) = _l; } while (0)
__device__ __forceinline__ void sort16_desc(int (&v)[16]) {
#pragma unroll
    for (int k = 2; k <= 16; k <<= 1)
#pragma unroll
        for (int j = k >> 1; j > 0; j >>= 1)
#pragma unroll
            for (int i = 0; i < 16; ++i) { const int l = i ^ j; if (l > i) { if ((i & k) == 0) CE_DESC(v[i], v[l]); else CE_DESC(v[l], v[i]); } }
}
__device__ __forceinline__ void merge16_desc(int (&a)[16], const int (&b)[16]) {
#pragma unroll
    for (int i = 0; i < 16; ++i) a[i] = max(a[i], b[15 - i]);
#pragma unroll
    for (int j = 8; j > 0; j >>= 1)
#pragma unroll
        for (int i = 0; i < 16; ++i) { const int l = i ^ j; if (l > i) CE_DESC(a[i], a[l]); }
}
__device__ __forceinline__ void peer_topk_side(const f32x16 (&acc)[4], int hi, int (&top)[16]) {
    int t[4][16];
#pragma unroll
    for (int kt = 0; kt < 4; ++kt)
#pragma unroll
        for (int j = 0; j < 16; ++j) { const unsigned key = (unsigned)(kt * 32 + (j & 3) + 8 * (j >> 2)) | (unsigned)(4 * hi);
            const float av = acc[kt][j];
            t[kt][j] = f2ord(__builtin_bit_cast(float, (__builtin_bit_cast(unsigned, av) & 0xFFFFFF80u) | key)); }
    sort16_desc(t[0]); sort16_desc(t[1]); sort16_desc(t[2]); sort16_desc(t[3]);
    merge16_desc(t[0], t[1]); merge16_desc(t[2], t[3]); merge16_desc(t[0], t[2]);
    int p[16];
#pragma unroll
    for (int i = 0; i < 16; ++i) p[i] = __shfl_xor(t[0][i], 32);
    merge16_desc(t[0], p);
#pragma unroll
    for (int i = 0; i < 16; ++i) top[i] = t[0][i];
}
__device__ __forceinline__ void peer_score_phase(Frame& F, const pg8::StaticOrder& SO) {
    LAS unsigned char* kl = F.lds + RING_OFF;
    LAS unsigned* look = (LAS unsigned*)(F.lds + RING_OFF + 65536 + F.wave * 8192);
    const bf16* keys = (const bf16*)(F.ws + WS_KEYS);
    for (int i = F.tid; i < 2 * 128 * 16; i += NWAVES * 64) { const int sn = i >> 4, c = i & 15, n = sn & 127;
        *(LAS v4u*)(kl + sn * 256 + ((c ^ (n & 15)) << 4)) = *(const GAS v4u*)(keys + (size_t)sn * 128 + c * 8); }
    __syncthreads();
    const int lane = F.lane, r32 = lane & 31, hi = lane >> 5;
    const bf16* Q2 = (const bf16*)(F.ws + WS_Q2);
    int* EIDX = (int*)(F.ws + WS_EIDX); float* EGATE = (float*)(F.ws + WS_EGATE);
    for (int ui = 0;; ++ui) { pg8::Unit gu; if (!SO.next(ui, gu)) break;
        const int blk = gu.pm * 8 + F.wave, h = gu.pn; const size_t tok = (size_t)blk * 32 + r32;
        const bf16* qrow = Q2 + tok * NQ2 + h * PQ + hi * 8;
        int top1[16], top2[16];
        bf16x8 qfs[2][8];
#pragma unroll
        for (int s = 0; s < 2; ++s)
#pragma unroll
            for (int ks = 0; ks < 8; ++ks) qfs[s][ks] = *(const GAS bf16x8*)(qrow + s * 128 + ks * 16);
#pragma unroll
        for (int s = 0; s < 2; ++s) {
            f32x16 acc[4];
#pragma unroll
            for (int kt = 0; kt < 4; ++kt) { acc[kt] = (f32x16){0.f, 0.f, 0.f, 0.f, 0.f, 0.f, 0.f, 0.f, 0.f, 0.f, 0.f, 0.f, 0.f, 0.f, 0.f, 0.f};
                const int n = kt * 32 + r32;
#pragma unroll
                for (int ks = 0; ks < 8; ++ks) { const bf16x8 kf = *(const LAS bf16x8*)(kl + (s * 128 + n) * 256 + (((2 * ks + hi) ^ (n & 15)) << 4));
                    acc[kt] = __builtin_amdgcn_mfma_f32_32x32x16_bf16(kf, qfs[s][ks], acc[kt], 0, 0, 0); } }
            if (s == 0) peer_topk_side(acc, hi, top1); else peer_topk_side(acc, hi, top2);
        }
        float v1[16], v2[16];
#pragma unroll
        for (int i = 0; i < 16; ++i) { v1[i] = ord2f(top1[i]); v2[i] = ord2f(top2[i]);
            look[i * 64 + lane] = __builtin_bit_cast(unsigned, v1[i]) & 0x7Fu; look[(16 + i) * 64 + lane] = __builtin_bit_cast(unsigned, v2[i]) & 0x7Fu; }
        int c[4][16]; int nc = 0;
#pragma unroll
        for (int i = 0; i < 16; ++i)
#pragma unroll
            for (int j = 0; j < 16; ++j) if ((i + 1) * (j + 1) <= 16) { const float sum = v1[i] + v2[j];
                c[nc >> 4][nc & 15] = f2ord(__builtin_bit_cast(float, (__builtin_bit_cast(unsigned, sum) & 0xFFFFFF00u) | (unsigned)(i * 16 + j))); ++nc; }
#pragma unroll
        for (int q = 50; q < 64; ++q) c[q >> 4][q & 15] = (int)0x80000000;
        sort16_desc(c[0]); sort16_desc(c[1]); sort16_desc(c[2]); sort16_desc(c[3]);
        merge16_desc(c[0], c[1]); merge16_desc(c[2], c[3]); merge16_desc(c[0], c[2]);
        float e[16], sum = 0.f;
        float cf[16];
#pragma unroll
        for (int k = 0; k < 16; ++k) cf[k] = ord2f(c[0][k]);
#pragma unroll
        for (int k = 0; k < 16; ++k) { e[k] = __expf(cf[k] - cf[0]); sum += e[k]; }
        const float inv = 1.f / sum;
        LDS_WAIT();
        int ex[8]; float gt[8];
#pragma unroll
        for (int k = 0; k < 8; ++k) { const float cv = hi ? cf[8 + k] : cf[k]; gt[k] = (hi ? e[8 + k] : e[k]) * inv;
            const unsigned pos = __builtin_bit_cast(unsigned, cv) & 0xFFu;
            ex[k] = (int)(look[(pos >> 4) * 64 + lane] * PK + look[(16 + (pos & 15)) * 64 + lane]); }
        int* eo = EIDX + (tok * PH + h) * 16 + hi * 8; float* go = EGATE + (tok * PH + h) * 16 + hi * 8;
        *(GAS v4u*)eo = (v4u){(unsigned)ex[0], (unsigned)ex[1], (unsigned)ex[2], (unsigned)ex[3]}; *(GAS v4u*)(eo + 4) = (v4u){(unsigned)ex[4], (unsigned)ex[5], (unsigned)ex[6], (unsigned)ex[7]};
        *(GAS f32x4*)go = (f32x4){gt[0], gt[1], gt[2], gt[3]}; *(GAS f32x4*)(go + 4) = (f32x4){gt[4], gt[5], gt[6], gt[7]};
        LDS_WAIT();
    }
}

typedef float f32x2 __attribute__((ext_vector_type(2)));
constexpr float PD_SCALE = 256.f, PU_SCALE = 32.f;
__device__ __forceinline__ void unpack_fp8x16(const v4u w, float (&f)[16]) {
    const unsigned ww[4] = {w.x, w.y, w.z, w.w};
#pragma unroll
    for (int i = 0; i < 4; ++i) { const f32x2 lo = __builtin_amdgcn_cvt_pk_f32_fp8((int)ww[i], false), hi = __builtin_amdgcn_cvt_pk_f32_fp8((int)ww[i], true);
        f[4 * i] = lo[0]; f[4 * i + 1] = lo[1]; f[4 * i + 2] = hi[0]; f[4 * i + 3] = hi[1]; }
}
__device__ __forceinline__ void peer_sort_experts(int& e0, int& e1, float& g0, float& g1, int lane) {
    int k0 = e0 * 128 + lane, k1 = e1 * 128 + 64 + lane;
#pragma unroll
    for (int k = 2; k <= 128; k <<= 1)
#pragma unroll
        for (int j = k >> 1; j > 0; j >>= 1) {
            if (j == 64) { const int lo = min(k0, k1), hi = max(k0, k1); k0 = lo; k1 = hi; }
            else { const int p0 = __shfl_xor(k0, j), p1 = __shfl_xor(k1, j); const bool lower = (lane & j) == 0;
                const bool asc0 = (lane & k) == 0, asc1 = ((64 + lane) & k) == 0;
                k0 = (lower == asc0) ? min(k0, p0) : max(k0, p0); k1 = (lower == asc1) ? min(k1, p1) : max(k1, p1); }
        }
    const int s0 = k0 & 127, s1 = k1 & 127;
    const float a0 = __shfl(g0, s0 & 63), b0 = __shfl(g1, s0 & 63), a1 = __shfl(g0, s1 & 63), b1 = __shfl(g1, s1 & 63);
    g0 = (s0 < 64) ? a0 : b0; g1 = (s1 < 64) ? a1 : b1; e0 = k0 >> 7; e1 = k1 >> 7;
}
typedef long i64_t;
__device__ __forceinline__ void peer_gather_phase(Frame& F) {
    const int gw = F.vcu * NWAVES + F.wave, NGW = F.G * NWAVES, lane = F.lane;
    const bf16* H1 = (const bf16*)(F.ws + WS_H); const unsigned char* PD = F.ws + WS_PD; const unsigned char* PU = F.ws + WS_PU;
    const int* EIDX = (const int*)(F.ws + WS_EIDX); const float* EGATE = (const float*)(F.ws + WS_EGATE);
    const int rep = ((lane >> 5) & 1) * 4 + ((lane >> 4) & 1) * 2 + ((lane >> 3) & 1);
    const bool diag = ((lane & 15) >> 2) == (lane >> 4); const int dr = lane & 3;
    const float m0 = (diag && dr == 0) ? 1.f : 0.f, m1 = (diag && dr == 1) ? 1.f : 0.f, m2 = (diag && dr == 2) ? 1.f : 0.f, m3 = (diag && dr == 3) ? 1.f : 0.f;
    constexpr int GT = 4; constexpr float XS = 16.f, AS = 32.f;
    const int si = lane & 15, sq = lane >> 4;
    const unsigned sb = 0xFFu << (8 * (si & 3));
    const unsigned m0lo = (sq == (si >> 3) && (si & 7) < 4) ? sb : 0u, m0hi = (sq == (si >> 3) && (si & 7) >= 4) ? sb : 0u;
    const unsigned m1lo = (sq == 2 + (si >> 3) && (si & 7) < 4) ? sb : 0u, m1hi = (sq == 2 + (si >> 3) && (si & 7) >= 4) ? sb : 0u;
    for (int pr = gw; pr < M / GT; pr += NGW) {
        __syncthreads();
        const size_t tokA = (size_t)pr * GT;
        int e0[GT], e1[GT]; float g0[GT], g1[GT]; f32x4 os[GT][4]; i64_t xb0[GT], xb1[GT];
#pragma unroll
        for (int t = 0; t < GT; ++t) { float a[8], c[8]; unpack8(*(const GAS v4u*)(H1 + (tokA + t) * D + lane * 16), a); unpack8(*(const GAS v4u*)(H1 + (tokA + t) * D + lane * 16 + 8), c);
            unsigned q0, q1, q2, q3; int pk;
            pk = __builtin_amdgcn_cvt_pk_fp8_f32(a[0] * XS, a[1] * XS, 0, false); pk = __builtin_amdgcn_cvt_pk_fp8_f32(a[2] * XS, a[3] * XS, pk, true); q0 = (unsigned)pk;
            pk = __builtin_amdgcn_cvt_pk_fp8_f32(a[4] * XS, a[5] * XS, 0, false); pk = __builtin_amdgcn_cvt_pk_fp8_f32(a[6] * XS, a[7] * XS, pk, true); q1 = (unsigned)pk;
            pk = __builtin_amdgcn_cvt_pk_fp8_f32(c[0] * XS, c[1] * XS, 0, false); pk = __builtin_amdgcn_cvt_pk_fp8_f32(c[2] * XS, c[3] * XS, pk, true); q2 = (unsigned)pk;
            pk = __builtin_amdgcn_cvt_pk_fp8_f32(c[4] * XS, c[5] * XS, 0, false); pk = __builtin_amdgcn_cvt_pk_fp8_f32(c[6] * XS, c[7] * XS, pk, true); q3 = (unsigned)pk;
            xb0[t] = (i64_t)(((unsigned long long)q1 << 32) | q0); xb1[t] = (i64_t)(((unsigned long long)q3 << 32) | q2);
            e0[t] = EIDX[(tokA + t) * 128 + lane]; e1[t] = EIDX[(tokA + t) * 128 + 64 + lane]; g0[t] = EGATE[(tokA + t) * 128 + lane]; g1[t] = EGATE[(tokA + t) * 128 + 64 + lane];
            peer_sort_experts(e0[t], e1[t], g0[t], g1[t], lane);
#pragma unroll
            for (int j = 0; j < 4; ++j) os[t][j] = (f32x4){0.f, 0.f, 0.f, 0.f}; }
#define GATHER_BATCH(E0, E1, G0, G1, XB0, XB1, O) do { const int ev = (bt < 8) ? E0 : E1; const float gv = (bt < 8) ? G0 : G1; const int lb8 = (bt & 7) * 8; v4u dw[8], uw[8]; \
            _Pragma("unroll") for (int i = 0; i < 8; ++i) { const int e = __builtin_amdgcn_readlane(ev, lb8 + i); dw[i] = *(const GAS v4u*)(PD + (size_t)e * D + lane * 16); uw[i] = *(const GAS v4u*)(PU + (size_t)e * D + lane * 16); } \
            float p[8]; \
            _Pragma("unroll") for (int i = 0; i < 8; ++i) { f32x4 dacc = (f32x4){0.f, 0.f, 0.f, 0.f}; \
                dacc = __builtin_amdgcn_mfma_f32_16x16x32_fp8_fp8((i64_t)(((unsigned long long)dw[i].y << 32) | dw[i].x), XB0, dacc, 0, 0, 0); \
                dacc = __builtin_amdgcn_mfma_f32_16x16x32_fp8_fp8((i64_t)(((unsigned long long)dw[i].w << 32) | dw[i].z), XB1, dacc, 0, 0, 0); \
                const float d0 = dacc[0] * m0, d1 = dacc[1] * m1, d2 = dacc[2] * m2, d3 = dacc[3] * m3; p[i] = (d0 + d1) + (d2 + d3); } \
            _Pragma("unroll") for (int i = 0; i < 4; ++i) { const float keep = (lane & 32) ? p[i + 4] : p[i], send = (lane & 32) ? p[i] : p[i + 4]; p[i] = keep + __shfl_xor(send, 32); } \
            _Pragma("unroll") for (int i = 0; i < 2; ++i) { const float keep = (lane & 16) ? p[i + 2] : p[i], send = (lane & 16) ? p[i] : p[i + 2]; p[i] = keep + __shfl_xor(send, 16); } \
            { const float keep = (lane & 8) ? p[1] : p[0], send = (lane & 8) ? p[0] : p[1]; p[0] = keep + __shfl_xor(send, 8); } \
            p[0] += __shfl_xor(p[0], 4); p[0] += __shfl_xor(p[0], 2); p[0] += __shfl_xor(p[0], 1); \
            const float gate = __shfl(gv, lb8 + rep); const float act = gelu_tanh(p[0] * (1.f / (PD_SCALE * XS))) * gate * AS; \
            const int act8 = __builtin_amdgcn_cvt_pk_fp8_f32(act, 0.f, 0, false) & 0xff; \
            _Pragma("unroll") for (int i = 0; i < 8; ++i) { const unsigned a8 = (unsigned)__builtin_amdgcn_readlane(act8, ((i >> 2) & 1) * 32 + ((i >> 1) & 1) * 16 + (i & 1) * 8) * 0x01010101u; \
                const i64_t A0 = (i64_t)(((unsigned long long)(a8 & m0hi) << 32) | (a8 & m0lo)), A1 = (i64_t)(((unsigned long long)(a8 & m1hi) << 32) | (a8 & m1lo)); \
                const i64_t B0 = (i64_t)(((unsigned long long)uw[i].y << 32) | uw[i].x), B1 = (i64_t)(((unsigned long long)uw[i].w << 32) | uw[i].z); \
                O[0] = __builtin_amdgcn_mfma_f32_16x16x32_fp8_fp8(A0, B0, O[0], 0, 0, 0); O[1] = __builtin_amdgcn_mfma_f32_16x16x32_fp8_fp8(A1, B0, O[1], 0, 0, 0); \
                O[2] = __builtin_amdgcn_mfma_f32_16x16x32_fp8_fp8(A0, B1, O[2], 0, 0, 0); O[3] = __builtin_amdgcn_mfma_f32_16x16x32_fp8_fp8(A1, B1, O[3], 0, 0, 0); } } while (0)
#pragma unroll 1
        for (int bt = 0; bt < 16; ++bt) { if ((bt & 3) == 0) __syncthreads();
#pragma unroll
            for (int t = 0; t < GT; ++t) { GATHER_BATCH(e0[t], e1[t], g0[t], g1[t], xb0[t], xb1[t], os[t]); __builtin_amdgcn_sched_barrier(0); } }
#undef GATHER_BATCH
#pragma unroll
        for (int t = 0; t < GT; ++t) {
            float o[16]; float s = 0.f;
#pragma unroll
            for (int a4 = 0; a4 < 4; ++a4) { const int hf = a4 >> 1, kh = a4 & 1, c0 = 16 * si + 256 * ((sq >> 1) + 2 * kh) + 8 * hf + 4 * (sq & 1);
                const v2u hw = *(const GAS v2u*)(H1 + (tokA + t) * D + c0);
                const float x0 = __builtin_bit_cast(float, hw.x << 16), x1 = __builtin_bit_cast(float, hw.x & 0xffff0000u), x2 = __builtin_bit_cast(float, hw.y << 16), x3 = __builtin_bit_cast(float, hw.y & 0xffff0000u);
                const f32x4 ov = os[t][a4];
                o[4 * a4 + 0] = ov[0] * (1.f / (AS * PU_SCALE)) + DN_ALPHA * x0; o[4 * a4 + 1] = ov[1] * (1.f / (AS * PU_SCALE)) + DN_ALPHA * x1;
                o[4 * a4 + 2] = ov[2] * (1.f / (AS * PU_SCALE)) + DN_ALPHA * x2; o[4 * a4 + 3] = ov[3] * (1.f / (AS * PU_SCALE)) + DN_ALPHA * x3;
                s += (o[4 * a4 + 0] + o[4 * a4 + 1]) + (o[4 * a4 + 2] + o[4 * a4 + 3]); }
            const float mean = wave_sum(s) * (1.f / D); float s2 = 0.f;
#pragma unroll
            for (int j = 0; j < 16; ++j) { o[j] -= mean; s2 += o[j] * o[j]; }
            const float rstd = 1.f / sqrtf(wave_sum(s2) * (1.f / D) + LN_EPS);
#pragma unroll
            for (int a4 = 0; a4 < 4; ++a4) { const int hf = a4 >> 1, kh = a4 & 1, c0 = 16 * si + 256 * ((sq >> 1) + 2 * kh) + 8 * hf + 4 * (sq & 1);
                const f32x4 ga = *(const GAS f32x4*)(F.in[I_LN2G] + c0), ba = *(const GAS f32x4*)(F.in[I_LN2B] + c0);
                f32x4 y; y.x = o[4 * a4 + 0] * rstd * ga.x + ba.x; y.y = o[4 * a4 + 1] * rstd * ga.y + ba.y; y.z = o[4 * a4 + 2] * rstd * ga.z + ba.z; y.w = o[4 * a4 + 3] * rstd * ga.w + ba.w;
                *(GAS f32x4*)(F.out + (tokA + t) * D + c0) = y; }
        }
    }
}

struct Args { const float* in[26]; float* out; unsigned char* ws; int ph_lo, ph_hi, li, pad; };
__global__ void __launch_bounds__(NWAVES * 64, 2) fwd_kernel(Args args) {
    extern __shared__ __attribute__((aligned(16))) unsigned char lds[];
    Frame F;
    F.lds = (LAS unsigned char*)lds;
    F.MISC = (volatile LAS unsigned*)(F.lds + MISC_OFF);
    F.tid = threadIdx.x; F.lane = F.tid & 63; F.wave = __builtin_amdgcn_readfirstlane(F.tid >> 6);
    F.G = gridDim.x; { const int bx = blockIdx.x; F.vcu = (F.G % 8 == 0) ? (bx % 8) * (F.G / 8) + bx / 8 : bx; }
#pragma unroll
    for (int i = 0; i < 26; ++i) F.in[i] = args.in[i];
    F.out = args.out; F.ws = args.ws;
    unsigned char* ws = args.ws;
    F.ctl = (gu32*)(ws + WS_CTL);
    for (int u = F.tid; u < (LDS_BYTES - LDSCTL_OFF) / 4; u += NWAVES * 64) ((LAS unsigned*)(F.lds + LDSCTL_OFF))[u] = 0u;
    __syncthreads();
    XcdBarrier bar; bar.bar = (unsigned*)(F.ctl + CW_BAR); bar.x = 0; bar.st = nullptr; bar.G = 0;
    XcdBarrier bar2 = bar;
    if (N_LAUNCHES == 1) { bar = xcd_barrier_post((unsigned*)(F.ctl + CW_BAR), F.MISC + 8, (unsigned)F.G);
        if (F.vcu >= 128) bar2 = xcd_barrier_post((unsigned*)(F.ctl + CW_BAR2), F.MISC + 10, (unsigned)(F.G - 128)); }
#define GRID_BAR() do { if (N_LAUNCHES == 1) xcd_barrier(bar); } while (0)
    const int lo = args.ph_lo, hi = args.ph_hi;
#define IN(k) (lo <= (k) && (k) < hi)
#define BOTH(k) (IN(k) && IN((k) + 1))
    bf16* const Hb = (bf16*)(ws + WS_H);
    bf16* const PRJ = (bf16*)(ws + WS_PROJ);

    if (IN(0)) { p0_prologue(F); if (BOTH(0)) GRID_BAR(); }

    if (IN(1)) {
        s5_tables_stage1(F);
        pg8::Gemm g{Hb, (const bf16*)(ws + WS_WIN), M, NPROJ, D, D, D}; pg8::StaticOrder S; S.init(M, NPROJ, F.G, (int)blockIdx.x);
        pg8::EpiProj E{PRJ, PRJ + (size_t)M * 512, PRJ + (size_t)2 * M * 512, PRJ + (size_t)3 * M * 512, (bf16*)(ws + WS_A5), (const float*)(ws + WS_LB), M};
        pg8::gemm_phase<pg8::EpiProj, pg8::StaticOrder, true, true>(F.lds + RING_OFF, g, S, E);
        if (BOTH(1)) GRID_BAR();
    }

    if (IN(2)) {
        s5_tables_stage2(F);
        if (F.vcu < 128) hgrn2_state_pass(F, F.vcu);
        else { pg8::Gemm g{(const bf16*)(ws + WS_A5), (const bf16*)(ws + WS_G5), 32 * S5I, 32 * 256, 512, S5K, 512}; pg8::GroupedOrder S{4, 1, F.G - 128, F.vcu - 128};
            pg8::EpiS5A E{(float*)(ws + WS_XLOC)};
            pg8::gemm_phase<pg8::EpiS5A, pg8::GroupedOrder, true, true>(F.lds + RING_OFF, g, S, E);
            if (N_LAUNCHES == 1) { xcd_barrier(bar2); if (F.vcu - 128 < 32) s5_scan(F, (F.vcu - 128) * 512 + F.tid); }
        }
        { constexpr int NTAB16 = PE * D / 16, NCHUNK = 2 * NTAB16 / 4096;
          for (;;) {
              if (F.tid == 0) F.MISC[4] = xb_add((unsigned*)(F.ctl + CW_CONV), 1u);
              __syncthreads();
              const int ch = (int)F.MISC[4];
              __syncthreads();
              if (ch >= NCHUNK) break;
#pragma unroll 2
              for (int q8 = 0; q8 < 8; ++q8) { const int i = ch * 4096 + q8 * 512 + F.tid; const bool up = i >= NTAB16; const int j = up ? i - NTAB16 : i; const float* src = (up ? F.in[I_PU] : F.in[I_PD]) + (size_t)j * 16; const float sc = up ? PU_SCALE : PD_SCALE;
                  v4u o; unsigned ow[4];
#pragma unroll
                  for (int q = 0; q < 4; ++q) { const f32x4 a = *(const GAS f32x4*)(src + 4 * q); int pk = __builtin_amdgcn_cvt_pk_fp8_f32(a.x * sc, a.y * sc, 0, false); pk = __builtin_amdgcn_cvt_pk_fp8_f32(a.z * sc, a.w * sc, pk, true); ow[q] = (unsigned)pk; }
                  o.x = ow[0]; o.y = ow[1]; o.z = ow[2]; o.w = ow[3];
                  *(GAS v4u*)(ws + (up ? WS_PU : WS_PD) + (size_t)j * 16) = o; }
          } }
        if (BOTH(2)) GRID_BAR();
    }

    if (IN(3)) {
        if (N_LAUNCHES != 1) { if (F.vcu < 32) s5_scan(F, F.vcu * 512 + F.tid); }
        { pg8::Gemm g{(const bf16*)(ws + WS_A5), (const bf16*)(ws + WS_T5), 32 * S5I, 32 * 512, S5K, S5K, S5K}; pg8::GroupedOrder S{4, 2, F.G, F.vcu};
          pg8::EpiS5C E{(bf16*)(ws + WS_Z)};
          pg8::gemm_phase<pg8::EpiS5C, pg8::GroupedOrder, true, true>(F.lds + RING_OFF, g, S, E); }
        hgrn2_out_phase(F);
        if (BOTH(3)) GRID_BAR();
    }

    if (IN(4)) {
        pg8::Gemm g{(const bf16*)(ws + WS_Z), (const bf16*)(ws + WS_WGLU), M, 512, 512, 512, 512}; pg8::StaticOrder S; S.init(M, 512, F.G, (int)blockIdx.x);
        pg8::EpiGlu E{(const bf16*)(ws + WS_Z), (bf16*)(ws + WS_MIX), F.in[I_BGLU]};
        pg8::gemm_phase<pg8::EpiGlu, pg8::StaticOrder, true, true>(F.lds + RING_OFF, g, S, E);
        if (BOTH(4)) GRID_BAR();
    }

    if (IN(5)) {
        pg8::Gemm g{(const bf16*)(ws + WS_MIX), (const bf16*)(ws + WS_WOUT), M, D, D, D, D}; pg8::StaticOrder S; S.init(M, D, F.G, (int)blockIdx.x);
        pg8::EpiOut E{Hb, DN_ALPHA};
        pg8::gemm_phase<pg8::EpiOut, pg8::StaticOrder, true, true>(F.lds + RING_OFF, g, S, E);
        if (BOTH(5)) GRID_BAR();
    }

    if (IN(6)) {
        const int gw = F.vcu * NWAVES + F.wave, NGW = F.G * NWAVES;
        for (int m = gw; m < M; m += NGW) ln1_row(Hb + (size_t)m * D, F.in[I_LN1G], F.in[I_LN1B], F.lane);
        if (BOTH(6)) GRID_BAR();
    }

    if (IN(7)) {
        pg8::Gemm g{Hb, (const bf16*)(ws + WS_WQ), M, NQ2, D, D, D}; pg8::StaticOrder S; S.init(M, NQ2, F.G, (int)blockIdx.x);
        pg8::EpiStore E{(bf16*)(ws + WS_Q2), NQ2};
        pg8::gemm_phase<pg8::EpiStore, pg8::StaticOrder, true, true>(F.lds + RING_OFF, g, S, E);
        VM_WAIT(); __syncthreads();
        if (F.tid == 0) { __builtin_amdgcn_fence(__ATOMIC_ACQUIRE, "agent"); VM_WAIT(); }
        __syncthreads();
        peer_score_phase(F, S);
        if (BOTH(7)) GRID_BAR();
    }

    if (IN(8)) { peer_gather_phase(F); }
#undef IN
#undef BOTH
}

extern "C" void kernel_launch(void* const* d_in, const int* in_sizes, int n_in, void* d_out, int out_size, void* d_ws, size_t ws_size, hipStream_t stream) {
    static int grid = 0;
    if (grid == 0) {
        if (n_in != 26 || in_sizes[0] != M * D || out_size != M * D || ws_size < WS_END) { fprintf(stderr, "kernel_launch: unexpected shapes: n_in %d in0 %d out %d ws %zu (need %zu)\n", n_in, n_in > 0 ? in_sizes[0] : -1, out_size, ws_size, (size_t)WS_END); grid = -1; return; }
        int dev = 0, cus = 0;
        if (hipGetDevice(&dev) != hipSuccess || hipDeviceGetAttribute(&cus, hipDeviceAttributeMultiprocessorCount, dev) != hipSuccess) { grid = -1; return; }
        if (hipFuncSetAttribute((const void*)fwd_kernel, hipFuncAttributeMaxDynamicSharedMemorySize, LDS_BYTES) != hipSuccess) { fprintf(stderr, "kernel_launch: hipFuncSetAttribute failed\n"); grid = -1; return; }
        (void)hipGetLastError();
        grid = cus;
    }
    if (grid < 0) return;
    if (hipMemsetAsync((char*)d_ws + WS_CTL, 0, CTL_ZERO_BYTES, stream) != hipSuccess) return;
    Args a{};
    for (int i = 0; i < 26; ++i) a.in[i] = (const float*)d_in[i];
    a.out = (float*)d_out; a.ws = (unsigned char*)d_ws;
    if (N_LAUNCHES == 1) { a.ph_lo = 0; a.ph_hi = NPH; a.li = 0; hipLaunchKernelGGL(fwd_kernel, dim3(grid), dim3(NWAVES * 64), LDS_BYTES, stream, a); }
    else for (int li = 0; li < NPH; ++li) { a.ph_lo = li; a.ph_hi = li + 1; a.li = li; hipLaunchKernelGGL(fwd_kernel, dim3(grid), dim3(NWAVES * 64), LDS_BYTES, stream, a); }
}
```

```cpp
#include <hip/hip_runtime.h>
#include <cstdio>
#include <cstdint>
namespace pg8 {
#define PG8_LAS __attribute__((address_space(3)))
typedef unsigned short bf16_t;
typedef short bf16x8 __attribute__((ext_vector_type(8)));
typedef float f32x4 __attribute__((ext_vector_type(4)));
typedef unsigned u32x4 __attribute__((ext_vector_type(4)));
constexpr int BM = 256, BK = 64, HALF = 128, HTB = HALF * BK * 2  , STAGE_BYTES = 8 * HTB, NXCD = 8, WGM = 8;

__host__ __device__ __forceinline__ int lds_byte(int r, int c) { const int st = (r >> 4) * 2 + (c >> 5), rr = r & 15, cc = c & 31, ob = rr * 64 + cc * 2; return st * 1024 + (ob ^ (((ob >> 9) & 1) << 5)); }
__host__ __device__ __forceinline__ void stage_rc(int b, int& R, int& C) { const int st = b / 1024, sb = b % 1024, swz = sb ^ (((sb >> 9) & 1) << 5); R = (st >> 1) * 16 + swz / 64; C = (st & 1) * 32 + (swz % 64) / 2; }
__host__ __device__ __forceinline__ int perm32(int rho) { const int n = rho >> 4, i = rho & 15; return 8 * (i >> 2) + 4 * n + (i & 3); }

struct Unit { int pm, pn; };
struct Gemm { const bf16_t* A; const bf16_t* Bt; int M, N, K, lda, ldb; };

struct StaticOrder {
    int nM, nN, nwg, G, c;
    __host__ __device__ void init(int M, int N, int G_, int c_) { nM = M / BM; nN = N / BM; nwg = nM * nN; G = G_; c = c_; }
    __host__ __device__ bool next(int i, Unit& u) const {
        const long L = (long)i * G + c; if (L >= nwg) return false;
        int wgid = (int)L; { const int q = nwg / NXCD, r = nwg % NXCD, xcd = wgid % NXCD, off = wgid / NXCD; wgid = (xcd < r ? xcd * (q + 1) : r * (q + 1) + (xcd - r) * q) + off; }
        const int nig = WGM * nN, gid = wgid / nig, fm = gid * WGM, gsz = (nM - fm) < WGM ? (nM - fm) : WGM;
        u.pm = fm + ((wgid % nig) % gsz); u.pn = (wgid % nig) / gsz; return true;
    }
    __device__ __forceinline__ void a_ready(const Unit&) const {}
    __device__ __forceinline__ void done(const Unit&) const {}
};

__device__ __forceinline__ unsigned cvt_pk_bf16(float lo, float hi) { unsigned r; asm volatile("v_cvt_pk_bf16_f32 %0, %1, %2" : "=v"(r) : "v"(lo), "v"(hi)); return r; }
__device__ __forceinline__ void unpack8(const u32x4 w, float (&f)[8]) {
    f[0] = __builtin_bit_cast(float, w.x << 16); f[1] = __builtin_bit_cast(float, w.x & 0xffff0000u);
    f[2] = __builtin_bit_cast(float, w.y << 16); f[3] = __builtin_bit_cast(float, w.y & 0xffff0000u);
    f[4] = __builtin_bit_cast(float, w.z << 16); f[5] = __builtin_bit_cast(float, w.z & 0xffff0000u);
    f[6] = __builtin_bit_cast(float, w.w << 16); f[7] = __builtin_bit_cast(float, w.w & 0xffff0000u);
}
__device__ __forceinline__ u32x4 pack8(const float (&f)[8]) { u32x4 w; w.x = cvt_pk_bf16(f[0], f[1]); w.y = cvt_pk_bf16(f[2], f[3]); w.z = cvt_pk_bf16(f[4], f[5]); w.w = cvt_pk_bf16(f[6], f[7]); return w; }

struct EpiStore {
    static constexpr bool PERM = true, AFTER_DRAIN = false;
    bf16_t* O; int ldc;
    __device__ __forceinline__ void operator()(const f32x4 (&acc)[2][2][4][2], const Unit& u, int wr, int wc, int fr, int fq) const {
        const int row0 = u.pm * BM + wr * 64 + fr, col0 = u.pn * BM + wc * 32 + 8 * fq;
#pragma unroll
        for (int ai = 0; ai < 2; ++ai)
#pragma unroll
            for (int m = 0; m < 4; ++m) { bf16_t* rowp = O + (size_t)(row0 + ai * HALF + m * 16) * ldc + col0;
#pragma unroll
                for (int bj = 0; bj < 2; ++bj) { const f32x4 v0 = acc[ai][bj][m][0], v1 = acc[ai][bj][m][1];
                    u32x4 w; w.x = cvt_pk_bf16(v0[0], v0[1]); w.y = cvt_pk_bf16(v0[2], v0[3]); w.z = cvt_pk_bf16(v1[0], v1[1]); w.w = cvt_pk_bf16(v1[2], v1[3]);
                    *(u32x4*)(rowp + bj * HALF) = w; } }
    }
};

struct EpiProj {
    static constexpr bool PERM = true, AFTER_DRAIN = false;
    bf16_t* Qb; bf16_t* LFb; bf16_t* Vb; bf16_t* Gb; bf16_t* Ub; const float* lb; int M;
    __device__ __forceinline__ void operator()(const f32x4 (&acc)[2][2][4][2], const Unit& u, int wr, int wc, int fr, int fq) const {
        const int row0 = u.pm * BM + wr * 64 + fr; const int colt = u.pn * BM; const int t = colt >> 9;
        const int cb = (colt & 511) + wc * 32 + 8 * fq;
        float lbv[2][8];
        if (t == 1) {
#pragma unroll
            for (int bj = 0; bj < 2; ++bj) { const f32x4 a = *(const f32x4*)(lb + cb + bj * HALF), b = *(const f32x4*)(lb + cb + bj * HALF + 4);
                lbv[bj][0] = a[0]; lbv[bj][1] = a[1]; lbv[bj][2] = a[2]; lbv[bj][3] = a[3]; lbv[bj][4] = b[0]; lbv[bj][5] = b[1]; lbv[bj][6] = b[2]; lbv[bj][7] = b[3]; }
        }
#pragma unroll
        for (int ai = 0; ai < 2; ++ai)
#pragma unroll
            for (int m = 0; m < 4; ++m) { const int row = row0 + ai * HALF + m * 16;
#pragma unroll
                for (int bj = 0; bj < 2; ++bj) { const f32x4 v0 = acc[ai][bj][m][0], v1 = acc[ai][bj][m][1]; const int c = cb + bj * HALF;
                    float f[8] = {v0[0], v0[1], v0[2], v0[3], v1[0], v1[1], v1[2], v1[3]};
                    if (t == 0) {
#pragma unroll
                        for (int j = 0; j < 8; ++j) f[j] *= 0.08838834764831845f;
                        *(u32x4*)(Qb + (size_t)row * 512 + c) = pack8(f);
                    } else if (t == 1) {
#pragma unroll
                        for (int j = 0; j < 8; ++j) { const float l = lbv[bj][j]; const float sg = 1.f / (1.f + __expf(-f[j])); f[j] = __logf(l + (1.f - l) * sg); }
                        *(u32x4*)(LFb + (size_t)row * 512 + c) = pack8(f);
                    } else if (t == 2) { *(u32x4*)(Vb + (size_t)row * 512 + c) = pack8(f);
                    } else if (t == 3) { *(u32x4*)(Gb + (size_t)row * 512 + c) = pack8(f);
                    } else { *(u32x4*)(Ub + ((size_t)(c >> 4) * (M / 32) + (row >> 5)) * 640 + (row & 31) * 16 + (c & 15)) = pack8(f); }
                } }
    }
};

struct EpiGlu {
    static constexpr bool PERM = true, AFTER_DRAIN = false;
    const bf16_t* Z; bf16_t* MIX; const float* bglu;
    __device__ __forceinline__ void operator()(const f32x4 (&acc)[2][2][4][2], const Unit& u, int wr, int wc, int fr, int fq) const {
        const int row0 = u.pm * BM + wr * 64 + fr, col0 = u.pn * BM + wc * 32 + 8 * fq;
#pragma unroll
        for (int bj = 0; bj < 2; ++bj) { const int c = col0 + bj * HALF;
            const f32x4 b0 = *(const f32x4*)(bglu + c), b1 = *(const f32x4*)(bglu + c + 4);
#pragma unroll
            for (int ai = 0; ai < 2; ++ai)
#pragma unroll
                for (int m = 0; m < 4; ++m) { const int row = row0 + ai * HALF + m * 16;
                    const f32x4 v0 = acc[ai][bj][m][0] + b0, v1 = acc[ai][bj][m][1] + b1;
                    float z[8]; unpack8(*(const u32x4*)(Z + (size_t)row * 512 + c), z);
                    float f[8] = {v0[0], v0[1], v0[2], v0[3], v1[0], v1[1], v1[2], v1[3]};
#pragma unroll
                    for (int j = 0; j < 8; ++j) f[j] = z[j] / (1.f + __expf(-f[j]));
                    *(u32x4*)(MIX + (size_t)row * 1024 + 512 + c) = pack8(f); } }
    }
};

struct EpiOut {
    static constexpr bool PERM = true, AFTER_DRAIN = false;
    bf16_t* H; float alpha;
    __device__ __forceinline__ void operator()(const f32x4 (&acc)[2][2][4][2], const Unit& u, int wr, int wc, int fr, int fq) const {
        const int row0 = u.pm * BM + wr * 64 + fr, col0 = u.pn * BM + wc * 32 + 8 * fq;
#pragma unroll
        for (int ai = 0; ai < 2; ++ai)
#pragma unroll
            for (int m = 0; m < 4; ++m) { bf16_t* rowp = H + (size_t)(row0 + ai * HALF + m * 16) * 1024 + col0;
#pragma unroll
                for (int bj = 0; bj < 2; ++bj) { const f32x4 v0 = acc[ai][bj][m][0], v1 = acc[ai][bj][m][1];
                    float h[8]; unpack8(*(const u32x4*)(rowp + bj * HALF), h);
                    float f[8] = {v0[0], v0[1], v0[2], v0[3], v1[0], v1[1], v1[2], v1[3]};
#pragma unroll
                    for (int j = 0; j < 8; ++j) f[j] = alpha * h[j] + f[j];
                    *(u32x4*)(rowp + bj * HALF) = pack8(f); } }
    }
};

struct GroupedOrder {
    int tm, tn, G, c;
    __device__ bool next(int i, Unit& u) const { const int L = i * G + c, per = tm * tn; if (c < 0 || L >= 32 * per) return false;
        const int g = L / per, r = L % per; u.pm = g * tm + r % tm; u.pn = g * tn + r / tm; return true; }
    __device__ __forceinline__ void a_ready(const Unit&) const {}
    __device__ __forceinline__ void done(const Unit&) const {}
};
struct EpiS5A {
    static constexpr bool PERM = true, AFTER_DRAIN = false;
    float* X;
    __device__ __forceinline__ void operator()(const f32x4 (&acc)[2][2][4][2], const Unit& u, int wr, int wc, int fr, int fq) const {
        const int g = u.pn, inst0 = (u.pm & 3) * BM + wr * 64 + fr, col = wc * 32 + 8 * fq;
#pragma unroll
        for (int ai = 0; ai < 2; ++ai)
#pragma unroll
            for (int m = 0; m < 4; ++m) { float* p = X + ((size_t)(inst0 + ai * HALF + m * 16) * 32 + g) * 128 + col;
                *(f32x4*)p = acc[ai][0][m][0]; *(f32x4*)(p + 4) = acc[ai][0][m][1]; }
    }
};
struct EpiS5C {
    static constexpr bool PERM = true, AFTER_DRAIN = false;
    bf16_t* Z;
    __device__ __forceinline__ void operator()(const f32x4 (&acc)[2][2][4][2], const Unit& u, int wr, int wc, int fr, int fq) const {
        const int g = u.pm >> 2, inst0 = (u.pm & 3) * BM + wr * 64 + fr, col0 = (u.pn & 1) * BM + wc * 32 + 8 * fq;
#pragma unroll
        for (int ai = 0; ai < 2; ++ai)
#pragma unroll
            for (int m = 0; m < 4; ++m) { const int inst = inst0 + ai * HALF + m * 16; const size_t tok0 = (size_t)(inst >> 7) * 4096 + (size_t)(inst & 127) * 32;
#pragma unroll
                for (int bj = 0; bj < 2; ++bj) { const int col = col0 + bj * HALF; const f32x4 v0 = acc[ai][bj][m][0], v1 = acc[ai][bj][m][1];
                    float f[8] = {v0[0], v0[1], v0[2], v0[3], v1[0], v1[1], v1[2], v1[3]};
#pragma unroll
                    for (int j = 0; j < 8; ++j) { const float x = f[j], y = 0.7978845608028654f * (x + 0.044715f * x * x * x); f[j] = x / (1.f + __expf(-2.f * y)); }
                    *(u32x4*)(Z + (tok0 + (col >> 4)) * 512 + g * 16 + (col & 15)) = pack8(f); } }
    }
};

template <class Epi, class Sched, bool ALIGN_EPI = false, bool SP2 = false>
__device__ __forceinline__ void gemm_phase(PG8_LAS unsigned char* lds, const Gemm g, const Sched& S, const Epi& E) {
    const int tid = threadIdx.x, wid = __builtin_amdgcn_readfirstlane(tid >> 6), lane = tid & 63, wr = wid >> 2, wc = wid & 3, fr = lane & 15, fq = lane >> 4;
    const int K = g.K, nt = K / BK;
    unsigned voffA[2], voffB[2];
#pragma unroll
    for (int i = 0; i < 2; ++i) { int R, C; stage_rc(tid * 16 + i * 8192, R, C); const int Rb = Epi::PERM ? ((R & ~31) + perm32(R & 31)) : R;
        voffA[i] = (unsigned)(R * g.lda + C) * 2u; voffB[i] = (unsigned)(Rb * g.ldb + C) * 2u; }
    const size_t kstep = (size_t)(BK * 2);
    const size_t hstepA = (size_t)HALF * g.lda * 2, hstepB = (size_t)HALF * g.ldb * 2;
    const size_t tstepA = 2 * hstepA, tstepB = 2 * hstepB;
    const unsigned ldsw = (unsigned)wid * 1024u;
    const int aoff = lds_byte(wr * 64 + fr, fq * 8), boff = lds_byte(wc * 32 + fr, fq * 8);
#define PG8_SA(b, h) (((b) * 2 + (h)) * HTB)
#define PG8_SB(b, h) ((4 + (b) * 2 + (h)) * HTB)
#define PG8_STAGE(bufoff, gbase, voff) do { _Pragma("unroll") for (int _i = 0; _i < 2; ++_i) \
        __builtin_amdgcn_global_load_lds((const unsigned*)((const char*)(gbase) + (voff)[_i]), (PG8_LAS unsigned*)(lds + (bufoff) + ldsw + _i * 8192), 16, 0, 0); } while (0)
#define PG8_LDA(dst, b, h) do { _Pragma("unroll") for (int m = 0; m < 4; ++m) _Pragma("unroll") for (int k = 0; k < 2; ++k) dst[m][k] = *(const PG8_LAS bf16x8*)(lds + PG8_SA(b, h) + aoff + m * 2048 + k * 1024); } while (0)
#define PG8_LDB(dst, b, h) do { _Pragma("unroll") for (int n = 0; n < 2; ++n) _Pragma("unroll") for (int k = 0; k < 2; ++k) dst[n][k] = *(const PG8_LAS bf16x8*)(lds + PG8_SB(b, h) + boff + n * 2048 + k * 1024); } while (0)
#define PG8_MMA(ai, bj, At, Bt) do { __builtin_amdgcn_s_setprio(1); _Pragma("unroll") for (int m = 0; m < 4; ++m) _Pragma("unroll") for (int n = 0; n < 2; ++n) _Pragma("unroll") for (int k = 0; k < 2; ++k) \
        acc[ai][bj][m][n] = __builtin_amdgcn_mfma_f32_16x16x32_bf16(Bt[n][k], At[m][k], acc[ai][bj][m][n], 0, 0, 0); __builtin_amdgcn_s_setprio(0); } while (0)
#define PG8_WAIT_V(n) asm volatile("s_waitcnt vmcnt(" #n ")" ::: "memory")
#define PG8_WAIT_L(n) asm volatile("s_waitcnt lgkmcnt(" #n ")" ::: "memory")
#define PG8_BAR __builtin_amdgcn_s_barrier()
#define PG8_SCHED __builtin_amdgcn_sched_barrier(0)
    Unit cur, nxt; int ui = 0;
    if (!S.next(0, cur)) return;
    f32x4 acc[2][2][4][2];
#pragma unroll
    for (int a = 0; a < 2; ++a)
#pragma unroll
        for (int b = 0; b < 2; ++b)
#pragma unroll
            for (int m = 0; m < 4; ++m)
#pragma unroll
                for (int n = 0; n < 2; ++n) acc[a][b][m][n] = (f32x4){0.f, 0.f, 0.f, 0.f};
    bf16x8 At[4][2], B0[2][2], B1[2][2];
    const char* cA = (const char*)g.A + (size_t)cur.pm * tstepA; const char* cB = (const char*)g.Bt + (size_t)cur.pn * tstepB;
    S.a_ready(cur);
    if constexpr (SP2) {
        PG8_STAGE(PG8_SB(0, 0), cB, voffB); PG8_STAGE(PG8_SB(0, 1), cB + hstepB, voffB); PG8_STAGE(PG8_SA(0, 0), cA, voffA); PG8_STAGE(PG8_SA(0, 1), cA + hstepA, voffA);
        if (wr == 1) PG8_BAR;
        PG8_WAIT_V(2); PG8_BAR;
        PG8_STAGE(PG8_SB(1, 0), cB + kstep, voffB); PG8_STAGE(PG8_SA(1, 0), cA + kstep, voffA); PG8_STAGE(PG8_SB(1, 1), cB + hstepB + kstep, voffB);
        PG8_WAIT_V(6); PG8_BAR;
    } else {
        PG8_STAGE(PG8_SB(0, 0), cB, voffB); PG8_STAGE(PG8_SA(0, 0), cA, voffA); PG8_STAGE(PG8_SB(0, 1), cB + hstepB, voffB); PG8_STAGE(PG8_SA(0, 1), cA + hstepA, voffA);
        if (wr == 1) PG8_BAR;
        PG8_WAIT_V(4); PG8_BAR;
        PG8_STAGE(PG8_SB(1, 0), cB + kstep, voffB); PG8_STAGE(PG8_SA(1, 0), cA + kstep, voffA); PG8_STAGE(PG8_SB(1, 1), cB + hstepB + kstep, voffB);
        PG8_WAIT_V(6); PG8_BAR;
    }
    for (;;) {
        const bool has_next = S.next(ui + 1, nxt);
        const char* nA = has_next ? (const char*)g.A + (size_t)nxt.pm * tstepA : cA; const char* nB = has_next ? (const char*)g.Bt + (size_t)nxt.pn * tstepB : cB;
        for (int t = 0; t < nt; t += 2) {
            const bool last = (t == nt - 2);
            const char* a1 = cA + (size_t)(t + 1) * kstep;
            const char* a2 = last ? nA : cA + (size_t)(t + 2) * kstep; const char* b2 = last ? nB : cB + (size_t)(t + 2) * kstep;
            const char* a3 = a2 + kstep; const char* b3 = b2 + kstep;
            if (last && has_next) S.a_ready(nxt);
            if constexpr (SP2) {
            PG8_LDB(B0, 0, 0); PG8_LDB(B1, 0, 1); PG8_SCHED; PG8_LDA(At, 0, 0); PG8_STAGE(PG8_SA(1, 1), a1 + hstepA, voffA);
            PG8_WAIT_V(8); PG8_WAIT_L(0); PG8_BAR; PG8_MMA(0, 0, At, B0); PG8_MMA(0, 1, At, B1); PG8_BAR; PG8_SCHED;
            PG8_LDA(At, 0, 1); PG8_STAGE(PG8_SB(0, 0), b2, voffB); PG8_STAGE(PG8_SB(0, 1), b2 + hstepB, voffB); PG8_STAGE(PG8_SA(0, 0), a2, voffA);
            PG8_WAIT_V(8); PG8_WAIT_L(0); PG8_BAR; PG8_MMA(1, 0, At, B0); PG8_MMA(1, 1, At, B1); PG8_BAR; PG8_SCHED;
            PG8_LDB(B0, 1, 0); PG8_LDB(B1, 1, 1); PG8_SCHED; PG8_LDA(At, 1, 0); PG8_STAGE(PG8_SA(0, 1), a2 + hstepA, voffA);
            PG8_WAIT_V(8); PG8_WAIT_L(0); PG8_BAR; PG8_MMA(0, 0, At, B0); PG8_MMA(0, 1, At, B1); PG8_BAR; PG8_SCHED;
            PG8_LDA(At, 1, 1); PG8_STAGE(PG8_SB(1, 0), b3, voffB); PG8_STAGE(PG8_SB(1, 1), b3 + hstepB, voffB); PG8_STAGE(PG8_SA(1, 0), a3, voffA);
            PG8_WAIT_V(8); PG8_WAIT_L(0); PG8_BAR; PG8_MMA(1, 0, At, B0); PG8_MMA(1, 1, At, B1); PG8_BAR; PG8_SCHED;
            } else {
            PG8_LDB(B0, 0, 0); PG8_SCHED; PG8_LDA(At, 0, 0); PG8_STAGE(PG8_SA(1, 1), a1 + hstepA, voffA);
            PG8_WAIT_L(8); PG8_BAR; PG8_WAIT_L(0); PG8_MMA(0, 0, At, B0); PG8_BAR; PG8_SCHED;
            PG8_LDB(B1, 0, 1); PG8_STAGE(PG8_SB(0, 0), b2, voffB);
            PG8_BAR; PG8_WAIT_L(0); PG8_MMA(0, 1, At, B1); PG8_BAR;
            PG8_LDA(At, 0, 1); PG8_STAGE(PG8_SA(0, 0), a2, voffA);
            PG8_BAR; PG8_WAIT_L(0); PG8_MMA(1, 0, At, B0); PG8_BAR; PG8_SCHED;
            PG8_STAGE(PG8_SB(0, 1), b2 + hstepB, voffB);
            PG8_WAIT_V(6); PG8_BAR; PG8_MMA(1, 1, At, B1); PG8_BAR;
            PG8_LDB(B0, 1, 0); PG8_SCHED; PG8_LDA(At, 1, 0); PG8_STAGE(PG8_SA(0, 1), a2 + hstepA, voffA);
            PG8_WAIT_L(8); PG8_BAR; PG8_WAIT_L(0); PG8_MMA(0, 0, At, B0); PG8_BAR; PG8_SCHED;
            PG8_LDB(B1, 1, 1); PG8_STAGE(PG8_SB(1, 0), b3, voffB);
            PG8_BAR; PG8_WAIT_L(0); PG8_MMA(0, 1, At, B1); PG8_BAR;
            PG8_LDA(At, 1, 1); PG8_STAGE(PG8_SA(1, 0), a3, voffA);
            PG8_BAR; PG8_WAIT_L(0); PG8_MMA(1, 0, At, B0); PG8_BAR; PG8_SCHED;
            PG8_STAGE(PG8_SB(1, 1), b3 + hstepB, voffB);
            PG8_WAIT_V(6); PG8_BAR; PG8_MMA(1, 1, At, B1); PG8_BAR;
            }
        }
        if constexpr (ALIGN_EPI) { if (wr == 0) PG8_BAR; }
        if constexpr (!Epi::AFTER_DRAIN) { E(acc, cur, wr, wc, fr, fq); S.done(cur); }
        if (!has_next) break;
#pragma unroll
        for (int a = 0; a < 2; ++a)
#pragma unroll
            for (int b = 0; b < 2; ++b)
#pragma unroll
                for (int m = 0; m < 4; ++m)
#pragma unroll
                    for (int n = 0; n < 2; ++n) acc[a][b][m][n] = (f32x4){0.f, 0.f, 0.f, 0.f};
        cur = nxt; cA = nA; cB = nB; ++ui;
        if constexpr (ALIGN_EPI) { if (wr == 1) PG8_BAR; }
    }
    PG8_WAIT_V(0);
    if constexpr (!ALIGN_EPI) { if (wr == 0) PG8_BAR; }
    PG8_BAR;
    if constexpr (Epi::AFTER_DRAIN) { E.fused(acc, cur, wr, wc, fr, fq, lds, wid, lane); S.done(cur); }
#undef PG8_SA
#undef PG8_SB
#undef PG8_STAGE
#undef PG8_LDA
#undef PG8_LDB
#undef PG8_MMA
#undef PG8_WAIT_V
#undef PG8_WAIT_L
#undef PG8_BAR
#undef PG8_SCHED
}
}

constexpr int NWAVES = 8;
#ifndef MK_N_LAUNCHES
#define MK_N_LAUNCHES 1
#endif
constexpr int N_LAUNCHES = MK_N_LAUNCHES;
constexpr int NPH = 9;

constexpr int BATCH = 8, SEQ = 4096, D = 1024, M = BATCH * SEQ;
constexpr int HGW = 512, HGH = 4, HGK = 128;
constexpr int S5W = 512, S5G = 32, S5P = 16, S5N = 64;
constexpr int S5L = 32, S5I = M / S5L, S5K = S5L * S5P + 2 * S5N;
constexpr int NPROJ = 2560;
constexpr int PK = 128, PH = 8, PTOPK = 16, PQ = 256, PHALF = 128, PE = PK * PK, NQ2 = PH * PQ;
constexpr float LN_EPS = 1e-5f, RMS_EPS = 1e-6f;
constexpr float DN_ALPHA = 1.189207115002721f;

constexpr size_t MiB = 1u << 20;
constexpr size_t WS_CTL = 0, CTL_ZERO_BYTES = 1 * MiB;
constexpr size_t WS_WIN = 1 * MiB;
constexpr size_t WS_WGLU = 6 * MiB;
constexpr size_t WS_KEYS = 6 * MiB + 512 * 1024;
constexpr size_t WS_LB = 6 * MiB + 640 * 1024;
constexpr size_t WS_S5T = 6 * MiB + 704 * 1024;
constexpr size_t WS_WOUT = 7 * MiB + 512 * 1024;
constexpr size_t WS_WQ = 10 * MiB;
constexpr size_t WS_SST = 14 * MiB;
constexpr size_t WS_H = 78 * MiB;
constexpr size_t WS_PROJ = 142 * MiB;
constexpr size_t WS_Q2 = WS_PROJ;
constexpr size_t WS_A5 = 270 * MiB;
constexpr size_t WS_MIX = 310 * MiB;
constexpr size_t WS_PD = 452 * MiB, WS_PU = 468 * MiB;
constexpr size_t WS_Z = 374 * MiB;
constexpr size_t WS_EIDX = WS_Z, WS_EGATE = WS_Z + 16 * MiB;
constexpr size_t WS_T5 = 406 * MiB;
constexpr size_t WS_G5 = 426 * MiB;
constexpr size_t WS_XLOC = 434 * MiB;
constexpr size_t WS_KTAU = 450 * MiB;
constexpr size_t WS_PW = 451 * MiB;
constexpr size_t WS_END = 484 * MiB;
constexpr int CW_TMO = 0, CW_CODE = 1;
constexpr int CW_BAR = 4096, CW_BAR2 = 8192;
constexpr int CW_CONV = 65536;

constexpr int RING_OFF = 0, RING_BYTES = 147456;
constexpr int LDSCTL_OFF = RING_BYTES, MISC_OFF = LDSCTL_OFF + 320;
constexpr int LDS_BYTES = 151552;
static_assert(MISC_OFF + 128 <= LDS_BYTES, "LDS map");

#define GAS __attribute__((address_space(1)))
#define LAS __attribute__((address_space(3)))
typedef unsigned short bf16;
typedef unsigned v4u __attribute__((ext_vector_type(4)));
typedef float f32x4 __attribute__((ext_vector_type(4)));
typedef short bf16x8 __attribute__((ext_vector_type(8)));
typedef GAS unsigned gu32;
typedef GAS unsigned long long gu64;
#define RLX_AGENT __ATOMIC_RELAXED, __HIP_MEMORY_SCOPE_AGENT
#define LDS_WAIT() asm volatile("s_waitcnt lgkmcnt(0)" ::: "memory")
#define VM_WAIT() asm volatile("s_waitcnt vmcnt(0)" ::: "memory")
__device__ __forceinline__ unsigned long long rt() { return __builtin_amdgcn_s_memrealtime(); }
__device__ __forceinline__ unsigned f2bf(float f) { unsigned u = __builtin_bit_cast(unsigned, f); return (u + 0x7fffu + ((u >> 16) & 1u)) >> 16; }
__device__ __forceinline__ unsigned pk2(float lo, float hi) { return f2bf(lo) | (f2bf(hi) << 16); }

#define XB_TMO      128
#define XB_XCNT(j)  (256  + 64 * (j))
#define XB_XSUB(j)  (1280 + 64 * (j))
#define XB_XGEN(j)  (2304 + 64 * (j))
#define XB_TOP      3328
#define XB_TOPGEN   3392
#define XCD_BAR_WORDS 3456
#define XB_SPIN_CAP (1u << 18)

__device__ __forceinline__ unsigned xb_ld(unsigned* p)              { return __hip_atomic_load(p, __ATOMIC_RELAXED, __HIP_MEMORY_SCOPE_AGENT); }
__device__ __forceinline__ unsigned xb_add(unsigned* p, unsigned v) { return __hip_atomic_fetch_add(p, v, __ATOMIC_RELAXED, __HIP_MEMORY_SCOPE_AGENT); }
__device__ __forceinline__ unsigned xb_xcc_id() { return (unsigned)__builtin_amdgcn_s_getreg((3 << 11) | 20) & 0xFu; }
#define XB_SPIN(cond, bar) do { unsigned _sp = 0; while (cond) { __builtin_amdgcn_s_sleep(1); \
    if ((++_sp & 255u) == 0u) { if (xb_ld(&(bar)[XB_TMO])) break; if (_sp > XB_SPIN_CAP) { atomicAdd(&(bar)[XB_TMO], 1u); break; } } } } while (0)

struct XcdBarrier {
    unsigned* bar; unsigned x; unsigned G;
    volatile LAS unsigned* st;
};

__device__ __forceinline__ XcdBarrier xcd_barrier_post(unsigned* bar, volatile LAS unsigned* st, unsigned G) {
    XcdBarrier b; b.bar = bar; b.x = xb_xcc_id(); b.st = st; b.G = G;
    if (threadIdx.x == 0) (void)xb_add(&bar[XB_XCNT(b.x)], 1u);
    return b;
}
__device__ __forceinline__ void xcd_barrier_complete(unsigned* bar, unsigned x, unsigned G, unsigned& nloc, unsigned& nx) {
    unsigned sum, cnt, mine, sp = 0u;
    for (;;) {
        sum = 0u; cnt = 0u; mine = 0u;
#pragma unroll
        for (unsigned j = 0; j < 16; ++j) { const unsigned c = xb_ld(&bar[XB_XCNT(j)]); sum += c; cnt += (c > 0u) ? 1u : 0u; mine = (j == x) ? c : mine; }
        if (sum == G) break;
        __builtin_amdgcn_s_sleep(1);
        if ((++sp & 255u) == 0u) { if (xb_ld(&bar[XB_TMO])) break; if (sp > XB_SPIN_CAP) { atomicAdd(&bar[XB_TMO], 1u); break; } }
    }
    nloc = mine > 0u ? mine : 1u; nx = cnt > 0u ? cnt : 1u;
}

__device__ __forceinline__ void xcd_barrier(const XcdBarrier& b) {
    asm volatile("s_waitcnt vmcnt(0)" ::: "memory");
    __syncthreads();
    if (threadIdx.x == 0) {
        unsigned* bar = b.bar;
        __builtin_amdgcn_s_waitcnt(0);
        unsigned nloc = b.st[0], nx = b.st[1];
        if (nloc == 0u) { xcd_barrier_complete(bar, b.x, b.G, nloc, nx); b.st[0] = nloc; b.st[1] = nx; }
        const unsigned old = xb_add(&bar[XB_XSUB(b.x)], 1u);
        const unsigned gen = old / nloc;
        if (old + 1u == (gen + 1u) * nloc) {
            __builtin_amdgcn_fence(__ATOMIC_RELEASE, "agent");
            asm volatile("s_waitcnt vmcnt(0)" ::: "memory");
            const unsigned og = xb_add(&bar[XB_TOP], 1u);
            const unsigned tg = og / nx;
            if (og + 1u == (tg + 1u) * nx) xb_add(&bar[XB_TOPGEN], 1u);
            else XB_SPIN(xb_ld(&bar[XB_TOPGEN]) == tg, bar);
            __builtin_amdgcn_fence(__ATOMIC_ACQUIRE, "agent");
            xb_add(&bar[XB_XGEN(b.x)], 1u);
            asm volatile("s_waitcnt vmcnt(0)" ::: "memory");
        } else {
            XB_SPIN(xb_ld(&bar[XB_XGEN(b.x)]) == gen, bar);
            __builtin_amdgcn_fence(__ATOMIC_ACQUIRE, "agent");
            asm volatile("s_waitcnt vmcnt(0)" ::: "memory");
        }
    }
    __syncthreads();
}

struct Frame {
    LAS unsigned char* lds;
    volatile LAS unsigned* MISC;
    gu32* ctl;
    int tid, lane, wave;
    int vcu, G;
    const float* in[26]; float* out; unsigned char* ws;
};
enum { I_X = 0, I_LN0G, I_LN0B, I_WIN, I_LBL, I_HGNG, I_ARE, I_AIM, I_LSTEP, I_BRE, I_BIM, I_CRE, I_CIM, I_DSK, I_WGLU, I_BGLU, I_WOUT, I_LN1G, I_LN1B, I_WQ, I_K1, I_K2, I_PD, I_PU, I_LN2G, I_LN2B };

typedef float f32x2 __attribute__((ext_vector_type(2)));
__device__ __forceinline__ float bf2f(bf16 v) { return __builtin_bit_cast(float, (unsigned)v << 16); }
__device__ __forceinline__ float wave_sum(float v) {
#pragma unroll
    for (int o = 1; o < 64; o <<= 1) v += __shfl_xor(v, o);
    return v;
}
__device__ __forceinline__ float wave_max(float v) {
#pragma unroll
    for (int o = 1; o < 64; o <<= 1) v = fmaxf(v, __shfl_xor(v, o));
    return v;
}
__device__ __forceinline__ float gelu_tanh(float x) { const float y = 0.7978845608028654f * (x + 0.044715f * x * x * x); return x / (1.f + __expf(-2.f * y)); }
__device__ __forceinline__ float silu_f(float x) { return x / (1.f + __expf(-x)); }
__device__ __forceinline__ void unpack8(const v4u w, float (&f)[8]) {
    f[0] = __builtin_bit_cast(float, w.x << 16); f[1] = __builtin_bit_cast(float, w.x & 0xffff0000u);
    f[2] = __builtin_bit_cast(float, w.y << 16); f[3] = __builtin_bit_cast(float, w.y & 0xffff0000u);
    f[4] = __builtin_bit_cast(float, w.z << 16); f[5] = __builtin_bit_cast(float, w.z & 0xffff0000u);
    f[6] = __builtin_bit_cast(float, w.w << 16); f[7] = __builtin_bit_cast(float, w.w & 0xffff0000u);
}
__device__ __forceinline__ v4u pack8(const float (&f)[8]) { v4u w; w.x = pk2(f[0], f[1]); w.y = pk2(f[2], f[3]); w.z = pk2(f[4], f[5]); w.w = pk2(f[6], f[7]); return w; }

__device__ __forceinline__ void fast_sincos(float x, float& sn, float& cs) {
    const float k = rintf(x * 0.15915494309189535f); float r = fmaf(-k, 6.28318548202514648f, x); r = fmaf(-k, -1.74845553146e-7f, r);
    sn = __sinf(r); cs = __cosf(r);
}
__device__ __forceinline__ void p0_transpose_item(const float* W, int K, int N, bf16* WT, int row_off, LAS float* scr, int item, int lane) {
    const int nblk = N / 32, kb = item / nblk, nb = item % nblk, k0 = 64 * kb, n0 = 32 * nb;
#pragma unroll 8
    for (int i = 0; i < 32; ++i) { const int kk = 2 * i + (lane >> 5); scr[kk * 33 + (lane & 31)] = W[(size_t)(k0 + kk) * N + n0 + (lane & 31)]; }
    LDS_WAIT(); asm volatile("" ::: "memory");
    const int c = lane & 7;
#pragma unroll
    for (int j = 0; j < 4; ++j) { const int n = (lane >> 3) + 8 * j; const LAS float* s = scr + (8 * c) * 33 + n;
        v4u o; o.x = pk2(s[0 * 33], s[1 * 33]); o.y = pk2(s[2 * 33], s[3 * 33]); o.z = pk2(s[4 * 33], s[5 * 33]); o.w = pk2(s[6 * 33], s[7 * 33]);
        *(GAS v4u*)(WT + (size_t)(row_off + n0 + n) * K + k0 + 8 * c) = o; }
    LDS_WAIT(); asm volatile("" ::: "memory");
}
__device__ __forceinline__ void ln0_row(const float* xrow, const float* g, const float* b, bf16* orow, int lane) {
    const GAS f32x4* xr = (const GAS f32x4*)xrow + lane;
    f32x4 v[4]; float s = 0.f;
#pragma unroll
    for (int j = 0; j < 4; ++j) { v[j] = xr[64 * j]; s += (v[j].x + v[j].y) + (v[j].z + v[j].w); }
    const float mean = wave_sum(s) * (1.f / D); float s2 = 0.f;
#pragma unroll
    for (int j = 0; j < 4; ++j) { v[j] = v[j] - mean; s2 += (v[j].x * v[j].x + v[j].y * v[j].y) + (v[j].z * v[j].z + v[j].w * v[j].w); }
    const float rstd = 1.f / sqrtf(wave_sum(s2) * (1.f / D) + LN_EPS);
    GAS unsigned long long* o8 = (GAS unsigned long long*)orow + lane;
#pragma unroll
    for (int j = 0; j < 4; ++j) { const f32x4 gg = ((const GAS f32x4*)g)[lane + 64 * j], bb = ((const GAS f32x4*)b)[lane + 64 * j];
        const f32x4 o = v[j] * rstd * gg + bb;
        o8[64 * j] = (unsigned long long)pk2(o.x, o.y) | ((unsigned long long)pk2(o.z, o.w) << 32); }
}
__device__ __forceinline__ void p0_prologue(Frame& F) {
    LAS float* scr = (LAS float*)(F.lds + RING_OFF + F.wave * 16384);
    const int gw = F.vcu * NWAVES + F.wave, NGW = F.G * NWAVES;
    unsigned char* ws = F.ws;
    constexpr int I_IN = (D / 64) * (NPROJ / 32), I_GLU = (512 / 64) * (512 / 32), I_OUT = (1024 / 64) * (1024 / 32), I_Q = (1024 / 64) * (2048 / 32);
    constexpr int NITEMS = I_IN + I_GLU + I_OUT + I_Q;
    for (int it = gw; it < NITEMS; it += NGW) {
        int r = it;
        if (r < I_IN) { p0_transpose_item(F.in[I_WIN], D, NPROJ, (bf16*)(ws + WS_WIN), 0, scr, r, F.lane); continue; } r -= I_IN;
        if (r < I_GLU) { p0_transpose_item(F.in[I_WGLU], 512, 512, (bf16*)(ws + WS_WGLU), 0, scr, r, F.lane); continue; } r -= I_GLU;
        if (r < I_OUT) { p0_transpose_item(F.in[I_WOUT], 1024, 1024, (bf16*)(ws + WS_WOUT), 0, scr, r, F.lane); continue; } r -= I_OUT;
        p0_transpose_item(F.in[I_WQ], 1024, 2048, (bf16*)(ws + WS_WQ), 0, scr, r, F.lane);
    }
    const int gt = gw * 64 + F.lane, NGT = NGW * 64;
    for (int i = ((gt - 68608) % NGT + NGT) % NGT; i < 2 * PK * PHALF; i += NGT) { const float v = (i < PK * PHALF) ? F.in[I_K1][i] : F.in[I_K2][i - PK * PHALF]; ((bf16*)(ws + WS_KEYS))[i] = (bf16)f2bf(v); }
    for (int i = ((gt - 104448) % NGT + NGT) % NGT; i < HGW; i += NGT) { const float l0 = F.in[I_LBL][i], l1 = F.in[I_LBL][HGW + i]; ((float*)(ws + WS_LB))[i] = 1.f / (1.f + expf(l1 - l0)); }
    for (int i = ((gt - 102400) % NGT + NGT) % NGT; i < S5G * S5N; i += NGT) { const int g = i / S5N;
        const float are = F.in[I_ARE][i], aim = F.in[I_AIM][i], step = expf(F.in[I_LSTEP][g]);
        const float zr = step * are, zi = step * aim, mag = expf(zr); float cz, sz, sh, ch; fast_sincos(zi, sz, cz); fast_sincos(0.5f * zi, sh, ch);
        const float abr = mag * cz, abi = mag * sz;
        const float nre = expm1f(zr) * cz - 2.f * sh * sh, nim = abi;
        const float den = are * are + aim * aim;
        const float cre = (nre * are + nim * aim) / den, cim = (nim * are - nre * aim) / den;
        f32x4 brv[4], biv[4];
#pragma unroll
        for (int p4 = 0; p4 < 4; ++p4) { brv[p4] = *(const GAS f32x4*)(F.in[I_BRE] + (size_t)i * S5P + 4 * p4); biv[p4] = *(const GAS f32x4*)(F.in[I_BIM] + (size_t)i * S5P + 4 * p4); }
        float* t = (float*)(ws + WS_S5T) + (size_t)i * 40; *(GAS f32x2*)t = (f32x2){abr, abi};
#pragma unroll
        for (int p4 = 0; p4 < 4; ++p4) { const f32x4 br = brv[p4], bi = biv[p4];
            *(GAS f32x2*)(t + 2 + 4 * p4) = (f32x2){cre * br.x - cim * bi.x, cre * br.y - cim * bi.y}; *(GAS f32x2*)(t + 4 + 4 * p4) = (f32x2){cre * br.z - cim * bi.z, cre * br.w - cim * bi.w};
            *(GAS f32x2*)(t + 18 + 4 * p4) = (f32x2){cre * bi.x + cim * br.x, cre * bi.y + cim * br.y}; *(GAS f32x2*)(t + 20 + 4 * p4) = (f32x2){cre * bi.z + cim * br.z, cre * bi.w + cim * br.w}; } }
    for (int i = gt; i < S5G * S5N * 33; i += NGT) { const int gn = i / 33, tau = i % 33, g = gn / S5N;
        const float step = expf(F.in[I_LSTEP][g]), zr = step * F.in[I_ARE][gn] * (float)tau, zi = step * F.in[I_AIM][gn] * (float)tau, mag = expf(zr);
        float sn, cs; fast_sincos(zi, sn, cs); *(GAS f32x2*)((float*)(ws + WS_PW) + (size_t)i * 2) = (f32x2){mag * cs, mag * sn}; }
    f32x4 gg[4], bb[4];
#pragma unroll
    for (int j = 0; j < 4; ++j) { gg[j] = ((const GAS f32x4*)F.in[I_LN0G])[F.lane + 64 * j]; bb[j] = ((const GAS f32x4*)F.in[I_LN0B])[F.lane + 64 * j]; }
    f32x4 nv[4][4];
    { const int m0 = gw * 4;
#pragma unroll
      for (int r = 0; r < 4; ++r)
#pragma unroll
          for (int j = 0; j < 4; ++j) nv[r][j] = ((const GAS f32x4*)(F.in[I_X] + (size_t)(m0 + r) * D))[F.lane + 64 * j]; }
    for (int m0 = gw * 4; m0 < M; m0 += NGW * 4) {
        f32x4 v[4][4];
#pragma unroll
        for (int r = 0; r < 4; ++r)
#pragma unroll
            for (int j = 0; j < 4; ++j) v[r][j] = nv[r][j];
        if (m0 + NGW * 4 < M) {
#pragma unroll
            for (int r = 0; r < 4; ++r)
#pragma unroll
                for (int j = 0; j < 4; ++j) nv[r][j] = ((const GAS f32x4*)(F.in[I_X] + (size_t)(m0 + NGW * 4 + r) * D))[F.lane + 64 * j]; }
#pragma unroll
        for (int r = 0; r < 4; ++r) { float sm = 0.f;
#pragma unroll
            for (int j = 0; j < 4; ++j) sm += (v[r][j].x + v[r][j].y) + (v[r][j].z + v[r][j].w);
            const float mean = wave_sum(sm) * (1.f / D); float s2 = 0.f;
#pragma unroll
            for (int j = 0; j < 4; ++j) { v[r][j] = v[r][j] - mean; s2 += (v[r][j].x * v[r][j].x + v[r][j].y * v[r][j].y) + (v[r][j].z * v[r][j].z + v[r][j].w * v[r][j].w); }
            const float rstd = 1.f / sqrtf(wave_sum(s2) * (1.f / D) + LN_EPS);
            GAS unsigned long long* o8 = (GAS unsigned long long*)((bf16*)(ws + WS_H) + (size_t)(m0 + r) * D) + F.lane;
#pragma unroll
            for (int j = 0; j < 4; ++j) { const f32x4 o = v[r][j] * rstd * gg[j] + bb[j]; o8[64 * j] = (unsigned long long)pk2(o.x, o.y) | ((unsigned long long)pk2(o.z, o.w) << 32); } }
    }
}

__device__ __forceinline__ int t256(int r, int c) { return r * 256 + ((((c >> 3) ^ (r & 15))) << 4) + (c & 7) * 2; }
__device__ __forceinline__ int t128(int r, int c) { return r * 128 + ((((c >> 3) ^ (r & 7))) << 4) + (c & 7) * 2; }
typedef unsigned v2u __attribute__((ext_vector_type(2)));
__device__ __forceinline__ unsigned offb(unsigned row, unsigned ch) { return 256u * row + 16u * (ch ^ (((row & 3u) << 2) | ((row >> 2) & 3u))); }
typedef short v4i16_t __attribute__((ext_vector_type(4)));
__device__ __forceinline__ bf16x8 tr_frag16(LAS unsigned char* tile, int lane, int c, int ks) {
    const unsigned g = lane >> 4, q = (lane & 15) >> 2, p = lane & 3;
    const v4i16_t lo = __builtin_amdgcn_ds_read_tr16_b64_v4i16((LAS v4i16_t*)(tile + offb(32 * ks + 8 * g + q, 2 * c + (p >> 1)) + 8 * (p & 1)));
    const v4i16_t hi = __builtin_amdgcn_ds_read_tr16_b64_v4i16((LAS v4i16_t*)(tile + offb(32 * ks + 8 * g + 4 + q, 2 * c + (p >> 1)) + 8 * (p & 1)));
    bf16x8 r; r[0] = lo[0]; r[1] = lo[1]; r[2] = lo[2]; r[3] = lo[3]; r[4] = hi[0]; r[5] = hi[1]; r[6] = hi[2]; r[7] = hi[3]; return r;
}
__device__ __forceinline__ void hgrn2_state_pass(Frame& F, int item) {
    const int bh = item >> 2, ksl = item & 3, b = bh >> 2, h = bh & 3, tid = F.tid, lane = F.lane, w = F.wave, fr = lane & 15, fq = lane >> 4;
    const int kcol = tid & 31, sg = tid >> 5;
    LAS unsigned char* L = F.lds + RING_OFF;
    LAS unsigned char* sRaw = L + 49152;
    const bf16* LFg = (const bf16*)(F.ws + WS_PROJ) + (size_t)M * 512 + (size_t)b * SEQ * 512 + h * 128 + ksl * 32;
    const bf16* Vg = (const bf16*)(F.ws + WS_PROJ) + (size_t)2 * M * 512 + (size_t)b * SEQ * 512 + h * 128;
    bf16* SST = (bf16*)(F.ws + WS_SST) + (size_t)bh * 64 * 128 * 128 + ksl * 32;
    float S[2][4];
#pragma unroll
    for (int i = 0; i < 2; ++i)
#pragma unroll
        for (int r = 0; r < 4; ++r) S[i][r] = 0.f;
    const int ls = (tid & 255) >> 2, lkg = tid & 3;
    const int vs0 = tid >> 4, vch = tid & 15;
    v4u nlf = *(const GAS v4u*)(LFg + (size_t)ls * 512 + lkg * 8);
    v4u nv0 = *(const GAS v4u*)(Vg + (size_t)vs0 * 512 + vch * 8), nv1 = *(const GAS v4u*)(Vg + (size_t)(32 + vs0) * 512 + vch * 8);
    v4u n2lf = *(const GAS v4u*)(LFg + (size_t)(64 + ls) * 512 + lkg * 8);
    v4u n2v0 = *(const GAS v4u*)(Vg + (size_t)(64 + vs0) * 512 + vch * 8), n2v1 = *(const GAS v4u*)(Vg + (size_t)(96 + vs0) * 512 + vch * 8);
    v4u n3lf = *(const GAS v4u*)(LFg + (size_t)(128 + ls) * 512 + lkg * 8);
    v4u n3v0 = *(const GAS v4u*)(Vg + (size_t)(128 + vs0) * 512 + vch * 8), n3v1 = *(const GAS v4u*)(Vg + (size_t)(160 + vs0) * 512 + vch * 8);
    for (int c = 0; c < 64; ++c) {
        LAS unsigned char* Lb = L + (c & 1) * 24576;
        LAS unsigned char* sKT = Lb; LAS unsigned char* sVT = Lb + 4096; LAS float* sTot = (LAS float*)(Lb + 20480); LAS float* sDec = (LAS float*)(Lb + 22528);
        if (tid < 256) *(LAS v4u*)(sRaw + ls * 64 + lkg * 16) = nlf;
        *(LAS v4u*)(sVT + offb(vs0, vch)) = nv0; *(LAS v4u*)(sVT + offb(32 + vs0, vch)) = nv1;
        nlf = n2lf; nv0 = n2v0; nv1 = n2v1; n2lf = n3lf; n2v0 = n3v0; n2v1 = n3v1;
        if (c + 3 < 64) { const size_t t3 = (size_t)(c + 3) * 64;
            n3lf = *(const GAS v4u*)(LFg + (t3 + ls) * 512 + lkg * 8); n3v0 = *(const GAS v4u*)(Vg + (t3 + vs0) * 512 + vch * 8); n3v1 = *(const GAS v4u*)(Vg + (t3 + 32 + vs0) * 512 + vch * 8); }
        __syncthreads();
        float lf[4];
#pragma unroll
        for (int j = 0; j < 4; ++j) lf[j] = bf2f(*(const LAS bf16*)(sRaw + (sg * 4 + j) * 64 + kcol * 2));
        float cl[4]; float run = 0.f;
#pragma unroll
        for (int j = 0; j < 4; ++j) { run += lf[j]; cl[j] = run; }
        sTot[sg * 32 + kcol] = run;
        __syncthreads();
        float off = 0.f, last = 0.f;
#pragma unroll
        for (int q = 0; q < 16; ++q) { const float tq = sTot[q * 32 + kcol]; off += (q < sg) ? tq : 0.f; last += tq; }
        float kh[4];
#pragma unroll
        for (int j = 0; j < 4; ++j) kh[j] = (1.f - __expf(lf[j])) * __expf(last - (off + cl[j]));
        { v2u pk; pk.x = pk2(kh[0], kh[1]); pk.y = pk2(kh[2], kh[3]);
          *(LAS v2u*)(sKT + kcol * 128 + ((((sg >> 1) ^ (kcol & 7))) << 4) + (sg & 1) * 8) = pk; }
        if (sg == 0) sDec[kcol] = __expf(last);
        __syncthreads();
        f32x4 acc[2] = {(f32x4){0.f, 0.f, 0.f, 0.f}, (f32x4){0.f, 0.f, 0.f, 0.f}};
        const int mt = w & 1, nt0 = (w >> 1) * 2;
#pragma unroll
        for (int ks = 0; ks < 2; ++ks) { const int ch = ks * 4 + fq, row = 16 * mt + fr;
            const bf16x8 af = *(const LAS bf16x8*)(sKT + row * 128 + ((ch ^ (row & 7)) << 4));
#pragma unroll
            for (int nt = 0; nt < 2; ++nt) { const bf16x8 bfm = tr_frag16(sVT, lane, nt0 + nt, ks);
                acc[nt] = __builtin_amdgcn_mfma_f32_16x16x32_bf16(af, bfm, acc[nt], 0, 0, 0); } }
        const int k0 = 16 * mt + fq * 4; const f32x4 dec = *(const LAS f32x4*)(sDec + k0);
#pragma unroll
        for (int nt = 0; nt < 2; ++nt) { const int vg = 16 * (nt0 + nt) + fr;
            v2u o; o.x = pk2(S[nt][0], S[nt][1]); o.y = pk2(S[nt][2], S[nt][3]);
            *(GAS v2u*)(SST + ((size_t)c * 128 + vg) * 128 + k0) = o;
            S[nt][0] = dec[0] * S[nt][0] + acc[nt][0]; S[nt][1] = dec[1] * S[nt][1] + acc[nt][1]; S[nt][2] = dec[2] * S[nt][2] + acc[nt][2]; S[nt][3] = dec[3] * S[nt][3] + acc[nt][3]; }
    }
    __syncthreads();
}
struct HgOutRegs { v4u lf[2], q[2], v[2], st[4]; };
__device__ __forceinline__ void hgrn2_out_load(Frame& F, int item, HgOutRegs& R) {
    const int bh = item >> 6, c = item & 63, b = bh >> 2, h = bh & 3, tid = F.tid;
    const size_t tok0 = (size_t)b * SEQ + (size_t)c * 64;
    const bf16* Qb = (const bf16*)(F.ws + WS_PROJ) + tok0 * 512 + h * 128; const bf16* LFb = Qb + (size_t)M * 512; const bf16* Vb = Qb + (size_t)2 * M * 512;
    const bf16* SST = (const bf16*)(F.ws + WS_SST) + (size_t)item * 128 * 128;
#pragma unroll
    for (int i = 0; i < 2; ++i) { const int idx = tid + 512 * i, sr = idx >> 4, ch = idx & 15;
        R.lf[i] = *(const GAS v4u*)(LFb + (size_t)sr * 512 + ch * 8); R.q[i] = *(const GAS v4u*)(Qb + (size_t)sr * 512 + ch * 8); R.v[i] = *(const GAS v4u*)(Vb + (size_t)sr * 512 + ch * 8); }
#pragma unroll
    for (int i = 0; i < 4; ++i) { const int idx = tid + 512 * i; R.st[i] = *(const GAS v4u*)(SST + (size_t)(idx >> 4) * 128 + (idx & 15) * 8); }
}
__device__ __forceinline__ void hgrn2_out_phase(Frame& F) {
    const int tid = F.tid, lane = F.lane, w = F.wave, fr = lane & 15, fq = lane >> 4;
    const int kcol = tid & 127, qtr = tid >> 7;
    LAS unsigned char* L = F.lds + RING_OFF;
    LAS unsigned char* sQt = L; LAS unsigned char* sQm = L + 16384; LAS unsigned char* sKm = L + 32768; LAS unsigned char* sV = L + 49152; LAS unsigned char* sST = L + 65536; LAS unsigned char* sP = L + 98304;
    LAS float* sTot = (LAS float*)(L + 106496); LAS float* sSS = (LAS float*)(L + 108544);
    LAS unsigned char* rLF = L + 110592; LAS unsigned char* rQ = L + 126976;
    HgOutRegs R;
    int item = F.vcu;
    if (item < 32 * 64) hgrn2_out_load(F, item, R);
    for (; item < 32 * 64; item += F.G) {
        const int bh = item >> 6, c = item & 63, b = bh >> 2, h = bh & 3;
        const size_t tok0 = (size_t)b * SEQ + (size_t)c * 64;
        const bf16* Gb = (const bf16*)(F.ws + WS_PROJ) + (size_t)3 * M * 512 + tok0 * 512 + h * 128;
        bf16* MIX = (bf16*)(F.ws + WS_MIX) + tok0 * 1024 + h * 128;
#pragma unroll
        for (int i = 0; i < 2; ++i) { const int idx = tid + 512 * i, sr = idx >> 4, ch = idx & 15;
            *(LAS v4u*)(rLF + sr * 256 + ch * 16) = R.lf[i]; *(LAS v4u*)(rQ + sr * 256 + ch * 16) = R.q[i]; *(LAS v4u*)(sV + offb(sr, ch)) = R.v[i]; }
#pragma unroll
        for (int i = 0; i < 4; ++i) { const int idx = tid + 512 * i, v = idx >> 4, kc = idx & 15; *(LAS v4u*)(sST + v * 256 + ((kc ^ (v & 15)) << 4)) = R.st[i]; }
        if (item + F.G < 32 * 64) hgrn2_out_load(F, item + F.G, R);
        __syncthreads();
        float lf[16], q[16];
#pragma unroll
        for (int j = 0; j < 16; ++j) { lf[j] = bf2f(*(const LAS bf16*)(rLF + (qtr * 16 + j) * 256 + kcol * 2)); q[j] = bf2f(*(const LAS bf16*)(rQ + (qtr * 16 + j) * 256 + kcol * 2)); }
        float cl[16]; float run = 0.f;
#pragma unroll
        for (int j = 0; j < 16; ++j) { run += lf[j]; cl[j] = run; }
        sTot[qtr * 128 + kcol] = run;
        __syncthreads();
        { const float t0 = sTot[kcol], t1 = sTot[128 + kcol], t2 = sTot[256 + kcol];
          const float off = (qtr > 0 ? t0 : 0.f) + (qtr > 1 ? t1 : 0.f) + (qtr > 2 ? t2 : 0.f), mid = t0 + t1;
#pragma unroll
          for (int j = 0; j < 16; ++j) { const int sdx = qtr * 16 + j; const float cum = off + cl[j];
              const int o = t256(sdx, kcol);
              *(LAS bf16*)(sQt + o) = (bf16)f2bf(q[j] * __expf(cum));
              *(LAS bf16*)(sQm + o) = (bf16)f2bf(q[j] * __expf(cum - mid));
              *(LAS bf16*)(sKm + o) = (bf16)f2bf((1.f - __expf(lf[j])) * __expf(mid - cum)); } }
        __syncthreads();
        const int tt = w >> 1, trow = 16 * tt + fr;
#pragma unroll
        for (int sti = 0; sti < 2; ++sti) { const int stl = (w & 1) * 2 + sti; f32x4 acc = (f32x4){0.f, 0.f, 0.f, 0.f};
            if (stl <= tt) {
#pragma unroll
                for (int ks = 0; ks < 4; ++ks) { const int ch = ks * 4 + fq, srow = 16 * stl + fr;
                    const bf16x8 af = *(const LAS bf16x8*)(sKm + srow * 256 + ((ch ^ (srow & 15)) << 4));
                    const bf16x8 bfm = *(const LAS bf16x8*)(sQm + trow * 256 + ((ch ^ (trow & 15)) << 4));
                    acc = __builtin_amdgcn_mfma_f32_16x16x32_bf16(af, bfm, acc, 0, 0, 0); } }
            const int s0 = 16 * stl + fq * 4;
            const float p0 = (s0 + 0 <= trow) ? acc[0] : 0.f, p1 = (s0 + 1 <= trow) ? acc[1] : 0.f, p2 = (s0 + 2 <= trow) ? acc[2] : 0.f, p3 = (s0 + 3 <= trow) ? acc[3] : 0.f;
            v2u o; o.x = pk2(p0, p1); o.y = pk2(p2, p3);
            *(LAS v2u*)(sP + trow * 128 + ((((s0 >> 3) ^ (trow & 7))) << 4) + (s0 & 7) * 2) = o; }
        __syncthreads();
        f32x4 oacc[4];
#pragma unroll
        for (int i = 0; i < 4; ++i) oacc[i] = (f32x4){0.f, 0.f, 0.f, 0.f};
#pragma unroll
        for (int ks = 0; ks < 4; ++ks) { const int ch = ks * 4 + fq;
            const bf16x8 bfm = *(const LAS bf16x8*)(sQt + trow * 256 + ((ch ^ (trow & 15)) << 4));
#pragma unroll
            for (int i = 0; i < 4; ++i) { const int vr = 16 * ((w & 1) * 4 + i) + fr; const bf16x8 af = *(const LAS bf16x8*)(sST + vr * 256 + ((ch ^ (vr & 15)) << 4));
                oacc[i] = __builtin_amdgcn_mfma_f32_16x16x32_bf16(af, bfm, oacc[i], 0, 0, 0); } }
#pragma unroll
        for (int ks = 0; ks < 2; ++ks) { const int ch = ks * 4 + fq;
            const bf16x8 bfm = *(const LAS bf16x8*)(sP + trow * 128 + ((ch ^ (trow & 7)) << 4));
#pragma unroll
            for (int i = 0; i < 4; ++i) { const bf16x8 af = tr_frag16(sV, lane, (w & 1) * 4 + i, ks);
                oacc[i] = __builtin_amdgcn_mfma_f32_16x16x32_bf16(af, bfm, oacc[i], 0, 0, 0); } }
        float ss = 0.f;
#pragma unroll
        for (int i = 0; i < 4; ++i) ss += (oacc[i][0] * oacc[i][0] + oacc[i][1] * oacc[i][1]) + (oacc[i][2] * oacc[i][2] + oacc[i][3] * oacc[i][3]);
        ss += __shfl_xor(ss, 16); ss += __shfl_xor(ss, 32);
        if (fq == 0) sSS[(w & 1) * 64 + trow] = ss;
        __syncthreads();
        const float rinv = 1.f / sqrtf((sSS[trow] + sSS[64 + trow]) * (1.f / 128.f) + RMS_EPS);
#pragma unroll
        for (int i = 0; i < 4; ++i) { const int v0 = 16 * ((w & 1) * 4 + i) + fq * 4;
            const v2u gw2 = *(const GAS v2u*)(Gb + (size_t)trow * 512 + v0); const f32x4 ng = *(const GAS f32x4*)(F.in[I_HGNG] + v0);
            const float g0 = __builtin_bit_cast(float, gw2.x << 16), g1 = __builtin_bit_cast(float, gw2.x & 0xffff0000u), g2 = __builtin_bit_cast(float, gw2.y << 16), g3 = __builtin_bit_cast(float, gw2.y & 0xffff0000u);
            v2u o; o.x = pk2(oacc[i][0] * rinv * ng[0] * silu_f(g0), oacc[i][1] * rinv * ng[1] * silu_f(g1)); o.y = pk2(oacc[i][2] * rinv * ng[2] * silu_f(g2), oacc[i][3] * rinv * ng[3] * silu_f(g3));
            *(GAS v2u*)(MIX + (size_t)trow * 1024 + v0) = o; }
        __syncthreads();
    }
}

__device__ __forceinline__ void s5_tables_stage1(Frame& F) {
    const int gt = (F.vcu * NWAVES + F.wave) * 64 + F.lane, NGT = F.G * NWAVES * 64;
    const float* S5T = (const float*)(F.ws + WS_S5T); const float* PW = (const float*)(F.ws + WS_PW);
    float* KT = (float*)(F.ws + WS_KTAU); bf16* G5 = (bf16*)(F.ws + WS_G5); bf16* T5 = (bf16*)(F.ws + WS_T5);
    for (int i = gt; i < S5G * 32 * 256; i += NGT) { const int g = i >> 13, tau = (i >> 8) & 31, p = (i >> 4) & 15, q = i & 15;
        float acc = (tau == 0 && p == q) ? F.in[I_DSK][g * 16 + p] : 0.f;
#pragma unroll 16
        for (int n = 0; n < S5N; ++n) { const int gn = g * S5N + n;
            const float cr = F.in[I_CRE][(size_t)(g * 16 + p) * S5N + n], ci = F.in[I_CIM][(size_t)(g * 16 + p) * S5N + n];
            const float wr = PW[((size_t)gn * 33 + tau) * 2], wi = PW[((size_t)gn * 33 + tau) * 2 + 1];
            const float br = S5T[(size_t)gn * 40 + 2 + q], bi = S5T[(size_t)gn * 40 + 18 + q];
            const float er = cr * wr - ci * wi, ei = cr * wi + ci * wr;
            acc += er * br - ei * bi; }
        KT[i] = acc; }
    for (int i = gt; i < S5G * 256 * 64; i += NGT) { const int g = i >> 14, r = (i >> 6) & 255, kc = i & 63, sdx = kc >> 1, q0 = (kc & 1) * 8;
        float f[8];
        if (r < 128) { const int n = r & 63, gn = g * S5N + n; const float wr = PW[((size_t)gn * 33 + (31 - sdx)) * 2], wi = PW[((size_t)gn * 33 + (31 - sdx)) * 2 + 1];
#pragma unroll
            for (int j = 0; j < 8; ++j) { const float br = S5T[(size_t)gn * 40 + 2 + q0 + j], bi = S5T[(size_t)gn * 40 + 18 + q0 + j]; f[j] = (r < 64) ? (wr * br - wi * bi) : (wr * bi + wi * br); }
        } else {
#pragma unroll
            for (int j = 0; j < 8; ++j) f[j] = 0.f; }
        *(GAS v4u*)(G5 + ((size_t)(g * 256 + r)) * 512 + kc * 8) = pack8(f); }
    for (int i = gt; i < S5G * 512 * 16; i += NGT) { const int g = i >> 13, row = (i >> 4) & 511, nc = i & 15, t = row >> 4, p = row & 15, im = nc >> 3, n0 = (nc & 7) * 8;
        float f[8];
#pragma unroll
        for (int j = 0; j < 8; ++j) { const int n = n0 + j, gn = g * S5N + n;
            const float cr = F.in[I_CRE][(size_t)(g * 16 + p) * S5N + n], ci = F.in[I_CIM][(size_t)(g * 16 + p) * S5N + n];
            const float wr = PW[((size_t)gn * 33 + t + 1) * 2], wi = PW[((size_t)gn * 33 + t + 1) * 2 + 1];
            f[j] = im ? -(cr * wi + ci * wr) : (cr * wr - ci * wi); }
        *(GAS v4u*)(T5 + ((size_t)(g * 512 + row)) * 640 + 512 + nc * 8) = pack8(f); }
}
__device__ __forceinline__ void s5_tables_stage2(Frame& F) {
    const int gt = (F.vcu * NWAVES + F.wave) * 64 + F.lane, NGT = F.G * NWAVES * 64;
    const float* KT = (const float*)(F.ws + WS_KTAU); bf16* T5 = (bf16*)(F.ws + WS_T5);
    for (int i = gt; i < S5G * 512 * 64; i += NGT) { const int g = i >> 15, row = (i >> 6) & 511, kc = i & 63, t = row >> 4, p = row & 15, sdx = kc >> 1, q0 = (kc & 1) * 8;
        float f[8];
        if (sdx <= t) { const float* k = KT + (((size_t)g * 32 + (t - sdx)) * 16 + p) * 16 + q0;
#pragma unroll
            for (int j = 0; j < 8; ++j) f[j] = k[j];
        } else {
#pragma unroll
            for (int j = 0; j < 8; ++j) f[j] = 0.f; }
        *(GAS v4u*)(T5 + ((size_t)(g * 512 + row)) * 640 + kc * 8) = pack8(f); }
}
__device__ __forceinline__ void s5_scan(Frame& F, int idx) {
    const int b = idx >> 11, g = (idx >> 6) & 31, n = idx & 63;
    const float* PW = (const float*)(F.ws + WS_PW); const float* XL = (const float*)(F.ws + WS_XLOC); bf16* A5 = (bf16*)(F.ws + WS_A5);
    const float ar = PW[((size_t)(g * S5N + n) * 33 + 32) * 2], ai = PW[((size_t)(g * S5N + n) * 33 + 32) * 2 + 1];
    float xr = 0.f, xi = 0.f;
    for (int c0 = 0; c0 < 128; c0 += 32) {
        float lr[32], li[32];
#pragma unroll
        for (int j = 0; j < 32; ++j) { const float* p = XL + ((size_t)(b * 128 + c0 + j) * 32 + g) * 128 + n; lr[j] = p[0]; li[j] = p[64]; }
#pragma unroll
        for (int j = 0; j < 32; ++j) { bf16* o = A5 + ((size_t)g * S5I + b * 128 + c0 + j) * 640 + 512 + n; o[0] = (bf16)f2bf(xr); o[64] = (bf16)f2bf(xi);
            const float nr = ar * xr - ai * xi + lr[j], ni = ar * xi + ai * xr + li[j]; xr = nr; xi = ni; }
    }
}

__device__ __forceinline__ void ln1_row(bf16* row, const float* g, const float* b, int lane) {
    const v4u w0 = *(const GAS v4u*)(row + lane * 8), w1 = *(const GAS v4u*)(row + 512 + lane * 8);
    float a[8], c[8]; unpack8(w0, a); unpack8(w1, c);
    float s = 0.f;
#pragma unroll
    for (int j = 0; j < 8; ++j) s += a[j] + c[j];
    const float mean = wave_sum(s) * (1.f / D); float s2 = 0.f;
#pragma unroll
    for (int j = 0; j < 8; ++j) { a[j] -= mean; c[j] -= mean; s2 += a[j] * a[j] + c[j] * c[j]; }
    const float rstd = 1.f / sqrtf(wave_sum(s2) * (1.f / D) + LN_EPS);
    const f32x4 g0 = *(const GAS f32x4*)(g + lane * 8), g1 = *(const GAS f32x4*)(g + lane * 8 + 4), g2 = *(const GAS f32x4*)(g + 512 + lane * 8), g3 = *(const GAS f32x4*)(g + 512 + lane * 8 + 4);
    const f32x4 b0 = *(const GAS f32x4*)(b + lane * 8), b1 = *(const GAS f32x4*)(b + lane * 8 + 4), b2 = *(const GAS f32x4*)(b + 512 + lane * 8), b3 = *(const GAS f32x4*)(b + 512 + lane * 8 + 4);
    const float gg0[8] = {g0.x, g0.y, g0.z, g0.w, g1.x, g1.y, g1.z, g1.w}, gg1[8] = {g2.x, g2.y, g2.z, g2.w, g3.x, g3.y, g3.z, g3.w};
    const float bb0[8] = {b0.x, b0.y, b0.z, b0.w, b1.x, b1.y, b1.z, b1.w}, bb1[8] = {b2.x, b2.y, b2.z, b2.w, b3.x, b3.y, b3.z, b3.w};
#pragma unroll
    for (int j = 0; j < 8; ++j) { a[j] = a[j] * rstd * gg0[j] + bb0[j]; c[j] = c[j] * rstd * gg1[j] + bb1[j]; }
    *(GAS v4u*)(row + lane * 8) = pack8(a); *(GAS v4u*)(row + 512 + lane * 8) = pack8(c);
}

typedef float f32x16 __attribute__((ext_vector_type(16)));
__device__ __forceinline__ int f2ord(float f) { const int x = __builtin_bit_cast(int, f); return x ^ ((x >> 31) & 0x7fffffff); }
__device__ __forceinline__ float ord2f(int x) { return __builtin_bit_cast(float, x ^ ((x >> 31) & 0x7fffffff)); }
#define CE_DESC(a, b) do { const int _h = max((a), (b)), _l = min((a), (b)); (a) = _h; (b) = _l; } while (0)
__device__ __forceinline__ void sort16_desc(int (&v)[16]) {
#pragma unroll
    for (int k = 2; k <= 16; k <<= 1)
#pragma unroll
        for (int j = k >> 1; j > 0; j >>= 1)
#pragma unroll
            for (int i = 0; i < 16; ++i) { const int l = i ^ j; if (l > i) { if ((i & k) == 0) CE_DESC(v[i], v[l]); else CE_DESC(v[l], v[i]); } }
}
__device__ __forceinline__ void merge16_desc(int (&a)[16], const int (&b)[16]) {
#pragma unroll
    for (int i = 0; i < 16; ++i) a[i] = max(a[i], b[15 - i]);
#pragma unroll
    for (int j = 8; j > 0; j >>= 1)
#pragma unroll
        for (int i = 0; i < 16; ++i) { const int l = i ^ j; if (l > i) CE_DESC(a[i], a[l]); }
}
__device__ __forceinline__ void peer_topk_side(const f32x16 (&acc)[4], int hi, int (&top)[16]) {
    int t[4][16];
#pragma unroll
    for (int kt = 0; kt < 4; ++kt)
#pragma unroll
        for (int j = 0; j < 16; ++j) { const unsigned key = (unsigned)(kt * 32 + (j & 3) + 8 * (j >> 2)) | (unsigned)(4 * hi);
            const float av = acc[kt][j];
            t[kt][j] = f2ord(__builtin_bit_cast(float, (__builtin_bit_cast(unsigned, av) & 0xFFFFFF80u) | key)); }
    sort16_desc(t[0]); sort16_desc(t[1]); sort16_desc(t[2]); sort16_desc(t[3]);
    merge16_desc(t[0], t[1]); merge16_desc(t[2], t[3]); merge16_desc(t[0], t[2]);
    int p[16];
#pragma unroll
    for (int i = 0; i < 16; ++i) p[i] = __shfl_xor(t[0][i], 32);
    merge16_desc(t[0], p);
#pragma unroll
    for (int i = 0; i < 16; ++i) top[i] = t[0][i];
}
__device__ __forceinline__ void peer_score_phase(Frame& F, const pg8::StaticOrder& SO) {
    LAS unsigned char* kl = F.lds + RING_OFF;
    LAS unsigned* look = (LAS unsigned*)(F.lds + RING_OFF + 65536 + F.wave * 8192);
    const bf16* keys = (const bf16*)(F.ws + WS_KEYS);
    for (int i = F.tid; i < 2 * 128 * 16; i += NWAVES * 64) { const int sn = i >> 4, c = i & 15, n = sn & 127;
        *(LAS v4u*)(kl + sn * 256 + ((c ^ (n & 15)) << 4)) = *(const GAS v4u*)(keys + (size_t)sn * 128 + c * 8); }
    __syncthreads();
    const int lane = F.lane, r32 = lane & 31, hi = lane >> 5;
    const bf16* Q2 = (const bf16*)(F.ws + WS_Q2);
    int* EIDX = (int*)(F.ws + WS_EIDX); float* EGATE = (float*)(F.ws + WS_EGATE);
    for (int ui = 0;; ++ui) { pg8::Unit gu; if (!SO.next(ui, gu)) break;
        const int blk = gu.pm * 8 + F.wave, h = gu.pn; const size_t tok = (size_t)blk * 32 + r32;
        const bf16* qrow = Q2 + tok * NQ2 + h * PQ + hi * 8;
        int top1[16], top2[16];
        bf16x8 qfs[2][8];
#pragma unroll
        for (int s = 0; s < 2; ++s)
#pragma unroll
            for (int ks = 0; ks < 8; ++ks) qfs[s][ks] = *(const GAS bf16x8*)(qrow + s * 128 + ks * 16);
#pragma unroll
        for (int s = 0; s < 2; ++s) {
            f32x16 acc[4];
#pragma unroll
            for (int kt = 0; kt < 4; ++kt) { acc[kt] = (f32x16){0.f, 0.f, 0.f, 0.f, 0.f, 0.f, 0.f, 0.f, 0.f, 0.f, 0.f, 0.f, 0.f, 0.f, 0.f, 0.f};
                const int n = kt * 32 + r32;
#pragma unroll
                for (int ks = 0; ks < 8; ++ks) { const bf16x8 kf = *(const LAS bf16x8*)(kl + (s * 128 + n) * 256 + (((2 * ks + hi) ^ (n & 15)) << 4));
                    acc[kt] = __builtin_amdgcn_mfma_f32_32x32x16_bf16(kf, qfs[s][ks], acc[kt], 0, 0, 0); } }
            if (s == 0) peer_topk_side(acc, hi, top1); else peer_topk_side(acc, hi, top2);
        }
        float v1[16], v2[16];
#pragma unroll
        for (int i = 0; i < 16; ++i) { v1[i] = ord2f(top1[i]); v2[i] = ord2f(top2[i]);
            look[i * 64 + lane] = __builtin_bit_cast(unsigned, v1[i]) & 0x7Fu; look[(16 + i) * 64 + lane] = __builtin_bit_cast(unsigned, v2[i]) & 0x7Fu; }
        int c[4][16]; int nc = 0;
#pragma unroll
        for (int i = 0; i < 16; ++i)
#pragma unroll
            for (int j = 0; j < 16; ++j) if ((i + 1) * (j + 1) <= 16) { const float sum = v1[i] + v2[j];
                c[nc >> 4][nc & 15] = f2ord(__builtin_bit_cast(float, (__builtin_bit_cast(unsigned, sum) & 0xFFFFFF00u) | (unsigned)(i * 16 + j))); ++nc; }
#pragma unroll
        for (int q = 50; q < 64; ++q) c[q >> 4][q & 15] = (int)0x80000000;
        sort16_desc(c[0]); sort16_desc(c[1]); sort16_desc(c[2]); sort16_desc(c[3]);
        merge16_desc(c[0], c[1]); merge16_desc(c[2], c[3]); merge16_desc(c[0], c[2]);
        float e[16], sum = 0.f;
        float cf[16];
#pragma unroll
        for (int k = 0; k < 16; ++k) cf[k] = ord2f(c[0][k]);
#pragma unroll
        for (int k = 0; k < 16; ++k) { e[k] = __expf(cf[k] - cf[0]); sum += e[k]; }
        const float inv = 1.f / sum;
        LDS_WAIT();
        int ex[8]; float gt[8];
#pragma unroll
        for (int k = 0; k < 8; ++k) { const float cv = hi ? cf[8 + k] : cf[k]; gt[k] = (hi ? e[8 + k] : e[k]) * inv;
            const unsigned pos = __builtin_bit_cast(unsigned, cv) & 0xFFu;
            ex[k] = (int)(look[(pos >> 4) * 64 + lane] * PK + look[(16 + (pos & 15)) * 64 + lane]); }
        int* eo = EIDX + (tok * PH + h) * 16 + hi * 8; float* go = EGATE + (tok * PH + h) * 16 + hi * 8;
        *(GAS v4u*)eo = (v4u){(unsigned)ex[0], (unsigned)ex[1], (unsigned)ex[2], (unsigned)ex[3]}; *(GAS v4u*)(eo + 4) = (v4u){(unsigned)ex[4], (unsigned)ex[5], (unsigned)ex[6], (unsigned)ex[7]};
        *(GAS f32x4*)go = (f32x4){gt[0], gt[1], gt[2], gt[3]}; *(GAS f32x4*)(go + 4) = (f32x4){gt[4], gt[5], gt[6], gt[7]};
        LDS_WAIT();
    }
}

constexpr float PD_SCALE = 256.f, PU_SCALE = 32.f;
__device__ __forceinline__ void unpack_fp8x16(const v4u w, float (&f)[16]) {
    const unsigned ww[4] = {w.x, w.y, w.z, w.w};
#pragma unroll
    for (int i = 0; i < 4; ++i) { const f32x2 lo = __builtin_amdgcn_cvt_pk_f32_fp8((int)ww[i], false), hi = __builtin_amdgcn_cvt_pk_f32_fp8((int)ww[i], true);
        f[4 * i] = lo[0]; f[4 * i + 1] = lo[1]; f[4 * i + 2] = hi[0]; f[4 * i + 3] = hi[1]; }
}
__device__ __forceinline__ void peer_sort_experts(int& e0, int& e1, float& g0, float& g1, int lane) {
    int k0 = e0 * 128 + lane, k1 = e1 * 128 + 64 + lane;
#pragma unroll
    for (int k = 2; k <= 128; k <<= 1)
#pragma unroll
        for (int j = k >> 1; j > 0; j >>= 1) {
            if (j == 64) { const int lo = min(k0, k1), hi = max(k0, k1); k0 = lo; k1 = hi; }
            else { const int p0 = __shfl_xor(k0, j), p1 = __shfl_xor(k1, j); const bool lower = (lane & j) == 0;
                const bool asc0 = (lane & k) == 0, asc1 = ((64 + lane) & k) == 0;
                k0 = (lower == asc0) ? min(k0, p0) : max(k0, p0); k1 = (lower == asc1) ? min(k1, p1) : max(k1, p1); }
        }
    const int s0 = k0 & 127, s1 = k1 & 127;
    const float a0 = __shfl(g0, s0 & 63), b0 = __shfl(g1, s0 & 63), a1 = __shfl(g0, s1 & 63), b1 = __shfl(g1, s1 & 63);
    g0 = (s0 < 64) ? a0 : b0; g1 = (s1 < 64) ? a1 : b1; e0 = k0 >> 7; e1 = k1 >> 7;
}
typedef long i64_t;
__device__ __forceinline__ void peer_gather_phase(Frame& F) {
    const int gw = F.vcu * NWAVES + F.wave, NGW = F.G * NWAVES, lane = F.lane;
    const bf16* H1 = (const bf16*)(F.ws + WS_H); const unsigned char* PD = F.ws + WS_PD; const unsigned char* PU = F.ws + WS_PU;
    const int* EIDX = (const int*)(F.ws + WS_EIDX); const float* EGATE = (const float*)(F.ws + WS_EGATE);
    const int rep = ((lane >> 5) & 1) * 4 + ((lane >> 4) & 1) * 2 + ((lane >> 3) & 1);
    const bool diag = ((lane & 15) >> 2) == (lane >> 4); const int dr = lane & 3;
    const float m0 = (diag && dr == 0) ? 1.f : 0.f, m1 = (diag && dr == 1) ? 1.f : 0.f, m2 = (diag && dr == 2) ? 1.f : 0.f, m3 = (diag && dr == 3) ? 1.f : 0.f;
    constexpr int GT = 4; constexpr float XS = 16.f, AS = 32.f;
    const int si = lane & 15, sq = lane >> 4;
    const unsigned sb = 0xFFu << (8 * (si & 3));
    const unsigned m0lo = (sq == (si >> 3) && (si & 7) < 4) ? sb : 0u, m0hi = (sq == (si >> 3) && (si & 7) >= 4) ? sb : 0u;
    const unsigned m1lo = (sq == 2 + (si >> 3) && (si & 7) < 4) ? sb : 0u, m1hi = (sq == 2 + (si >> 3) && (si & 7) >= 4) ? sb : 0u;
    for (int pr = gw; pr < M / GT; pr += NGW) {
        __syncthreads();
        const size_t tokA = (size_t)pr * GT;
        int e0[GT], e1[GT]; float g0[GT], g1[GT]; f32x4 os[GT][4]; i64_t xb0[GT], xb1[GT];
#pragma unroll
        for (int t = 0; t < GT; ++t) { float a[8], c[8]; unpack8(*(const GAS v4u*)(H1 + (tokA + t) * D + lane * 16), a); unpack8(*(const GAS v4u*)(H1 + (tokA + t) * D + lane * 16 + 8), c);
            unsigned q0, q1, q2, q3; int pk;
            pk = __builtin_amdgcn_cvt_pk_fp8_f32(a[0] * XS, a[1] * XS, 0, false); pk = __builtin_amdgcn_cvt_pk_fp8_f32(a[2] * XS, a[3] * XS, pk, true); q0 = (unsigned)pk;
            pk = __builtin_amdgcn_cvt_pk_fp8_f32(a[4] * XS, a[5] * XS, 0, false); pk = __builtin_amdgcn_cvt_pk_fp8_f32(a[6] * XS, a[7] * XS, pk, true); q1 = (unsigned)pk;
            pk = __builtin_amdgcn_cvt_pk_fp8_f32(c[0] * XS, c[1] * XS, 0, false); pk = __builtin_amdgcn_cvt_pk_fp8_f32(c[2] * XS, c[3] * XS, pk, true); q2 = (unsigned)pk;
            pk = __builtin_amdgcn_cvt_pk_fp8_f32(c[4] * XS, c[5] * XS, 0, false); pk = __builtin_amdgcn_cvt_pk_fp8_f32(c[6] * XS, c[7] * XS, pk, true); q3 = (unsigned)pk;
            xb0[t] = (i64_t)(((unsigned long long)q1 << 32) | q0); xb1[t] = (i64_t)(((unsigned long long)q3 << 32) | q2);
            e0[t] = EIDX[(tokA + t) * 128 + lane]; e1[t] = EIDX[(tokA + t) * 128 + 64 + lane]; g0[t] = EGATE[(tokA + t) * 128 + lane]; g1[t] = EGATE[(tokA + t) * 128 + 64 + lane];
            peer_sort_experts(e0[t], e1[t], g0[t], g1[t], lane);
#pragma unroll
            for (int j = 0; j < 4; ++j) os[t][j] = (f32x4){0.f, 0.f, 0.f, 0.f}; }
#define GATHER_BATCH(E0, E1, G0, G1, XB0, XB1, O) do { const int ev = (bt < 8) ? E0 : E1; const float gv = (bt < 8) ? G0 : G1; const int lb8 = (bt & 7) * 8; v4u dw[8], uw[8]; \
            _Pragma("unroll") for (int i = 0; i < 8; ++i) { const int e = __builtin_amdgcn_readlane(ev, lb8 + i); dw[i] = *(const GAS v4u*)(PD + (size_t)e * D + lane * 16); uw[i] = *(const GAS v4u*)(PU + (size_t)e * D + lane * 16); } \
            float p[8]; \
            _Pragma("unroll") for (int i = 0; i < 8; ++i) { f32x4 dacc = (f32x4){0.f, 0.f, 0.f, 0.f}; \
                dacc = __builtin_amdgcn_mfma_f32_16x16x32_fp8_fp8((i64_t)(((unsigned long long)dw[i].y << 32) | dw[i].x), XB0, dacc, 0, 0, 0); \
                dacc = __builtin_amdgcn_mfma_f32_16x16x32_fp8_fp8((i64_t)(((unsigned long long)dw[i].w << 32) | dw[i].z), XB1, dacc, 0, 0, 0); \
                const float d0 = dacc[0] * m0, d1 = dacc[1] * m1, d2 = dacc[2] * m2, d3 = dacc[3] * m3; p[i] = (d0 + d1) + (d2 + d3); } \
            _Pragma("unroll") for (int i = 0; i < 4; ++i) { const float keep = (lane & 32) ? p[i + 4] : p[i], send = (lane & 32) ? p[i] : p[i + 4]; p[i] = keep + __shfl_xor(send, 32); } \
            _Pragma("unroll") for (int i = 0; i < 2; ++i) { const float keep = (lane & 16) ? p[i + 2] : p[i], send = (lane & 16) ? p[i] : p[i + 2]; p[i] = keep + __shfl_xor(send, 16); } \
            { const float keep = (lane & 8) ? p[1] : p[0], send = (lane & 8) ? p[0] : p[1]; p[0] = keep + __shfl_xor(send, 8); } \
            p[0] += __shfl_xor(p[0], 4); p[0] += __shfl_xor(p[0], 2); p[0] += __shfl_xor(p[0], 1); \
            const float gate = __shfl(gv, lb8 + rep); const float act = gelu_tanh(p[0] * (1.f / (PD_SCALE * XS))) * gate * AS; \
            const int act8 = __builtin_amdgcn_cvt_pk_fp8_f32(act, 0.f, 0, false) & 0xff; \
            _Pragma("unroll") for (int i = 0; i < 8; ++i) { const unsigned a8 = (unsigned)__builtin_amdgcn_readlane(act8, ((i >> 2) & 1) * 32 + ((i >> 1) & 1) * 16 + (i & 1) * 8) * 0x01010101u; \
                const i64_t A0 = (i64_t)(((unsigned long long)(a8 & m0hi) << 32) | (a8 & m0lo)), A1 = (i64_t)(((unsigned long long)(a8 & m1hi) << 32) | (a8 & m1lo)); \
                const i64_t B0 = (i64_t)(((unsigned long long)uw[i].y << 32) | uw[i].x), B1 = (i64_t)(((unsigned long long)uw[i].w << 32) | uw[i].z); \
                O[0] = __builtin_amdgcn_mfma_f32_16x16x32_fp8_fp8(A0, B0, O[0], 0, 0, 0); O[1] = __builtin_amdgcn_mfma_f32_16x16x32_fp8_fp8(A1, B0, O[1], 0, 0, 0); \
                O[2] = __builtin_amdgcn_mfma_f32_16x16x32_fp8_fp8(A0, B1, O[2], 0, 0, 0); O[3] = __builtin_amdgcn_mfma_f32_16x16x32_fp8_fp8(A1, B1, O[3], 0, 0, 0); } } while (0)
#pragma unroll 1
        for (int bt = 0; bt < 16; ++bt) { if ((bt & 3) == 0) __syncthreads();
#pragma unroll
            for (int t = 0; t < GT; ++t) { GATHER_BATCH(e0[t], e1[t], g0[t], g1[t], xb0[t], xb1[t], os[t]); __builtin_amdgcn_sched_barrier(0); } }
#undef GATHER_BATCH
#pragma unroll
        for (int t = 0; t < GT; ++t) {
            float o[16]; float s = 0.f;
#pragma unroll
            for (int a4 = 0; a4 < 4; ++a4) { const int hf = a4 >> 1, kh = a4 & 1, c0 = 16 * si + 256 * ((sq >> 1) + 2 * kh) + 8 * hf + 4 * (sq & 1);
                const v2u hw = *(const GAS v2u*)(H1 + (tokA + t) * D + c0);
                const float x0 = __builtin_bit_cast(float, hw.x << 16), x1 = __builtin_bit_cast(float, hw.x & 0xffff0000u), x2 = __builtin_bit_cast(float, hw.y << 16), x3 = __builtin_bit_cast(float, hw.y & 0xffff0000u);
                const f32x4 ov = os[t][a4];
                o[4 * a4 + 0] = ov[0] * (1.f / (AS * PU_SCALE)) + DN_ALPHA * x0; o[4 * a4 + 1] = ov[1] * (1.f / (AS * PU_SCALE)) + DN_ALPHA * x1;
                o[4 * a4 + 2] = ov[2] * (1.f / (AS * PU_SCALE)) + DN_ALPHA * x2; o[4 * a4 + 3] = ov[3] * (1.f / (AS * PU_SCALE)) + DN_ALPHA * x3;
                s += (o[4 * a4 + 0] + o[4 * a4 + 1]) + (o[4 * a4 + 2] + o[4 * a4 + 3]); }
            const float mean = wave_sum(s) * (1.f / D); float s2 = 0.f;
#pragma unroll
            for (int j = 0; j < 16; ++j) { o[j] -= mean; s2 += o[j] * o[j]; }
            const float rstd = 1.f / sqrtf(wave_sum(s2) * (1.f / D) + LN_EPS);
#pragma unroll
            for (int a4 = 0; a4 < 4; ++a4) { const int hf = a4 >> 1, kh = a4 & 1, c0 = 16 * si + 256 * ((sq >> 1) + 2 * kh) + 8 * hf + 4 * (sq & 1);
                const f32x4 ga = *(const GAS f32x4*)(F.in[I_LN2G] + c0), ba = *(const GAS f32x4*)(F.in[I_LN2B] + c0);
                f32x4 y; y.x = o[4 * a4 + 0] * rstd * ga.x + ba.x; y.y = o[4 * a4 + 1] * rstd * ga.y + ba.y; y.z = o[4 * a4 + 2] * rstd * ga.z + ba.z; y.w = o[4 * a4 + 3] * rstd * ga.w + ba.w;
                *(GAS f32x4*)(F.out + (tokA + t) * D + c0) = y; }
        }
    }
}

struct Args { const float* in[26]; float* out; unsigned char* ws; int ph_lo, ph_hi, li, pad; };
__global__ void __launch_bounds__(NWAVES * 64, 2) fwd_kernel(Args args) {
    extern __shared__ __attribute__((aligned(16))) unsigned char lds[];
    Frame F;
    F.lds = (LAS unsigned char*)lds;
    F.MISC = (volatile LAS unsigned*)(F.lds + MISC_OFF);
    F.tid = threadIdx.x; F.lane = F.tid & 63; F.wave = __builtin_amdgcn_readfirstlane(F.tid >> 6);
    F.G = gridDim.x; { const int bx = blockIdx.x; F.vcu = (F.G % 8 == 0) ? (bx % 8) * (F.G / 8) + bx / 8 : bx; }
#pragma unroll
    for (int i = 0; i < 26; ++i) F.in[i] = args.in[i];
    F.out = args.out; F.ws = args.ws;
    unsigned char* ws = args.ws;
    F.ctl = (gu32*)(ws + WS_CTL);
    for (int u = F.tid; u < (LDS_BYTES - LDSCTL_OFF) / 4; u += NWAVES * 64) ((LAS unsigned*)(F.lds + LDSCTL_OFF))[u] = 0u;
    __syncthreads();
    XcdBarrier bar; bar.bar = (unsigned*)(F.ctl + CW_BAR); bar.x = 0; bar.st = nullptr; bar.G = 0;
    XcdBarrier bar2 = bar;
    if (N_LAUNCHES == 1) { bar = xcd_barrier_post((unsigned*)(F.ctl + CW_BAR), F.MISC + 8, (unsigned)F.G);
        if (F.vcu >= 128) bar2 = xcd_barrier_post((unsigned*)(F.ctl + CW_BAR2), F.MISC + 10, (unsigned)(F.G - 128)); }
#define GRID_BAR() do { if (N_LAUNCHES == 1) xcd_barrier(bar); } while (0)
    const int lo = args.ph_lo, hi = args.ph_hi;
#define IN(k) (lo <= (k) && (k) < hi)
#define BOTH(k) (IN(k) && IN((k) + 1))
    bf16* const Hb = (bf16*)(ws + WS_H);
    bf16* const PRJ = (bf16*)(ws + WS_PROJ);

    if (IN(0)) { p0_prologue(F); if (BOTH(0)) GRID_BAR(); }

    if (IN(1)) {
        s5_tables_stage1(F);
        pg8::Gemm g{Hb, (const bf16*)(ws + WS_WIN), M, NPROJ, D, D, D}; pg8::StaticOrder S; S.init(M, NPROJ, F.G, (int)blockIdx.x);
        pg8::EpiProj E{PRJ, PRJ + (size_t)M * 512, PRJ + (size_t)2 * M * 512, PRJ + (size_t)3 * M * 512, (bf16*)(ws + WS_A5), (const float*)(ws + WS_LB), M};
        pg8::gemm_phase<pg8::EpiProj, pg8::StaticOrder, true, true>(F.lds + RING_OFF, g, S, E);
        if (BOTH(1)) GRID_BAR();
    }

    if (IN(2)) {
        s5_tables_stage2(F);
        if (F.vcu < 128) hgrn2_state_pass(F, F.vcu);
        else { pg8::Gemm g{(const bf16*)(ws + WS_A5), (const bf16*)(ws + WS_G5), 32 * S5I, 32 * 256, 512, S5K, 512}; pg8::GroupedOrder S{4, 1, F.G - 128, F.vcu - 128};
            pg8::EpiS5A E{(float*)(ws + WS_XLOC)};
            pg8::gemm_phase<pg8::EpiS5A, pg8::GroupedOrder, true, true>(F.lds + RING_OFF, g, S, E);
            if (N_LAUNCHES == 1) { xcd_barrier(bar2); if (F.vcu - 128 < 32) s5_scan(F, (F.vcu - 128) * 512 + F.tid); }
        }
        { constexpr int NTAB16 = PE * D / 16, NCHUNK = 2 * NTAB16 / 4096;
          for (;;) {
              if (F.tid == 0) F.MISC[4] = xb_add((unsigned*)(F.ctl + CW_CONV), 1u);
              __syncthreads();
              const int ch = (int)F.MISC[4];
              __syncthreads();
              if (ch >= NCHUNK) break;
#pragma unroll 2
              for (int q8 = 0; q8 < 8; ++q8) { const int i = ch * 4096 + q8 * 512 + F.tid; const bool up = i >= NTAB16; const int j = up ? i - NTAB16 : i; const float* src = (up ? F.in[I_PU] : F.in[I_PD]) + (size_t)j * 16; const float sc = up ? PU_SCALE : PD_SCALE;
                  v4u o; unsigned ow[4];
#pragma unroll
                  for (int q = 0; q < 4; ++q) { const f32x4 a = *(const GAS f32x4*)(src + 4 * q); int pk = __builtin_amdgcn_cvt_pk_fp8_f32(a.x * sc, a.y * sc, 0, false); pk = __builtin_amdgcn_cvt_pk_fp8_f32(a.z * sc, a.w * sc, pk, true); ow[q] = (unsigned)pk; }
                  o.x = ow[0]; o.y = ow[1]; o.z = ow[2]; o.w = ow[3];
                  *(GAS v4u*)(ws + (up ? WS_PU : WS_PD) + (size_t)j * 16) = o; }
          } }
        if (BOTH(2)) GRID_BAR();
    }

    if (IN(3)) {
        if (N_LAUNCHES != 1) { if (F.vcu < 32) s5_scan(F, F.vcu * 512 + F.tid); }
        { pg8::Gemm g{(const bf16*)(ws + WS_A5), (const bf16*)(ws + WS_T5), 32 * S5I, 32 * 512, S5K, S5K, S5K}; pg8::GroupedOrder S{4, 2, F.G, F.vcu};
          pg8::EpiS5C E{(bf16*)(ws + WS_Z)};
          pg8::gemm_phase<pg8::EpiS5C, pg8::GroupedOrder, true, true>(F.lds + RING_OFF, g, S, E); }
        hgrn2_out_phase(F);
        if (BOTH(3)) GRID_BAR();
    }

    if (IN(4)) {
        pg8::Gemm g{(const bf16*)(ws + WS_Z), (const bf16*)(ws + WS_WGLU), M, 512, 512, 512, 512}; pg8::StaticOrder S; S.init(M, 512, F.G, (int)blockIdx.x);
        pg8::EpiGlu E{(const bf16*)(ws + WS_Z), (bf16*)(ws + WS_MIX), F.in[I_BGLU]};
        pg8::gemm_phase<pg8::EpiGlu, pg8::StaticOrder, true, true>(F.lds + RING_OFF, g, S, E);
        if (BOTH(4)) GRID_BAR();
    }

    if (IN(5)) {
        pg8::Gemm g{(const bf16*)(ws + WS_MIX), (const bf16*)(ws + WS_WOUT), M, D, D, D, D}; pg8::StaticOrder S; S.init(M, D, F.G, (int)blockIdx.x);
        pg8::EpiOut E{Hb, DN_ALPHA};
        pg8::gemm_phase<pg8::EpiOut, pg8::StaticOrder, true, true>(F.lds + RING_OFF, g, S, E);
        if (BOTH(5)) GRID_BAR();
    }

    if (IN(6)) {
        const int gw = F.vcu * NWAVES + F.wave, NGW = F.G * NWAVES;
        for (int m = gw; m < M; m += NGW) ln1_row(Hb + (size_t)m * D, F.in[I_LN1G], F.in[I_LN1B], F.lane);
        if (BOTH(6)) GRID_BAR();
    }

    if (IN(7)) {
        pg8::Gemm g{Hb, (const bf16*)(ws + WS_WQ), M, NQ2, D, D, D}; pg8::StaticOrder S; S.init(M, NQ2, F.G, (int)blockIdx.x);
        pg8::EpiStore E{(bf16*)(ws + WS_Q2), NQ2};
        pg8::gemm_phase<pg8::EpiStore, pg8::StaticOrder, true, true>(F.lds + RING_OFF, g, S, E);
        VM_WAIT(); __syncthreads();
        if (F.tid == 0) { __builtin_amdgcn_fence(__ATOMIC_ACQUIRE, "agent"); VM_WAIT(); }
        __syncthreads();
        peer_score_phase(F, S);
        if (BOTH(7)) GRID_BAR();
    }

    if (IN(8)) { peer_gather_phase(F); }
#undef IN
#undef BOTH
}

extern "C" void kernel_launch(void* const* d_in, const int* in_sizes, int n_in, void* d_out, int out_size, void* d_ws, size_t ws_size, hipStream_t stream) {
    static int grid = 0;
    if (grid == 0) {
        if (n_in != 26 || in_sizes[0] != M * D || out_size != M * D || ws_size < WS_END) { fprintf(stderr, "kernel_launch: unexpected shapes: n_in %d in0 %d out %d ws %zu (need %zu)\n", n_in, n_in > 0 ? in_sizes[0] : -1, out_size, ws_size, (size_t)WS_END); grid = -1; return; }
        int dev = 0, cus = 0;
        if (hipGetDevice(&dev) != hipSuccess || hipDeviceGetAttribute(&cus, hipDeviceAttributeMultiprocessorCount, dev) != hipSuccess) { grid = -1; return; }
        if (hipFuncSetAttribute((const void*)fwd_kernel, hipFuncAttributeMaxDynamicSharedMemorySize, LDS_BYTES) != hipSuccess) { fprintf(stderr, "kernel_launch: hipFuncSetAttribute failed\n"); grid = -1; return; }
        (void)hipGetLastError();
        grid = cus;
    }
    if (grid < 0) return;
    if (hipMemsetAsync((char*)d_ws + WS_CTL, 0, CTL_ZERO_BYTES, stream) != hipSuccess) return;
    Args a{};
    for (int i = 0; i < 26; ++i) a.in[i] = (const float*)d_in[i];
    a.out = (float*)d_out; a.ws = (unsigned char*)d_ws;
    if (N_LAUNCHES == 1) { a.ph_lo = 0; a.ph_hi = NPH; a.li = 0; hipLaunchKernelGGL(fwd_kernel, dim3(grid), dim3(NWAVES * 64), LDS_BYTES, stream, a); }
    else for (int li = 0; li < NPH; ++li) { a.ph_lo = li; a.ph_hi = li + 1; a.li = li; hipLaunchKernelGGL(fwd_kernel, dim3(grid), dim3(NWAVES * 64), LDS_BYTES, stream, a); }
}
```

```cpp
#include <hip/hip_runtime.h>
#include <cstdio>
#include <cstdint>
namespace pg8 {
#define PG8_LAS __attribute__((address_space(3)))
typedef unsigned short bf16_t;
typedef short bf16x8 __attribute__((ext_vector_type(8)));
typedef float f32x4 __attribute__((ext_vector_type(4)));
typedef unsigned u32x4 __attribute__((ext_vector_type(4)));
constexpr int BM = 256, BK = 64, HALF = 128, HTB = HALF * BK * 2  , STAGE_BYTES = 8 * HTB, NXCD = 8, WGM = 8;

__host__ __device__ __forceinline__ int lds_byte(int r, int c) { const int st = (r >> 4) * 2 + (c >> 5), rr = r & 15, cc = c & 31, ob = rr * 64 + cc * 2; return st * 1024 + (ob ^ (((ob >> 9) & 1) << 5)); }
__host__ __device__ __forceinline__ void stage_rc(int b, int& R, int& C) { const int st = b / 1024, sb = b % 1024, swz = sb ^ (((sb >> 9) & 1) << 5); R = (st >> 1) * 16 + swz / 64; C = (st & 1) * 32 + (swz % 64) / 2; }
__host__ __device__ __forceinline__ int perm32(int rho) { const int n = rho >> 4, i = rho & 15; return 8 * (i >> 2) + 4 * n + (i & 3); }

struct Unit { int pm, pn; };
struct Gemm { const bf16_t* A; const bf16_t* Bt; int M, N, K, lda, ldb; };

struct StaticOrder {
    int nM, nN, nwg, G, c;
    __host__ __device__ void init(int M, int N, int G_, int c_) { nM = M / BM; nN = N / BM; nwg = nM * nN; G = G_; c = c_; }
    __host__ __device__ bool next(int i, Unit& u) const {
        const long L = (long)i * G + c; if (L >= nwg) return false;
        int wgid = (int)L; { const int q = nwg / NXCD, r = nwg % NXCD, xcd = wgid % NXCD, off = wgid / NXCD; wgid = (xcd < r ? xcd * (q + 1) : r * (q + 1) + (xcd - r) * q) + off; }
        const int nig = WGM * nN, gid = wgid / nig, fm = gid * WGM, gsz = (nM - fm) < WGM ? (nM - fm) : WGM;
        u.pm = fm + ((wgid % nig) % gsz); u.pn = (wgid % nig) / gsz; return true;
    }
    __device__ __forceinline__ void a_ready(const Unit&) const {}
    __device__ __forceinline__ void done(const Unit&) const {}
};

__device__ __forceinline__ unsigned cvt_pk_bf16(float lo, float hi) { unsigned r; asm volatile("v_cvt_pk_bf16_f32 %0, %1, %2" : "=v"(r) : "v"(lo), "v"(hi)); return r; }
__device__ __forceinline__ void unpack8(const u32x4 w, float (&f)[8]) {
    f[0] = __builtin_bit_cast(float, w.x << 16); f[1] = __builtin_bit_cast(float, w.x & 0xffff0000u);
    f[2] = __builtin_bit_cast(float, w.y << 16); f[3] = __builtin_bit_cast(float, w.y & 0xffff0000u);
    f[4] = __builtin_bit_cast(float, w.z << 16); f[5] = __builtin_bit_cast(float, w.z & 0xffff0000u);
    f[6] = __builtin_bit_cast(float, w.w << 16); f[7] = __builtin_bit_cast(float, w.w & 0xffff0000u);
}
__device__ __forceinline__ u32x4 pack8(const float (&f)[8]) { u32x4 w; w.x = cvt_pk_bf16(f[0], f[1]); w.y = cvt_pk_bf16(f[2], f[3]); w.z = cvt_pk_bf16(f[4], f[5]); w.w = cvt_pk_bf16(f[6], f[7]); return w; }

struct EpiStore {
    static constexpr bool PERM = true, AFTER_DRAIN = false;
    bf16_t* O; int ldc;
    __device__ __forceinline__ void operator()(const f32x4 (&acc)[2][2][4][2], const Unit& u, int wr, int wc, int fr, int fq) const {
        const int row0 = u.pm * BM + wr * 64 + fr, col0 = u.pn * BM + wc * 32 + 8 * fq;
#pragma unroll
        for (int ai = 0; ai < 2; ++ai)
#pragma unroll
            for (int m = 0; m < 4; ++m) { bf16_t* rowp = O + (size_t)(row0 + ai * HALF + m * 16) * ldc + col0;
#pragma unroll
                for (int bj = 0; bj < 2; ++bj) { const f32x4 v0 = acc[ai][bj][m][0], v1 = acc[ai][bj][m][1];
                    u32x4 w; w.x = cvt_pk_bf16(v0[0], v0[1]); w.y = cvt_pk_bf16(v0[2], v0[3]); w.z = cvt_pk_bf16(v1[0], v1[1]); w.w = cvt_pk_bf16(v1[2], v1[3]);
                    *(u32x4*)(rowp + bj * HALF) = w; } }
    }
};

struct EpiProj {
    static constexpr bool PERM = true, AFTER_DRAIN = false;
    bf16_t* Qb; bf16_t* LFb; bf16_t* Vb; bf16_t* Gb; bf16_t* Ub; const float* lb; int M;
    __device__ __forceinline__ void operator()(const f32x4 (&acc)[2][2][4][2], const Unit& u, int wr, int wc, int fr, int fq) const {
        const int row0 = u.pm * BM + wr * 64 + fr; const int colt = u.pn * BM; const int t = colt >> 9;
        const int cb = (colt & 511) + wc * 32 + 8 * fq;
        float lbv[2][8];
        if (t == 1) {
#pragma unroll
            for (int bj = 0; bj < 2; ++bj) { const f32x4 a = *(const f32x4*)(lb + cb + bj * HALF), b = *(const f32x4*)(lb + cb + bj * HALF + 4);
                lbv[bj][0] = a[0]; lbv[bj][1] = a[1]; lbv[bj][2] = a[2]; lbv[bj][3] = a[3]; lbv[bj][4] = b[0]; lbv[bj][5] = b[1]; lbv[bj][6] = b[2]; lbv[bj][7] = b[3]; }
        }
#pragma unroll
        for (int ai = 0; ai < 2; ++ai)
#pragma unroll
            for (int m = 0; m < 4; ++m) { const int row = row0 + ai * HALF + m * 16;
#pragma unroll
                for (int bj = 0; bj < 2; ++bj) { const f32x4 v0 = acc[ai][bj][m][0], v1 = acc[ai][bj][m][1]; const int c = cb + bj * HALF;
                    float f[8] = {v0[0], v0[1], v0[2], v0[3], v1[0], v1[1], v1[2], v1[3]};
                    if (t == 0) {
#pragma unroll
                        for (int j = 0; j < 8; ++j) f[j] *= 0.08838834764831845f;
                        *(u32x4*)(Qb + (size_t)row * 512 + c) = pack8(f);
                    } else if (t == 1) {
#pragma unroll
                        for (int j = 0; j < 8; ++j) { const float l = lbv[bj][j]; const float sg = 1.f / (1.f + __expf(-f[j])); f[j] = __logf(l + (1.f - l) * sg); }
                        *(u32x4*)(LFb + (size_t)row * 512 + c) = pack8(f);
                    } else if (t == 2) { *(u32x4*)(Vb + (size_t)row * 512 + c) = pack8(f);
                    } else if (t == 3) { *(u32x4*)(Gb + (size_t)row * 512 + c) = pack8(f);
                    } else { *(u32x4*)(Ub + ((size_t)(c >> 4) * (M / 32) + (row >> 5)) * 640 + (row & 31) * 16 + (c & 15)) = pack8(f); }
                } }
    }
};

struct EpiGlu {
    static constexpr bool PERM = true, AFTER_DRAIN = false;
    const bf16_t* Z; bf16_t* MIX; const float* bglu;
    __device__ __forceinline__ void operator()(const f32x4 (&acc)[2][2][4][2], const Unit& u, int wr, int wc, int fr, int fq) const {
        const int row0 = u.pm * BM + wr * 64 + fr, col0 = u.pn * BM + wc * 32 + 8 * fq;
#pragma unroll
        for (int bj = 0; bj < 2; ++bj) { const int c = col0 + bj * HALF;
            const f32x4 b0 = *(const f32x4*)(bglu + c), b1 = *(const f32x4*)(bglu + c + 4);
#pragma unroll
            for (int ai = 0; ai < 2; ++ai)
#pragma unroll
                for (int m = 0; m < 4; ++m) { const int row = row0 + ai * HALF + m * 16;
                    const f32x4 v0 = acc[ai][bj][m][0] + b0, v1 = acc[ai][bj][m][1] + b1;
                    float z[8]; unpack8(*(const u32x4*)(Z + (size_t)row * 512 + c), z);
                    float f[8] = {v0[0], v0[1], v0[2], v0[3], v1[0], v1[1], v1[2], v1[3]};
#pragma unroll
                    for (int j = 0; j < 8; ++j) f[j] = z[j] / (1.f + __expf(-f[j]));
                    *(u32x4*)(MIX + (size_t)row * 1024 + 512 + c) = pack8(f); } }
    }
};

struct EpiOut {
    static constexpr bool PERM = true, AFTER_DRAIN = false;
    bf16_t* H; float alpha;
    __device__ __forceinline__ void operator()(const f32x4 (&acc)[2][2][4][2], const Unit& u, int wr, int wc, int fr, int fq) const {
        const int row0 = u.pm * BM + wr * 64 + fr, col0 = u.pn * BM + wc * 32 + 8 * fq;
#pragma unroll
        for (int ai = 0; ai < 2; ++ai)
#pragma unroll
            for (int m = 0; m < 4; ++m) { bf16_t* rowp = H + (size_t)(row0 + ai * HALF + m * 16) * 1024 + col0;
#pragma unroll
                for (int bj = 0; bj < 2; ++bj) { const f32x4 v0 = acc[ai][bj][m][0], v1 = acc[ai][bj][m][1];
                    float h[8]; unpack8(*(const u32x4*)(rowp + bj * HALF), h);
                    float f[8] = {v0[0], v0[1], v0[2], v0[3], v1[0], v1[1], v1[2], v1[3]};
#pragma unroll
                    for (int j = 0; j < 8; ++j) f[j] = alpha * h[j] + f[j];
                    *(u32x4*)(rowp + bj * HALF) = pack8(f); } }
    }
};

struct GroupedOrder {
    int tm, tn, G, c;
    __device__ bool next(int i, Unit& u) const { const int L = i * G + c, per = tm * tn; if (c < 0 || L >= 32 * per) return false;
        const int g = L / per, r = L % per; u.pm = g * tm + r % tm; u.pn = g * tn + r / tm; return true; }
    __device__ __forceinline__ void a_ready(const Unit&) const {}
    __device__ __forceinline__ void done(const Unit&) const {}
};
struct EpiS5A {
    static constexpr bool PERM = true, AFTER_DRAIN = false;
    float* X;
    __device__ __forceinline__ void operator()(const f32x4 (&acc)[2][2][4][2], const Unit& u, int wr, int wc, int fr, int fq) const {
        const int g = u.pn, inst0 = (u.pm & 3) * BM + wr * 64 + fr, col = wc * 32 + 8 * fq;
#pragma unroll
        for (int ai = 0; ai < 2; ++ai)
#pragma unroll
            for (int m = 0; m < 4; ++m) { float* p = X + ((size_t)(inst0 + ai * HALF + m * 16) * 32 + g) * 128 + col;
                *(f32x4*)p = acc[ai][0][m][0]; *(f32x4*)(p + 4) = acc[ai][0][m][1]; }
    }
};
struct EpiS5C {
    static constexpr bool PERM = true, AFTER_DRAIN = false;
    bf16_t* Z;
    __device__ __forceinline__ void operator()(const f32x4 (&acc)[2][2][4][2], const Unit& u, int wr, int wc, int fr, int fq) const {
        const int g = u.pm >> 2, inst0 = (u.pm & 3) * BM + wr * 64 + fr, col0 = (u.pn & 1) * BM + wc * 32 + 8 * fq;
#pragma unroll
        for (int ai = 0; ai < 2; ++ai)
#pragma unroll
            for (int m = 0; m < 4; ++m) { const int inst = inst0 + ai * HALF + m * 16; const size_t tok0 = (size_t)(inst >> 7) * 4096 + (size_t)(inst & 127) * 32;
#pragma unroll
                for (int bj = 0; bj < 2; ++bj) { const int col = col0 + bj * HALF; const f32x4 v0 = acc[ai][bj][m][0], v1 = acc[ai][bj][m][1];
                    float f[8] = {v0[0], v0[1], v0[2], v0[3], v1[0], v1[1], v1[2], v1[3]};
#pragma unroll
                    for (int j = 0; j < 8; ++j) { const float x = f[j], y = 0.7978845608028654f * (x + 0.044715f * x * x * x); f[j] = x / (1.f + __expf(-2.f * y)); }
                    *(u32x4*)(Z + (tok0 + (col >> 4)) * 512 + g * 16 + (col & 15)) = pack8(f); } }
    }
};

template <class Epi, class Sched, bool ALIGN_EPI = false, bool SP2 = false>
__device__ __forceinline__ void gemm_phase(PG8_LAS unsigned char* lds, const Gemm g, const Sched& S, const Epi& E) {
    const int tid = threadIdx.x, wid = __builtin_amdgcn_readfirstlane(tid >> 6), lane = tid & 63, wr = wid >> 2, wc = wid & 3, fr = lane & 15, fq = lane >> 4;
    const int K = g.K, nt = K / BK;
    unsigned voffA[2], voffB[2];
#pragma unroll
    for (int i = 0; i < 2; ++i) { int R, C; stage_rc(tid * 16 + i * 8192, R, C); const int Rb = Epi::PERM ? ((R & ~31) + perm32(R & 31)) : R;
        voffA[i] = (unsigned)(R * g.lda + C) * 2u; voffB[i] = (unsigned)(Rb * g.ldb + C) * 2u; }
    const size_t kstep = (size_t)(BK * 2);
    const size_t hstepA = (size_t)HALF * g.lda * 2, hstepB = (size_t)HALF * g.ldb * 2;
    const size_t tstepA = 2 * hstepA, tstepB = 2 * hstepB;
    const unsigned ldsw = (unsigned)wid * 1024u;
    const int aoff = lds_byte(wr * 64 + fr, fq * 8), boff = lds_byte(wc * 32 + fr, fq * 8);
#define PG8_SA(b, h) (((b) * 2 + (h)) * HTB)
#define PG8_SB(b, h) ((4 + (b) * 2 + (h)) * HTB)
#define PG8_STAGE(bufoff, gbase, voff) do { _Pragma("unroll") for (int _i = 0; _i < 2; ++_i) \
        __builtin_amdgcn_global_load_lds((const unsigned*)((const char*)(gbase) + (voff)[_i]), (PG8_LAS unsigned*)(lds + (bufoff) + ldsw + _i * 8192), 16, 0, 0); } while (0)
#define PG8_LDA(dst, b, h) do { _Pragma("unroll") for (int m = 0; m < 4; ++m) _Pragma("unroll") for (int k = 0; k < 2; ++k) dst[m][k] = *(const PG8_LAS bf16x8*)(lds + PG8_SA(b, h) + aoff + m * 2048 + k * 1024); } while (0)
#define PG8_LDB(dst, b, h) do { _Pragma("unroll") for (int n = 0; n < 2; ++n) _Pragma("unroll") for (int k = 0; k < 2; ++k) dst[n][k] = *(const PG8_LAS bf16x8*)(lds + PG8_SB(b, h) + boff + n * 2048 + k * 1024); } while (0)
#define PG8_MMA(ai, bj, At, Bt) do { __builtin_amdgcn_s_setprio(1); _Pragma("unroll") for (int m = 0; m < 4; ++m) _Pragma("unroll") for (int n = 0; n < 2; ++n) _Pragma("unroll") for (int k = 0; k < 2; ++k) \
        acc[ai][bj][m][n] = __builtin_amdgcn_mfma_f32_16x16x32_bf16(Bt[n][k], At[m][k], acc[ai][bj][m][n], 0, 0, 0); __builtin_amdgcn_s_setprio(0); } while (0)
#define PG8_WAIT_V(n) asm volatile("s_waitcnt vmcnt(" #n ")" ::: "memory")
#define PG8_WAIT_L(n) asm volatile("s_waitcnt lgkmcnt(" #n ")" ::: "memory")
#define PG8_BAR __builtin_amdgcn_s_barrier()
#define PG8_SCHED __builtin_amdgcn_sched_barrier(0)
    Unit cur, nxt; int ui = 0;
    if (!S.next(0, cur)) return;
    f32x4 acc[2][2][4][2];
#pragma unroll
    for (int a = 0; a < 2; ++a)
#pragma unroll
        for (int b = 0; b < 2; ++b)
#pragma unroll
            for (int m = 0; m < 4; ++m)
#pragma unroll
                for (int n = 0; n < 2; ++n) acc[a][b][m][n] = (f32x4){0.f, 0.f, 0.f, 0.f};
    bf16x8 At[4][2], B0[2][2], B1[2][2];
    const char* cA = (const char*)g.A + (size_t)cur.pm * tstepA; const char* cB = (const char*)g.Bt + (size_t)cur.pn * tstepB;
    S.a_ready(cur);
    if constexpr (SP2) {
        PG8_STAGE(PG8_SB(0, 0), cB, voffB); PG8_STAGE(PG8_SB(0, 1), cB + hstepB, voffB); PG8_STAGE(PG8_SA(0, 0), cA, voffA); PG8_STAGE(PG8_SA(0, 1), cA + hstepA, voffA);
        if (wr == 1) PG8_BAR;
        PG8_WAIT_V(2); PG8_BAR;
        PG8_STAGE(PG8_SB(1, 0), cB + kstep, voffB); PG8_STAGE(PG8_SA(1, 0), cA + kstep, voffA); PG8_STAGE(PG8_SB(1, 1), cB + hstepB + kstep, voffB);
        PG8_WAIT_V(6); PG8_BAR;
    } else {
        PG8_STAGE(PG8_SB(0, 0), cB, voffB); PG8_STAGE(PG8_SA(0, 0), cA, voffA); PG8_STAGE(PG8_SB(0, 1), cB + hstepB, voffB); PG8_STAGE(PG8_SA(0, 1), cA + hstepA, voffA);
        if (wr == 1) PG8_BAR;
        PG8_WAIT_V(4); PG8_BAR;
        PG8_STAGE(PG8_SB(1, 0), cB + kstep, voffB); PG8_STAGE(PG8_SA(1, 0), cA + kstep, voffA); PG8_STAGE(PG8_SB(1, 1), cB + hstepB + kstep, voffB);
        PG8_WAIT_V(6); PG8_BAR;
    }
    for (;;) {
        const bool has_next = S.next(ui + 1, nxt);
        const char* nA = has_next ? (const char*)g.A + (size_t)nxt.pm * tstepA : cA; const char* nB = has_next ? (const char*)g.Bt + (size_t)nxt.pn * tstepB : cB;
        for (int t = 0; t < nt; t += 2) {
            const bool last = (t == nt - 2);
            const char* a1 = cA + (size_t)(t + 1) * kstep;
            const char* a2 = last ? nA : cA + (size_t)(t + 2) * kstep; const char* b2 = last ? nB : cB + (size_t)(t + 2) * kstep;
            const char* a3 = a2 + kstep; const char* b3 = b2 + kstep;
            if (last && has_next) S.a_ready(nxt);
            if constexpr (SP2) {
            PG8_LDB(B0, 0, 0); PG8_LDB(B1, 0, 1); PG8_SCHED; PG8_LDA(At, 0, 0); PG8_STAGE(PG8_SA(1, 1), a1 + hstepA, voffA);
            PG8_WAIT_V(8); PG8_WAIT_L(0); PG8_BAR; PG8_MMA(0, 0, At, B0); PG8_MMA(0, 1, At, B1); PG8_BAR; PG8_SCHED;
            PG8_LDA(At, 0, 1); PG8_STAGE(PG8_SB(0, 0), b2, voffB); PG8_STAGE(PG8_SB(0, 1), b2 + hstepB, voffB); PG8_STAGE(PG8_SA(0, 0), a2, voffA);
            PG8_WAIT_V(8); PG8_WAIT_L(0); PG8_BAR; PG8_MMA(1, 0, At, B0); PG8_MMA(1, 1, At, B1); PG8_BAR; PG8_SCHED;
            PG8_LDB(B0, 1, 0); PG8_LDB(B1, 1, 1); PG8_SCHED; PG8_LDA(At, 1, 0); PG8_STAGE(PG8_SA(0, 1), a2 + hstepA, voffA);
            PG8_WAIT_V(8); PG8_WAIT_L(0); PG8_BAR; PG8_MMA(0, 0, At, B0); PG8_MMA(0, 1, At, B1); PG8_BAR; PG8_SCHED;
            PG8_LDA(At, 1, 1); PG8_STAGE(PG8_SB(1, 0), b3, voffB); PG8_STAGE(PG8_SB(1, 1), b3 + hstepB, voffB); PG8_STAGE(PG8_SA(1, 0), a3, voffA);
            PG8_WAIT_V(8); PG8_WAIT_L(0); PG8_BAR; PG8_MMA(1, 0, At, B0); PG8_MMA(1, 1, At, B1); PG8_BAR; PG8_SCHED;
            } else {
            PG8_LDB(B0, 0, 0); PG8_SCHED; PG8_LDA(At, 0, 0); PG8_STAGE(PG8_SA(1, 1), a1 + hstepA, voffA);
            PG8_WAIT_L(8); PG8_BAR; PG8_WAIT_L(0); PG8_MMA(0, 0, At, B0); PG8_BAR; PG8_SCHED;
            PG8_LDB(B1, 0, 1); PG8_STAGE(PG8_SB(0, 0), b2, voffB);
            PG8_BAR; PG8_WAIT_L(0); PG8_MMA(0, 1, At, B1); PG8_BAR;
            PG8_LDA(At, 0, 1); PG8_STAGE(PG8_SA(0, 0), a2, voffA);
            PG8_BAR; PG8_WAIT_L(0); PG8_MMA(1, 0, At, B0); PG8_BAR; PG8_SCHED;
            PG8_STAGE(PG8_SB(0, 1), b2 + hstepB, voffB);
            PG8_WAIT_V(6); PG8_BAR; PG8_MMA(1, 1, At, B1); PG8_BAR;
            PG8_LDB(B0, 1, 0); PG8_SCHED; PG8_LDA(At, 1, 0); PG8_STAGE(PG8_SA(0, 1), a2 + hstepA, voffA);
            PG8_WAIT_L(8); PG8_BAR; PG8_WAIT_L(0); PG8_MMA(0, 0, At, B0); PG8_BAR; PG8_SCHED;
            PG8_LDB(B1, 1, 1); PG8_STAGE(PG8_SB(1, 0), b3, voffB);
            PG8_BAR; PG8_WAIT_L(0); PG8_MMA(0, 1, At, B1); PG8_BAR;
            PG8_LDA(At, 1, 1); PG8_STAGE(PG8_SA(1, 0), a3, voffA);
            PG8_BAR; PG8_WAIT_L(0); PG8_MMA(1, 0, At, B0); PG8_BAR; PG8_SCHED;
            PG8_STAGE(PG8_SB(1, 1), b3 + hstepB, voffB);
            PG8_WAIT_V(6); PG8_BAR; PG8_MMA(1, 1, At, B1); PG8_BAR;
            }
        }
        if constexpr (ALIGN_EPI) { if (wr == 0) PG8_BAR; }
        if constexpr (!Epi::AFTER_DRAIN) { E(acc, cur, wr, wc, fr, fq); S.done(cur); }
        if (!has_next) break;
#pragma unroll
        for (int a = 0; a < 2; ++a)
#pragma unroll
            for (int b = 0; b < 2; ++b)
#pragma unroll
                for (int m = 0; m < 4; ++m)
#pragma unroll
                    for (int n = 0; n < 2; ++n) acc[a][b][m][n] = (f32x4){0.f, 0.f, 0.f, 0.f};
        cur = nxt; cA = nA; cB = nB; ++ui;
        if constexpr (ALIGN_EPI) { if (wr == 1) PG8_BAR; }
    }
    PG8_WAIT_V(0);
    if constexpr (!ALIGN_EPI) { if (wr == 0) PG8_BAR; }
    PG8_BAR;
    if constexpr (Epi::AFTER_DRAIN) { E.fused(acc, cur, wr, wc, fr, fq, lds, wid, lane); S.done(cur); }
#undef PG8_SA
#undef PG8_SB
#undef PG8_STAGE
#undef PG8_LDA
#undef PG8_LDB
#undef PG8_MMA
#undef PG8_WAIT_V
#undef PG8_WAIT_L
#undef PG8_BAR
#undef PG8_SCHED
}
}

constexpr int NWAVES = 8;
#ifndef MK_N_LAUNCHES
#define MK_N_LAUNCHES 1
#endif
constexpr int N_LAUNCHES = MK_N_LAUNCHES;
constexpr int NPH = 9;

constexpr int BATCH = 8, SEQ = 4096, D = 1024, M = BATCH * SEQ;
constexpr int HGW = 512, HGH = 4, HGK = 128;
constexpr int S5W = 512, S5G = 32, S5P = 16, S5N = 64;
constexpr int S5L = 32, S5I = M / S5L, S5K = S5L * S5P + 2 * S5N;
constexpr int NPROJ = 2560;
constexpr int PK = 128, PH = 8, PTOPK = 16, PQ = 256, PHALF = 128, PE = PK * PK, NQ2 = PH * PQ;
constexpr float LN_EPS = 1e-5f, RMS_EPS = 1e-6f;
constexpr float DN_ALPHA = 1.189207115002721f;

constexpr size_t MiB = 1u << 20;
constexpr size_t WS_CTL = 0, CTL_ZERO_BYTES = 1 * MiB;
constexpr size_t WS_WIN = 1 * MiB;
constexpr size_t WS_WGLU = 6 * MiB;
constexpr size_t WS_KEYS = 6 * MiB + 512 * 1024;
constexpr size_t WS_LB = 6 * MiB + 640 * 1024;
constexpr size_t WS_S5T = 6 * MiB + 704 * 1024;
constexpr size_t WS_WOUT = 7 * MiB + 512 * 1024;
constexpr size_t WS_WQ = 10 * MiB;
constexpr size_t WS_SST = 14 * MiB;
constexpr size_t WS_H = 78 * MiB;
constexpr size_t WS_PROJ = 142 * MiB;
constexpr size_t WS_Q2 = WS_PROJ;
constexpr size_t WS_A5 = 270 * MiB;
constexpr size_t WS_MIX = 310 * MiB;
constexpr size_t WS_PD = 452 * MiB, WS_PU = 468 * MiB;
constexpr size_t WS_Z = 374 * MiB;
constexpr size_t WS_EIDX = WS_Z, WS_EGATE = WS_Z + 16 * MiB;
constexpr size_t WS_T5 = 406 * MiB;
constexpr size_t WS_G5 = 426 * MiB;
constexpr size_t WS_XLOC = 434 * MiB;
constexpr size_t WS_KTAU = 450 * MiB;
constexpr size_t WS_PW = 451 * MiB;
constexpr size_t WS_END = 484 * MiB;
constexpr int CW_TMO = 0, CW_CODE = 1;
constexpr int CW_BAR = 4096, CW_BAR2 = 8192;
constexpr int CW_CONV = 65536;

constexpr int RING_OFF = 0, RING_BYTES = 147456;
constexpr int LDSCTL_OFF = RING_BYTES, MISC_OFF = LDSCTL_OFF + 320;
constexpr int LDS_BYTES = 151552;
static_assert(MISC_OFF + 128 <= LDS_BYTES, "LDS map");

#define GAS __attribute__((address_space(1)))
#define LAS __attribute__((address_space(3)))
typedef unsigned short bf16;
typedef unsigned v4u __attribute__((ext_vector_type(4)));
typedef float f32x4 __attribute__((ext_vector_type(4)));
typedef short bf16x8 __attribute__((ext_vector_type(8)));
typedef GAS unsigned gu32;
typedef GAS unsigned long long gu64;
#define RLX_AGENT __ATOMIC_RELAXED, __HIP_MEMORY_SCOPE_AGENT
#define LDS_WAIT() asm volatile("s_waitcnt lgkmcnt(0)" ::: "memory")
#define VM_WAIT() asm volatile("s_waitcnt vmcnt(0)" ::: "memory")
__device__ __forceinline__ unsigned long long rt() { return __builtin_amdgcn_s_memrealtime(); }
__device__ __forceinline__ unsigned f2bf(float f) { unsigned u = __builtin_bit_cast(unsigned, f); return (u + 0x7fffu + ((u >> 16) & 1u)) >> 16; }
__device__ __forceinline__ unsigned pk2(float lo, float hi) { return f2bf(lo) | (f2bf(hi) << 16); }

#define XB_TMO      128
#define XB_XCNT(j)  (256  + 64 * (j))
#define XB_XSUB(j)  (1280 + 64 * (j))
#define XB_XGEN(j)  (2304 + 64 * (j))
#define XB_TOP      3328
#define XB_TOPGEN   3392
#define XCD_BAR_WORDS 3456
#define XB_SPIN_CAP (1u << 18)

__device__ __forceinline__ unsigned xb_ld(unsigned* p)              { return __hip_atomic_load(p, __ATOMIC_RELAXED, __HIP_MEMORY_SCOPE_AGENT); }
__device__ __forceinline__ unsigned xb_add(unsigned* p, unsigned v) { return __hip_atomic_fetch_add(p, v, __ATOMIC_RELAXED, __HIP_MEMORY_SCOPE_AGENT); }
__device__ __forceinline__ unsigned xb_xcc_id() { return (unsigned)__builtin_amdgcn_s_getreg((3 << 11) | 20) & 0xFu; }
#define XB_SPIN(cond, bar) do { unsigned _sp = 0; while (cond) { __builtin_amdgcn_s_sleep(1); \
    if ((++_sp & 255u) == 0u) { if (xb_ld(&(bar)[XB_TMO])) break; if (_sp > XB_SPIN_CAP) { atomicAdd(&(bar)[XB_TMO], 1u); break; } } } } while (0)

struct XcdBarrier {
    unsigned* bar; unsigned x; unsigned G;
    volatile LAS unsigned* st;
};

__device__ __forceinline__ XcdBarrier xcd_barrier_post(unsigned* bar, volatile LAS unsigned* st, unsigned G) {
    XcdBarrier b; b.bar = bar; b.x = xb_xcc_id(); b.st = st; b.G = G;
    if (threadIdx.x == 0) (void)xb_add(&bar[XB_XCNT(b.x)], 1u);
    return b;
}
__device__ __forceinline__ void xcd_barrier_complete(unsigned* bar, unsigned x, unsigned G, unsigned& nloc, unsigned& nx) {
    unsigned sum, cnt, mine, sp = 0u;
    for (;;) {
        sum = 0u; cnt = 0u; mine = 0u;
#pragma unroll
        for (unsigned j = 0; j < 16; ++j) { const unsigned c = xb_ld(&bar[XB_XCNT(j)]); sum += c; cnt += (c > 0u) ? 1u : 0u; mine = (j == x) ? c : mine; }
        if (sum == G) break;
        __builtin_amdgcn_s_sleep(1);
        if ((++sp & 255u) == 0u) { if (xb_ld(&bar[XB_TMO])) break; if (sp > XB_SPIN_CAP) { atomicAdd(&bar[XB_TMO], 1u); break; } }
    }
    nloc = mine > 0u ? mine : 1u; nx = cnt > 0u ? cnt : 1u;
}

__device__ __forceinline__ void xcd_barrier(const XcdBarrier& b) {
    asm volatile("s_waitcnt vmcnt(0)" ::: "memory");
    __syncthreads();
    if (threadIdx.x == 0) {
        unsigned* bar = b.bar;
        __builtin_amdgcn_s_waitcnt(0);
        unsigned nloc = b.st[0], nx = b.st[1];
        if (nloc == 0u) { xcd_barrier_complete(bar, b.x, b.G, nloc, nx); b.st[0] = nloc; b.st[1] = nx; }
        const unsigned old = xb_add(&bar[XB_XSUB(b.x)], 1u);
        const unsigned gen = old / nloc;
        if (old + 1u == (gen + 1u) * nloc) {
            __builtin_amdgcn_fence(__ATOMIC_RELEASE, "agent");
            asm volatile("s_waitcnt vmcnt(0)" ::: "memory");
            const unsigned og = xb_add(&bar[XB_TOP], 1u);
            const unsigned tg = og / nx;
            if (og + 1u == (tg + 1u) * nx) xb_add(&bar[XB_TOPGEN], 1u);
            else XB_SPIN(xb_ld(&bar[XB_TOPGEN]) == tg, bar);
            __builtin_amdgcn_fence(__ATOMIC_ACQUIRE, "agent");
            xb_add(&bar[XB_XGEN(b.x)], 1u);
            asm volatile("s_waitcnt vmcnt(0)" ::: "memory");
        } else {
            XB_SPIN(xb_ld(&bar[XB_XGEN(b.x)]) == gen, bar);
            __builtin_amdgcn_fence(__ATOMIC_ACQUIRE, "agent");
            asm volatile("s_waitcnt vmcnt(0)" ::: "memory");
        }
    }
    __syncthreads();
}

struct Frame {
    LAS unsigned char* lds;
    volatile LAS unsigned* MISC;
    gu32* ctl;
    int tid, lane, wave;
    int vcu, G;
    const float* in[26]; float* out; unsigned char* ws;
};
enum { I_X = 0, I_LN0G, I_LN0B, I_WIN, I_LBL, I_HGNG, I_ARE, I_AIM, I_LSTEP, I_BRE, I_BIM, I_CRE, I_CIM, I_DSK, I_WGLU, I_BGLU, I_WOUT, I_LN1G, I_LN1B, I_WQ, I_K1, I_K2, I_PD, I_PU, I_LN2G, I_LN2B };

typedef float f32x2 __attribute__((ext_vector_type(2)));
__device__ __forceinline__ float bf2f(bf16 v) { return __builtin_bit_cast(float, (unsigned)v << 16); }
__device__ __forceinline__ float wave_sum(float v) {
#pragma unroll
    for (int o = 1; o < 64; o <<= 1) v += __shfl_xor(v, o);
    return v;
}
__device__ __forceinline__ float wave_max(float v) {
#pragma unroll
    for (int o = 1; o < 64; o <<= 1) v = fmaxf(v, __shfl_xor(v, o));
    return v;
}
__device__ __forceinline__ float gelu_tanh(float x) { const float y = 0.7978845608028654f * (x + 0.044715f * x * x * x); return x / (1.f + __expf(-2.f * y)); }
__device__ __forceinline__ float silu_f(float x) { return x / (1.f + __expf(-x)); }
__device__ __forceinline__ void unpack8(const v4u w, float (&f)[8]) {
    f[0] = __builtin_bit_cast(float, w.x << 16); f[1] = __builtin_bit_cast(float, w.x & 0xffff0000u);
    f[2] = __builtin_bit_cast(float, w.y << 16); f[3] = __builtin_bit_cast(float, w.y & 0xffff0000u);
    f[4] = __builtin_bit_cast(float, w.z << 16); f[5] = __builtin_bit_cast(float, w.z & 0xffff0000u);
    f[6] = __builtin_bit_cast(float, w.w << 16); f[7] = __builtin_bit_cast(float, w.w & 0xffff0000u);
}
__device__ __forceinline__ v4u pack8(const float (&f)[8]) { v4u w; w.x = pk2(f[0], f[1]); w.y = pk2(f[2], f[3]); w.z = pk2(f[4], f[5]); w.w = pk2(f[6], f[7]); return w; }

__device__ __forceinline__ void fast_sincos(float x, float& sn, float& cs) {
    const float k = rintf(x * 0.15915494309189535f); float r = fmaf(-k, 6.28318548202514648f, x); r = fmaf(-k, -1.74845553146e-7f, r);
    sn = __sinf(r); cs = __cosf(r);
}
__device__ __forceinline__ void p0_transpose_item(const float* W, int K, int N, bf16* WT, int row_off, LAS float* scr, int item, int lane) {
    const int nblk = N / 32, kb = item / nblk, nb = item % nblk, k0 = 64 * kb, n0 = 32 * nb;
#pragma unroll 8
    for (int i = 0; i < 32; ++i) { const int kk = 2 * i + (lane >> 5); scr[kk * 33 + (lane & 31)] = W[(size_t)(k0 + kk) * N + n0 + (lane & 31)]; }
    LDS_WAIT(); asm volatile("" ::: "memory");
    const int c = lane & 7;
#pragma unroll
    for (int j = 0; j < 4; ++j) { const int n = (lane >> 3) + 8 * j; const LAS float* s = scr + (8 * c) * 33 + n;
        v4u o; o.x = pk2(s[0 * 33], s[1 * 33]); o.y = pk2(s[2 * 33], s[3 * 33]); o.z = pk2(s[4 * 33], s[5 * 33]); o.w = pk2(s[6 * 33], s[7 * 33]);
        *(GAS v4u*)(WT + (size_t)(row_off + n0 + n) * K + k0 + 8 * c) = o; }
    LDS_WAIT(); asm volatile("" ::: "memory");
}
__device__ __forceinline__ void ln0_row(const float* xrow, const float* g, const float* b, bf16* orow, int lane) {
    const GAS f32x4* xr = (const GAS f32x4*)xrow + lane;
    f32x4 v[4]; float s = 0.f;
#pragma unroll
    for (int j = 0; j < 4; ++j) { v[j] = xr[64 * j]; s += (v[j].x + v[j].y) + (v[j].z + v[j].w); }
    const float mean = wave_sum(s) * (1.f / D); float s2 = 0.f;
#pragma unroll
    for (int j = 0; j < 4; ++j) { v[j] = v[j] - mean; s2 += (v[j].x * v[j].x + v[j].y * v[j].y) + (v[j].z * v[j].z + v[j].w * v[j].w); }
    const float rstd = 1.f / sqrtf(wave_sum(s2) * (1.f / D) + LN_EPS);
    GAS unsigned long long* o8 = (GAS unsigned long long*)orow + lane;
#pragma unroll
    for (int j = 0; j < 4; ++j) { const f32x4 gg = ((const GAS f32x4*)g)[lane + 64 * j], bb = ((const GAS f32x4*)b)[lane + 64 * j];
        const f32x4 o = v[j] * rstd * gg + bb;
        o8[64 * j] = (unsigned long long)pk2(o.x, o.y) | ((unsigned long long)pk2(o.z, o.w) << 32); }
}
__device__ __forceinline__ void p0_prologue(Frame& F) {
    LAS float* scr = (LAS float*)(F.lds + RING_OFF + F.wave * 16384);
    const int gw = F.vcu * NWAVES + F.wave, NGW = F.G * NWAVES;
    unsigned char* ws = F.ws;
    constexpr int I_IN = (D / 64) * (NPROJ / 32), I_GLU = (512 / 64) * (512 / 32), I_OUT = (1024 / 64) * (1024 / 32), I_Q = (1024 / 64) * (2048 / 32);
    constexpr int NITEMS = I_IN + I_GLU + I_OUT + I_Q;
    for (int it = gw; it < NITEMS; it += NGW) {
        int r = it;
        if (r < I_IN) { p0_transpose_item(F.in[I_WIN], D, NPROJ, (bf16*)(ws + WS_WIN), 0, scr, r, F.lane); continue; } r -= I_IN;
        if (r < I_GLU) { p0_transpose_item(F.in[I_WGLU], 512, 512, (bf16*)(ws + WS_WGLU), 0, scr, r, F.lane); continue; } r -= I_GLU;
        if (r < I_OUT) { p0_transpose_item(F.in[I_WOUT], 1024, 1024, (bf16*)(ws + WS_WOUT), 0, scr, r, F.lane); continue; } r -= I_OUT;
        p0_transpose_item(F.in[I_WQ], 1024, 2048, (bf16*)(ws + WS_WQ), 0, scr, r, F.lane);
    }
    const int gt = gw * 64 + F.lane, NGT = NGW * 64;
    for (int i = ((gt - 68608) % NGT + NGT) % NGT; i < 2 * PK * PHALF; i += NGT) { const float v = (i < PK * PHALF) ? F.in[I_K1][i] : F.in[I_K2][i - PK * PHALF]; ((bf16*)(ws + WS_KEYS))[i] = (bf16)f2bf(v); }
    for (int i = ((gt - 104448) % NGT + NGT) % NGT; i < HGW; i += NGT) { const float l0 = F.in[I_LBL][i], l1 = F.in[I_LBL][HGW + i]; ((float*)(ws + WS_LB))[i] = 1.f / (1.f + expf(l1 - l0)); }
    for (int i = ((gt - 102400) % NGT + NGT) % NGT; i < S5G * S5N; i += NGT) { const int g = i / S5N;
        const float are = F.in[I_ARE][i], aim = F.in[I_AIM][i], step = expf(F.in[I_LSTEP][g]);
        const float zr = step * are, zi = step * aim, mag = expf(zr); float cz, sz, sh, ch; fast_sincos(zi, sz, cz); fast_sincos(0.5f * zi, sh, ch);
        const float abr = mag * cz, abi = mag * sz;
        const float nre = expm1f(zr) * cz - 2.f * sh * sh, nim = abi;
        const float den = are * are + aim * aim;
        const float cre = (nre * are + nim * aim) / den, cim = (nim * are - nre * aim) / den;
        f32x4 brv[4], biv[4];
#pragma unroll
        for (int p4 = 0; p4 < 4; ++p4) { brv[p4] = *(const GAS f32x4*)(F.in[I_BRE] + (size_t)i * S5P + 4 * p4); biv[p4] = *(const GAS f32x4*)(F.in[I_BIM] + (size_t)i * S5P + 4 * p4); }
        float* t = (float*)(ws + WS_S5T) + (size_t)i * 40; *(GAS f32x2*)t = (f32x2){abr, abi};
#pragma unroll
        for (int p4 = 0; p4 < 4; ++p4) { const f32x4 br = brv[p4], bi = biv[p4];
            *(GAS f32x2*)(t + 2 + 4 * p4) = (f32x2){cre * br.x - cim * bi.x, cre * br.y - cim * bi.y}; *(GAS f32x2*)(t + 4 + 4 * p4) = (f32x2){cre * br.z - cim * bi.z, cre * br.w - cim * bi.w};
            *(GAS f32x2*)(t + 18 + 4 * p4) = (f32x2){cre * bi.x + cim * br.x, cre * bi.y + cim * br.y}; *(GAS f32x2*)(t + 20 + 4 * p4) = (f32x2){cre * bi.z + cim * br.z, cre * bi.w + cim * br.w}; } }
    for (int i = gt; i < S5G * S5N * 33; i += NGT) { const int gn = i / 33, tau = i % 33, g = gn / S5N;
        const float step = expf(F.in[I_LSTEP][g]), zr = step * F.in[I_ARE][gn] * (float)tau, zi = step * F.in[I_AIM][gn] * (float)tau, mag = expf(zr);
        float sn, cs; fast_sincos(zi, sn, cs); *(GAS f32x2*)((float*)(ws + WS_PW) + (size_t)i * 2) = (f32x2){mag * cs, mag * sn}; }
    f32x4 gg[4], bb[4];
#pragma unroll
    for (int j = 0; j < 4; ++j) { gg[j] = ((const GAS f32x4*)F.in[I_LN0G])[F.lane + 64 * j]; bb[j] = ((const GAS f32x4*)F.in[I_LN0B])[F.lane + 64 * j]; }
    f32x4 nv[4][4];
    { const int m0 = gw * 4;
#pragma unroll
      for (int r = 0; r < 4; ++r)
#pragma unroll
          for (int j = 0; j < 4; ++j) nv[r][j] = ((const GAS f32x4*)(F.in[I_X] + (size_t)(m0 + r) * D))[F.lane + 64 * j]; }
    for (int m0 = gw * 4; m0 < M; m0 += NGW * 4) {
        f32x4 v[4][4];
#pragma unroll
        for (int r = 0; r < 4; ++r)
#pragma unroll
            for (int j = 0; j < 4; ++j) v[r][j] = nv[r][j];
        if (m0 + NGW * 4 < M) {
#pragma unroll
            for (int r = 0; r < 4; ++r)
#pragma unroll
                for (int j = 0; j < 4; ++j) nv[r][j] = ((const GAS f32x4*)(F.in[I_X] + (size_t)(m0 + NGW * 4 + r) * D))[F.lane + 64 * j]; }
#pragma unroll
        for (int r = 0; r < 4; ++r) { float sm = 0.f;
#pragma unroll
            for (int j = 0; j < 4; ++j) sm += (v[r][j].x + v[r][j].y) + (v[r][j].z + v[r][j].w);
            const float mean = wave_sum(sm) * (1.f / D); float s2 = 0.f;
#pragma unroll
            for (int j = 0; j < 4; ++j) { v[r][j] = v[r][j] - mean; s2 += (v[r][j].x * v[r][j].x + v[r][j].y * v[r][j].y) + (v[r][j].z * v[r][j].z + v[r][j].w * v[r][j].w); }
            const float rstd = 1.f / sqrtf(wave_sum(s2) * (1.f / D) + LN_EPS);
            GAS unsigned long long* o8 = (GAS unsigned long long*)((bf16*)(ws + WS_H) + (size_t)(m0 + r) * D) + F.lane;
#pragma unroll
            for (int j = 0; j < 4; ++j) { const f32x4 o = v[r][j] * rstd * gg[j] + bb[j]; o8[64 * j] = (unsigned long long)pk2(o.x, o.y) | ((unsigned long long)pk2(o.z, o.w) << 32); } }
    }
}

__device__ __forceinline__ int t256(int r, int c) { return r * 256 + ((((c >> 3) ^ (r & 15))) << 4) + (c & 7) * 2; }
__device__ __forceinline__ int t128(int r, int c) { return r * 128 + ((((c >> 3) ^ (r & 7))) << 4) + (c & 7) * 2; }
typedef unsigned v2u __attribute__((ext_vector_type(2)));
__device__ __forceinline__ unsigned offb(unsigned row, unsigned ch) { return 256u * row + 16u * (ch ^ (((row & 3u) << 2) | ((row >> 2) & 3u))); }
typedef short v4i16_t __attribute__((ext_vector_type(4)));
__device__ __forceinline__ bf16x8 tr_frag16(LAS unsigned char* tile, int lane, int c, int ks) {
    const unsigned g = lane >> 4, q = (lane & 15) >> 2, p = lane & 3;
    const v4i16_t lo = __builtin_amdgcn_ds_read_tr16_b64_v4i16((LAS v4i16_t*)(tile + offb(32 * ks + 8 * g + q, 2 * c + (p >> 1)) + 8 * (p & 1)));
    const v4i16_t hi = __builtin_amdgcn_ds_read_tr16_b64_v4i16((LAS v4i16_t*)(tile + offb(32 * ks + 8 * g + 4 + q, 2 * c + (p >> 1)) + 8 * (p & 1)));
    bf16x8 r; r[0] = lo[0]; r[1] = lo[1]; r[2] = lo[2]; r[3] = lo[3]; r[4] = hi[0]; r[5] = hi[1]; r[6] = hi[2]; r[7] = hi[3]; return r;
}
__device__ __forceinline__ void hgrn2_state_pass(Frame& F, int item) {
    const int bh = item >> 2, ksl = item & 3, b = bh >> 2, h = bh & 3, tid = F.tid, lane = F.lane, w = F.wave, fr = lane & 15, fq = lane >> 4;
    const int kcol = tid & 31, sg = tid >> 5;
    LAS unsigned char* L = F.lds + RING_OFF;
    LAS unsigned char* sRaw = L + 49152;
    const bf16* LFg = (const bf16*)(F.ws + WS_PROJ) + (size_t)M * 512 + (size_t)b * SEQ * 512 + h * 128 + ksl * 32;
    const bf16* Vg = (const bf16*)(F.ws + WS_PROJ) + (size_t)2 * M * 512 + (size_t)b * SEQ * 512 + h * 128;
    bf16* SST = (bf16*)(F.ws + WS_SST) + (size_t)bh * 64 * 128 * 128 + ksl * 32;
    float S[2][4];
#pragma unroll
    for (int i = 0; i < 2; ++i)
#pragma unroll
        for (int r = 0; r < 4; ++r) S[i][r] = 0.f;
    const int ls = (tid & 255) >> 2, lkg = tid & 3;
    const int vs0 = tid >> 4, vch = tid & 15;
    v4u nlf = *(const GAS v4u*)(LFg + (size_t)ls * 512 + lkg * 8);
    v4u nv0 = *(const GAS v4u*)(Vg + (size_t)vs0 * 512 + vch * 8), nv1 = *(const GAS v4u*)(Vg + (size_t)(32 + vs0) * 512 + vch * 8);
    v4u n2lf = *(const GAS v4u*)(LFg + (size_t)(64 + ls) * 512 + lkg * 8);
    v4u n2v0 = *(const GAS v4u*)(Vg + (size_t)(64 + vs0) * 512 + vch * 8), n2v1 = *(const GAS v4u*)(Vg + (size_t)(96 + vs0) * 512 + vch * 8);
    v4u n3lf = *(const GAS v4u*)(LFg + (size_t)(128 + ls) * 512 + lkg * 8);
    v4u n3v0 = *(const GAS v4u*)(Vg + (size_t)(128 + vs0) * 512 + vch * 8), n3v1 = *(const GAS v4u*)(Vg + (size_t)(160 + vs0) * 512 + vch * 8);
    for (int c = 0; c < 64; ++c) {
        LAS unsigned char* Lb = L + (c & 1) * 24576;
        LAS unsigned char* sKT = Lb; LAS unsigned char* sVT = Lb + 4096; LAS float* sTot = (LAS float*)(Lb + 20480); LAS float* sDec = (LAS float*)(Lb + 22528);
        if (tid < 256) *(LAS v4u*)(sRaw + ls * 64 + lkg * 16) = nlf;
        *(LAS v4u*)(sVT + offb(vs0, vch)) = nv0; *(LAS v4u*)(sVT + offb(32 + vs0, vch)) = nv1;
        nlf = n2lf; nv0 = n2v0; nv1 = n2v1; n2lf = n3lf; n2v0 = n3v0; n2v1 = n3v1;
        if (c + 3 < 64) { const size_t t3 = (size_t)(c + 3) * 64;
            n3lf = *(const GAS v4u*)(LFg + (t3 + ls) * 512 + lkg * 8); n3v0 = *(const GAS v4u*)(Vg + (t3 + vs0) * 512 + vch * 8); n3v1 = *(const GAS v4u*)(Vg + (t3 + 32 + vs0) * 512 + vch * 8); }
        __syncthreads();
        float lf[4];
#pragma unroll
        for (int j = 0; j < 4; ++j) lf[j] = bf2f(*(const LAS bf16*)(sRaw + (sg * 4 + j) * 64 + kcol * 2));
        float cl[4]; float run = 0.f;
#pragma unroll
        for (int j = 0; j < 4; ++j) { run += lf[j]; cl[j] = run; }
        sTot[sg * 32 + kcol] = run;
        __syncthreads();
        float off = 0.f, last = 0.f;
#pragma unroll
        for (int q = 0; q < 16; ++q) { const float tq = sTot[q * 32 + kcol]; off += (q < sg) ? tq : 0.f; last += tq; }
        float kh[4];
#pragma unroll
        for (int j = 0; j < 4; ++j) kh[j] = (1.f - __expf(lf[j])) * __expf(last - (off + cl[j]));
        { v2u pk; pk.x = pk2(kh[0], kh[1]); pk.y = pk2(kh[2], kh[3]);
          *(LAS v2u*)(sKT + kcol * 128 + ((((sg >> 1) ^ (kcol & 7))) << 4) + (sg & 1) * 8) = pk; }
        if (sg == 0) sDec[kcol] = __expf(last);
        __syncthreads();
        f32x4 acc[2] = {(f32x4){0.f, 0.f, 0.f, 0.f}, (f32x4){0.f, 0.f, 0.f, 0.f}};
        const int mt = w & 1, nt0 = (w >> 1) * 2;
#pragma unroll
        for (int ks = 0; ks < 2; ++ks) { const int ch = ks * 4 + fq, row = 16 * mt + fr;
            const bf16x8 af = *(const LAS bf16x8*)(sKT + row * 128 + ((ch ^ (row & 7)) << 4));
#pragma unroll
            for (int nt = 0; nt < 2; ++nt) { const bf16x8 bfm = tr_frag16(sVT, lane, nt0 + nt, ks);
                acc[nt] = __builtin_amdgcn_mfma_f32_16x16x32_bf16(af, bfm, acc[nt], 0, 0, 0); } }
        const int k0 = 16 * mt + fq * 4; const f32x4 dec = *(const LAS f32x4*)(sDec + k0);
#pragma unroll
        for (int nt = 0; nt < 2; ++nt) { const int vg = 16 * (nt0 + nt) + fr;
            v2u o; o.x = pk2(S[nt][0], S[nt][1]); o.y = pk2(S[nt][2], S[nt][3]);
            *(GAS v2u*)(SST + ((size_t)c * 128 + vg) * 128 + k0) = o;
            S[nt][0] = dec[0] * S[nt][0] + acc[nt][0]; S[nt][1] = dec[1] * S[nt][1] + acc[nt][1]; S[nt][2] = dec[2] * S[nt][2] + acc[nt][2]; S[nt][3] = dec[3] * S[nt][3] + acc[nt][3]; }
    }
    __syncthreads();
}
struct HgOutRegs { v4u lf[2], q[2], v[2], st[4]; };
__device__ __forceinline__ void hgrn2_out_load(Frame& F, int item, HgOutRegs& R) {
    const int bh = item >> 6, c = item & 63, b = bh >> 2, h = bh & 3, tid = F.tid;
    const size_t tok0 = (size_t)b * SEQ + (size_t)c * 64;
    const bf16* Qb = (const bf16*)(F.ws + WS_PROJ) + tok0 * 512 + h * 128; const bf16* LFb = Qb + (size_t)M * 512; const bf16* Vb = Qb + (size_t)2 * M * 512;
    const bf16* SST = (const bf16*)(F.ws + WS_SST) + (size_t)item * 128 * 128;
#pragma unroll
    for (int i = 0; i < 2; ++i) { const int idx = tid + 512 * i, sr = idx >> 4, ch = idx & 15;
        R.lf[i] = *(const GAS v4u*)(LFb + (size_t)sr * 512 + ch * 8); R.q[i] = *(const GAS v4u*)(Qb + (size_t)sr * 512 + ch * 8); R.v[i] = *(const GAS v4u*)(Vb + (size_t)sr * 512 + ch * 8); }
#pragma unroll
    for (int i = 0; i < 4; ++i) { const int idx = tid + 512 * i; R.st[i] = *(const GAS v4u*)(SST + (size_t)(idx >> 4) * 128 + (idx & 15) * 8); }
}
__device__ __forceinline__ void hgrn2_out_phase(Frame& F) {
    const int tid = F.tid, lane = F.lane, w = F.wave, fr = lane & 15, fq = lane >> 4;
    const int kcol = tid & 127, qtr = tid >> 7;
    LAS unsigned char* L = F.lds + RING_OFF;
    LAS unsigned char* sQt = L; LAS unsigned char* sQm = L + 16384; LAS unsigned char* sKm = L + 32768; LAS unsigned char* sV = L + 49152; LAS unsigned char* sST = L + 65536; LAS unsigned char* sP = L + 98304;
    LAS float* sTot = (LAS float*)(L + 106496); LAS float* sSS = (LAS float*)(L + 108544);
    LAS unsigned char* rLF = L + 110592; LAS unsigned char* rQ = L + 126976;
    HgOutRegs R;
    int item = F.vcu;
    if (item < 32 * 64) hgrn2_out_load(F, item, R);
    for (; item < 32 * 64; item += F.G) {
        const int bh = item >> 6, c = item & 63, b = bh >> 2, h = bh & 3;
        const size_t tok0 = (size_t)b * SEQ + (size_t)c * 64;
        const bf16* Gb = (const bf16*)(F.ws + WS_PROJ) + (size_t)3 * M * 512 + tok0 * 512 + h * 128;
        bf16* MIX = (bf16*)(F.ws + WS_MIX) + tok0 * 1024 + h * 128;
#pragma unroll
        for (int i = 0; i < 2; ++i) { const int idx = tid + 512 * i, sr = idx >> 4, ch = idx & 15;
            *(LAS v4u*)(rLF + sr * 256 + ch * 16) = R.lf[i]; *(LAS v4u*)(rQ + sr * 256 + ch * 16) = R.q[i]; *(LAS v4u*)(sV + offb(sr, ch)) = R.v[i]; }
#pragma unroll
        for (int i = 0; i < 4; ++i) { const int idx = tid + 512 * i, v = idx >> 4, kc = idx & 15; *(LAS v4u*)(sST + v * 256 + ((kc ^ (v & 15)) << 4)) = R.st[i]; }
        if (item + F.G < 32 * 64) hgrn2_out_load(F, item + F.G, R);
        __syncthreads();
        float lf[16], q[16];
#pragma unroll
        for (int j = 0; j < 16; ++j) { lf[j] = bf2f(*(const LAS bf16*)(rLF + (qtr * 16 + j) * 256 + kcol * 2)); q[j] = bf2f(*(const LAS bf16*)(rQ + (qtr * 16 + j) * 256 + kcol * 2)); }
        float cl[16]; float run = 0.f;
#pragma unroll
        for (int j = 0; j < 16; ++j) { run += lf[j]; cl[j] = run; }
        sTot[qtr * 128 + kcol] = run;
        __syncthreads();
        { const float t0 = sTot[kcol], t1 = sTot[128 + kcol], t2 = sTot[256 + kcol];
          const float off = (qtr > 0 ? t0 : 0.f) + (qtr > 1 ? t1 : 0.f) + (qtr > 2 ? t2 : 0.f), mid = t0 + t1;
#pragma unroll
          for (int j = 0; j < 16; ++j) { const int sdx = qtr * 16 + j; const float cum = off + cl[j];
              const int o = t256(sdx, kcol);
              *(LAS bf16*)(sQt + o) = (bf16)f2bf(q[j] * __expf(cum));
              *(LAS bf16*)(sQm + o) = (bf16)f2bf(q[j] * __expf(cum - mid));
              *(LAS bf16*)(sKm + o) = (bf16)f2bf((1.f - __expf(lf[j])) * __expf(mid - cum)); } }
        __syncthreads();
        const int tt = w >> 1, trow = 16 * tt + fr;
        v2u gpre[4];
#pragma unroll
        for (int i = 0; i < 4; ++i) gpre[i] = *(const GAS v2u*)(Gb + (size_t)trow * 512 + 16 * ((w & 1) * 4 + i) + fq * 4);
#pragma unroll
        for (int sti = 0; sti < 2; ++sti) { const int stl = (w & 1) * 2 + sti; f32x4 acc = (f32x4){0.f, 0.f, 0.f, 0.f};
            if (stl <= tt) {
#pragma unroll
                for (int ks = 0; ks < 4; ++ks) { const int ch = ks * 4 + fq, srow = 16 * stl + fr;
                    const bf16x8 af = *(const LAS bf16x8*)(sKm + srow * 256 + ((ch ^ (srow & 15)) << 4));
                    const bf16x8 bfm = *(const LAS bf16x8*)(sQm + trow * 256 + ((ch ^ (trow & 15)) << 4));
                    acc = __builtin_amdgcn_mfma_f32_16x16x32_bf16(af, bfm, acc, 0, 0, 0); } }
            const int s0 = 16 * stl + fq * 4;
            const float p0 = (s0 + 0 <= trow) ? acc[0] : 0.f, p1 = (s0 + 1 <= trow) ? acc[1] : 0.f, p2 = (s0 + 2 <= trow) ? acc[2] : 0.f, p3 = (s0 + 3 <= trow) ? acc[3] : 0.f;
            v2u o; o.x = pk2(p0, p1); o.y = pk2(p2, p3);
            *(LAS v2u*)(sP + trow * 128 + ((((s0 >> 3) ^ (trow & 7))) << 4) + (s0 & 7) * 2) = o; }
        __syncthreads();
        f32x4 oacc[4];
#pragma unroll
        for (int i = 0; i < 4; ++i) oacc[i] = (f32x4){0.f, 0.f, 0.f, 0.f};
#pragma unroll
        for (int ks = 0; ks < 4; ++ks) { const int ch = ks * 4 + fq;
            const bf16x8 bfm = *(const LAS bf16x8*)(sQt + trow * 256 + ((ch ^ (trow & 15)) << 4));
#pragma unroll
            for (int i = 0; i < 4; ++i) { const int vr = 16 * ((w & 1) * 4 + i) + fr; const bf16x8 af = *(const LAS bf16x8*)(sST + vr * 256 + ((ch ^ (vr & 15)) << 4));
                oacc[i] = __builtin_amdgcn_mfma_f32_16x16x32_bf16(af, bfm, oacc[i], 0, 0, 0); } }
#pragma unroll
        for (int ks = 0; ks < 2; ++ks) { const int ch = ks * 4 + fq;
            const bf16x8 bfm = *(const LAS bf16x8*)(sP + trow * 128 + ((ch ^ (trow & 7)) << 4));
#pragma unroll
            for (int i = 0; i < 4; ++i) { const bf16x8 af = tr_frag16(sV, lane, (w & 1) * 4 + i, ks);
                oacc[i] = __builtin_amdgcn_mfma_f32_16x16x32_bf16(af, bfm, oacc[i], 0, 0, 0); } }
        float ss = 0.f;
#pragma unroll
        for (int i = 0; i < 4; ++i) ss += (oacc[i][0] * oacc[i][0] + oacc[i][1] * oacc[i][1]) + (oacc[i][2] * oacc[i][2] + oacc[i][3] * oacc[i][3]);
        ss += __shfl_xor(ss, 16); ss += __shfl_xor(ss, 32);
        if (fq == 0) sSS[(w & 1) * 64 + trow] = ss;
        __syncthreads();
        const float rinv = 1.f / sqrtf((sSS[trow] + sSS[64 + trow]) * (1.f / 128.f) + RMS_EPS);
#pragma unroll
        for (int i = 0; i < 4; ++i) { const int v0 = 16 * ((w & 1) * 4 + i) + fq * 4;
            const v2u gw2 = gpre[i]; const f32x4 ng = *(const GAS f32x4*)(F.in[I_HGNG] + v0);
            const float g0 = __builtin_bit_cast(float, gw2.x << 16), g1 = __builtin_bit_cast(float, gw2.x & 0xffff0000u), g2 = __builtin_bit_cast(float, gw2.y << 16), g3 = __builtin_bit_cast(float, gw2.y & 0xffff0000u);
            v2u o; o.x = pk2(oacc[i][0] * rinv * ng[0] * silu_f(g0), oacc[i][1] * rinv * ng[1] * silu_f(g1)); o.y = pk2(oacc[i][2] * rinv * ng[2] * silu_f(g2), oacc[i][3] * rinv * ng[3] * silu_f(g3));
            *(GAS v2u*)(MIX + (size_t)trow * 1024 + v0) = o; }
        __syncthreads();
    }
}

__device__ __forceinline__ void s5_tables_stage1(Frame& F) {
    const int gt = (F.vcu * NWAVES + F.wave) * 64 + F.lane, NGT = F.G * NWAVES * 64;
    const float* S5T = (const float*)(F.ws + WS_S5T); const float* PW = (const float*)(F.ws + WS_PW);
    float* KT = (float*)(F.ws + WS_KTAU); bf16* G5 = (bf16*)(F.ws + WS_G5); bf16* T5 = (bf16*)(F.ws + WS_T5);
    for (int i = gt; i < S5G * 32 * 256; i += NGT) { const int g = i >> 13, tau = (i >> 8) & 31, p = (i >> 4) & 15, q = i & 15;
        float acc = (tau == 0 && p == q) ? F.in[I_DSK][g * 16 + p] : 0.f;
#pragma unroll 16
        for (int n = 0; n < S5N; ++n) { const int gn = g * S5N + n;
            const float cr = F.in[I_CRE][(size_t)(g * 16 + p) * S5N + n], ci = F.in[I_CIM][(size_t)(g * 16 + p) * S5N + n];
            const float wr = PW[((size_t)gn * 33 + tau) * 2], wi = PW[((size_t)gn * 33 + tau) * 2 + 1];
            const float br = S5T[(size_t)gn * 40 + 2 + q], bi = S5T[(size_t)gn * 40 + 18 + q];
            const float er = cr * wr - ci * wi, ei = cr * wi + ci * wr;
            acc += er * br - ei * bi; }
        KT[i] = acc; }
    for (int i = gt; i < S5G * 256 * 64; i += NGT) { const int g = i >> 14, r = (i >> 6) & 255, kc = i & 63, sdx = kc >> 1, q0 = (kc & 1) * 8;
        float f[8];
        if (r < 128) { const int n = r & 63, gn = g * S5N + n; const float wr = PW[((size_t)gn * 33 + (31 - sdx)) * 2], wi = PW[((size_t)gn * 33 + (31 - sdx)) * 2 + 1];
#pragma unroll
            for (int j = 0; j < 8; ++j) { const float br = S5T[(size_t)gn * 40 + 2 + q0 + j], bi = S5T[(size_t)gn * 40 + 18 + q0 + j]; f[j] = (r < 64) ? (wr * br - wi * bi) : (wr * bi + wi * br); }
        } else {
#pragma unroll
            for (int j = 0; j < 8; ++j) f[j] = 0.f; }
        *(GAS v4u*)(G5 + ((size_t)(g * 256 + r)) * 512 + kc * 8) = pack8(f); }
    for (int i = gt; i < S5G * 512 * 16; i += NGT) { const int g = i >> 13, row = (i >> 4) & 511, nc = i & 15, t = row >> 4, p = row & 15, im = nc >> 3, n0 = (nc & 7) * 8;
        float f[8];
#pragma unroll
        for (int j = 0; j < 8; ++j) { const int n = n0 + j, gn = g * S5N + n;
            const float cr = F.in[I_CRE][(size_t)(g * 16 + p) * S5N + n], ci = F.in[I_CIM][(size_t)(g * 16 + p) * S5N + n];
            const float wr = PW[((size_t)gn * 33 + t + 1) * 2], wi = PW[((size_t)gn * 33 + t + 1) * 2 + 1];
            f[j] = im ? -(cr * wi + ci * wr) : (cr * wr - ci * wi); }
        *(GAS v4u*)(T5 + ((size_t)(g * 512 + row)) * 640 + 512 + nc * 8) = pack8(f); }
}
__device__ __forceinline__ void s5_tables_stage2(Frame& F) {
    const int gt = (F.vcu * NWAVES + F.wave) * 64 + F.lane, NGT = F.G * NWAVES * 64;
    const float* KT = (const float*)(F.ws + WS_KTAU); bf16* T5 = (bf16*)(F.ws + WS_T5);
    for (int i = gt; i < S5G * 512 * 64; i += NGT) { const int g = i >> 15, row = (i >> 6) & 511, kc = i & 63, t = row >> 4, p = row & 15, sdx = kc >> 1, q0 = (kc & 1) * 8;
        float f[8];
        if (sdx <= t) { const float* k = KT + (((size_t)g * 32 + (t - sdx)) * 16 + p) * 16 + q0;
#pragma unroll
            for (int j = 0; j < 8; ++j) f[j] = k[j];
        } else {
#pragma unroll
            for (int j = 0; j < 8; ++j) f[j] = 0.f; }
        *(GAS v4u*)(T5 + ((size_t)(g * 512 + row)) * 640 + kc * 8) = pack8(f); }
}
__device__ __forceinline__ void s5_scan(Frame& F, int idx) {
    const int b = idx >> 11, g = (idx >> 6) & 31, n = idx & 63;
    const float* PW = (const float*)(F.ws + WS_PW); const float* XL = (const float*)(F.ws + WS_XLOC); bf16* A5 = (bf16*)(F.ws + WS_A5);
    const float ar = PW[((size_t)(g * S5N + n) * 33 + 32) * 2], ai = PW[((size_t)(g * S5N + n) * 33 + 32) * 2 + 1];
    float xr = 0.f, xi = 0.f;
    for (int c0 = 0; c0 < 128; c0 += 32) {
        float lr[32], li[32];
#pragma unroll
        for (int j = 0; j < 32; ++j) { const float* p = XL + ((size_t)(b * 128 + c0 + j) * 32 + g) * 128 + n; lr[j] = p[0]; li[j] = p[64]; }
#pragma unroll
        for (int j = 0; j < 32; ++j) { bf16* o = A5 + ((size_t)g * S5I + b * 128 + c0 + j) * 640 + 512 + n; o[0] = (bf16)f2bf(xr); o[64] = (bf16)f2bf(xi);
            const float nr = ar * xr - ai * xi + lr[j], ni = ar * xi + ai * xr + li[j]; xr = nr; xi = ni; }
    }
}

__device__ __forceinline__ void ln1_row(bf16* row, const float* g, const float* b, int lane) {
    const v4u w0 = *(const GAS v4u*)(row + lane * 8), w1 = *(const GAS v4u*)(row + 512 + lane * 8);
    float a[8], c[8]; unpack8(w0, a); unpack8(w1, c);
    float s = 0.f;
#pragma unroll
    for (int j = 0; j < 8; ++j) s += a[j] + c[j];
    const float mean = wave_sum(s) * (1.f / D); float s2 = 0.f;
#pragma unroll
    for (int j = 0; j < 8; ++j) { a[j] -= mean; c[j] -= mean; s2 += a[j] * a[j] + c[j] * c[j]; }
    const float rstd = 1.f / sqrtf(wave_sum(s2) * (1.f / D) + LN_EPS);
    const f32x4 g0 = *(const GAS f32x4*)(g + lane * 8), g1 = *(const GAS f32x4*)(g + lane * 8 + 4), g2 = *(const GAS f32x4*)(g + 512 + lane * 8), g3 = *(const GAS f32x4*)(g + 512 + lane * 8 + 4);
    const f32x4 b0 = *(const GAS f32x4*)(b + lane * 8), b1 = *(const GAS f32x4*)(b + lane * 8 + 4), b2 = *(const GAS f32x4*)(b + 512 + lane * 8), b3 = *(const GAS f32x4*)(b + 512 + lane * 8 + 4);
    const float gg0[8] = {g0.x, g0.y, g0.z, g0.w, g1.x, g1.y, g1.z, g1.w}, gg1[8] = {g2.x, g2.y, g2.z, g2.w, g3.x, g3.y, g3.z, g3.w};
    const float bb0[8] = {b0.x, b0.y, b0.z, b0.w, b1.x, b1.y, b1.z, b1.w}, bb1[8] = {b2.x, b2.y, b2.z, b2.w, b3.x, b3.y, b3.z, b3.w};
#pragma unroll
    for (int j = 0; j < 8; ++j) { a[j] = a[j] * rstd * gg0[j] + bb0[j]; c[j] = c[j] * rstd * gg1[j] + bb1[j]; }
    *(GAS v4u*)(row + lane * 8) = pack8(a); *(GAS v4u*)(row + 512 + lane * 8) = pack8(c);
}

typedef float f32x16 __attribute__((ext_vector_type(16)));
__device__ __forceinline__ int f2ord(float f) { const int x = __builtin_bit_cast(int, f); return x ^ ((x >> 31) & 0x7fffffff); }
__device__ __forceinline__ float ord2f(int x) { return __builtin_bit_cast(float, x ^ ((x >> 31) & 0x7fffffff)); }
#define CE_DESC(a, b) do { const int _h = max((a), (b)), _l = min((a), (b)); (a) = _h; (b) = _l; } while (0)
__device__ __forceinline__ void sort16_desc(int (&v)[16]) {
#pragma unroll
    for (int k = 2; k <= 16; k <<= 1)
#pragma unroll
        for (int j = k >> 1; j > 0; j >>= 1)
#pragma unroll
            for (int i = 0; i < 16; ++i) { const int l = i ^ j; if (l > i) { if ((i & k) == 0) CE_DESC(v[i], v[l]); else CE_DESC(v[l], v[i]); } }
}
__device__ __forceinline__ void merge16_desc(int (&a)[16], const int (&b)[16]) {
#pragma unroll
    for (int i = 0; i < 16; ++i) a[i] = max(a[i], b[15 - i]);
#pragma unroll
    for (int j = 8; j > 0; j >>= 1)
#pragma unroll
        for (int i = 0; i < 16; ++i) { const int l = i ^ j; if (l > i) CE_DESC(a[i], a[l]); }
}
__device__ __forceinline__ void peer_topk_side(const f32x16 (&acc)[4], int hi, int (&top)[16]) {
    int t[4][16];
#pragma unroll
    for (int kt = 0; kt < 4; ++kt)
#pragma unroll
        for (int j = 0; j < 16; ++j) { const unsigned key = (unsigned)(kt * 32 + (j & 3) + 8 * (j >> 2)) | (unsigned)(4 * hi);
            const float av = acc[kt][j];
            t[kt][j] = f2ord(__builtin_bit_cast(float, (__builtin_bit_cast(unsigned, av) & 0xFFFFFF80u) | key)); }
    sort16_desc(t[0]); sort16_desc(t[1]); sort16_desc(t[2]); sort16_desc(t[3]);
    merge16_desc(t[0], t[1]); merge16_desc(t[2], t[3]); merge16_desc(t[0], t[2]);
    int p[16];
#pragma unroll
    for (int i = 0; i < 16; ++i) p[i] = __shfl_xor(t[0][i], 32);
    merge16_desc(t[0], p);
#pragma unroll
    for (int i = 0; i < 16; ++i) top[i] = t[0][i];
}
__device__ __forceinline__ void peer_score_phase(Frame& F, const pg8::StaticOrder& SO) {
    LAS unsigned char* kl = F.lds + RING_OFF;
    LAS unsigned* look = (LAS unsigned*)(F.lds + RING_OFF + 65536 + F.wave * 8192);
    const bf16* keys = (const bf16*)(F.ws + WS_KEYS);
    for (int i = F.tid; i < 2 * 128 * 16; i += NWAVES * 64) { const int sn = i >> 4, c = i & 15, n = sn & 127;
        *(LAS v4u*)(kl + sn * 256 + ((c ^ (n & 15)) << 4)) = *(const GAS v4u*)(keys + (size_t)sn * 128 + c * 8); }
    __syncthreads();
    const int lane = F.lane, r32 = lane & 31, hi = lane >> 5;
    const bf16* Q2 = (const bf16*)(F.ws + WS_Q2);
    int* EIDX = (int*)(F.ws + WS_EIDX); float* EGATE = (float*)(F.ws + WS_EGATE);
    for (int ui = 0;; ++ui) { pg8::Unit gu; if (!SO.next(ui, gu)) break;
        const int blk = gu.pm * 8 + F.wave, h = gu.pn; const size_t tok = (size_t)blk * 32 + r32;
        const bf16* qrow = Q2 + tok * NQ2 + h * PQ + hi * 8;
        int top1[16], top2[16];
        bf16x8 qfs[2][8];
#pragma unroll
        for (int s = 0; s < 2; ++s)
#pragma unroll
            for (int ks = 0; ks < 8; ++ks) qfs[s][ks] = *(const GAS bf16x8*)(qrow + s * 128 + ks * 16);
#pragma unroll
        for (int s = 0; s < 2; ++s) {
            f32x16 acc[4];
#pragma unroll
            for (int kt = 0; kt < 4; ++kt) { acc[kt] = (f32x16){0.f, 0.f, 0.f, 0.f, 0.f, 0.f, 0.f, 0.f, 0.f, 0.f, 0.f, 0.f, 0.f, 0.f, 0.f, 0.f};
                const int n = kt * 32 + r32;
#pragma unroll
                for (int ks = 0; ks < 8; ++ks) { const bf16x8 kf = *(const LAS bf16x8*)(kl + (s * 128 + n) * 256 + (((2 * ks + hi) ^ (n & 15)) << 4));
                    acc[kt] = __builtin_amdgcn_mfma_f32_32x32x16_bf16(kf, qfs[s][ks], acc[kt], 0, 0, 0); } }
            if (s == 0) peer_topk_side(acc, hi, top1); else peer_topk_side(acc, hi, top2);
        }
        float v1[16], v2[16];
#pragma unroll
        for (int i = 0; i < 16; ++i) { v1[i] = ord2f(top1[i]); v2[i] = ord2f(top2[i]);
            look[i * 64 + lane] = __builtin_bit_cast(unsigned, v1[i]) & 0x7Fu; look[(16 + i) * 64 + lane] = __builtin_bit_cast(unsigned, v2[i]) & 0x7Fu; }
        int c[4][16]; int nc = 0;
#pragma unroll
        for (int i = 0; i < 16; ++i)
#pragma unroll
            for (int j = 0; j < 16; ++j) if ((i + 1) * (j + 1) <= 16) { const float sum = v1[i] + v2[j];
                c[nc >> 4][nc & 15] = f2ord(__builtin_bit_cast(float, (__builtin_bit_cast(unsigned, sum) & 0xFFFFFF00u) | (unsigned)(i * 16 + j))); ++nc; }
#pragma unroll
        for (int q = 50; q < 64; ++q) c[q >> 4][q & 15] = (int)0x80000000;
        sort16_desc(c[0]); sort16_desc(c[1]); sort16_desc(c[2]); sort16_desc(c[3]);
        merge16_desc(c[0], c[1]); merge16_desc(c[2], c[3]); merge16_desc(c[0], c[2]);
        float e[16], sum = 0.f;
        float cf[16];
#pragma unroll
        for (int k = 0; k < 16; ++k) cf[k] = ord2f(c[0][k]);
#pragma unroll
        for (int k = 0; k < 16; ++k) { e[k] = __expf(cf[k] - cf[0]); sum += e[k]; }
        const float inv = 1.f / sum;
        LDS_WAIT();
        int ex[8]; float gt[8];
#pragma unroll
        for (int k = 0; k < 8; ++k) { const float cv = hi ? cf[8 + k] : cf[k]; gt[k] = (hi ? e[8 + k] : e[k]) * inv;
            const unsigned pos = __builtin_bit_cast(unsigned, cv) & 0xFFu;
            ex[k] = (int)(look[(pos >> 4) * 64 + lane] * PK + look[(16 + (pos & 15)) * 64 + lane]); }
        int* eo = EIDX + (tok * PH + h) * 16 + hi * 8; float* go = EGATE + (tok * PH + h) * 16 + hi * 8;
        *(GAS v4u*)eo = (v4u){(unsigned)ex[0], (unsigned)ex[1], (unsigned)ex[2], (unsigned)ex[3]}; *(GAS v4u*)(eo + 4) = (v4u){(unsigned)ex[4], (unsigned)ex[5], (unsigned)ex[6], (unsigned)ex[7]};
        *(GAS f32x4*)go = (f32x4){gt[0], gt[1], gt[2], gt[3]}; *(GAS f32x4*)(go + 4) = (f32x4){gt[4], gt[5], gt[6], gt[7]};
        LDS_WAIT();
    }
}

constexpr float PD_SCALE = 256.f, PU_SCALE = 32.f;
__device__ __forceinline__ void unpack_fp8x16(const v4u w, float (&f)[16]) {
    const unsigned ww[4] = {w.x, w.y, w.z, w.w};
#pragma unroll
    for (int i = 0; i < 4; ++i) { const f32x2 lo = __builtin_amdgcn_cvt_pk_f32_fp8((int)ww[i], false), hi = __builtin_amdgcn_cvt_pk_f32_fp8((int)ww[i], true);
        f[4 * i] = lo[0]; f[4 * i + 1] = lo[1]; f[4 * i + 2] = hi[0]; f[4 * i + 3] = hi[1]; }
}
__device__ __forceinline__ void peer_sort_experts(int& e0, int& e1, float& g0, float& g1, int lane) {
    int k0 = e0 * 128 + lane, k1 = e1 * 128 + 64 + lane;
#pragma unroll
    for (int k = 2; k <= 128; k <<= 1)
#pragma unroll
        for (int j = k >> 1; j > 0; j >>= 1) {
            if (j == 64) { const int lo = min(k0, k1), hi = max(k0, k1); k0 = lo; k1 = hi; }
            else { const int p0 = __shfl_xor(k0, j), p1 = __shfl_xor(k1, j); const bool lower = (lane & j) == 0;
                const bool asc0 = (lane & k) == 0, asc1 = ((64 + lane) & k) == 0;
                k0 = (lower == asc0) ? min(k0, p0) : max(k0, p0); k1 = (lower == asc1) ? min(k1, p1) : max(k1, p1); }
        }
    const int s0 = k0 & 127, s1 = k1 & 127;
    const float a0 = __shfl(g0, s0 & 63), b0 = __shfl(g1, s0 & 63), a1 = __shfl(g0, s1 & 63), b1 = __shfl(g1, s1 & 63);
    g0 = (s0 < 64) ? a0 : b0; g1 = (s1 < 64) ? a1 : b1; e0 = k0 >> 7; e1 = k1 >> 7;
}
typedef long i64_t;
__device__ __forceinline__ void peer_gather_phase(Frame& F) {
    const int gw = F.vcu * NWAVES + F.wave, NGW = F.G * NWAVES, lane = F.lane;
    const bf16* H1 = (const bf16*)(F.ws + WS_H); const unsigned char* PD = F.ws + WS_PD; const unsigned char* PU = F.ws + WS_PU;
    const int* EIDX = (const int*)(F.ws + WS_EIDX); const float* EGATE = (const float*)(F.ws + WS_EGATE);
    const int rep = ((lane >> 5) & 1) * 4 + ((lane >> 4) & 1) * 2 + ((lane >> 3) & 1);
    const bool diag = ((lane & 15) >> 2) == (lane >> 4); const int dr = lane & 3;
    const float m0 = (diag && dr == 0) ? 1.f : 0.f, m1 = (diag && dr == 1) ? 1.f : 0.f, m2 = (diag && dr == 2) ? 1.f : 0.f, m3 = (diag && dr == 3) ? 1.f : 0.f;
    constexpr int GT = 4; constexpr float XS = 16.f, AS = 32.f;
    const int si = lane & 15, sq = lane >> 4;
    const unsigned sb = 0xFFu << (8 * (si & 3));
    const unsigned m0lo = (sq == (si >> 3) && (si & 7) < 4) ? sb : 0u, m0hi = (sq == (si >> 3) && (si & 7) >= 4) ? sb : 0u;
    const unsigned m1lo = (sq == 2 + (si >> 3) && (si & 7) < 4) ? sb : 0u, m1hi = (sq == 2 + (si >> 3) && (si & 7) >= 4) ? sb : 0u;
    for (int pr = gw; pr < M / GT; pr += NGW) {
        __syncthreads();
        const size_t tokA = (size_t)pr * GT;
        int e0[GT], e1[GT]; float g0[GT], g1[GT]; f32x4 os[GT][4]; i64_t xb0[GT], xb1[GT];
#pragma unroll
        for (int t = 0; t < GT; ++t) { float a[8], c[8]; unpack8(*(const GAS v4u*)(H1 + (tokA + t) * D + lane * 16), a); unpack8(*(const GAS v4u*)(H1 + (tokA + t) * D + lane * 16 + 8), c);
            unsigned q0, q1, q2, q3; int pk;
            pk = __builtin_amdgcn_cvt_pk_fp8_f32(a[0] * XS, a[1] * XS, 0, false); pk = __builtin_amdgcn_cvt_pk_fp8_f32(a[2] * XS, a[3] * XS, pk, true); q0 = (unsigned)pk;
            pk = __builtin_amdgcn_cvt_pk_fp8_f32(a[4] * XS, a[5] * XS, 0, false); pk = __builtin_amdgcn_cvt_pk_fp8_f32(a[6] * XS, a[7] * XS, pk, true); q1 = (unsigned)pk;
            pk = __builtin_amdgcn_cvt_pk_fp8_f32(c[0] * XS, c[1] * XS, 0, false); pk = __builtin_amdgcn_cvt_pk_fp8_f32(c[2] * XS, c[3] * XS, pk, true); q2 = (unsigned)pk;
            pk = __builtin_amdgcn_cvt_pk_fp8_f32(c[4] * XS, c[5] * XS, 0, false); pk = __builtin_amdgcn_cvt_pk_fp8_f32(c[6] * XS, c[7] * XS, pk, true); q3 = (unsigned)pk;
            xb0[t] = (i64_t)(((unsigned long long)q1 << 32) | q0); xb1[t] = (i64_t)(((unsigned long long)q3 << 32) | q2);
            e0[t] = EIDX[(tokA + t) * 128 + lane]; e1[t] = EIDX[(tokA + t) * 128 + 64 + lane]; g0[t] = EGATE[(tokA + t) * 128 + lane]; g1[t] = EGATE[(tokA + t) * 128 + 64 + lane];
            peer_sort_experts(e0[t], e1[t], g0[t], g1[t], lane);
#pragma unroll
            for (int j = 0; j < 4; ++j) os[t][j] = (f32x4){0.f, 0.f, 0.f, 0.f}; }
#define GATHER_BATCH(E0, E1, G0, G1, XB0, XB1, O) do { const int ev = (bt < 8) ? E0 : E1; const float gv = (bt < 8) ? G0 : G1; const int lb8 = (bt & 7) * 8; v4u dw[8], uw[8]; \
            _Pragma("unroll") for (int i = 0; i < 8; ++i) { const int e = __builtin_amdgcn_readlane(ev, lb8 + i); dw[i] = *(const GAS v4u*)(PD + (size_t)e * D + lane * 16); uw[i] = *(const GAS v4u*)(PU + (size_t)e * D + lane * 16); } \
            float p[8]; \
            _Pragma("unroll") for (int i = 0; i < 8; ++i) { f32x4 dacc = (f32x4){0.f, 0.f, 0.f, 0.f}; \
                dacc = __builtin_amdgcn_mfma_f32_16x16x32_fp8_fp8((i64_t)(((unsigned long long)dw[i].y << 32) | dw[i].x), XB0, dacc, 0, 0, 0); \
                dacc = __builtin_amdgcn_mfma_f32_16x16x32_fp8_fp8((i64_t)(((unsigned long long)dw[i].w << 32) | dw[i].z), XB1, dacc, 0, 0, 0); \
                const float d0 = dacc[0] * m0, d1 = dacc[1] * m1, d2 = dacc[2] * m2, d3 = dacc[3] * m3; p[i] = (d0 + d1) + (d2 + d3); } \
            _Pragma("unroll") for (int i = 0; i < 4; ++i) { const float keep = (lane & 32) ? p[i + 4] : p[i], send = (lane & 32) ? p[i] : p[i + 4]; p[i] = keep + __shfl_xor(send, 32); } \
            _Pragma("unroll") for (int i = 0; i < 2; ++i) { const float keep = (lane & 16) ? p[i + 2] : p[i], send = (lane & 16) ? p[i] : p[i + 2]; p[i] = keep + __shfl_xor(send, 16); } \
            { const float keep = (lane & 8) ? p[1] : p[0], send = (lane & 8) ? p[0] : p[1]; p[0] = keep + __shfl_xor(send, 8); } \
            p[0] += __shfl_xor(p[0], 4); p[0] += __shfl_xor(p[0], 2); p[0] += __shfl_xor(p[0], 1); \
            const float gate = __shfl(gv, lb8 + rep); const float act = gelu_tanh(p[0] * (1.f / (PD_SCALE * XS))) * gate * AS; \
            const int act8 = __builtin_amdgcn_cvt_pk_fp8_f32(act, 0.f, 0, false) & 0xff; \
            _Pragma("unroll") for (int i = 0; i < 8; ++i) { const unsigned a8 = (unsigned)__builtin_amdgcn_readlane(act8, ((i >> 2) & 1) * 32 + ((i >> 1) & 1) * 16 + (i & 1) * 8) * 0x01010101u; \
                const i64_t A0 = (i64_t)(((unsigned long long)(a8 & m0hi) << 32) | (a8 & m0lo)), A1 = (i64_t)(((unsigned long long)(a8 & m1hi) << 32) | (a8 & m1lo)); \
                const i64_t B0 = (i64_t)(((unsigned long long)uw[i].y << 32) | uw[i].x), B1 = (i64_t)(((unsigned long long)uw[i].w << 32) | uw[i].z); \
                O[0] = __builtin_amdgcn_mfma_f32_16x16x32_fp8_fp8(A0, B0, O[0], 0, 0, 0); O[1] = __builtin_amdgcn_mfma_f32_16x16x32_fp8_fp8(A1, B0, O[1], 0, 0, 0); \
                O[2] = __builtin_amdgcn_mfma_f32_16x16x32_fp8_fp8(A0, B1, O[2], 0, 0, 0); O[3] = __builtin_amdgcn_mfma_f32_16x16x32_fp8_fp8(A1, B1, O[3], 0, 0, 0); } } while (0)
#pragma unroll 1
        for (int bt = 0; bt < 16; ++bt) { if ((bt & 3) == 0) __syncthreads();
#pragma unroll
            for (int t = 0; t < GT; ++t) { GATHER_BATCH(e0[t], e1[t], g0[t], g1[t], xb0[t], xb1[t], os[t]); __builtin_amdgcn_sched_barrier(0); } }
#undef GATHER_BATCH
#pragma unroll
        for (int t = 0; t < GT; ++t) {
            float o[16]; float s = 0.f;
#pragma unroll
            for (int a4 = 0; a4 < 4; ++a4) { const int hf = a4 >> 1, kh = a4 & 1, c0 = 16 * si + 256 * ((sq >> 1) + 2 * kh) + 8 * hf + 4 * (sq & 1);
                const v2u hw = *(const GAS v2u*)(H1 + (tokA + t) * D + c0);
                const float x0 = __builtin_bit_cast(float, hw.x << 16), x1 = __builtin_bit_cast(float, hw.x & 0xffff0000u), x2 = __builtin_bit_cast(float, hw.y << 16), x3 = __builtin_bit_cast(float, hw.y & 0xffff0000u);
                const f32x4 ov = os[t][a4];
                o[4 * a4 + 0] = ov[0] * (1.f / (AS * PU_SCALE)) + DN_ALPHA * x0; o[4 * a4 + 1] = ov[1] * (1.f / (AS * PU_SCALE)) + DN_ALPHA * x1;
                o[4 * a4 + 2] = ov[2] * (1.f / (AS * PU_SCALE)) + DN_ALPHA * x2; o[4 * a4 + 3] = ov[3] * (1.f / (AS * PU_SCALE)) + DN_ALPHA * x3;
                s += (o[4 * a4 + 0] + o[4 * a4 + 1]) + (o[4 * a4 + 2] + o[4 * a4 + 3]); }
            const float mean = wave_sum(s) * (1.f / D); float s2 = 0.f;
#pragma unroll
            for (int j = 0; j < 16; ++j) { o[j] -= mean; s2 += o[j] * o[j]; }
            const float rstd = 1.f / sqrtf(wave_sum(s2) * (1.f / D) + LN_EPS);
#pragma unroll
            for (int a4 = 0; a4 < 4; ++a4) { const int hf = a4 >> 1, kh = a4 & 1, c0 = 16 * si + 256 * ((sq >> 1) + 2 * kh) + 8 * hf + 4 * (sq & 1);
                const f32x4 ga = *(const GAS f32x4*)(F.in[I_LN2G] + c0), ba = *(const GAS f32x4*)(F.in[I_LN2B] + c0);
                f32x4 y; y.x = o[4 * a4 + 0] * rstd * ga.x + ba.x; y.y = o[4 * a4 + 1] * rstd * ga.y + ba.y; y.z = o[4 * a4 + 2] * rstd * ga.z + ba.z; y.w = o[4 * a4 + 3] * rstd * ga.w + ba.w;
                *(GAS f32x4*)(F.out + (tokA + t) * D + c0) = y; }
        }
    }
}

struct Args { const float* in[26]; float* out; unsigned char* ws; int ph_lo, ph_hi, li, pad; };
__global__ void __launch_bounds__(NWAVES * 64, 2) fwd_kernel(Args args) {
    extern __shared__ __attribute__((aligned(16))) unsigned char lds[];
    Frame F;
    F.lds = (LAS unsigned char*)lds;
    F.MISC = (volatile LAS unsigned*)(F.lds + MISC_OFF);
    F.tid = threadIdx.x; F.lane = F.tid & 63; F.wave = __builtin_amdgcn_readfirstlane(F.tid >> 6);
    F.G = gridDim.x; { const int bx = blockIdx.x; F.vcu = (F.G % 8 == 0) ? (bx % 8) * (F.G / 8) + bx / 8 : bx; }
#pragma unroll
    for (int i = 0; i < 26; ++i) F.in[i] = args.in[i];
    F.out = args.out; F.ws = args.ws;
    unsigned char* ws = args.ws;
    F.ctl = (gu32*)(ws + WS_CTL);
    for (int u = F.tid; u < (LDS_BYTES - LDSCTL_OFF) / 4; u += NWAVES * 64) ((LAS unsigned*)(F.lds + LDSCTL_OFF))[u] = 0u;
    __syncthreads();
    XcdBarrier bar; bar.bar = (unsigned*)(F.ctl + CW_BAR); bar.x = 0; bar.st = nullptr; bar.G = 0;
    XcdBarrier bar2 = bar;
    if (N_LAUNCHES == 1) { bar = xcd_barrier_post((unsigned*)(F.ctl + CW_BAR), F.MISC + 8, (unsigned)F.G);
        if (F.vcu >= 128) bar2 = xcd_barrier_post((unsigned*)(F.ctl + CW_BAR2), F.MISC + 10, (unsigned)(F.G - 128)); }
#define GRID_BAR() do { if (N_LAUNCHES == 1) xcd_barrier(bar); } while (0)
    const int lo = args.ph_lo, hi = args.ph_hi;
#define IN(k) (lo <= (k) && (k) < hi)
#define BOTH(k) (IN(k) && IN((k) + 1))
    bf16* const Hb = (bf16*)(ws + WS_H);
    bf16* const PRJ = (bf16*)(ws + WS_PROJ);

    if (IN(0)) { p0_prologue(F); if (BOTH(0)) GRID_BAR(); }

    if (IN(1)) {
        s5_tables_stage1(F);
        pg8::Gemm g{Hb, (const bf16*)(ws + WS_WIN), M, NPROJ, D, D, D}; pg8::StaticOrder S; S.init(M, NPROJ, F.G, (int)blockIdx.x);
        pg8::EpiProj E{PRJ, PRJ + (size_t)M * 512, PRJ + (size_t)2 * M * 512, PRJ + (size_t)3 * M * 512, (bf16*)(ws + WS_A5), (const float*)(ws + WS_LB), M};
        pg8::gemm_phase<pg8::EpiProj, pg8::StaticOrder, true, true>(F.lds + RING_OFF, g, S, E);
        if (BOTH(1)) GRID_BAR();
    }

    if (IN(2)) {
        s5_tables_stage2(F);
        if (F.vcu < 128) hgrn2_state_pass(F, F.vcu);
        else { pg8::Gemm g{(const bf16*)(ws + WS_A5), (const bf16*)(ws + WS_G5), 32 * S5I, 32 * 256, 512, S5K, 512}; pg8::GroupedOrder S{4, 1, F.G - 128, F.vcu - 128};
            pg8::EpiS5A E{(float*)(ws + WS_XLOC)};
            pg8::gemm_phase<pg8::EpiS5A, pg8::GroupedOrder, true, true>(F.lds + RING_OFF, g, S, E);
            if (N_LAUNCHES == 1) { xcd_barrier(bar2); if (F.vcu - 128 < 32) s5_scan(F, (F.vcu - 128) * 512 + F.tid); }
        }
        { constexpr int NTAB16 = PE * D / 16, NCHUNK = 2 * NTAB16 / 4096;
          for (;;) {
              if (F.tid == 0) F.MISC[4] = xb_add((unsigned*)(F.ctl + CW_CONV), 1u);
              __syncthreads();
              const int ch = (int)F.MISC[4];
              __syncthreads();
              if (ch >= NCHUNK) break;
#pragma unroll 2
              for (int q8 = 0; q8 < 8; ++q8) { const int i = ch * 4096 + q8 * 512 + F.tid; const bool up = i >= NTAB16; const int j = up ? i - NTAB16 : i; const float* src = (up ? F.in[I_PU] : F.in[I_PD]) + (size_t)j * 16; const float sc = up ? PU_SCALE : PD_SCALE;
                  v4u o; unsigned ow[4];
#pragma unroll
                  for (int q = 0; q < 4; ++q) { const f32x4 a = *(const GAS f32x4*)(src + 4 * q); int pk = __builtin_amdgcn_cvt_pk_fp8_f32(a.x * sc, a.y * sc, 0, false); pk = __builtin_amdgcn_cvt_pk_fp8_f32(a.z * sc, a.w * sc, pk, true); ow[q] = (unsigned)pk; }
                  o.x = ow[0]; o.y = ow[1]; o.z = ow[2]; o.w = ow[3];
                  *(GAS v4u*)(ws + (up ? WS_PU : WS_PD) + (size_t)j * 16) = o; }
          } }
        if (BOTH(2)) GRID_BAR();
    }

    if (IN(3)) {
        if (N_LAUNCHES != 1) { if (F.vcu < 32) s5_scan(F, F.vcu * 512 + F.tid); }
        { pg8::Gemm g{(const bf16*)(ws + WS_A5), (const bf16*)(ws + WS_T5), 32 * S5I, 32 * 512, S5K, S5K, S5K}; pg8::GroupedOrder S{4, 2, F.G, F.vcu};
          pg8::EpiS5C E{(bf16*)(ws + WS_Z)};
          pg8::gemm_phase<pg8::EpiS5C, pg8::GroupedOrder, true, true>(F.lds + RING_OFF, g, S, E); }
        hgrn2_out_phase(F);
        if (BOTH(3)) GRID_BAR();
    }

    if (IN(4)) {
        pg8::Gemm g{(const bf16*)(ws + WS_Z), (const bf16*)(ws + WS_WGLU), M, 512, 512, 512, 512}; pg8::StaticOrder S; S.init(M, 512, F.G, (int)blockIdx.x);
        pg8::EpiGlu E{(const bf16*)(ws + WS_Z), (bf16*)(ws + WS_MIX), F.in[I_BGLU]};
        pg8::gemm_phase<pg8::EpiGlu, pg8::StaticOrder, true, true>(F.lds + RING_OFF, g, S, E);
        if (BOTH(4)) GRID_BAR();
    }

    if (IN(5)) {
        pg8::Gemm g{(const bf16*)(ws + WS_MIX), (const bf16*)(ws + WS_WOUT), M, D, D, D, D}; pg8::StaticOrder S; S.init(M, D, F.G, (int)blockIdx.x);
        pg8::EpiOut E{Hb, DN_ALPHA};
        pg8::gemm_phase<pg8::EpiOut, pg8::StaticOrder, true, true>(F.lds + RING_OFF, g, S, E);
        if (BOTH(5)) GRID_BAR();
    }

    if (IN(6)) {
        const int gw = F.vcu * NWAVES + F.wave, NGW = F.G * NWAVES;
        for (int m = gw; m < M; m += NGW) ln1_row(Hb + (size_t)m * D, F.in[I_LN1G], F.in[I_LN1B], F.lane);
        if (BOTH(6)) GRID_BAR();
    }

    if (IN(7)) {
        pg8::Gemm g{Hb, (const bf16*)(ws + WS_WQ), M, NQ2, D, D, D}; pg8::StaticOrder S; S.init(M, NQ2, F.G, (int)blockIdx.x);
        pg8::EpiStore E{(bf16*)(ws + WS_Q2), NQ2};
        pg8::gemm_phase<pg8::EpiStore, pg8::StaticOrder, true, true>(F.lds + RING_OFF, g, S, E);
        VM_WAIT(); __syncthreads();
        if (F.tid == 0) { __builtin_amdgcn_fence(__ATOMIC_ACQUIRE, "agent"); VM_WAIT(); }
        __syncthreads();
        peer_score_phase(F, S);
        if (BOTH(7)) GRID_BAR();
    }

    if (IN(8)) { peer_gather_phase(F); }
#undef IN
#undef BOTH
}

extern "C" void kernel_launch(void* const* d_in, const int* in_sizes, int n_in, void* d_out, int out_size, void* d_ws, size_t ws_size, hipStream_t stream) {
    static int grid = 0;
    if (grid == 0) {
        if (n_in != 26 || in_sizes[0] != M * D || out_size != M * D || ws_size < WS_END) { fprintf(stderr, "kernel_launch: unexpected shapes: n_in %d in0 %d out %d ws %zu (need %zu)\n", n_in, n_in > 0 ? in_sizes[0] : -1, out_size, ws_size, (size_t)WS_END); grid = -1; return; }
        int dev = 0, cus = 0;
        if (hipGetDevice(&dev) != hipSuccess || hipDeviceGetAttribute(&cus, hipDeviceAttributeMultiprocessorCount, dev) != hipSuccess) { grid = -1; return; }
        if (hipFuncSetAttribute((const void*)fwd_kernel, hipFuncAttributeMaxDynamicSharedMemorySize, LDS_BYTES) != hipSuccess) { fprintf(stderr, "kernel_launch: hipFuncSetAttribute failed\n"); grid = -1; return; }
        (void)hipGetLastError();
        grid = cus;
    }
    if (grid < 0) return;
    if (hipMemsetAsync((char*)d_ws + WS_CTL, 0, CTL_ZERO_BYTES, stream) != hipSuccess) return;
    Args a{};
    for (int i = 0; i < 26; ++i) a.in[i] = (const float*)d_in[i];
    a.out = (float*)d_out; a.ws = (unsigned char*)d_ws;
    if (N_LAUNCHES == 1) { a.ph_lo = 0; a.ph_hi = NPH; a.li = 0; hipLaunchKernelGGL(fwd_kernel, dim3(grid), dim3(NWAVES * 64), LDS_BYTES, stream, a); }
    else for (int li = 0; li < NPH; ++li) { a.ph_lo = li; a.ph_hi = li + 1; a.li = li; hipLaunchKernelGGL(fwd_kernel, dim3(grid), dim3(NWAVES * 64), LDS_BYTES, stream, a); }
}
```

```cpp
#include <hip/hip_runtime.h>
#include <cstdio>
#include <cstdint>
namespace pg8 {
#define PG8_LAS __attribute__((address_space(3)))
typedef unsigned short bf16_t;
typedef short bf16x8 __attribute__((ext_vector_type(8)));
typedef float f32x4 __attribute__((ext_vector_type(4)));
typedef unsigned u32x4 __attribute__((ext_vector_type(4)));
constexpr int BM = 256, BK = 64, HALF = 128, HTB = HALF * BK * 2  , STAGE_BYTES = 8 * HTB, NXCD = 8, WGM = 8;

__host__ __device__ __forceinline__ int lds_byte(int r, int c) { const int st = (r >> 4) * 2 + (c >> 5), rr = r & 15, cc = c & 31, ob = rr * 64 + cc * 2; return st * 1024 + (ob ^ (((ob >> 9) & 1) << 5)); }
__host__ __device__ __forceinline__ void stage_rc(int b, int& R, int& C) { const int st = b / 1024, sb = b % 1024, swz = sb ^ (((sb >> 9) & 1) << 5); R = (st >> 1) * 16 + swz / 64; C = (st & 1) * 32 + (swz % 64) / 2; }
__host__ __device__ __forceinline__ int perm32(int rho) { const int n = rho >> 4, i = rho & 15; return 8 * (i >> 2) + 4 * n + (i & 3); }

struct Unit { int pm, pn; };
struct Gemm { const bf16_t* A; const bf16_t* Bt; int M, N, K, lda, ldb; };

struct StaticOrder {
    int nM, nN, nwg, G, c;
    __host__ __device__ void init(int M, int N, int G_, int c_) { nM = M / BM; nN = N / BM; nwg = nM * nN; G = G_; c = c_; }
    __host__ __device__ bool next(int i, Unit& u) const {
        const long L = (long)i * G + c; if (L >= nwg) return false;
        int wgid = (int)L; { const int q = nwg / NXCD, r = nwg % NXCD, xcd = wgid % NXCD, off = wgid / NXCD; wgid = (xcd < r ? xcd * (q + 1) : r * (q + 1) + (xcd - r) * q) + off; }
        const int nig = WGM * nN, gid = wgid / nig, fm = gid * WGM, gsz = (nM - fm) < WGM ? (nM - fm) : WGM;
        u.pm = fm + ((wgid % nig) % gsz); u.pn = (wgid % nig) / gsz; return true;
    }
    __device__ __forceinline__ void a_ready(const Unit&) const {}
    __device__ __forceinline__ void done(const Unit&) const {}
};

__device__ __forceinline__ unsigned cvt_pk_bf16(float lo, float hi) { unsigned r; asm volatile("v_cvt_pk_bf16_f32 %0, %1, %2" : "=v"(r) : "v"(lo), "v"(hi)); return r; }
__device__ __forceinline__ void unpack8(const u32x4 w, float (&f)[8]) {
    f[0] = __builtin_bit_cast(float, w.x << 16); f[1] = __builtin_bit_cast(float, w.x & 0xffff0000u);
    f[2] = __builtin_bit_cast(float, w.y << 16); f[3] = __builtin_bit_cast(float, w.y & 0xffff0000u);
    f[4] = __builtin_bit_cast(float, w.z << 16); f[5] = __builtin_bit_cast(float, w.z & 0xffff0000u);
    f[6] = __builtin_bit_cast(float, w.w << 16); f[7] = __builtin_bit_cast(float, w.w & 0xffff0000u);
}
__device__ __forceinline__ u32x4 pack8(const float (&f)[8]) { u32x4 w; w.x = cvt_pk_bf16(f[0], f[1]); w.y = cvt_pk_bf16(f[2], f[3]); w.z = cvt_pk_bf16(f[4], f[5]); w.w = cvt_pk_bf16(f[6], f[7]); return w; }

struct EpiStore {
    static constexpr bool PERM = true, AFTER_DRAIN = false;
    bf16_t* O; int ldc;
    __device__ __forceinline__ void operator()(const f32x4 (&acc)[2][2][4][2], const Unit& u, int wr, int wc, int fr, int fq) const {
        const int row0 = u.pm * BM + wr * 64 + fr, col0 = u.pn * BM + wc * 32 + 8 * fq;
#pragma unroll
        for (int ai = 0; ai < 2; ++ai)
#pragma unroll
            for (int m = 0; m < 4; ++m) { bf16_t* rowp = O + (size_t)(row0 + ai * HALF + m * 16) * ldc + col0;
#pragma unroll
                for (int bj = 0; bj < 2; ++bj) { const f32x4 v0 = acc[ai][bj][m][0], v1 = acc[ai][bj][m][1];
                    u32x4 w; w.x = cvt_pk_bf16(v0[0], v0[1]); w.y = cvt_pk_bf16(v0[2], v0[3]); w.z = cvt_pk_bf16(v1[0], v1[1]); w.w = cvt_pk_bf16(v1[2], v1[3]);
                    *(u32x4*)(rowp + bj * HALF) = w; } }
    }
};

struct EpiProj {
    static constexpr bool PERM = true, AFTER_DRAIN = false;
    bf16_t* Qb; bf16_t* LFb; bf16_t* Vb; bf16_t* Gb; bf16_t* Ub; const float* lb; int M;
    __device__ __forceinline__ void operator()(const f32x4 (&acc)[2][2][4][2], const Unit& u, int wr, int wc, int fr, int fq) const {
        const int row0 = u.pm * BM + wr * 64 + fr; const int colt = u.pn * BM; const int t = colt >> 9;
        const int cb = (colt & 511) + wc * 32 + 8 * fq;
        float lbv[2][8];
        if (t == 1) {
#pragma unroll
            for (int bj = 0; bj < 2; ++bj) { const f32x4 a = *(const f32x4*)(lb + cb + bj * HALF), b = *(const f32x4*)(lb + cb + bj * HALF + 4);
                lbv[bj][0] = a[0]; lbv[bj][1] = a[1]; lbv[bj][2] = a[2]; lbv[bj][3] = a[3]; lbv[bj][4] = b[0]; lbv[bj][5] = b[1]; lbv[bj][6] = b[2]; lbv[bj][7] = b[3]; }
        }
#pragma unroll
        for (int ai = 0; ai < 2; ++ai)
#pragma unroll
            for (int m = 0; m < 4; ++m) { const int row = row0 + ai * HALF + m * 16;
#pragma unroll
                for (int bj = 0; bj < 2; ++bj) { const f32x4 v0 = acc[ai][bj][m][0], v1 = acc[ai][bj][m][1]; const int c = cb + bj * HALF;
                    float f[8] = {v0[0], v0[1], v0[2], v0[3], v1[0], v1[1], v1[2], v1[3]};
                    if (t == 0) {
#pragma unroll
                        for (int j = 0; j < 8; ++j) f[j] *= 0.08838834764831845f;
                        *(u32x4*)(Qb + (size_t)row * 512 + c) = pack8(f);
                    } else if (t == 1) {
#pragma unroll
                        for (int j = 0; j < 8; ++j) { const float l = lbv[bj][j]; const float sg = 1.f / (1.f + __expf(-f[j])); f[j] = __logf(l + (1.f - l) * sg); }
                        *(u32x4*)(LFb + (size_t)row * 512 + c) = pack8(f);
                    } else if (t == 2) { *(u32x4*)(Vb + (size_t)row * 512 + c) = pack8(f);
                    } else if (t == 3) { *(u32x4*)(Gb + (size_t)row * 512 + c) = pack8(f);
                    } else { *(u32x4*)(Ub + ((size_t)(c >> 4) * (M / 32) + (row >> 5)) * 640 + (row & 31) * 16 + (c & 15)) = pack8(f); }
                } }
    }
};

struct EpiGlu {
    static constexpr bool PERM = true, AFTER_DRAIN = false;
    const bf16_t* Z; bf16_t* MIX; const float* bglu;
    __device__ __forceinline__ void operator()(const f32x4 (&acc)[2][2][4][2], const Unit& u, int wr, int wc, int fr, int fq) const {
        const int row0 = u.pm * BM + wr * 64 + fr, col0 = u.pn * BM + wc * 32 + 8 * fq;
#pragma unroll
        for (int bj = 0; bj < 2; ++bj) { const int c = col0 + bj * HALF;
            const f32x4 b0 = *(const f32x4*)(bglu + c), b1 = *(const f32x4*)(bglu + c + 4);
#pragma unroll
            for (int ai = 0; ai < 2; ++ai)
#pragma unroll
                for (int m = 0; m < 4; ++m) { const int row = row0 + ai * HALF + m * 16;
                    const f32x4 v0 = acc[ai][bj][m][0] + b0, v1 = acc[ai][bj][m][1] + b1;
                    float z[8]; unpack8(*(const u32x4*)(Z + (size_t)row * 512 + c), z);
                    float f[8] = {v0[0], v0[1], v0[2], v0[3], v1[0], v1[1], v1[2], v1[3]};
#pragma unroll
                    for (int j = 0; j < 8; ++j) f[j] = z[j] / (1.f + __expf(-f[j]));
                    *(u32x4*)(MIX + (size_t)row * 1024 + 512 + c) = pack8(f); } }
    }
};

struct EpiOut {
    static constexpr bool PERM = true, AFTER_DRAIN = false;
    bf16_t* H; float alpha;
    __device__ __forceinline__ void operator()(const f32x4 (&acc)[2][2][4][2], const Unit& u, int wr, int wc, int fr, int fq) const {
        const int row0 = u.pm * BM + wr * 64 + fr, col0 = u.pn * BM + wc * 32 + 8 * fq;
#pragma unroll
        for (int ai = 0; ai < 2; ++ai)
#pragma unroll
            for (int m = 0; m < 4; ++m) { bf16_t* rowp = H + (size_t)(row0 + ai * HALF + m * 16) * 1024 + col0;
#pragma unroll
                for (int bj = 0; bj < 2; ++bj) { const f32x4 v0 = acc[ai][bj][m][0], v1 = acc[ai][bj][m][1];
                    float h[8]; unpack8(*(const u32x4*)(rowp + bj * HALF), h);
                    float f[8] = {v0[0], v0[1], v0[2], v0[3], v1[0], v1[1], v1[2], v1[3]};
#pragma unroll
                    for (int j = 0; j < 8; ++j) f[j] = alpha * h[j] + f[j];
                    *(u32x4*)(rowp + bj * HALF) = pack8(f); } }
    }
};

struct GroupedOrder {
    int tm, tn, G, c;
    __device__ bool next(int i, Unit& u) const { const int L = i * G + c, per = tm * tn; if (c < 0 || L >= 32 * per) return false;
        const int g = L / per, r = L % per; u.pm = g * tm + r % tm; u.pn = g * tn + r / tm; return true; }
    __device__ __forceinline__ void a_ready(const Unit&) const {}
    __device__ __forceinline__ void done(const Unit&) const {}
};
struct EpiS5A {
    static constexpr bool PERM = true, AFTER_DRAIN = false;
    float* X;
    __device__ __forceinline__ void operator()(const f32x4 (&acc)[2][2][4][2], const Unit& u, int wr, int wc, int fr, int fq) const {
        const int g = u.pn, inst0 = (u.pm & 3) * BM + wr * 64 + fr, col = wc * 32 + 8 * fq;
#pragma unroll
        for (int ai = 0; ai < 2; ++ai)
#pragma unroll
            for (int m = 0; m < 4; ++m) { float* p = X + ((size_t)(inst0 + ai * HALF + m * 16) * 32 + g) * 128 + col;
                *(f32x4*)p = acc[ai][0][m][0]; *(f32x4*)(p + 4) = acc[ai][0][m][1]; }
    }
};
struct EpiS5C {
    static constexpr bool PERM = true, AFTER_DRAIN = false;
    bf16_t* Z;
    __device__ __forceinline__ void operator()(const f32x4 (&acc)[2][2][4][2], const Unit& u, int wr, int wc, int fr, int fq) const {
        const int g = u.pm >> 2, inst0 = (u.pm & 3) * BM + wr * 64 + fr, col0 = (u.pn & 1) * BM + wc * 32 + 8 * fq;
#pragma unroll
        for (int ai = 0; ai < 2; ++ai)
#pragma unroll
            for (int m = 0; m < 4; ++m) { const int inst = inst0 + ai * HALF + m * 16; const size_t tok0 = (size_t)(inst >> 7) * 4096 + (size_t)(inst & 127) * 32;
#pragma unroll
                for (int bj = 0; bj < 2; ++bj) { const int col = col0 + bj * HALF; const f32x4 v0 = acc[ai][bj][m][0], v1 = acc[ai][bj][m][1];
                    float f[8] = {v0[0], v0[1], v0[2], v0[3], v1[0], v1[1], v1[2], v1[3]};
#pragma unroll
                    for (int j = 0; j < 8; ++j) { const float x = f[j], y = 0.7978845608028654f * (x + 0.044715f * x * x * x); f[j] = x / (1.f + __expf(-2.f * y)); }
                    *(u32x4*)(Z + (tok0 + (col >> 4)) * 512 + g * 16 + (col & 15)) = pack8(f); } }
    }
};

template <class Epi, class Sched, bool ALIGN_EPI = false, bool SP2 = false>
__device__ __forceinline__ void gemm_phase(PG8_LAS unsigned char* lds, const Gemm g, const Sched& S, const Epi& E) {
    const int tid = threadIdx.x, wid = __builtin_amdgcn_readfirstlane(tid >> 6), lane = tid & 63, wr = wid >> 2, wc = wid & 3, fr = lane & 15, fq = lane >> 4;
    const int K = g.K, nt = K / BK;
    unsigned voffA[2], voffB[2];
#pragma unroll
    for (int i = 0; i < 2; ++i) { int R, C; stage_rc(tid * 16 + i * 8192, R, C); const int Rb = Epi::PERM ? ((R & ~31) + perm32(R & 31)) : R;
        voffA[i] = (unsigned)(R * g.lda + C) * 2u; voffB[i] = (unsigned)(Rb * g.ldb + C) * 2u; }
    const size_t kstep = (size_t)(BK * 2);
    const size_t hstepA = (size_t)HALF * g.lda * 2, hstepB = (size_t)HALF * g.ldb * 2;
    const size_t tstepA = 2 * hstepA, tstepB = 2 * hstepB;
    const unsigned ldsw = (unsigned)wid * 1024u;
    const int aoff = lds_byte(wr * 64 + fr, fq * 8), boff = lds_byte(wc * 32 + fr, fq * 8);
#define PG8_SA(b, h) (((b) * 2 + (h)) * HTB)
#define PG8_SB(b, h) ((4 + (b) * 2 + (h)) * HTB)
#define PG8_STAGE(bufoff, gbase, voff) do { _Pragma("unroll") for (int _i = 0; _i < 2; ++_i) \
        __builtin_amdgcn_global_load_lds((const unsigned*)((const char*)(gbase) + (voff)[_i]), (PG8_LAS unsigned*)(lds + (bufoff) + ldsw + _i * 8192), 16, 0, 0); } while (0)
#define PG8_LDA(dst, b, h) do { _Pragma("unroll") for (int m = 0; m < 4; ++m) _Pragma("unroll") for (int k = 0; k < 2; ++k) dst[m][k] = *(const PG8_LAS bf16x8*)(lds + PG8_SA(b, h) + aoff + m * 2048 + k * 1024); } while (0)
#define PG8_LDB(dst, b, h) do { _Pragma("unroll") for (int n = 0; n < 2; ++n) _Pragma("unroll") for (int k = 0; k < 2; ++k) dst[n][k] = *(const PG8_LAS bf16x8*)(lds + PG8_SB(b, h) + boff + n * 2048 + k * 1024); } while (0)
#define PG8_MMA(ai, bj, At, Bt) do { __builtin_amdgcn_s_setprio(1); _Pragma("unroll") for (int m = 0; m < 4; ++m) _Pragma("unroll") for (int n = 0; n < 2; ++n) _Pragma("unroll") for (int k = 0; k < 2; ++k) \
        acc[ai][bj][m][n] = __builtin_amdgcn_mfma_f32_16x16x32_bf16(Bt[n][k], At[m][k], acc[ai][bj][m][n], 0, 0, 0); __builtin_amdgcn_s_setprio(0); } while (0)
#define PG8_WAIT_V(n) asm volatile("s_waitcnt vmcnt(" #n ")" ::: "memory")
#define PG8_WAIT_L(n) asm volatile("s_waitcnt lgkmcnt(" #n ")" ::: "memory")
#define PG8_BAR __builtin_amdgcn_s_barrier()
#define PG8_SCHED __builtin_amdgcn_sched_barrier(0)
    Unit cur, nxt; int ui = 0;
    if (!S.next(0, cur)) return;
    f32x4 acc[2][2][4][2];
#pragma unroll
    for (int a = 0; a < 2; ++a)
#pragma unroll
        for (int b = 0; b < 2; ++b)
#pragma unroll
            for (int m = 0; m < 4; ++m)
#pragma unroll
                for (int n = 0; n < 2; ++n) acc[a][b][m][n] = (f32x4){0.f, 0.f, 0.f, 0.f};
    bf16x8 At[4][2], B0[2][2], B1[2][2];
    const char* cA = (const char*)g.A + (size_t)cur.pm * tstepA; const char* cB = (const char*)g.Bt + (size_t)cur.pn * tstepB;
    S.a_ready(cur);
    if constexpr (SP2) {
        PG8_STAGE(PG8_SB(0, 0), cB, voffB); PG8_STAGE(PG8_SB(0, 1), cB + hstepB, voffB); PG8_STAGE(PG8_SA(0, 0), cA, voffA); PG8_STAGE(PG8_SA(0, 1), cA + hstepA, voffA);
        if (wr == 1) PG8_BAR;
        PG8_WAIT_V(2); PG8_BAR;
        PG8_STAGE(PG8_SB(1, 0), cB + kstep, voffB); PG8_STAGE(PG8_SA(1, 0), cA + kstep, voffA); PG8_STAGE(PG8_SB(1, 1), cB + hstepB + kstep, voffB);
        PG8_WAIT_V(6); PG8_BAR;
    } else {
        PG8_STAGE(PG8_SB(0, 0), cB, voffB); PG8_STAGE(PG8_SA(0, 0), cA, voffA); PG8_STAGE(PG8_SB(0, 1), cB + hstepB, voffB); PG8_STAGE(PG8_SA(0, 1), cA + hstepA, voffA);
        if (wr == 1) PG8_BAR;
        PG8_WAIT_V(4); PG8_BAR;
        PG8_STAGE(PG8_SB(1, 0), cB + kstep, voffB); PG8_STAGE(PG8_SA(1, 0), cA + kstep, voffA); PG8_STAGE(PG8_SB(1, 1), cB + hstepB + kstep, voffB);
        PG8_WAIT_V(6); PG8_BAR;
    }
    for (;;) {
        const bool has_next = S.next(ui + 1, nxt);
        const char* nA = has_next ? (const char*)g.A + (size_t)nxt.pm * tstepA : cA; const char* nB = has_next ? (const char*)g.Bt + (size_t)nxt.pn * tstepB : cB;
        for (int t = 0; t < nt; t += 2) {
            const bool last = (t == nt - 2);
            const char* a1 = cA + (size_t)(t + 1) * kstep;
            const char* a2 = last ? nA : cA + (size_t)(t + 2) * kstep; const char* b2 = last ? nB : cB + (size_t)(t + 2) * kstep;
            const char* a3 = a2 + kstep; const char* b3 = b2 + kstep;
            if (last && has_next) S.a_ready(nxt);
            if constexpr (SP2) {
            PG8_LDB(B0, 0, 0); PG8_LDB(B1, 0, 1); PG8_SCHED; PG8_LDA(At, 0, 0); PG8_STAGE(PG8_SA(1, 1), a1 + hstepA, voffA);
            PG8_WAIT_V(8); PG8_WAIT_L(0); PG8_BAR; PG8_MMA(0, 0, At, B0); PG8_MMA(0, 1, At, B1); PG8_BAR; PG8_SCHED;
            PG8_LDA(At, 0, 1); PG8_STAGE(PG8_SB(0, 0), b2, voffB); PG8_STAGE(PG8_SB(0, 1), b2 + hstepB, voffB); PG8_STAGE(PG8_SA(0, 0), a2, voffA);
            PG8_WAIT_V(8); PG8_WAIT_L(0); PG8_BAR; PG8_MMA(1, 0, At, B0); PG8_MMA(1, 1, At, B1); PG8_BAR; PG8_SCHED;
            PG8_LDB(B0, 1, 0); PG8_LDB(B1, 1, 1); PG8_SCHED; PG8_LDA(At, 1, 0); PG8_STAGE(PG8_SA(0, 1), a2 + hstepA, voffA);
            PG8_WAIT_V(8); PG8_WAIT_L(0); PG8_BAR; PG8_MMA(0, 0, At, B0); PG8_MMA(0, 1, At, B1); PG8_BAR; PG8_SCHED;
            PG8_LDA(At, 1, 1); PG8_STAGE(PG8_SB(1, 0), b3, voffB); PG8_STAGE(PG8_SB(1, 1), b3 + hstepB, voffB); PG8_STAGE(PG8_SA(1, 0), a3, voffA);
            PG8_WAIT_V(8); PG8_WAIT_L(0); PG8_BAR; PG8_MMA(1, 0, At, B0); PG8_MMA(1, 1, At, B1); PG8_BAR; PG8_SCHED;
            } else {
            PG8_LDB(B0, 0, 0); PG8_SCHED; PG8_LDA(At, 0, 0); PG8_STAGE(PG8_SA(1, 1), a1 + hstepA, voffA);
            PG8_WAIT_L(8); PG8_BAR; PG8_WAIT_L(0); PG8_MMA(0, 0, At, B0); PG8_BAR; PG8_SCHED;
            PG8_LDB(B1, 0, 1); PG8_STAGE(PG8_SB(0, 0), b2, voffB);
            PG8_BAR; PG8_WAIT_L(0); PG8_MMA(0, 1, At, B1); PG8_BAR;
            PG8_LDA(At, 0, 1); PG8_STAGE(PG8_SA(0, 0), a2, voffA);
            PG8_BAR; PG8_WAIT_L(0); PG8_MMA(1, 0, At, B0); PG8_BAR; PG8_SCHED;
            PG8_STAGE(PG8_SB(0, 1), b2 + hstepB, voffB);
            PG8_WAIT_V(6); PG8_BAR; PG8_MMA(1, 1, At, B1); PG8_BAR;
            PG8_LDB(B0, 1, 0); PG8_SCHED; PG8_LDA(At, 1, 0); PG8_STAGE(PG8_SA(0, 1), a2 + hstepA, voffA);
            PG8_WAIT_L(8); PG8_BAR; PG8_WAIT_L(0); PG8_MMA(0, 0, At, B0); PG8_BAR; PG8_SCHED;
            PG8_LDB(B1, 1, 1); PG8_STAGE(PG8_SB(1, 0), b3, voffB);
            PG8_BAR; PG8_WAIT_L(0); PG8_MMA(0, 1, At, B1); PG8_BAR;
            PG8_LDA(At, 1, 1); PG8_STAGE(PG8_SA(1, 0), a3, voffA);
            PG8_BAR; PG8_WAIT_L(0); PG8_MMA(1, 0, At, B0); PG8_BAR; PG8_SCHED;
            PG8_STAGE(PG8_SB(1, 1), b3 + hstepB, voffB);
            PG8_WAIT_V(6); PG8_BAR; PG8_MMA(1, 1, At, B1); PG8_BAR;
            }
        }
        if constexpr (ALIGN_EPI) { if (wr == 0) PG8_BAR; }
        if constexpr (!Epi::AFTER_DRAIN) { E(acc, cur, wr, wc, fr, fq); S.done(cur); }
        if (!has_next) break;
#pragma unroll
        for (int a = 0; a < 2; ++a)
#pragma unroll
            for (int b = 0; b < 2; ++b)
#pragma unroll
                for (int m = 0; m < 4; ++m)
#pragma unroll
                    for (int n = 0; n < 2; ++n) acc[a][b][m][n] = (f32x4){0.f, 0.f, 0.f, 0.f};
        cur = nxt; cA = nA; cB = nB; ++ui;
        if constexpr (ALIGN_EPI) { if (wr == 1) PG8_BAR; }
    }
    PG8_WAIT_V(0);
    if constexpr (!ALIGN_EPI) { if (wr == 0) PG8_BAR; }
    PG8_BAR;
    if constexpr (Epi::AFTER_DRAIN) { E.fused(acc, cur, wr, wc, fr, fq, lds, wid, lane); S.done(cur); }
#undef PG8_SA
#undef PG8_SB
#undef PG8_STAGE
#undef PG8_LDA
#undef PG8_LDB
#undef PG8_MMA
#undef PG8_WAIT_V
#undef PG8_WAIT_L
#undef PG8_BAR
#undef PG8_SCHED
}
}

constexpr int NWAVES = 8;
#ifndef MK_N_LAUNCHES
#define MK_N_LAUNCHES 1
#endif
constexpr int N_LAUNCHES = MK_N_LAUNCHES;
constexpr int NPH = 9;

constexpr int BATCH = 8, SEQ = 4096, D = 1024, M = BATCH * SEQ;
constexpr int HGW = 512, HGH = 4, HGK = 128;
constexpr int S5W = 512, S5G = 32, S5P = 16, S5N = 64;
constexpr int S5L = 32, S5I = M / S5L, S5K = S5L * S5P + 2 * S5N;
constexpr int NPROJ = 2560;
constexpr int PK = 128, PH = 8, PTOPK = 16, PQ = 256, PHALF = 128, PE = PK * PK, NQ2 = PH * PQ;
constexpr float LN_EPS = 1e-5f, RMS_EPS = 1e-6f;
constexpr float DN_ALPHA = 1.189207115002721f;

constexpr size_t MiB = 1u << 20;
constexpr size_t WS_CTL = 0, CTL_ZERO_BYTES = 1 * MiB;
constexpr size_t WS_WIN = 1 * MiB;
constexpr size_t WS_WGLU = 6 * MiB;
constexpr size_t WS_KEYS = 6 * MiB + 512 * 1024;
constexpr size_t WS_LB = 6 * MiB + 640 * 1024;
constexpr size_t WS_S5T = 6 * MiB + 704 * 1024;
constexpr size_t WS_WOUT = 7 * MiB + 512 * 1024;
constexpr size_t WS_WQ = 10 * MiB;
constexpr size_t WS_SST = 14 * MiB;
constexpr size_t WS_H = 78 * MiB;
constexpr size_t WS_PROJ = 142 * MiB;
constexpr size_t WS_Q2 = WS_PROJ;
constexpr size_t WS_A5 = 270 * MiB;
constexpr size_t WS_MIX = 310 * MiB;
constexpr size_t WS_PD = 452 * MiB, WS_PU = 468 * MiB;
constexpr size_t WS_Z = 374 * MiB;
constexpr size_t WS_EIDX = WS_Z, WS_EGATE = WS_Z + 16 * MiB;
constexpr size_t WS_T5 = 406 * MiB;
constexpr size_t WS_G5 = 426 * MiB;
constexpr size_t WS_XLOC = 434 * MiB;
constexpr size_t WS_KTAU = 450 * MiB;
constexpr size_t WS_PW = 451 * MiB;
constexpr size_t WS_END = 484 * MiB;
constexpr int CW_TMO = 0, CW_CODE = 1;
constexpr int CW_BAR = 4096, CW_BAR2 = 8192;
constexpr int CW_CONV = 65536;

constexpr int RING_OFF = 0, RING_BYTES = 147456;
constexpr int LDSCTL_OFF = RING_BYTES, MISC_OFF = LDSCTL_OFF + 320;
constexpr int LDS_BYTES = 151552;
static_assert(MISC_OFF + 128 <= LDS_BYTES, "LDS map");

#define GAS __attribute__((address_space(1)))
#define LAS __attribute__((address_space(3)))
typedef unsigned short bf16;
typedef unsigned v4u __attribute__((ext_vector_type(4)));
typedef float f32x4 __attribute__((ext_vector_type(4)));
typedef short bf16x8 __attribute__((ext_vector_type(8)));
typedef GAS unsigned gu32;
typedef GAS unsigned long long gu64;
#define RLX_AGENT __ATOMIC_RELAXED, __HIP_MEMORY_SCOPE_AGENT
#define LDS_WAIT() asm volatile("s_waitcnt lgkmcnt(0)" ::: "memory")
#define VM_WAIT() asm volatile("s_waitcnt vmcnt(0)" ::: "memory")
__device__ __forceinline__ unsigned long long rt() { return __builtin_amdgcn_s_memrealtime(); }
__device__ __forceinline__ unsigned f2bf(float f) { unsigned u = __builtin_bit_cast(unsigned, f); return (u + 0x7fffu + ((u >> 16) & 1u)) >> 16; }
__device__ __forceinline__ unsigned pk2(float lo, float hi) { return f2bf(lo) | (f2bf(hi) << 16); }

#define XB_TMO      128
#define XB_XCNT(j)  (256  + 64 * (j))
#define XB_XSUB(j)  (1280 + 64 * (j))
#define XB_XGEN(j)  (2304 + 64 * (j))
#define XB_TOP      3328
#define XB_TOPGEN   3392
#define XCD_BAR_WORDS 3456
#define XB_SPIN_CAP (1u << 18)

__device__ __forceinline__ unsigned xb_ld(unsigned* p)              { return __hip_atomic_load(p, __ATOMIC_RELAXED, __HIP_MEMORY_SCOPE_AGENT); }
__device__ __forceinline__ unsigned xb_add(unsigned* p, unsigned v) { return __hip_atomic_fetch_add(p, v, __ATOMIC_RELAXED, __HIP_MEMORY_SCOPE_AGENT); }
__device__ __forceinline__ unsigned xb_xcc_id() { return (unsigned)__builtin_amdgcn_s_getreg((3 << 11) | 20) & 0xFu; }
#define XB_SPIN(cond, bar) do { unsigned _sp = 0; while (cond) { __builtin_amdgcn_s_sleep(1); \
    if ((++_sp & 255u) == 0u) { if (xb_ld(&(bar)[XB_TMO])) break; if (_sp > XB_SPIN_CAP) { atomicAdd(&(bar)[XB_TMO], 1u); break; } } } } while (0)

struct XcdBarrier {
    unsigned* bar; unsigned x; unsigned G;
    volatile LAS unsigned* st;
};

__device__ __forceinline__ XcdBarrier xcd_barrier_post(unsigned* bar, volatile LAS unsigned* st, unsigned G) {
    XcdBarrier b; b.bar = bar; b.x = xb_xcc_id(); b.st = st; b.G = G;
    if (threadIdx.x == 0) (void)xb_add(&bar[XB_XCNT(b.x)], 1u);
    return b;
}
__device__ __forceinline__ void xcd_barrier_complete(unsigned* bar, unsigned x, unsigned G, unsigned& nloc, unsigned& nx) {
    unsigned sum, cnt, mine, sp = 0u;
    for (;;) {
        sum = 0u; cnt = 0u; mine = 0u;
#pragma unroll
        for (unsigned j = 0; j < 16; ++j) { const unsigned c = xb_ld(&bar[XB_XCNT(j)]); sum += c; cnt += (c > 0u) ? 1u : 0u; mine = (j == x) ? c : mine; }
        if (sum == G) break;
        __builtin_amdgcn_s_sleep(1);
        if ((++sp & 255u) == 0u) { if (xb_ld(&bar[XB_TMO])) break; if (sp > XB_SPIN_CAP) { atomicAdd(&bar[XB_TMO], 1u); break; } }
    }
    nloc = mine > 0u ? mine : 1u; nx = cnt > 0u ? cnt : 1u;
}

__device__ __forceinline__ void xcd_barrier(const XcdBarrier& b) {
    asm volatile("s_waitcnt vmcnt(0)" ::: "memory");
    __syncthreads();
    if (threadIdx.x == 0) {
        unsigned* bar = b.bar;
        __builtin_amdgcn_s_waitcnt(0);
        unsigned nloc = b.st[0], nx = b.st[1];
        if (nloc == 0u) { xcd_barrier_complete(bar, b.x, b.G, nloc, nx); b.st[0] = nloc; b.st[1] = nx; }
        const unsigned old = xb_add(&bar[XB_XSUB(b.x)], 1u);
        const unsigned gen = old / nloc;
        if (old + 1u == (gen + 1u) * nloc) {
            __builtin_amdgcn_fence(__ATOMIC_RELEASE, "agent");
            asm volatile("s_waitcnt vmcnt(0)" ::: "memory");
            const unsigned og = xb_add(&bar[XB_TOP], 1u);
            const unsigned tg = og / nx;
            if (og + 1u == (tg + 1u) * nx) xb_add(&bar[XB_TOPGEN], 1u);
            else XB_SPIN(xb_ld(&bar[XB_TOPGEN]) == tg, bar);
            __builtin_amdgcn_fence(__ATOMIC_ACQUIRE, "agent");
            xb_add(&bar[XB_XGEN(b.x)], 1u);
            asm volatile("s_waitcnt vmcnt(0)" ::: "memory");
        } else {
            XB_SPIN(xb_ld(&bar[XB_XGEN(b.x)]) == gen, bar);
            __builtin_amdgcn_fence(__ATOMIC_ACQUIRE, "agent");
            asm volatile("s_waitcnt vmcnt(0)" ::: "memory");
        }
    }
    __syncthreads();
}

struct Frame {
    LAS unsigned char* lds;
    volatile LAS unsigned* MISC;
    gu32* ctl;
    int tid, lane, wave;
    int vcu, G;
    const float* in[26]; float* out; unsigned char* ws;
};
enum { I_X = 0, I_LN0G, I_LN0B, I_WIN, I_LBL, I_HGNG, I_ARE, I_AIM, I_LSTEP, I_BRE, I_BIM, I_CRE, I_CIM, I_DSK, I_WGLU, I_BGLU, I_WOUT, I_LN1G, I_LN1B, I_WQ, I_K1, I_K2, I_PD, I_PU, I_LN2G, I_LN2B };

typedef float f32x2 __attribute__((ext_vector_type(2)));
__device__ __forceinline__ float bf2f(bf16 v) { return __builtin_bit_cast(float, (unsigned)v << 16); }
__device__ __forceinline__ float wave_sum(float v) {
#pragma unroll
    for (int o = 1; o < 64; o <<= 1) v += __shfl_xor(v, o);
    return v;
}
__device__ __forceinline__ float wave_max(float v) {
#pragma unroll
    for (int o = 1; o < 64; o <<= 1) v = fmaxf(v, __shfl_xor(v, o));
    return v;
}
__device__ __forceinline__ float gelu_tanh(float x) { const float y = 0.7978845608028654f * (x + 0.044715f * x * x * x); return x / (1.f + __expf(-2.f * y)); }
__device__ __forceinline__ float silu_f(float x) { return x / (1.f + __expf(-x)); }
__device__ __forceinline__ void unpack8(const v4u w, float (&f)[8]) {
    f[0] = __builtin_bit_cast(float, w.x << 16); f[1] = __builtin_bit_cast(float, w.x & 0xffff0000u);
    f[2] = __builtin_bit_cast(float, w.y << 16); f[3] = __builtin_bit_cast(float, w.y & 0xffff0000u);
    f[4] = __builtin_bit_cast(float, w.z << 16); f[5] = __builtin_bit_cast(float, w.z & 0xffff0000u);
    f[6] = __builtin_bit_cast(float, w.w << 16); f[7] = __builtin_bit_cast(float, w.w & 0xffff0000u);
}
__device__ __forceinline__ v4u pack8(const float (&f)[8]) { v4u w; w.x = pk2(f[0], f[1]); w.y = pk2(f[2], f[3]); w.z = pk2(f[4], f[5]); w.w = pk2(f[6], f[7]); return w; }

__device__ __forceinline__ void fast_sincos(float x, float& sn, float& cs) {
    const float k = rintf(x * 0.15915494309189535f); float r = fmaf(-k, 6.28318548202514648f, x); r = fmaf(-k, -1.74845553146e-7f, r);
    sn = __sinf(r); cs = __cosf(r);
}
__device__ __forceinline__ void p0_transpose_item(const float* W, int K, int N, bf16* WT, int row_off, LAS float* scr, int item, int lane) {
    const int nblk = N / 32, kb = item / nblk, nb = item % nblk, k0 = 64 * kb, n0 = 32 * nb;
#pragma unroll 8
    for (int i = 0; i < 32; ++i) { const int kk = 2 * i + (lane >> 5); scr[kk * 33 + (lane & 31)] = W[(size_t)(k0 + kk) * N + n0 + (lane & 31)]; }
    LDS_WAIT(); asm volatile("" ::: "memory");
    const int c = lane & 7;
#pragma unroll
    for (int j = 0; j < 4; ++j) { const int n = (lane >> 3) + 8 * j; const LAS float* s = scr + (8 * c) * 33 + n;
        v4u o; o.x = pk2(s[0 * 33], s[1 * 33]); o.y = pk2(s[2 * 33], s[3 * 33]); o.z = pk2(s[4 * 33], s[5 * 33]); o.w = pk2(s[6 * 33], s[7 * 33]);
        *(GAS v4u*)(WT + (size_t)(row_off + n0 + n) * K + k0 + 8 * c) = o; }
    LDS_WAIT(); asm volatile("" ::: "memory");
}
__device__ __forceinline__ void ln0_row(const float* xrow, const float* g, const float* b, bf16* orow, int lane) {
    const GAS f32x4* xr = (const GAS f32x4*)xrow + lane;
    f32x4 v[4]; float s = 0.f;
#pragma unroll
    for (int j = 0; j < 4; ++j) { v[j] = xr[64 * j]; s += (v[j].x + v[j].y) + (v[j].z + v[j].w); }
    const float mean = wave_sum(s) * (1.f / D); float s2 = 0.f;
#pragma unroll
    for (int j = 0; j < 4; ++j) { v[j] = v[j] - mean; s2 += (v[j].x * v[j].x + v[j].y * v[j].y) + (v[j].z * v[j].z + v[j].w * v[j].w); }
    const float rstd = 1.f / sqrtf(wave_sum(s2) * (1.f / D) + LN_EPS);
    GAS unsigned long long* o8 = (GAS unsigned long long*)orow + lane;
#pragma unroll
    for (int j = 0; j < 4; ++j) { const f32x4 gg = ((const GAS f32x4*)g)[lane + 64 * j], bb = ((const GAS f32x4*)b)[lane + 64 * j];
        const f32x4 o = v[j] * rstd * gg + bb;
        o8[64 * j] = (unsigned long long)pk2(o.x, o.y) | ((unsigned long long)pk2(o.z, o.w) << 32); }
}
__device__ __forceinline__ void p0_prologue(Frame& F) {
    LAS float* scr = (LAS float*)(F.lds + RING_OFF + F.wave * 16384);
    constexpr int TW = 2, LW = NWAVES - TW;
    unsigned char* ws = F.ws;
    if (F.wave >= LW) {
    const int gw = F.vcu * TW + (F.wave - LW), NGW = F.G * TW;
    constexpr int I_IN = (D / 64) * (NPROJ / 32), I_GLU = (512 / 64) * (512 / 32), I_OUT = (1024 / 64) * (1024 / 32), I_Q = (1024 / 64) * (2048 / 32);
    constexpr int NITEMS = I_IN + I_GLU + I_OUT + I_Q;
    for (int it = gw; it < NITEMS; it += NGW) {
        int r = it;
        if (r < I_IN) { p0_transpose_item(F.in[I_WIN], D, NPROJ, (bf16*)(ws + WS_WIN), 0, scr, r, F.lane); continue; } r -= I_IN;
        if (r < I_GLU) { p0_transpose_item(F.in[I_WGLU], 512, 512, (bf16*)(ws + WS_WGLU), 0, scr, r, F.lane); continue; } r -= I_GLU;
        if (r < I_OUT) { p0_transpose_item(F.in[I_WOUT], 1024, 1024, (bf16*)(ws + WS_WOUT), 0, scr, r, F.lane); continue; } r -= I_OUT;
        p0_transpose_item(F.in[I_WQ], 1024, 2048, (bf16*)(ws + WS_WQ), 0, scr, r, F.lane);
    }
    const int gt = gw * 64 + F.lane, NGT = NGW * 64;
    for (int i = gt; i < 2 * PK * PHALF; i += NGT) { const float v = (i < PK * PHALF) ? F.in[I_K1][i] : F.in[I_K2][i - PK * PHALF]; ((bf16*)(ws + WS_KEYS))[i] = (bf16)f2bf(v); }
    for (int i = ((gt - 2048) % NGT + NGT) % NGT; i < HGW; i += NGT) { const float l0 = F.in[I_LBL][i], l1 = F.in[I_LBL][HGW + i]; ((float*)(ws + WS_LB))[i] = 1.f / (1.f + expf(l1 - l0)); }
    for (int i = gt; i < S5G * S5N; i += NGT) { const int g = i / S5N;
        const float are = F.in[I_ARE][i], aim = F.in[I_AIM][i], step = expf(F.in[I_LSTEP][g]);
        const float zr = step * are, zi = step * aim, mag = expf(zr); float cz, sz, sh, ch; fast_sincos(zi, sz, cz); fast_sincos(0.5f * zi, sh, ch);
        const float abr = mag * cz, abi = mag * sz;
        const float nre = expm1f(zr) * cz - 2.f * sh * sh, nim = abi;
        const float den = are * are + aim * aim;
        const float cre = (nre * are + nim * aim) / den, cim = (nim * are - nre * aim) / den;
        f32x4 brv[4], biv[4];
#pragma unroll
        for (int p4 = 0; p4 < 4; ++p4) { brv[p4] = *(const GAS f32x4*)(F.in[I_BRE] + (size_t)i * S5P + 4 * p4); biv[p4] = *(const GAS f32x4*)(F.in[I_BIM] + (size_t)i * S5P + 4 * p4); }
        float* t = (float*)(ws + WS_S5T) + (size_t)i * 40; *(GAS f32x2*)t = (f32x2){abr, abi};
#pragma unroll
        for (int p4 = 0; p4 < 4; ++p4) { const f32x4 br = brv[p4], bi = biv[p4];
            *(GAS f32x2*)(t + 2 + 4 * p4) = (f32x2){cre * br.x - cim * bi.x, cre * br.y - cim * bi.y}; *(GAS f32x2*)(t + 4 + 4 * p4) = (f32x2){cre * br.z - cim * bi.z, cre * br.w - cim * bi.w};
            *(GAS f32x2*)(t + 18 + 4 * p4) = (f32x2){cre * bi.x + cim * br.x, cre * bi.y + cim * br.y}; *(GAS f32x2*)(t + 20 + 4 * p4) = (f32x2){cre * bi.z + cim * br.z, cre * bi.w + cim * br.w}; } }
    for (int i = gt; i < S5G * S5N * 33; i += NGT) { const int gn = i / 33, tau = i % 33, g = gn / S5N;
        const float step = expf(F.in[I_LSTEP][g]), zr = step * F.in[I_ARE][gn] * (float)tau, zi = step * F.in[I_AIM][gn] * (float)tau, mag = expf(zr);
        float sn, cs; fast_sincos(zi, sn, cs); *(GAS f32x2*)((float*)(ws + WS_PW) + (size_t)i * 2) = (f32x2){mag * cs, mag * sn}; }
    } else {
    f32x4 gg[4], bb[4];
#pragma unroll
    for (int j = 0; j < 4; ++j) { gg[j] = ((const GAS f32x4*)F.in[I_LN0G])[F.lane + 64 * j]; bb[j] = ((const GAS f32x4*)F.in[I_LN0B])[F.lane + 64 * j]; }
    const int gw = F.vcu * LW + F.wave, NGW = F.G * LW;
    f32x4 nv[4][4];
    { const int m0 = gw * 4;
#pragma unroll
      for (int r = 0; r < 4; ++r)
#pragma unroll
          for (int j = 0; j < 4; ++j) nv[r][j] = ((const GAS f32x4*)(F.in[I_X] + (size_t)(m0 + r) * D))[F.lane + 64 * j]; }
    for (int m0 = gw * 4; m0 < M; m0 += NGW * 4) {
        f32x4 v[4][4];
#pragma unroll
        for (int r = 0; r < 4; ++r)
#pragma unroll
            for (int j = 0; j < 4; ++j) v[r][j] = nv[r][j];
        if (m0 + NGW * 4 < M) {
#pragma unroll
            for (int r = 0; r < 4; ++r)
#pragma unroll
                for (int j = 0; j < 4; ++j) nv[r][j] = ((const GAS f32x4*)(F.in[I_X] + (size_t)(m0 + NGW * 4 + r) * D))[F.lane + 64 * j]; }
#pragma unroll
        for (int r = 0; r < 4; ++r) { float sm = 0.f;
#pragma unroll
            for (int j = 0; j < 4; ++j) sm += (v[r][j].x + v[r][j].y) + (v[r][j].z + v[r][j].w);
            const float mean = wave_sum(sm) * (1.f / D); float s2 = 0.f;
#pragma unroll
            for (int j = 0; j < 4; ++j) { v[r][j] = v[r][j] - mean; s2 += (v[r][j].x * v[r][j].x + v[r][j].y * v[r][j].y) + (v[r][j].z * v[r][j].z + v[r][j].w * v[r][j].w); }
            const float rstd = 1.f / sqrtf(wave_sum(s2) * (1.f / D) + LN_EPS);
            GAS unsigned long long* o8 = (GAS unsigned long long*)((bf16*)(ws + WS_H) + (size_t)(m0 + r) * D) + F.lane;
#pragma unroll
            for (int j = 0; j < 4; ++j) { const f32x4 o = v[r][j] * rstd * gg[j] + bb[j]; o8[64 * j] = (unsigned long long)pk2(o.x, o.y) | ((unsigned long long)pk2(o.z, o.w) << 32); } }
    }
    }
}

__device__ __forceinline__ int t256(int r, int c) { return r * 256 + ((((c >> 3) ^ (r & 15))) << 4) + (c & 7) * 2; }
__device__ __forceinline__ int t128(int r, int c) { return r * 128 + ((((c >> 3) ^ (r & 7))) << 4) + (c & 7) * 2; }
typedef unsigned v2u __attribute__((ext_vector_type(2)));
__device__ __forceinline__ unsigned offb(unsigned row, unsigned ch) { return 256u * row + 16u * (ch ^ (((row & 3u) << 2) | ((row >> 2) & 3u))); }
typedef short v4i16_t __attribute__((ext_vector_type(4)));
__device__ __forceinline__ bf16x8 tr_frag16(LAS unsigned char* tile, int lane, int c, int ks) {
    const unsigned g = lane >> 4, q = (lane & 15) >> 2, p = lane & 3;
    const v4i16_t lo = __builtin_amdgcn_ds_read_tr16_b64_v4i16((LAS v4i16_t*)(tile + offb(32 * ks + 8 * g + q, 2 * c + (p >> 1)) + 8 * (p & 1)));
    const v4i16_t hi = __builtin_amdgcn_ds_read_tr16_b64_v4i16((LAS v4i16_t*)(tile + offb(32 * ks + 8 * g + 4 + q, 2 * c + (p >> 1)) + 8 * (p & 1)));
    bf16x8 r; r[0] = lo[0]; r[1] = lo[1]; r[2] = lo[2]; r[3] = lo[3]; r[4] = hi[0]; r[5] = hi[1]; r[6] = hi[2]; r[7] = hi[3]; return r;
}
__device__ __forceinline__ void hgrn2_state_pass(Frame& F, int item) {
    const int bh = item >> 2, ksl = item & 3, b = bh >> 2, h = bh & 3, tid = F.tid, lane = F.lane, w = F.wave, fr = lane & 15, fq = lane >> 4;
    const int kcol = tid & 31, sg = tid >> 5;
    LAS unsigned char* L = F.lds + RING_OFF;
    LAS unsigned char* sRaw = L + 49152;
    const bf16* LFg = (const bf16*)(F.ws + WS_PROJ) + (size_t)M * 512 + (size_t)b * SEQ * 512 + h * 128 + ksl * 32;
    const bf16* Vg = (const bf16*)(F.ws + WS_PROJ) + (size_t)2 * M * 512 + (size_t)b * SEQ * 512 + h * 128;
    bf16* SST = (bf16*)(F.ws + WS_SST) + (size_t)bh * 64 * 128 * 128 + ksl * 32;
    float S[2][4];
#pragma unroll
    for (int i = 0; i < 2; ++i)
#pragma unroll
        for (int r = 0; r < 4; ++r) S[i][r] = 0.f;
    const int ls = (tid & 255) >> 2, lkg = tid & 3;
    const int vs0 = tid >> 4, vch = tid & 15;
    v4u nlf = *(const GAS v4u*)(LFg + (size_t)ls * 512 + lkg * 8);
    v4u nv0 = *(const GAS v4u*)(Vg + (size_t)vs0 * 512 + vch * 8), nv1 = *(const GAS v4u*)(Vg + (size_t)(32 + vs0) * 512 + vch * 8);
    v4u n2lf = *(const GAS v4u*)(LFg + (size_t)(64 + ls) * 512 + lkg * 8);
    v4u n2v0 = *(const GAS v4u*)(Vg + (size_t)(64 + vs0) * 512 + vch * 8), n2v1 = *(const GAS v4u*)(Vg + (size_t)(96 + vs0) * 512 + vch * 8);
    v4u n3lf = *(const GAS v4u*)(LFg + (size_t)(128 + ls) * 512 + lkg * 8);
    v4u n3v0 = *(const GAS v4u*)(Vg + (size_t)(128 + vs0) * 512 + vch * 8), n3v1 = *(const GAS v4u*)(Vg + (size_t)(160 + vs0) * 512 + vch * 8);
    for (int c = 0; c < 64; ++c) {
        LAS unsigned char* Lb = L + (c & 1) * 24576;
        LAS unsigned char* sKT = Lb; LAS unsigned char* sVT = Lb + 4096; LAS float* sTot = (LAS float*)(Lb + 20480); LAS float* sDec = (LAS float*)(Lb + 22528);
        if (tid < 256) *(LAS v4u*)(sRaw + ls * 64 + lkg * 16) = nlf;
        *(LAS v4u*)(sVT + offb(vs0, vch)) = nv0; *(LAS v4u*)(sVT + offb(32 + vs0, vch)) = nv1;
        nlf = n2lf; nv0 = n2v0; nv1 = n2v1; n2lf = n3lf; n2v0 = n3v0; n2v1 = n3v1;
        if (c + 3 < 64) { const size_t t3 = (size_t)(c + 3) * 64;
            n3lf = *(const GAS v4u*)(LFg + (t3 + ls) * 512 + lkg * 8); n3v0 = *(const GAS v4u*)(Vg + (t3 + vs0) * 512 + vch * 8); n3v1 = *(const GAS v4u*)(Vg + (t3 + 32 + vs0) * 512 + vch * 8); }
        __syncthreads();
        float lf[4];
#pragma unroll
        for (int j = 0; j < 4; ++j) lf[j] = bf2f(*(const LAS bf16*)(sRaw + (sg * 4 + j) * 64 + kcol * 2));
        float cl[4]; float run = 0.f;
#pragma unroll
        for (int j = 0; j < 4; ++j) { run += lf[j]; cl[j] = run; }
        sTot[sg * 32 + kcol] = run;
        __syncthreads();
        float off = 0.f, last = 0.f;
#pragma unroll
        for (int q = 0; q < 16; ++q) { const float tq = sTot[q * 32 + kcol]; off += (q < sg) ? tq : 0.f; last += tq; }
        float kh[4];
#pragma unroll
        for (int j = 0; j < 4; ++j) kh[j] = (1.f - __expf(lf[j])) * __expf(last - (off + cl[j]));
        { v2u pk; pk.x = pk2(kh[0], kh[1]); pk.y = pk2(kh[2], kh[3]);
          *(LAS v2u*)(sKT + kcol * 128 + ((((sg >> 1) ^ (kcol & 7))) << 4) + (sg & 1) * 8) = pk; }
        if (sg == 0) sDec[kcol] = __expf(last);
        __syncthreads();
        f32x4 acc[2] = {(f32x4){0.f, 0.f, 0.f, 0.f}, (f32x4){0.f, 0.f, 0.f, 0.f}};
        const int mt = w & 1, nt0 = (w >> 1) * 2;
#pragma unroll
        for (int ks = 0; ks < 2; ++ks) { const int ch = ks * 4 + fq, row = 16 * mt + fr;
            const bf16x8 af = *(const LAS bf16x8*)(sKT + row * 128 + ((ch ^ (row & 7)) << 4));
#pragma unroll
            for (int nt = 0; nt < 2; ++nt) { const bf16x8 bfm = tr_frag16(sVT, lane, nt0 + nt, ks);
                acc[nt] = __builtin_amdgcn_mfma_f32_16x16x32_bf16(af, bfm, acc[nt], 0, 0, 0); } }
        const int k0 = 16 * mt + fq * 4; const f32x4 dec = *(const LAS f32x4*)(sDec + k0);
#pragma unroll
        for (int nt = 0; nt < 2; ++nt) { const int vg = 16 * (nt0 + nt) + fr;
            v2u o; o.x = pk2(S[nt][0], S[nt][1]); o.y = pk2(S[nt][2], S[nt][3]);
            *(GAS v2u*)(SST + ((size_t)c * 128 + vg) * 128 + k0) = o;
            S[nt][0] = dec[0] * S[nt][0] + acc[nt][0]; S[nt][1] = dec[1] * S[nt][1] + acc[nt][1]; S[nt][2] = dec[2] * S[nt][2] + acc[nt][2]; S[nt][3] = dec[3] * S[nt][3] + acc[nt][3]; }
    }
    __syncthreads();
}
struct HgOutRegs { v4u lf[2], q[2], v[2], st[4]; };
__device__ __forceinline__ void hgrn2_out_load(Frame& F, int item, HgOutRegs& R) {
    const int bh = item >> 6, c = item & 63, b = bh >> 2, h = bh & 3, tid = F.tid;
    const size_t tok0 = (size_t)b * SEQ + (size_t)c * 64;
    const bf16* Qb = (const bf16*)(F.ws + WS_PROJ) + tok0 * 512 + h * 128; const bf16* LFb = Qb + (size_t)M * 512; const bf16* Vb = Qb + (size_t)2 * M * 512;
    const bf16* SST = (const bf16*)(F.ws + WS_SST) + (size_t)item * 128 * 128;
#pragma unroll
    for (int i = 0; i < 2; ++i) { const int idx = tid + 512 * i, sr = idx >> 4, ch = idx & 15;
        R.lf[i] = *(const GAS v4u*)(LFb + (size_t)sr * 512 + ch * 8); R.q[i] = *(const GAS v4u*)(Qb + (size_t)sr * 512 + ch * 8); R.v[i] = *(const GAS v4u*)(Vb + (size_t)sr * 512 + ch * 8); }
#pragma unroll
    for (int i = 0; i < 4; ++i) { const int idx = tid + 512 * i; R.st[i] = *(const GAS v4u*)(SST + (size_t)(idx >> 4) * 128 + (idx & 15) * 8); }
}
__device__ __forceinline__ void hgrn2_out_phase(Frame& F) {
    const int tid = F.tid, lane = F.lane, w = F.wave, fr = lane & 15, fq = lane >> 4;
    const int kcol = tid & 127, qtr = tid >> 7;
    LAS unsigned char* L = F.lds + RING_OFF;
    LAS unsigned char* sQt = L; LAS unsigned char* sQm = L + 16384; LAS unsigned char* sKm = L + 32768; LAS unsigned char* sV = L + 49152; LAS unsigned char* sST = L + 65536; LAS unsigned char* sP = L + 98304;
    LAS float* sTot = (LAS float*)(L + 106496); LAS float* sSS = (LAS float*)(L + 108544);
    LAS unsigned char* rLF = L + 110592; LAS unsigned char* rQ = L + 126976;
    HgOutRegs R;
    int item = F.vcu;
    if (item < 32 * 64) hgrn2_out_load(F, item, R);
    for (; item < 32 * 64; item += F.G) {
        const int bh = item >> 6, c = item & 63, b = bh >> 2, h = bh & 3;
        const size_t tok0 = (size_t)b * SEQ + (size_t)c * 64;
        const bf16* Gb = (const bf16*)(F.ws + WS_PROJ) + (size_t)3 * M * 512 + tok0 * 512 + h * 128;
        bf16* MIX = (bf16*)(F.ws + WS_MIX) + tok0 * 1024 + h * 128;
#pragma unroll
        for (int i = 0; i < 2; ++i) { const int idx = tid + 512 * i, sr = idx >> 4, ch = idx & 15;
            *(LAS v4u*)(rLF + sr * 256 + ch * 16) = R.lf[i]; *(LAS v4u*)(rQ + sr * 256 + ch * 16) = R.q[i]; *(LAS v4u*)(sV + offb(sr, ch)) = R.v[i]; }
#pragma unroll
        for (int i = 0; i < 4; ++i) { const int idx = tid + 512 * i, v = idx >> 4, kc = idx & 15; *(LAS v4u*)(sST + v * 256 + ((kc ^ (v & 15)) << 4)) = R.st[i]; }
        if (item + F.G < 32 * 64) hgrn2_out_load(F, item + F.G, R);
        __syncthreads();
        float lf[16], q[16];
#pragma unroll
        for (int j = 0; j < 16; ++j) { lf[j] = bf2f(*(const LAS bf16*)(rLF + (qtr * 16 + j) * 256 + kcol * 2)); q[j] = bf2f(*(const LAS bf16*)(rQ + (qtr * 16 + j) * 256 + kcol * 2)); }
        float cl[16]; float run = 0.f;
#pragma unroll
        for (int j = 0; j < 16; ++j) { run += lf[j]; cl[j] = run; }
        sTot[qtr * 128 + kcol] = run;
        __syncthreads();
        { const float t0 = sTot[kcol], t1 = sTot[128 + kcol], t2 = sTot[256 + kcol];
          const float off = (qtr > 0 ? t0 : 0.f) + (qtr > 1 ? t1 : 0.f) + (qtr > 2 ? t2 : 0.f), mid = t0 + t1;
#pragma unroll
          for (int j = 0; j < 16; ++j) { const int sdx = qtr * 16 + j; const float cum = off + cl[j];
              const int o = t256(sdx, kcol);
              *(LAS bf16*)(sQt + o) = (bf16)f2bf(q[j] * __expf(cum));
              *(LAS bf16*)(sQm + o) = (bf16)f2bf(q[j] * __expf(cum - mid));
              *(LAS bf16*)(sKm + o) = (bf16)f2bf((1.f - __expf(lf[j])) * __expf(mid - cum)); } }
        __syncthreads();
        const int tt = w >> 1, trow = 16 * tt + fr;
        v2u gpre[4];
#pragma unroll
        for (int i = 0; i < 4; ++i) gpre[i] = *(const GAS v2u*)(Gb + (size_t)trow * 512 + 16 * ((w & 1) * 4 + i) + fq * 4);
#pragma unroll
        for (int sti = 0; sti < 2; ++sti) { const int stl = (w & 1) * 2 + sti; f32x4 acc = (f32x4){0.f, 0.f, 0.f, 0.f};
            if (stl <= tt) {
#pragma unroll
                for (int ks = 0; ks < 4; ++ks) { const int ch = ks * 4 + fq, srow = 16 * stl + fr;
                    const bf16x8 af = *(const LAS bf16x8*)(sKm + srow * 256 + ((ch ^ (srow & 15)) << 4));
                    const bf16x8 bfm = *(const LAS bf16x8*)(sQm + trow * 256 + ((ch ^ (trow & 15)) << 4));
                    acc = __builtin_amdgcn_mfma_f32_16x16x32_bf16(af, bfm, acc, 0, 0, 0); } }
            const int s0 = 16 * stl + fq * 4;
            const float p0 = (s0 + 0 <= trow) ? acc[0] : 0.f, p1 = (s0 + 1 <= trow) ? acc[1] : 0.f, p2 = (s0 + 2 <= trow) ? acc[2] : 0.f, p3 = (s0 + 3 <= trow) ? acc[3] : 0.f;
            v2u o; o.x = pk2(p0, p1); o.y = pk2(p2, p3);
            *(LAS v2u*)(sP + trow * 128 + ((((s0 >> 3) ^ (trow & 7))) << 4) + (s0 & 7) * 2) = o; }
        __syncthreads();
        f32x4 oacc[4];
#pragma unroll
        for (int i = 0; i < 4; ++i) oacc[i] = (f32x4){0.f, 0.f, 0.f, 0.f};
#pragma unroll
        for (int ks = 0; ks < 4; ++ks) { const int ch = ks * 4 + fq;
            const bf16x8 bfm = *(const LAS bf16x8*)(sQt + trow * 256 + ((ch ^ (trow & 15)) << 4));
#pragma unroll
            for (int i = 0; i < 4; ++i) { const int vr = 16 * ((w & 1) * 4 + i) + fr; const bf16x8 af = *(const LAS bf16x8*)(sST + vr * 256 + ((ch ^ (vr & 15)) << 4));
                oacc[i] = __builtin_amdgcn_mfma_f32_16x16x32_bf16(af, bfm, oacc[i], 0, 0, 0); } }
#pragma unroll
        for (int ks = 0; ks < 2; ++ks) { const int ch = ks * 4 + fq;
            const bf16x8 bfm = *(const LAS bf16x8*)(sP + trow * 128 + ((ch ^ (trow & 7)) << 4));
#pragma unroll
            for (int i = 0; i < 4; ++i) { const bf16x8 af = tr_frag16(sV, lane, (w & 1) * 4 + i, ks);
                oacc[i] = __builtin_amdgcn_mfma_f32_16x16x32_bf16(af, bfm, oacc[i], 0, 0, 0); } }
        float ss = 0.f;
#pragma unroll
        for (int i = 0; i < 4; ++i) ss += (oacc[i][0] * oacc[i][0] + oacc[i][1] * oacc[i][1]) + (oacc[i][2] * oacc[i][2] + oacc[i][3] * oacc[i][3]);
        ss += __shfl_xor(ss, 16); ss += __shfl_xor(ss, 32);
        if (fq == 0) sSS[(w & 1) * 64 + trow] = ss;
        __syncthreads();
        const float rinv = 1.f / sqrtf((sSS[trow] + sSS[64 + trow]) * (1.f / 128.f) + RMS_EPS);
#pragma unroll
        for (int i = 0; i < 4; ++i) { const int v0 = 16 * ((w & 1) * 4 + i) + fq * 4;
            const v2u gw2 = gpre[i]; const f32x4 ng = *(const GAS f32x4*)(F.in[I_HGNG] + v0);
            const float g0 = __builtin_bit_cast(float, gw2.x << 16), g1 = __builtin_bit_cast(float, gw2.x & 0xffff0000u), g2 = __builtin_bit_cast(float, gw2.y << 16), g3 = __builtin_bit_cast(float, gw2.y & 0xffff0000u);
            v2u o; o.x = pk2(oacc[i][0] * rinv * ng[0] * silu_f(g0), oacc[i][1] * rinv * ng[1] * silu_f(g1)); o.y = pk2(oacc[i][2] * rinv * ng[2] * silu_f(g2), oacc[i][3] * rinv * ng[3] * silu_f(g3));
            *(GAS v2u*)(MIX + (size_t)trow * 1024 + v0) = o; }
        __syncthreads();
    }
}

__device__ __forceinline__ void s5_tables_stage1(Frame& F) {
    const int gt = (F.vcu * NWAVES + F.wave) * 64 + F.lane, NGT = F.G * NWAVES * 64;
    const float* S5T = (const float*)(F.ws + WS_S5T); const float* PW = (const float*)(F.ws + WS_PW);
    float* KT = (float*)(F.ws + WS_KTAU); bf16* G5 = (bf16*)(F.ws + WS_G5); bf16* T5 = (bf16*)(F.ws + WS_T5);
    for (int i = gt; i < S5G * 32 * 256; i += NGT) { const int g = i >> 13, tau = (i >> 8) & 31, p = (i >> 4) & 15, q = i & 15;
        float acc = (tau == 0 && p == q) ? F.in[I_DSK][g * 16 + p] : 0.f;
#pragma unroll 16
        for (int n = 0; n < S5N; ++n) { const int gn = g * S5N + n;
            const float cr = F.in[I_CRE][(size_t)(g * 16 + p) * S5N + n], ci = F.in[I_CIM][(size_t)(g * 16 + p) * S5N + n];
            const float wr = PW[((size_t)gn * 33 + tau) * 2], wi = PW[((size_t)gn * 33 + tau) * 2 + 1];
            const float br = S5T[(size_t)gn * 40 + 2 + q], bi = S5T[(size_t)gn * 40 + 18 + q];
            const float er = cr * wr - ci * wi, ei = cr * wi + ci * wr;
            acc += er * br - ei * bi; }
        KT[i] = acc; }
    for (int i = gt; i < S5G * 256 * 64; i += NGT) { const int g = i >> 14, r = (i >> 6) & 255, kc = i & 63, sdx = kc >> 1, q0 = (kc & 1) * 8;
        float f[8];
        if (r < 128) { const int n = r & 63, gn = g * S5N + n; const float wr = PW[((size_t)gn * 33 + (31 - sdx)) * 2], wi = PW[((size_t)gn * 33 + (31 - sdx)) * 2 + 1];
#pragma unroll
            for (int j = 0; j < 8; ++j) { const float br = S5T[(size_t)gn * 40 + 2 + q0 + j], bi = S5T[(size_t)gn * 40 + 18 + q0 + j]; f[j] = (r < 64) ? (wr * br - wi * bi) : (wr * bi + wi * br); }
        } else {
#pragma unroll
            for (int j = 0; j < 8; ++j) f[j] = 0.f; }
        *(GAS v4u*)(G5 + ((size_t)(g * 256 + r)) * 512 + kc * 8) = pack8(f); }
    for (int i = gt; i < S5G * 512 * 16; i += NGT) { const int g = i >> 13, row = (i >> 4) & 511, nc = i & 15, t = row >> 4, p = row & 15, im = nc >> 3, n0 = (nc & 7) * 8;
        float f[8];
#pragma unroll
        for (int j = 0; j < 8; ++j) { const int n = n0 + j, gn = g * S5N + n;
            const float cr = F.in[I_CRE][(size_t)(g * 16 + p) * S5N + n], ci = F.in[I_CIM][(size_t)(g * 16 + p) * S5N + n];
            const float wr = PW[((size_t)gn * 33 + t + 1) * 2], wi = PW[((size_t)gn * 33 + t + 1) * 2 + 1];
            f[j] = im ? -(cr * wi + ci * wr) : (cr * wr - ci * wi); }
        *(GAS v4u*)(T5 + ((size_t)(g * 512 + row)) * 640 + 512 + nc * 8) = pack8(f); }
}
__device__ __forceinline__ void s5_tables_stage2(Frame& F) {
    const int gt = (F.vcu * NWAVES + F.wave) * 64 + F.lane, NGT = F.G * NWAVES * 64;
    const float* KT = (const float*)(F.ws + WS_KTAU); bf16* T5 = (bf16*)(F.ws + WS_T5);
    for (int i = gt; i < S5G * 512 * 64; i += NGT) { const int g = i >> 15, row = (i >> 6) & 511, kc = i & 63, t = row >> 4, p = row & 15, sdx = kc >> 1, q0 = (kc & 1) * 8;
        float f[8];
        if (sdx <= t) { const float* k = KT + (((size_t)g * 32 + (t - sdx)) * 16 + p) * 16 + q0;
#pragma unroll
            for (int j = 0; j < 8; ++j) f[j] = k[j];
        } else {
#pragma unroll
            for (int j = 0; j < 8; ++j) f[j] = 0.f; }
        *(GAS v4u*)(T5 + ((size_t)(g * 512 + row)) * 640 + kc * 8) = pack8(f); }
}
__device__ __forceinline__ void s5_scan(Frame& F, int idx) {
    const int b = idx >> 11, g = (idx >> 6) & 31, n = idx & 63;
    const float* PW = (const float*)(F.ws + WS_PW); const float* XL = (const float*)(F.ws + WS_XLOC); bf16* A5 = (bf16*)(F.ws + WS_A5);
    const float ar = PW[((size_t)(g * S5N + n) * 33 + 32) * 2], ai = PW[((size_t)(g * S5N + n) * 33 + 32) * 2 + 1];
    float xr = 0.f, xi = 0.f;
    for (int c0 = 0; c0 < 128; c0 += 32) {
        float lr[32], li[32];
#pragma unroll
        for (int j = 0; j < 32; ++j) { const float* p = XL + ((size_t)(b * 128 + c0 + j) * 32 + g) * 128 + n; lr[j] = p[0]; li[j] = p[64]; }
#pragma unroll
        for (int j = 0; j < 32; ++j) { bf16* o = A5 + ((size_t)g * S5I + b * 128 + c0 + j) * 640 + 512 + n; o[0] = (bf16)f2bf(xr); o[64] = (bf16)f2bf(xi);
            const float nr = ar * xr - ai * xi + lr[j], ni = ar * xi + ai * xr + li[j]; xr = nr; xi = ni; }
    }
}

__device__ __forceinline__ void ln1_row(bf16* row, const float* g, const float* b, int lane) {
    const v4u w0 = *(const GAS v4u*)(row + lane * 8), w1 = *(const GAS v4u*)(row + 512 + lane * 8);
    float a[8], c[8]; unpack8(w0, a); unpack8(w1, c);
    float s = 0.f;
#pragma unroll
    for (int j = 0; j < 8; ++j) s += a[j] + c[j];
    const float mean = wave_sum(s) * (1.f / D); float s2 = 0.f;
#pragma unroll
    for (int j = 0; j < 8; ++j) { a[j] -= mean; c[j] -= mean; s2 += a[j] * a[j] + c[j] * c[j]; }
    const float rstd = 1.f / sqrtf(wave_sum(s2) * (1.f / D) + LN_EPS);
    const f32x4 g0 = *(const GAS f32x4*)(g + lane * 8), g1 = *(const GAS f32x4*)(g + lane * 8 + 4), g2 = *(const GAS f32x4*)(g + 512 + lane * 8), g3 = *(const GAS f32x4*)(g + 512 + lane * 8 + 4);
    const f32x4 b0 = *(const GAS f32x4*)(b + lane * 8), b1 = *(const GAS f32x4*)(b + lane * 8 + 4), b2 = *(const GAS f32x4*)(b + 512 + lane * 8), b3 = *(const GAS f32x4*)(b + 512 + lane * 8 + 4);
    const float gg0[8] = {g0.x, g0.y, g0.z, g0.w, g1.x, g1.y, g1.z, g1.w}, gg1[8] = {g2.x, g2.y, g2.z, g2.w, g3.x, g3.y, g3.z, g3.w};
    const float bb0[8] = {b0.x, b0.y, b0.z, b0.w, b1.x, b1.y, b1.z, b1.w}, bb1[8] = {b2.x, b2.y, b2.z, b2.w, b3.x, b3.y, b3.z, b3.w};
#pragma unroll
    for (int j = 0; j < 8; ++j) { a[j] = a[j] * rstd * gg0[j] + bb0[j]; c[j] = c[j] * rstd * gg1[j] + bb1[j]; }
    *(GAS v4u*)(row + lane * 8) = pack8(a); *(GAS v4u*)(row + 512 + lane * 8) = pack8(c);
}

typedef float f32x16 __attribute__((ext_vector_type(16)));
__device__ __forceinline__ int f2ord(float f) { const int x = __builtin_bit_cast(int, f); return x ^ ((x >> 31) & 0x7fffffff); }
__device__ __forceinline__ float ord2f(int x) { return __builtin_bit_cast(float, x ^ ((x >> 31) & 0x7fffffff)); }
#define CE_DESC(a, b) do { const int _h = max((a), (b)), _l = min((a), (b)); (a) = _h; (b) = _l; } while (0)
__device__ __forceinline__ void sort16_desc(int (&v)[16]) {
#pragma unroll
    for (int k = 2; k <= 16; k <<= 1)
#pragma unroll
        for (int j = k >> 1; j > 0; j >>= 1)
#pragma unroll
            for (int i = 0; i < 16; ++i) { const int l = i ^ j; if (l > i) { if ((i & k) == 0) CE_DESC(v[i], v[l]); else CE_DESC(v[l], v[i]); } }
}
__device__ __forceinline__ void merge16_desc(int (&a)[16], const int (&b)[16]) {
#pragma unroll
    for (int i = 0; i < 16; ++i) a[i] = max(a[i], b[15 - i]);
#pragma unroll
    for (int j = 8; j > 0; j >>= 1)
#pragma unroll
        for (int i = 0; i < 16; ++i) { const int l = i ^ j; if (l > i) CE_DESC(a[i], a[l]); }
}
__device__ __forceinline__ void peer_topk_side(const f32x16 (&acc)[4], int hi, int (&top)[16]) {
    int t[4][16];
#pragma unroll
    for (int kt = 0; kt < 4; ++kt)
#pragma unroll
        for (int j = 0; j < 16; ++j) { const unsigned key = (unsigned)(kt * 32 + (j & 3) + 8 * (j >> 2)) | (unsigned)(4 * hi);
            const float av = acc[kt][j];
            t[kt][j] = f2ord(__builtin_bit_cast(float, (__builtin_bit_cast(unsigned, av) & 0xFFFFFF80u) | key)); }
    sort16_desc(t[0]); sort16_desc(t[1]); sort16_desc(t[2]); sort16_desc(t[3]);
    merge16_desc(t[0], t[1]); merge16_desc(t[2], t[3]); merge16_desc(t[0], t[2]);
    int p[16];
#pragma unroll
    for (int i = 0; i < 16; ++i) p[i] = __shfl_xor(t[0][i], 32);
    merge16_desc(t[0], p);
#pragma unroll
    for (int i = 0; i < 16; ++i) top[i] = t[0][i];
}
__device__ __forceinline__ void peer_score_phase(Frame& F, const pg8::StaticOrder& SO) {
    LAS unsigned char* kl = F.lds + RING_OFF;
    LAS unsigned* look = (LAS unsigned*)(F.lds + RING_OFF + 65536 + F.wave * 8192);
    const bf16* keys = (const bf16*)(F.ws + WS_KEYS);
    for (int i = F.tid; i < 2 * 128 * 16; i += NWAVES * 64) { const int sn = i >> 4, c = i & 15, n = sn & 127;
        *(LAS v4u*)(kl + sn * 256 + ((c ^ (n & 15)) << 4)) = *(const GAS v4u*)(keys + (size_t)sn * 128 + c * 8); }
    __syncthreads();
    const int lane = F.lane, r32 = lane & 31, hi = lane >> 5;
    const bf16* Q2 = (const bf16*)(F.ws + WS_Q2);
    int* EIDX = (int*)(F.ws + WS_EIDX); float* EGATE = (float*)(F.ws + WS_EGATE);
    for (int ui = 0;; ++ui) { pg8::Unit gu; if (!SO.next(ui, gu)) break;
        const int blk = gu.pm * 8 + F.wave, h = gu.pn; const size_t tok = (size_t)blk * 32 + r32;
        const bf16* qrow = Q2 + tok * NQ2 + h * PQ + hi * 8;
        int top1[16], top2[16];
        bf16x8 qfs[2][8];
#pragma unroll
        for (int s = 0; s < 2; ++s)
#pragma unroll
            for (int ks = 0; ks < 8; ++ks) qfs[s][ks] = *(const GAS bf16x8*)(qrow + s * 128 + ks * 16);
#pragma unroll
        for (int s = 0; s < 2; ++s) {
            f32x16 acc[4];
#pragma unroll
            for (int kt = 0; kt < 4; ++kt) { acc[kt] = (f32x16){0.f, 0.f, 0.f, 0.f, 0.f, 0.f, 0.f, 0.f, 0.f, 0.f, 0.f, 0.f, 0.f, 0.f, 0.f, 0.f};
                const int n = kt * 32 + r32;
#pragma unroll
                for (int ks = 0; ks < 8; ++ks) { const bf16x8 kf = *(const LAS bf16x8*)(kl + (s * 128 + n) * 256 + (((2 * ks + hi) ^ (n & 15)) << 4));
                    acc[kt] = __builtin_amdgcn_mfma_f32_32x32x16_bf16(kf, qfs[s][ks], acc[kt], 0, 0, 0); } }
            if (s == 0) peer_topk_side(acc, hi, top1); else peer_topk_side(acc, hi, top2);
        }
        float v1[16], v2[16];
#pragma unroll
        for (int i = 0; i < 16; ++i) { v1[i] = ord2f(top1[i]); v2[i] = ord2f(top2[i]);
            look[i * 64 + lane] = __builtin_bit_cast(unsigned, v1[i]) & 0x7Fu; look[(16 + i) * 64 + lane] = __builtin_bit_cast(unsigned, v2[i]) & 0x7Fu; }
        int c[4][16]; int nc = 0;
#pragma unroll
        for (int i = 0; i < 16; ++i)
#pragma unroll
            for (int j = 0; j < 16; ++j) if ((i + 1) * (j + 1) <= 16) { const float sum = v1[i] + v2[j];
                c[nc >> 4][nc & 15] = f2ord(__builtin_bit_cast(float, (__builtin_bit_cast(unsigned, sum) & 0xFFFFFF00u) | (unsigned)(i * 16 + j))); ++nc; }
#pragma unroll
        for (int q = 50; q < 64; ++q) c[q >> 4][q & 15] = (int)0x80000000;
        sort16_desc(c[0]); sort16_desc(c[1]); sort16_desc(c[2]); sort16_desc(c[3]);
        merge16_desc(c[0], c[1]); merge16_desc(c[2], c[3]); merge16_desc(c[0], c[2]);
        float e[16], sum = 0.f;
        float cf[16];
#pragma unroll
        for (int k = 0; k < 16; ++k) cf[k] = ord2f(c[0][k]);
#pragma unroll
        for (int k = 0; k < 16; ++k) { e[k] = __expf(cf[k] - cf[0]); sum += e[k]; }
        const float inv = 1.f / sum;
        LDS_WAIT();
        int ex[8]; float gt[8];
#pragma unroll
        for (int k = 0; k < 8; ++k) { const float cv = hi ? cf[8 + k] : cf[k]; gt[k] = (hi ? e[8 + k] : e[k]) * inv;
            const unsigned pos = __builtin_bit_cast(unsigned, cv) & 0xFFu;
            ex[k] = (int)(look[(pos >> 4) * 64 + lane] * PK + look[(16 + (pos & 15)) * 64 + lane]); }
        int* eo = EIDX + (tok * PH + h) * 16 + hi * 8; float* go = EGATE + (tok * PH + h) * 16 + hi * 8;
        *(GAS v4u*)eo = (v4u){(unsigned)ex[0], (unsigned)ex[1], (unsigned)ex[2], (unsigned)ex[3]}; *(GAS v4u*)(eo + 4) = (v4u){(unsigned)ex[4], (unsigned)ex[5], (unsigned)ex[6], (unsigned)ex[7]};
        *(GAS f32x4*)go = (f32x4){gt[0], gt[1], gt[2], gt[3]}; *(GAS f32x4*)(go + 4) = (f32x4){gt[4], gt[5], gt[6], gt[7]};
        LDS_WAIT();
    }
}

constexpr float PD_SCALE = 256.f, PU_SCALE = 32.f;
__device__ __forceinline__ void unpack_fp8x16(const v4u w, float (&f)[16]) {
    const unsigned ww[4] = {w.x, w.y, w.z, w.w};
#pragma unroll
    for (int i = 0; i < 4; ++i) { const f32x2 lo = __builtin_amdgcn_cvt_pk_f32_fp8((int)ww[i], false), hi = __builtin_amdgcn_cvt_pk_f32_fp8((int)ww[i], true);
        f[4 * i] = lo[0]; f[4 * i + 1] = lo[1]; f[4 * i + 2] = hi[0]; f[4 * i + 3] = hi[1]; }
}
__device__ __forceinline__ void peer_sort_experts(int& e0, int& e1, float& g0, float& g1, int lane) {
    int k0 = e0 * 128 + lane, k1 = e1 * 128 + 64 + lane;
#pragma unroll
    for (int k = 2; k <= 128; k <<= 1)
#pragma unroll
        for (int j = k >> 1; j > 0; j >>= 1) {
            if (j == 64) { const int lo = min(k0, k1), hi = max(k0, k1); k0 = lo; k1 = hi; }
            else { const int p0 = __shfl_xor(k0, j), p1 = __shfl_xor(k1, j); const bool lower = (lane & j) == 0;
                const bool asc0 = (lane & k) == 0, asc1 = ((64 + lane) & k) == 0;
                k0 = (lower == asc0) ? min(k0, p0) : max(k0, p0); k1 = (lower == asc1) ? min(k1, p1) : max(k1, p1); }
        }
    const int s0 = k0 & 127, s1 = k1 & 127;
    const float a0 = __shfl(g0, s0 & 63), b0 = __shfl(g1, s0 & 63), a1 = __shfl(g0, s1 & 63), b1 = __shfl(g1, s1 & 63);
    g0 = (s0 < 64) ? a0 : b0; g1 = (s1 < 64) ? a1 : b1; e0 = k0 >> 7; e1 = k1 >> 7;
}
typedef long i64_t;
__device__ __forceinline__ void peer_gather_phase(Frame& F) {
    const int gw = F.vcu * NWAVES + F.wave, NGW = F.G * NWAVES, lane = F.lane;
    const bf16* H1 = (const bf16*)(F.ws + WS_H); const unsigned char* PD = F.ws + WS_PD; const unsigned char* PU = F.ws + WS_PU;
    const int* EIDX = (const int*)(F.ws + WS_EIDX); const float* EGATE = (const float*)(F.ws + WS_EGATE);
    const int rep = ((lane >> 5) & 1) * 4 + ((lane >> 4) & 1) * 2 + ((lane >> 3) & 1);
    const bool diag = ((lane & 15) >> 2) == (lane >> 4); const int dr = lane & 3;
    const float m0 = (diag && dr == 0) ? 1.f : 0.f, m1 = (diag && dr == 1) ? 1.f : 0.f, m2 = (diag && dr == 2) ? 1.f : 0.f, m3 = (diag && dr == 3) ? 1.f : 0.f;
    constexpr int GT = 4; constexpr float XS = 16.f, AS = 32.f;
    const int si = lane & 15, sq = lane >> 4;
    const unsigned sb = 0xFFu << (8 * (si & 3));
    const unsigned m0lo = (sq == (si >> 3) && (si & 7) < 4) ? sb : 0u, m0hi = (sq == (si >> 3) && (si & 7) >= 4) ? sb : 0u;
    const unsigned m1lo = (sq == 2 + (si >> 3) && (si & 7) < 4) ? sb : 0u, m1hi = (sq == 2 + (si >> 3) && (si & 7) >= 4) ? sb : 0u;
    for (int pr = gw; pr < M / GT; pr += NGW) {
        __syncthreads();
        const size_t tokA = (size_t)pr * GT;
        int e0[GT], e1[GT]; float g0[GT], g1[GT]; f32x4 os[GT][4]; i64_t xb0[GT], xb1[GT];
#pragma unroll
        for (int t = 0; t < GT; ++t) { float a[8], c[8]; unpack8(*(const GAS v4u*)(H1 + (tokA + t) * D + lane * 16), a); unpack8(*(const GAS v4u*)(H1 + (tokA + t) * D + lane * 16 + 8), c);
            unsigned q0, q1, q2, q3; int pk;
            pk = __builtin_amdgcn_cvt_pk_fp8_f32(a[0] * XS, a[1] * XS, 0, false); pk = __builtin_amdgcn_cvt_pk_fp8_f32(a[2] * XS, a[3] * XS, pk, true); q0 = (unsigned)pk;
            pk = __builtin_amdgcn_cvt_pk_fp8_f32(a[4] * XS, a[5] * XS, 0, false); pk = __builtin_amdgcn_cvt_pk_fp8_f32(a[6] * XS, a[7] * XS, pk, true); q1 = (unsigned)pk;
            pk = __builtin_amdgcn_cvt_pk_fp8_f32(c[0] * XS, c[1] * XS, 0, false); pk = __builtin_amdgcn_cvt_pk_fp8_f32(c[2] * XS, c[3] * XS, pk, true); q2 = (unsigned)pk;
            pk = __builtin_amdgcn_cvt_pk_fp8_f32(c[4] * XS, c[5] * XS, 0, false); pk = __builtin_amdgcn_cvt_pk_fp8_f32(c[6] * XS, c[7] * XS, pk, true); q3 = (unsigned)pk;
            xb0[t] = (i64_t)(((unsigned long long)q1 << 32) | q0); xb1[t] = (i64_t)(((unsigned long long)q3 << 32) | q2);
            e0[t] = EIDX[(tokA + t) * 128 + lane]; e1[t] = EIDX[(tokA + t) * 128 + 64 + lane]; g0[t] = EGATE[(tokA + t) * 128 + lane]; g1[t] = EGATE[(tokA + t) * 128 + 64 + lane];
            peer_sort_experts(e0[t], e1[t], g0[t], g1[t], lane);
#pragma unroll
            for (int j = 0; j < 4; ++j) os[t][j] = (f32x4){0.f, 0.f, 0.f, 0.f}; }
#define GATHER_BATCH(E0, E1, G0, G1, XB0, XB1, O) do { const int ev = (bt < 8) ? E0 : E1; const float gv = (bt < 8) ? G0 : G1; const int lb8 = (bt & 7) * 8; v4u dw[8], uw[8]; \
            _Pragma("unroll") for (int i = 0; i < 8; ++i) { const int e = __builtin_amdgcn_readlane(ev, lb8 + i); dw[i] = *(const GAS v4u*)(PD + (size_t)e * D + lane * 16); uw[i] = *(const GAS v4u*)(PU + (size_t)e * D + lane * 16); } \
            float p[8]; \
            _Pragma("unroll") for (int i = 0; i < 8; ++i) { f32x4 dacc = (f32x4){0.f, 0.f, 0.f, 0.f}; \
                dacc = __builtin_amdgcn_mfma_f32_16x16x32_fp8_fp8((i64_t)(((unsigned long long)dw[i].y << 32) | dw[i].x), XB0, dacc, 0, 0, 0); \
                dacc = __builtin_amdgcn_mfma_f32_16x16x32_fp8_fp8((i64_t)(((unsigned long long)dw[i].w << 32) | dw[i].z), XB1, dacc, 0, 0, 0); \
                const float d0 = dacc[0] * m0, d1 = dacc[1] * m1, d2 = dacc[2] * m2, d3 = dacc[3] * m3; p[i] = (d0 + d1) + (d2 + d3); } \
            _Pragma("unroll") for (int i = 0; i < 4; ++i) { const float keep = (lane & 32) ? p[i + 4] : p[i], send = (lane & 32) ? p[i] : p[i + 4]; p[i] = keep + __shfl_xor(send, 32); } \
            _Pragma("unroll") for (int i = 0; i < 2; ++i) { const float keep = (lane & 16) ? p[i + 2] : p[i], send = (lane & 16) ? p[i] : p[i + 2]; p[i] = keep + __shfl_xor(send, 16); } \
            { const float keep = (lane & 8) ? p[1] : p[0], send = (lane & 8) ? p[0] : p[1]; p[0] = keep + __shfl_xor(send, 8); } \
            p[0] += __shfl_xor(p[0], 4); p[0] += __shfl_xor(p[0], 2); p[0] += __shfl_xor(p[0], 1); \
            const float gate = __shfl(gv, lb8 + rep); const float act = gelu_tanh(p[0] * (1.f / (PD_SCALE * XS))) * gate * AS; \
            const int act8 = __builtin_amdgcn_cvt_pk_fp8_f32(act, 0.f, 0, false) & 0xff; \
            _Pragma("unroll") for (int i = 0; i < 8; ++i) { const unsigned a8 = (unsigned)__builtin_amdgcn_readlane(act8, ((i >> 2) & 1) * 32 + ((i >> 1) & 1) * 16 + (i & 1) * 8) * 0x01010101u; \
                const i64_t A0 = (i64_t)(((unsigned long long)(a8 & m0hi) << 32) | (a8 & m0lo)), A1 = (i64_t)(((unsigned long long)(a8 & m1hi) << 32) | (a8 & m1lo)); \
                const i64_t B0 = (i64_t)(((unsigned long long)uw[i].y << 32) | uw[i].x), B1 = (i64_t)(((unsigned long long)uw[i].w << 32) | uw[i].z); \
                O[0] = __builtin_amdgcn_mfma_f32_16x16x32_fp8_fp8(A0, B0, O[0], 0, 0, 0); O[1] = __builtin_amdgcn_mfma_f32_16x16x32_fp8_fp8(A1, B0, O[1], 0, 0, 0); \
                O[2] = __builtin_amdgcn_mfma_f32_16x16x32_fp8_fp8(A0, B1, O[2], 0, 0, 0); O[3] = __builtin_amdgcn_mfma_f32_16x16x32_fp8_fp8(A1, B1, O[3], 0, 0, 0); } } while (0)
#pragma unroll 1
        for (int bt = 0; bt < 16; ++bt) { if ((bt & 3) == 0) __syncthreads();
#pragma unroll
            for (int t = 0; t < GT; ++t) { GATHER_BATCH(e0[t], e1[t], g0[t], g1[t], xb0[t], xb1[t], os[t]); __builtin_amdgcn_sched_barrier(0); } }
#undef GATHER_BATCH
#pragma unroll
        for (int t = 0; t < GT; ++t) {
            float o[16]; float s = 0.f;
#pragma unroll
            for (int a4 = 0; a4 < 4; ++a4) { const int hf = a4 >> 1, kh = a4 & 1, c0 = 16 * si + 256 * ((sq >> 1) + 2 * kh) + 8 * hf + 4 * (sq & 1);
                const v2u hw = *(const GAS v2u*)(H1 + (tokA + t) * D + c0);
                const float x0 = __builtin_bit_cast(float, hw.x << 16), x1 = __builtin_bit_cast(float, hw.x & 0xffff0000u), x2 = __builtin_bit_cast(float, hw.y << 16), x3 = __builtin_bit_cast(float, hw.y & 0xffff0000u);
                const f32x4 ov = os[t][a4];
                o[4 * a4 + 0] = ov[0] * (1.f / (AS * PU_SCALE)) + DN_ALPHA * x0; o[4 * a4 + 1] = ov[1] * (1.f / (AS * PU_SCALE)) + DN_ALPHA * x1;
                o[4 * a4 + 2] = ov[2] * (1.f / (AS * PU_SCALE)) + DN_ALPHA * x2; o[4 * a4 + 3] = ov[3] * (1.f / (AS * PU_SCALE)) + DN_ALPHA * x3;
                s += (o[4 * a4 + 0] + o[4 * a4 + 1]) + (o[4 * a4 + 2] + o[4 * a4 + 3]); }
            const float mean = wave_sum(s) * (1.f / D); float s2 = 0.f;
#pragma unroll
            for (int j = 0; j < 16; ++j) { o[j] -= mean; s2 += o[j] * o[j]; }
            const float rstd = 1.f / sqrtf(wave_sum(s2) * (1.f / D) + LN_EPS);
#pragma unroll
            for (int a4 = 0; a4 < 4; ++a4) { const int hf = a4 >> 1, kh = a4 & 1, c0 = 16 * si + 256 * ((sq >> 1) + 2 * kh) + 8 * hf + 4 * (sq & 1);
                const f32x4 ga = *(const GAS f32x4*)(F.in[I_LN2G] + c0), ba = *(const GAS f32x4*)(F.in[I_LN2B] + c0);
                f32x4 y; y.x = o[4 * a4 + 0] * rstd * ga.x + ba.x; y.y = o[4 * a4 + 1] * rstd * ga.y + ba.y; y.z = o[4 * a4 + 2] * rstd * ga.z + ba.z; y.w = o[4 * a4 + 3] * rstd * ga.w + ba.w;
                *(GAS f32x4*)(F.out + (tokA + t) * D + c0) = y; }
        }
    }
}

struct Args { const float* in[26]; float* out; unsigned char* ws; int ph_lo, ph_hi, li, pad; };
__global__ void __launch_bounds__(NWAVES * 64, 2) fwd_kernel(Args args) {
    extern __shared__ __attribute__((aligned(16))) unsigned char lds[];
    Frame F;
    F.lds = (LAS unsigned char*)lds;
    F.MISC = (volatile LAS unsigned*)(F.lds + MISC_OFF);
    F.tid = threadIdx.x; F.lane = F.tid & 63; F.wave = __builtin_amdgcn_readfirstlane(F.tid >> 6);
    F.G = gridDim.x; { const int bx = blockIdx.x; F.vcu = (F.G % 8 == 0) ? (bx % 8) * (F.G / 8) + bx / 8 : bx; }
#pragma unroll
    for (int i = 0; i < 26; ++i) F.in[i] = args.in[i];
    F.out = args.out; F.ws = args.ws;
    unsigned char* ws = args.ws;
    F.ctl = (gu32*)(ws + WS_CTL);
    for (int u = F.tid; u < (LDS_BYTES - LDSCTL_OFF) / 4; u += NWAVES * 64) ((LAS unsigned*)(F.lds + LDSCTL_OFF))[u] = 0u;
    __syncthreads();
    XcdBarrier bar; bar.bar = (unsigned*)(F.ctl + CW_BAR); bar.x = 0; bar.st = nullptr; bar.G = 0;
    XcdBarrier bar2 = bar;
    if (N_LAUNCHES == 1) { bar = xcd_barrier_post((unsigned*)(F.ctl + CW_BAR), F.MISC + 8, (unsigned)F.G);
        if (F.vcu >= 128) bar2 = xcd_barrier_post((unsigned*)(F.ctl + CW_BAR2), F.MISC + 10, (unsigned)(F.G - 128)); }
#define GRID_BAR() do { if (N_LAUNCHES == 1) xcd_barrier(bar); } while (0)
    const int lo = args.ph_lo, hi = args.ph_hi;
#define IN(k) (lo <= (k) && (k) < hi)
#define BOTH(k) (IN(k) && IN((k) + 1))
    bf16* const Hb = (bf16*)(ws + WS_H);
    bf16* const PRJ = (bf16*)(ws + WS_PROJ);

    if (IN(0)) { p0_prologue(F); if (BOTH(0)) GRID_BAR(); }

    if (IN(1)) {
        s5_tables_stage1(F);
        pg8::Gemm g{Hb, (const bf16*)(ws + WS_WIN), M, NPROJ, D, D, D}; pg8::StaticOrder S; S.init(M, NPROJ, F.G, (int)blockIdx.x);
        pg8::EpiProj E{PRJ, PRJ + (size_t)M * 512, PRJ + (size_t)2 * M * 512, PRJ + (size_t)3 * M * 512, (bf16*)(ws + WS_A5), (const float*)(ws + WS_LB), M};
        pg8::gemm_phase<pg8::EpiProj, pg8::StaticOrder, true, true>(F.lds + RING_OFF, g, S, E);
        if (BOTH(1)) GRID_BAR();
    }

    if (IN(2)) {
        s5_tables_stage2(F);
        if (F.vcu < 128) hgrn2_state_pass(F, F.vcu);
        else { pg8::Gemm g{(const bf16*)(ws + WS_A5), (const bf16*)(ws + WS_G5), 32 * S5I, 32 * 256, 512, S5K, 512}; pg8::GroupedOrder S{4, 1, F.G - 128, F.vcu - 128};
            pg8::EpiS5A E{(float*)(ws + WS_XLOC)};
            pg8::gemm_phase<pg8::EpiS5A, pg8::GroupedOrder, true, true>(F.lds + RING_OFF, g, S, E);
            if (N_LAUNCHES == 1) { xcd_barrier(bar2); if (F.vcu - 128 < 32) s5_scan(F, (F.vcu - 128) * 512 + F.tid); }
        }
        { constexpr int NTAB16 = PE * D / 16, NCHUNK = 2 * NTAB16 / 4096;
          for (;;) {
              if (F.tid == 0) F.MISC[4] = xb_add((unsigned*)(F.ctl + CW_CONV), 1u);
              __syncthreads();
              const int ch = (int)F.MISC[4];
              __syncthreads();
              if (ch >= NCHUNK) break;
#pragma unroll 2
              for (int q8 = 0; q8 < 8; ++q8) { const int i = ch * 4096 + q8 * 512 + F.tid; const bool up = i >= NTAB16; const int j = up ? i - NTAB16 : i; const float* src = (up ? F.in[I_PU] : F.in[I_PD]) + (size_t)j * 16; const float sc = up ? PU_SCALE : PD_SCALE;
                  v4u o; unsigned ow[4];
#pragma unroll
                  for (int q = 0; q < 4; ++q) { const f32x4 a = *(const GAS f32x4*)(src + 4 * q); int pk = __builtin_amdgcn_cvt_pk_fp8_f32(a.x * sc, a.y * sc, 0, false); pk = __builtin_amdgcn_cvt_pk_fp8_f32(a.z * sc, a.w * sc, pk, true); ow[q] = (unsigned)pk; }
                  o.x = ow[0]; o.y = ow[1]; o.z = ow[2]; o.w = ow[3];
                  *(GAS v4u*)(ws + (up ? WS_PU : WS_PD) + (size_t)j * 16) = o; }
          } }
        if (BOTH(2)) GRID_BAR();
    }

    if (IN(3)) {
        if (N_LAUNCHES != 1) { if (F.vcu < 32) s5_scan(F, F.vcu * 512 + F.tid); }
        { pg8::Gemm g{(const bf16*)(ws + WS_A5), (const bf16*)(ws + WS_T5), 32 * S5I, 32 * 512, S5K, S5K, S5K}; pg8::GroupedOrder S{4, 2, F.G, F.vcu};
          pg8::EpiS5C E{(bf16*)(ws + WS_Z)};
          pg8::gemm_phase<pg8::EpiS5C, pg8::GroupedOrder, true, true>(F.lds + RING_OFF, g, S, E); }
        hgrn2_out_phase(F);
        if (BOTH(3)) GRID_BAR();
    }

    if (IN(4)) {
        pg8::Gemm g{(const bf16*)(ws + WS_Z), (const bf16*)(ws + WS_WGLU), M, 512, 512, 512, 512}; pg8::StaticOrder S; S.init(M, 512, F.G, (int)blockIdx.x);
        pg8::EpiGlu E{(const bf16*)(ws + WS_Z), (bf16*)(ws + WS_MIX), F.in[I_BGLU]};
        pg8::gemm_phase<pg8::EpiGlu, pg8::StaticOrder, true, true>(F.lds + RING_OFF, g, S, E);
        if (BOTH(4)) GRID_BAR();
    }

    if (IN(5)) {
        pg8::Gemm g{(const bf16*)(ws + WS_MIX), (const bf16*)(ws + WS_WOUT), M, D, D, D, D}; pg8::StaticOrder S; S.init(M, D, F.G, (int)blockIdx.x);
        pg8::EpiOut E{Hb, DN_ALPHA};
        pg8::gemm_phase<pg8::EpiOut, pg8::StaticOrder, true, true>(F.lds + RING_OFF, g, S, E);
        if (BOTH(5)) GRID_BAR();
    }

    if (IN(6)) {
        const int gw = F.vcu * NWAVES + F.wave, NGW = F.G * NWAVES;
        for (int m = gw; m < M; m += NGW) ln1_row(Hb + (size_t)m * D, F.in[I_LN1G], F.in[I_LN1B], F.lane);
        if (BOTH(6)) GRID_BAR();
    }

    if (IN(7)) {
        pg8::Gemm g{Hb, (const bf16*)(ws + WS_WQ), M, NQ2, D, D, D}; pg8::StaticOrder S; S.init(M, NQ2, F.G, (int)blockIdx.x);
        pg8::EpiStore E{(bf16*)(ws + WS_Q2), NQ2};
        pg8::gemm_phase<pg8::EpiStore, pg8::StaticOrder, true, true>(F.lds + RING_OFF, g, S, E);
        VM_WAIT(); __syncthreads();
        if (F.tid == 0) { __builtin_amdgcn_fence(__ATOMIC_ACQUIRE, "agent"); VM_WAIT(); }
        __syncthreads();
        peer_score_phase(F, S);
        if (BOTH(7)) GRID_BAR();
    }

    if (IN(8)) { peer_gather_phase(F); }
#undef IN
#undef BOTH
}

extern "C" void kernel_launch(void* const* d_in, const int* in_sizes, int n_in, void* d_out, int out_size, void* d_ws, size_t ws_size, hipStream_t stream) {
    static int grid = 0;
    if (grid == 0) {
        if (n_in != 26 || in_sizes[0] != M * D || out_size != M * D || ws_size < WS_END) { fprintf(stderr, "kernel_launch: unexpected shapes: n_in %d in0 %d out %d ws %zu (need %zu)\n", n_in, n_in > 0 ? in_sizes[0] : -1, out_size, ws_size, (size_t)WS_END); grid = -1; return; }
        int dev = 0, cus = 0;
        if (hipGetDevice(&dev) != hipSuccess || hipDeviceGetAttribute(&cus, hipDeviceAttributeMultiprocessorCount, dev) != hipSuccess) { grid = -1; return; }
        if (hipFuncSetAttribute((const void*)fwd_kernel, hipFuncAttributeMaxDynamicSharedMemorySize, LDS_BYTES) != hipSuccess) { fprintf(stderr, "kernel_launch: hipFuncSetAttribute failed\n"); grid = -1; return; }
        (void)hipGetLastError();
        grid = cus;
    }
    if (grid < 0) return;
    if (hipMemsetAsync((char*)d_ws + WS_CTL, 0, CTL_ZERO_BYTES, stream) != hipSuccess) return;
    Args a{};
    for (int i = 0; i < 26; ++i) a.in[i] = (const float*)d_in[i];
    a.out = (float*)d_out; a.ws = (unsigned char*)d_ws;
    if (N_LAUNCHES == 1) { a.ph_lo = 0; a.ph_hi = NPH; a.li = 0; hipLaunchKernelGGL(fwd_kernel, dim3(grid), dim3(NWAVES * 64), LDS_BYTES, stream, a); }
    else for (int li = 0; li < NPH; ++li) { a.ph_lo = li; a.ph_hi = li + 1; a.li = li; hipLaunchKernelGGL(fwd_kernel, dim3(grid), dim3(NWAVES * 64), LDS_BYTES, stream, a); }
}
```
